# Optimizing an MI355X kernel written in HIP

```python
import math
import jax
import jax.numpy as jnp
from jax import lax
import numpy as np

D_MODEL = 1024
BATCH = 1
SEQ = 16384
DEPTH = 1
DEC_BATCH = 8
DEC_SEQ = 2048
PAST_LEN = 128

DA_HEADS = 4
DA_HEAD_DIM = 64
DA_V_DIM = 2 * DA_HEAD_DIM
DA_WIDTH = DA_HEADS * DA_V_DIM
RW_WIDTH = D_MODEL - DA_WIDTH
RW_HEAD = 64
RW_HEADS = RW_WIDTH // RW_HEAD
DECAY_LORA = 64
ICLR_LORA = 64
GATE_LORA = 128
D_FF = 4 * D_MODEL
ROPE_THETA = 10000.0
Q_BLOCK = 128
NORM_EPS = 1e-6
LN_X_EPS = 64e-5
DA_QK_COLS = DA_HEADS * 2 * DA_HEAD_DIM
DA_COLS = 2 * DA_QK_COLS + DA_WIDTH
RW_COLS = 3 * RW_WIDTH + DECAY_LORA + ICLR_LORA + GATE_LORA
IN_COLS = DA_COLS + RW_COLS

kernel_name = "hymba_diffattn_birwkv7_encoder"


def rms_norm(x, g, eps=NORM_EPS):
    xf = x.astype(jnp.float32)
    y = xf * lax.rsqrt(jnp.mean(xf * xf, axis=-1, keepdims=True) + eps)
    return (y * g.astype(jnp.float32)).astype(x.dtype)


def rope_tables(seq_len):
    inv_freq = 1.0 / (ROPE_THETA ** (jnp.arange(0, DA_HEAD_DIM, 2, dtype=jnp.float32) / DA_HEAD_DIM))
    ang = jnp.arange(seq_len, dtype=jnp.float32)[:, None] * inv_freq[None, :]
    ang = jnp.concatenate([ang, ang], axis=-1)
    return jnp.cos(ang), jnp.sin(ang)


def apply_rope(x, cos, sin):
    half = DA_HEAD_DIM // 2
    xf = x.astype(jnp.float32)
    rot = jnp.concatenate([-xf[..., half:], xf[..., :half]], axis=-1)
    c = cos[None, :, None, None, :]
    s = sin[None, :, None, None, :]
    return (xf * c + rot * s).astype(x.dtype)


def diff_attention(q, k, v, lam):
    B, S = q.shape[0], q.shape[1]
    nb = S // Q_BLOCK
    scale = DA_HEAD_DIM ** -0.5
    qb = jnp.moveaxis(q.reshape(B, nb, Q_BLOCK, DA_HEADS, 2, DA_HEAD_DIM), 1, 0)

    def one_block(q_blk):
        s = jnp.einsum("bqhcd,bkhcd->bhcqk", q_blk, k, preferred_element_type=jnp.float32) * scale
        p = jax.nn.softmax(s, axis=-1)
        attn = p[:, :, 0] - lam * p[:, :, 1]
        return jnp.einsum("bhqk,bkhe->bqhe", attn.astype(v.dtype), v)

    o = lax.map(one_block, qb)
    return jnp.moveaxis(o, 0, 1).reshape(B, S, DA_HEADS, DA_V_DIM)


def diff_attn_mixer(z, cos, sin, lambda_init, q_norm_g, k_norm_g, lam_q1, lam_k1, lam_q2, lam_k2, subln_g):
    B, S = z.shape[0], z.shape[1]
    q = z[..., :DA_QK_COLS].reshape(B, S, DA_HEADS, 2, DA_HEAD_DIM)
    k = z[..., DA_QK_COLS:2 * DA_QK_COLS].reshape(B, S, DA_HEADS, 2, DA_HEAD_DIM)
    v = z[..., 2 * DA_QK_COLS:].reshape(B, S, DA_HEADS, DA_V_DIM)
    q = apply_rope(rms_norm(q, q_norm_g), cos, sin)
    k = apply_rope(rms_norm(k, k_norm_g), cos, sin)
    lam = (jnp.exp(jnp.sum(lam_q1.astype(jnp.float32) * lam_k1.astype(jnp.float32)))
           - jnp.exp(jnp.sum(lam_q2.astype(jnp.float32) * lam_k2.astype(jnp.float32)))
           + lambda_init)
    o = diff_attention(q, k, v, lam)
    o = rms_norm(o, subln_g) * (1.0 - lambda_init)
    return o.reshape(B, S, DA_WIDTH)


def rwkv7_scan(r, w, k, v, a, b):
    def step(state, inp):
        r_t, w_t, k_t, v_t, a_t, b_t = inp
        sa = jnp.einsum("dbhij,dbhj->dbhi", state, a_t)
        state = (state * w_t[..., None, :] + sa[..., :, None] * b_t[..., None, :]
                 + v_t[..., :, None] * k_t[..., None, :])
        y = jnp.einsum("dbhij,dbhj->dbhi", state, r_t)
        return state, y

    s0 = jnp.zeros(r.shape[1:] + (RW_HEAD,), jnp.float32)
    _, y = lax.scan(step, s0, (r, w, k, v, a, b))
    return y


def rwkv7_mixer(z, mu_prev, mu_next, w0, w_up, a0, a_up, g_up, k_k, k_a, r_k, ln_x_g, ln_x_b):
    B, S = z.shape[0], z.shape[1]
    zf = z.astype(jnp.float32)
    z_prev = jnp.pad(zf[:, :-1], ((0, 0), (1, 0), (0, 0)))
    z_next = jnp.pad(zf[:, 1:], ((0, 0), (0, 1), (0, 0)))
    zf = zf + mu_prev * (z_prev - zf) + mu_next * (z_next - zf)
    o1, o2, o3 = RW_WIDTH, 2 * RW_WIDTH, 3 * RW_WIDTH
    o4 = o3 + DECAY_LORA
    o5 = o4 + ICLR_LORA
    r, k, v = zf[..., :o1], zf[..., o1:o2], zf[..., o2:o3]
    w_dn, a_dn, g_dn = zf[..., o3:o4], zf[..., o4:o5], zf[..., o5:]
    w_log = -jax.nn.softplus(-(w0[:, None, None, :] + jnp.einsum("bsr,drc->dbsc", jnp.tanh(w_dn), w_up))) - 0.5
    decay = jnp.exp(-jnp.exp(w_log))
    a_rate = jax.nn.sigmoid(a0[:, None, None, :] + jnp.einsum("bsr,drc->dbsc", a_dn, a_up))
    g = jnp.einsum("bsr,rc->bsc", jax.nn.sigmoid(g_dn), g_up)

    def heads(t):
        return t.reshape(t.shape[:-1] + (RW_HEADS, RW_HEAD))

    kk = heads(k * k_k)
    kk = kk * lax.rsqrt(jnp.sum(kk * kk, axis=-1, keepdims=True) + 1e-12)
    k_dir = heads(k[None] * (1.0 + (a_rate - 1.0) * k_a))
    a_dir = heads(a_rate)
    decay = heads(decay)
    r_h, v_h = heads(r), heads(v)

    def both(t):
        return jnp.broadcast_to(t[None], (2,) + t.shape)

    def time_major(t):
        t = jnp.stack([t[0], jnp.flip(t[1], axis=1)])
        return jnp.moveaxis(t, 2, 0)

    y = rwkv7_scan(time_major(both(r_h)), time_major(decay), time_major(k_dir),
                   time_major(both(v_h)), time_major(both(-kk)), time_major(kk[None] * a_dir))
    y = jnp.moveaxis(y, 0, 2)
    y = y[0] + jnp.flip(y[1], axis=1)
    mean = jnp.mean(y, axis=-1, keepdims=True)
    var = jnp.mean(jnp.square(y - mean), axis=-1, keepdims=True)
    y = ((y - mean) * lax.rsqrt(var + LN_X_EPS)).reshape(B, S, RW_WIDTH) * ln_x_g + ln_x_b
    bonus = jnp.sum(r_h[None] * k_dir * r_k, axis=-1, keepdims=True) * v_h[None]
    y = y + jnp.sum(bonus, axis=0).reshape(B, S, RW_WIDTH)
    return (y * g).astype(z.dtype)


def encoder_layer(x, cos, sin, lambda_init, norm1_g, w_in, q_norm_g, k_norm_g, lam_q1, lam_k1,
                  lam_q2, lam_k2, subln_g, mu_prev, mu_next, w0, w_up, a0, a_up, g_up, k_k, k_a,
                  r_k, ln_x_g, ln_x_b, w_out, norm2_g, w_ff1, w_ff2):
    h = rms_norm(x, norm1_g)
    z = jnp.einsum("bsd,dc->bsc", h, w_in)
    o_da = diff_attn_mixer(z[..., :DA_COLS], cos, sin, lambda_init, q_norm_g, k_norm_g,
                           lam_q1, lam_k1, lam_q2, lam_k2, subln_g)
    o_rw = rwkv7_mixer(z[..., DA_COLS:], mu_prev, mu_next, w0, w_up, a0, a_up, g_up,
                       k_k, k_a, r_k, ln_x_g, ln_x_b)
    mixed = jnp.concatenate([o_da, o_rw.astype(o_da.dtype)], axis=-1)
    x = x + jnp.einsum("bsc,cd->bsd", mixed, w_out)
    h2 = rms_norm(x, norm2_g)
    u = jax.nn.relu(jnp.einsum("bsd,df->bsf", h2, w_ff1))
    return x + jnp.einsum("bsf,fd->bsd", u * u, w_ff2)


def setup_inputs(seed: int = 0) -> dict:
    key = jax.random.key(seed)
    ks = jax.random.split(key, 32)
    f32 = jnp.float32
    nrm = lambda i, shape: jax.random.normal(ks[i], shape, f32)
    L = DEPTH
    return {
        "x_prompt": nrm(0, (BATCH, SEQ, D_MODEL)),
        "x_sample": nrm(1, (DEC_BATCH, DEC_SEQ, D_MODEL)),
        "norm1_g": 1.0 + 0.02 * nrm(2, (L, D_MODEL)),
        "w_in": nrm(3, (L, D_MODEL, IN_COLS)) * D_MODEL ** -0.5,
        "q_norm_g": 1.0 + 0.02 * nrm(4, (L, DA_HEAD_DIM)),
        "k_norm_g": 1.0 + 0.02 * nrm(5, (L, DA_HEAD_DIM)),
        "lam_q1": 0.1 * nrm(6, (L, DA_HEAD_DIM)),
        "lam_k1": 0.1 * nrm(7, (L, DA_HEAD_DIM)),
        "lam_q2": 0.1 * nrm(8, (L, DA_HEAD_DIM)),
        "lam_k2": 0.1 * nrm(9, (L, DA_HEAD_DIM)),
        "subln_g": 1.0 + 0.02 * nrm(10, (L, DA_V_DIM)),
        "mu_prev": jax.random.uniform(ks[11], (L, RW_COLS), f32, 0.0, 0.5),
        "mu_next": jax.random.uniform(ks[12], (L, RW_COLS), f32, 0.0, 0.5),
        "w0": jax.random.uniform(ks[13], (L, 2, RW_WIDTH), f32, -4.0, 0.0),
        "w_up": 0.5 * nrm(14, (L, 2, DECAY_LORA, RW_WIDTH)) * DECAY_LORA ** -0.5,
        "a0": 0.1 * nrm(15, (L, 2, RW_WIDTH)),
        "a_up": 0.5 * nrm(16, (L, 2, ICLR_LORA, RW_WIDTH)) * ICLR_LORA ** -0.5,
        "g_up": nrm(17, (L, GATE_LORA, RW_WIDTH)) * GATE_LORA ** -0.5,
        "k_k": 0.85 + 0.05 * nrm(18, (L, RW_WIDTH)),
        "k_a": 1.0 + 0.05 * nrm(19, (L, RW_WIDTH)),
        "r_k": 0.1 * nrm(20, (L, RW_HEADS, RW_HEAD)),
        "ln_x_g": 1.0 + 0.02 * nrm(21, (L, RW_WIDTH)),
        "ln_x_b": 0.02 * nrm(22, (L, RW_WIDTH)),
        "w_out": nrm(23, (L, D_MODEL, D_MODEL)) * D_MODEL ** -0.5,
        "norm2_g": 1.0 + 0.02 * nrm(24, (L, D_MODEL)),
        "w_ff1": nrm(25, (L, D_MODEL, D_FF)) * D_MODEL ** -0.5,
        "w_ff2": nrm(26, (L, D_FF, D_MODEL)) * D_FF ** -0.5,
    }


def reference(x_prompt, x_sample, norm1_g, w_in, q_norm_g, k_norm_g, lam_q1, lam_k1, lam_q2,
              lam_k2, subln_g, mu_prev, mu_next, w0, w_up, a0, a_up, g_up, k_k, k_a, r_k,
              ln_x_g, ln_x_b, w_out, norm2_g, w_ff1, w_ff2):
    def run(x):
        cos, sin = rope_tables(x.shape[1])
        for l in range(DEPTH):
            lambda_init = 0.8 - 0.6 * math.exp(-0.3 * l)
            x = encoder_layer(x, cos, sin, lambda_init, norm1_g[l], w_in[l], q_norm_g[l],
                              k_norm_g[l], lam_q1[l], lam_k1[l], lam_q2[l], lam_k2[l],
                              subln_g[l], mu_prev[l], mu_next[l], w0[l], w_up[l], a0[l],
                              a_up[l], g_up[l], k_k[l], k_a[l], r_k[l], ln_x_g[l], ln_x_b[l],
                              w_out[l], norm2_g[l], w_ff1[l], w_ff2[l])
        return x

    y_prompt = run(x_prompt)
    y_sample = run(x_sample)
    return (y_prompt, y_sample)
```

```cpp
#include <hip/hip_runtime.h>
#include <hip/hip_cooperative_groups.h>
#include <cstdio>
#include <cstdint>
namespace cg = cooperative_groups;

#define LAS __attribute__((address_space(3)))
typedef unsigned short bf16_t;
typedef short bf16x8 __attribute__((ext_vector_type(8)));
typedef short s16x4 __attribute__((ext_vector_type(4)));
typedef float f32x4 __attribute__((ext_vector_type(4)));
typedef float f32x16 __attribute__((ext_vector_type(16)));
typedef unsigned u32x4 __attribute__((ext_vector_type(4)));
typedef unsigned u32x2 __attribute__((ext_vector_type(2)));
typedef float f32x2_t __attribute__((ext_vector_type(2)));
typedef __bf16 bf16x2_t __attribute__((ext_vector_type(2)));

constexpr int MTOK = 32768, DM = 1024, ZP = 3328, DFF = 4096;
constexpr int SP = 16384, SS = 2048;
constexpr int ZQ = 0, ZK = 512, ZV = 1024, ZRR = 1536, ZRK = 2048, ZRV = 2560, ZWD = 3072, ZAD = 3136, ZGD = 3200;
constexpr int ZXN2 = 2048;
constexpr float NORM_EPS = 1e-6f, LNX_EPS = 64e-5f;
constexpr float QSCALE = 0.125f * 1.4426950408889634f;
constexpr float LAMBDA_INIT = 0.2f;
constexpr int NCHUNK_P = SP / 64, NCHUNK_S = SS / 64;

constexpr size_t MiB = 1u << 20;
constexpr size_t WS_CTL = 0;
constexpr size_t WS_WIN = 1 * MiB, WS_WOUT = 8 * MiB, WS_W1 = 10 * MiB, WS_W2 = 18 * MiB;
constexpr size_t WS_ROPE = 26 * MiB;
constexpr size_t WS_LORA = 30 * MiB;
constexpr size_t WS_ROWSQ = 31 * MiB;
constexpr size_t WS_BONUS = 33 * MiB;
constexpr size_t WS_Z = 36 * MiB;
constexpr size_t WS_END = 244 * MiB;
static_assert(WS_Z + (size_t)MTOK * ZP * 2 <= WS_END, "ws map");
constexpr size_t SLOT_BYTES = 32768;

__device__ __forceinline__ unsigned cvt_pk_bf16(float lo, float hi) { f32x2_t v = {lo, hi}; bf16x2_t b = __builtin_convertvector(v, bf16x2_t); return __builtin_bit_cast(unsigned, b); }
__device__ __forceinline__ float bf2f(unsigned short u) { return __uint_as_float(((unsigned)u) << 16); }
__device__ __forceinline__ float bflo(unsigned u) { return __uint_as_float(u << 16); }
__device__ __forceinline__ float bfhi(unsigned u) { return __uint_as_float(u & 0xffff0000u); }
__device__ __forceinline__ unsigned short f2bf(float f) { return (unsigned short)(cvt_pk_bf16(f, 0.f) & 0xffffu); }
__device__ __forceinline__ float wave_sum(float v) {
#pragma unroll
    for (int o = 1; o < 64; o <<= 1) v += __shfl_xor(v, o);
    return v;
}
#define LDS_WAIT() asm volatile("s_waitcnt lgkmcnt(0)" ::: "memory")
#define VM_WAIT() asm volatile("s_waitcnt vmcnt(0)" ::: "memory")

namespace pg8 {
constexpr int BM = 256, BK = 64, HALF = 128, HTB = HALF * BK * 2, STAGE_BYTES = 8 * HTB, NXCD = 8, WGM = 8;
__host__ __device__ __forceinline__ int lds_byte(int r, int c) { const int st = (r >> 4) * 2 + (c >> 5), rr = r & 15, cc = c & 31, ob = rr * 64 + cc * 2; return st * 1024 + (ob ^ (((ob >> 9) & 1) << 5)); }
__host__ __device__ __forceinline__ void stage_rc(int b, int& R, int& C) { const int st = b / 1024, sb = b % 1024, swz = sb ^ (((sb >> 9) & 1) << 5); R = (st >> 1) * 16 + swz / 64; C = (st & 1) * 32 + (swz % 64) / 2; }
__host__ __device__ __forceinline__ int perm32(int rho) { const int n = rho >> 4, i = rho & 15; return 8 * (i >> 2) + 4 * n + (i & 3); }
struct Unit { int pm, pn; };
struct Gemm { const char* A; const bf16_t* Bt; int M, N, K; int lda; int jkt; int jbytes; };
struct StaticOrder {
    int nM, nN, nwg, G, c;
    __host__ __device__ void init(int M, int N, int G_, int c_) { nM = M / BM; nN = N / BM; nwg = nM * nN; G = G_; c = c_; }
    __host__ __device__ bool next(int i, Unit& u) const {
        const long L = (long)i * G + c; if (L >= nwg) return false;
        int wgid = (int)L; { const int q = nwg / NXCD, r = nwg % NXCD, xcd = wgid % NXCD, off = wgid / NXCD; wgid = (xcd < r ? xcd * (q + 1) : r * (q + 1) + (xcd - r) * q) + off; }
        const int nig = WGM * nN, gid = wgid / nig, fm = gid * WGM, gsz = (nM - fm) < WGM ? (nM - fm) : WGM;
        u.pm = fm + ((wgid % nig) % gsz); u.pn = (wgid % nig) / gsz; return true;
    }
};

struct EpiZ {
    static constexpr bool PERM = true;
    bf16_t* O; int ldc;
    __device__ __forceinline__ void operator()(const f32x4 (&acc)[2][2][4][2], const Unit& u, int wr, int wc, int fr, int fq) const {
        const int row0 = u.pm * BM + wr * 64 + fr, col0 = u.pn * BM + wc * 32 + 8 * fq;
#pragma unroll
        for (int ai = 0; ai < 2; ++ai)
#pragma unroll
            for (int m = 0; m < 4; ++m) { bf16_t* rowp = O + (size_t)(row0 + ai * HALF + m * 16) * ldc + col0;
#pragma unroll
                for (int bj = 0; bj < 2; ++bj) { const f32x4 v0 = acc[ai][bj][m][0], v1 = acc[ai][bj][m][1];
                    u32x4 w; w.x = cvt_pk_bf16(v0[0], v0[1]); w.y = cvt_pk_bf16(v0[2], v0[3]); w.z = cvt_pk_bf16(v1[0], v1[1]); w.w = cvt_pk_bf16(v1[2], v1[3]);
                    *(u32x4*)(rowp + bj * HALF) = w; } }
    }
};
struct EpiOut {
    static constexpr bool PERM = false;
    const float* xp; const float* xs; float* out; bf16_t* Z; float* rowsq;
    __device__ __forceinline__ void operator()(const f32x4 (&acc)[2][2][4][2], const Unit& u, int wr, int wc, int fr, int fq) const {
        const int col0 = u.pn * BM + wc * 32 + 4 * fq;
#pragma unroll
        for (int ai = 0; ai < 2; ++ai)
#pragma unroll
            for (int m = 0; m < 4; ++m) { const int r = u.pm * BM + ai * HALF + wr * 64 + m * 16 + fr;
                const float* xr = (r < SP ? xp + (size_t)r * DM : xs + (size_t)(r - SP) * DM) + col0; float* orow = out + (size_t)r * DM + col0; bf16_t* zr = Z + (size_t)r * ZP + ZXN2 + col0;
                float ss = 0.f;
#pragma unroll
                for (int bj = 0; bj < 2; ++bj)
#pragma unroll
                    for (int n = 0; n < 2; ++n) { const f32x4 xv = *(const f32x4*)(xr + bj * HALF + n * 16); const f32x4 o = xv + acc[ai][bj][m][n];
                        *(f32x4*)(orow + bj * HALF + n * 16) = o; ss += (o[0] * o[0] + o[1] * o[1]) + (o[2] * o[2] + o[3] * o[3]);
                        u32x2 w; w.x = cvt_pk_bf16(o[0], o[1]); w.y = cvt_pk_bf16(o[2], o[3]); *(u32x2*)(zr + bj * HALF + n * 16) = w; }
                ss += __shfl_xor(ss, 16); ss += __shfl_xor(ss, 32);
                if (fq == 0) rowsq[(size_t)r * 16 + u.pn * 4 + wc] = ss;
                if (m & 1) asm volatile("" ::: "memory"); }
    }
};
struct EpiUp {
    static constexpr bool PERM = true;
    char* H; const float* rowsq; int row_off;
    __device__ __forceinline__ void operator()(const f32x4 (&acc)[2][2][4][2], const Unit& u, int wr, int wc, int fr, int fq) const {
        const int row0 = u.pm * BM + wr * 64 + fr, col0 = u.pn * BM + wc * 32 + 8 * fq;
#pragma unroll
        for (int ai = 0; ai < 2; ++ai)
#pragma unroll
            for (int m = 0; m < 4; ++m) { const int r = row0 + ai * HALF + m * 16; const f32x4* rq = (const f32x4*)(rowsq + (size_t)(row_off + r) * 16);
                const f32x4 q0 = rq[0], q1 = rq[1], q2 = rq[2], q3 = rq[3];
                const float ssum = ((q0[0] + q0[1]) + (q0[2] + q0[3])) + ((q1[0] + q1[1]) + (q1[2] + q1[3])) + ((q2[0] + q2[1]) + (q2[2] + q2[3])) + ((q3[0] + q3[1]) + (q3[2] + q3[3]));
                const float rstd = __builtin_amdgcn_rsqf(ssum * (1.0f / DM) + NORM_EPS);
                char* rowp = H + (size_t)r * 13312;
#pragma unroll
                for (int bj = 0; bj < 2; ++bj) { const int c = col0 + bj * HALF; f32x4 v0 = acc[ai][bj][m][0] * rstd, v1 = acc[ai][bj][m][1] * rstd;
#pragma unroll
                    for (int e = 0; e < 4; ++e) { const float a = fmaxf(v0[e], 0.f), b = fmaxf(v1[e], 0.f); v0[e] = a * a; v1[e] = b * b; }
                    u32x4 w; w.x = cvt_pk_bf16(v0[0], v0[1]); w.y = cvt_pk_bf16(v0[2], v0[3]); w.z = cvt_pk_bf16(v1[0], v1[1]); w.w = cvt_pk_bf16(v1[2], v1[3]);
                    *(u32x4*)(rowp + (size_t)c * 2 + (c >= 2048 ? 2560 : 0)) = w; } }
    }
};
struct EpiDown {
    static constexpr bool PERM = false;
    float* out; int row_off;
    __device__ __forceinline__ void operator()(const f32x4 (&acc)[2][2][4][2], const Unit& u, int wr, int wc, int fr, int fq) const {
        const int col0 = u.pn * BM + wc * 32 + 4 * fq;
#pragma unroll
        for (int ai = 0; ai < 2; ++ai)
#pragma unroll
            for (int m = 0; m < 4; ++m) { const int r = row_off + u.pm * BM + ai * HALF + wr * 64 + m * 16 + fr; float* orow = out + (size_t)r * DM + col0;
#pragma unroll
                for (int bj = 0; bj < 2; ++bj)
#pragma unroll
                    for (int n = 0; n < 2; ++n) { const f32x4 xv = *(const f32x4*)(orow + bj * HALF + n * 16); *(f32x4*)(orow + bj * HALF + n * 16) = xv + acc[ai][bj][m][n]; }
                if (m & 1) asm volatile("" ::: "memory"); }
    }
};

template <class Epi, class Sched, bool ALIGN_EPI>
__device__ __forceinline__ void gemm_phase(LAS unsigned char* lds, const Gemm g, const Sched& S, const Epi& E) {
    const int tid = threadIdx.x, wid = __builtin_amdgcn_readfirstlane(tid >> 6), lane = tid & 63, wr = wid >> 2, wc = wid & 3, fr = lane & 15, fq = lane >> 4;
    const int K = g.K, nt = K / BK;
    unsigned voffA[2], voffB[2];
#pragma unroll
    for (int i = 0; i < 2; ++i) { int R, C; stage_rc(tid * 16 + i * 8192, R, C); const int Rb = Epi::PERM ? ((R & ~31) + perm32(R & 31)) : R;
        voffA[i] = (unsigned)(R * g.lda + C * 2); voffB[i] = (unsigned)(Rb * K + C) * 2u; }
    const size_t kstep = (size_t)(BK * 2);
    const size_t hstepA = (size_t)HALF * g.lda, tstepA = 2 * hstepA;
    const size_t hstepB = (size_t)HALF * K * 2, tstepB = 2 * hstepB;
    const unsigned ldsw = (unsigned)wid * 1024u;
    const int aoff = lds_byte(wr * 64 + fr, fq * 8), boff = lds_byte(wc * 32 + fr, fq * 8);
#define PG8_AOFF(kt) ((size_t)(kt) * kstep + ((kt) >= g.jkt ? (size_t)g.jbytes : (size_t)0))
#define PG8_SA(b, h) (((b) * 2 + (h)) * HTB)
#define PG8_SB(b, h) ((4 + (b) * 2 + (h)) * HTB)
#define PG8_STAGE(bufoff, gbase, voff) do { _Pragma("unroll") for (int _i = 0; _i < 2; ++_i) \
        __builtin_amdgcn_global_load_lds((const unsigned*)((const char*)(gbase) + (voff)[_i]), (LAS unsigned*)(lds + (bufoff) + ldsw + _i * 8192), 16, 0, 0); } while (0)
#define PG8_LDA(dst, b, h) do { _Pragma("unroll") for (int m = 0; m < 4; ++m) _Pragma("unroll") for (int k = 0; k < 2; ++k) dst[m][k] = *(const LAS bf16x8*)(lds + PG8_SA(b, h) + aoff + m * 2048 + k * 1024); } while (0)
#define PG8_LDB(dst, b, h) do { _Pragma("unroll") for (int n = 0; n < 2; ++n) _Pragma("unroll") for (int k = 0; k < 2; ++k) dst[n][k] = *(const LAS bf16x8*)(lds + PG8_SB(b, h) + boff + n * 2048 + k * 1024); } while (0)
#define PG8_MMA(ai, bj, At, Bt) do { __builtin_amdgcn_s_setprio(1); _Pragma("unroll") for (int m = 0; m < 4; ++m) _Pragma("unroll") for (int n = 0; n < 2; ++n) _Pragma("unroll") for (int k = 0; k < 2; ++k) \
        acc[ai][bj][m][n] = __builtin_amdgcn_mfma_f32_16x16x32_bf16(Bt[n][k], At[m][k], acc[ai][bj][m][n], 0, 0, 0); __builtin_amdgcn_s_setprio(0); } while (0)
#define PG8_WAIT_V(n) asm volatile("s_waitcnt vmcnt(" #n ")" ::: "memory")
#define PG8_WAIT_L(n) asm volatile("s_waitcnt lgkmcnt(" #n ")" ::: "memory")
#define PG8_BAR __builtin_amdgcn_s_barrier()
#define PG8_SCHED __builtin_amdgcn_sched_barrier(0)
    Unit cur, nxt; int ui = 0;
    if (!S.next(0, cur)) return;
    f32x4 acc[2][2][4][2];
#pragma unroll
    for (int a = 0; a < 2; ++a)
#pragma unroll
        for (int b = 0; b < 2; ++b)
#pragma unroll
            for (int m = 0; m < 4; ++m)
#pragma unroll
                for (int n = 0; n < 2; ++n) acc[a][b][m][n] = (f32x4){0.f, 0.f, 0.f, 0.f};
    bf16x8 At[4][2], B0[2][2], B1[2][2];
    const char* cA = g.A + (size_t)cur.pm * tstepA; const char* cB = (const char*)g.Bt + (size_t)cur.pn * tstepB;
    {
        PG8_STAGE(PG8_SB(0, 0), cB, voffB); PG8_STAGE(PG8_SB(0, 1), cB + hstepB, voffB); PG8_STAGE(PG8_SA(0, 0), cA + PG8_AOFF(0), voffA); PG8_STAGE(PG8_SA(0, 1), cA + hstepA + PG8_AOFF(0), voffA);
        if (wr == 1) PG8_BAR;
        PG8_WAIT_V(2); PG8_BAR;
        PG8_STAGE(PG8_SB(1, 0), cB + kstep, voffB); PG8_STAGE(PG8_SA(1, 0), cA + PG8_AOFF(1), voffA); PG8_STAGE(PG8_SB(1, 1), cB + hstepB + kstep, voffB);
        PG8_WAIT_V(6); PG8_BAR;
    }
    for (;;) {
        const bool has_next = S.next(ui + 1, nxt);
        const char* nA = has_next ? g.A + (size_t)nxt.pm * tstepA : cA; const char* nB = has_next ? (const char*)g.Bt + (size_t)nxt.pn * tstepB : cB;
        for (int t = 0; t < nt; t += 2) {
            const bool last = (t == nt - 2);
            const char* a1 = cA + PG8_AOFF(t + 1);
            const char* a2 = last ? nA + PG8_AOFF(0) : cA + PG8_AOFF(t + 2); const char* b2 = last ? nB : cB + (size_t)(t + 2) * kstep;
            const char* a3 = last ? nA + PG8_AOFF(1) : cA + PG8_AOFF(t + 3); const char* b3 = b2 + kstep;
            PG8_LDB(B0, 0, 0); PG8_LDB(B1, 0, 1); PG8_SCHED; PG8_LDA(At, 0, 0); PG8_STAGE(PG8_SA(1, 1), a1 + hstepA, voffA);
            PG8_WAIT_V(8); PG8_WAIT_L(0); PG8_BAR; PG8_MMA(0, 0, At, B0); PG8_MMA(0, 1, At, B1); PG8_BAR; PG8_SCHED;
            PG8_LDA(At, 0, 1); PG8_STAGE(PG8_SB(0, 0), b2, voffB); PG8_STAGE(PG8_SB(0, 1), b2 + hstepB, voffB); PG8_STAGE(PG8_SA(0, 0), a2, voffA);
            PG8_WAIT_V(8); PG8_WAIT_L(0); PG8_BAR; PG8_MMA(1, 0, At, B0); PG8_MMA(1, 1, At, B1); PG8_BAR; PG8_SCHED;
            PG8_LDB(B0, 1, 0); PG8_LDB(B1, 1, 1); PG8_SCHED; PG8_LDA(At, 1, 0); PG8_STAGE(PG8_SA(0, 1), a2 + hstepA, voffA);
            PG8_WAIT_V(8); PG8_WAIT_L(0); PG8_BAR; PG8_MMA(0, 0, At, B0); PG8_MMA(0, 1, At, B1); PG8_BAR; PG8_SCHED;
            PG8_LDA(At, 1, 1); PG8_STAGE(PG8_SB(1, 0), b3, voffB); PG8_STAGE(PG8_SB(1, 1), b3 + hstepB, voffB); PG8_STAGE(PG8_SA(1, 0), a3, voffA);
            PG8_WAIT_V(8); PG8_WAIT_L(0); PG8_BAR; PG8_MMA(1, 0, At, B0); PG8_MMA(1, 1, At, B1); PG8_BAR; PG8_SCHED;
        }
        if constexpr (ALIGN_EPI) { if (wr == 0) PG8_BAR; }
        E(acc, cur, wr, wc, fr, fq);
        if (!has_next) break;
#pragma unroll
        for (int a = 0; a < 2; ++a)
#pragma unroll
            for (int b = 0; b < 2; ++b)
#pragma unroll
                for (int m = 0; m < 4; ++m)
#pragma unroll
                    for (int n = 0; n < 2; ++n) acc[a][b][m][n] = (f32x4){0.f, 0.f, 0.f, 0.f};
        cur = nxt; cA = nA; cB = nB; ++ui;
        if constexpr (ALIGN_EPI) { if (wr == 1) PG8_BAR; }
    }
    PG8_WAIT_V(0);
    if constexpr (!ALIGN_EPI) { if (wr == 0) PG8_BAR; }
    PG8_BAR;
#undef PG8_AOFF
#undef PG8_SA
#undef PG8_SB
#undef PG8_STAGE
#undef PG8_LDA
#undef PG8_LDB
#undef PG8_MMA
#undef PG8_WAIT_V
#undef PG8_WAIT_L
#undef PG8_BAR
#undef PG8_SCHED
}
}

constexpr int NWAVES = 8, NTHR = 512;
constexpr int LDS_BYTES = 163840;
struct Args {
    const float* in[27]; float* out; unsigned char* ws; int ph_lo, ph_hi;
};
struct Frame {
    LAS unsigned char* lds; int tid, lane, wave, vcu, G;
};
__device__ __forceinline__ int seq_row0(int q) { return q == 0 ? 0 : SP + (q - 1) * SS; }
__device__ __forceinline__ int seq_len(int q) { return q == 0 ? SP : SS; }

__device__ __forceinline__ void p0_transpose_item(const float* W, int K, int N, bf16_t* WT, const float* kscale, LAS float* scr, int item, int lane) {
    const int nblk = N / 32, kb = item / nblk, nb = item % nblk, k0 = 64 * kb, n0 = 32 * nb;
#pragma unroll 8
    for (int i = 0; i < 32; ++i) { const int kk = 2 * i + (lane >> 5); float v = W[(size_t)(k0 + kk) * N + n0 + (lane & 31)]; if (kscale) v *= kscale[k0 + kk]; scr[kk * 33 + (lane & 31)] = v; }
    LDS_WAIT(); asm volatile("" ::: "memory");
    const int c = lane & 7;
#pragma unroll
    for (int j = 0; j < 4; ++j) { const int n = (lane >> 3) + 8 * j; const LAS float* s = scr + (8 * c) * 33 + n;
        u32x4 o; o.x = cvt_pk_bf16(s[0 * 33], s[1 * 33]); o.y = cvt_pk_bf16(s[2 * 33], s[3 * 33]); o.z = cvt_pk_bf16(s[4 * 33], s[5 * 33]); o.w = cvt_pk_bf16(s[6 * 33], s[7 * 33]);
        *(u32x4*)(WT + (size_t)(n0 + n) * K + k0 + 8 * c) = o; }
    LDS_WAIT(); asm volatile("" ::: "memory");
}
__device__ __forceinline__ void p0_prologue(const Frame& F, const Args& a) {
    LAS float* scr = (LAS float*)(F.lds + F.wave * 16384);
    const int gw = F.vcu * NWAVES + F.wave, NGW = F.G * NWAVES;
    unsigned char* ws = a.ws;
    constexpr int I_IN = (DM / 64) * (ZP / 32), I_O = (DM / 64) * (DM / 32), I_1 = (DM / 64) * (DFF / 32), I_2 = (DFF / 64) * (DM / 32);
    for (int it = gw; it < I_IN + I_O + I_1 + I_2; it += NGW) {
        int r = it;
        if (r < I_IN) { p0_transpose_item(a.in[3], DM, ZP, (bf16_t*)(ws + WS_WIN), nullptr, scr, r, F.lane); continue; } r -= I_IN;
        if (r < I_O) { p0_transpose_item(a.in[23], DM, DM, (bf16_t*)(ws + WS_WOUT), nullptr, scr, r, F.lane); continue; } r -= I_O;
        if (r < I_1) { p0_transpose_item(a.in[25], DM, DFF, (bf16_t*)(ws + WS_W1), a.in[24], scr, r, F.lane); continue; } r -= I_1;
        p0_transpose_item(a.in[26], DFF, DM, (bf16_t*)(ws + WS_W2), nullptr, scr, r, F.lane);
    }
    bf16_t* XN = (bf16_t*)a.out; const float* g1 = a.in[2];
    for (int m = gw; m < MTOK; m += NGW) {
        const float* xrow = m < SP ? a.in[0] + (size_t)m * DM : a.in[1] + (size_t)(m - SP) * DM;
        const f32x4* xr = (const f32x4*)xrow + F.lane; f32x4 v[4]; float s = 0.f;
#pragma unroll
        for (int j = 0; j < 4; ++j) { v[j] = xr[64 * j]; s += (v[j][0] * v[j][0] + v[j][1] * v[j][1]) + (v[j][2] * v[j][2] + v[j][3] * v[j][3]); }
        const float rstd = 1.0f / sqrtf(wave_sum(s) * (1.f / DM) + NORM_EPS);
        u32x2* o8 = (u32x2*)(XN + (size_t)m * DM) + F.lane;
#pragma unroll
        for (int j = 0; j < 4; ++j) { const f32x4 gv = ((const f32x4*)g1)[F.lane + 64 * j]; u32x2 w; w.x = cvt_pk_bf16(v[j][0] * rstd * gv[0], v[j][1] * rstd * gv[1]); w.y = cvt_pk_bf16(v[j][2] * rstd * gv[2], v[j][3] * rstd * gv[3]); o8[64 * j] = w; }
    }
    const int gt = F.vcu * NTHR + F.tid, NGT = F.G * NTHR;
    float* rope = (float*)(ws + WS_ROPE);
    for (int e = gt; e < SP * 32; e += NGT) { const int pos = e >> 5, i = e & 31;
        const float invf = 1.0f / powf(10000.0f, (float)(2 * i) / 64.0f); const float ang = (float)pos * invf; float sn, cs; sincosf(ang, &sn, &cs);
        rope[2 * e] = cs; rope[2 * e + 1] = sn; }
    bf16_t* wupT = (bf16_t*)(ws + WS_LORA); bf16_t* aupT = wupT + 2 * 512 * 64; bf16_t* gupT = aupT + 2 * 512 * 64;
    for (int e = gt; e < 2 * 512 * 64; e += NGT) { const int d = e >> 15, c = (e >> 6) & 511, r = e & 63;
        wupT[e] = f2bf(a.in[14][((size_t)d * 64 + r) * 512 + c]); aupT[e] = f2bf(a.in[16][((size_t)d * 64 + r) * 512 + c]); }
    for (int e = gt; e < 512 * 128; e += NGT) { const int c = e >> 7, r = e & 127; gupT[e] = f2bf(a.in[17][(size_t)r * 512 + c]); }
}

__device__ __forceinline__ void qk_prep(const Frame& F, const Args& a) {
    const int gw = F.vcu * NWAVES + F.wave, NGW = F.G * NWAVES;
    bf16_t* Z = (bf16_t*)(a.ws + WS_Z); const float* rope = (const float*)(a.ws + WS_ROPE);
    const int g = F.lane >> 2, qd = F.lane & 3;
    const float* gain = (g < 8) ? a.in[4] : a.in[5];
    float glo[8], ghi[8];
#pragma unroll
    for (int j = 0; j < 8; ++j) { glo[j] = gain[8 * qd + j]; ghi[j] = gain[32 + 8 * qd + j]; }
    const float osc = (g < 8) ? QSCALE : 1.0f;
    for (int m = gw; m < MTOK; m += NGW) {
        const int pos = m < SP ? m : ((m - SP) & (SS - 1));
        bf16_t* p = Z + (size_t)m * ZP + g * 64 + 8 * qd;
        const u32x4 lo4 = *(const u32x4*)p, hi4 = *(const u32x4*)(p + 32);
        float lo[8], hi[8];
#pragma unroll
        for (int j = 0; j < 4; ++j) { lo[2 * j] = bflo(lo4[j]); lo[2 * j + 1] = bfhi(lo4[j]); hi[2 * j] = bflo(hi4[j]); hi[2 * j + 1] = bfhi(hi4[j]); }
        float ss = 0.f;
#pragma unroll
        for (int j = 0; j < 8; ++j) ss += lo[j] * lo[j] + hi[j] * hi[j];
        ss += __shfl_xor(ss, 1); ss += __shfl_xor(ss, 2);
        const float rstd = 1.0f / sqrtf(ss * (1.f / 64.f) + NORM_EPS);
        const f32x4* rp = (const f32x4*)(rope + ((size_t)pos * 32 + 8 * qd) * 2);
        float ol[8], oh[8];
#pragma unroll
        for (int j2 = 0; j2 < 4; ++j2) { const f32x4 cs = rp[j2];
#pragma unroll
            for (int e = 0; e < 2; ++e) { const int j = 2 * j2 + e; const float c = cs[2 * e], s = cs[2 * e + 1]; const float l = lo[j] * rstd * glo[j], h = hi[j] * rstd * ghi[j];
                ol[j] = (l * c - h * s) * osc; oh[j] = (h * c + l * s) * osc; } }
        u32x4 wl, wh;
#pragma unroll
        for (int j = 0; j < 4; ++j) { wl[j] = cvt_pk_bf16(ol[2 * j], ol[2 * j + 1]); wh[j] = cvt_pk_bf16(oh[2 * j], oh[2 * j + 1]); }
        *(u32x4*)p = wl; *(u32x4*)(p + 32) = wh;
    }
}

namespace att {
constexpr int KSLOT = 8192, VSLOT = 16384;
constexpr int L_K = 0, L_V = 2 * KSLOT, L_WS = L_V + 2 * VSLOT, L_ST = L_WS + NWAVES * 256, L_END = L_ST + NWAVES * 8192;
__device__ __forceinline__ int crow(int r, int hi) { return (r & 3) + 8 * (r >> 2) + 4 * hi; }
__device__ __forceinline__ void glds16(const void* gsrc, unsigned lds_dst) { unsigned keep;
    asm volatile("s_mov_b32 %0, m0\n\ts_mov_b32 m0, %2\n\ts_nop 0\n\tglobal_load_lds_dwordx4 %1, off\n\ts_mov_b32 m0, %0" : "=&s"(keep) : "v"(gsrc), "s"(lds_dst) : "memory"); }
typedef short v4i16_t __attribute__((ext_vector_type(4)));
__device__ __forceinline__ s16x4 vtr(const LAS char* p) { return __builtin_bit_cast(s16x4, __builtin_amdgcn_ds_read_tr16_b64_v4i16((LAS v4i16_t*)p)); }
#define ATT_WAIT_BAR() asm volatile("s_waitcnt vmcnt(0) lgkmcnt(0)\n\ts_barrier" ::: "memory")

__device__ __forceinline__ void attn_unit(int row0, int S, int h, int qb, bf16_t* Z, LAS unsigned char* shm, float lam, const float* subln_g) {
    const int tid = threadIdx.x, lane = tid & 63, r32 = lane & 31, hi = lane >> 5; const int wid = __builtin_amdgcn_readfirstlane(tid >> 6);
    const unsigned lds0 = (unsigned)(uintptr_t)shm;
    LAS float* wsf = (LAS float*)(shm + L_WS) + wid * 64;
    LAS bf16_t* stash = (LAS bf16_t*)(shm + L_ST) + wid * 4096;
    const int NT = S / 64;
    const size_t qrow = (size_t)(row0 + qb * 256 + wid * 32);
    const LAS char* kp0 = (const LAS char*)shm + L_K + hi * 1024 + r32 * 16;
    const LAS char* vp0 = (const LAS char*)shm + L_V + ((lane >> 4) & 1) * 32 + (lane & 3) * 8 + (4 * hi + ((lane & 15) >> 2)) * 64;
    f32x16 o[4];
    for (int c = 0; c < 2; ++c) {
        const bf16_t* Qw = Z + qrow * ZP + ZQ + h * 128 + c * 64;
        const bf16_t* Kh = Z + (size_t)row0 * ZP + ZK + h * 128 + c * 64;
        const bf16_t* Vh = Z + (size_t)row0 * ZP + ZV + h * 128;
        const bf16_t* ksrc = Kh + (size_t)lane * ZP + wid * 8;
        const int p0 = 2 * wid, p1 = 2 * wid + 1;
        const bf16_t* vsrc0 = Vh + (size_t)(16 * (p0 & 3) + (lane >> 2)) * ZP + (p0 >> 2) * 32 + (lane & 3) * 8;
        const bf16_t* vsrc1 = Vh + (size_t)(16 * (p1 & 3) + (lane >> 2)) * ZP + (p1 >> 2) * 32 + (lane & 3) * 8;
        bf16x8 qr[4];
#pragma unroll
        for (int d0 = 0; d0 < 4; ++d0) qr[d0] = *(const bf16x8*)(Qw + (size_t)r32 * ZP + d0 * 16 + hi * 8);
#pragma unroll
        for (int d0 = 0; d0 < 4; ++d0) o[d0] = f32x16{};
        float l_reg = 0.f;
#define ATT_DMA(t, sl) do { const size_t ro_ = (size_t)(t) * 64 * ZP; \
        glds16(ksrc + ro_, (unsigned)__builtin_amdgcn_readfirstlane(lds0 + L_K + (sl) * KSLOT + wid * 1024)); \
        glds16(vsrc0 + ro_, (unsigned)__builtin_amdgcn_readfirstlane(lds0 + L_V + (sl) * VSLOT + p0 * 1024)); \
        glds16(vsrc1 + ro_, (unsigned)__builtin_amdgcn_readfirstlane(lds0 + L_V + (sl) * VSLOT + p1 * 1024)); } while (0)
        ATT_DMA(0, 0);
        for (int t = 0; t < NT; ++t) {
            const int sl = t & 1;
            ATT_WAIT_BAR();
            if (t + 1 < NT) ATT_DMA(t + 1, sl ^ 1);
            const LAS char* kb = kp0 + sl * KSLOT;
            f32x16 pa = f32x16{}, pb = f32x16{};
#pragma unroll
            for (int d0 = 0; d0 < 4; ++d0) {
                const bf16x8 b0 = *(const LAS bf16x8*)(kb + d0 * 2048), b1 = *(const LAS bf16x8*)(kb + d0 * 2048 + 512);
                pa = __builtin_amdgcn_mfma_f32_32x32x16_bf16(b0, qr[d0], pa, 0, 0, 0); pb = __builtin_amdgcn_mfma_f32_32x32x16_bf16(b1, qr[d0], pb, 0, 0, 0); }
            float sacc = 0.f;
#pragma unroll
            for (int r = 0; r < 16; ++r) { pa[r] = __builtin_amdgcn_exp2f(pa[r]); pb[r] = __builtin_amdgcn_exp2f(pb[r]); sacc += pa[r] + pb[r]; }
            l_reg += sacc;
            u32x4 pw0, pw1, pw2, pw3;
#pragma unroll
            for (int j = 0; j < 4; ++j) { pw0[j] = cvt_pk_bf16(pa[2 * j], pa[2 * j + 1]); pw1[j] = cvt_pk_bf16(pa[8 + 2 * j], pa[9 + 2 * j]); pw2[j] = cvt_pk_bf16(pb[2 * j], pb[2 * j + 1]); pw3[j] = cvt_pk_bf16(pb[8 + 2 * j], pb[9 + 2 * j]); }
            const LAS char* vb = vp0 + sl * VSLOT;
#pragma unroll
            for (int d0 = 0; d0 < 4; ++d0) {
                s16x4 lo[4], hh[4];
#pragma unroll
                for (int ks = 0; ks < 4; ++ks) { lo[ks] = vtr(vb + d0 * 4096 + ks * 1024); hh[ks] = vtr(vb + d0 * 4096 + ks * 1024 + 512); }
#define ATT_PK(k) (bf16x8){lo[k][0], lo[k][1], lo[k][2], lo[k][3], hh[k][0], hh[k][1], hh[k][2], hh[k][3]}
                o[d0] = __builtin_amdgcn_mfma_f32_32x32x16_bf16(__builtin_bit_cast(bf16x8, pw0), ATT_PK(0), o[d0], 0, 0, 0);
                o[d0] = __builtin_amdgcn_mfma_f32_32x32x16_bf16(__builtin_bit_cast(bf16x8, pw1), ATT_PK(1), o[d0], 0, 0, 0);
                o[d0] = __builtin_amdgcn_mfma_f32_32x32x16_bf16(__builtin_bit_cast(bf16x8, pw2), ATT_PK(2), o[d0], 0, 0, 0);
                o[d0] = __builtin_amdgcn_mfma_f32_32x32x16_bf16(__builtin_bit_cast(bf16x8, pw3), ATT_PK(3), o[d0], 0, 0, 0);
#undef ATT_PK
            }
        }
#undef ATT_DMA
        { auto rr = __builtin_amdgcn_permlane32_swap(__float_as_uint(l_reg), __float_as_uint(l_reg), false, false); l_reg = __uint_as_float(rr[0]) + __uint_as_float(rr[1]); }
        if (hi == 0) wsf[r32] = l_reg;
        LDS_WAIT();
        float rli[16];
#pragma unroll
        for (int r = 0; r < 16; ++r) rli[r] = 1.0f / wsf[crow(r, hi)];
        if (c == 0) {
#pragma unroll
            for (int d0 = 0; d0 < 4; ++d0)
#pragma unroll
                for (int r = 0; r < 16; ++r) stash[(d0 * 16 + r) * 64 + lane] = f2bf(o[d0][r] * rli[r]);
            LDS_WAIT();
        } else {
#pragma unroll
            for (int d0 = 0; d0 < 4; ++d0)
#pragma unroll
                for (int r = 0; r < 16; ++r) o[d0][r] = bf2f(stash[(d0 * 16 + r) * 64 + lane]) - lam * (o[d0][r] * rli[r]);
            LDS_WAIT(); asm volatile("" ::: "memory");
#pragma unroll
            for (int d0 = 0; d0 < 4; ++d0)
#pragma unroll
                for (int r = 0; r < 16; ++r) stash[crow(r, hi) * 128 + d0 * 32 + r32] = f2bf(o[d0][r]);
            LDS_WAIT(); asm volatile("" ::: "memory");
            bf16_t* Ow = Z + qrow * ZP + ZQ + h * 128;
#pragma unroll
            for (int i = 0; i < 4; ++i) { const int row = i * 8 + (lane >> 3), ch = lane & 7;
                const u32x4 w0 = *(const LAS u32x4*)(stash + row * 128 + ch * 16), w1 = *(const LAS u32x4*)(stash + row * 128 + ch * 16 + 8);
                float v[16];
#pragma unroll
                for (int j = 0; j < 4; ++j) { v[2 * j] = bflo(w0[j]); v[2 * j + 1] = bfhi(w0[j]); v[8 + 2 * j] = bflo(w1[j]); v[9 + 2 * j] = bfhi(w1[j]); }
                float ss = 0.f;
#pragma unroll
                for (int j = 0; j < 16; ++j) ss += v[j] * v[j];
                ss += __shfl_xor(ss, 1); ss += __shfl_xor(ss, 2); ss += __shfl_xor(ss, 4);
                const float rs = (1.0f - LAMBDA_INIT) / sqrtf(ss * (1.f / 128.f) + NORM_EPS);
                u32x4 x0, x1;
#pragma unroll
                for (int j = 0; j < 4; ++j) { x0[j] = cvt_pk_bf16(v[2 * j] * rs * subln_g[ch * 16 + 2 * j], v[2 * j + 1] * rs * subln_g[ch * 16 + 2 * j + 1]);
                                              x1[j] = cvt_pk_bf16(v[8 + 2 * j] * rs * subln_g[ch * 16 + 8 + 2 * j], v[9 + 2 * j] * rs * subln_g[ch * 16 + 9 + 2 * j]); }
                *(u32x4*)(Ow + (size_t)row * ZP + ch * 16) = x0; *(u32x4*)(Ow + (size_t)row * ZP + ch * 16 + 8) = x1; }
            LDS_WAIT();
        }
    }
    asm volatile("s_waitcnt vmcnt(0) lgkmcnt(0)\n\ts_barrier" ::: "memory");
}
}

namespace rw {
constexpr int P = 144, MAT = 64 * P;
constexpr int O_AT = 0, O_RT = MAT, O_BT = 2 * MAT, O_KT = 3 * MAT, O_ATT = 4 * MAT, O_VT = 5 * MAT, O_BHT = 6 * MAT, O_KHT = 7 * MAT;
constexpr int O_LAB = 8 * MAT, O_LAK = 9 * MAT, O_ARB = 10 * MAT, O_ARK = 11 * MAT, O_XT = 12 * MAT, O_ABT = 13 * MAT, O_U0T = 14 * MAT;
constexpr int O_LABD = 15 * MAT, O_TII = O_LABD + 4096, O_WC = O_TII + 2048, O_GSUM = O_WC + 256, O_END = O_GSUM + 2048;
constexpr int O_TW = O_LAB, O_ADN = O_LAK, O_WL = O_ARB, O_AR = O_XT, PF = 272;
static_assert(O_END <= LDS_BYTES && 64 * PF <= 2 * MAT, "rwkv lds");
__device__ __forceinline__ int crow(int r, int hi) { return (r & 3) + 8 * (r >> 2) + 4 * hi; }
__device__ __forceinline__ float sigmoidf_(float x) { return 1.0f / (1.0f + __expf(-x)); }
__device__ __forceinline__ void load10(const bf16_t* zc, int t_lo, int S, float (&z)[10]) {
#pragma unroll
    for (int i = 0; i < 10; ++i) { const int t = t_lo - 1 + i; z[i] = (t >= 0 && t < S) ? bf2f(zc[(size_t)t * ZP]) : 0.f; }
}
__device__ __forceinline__ float tshift(const float (&z)[10], int u, float mp, float mn) { const float c = z[u + 1]; return c + mp * (z[u] - c) + mn * (z[u + 2] - c); }
__device__ __forceinline__ f32x16 mm_ll(const LAS unsigned char* A, int rowA, const LAS unsigned char* B, int rowB, f32x16 acc, int r32, int hi) {
#pragma unroll
    for (int ks = 0; ks < 4; ++ks) { const bf16x8 a = *(const LAS bf16x8*)(A + (rowA + r32) * P + (16 * ks + 8 * hi) * 2), b = *(const LAS bf16x8*)(B + (rowB + r32) * P + (16 * ks + 8 * hi) * 2);
        acc = __builtin_amdgcn_mfma_f32_32x32x16_bf16(a, b, acc, 0, 0, 0); }
    return acc;
}
__device__ __forceinline__ void store_native(unsigned char* dst, const f32x16& acc, int lane) {
    u32x4 w0, w1;
#pragma unroll
    for (int q = 0; q < 4; ++q) { w0[q] = cvt_pk_bf16(acc[2 * q], acc[2 * q + 1]); w1[q] = cvt_pk_bf16(acc[8 + 2 * q], acc[9 + 2 * q]); }
    *(u32x4*)(dst + lane * 32) = w0; *(u32x4*)(dst + lane * 32 + 16) = w1;
}
__device__ __forceinline__ void st4(LAS unsigned char* p, float a, float b, float c, float d) { u32x2 w; w.x = cvt_pk_bf16(a, b); w.y = cvt_pk_bf16(c, d); *(LAS u32x2*)p = w; }

__device__ __forceinline__ void s1_item(const Frame& F, const Args& a, int d, int q, int h, int ck, unsigned char* slot) {
    LAS unsigned char* L = F.lds;
    const int tid = F.tid, lane = F.lane, w = F.wave, r32 = lane & 31, hi = lane >> 5;
    const int j = lane, tg = w;
    const int row0 = seq_row0(q), S = seq_len(q), t0 = ck * 64;
    const bf16_t* Zs = (const bf16_t*)(a.ws + WS_Z) + (size_t)row0 * ZP;
    const int t_lo = d == 0 ? t0 + 8 * tg : t0 + 56 - 8 * tg;
    const int tau0 = 8 * tg;
#define TAU(u) (d == 0 ? tau0 + (u) : tau0 + 7 - (u))
    const float* mup = a.in[11]; const float* mun = a.in[12];
    const int ch = h * 64 + j;
    float zr[10], zk[10], zv[10];
    load10(Zs + ZRR + ch, t_lo, S, zr); load10(Zs + ZRK + ch, t_lo, S, zk); load10(Zs + ZRV + ch, t_lo, S, zv);
    {
        float zw[10], za[10]; load10(Zs + ZWD + j, t_lo, S, zw); load10(Zs + ZAD + j, t_lo, S, za);
        const float mpw = mup[ZWD - ZRR + j], mnw = mun[ZWD - ZRR + j], mpa = mup[ZAD - ZRR + j], mna = mun[ZAD - ZRR + j];
#pragma unroll
        for (int u = 0; u < 8; ++u) { const int tau = TAU(u);
            *(LAS bf16_t*)(L + O_TW + tau * P + j * 2) = f2bf(tanhf(tshift(zw, u, mpw, mnw)));
            *(LAS bf16_t*)(L + O_ADN + tau * P + j * 2) = f2bf(tshift(za, u, mpa, mna)); }
    }
    __syncthreads();
    {
        const int which = w >> 2, mt = (w >> 1) & 1, nt = w & 1;
        const bf16_t* WT = (const bf16_t*)(a.ws + WS_LORA) + (which ? 2 * 512 * 64 : 0) + ((size_t)d * 512 + h * 64 + 32 * mt + r32) * 64;
        const LAS unsigned char* B = L + (which ? O_ADN : O_TW);
        f32x16 acc = f32x16{};
#pragma unroll
        for (int ks = 0; ks < 4; ++ks) { const bf16x8 av = *(const bf16x8*)(WT + 16 * ks + 8 * hi), bv = *(const LAS bf16x8*)(B + (32 * nt + r32) * P + (16 * ks + 8 * hi) * 2);
            acc = __builtin_amdgcn_mfma_f32_32x32x16_bf16(av, bv, acc, 0, 0, 0); }
        const float* bias = (which ? a.in[15] : a.in[13]) + d * 512 + h * 64 + 32 * mt;
        LAS unsigned char* O = L + (which ? O_AR : O_WL) + (32 * nt + r32) * PF;
#pragma unroll
        for (int g = 0; g < 4; ++g) { const int jj = 8 * g + 4 * hi; const f32x4 bv = *(const f32x4*)(bias + jj);
            *(LAS f32x4*)(O + (32 * mt + jj) * 4) = (f32x4){acc[4 * g] + bv[0], acc[4 * g + 1] + bv[1], acc[4 * g + 2] + bv[2], acc[4 * g + 3] + bv[3]}; }
    }
    __syncthreads();
    float aa[8], bb[8], rr[8], kd[8], vv[8], ld[8];
    {
        const float mpr = mup[ch], mnr = mun[ch], mpk = mup[512 + ch], mnk = mun[512 + ch], mpv = mup[1024 + ch], mnv = mun[1024 + ch];
        const float kkc = a.in[18][ch], kac = a.in[19][ch], rkc = a.in[20][ch];
        float* bon = (float*)(a.ws + WS_BONUS) + ((size_t)d * MTOK + row0) * 8 + h;
#pragma unroll
        for (int u = 0; u < 8; ++u) { const int tau = TAU(u);
            const float wl = *(const LAS float*)(L + O_WL + tau * PF + j * 4), ar = *(const LAS float*)(L + O_AR + tau * PF + j * 4);
            ld[u] = -0.6065306597126334f * sigmoidf_(wl); const float arate = sigmoidf_(ar);
            rr[u] = tshift(zr, u, mpr, mnr); const float k0 = tshift(zk, u, mpk, mnk); vv[u] = tshift(zv, u, mpv, mnv);
            const float kkr = k0 * kkc; const float ssq = wave_sum(kkr * kkr); const float kkn = kkr * (1.0f / sqrtf(ssq + 1e-12f));
            kd[u] = k0 * (1.0f + (arate - 1.0f) * kac); aa[u] = -kkn; bb[u] = kkn * arate;
            const float bsum = wave_sum(rr[u] * kd[u] * rkc);
            if (lane == 0) bon[(size_t)(t_lo + u) * 8] = bsum; }
        float tot = 0.f;
#pragma unroll
        for (int u = 0; u < 8; ++u) tot += ld[u];
        *(LAS float*)(L + O_GSUM + tg * 256 + j * 4) = tot;
    }
    __syncthreads();
    {
        float pre = 0.f, cC = 0.f;
#pragma unroll
        for (int g = 0; g < 8; ++g) { const float s = *(const LAS float*)(L + O_GSUM + g * 256 + j * 4); cC += s; if (g < tg) pre += s; }
        float tot = 0.f;
#pragma unroll
        for (int u = 0; u < 8; ++u) tot += ld[u];
        float At[8], Vt[8], Bh[8], Kh[8]; float pf = 0.f;
#pragma unroll
        for (int u = 0; u < 8; ++u) { pf += ld[u]; const int tau = TAU(u);
            const float cl = pre + (d == 0 ? pf : tot - pf + ld[u]);
            const float e_m1 = __expf(cl - ld[u]), e_p = __expf(cl), e_n = __expf(-cl), e_c = __expf(cC - cl);
            At[u] = aa[u] * e_m1; Vt[u] = vv[u]; Bh[u] = bb[u] * e_c; Kh[u] = kd[u] * e_c;
            *(LAS bf16_t*)(L + O_AT + tau * P + j * 2) = f2bf(At[u]); *(LAS bf16_t*)(L + O_RT + tau * P + j * 2) = f2bf(rr[u] * e_p);
            *(LAS bf16_t*)(L + O_BT + tau * P + j * 2) = f2bf(bb[u] * e_n); *(LAS bf16_t*)(L + O_KT + tau * P + j * 2) = f2bf(kd[u] * e_n); }
#define PK8(dst, X) do { u32x4 w_; _Pragma("unroll") for (int k = 0; k < 4; ++k) { const float x0 = d == 0 ? X[2 * k] : X[7 - 2 * k], x1 = d == 0 ? X[2 * k + 1] : X[6 - 2 * k]; w_[k] = cvt_pk_bf16(x0, x1); } \
            *(LAS u32x4*)(L + (dst) + j * P + tau0 * 2) = w_; } while (0)
        PK8(O_ATT, At); PK8(O_VT, Vt); PK8(O_BHT, Bh); PK8(O_KHT, Kh);
#undef PK8
        if (tg == 0) *(LAS float*)(L + O_WC + j * 4) = __expf(cC);
    }
    __syncthreads();
#pragma unroll
    for (int i = 0; i < 2; ++i) {
        const int ti = 2 * w + i, ms = ti >> 2, nl = ti & 3;
        const int sb = 32 * (ms & 1), tb = 32 * (nl & 1);
        f32x16 acc = f32x16{};
        acc = mm_ll(L + (ms < 2 ? O_BT : O_KT), sb, L + (nl < 2 ? O_AT : O_RT), tb, acc, r32, hi);
        const bool incl = nl >= 2; const int dst = ms < 2 ? (nl < 2 ? O_LAB : O_ARB) : (nl < 2 ? O_LAK : O_ARK);
        const int t = tb + r32;
#pragma unroll
        for (int g = 0; g < 4; ++g) { const int s0 = sb + 8 * g + 4 * hi; float v[4];
#pragma unroll
            for (int e = 0; e < 4; ++e) { const int s = s0 + e; v[e] = (incl ? (s <= t) : (s < t)) ? acc[4 * g + e] : 0.f; }
            st4(L + dst + t * P + s0 * 2, v[0], v[1], v[2], v[3]);
            if (dst == O_LAB && (s0 >> 4) == (t >> 4)) *(LAS f32x4*)(L + O_LABD + (((t >> 4) * 16 + (t & 15)) * 16 + (s0 & 15)) * 4) = (f32x4){v[0], v[1], v[2], v[3]}; }
    }
    __syncthreads();
    if (w < 4) {
        const int mt = w >> 1, nt = w & 1; f32x16 acc = f32x16{};
        acc = mm_ll(L + O_LAK, 32 * mt, L + O_VT, 32 * nt, acc, r32, hi);
#pragma unroll
        for (int g = 0; g < 4; ++g) st4(L + O_XT + (32 * nt + r32) * P + (32 * mt + 8 * g + 4 * hi) * 2, acc[4 * g], acc[4 * g + 1], acc[4 * g + 2], acc[4 * g + 3]);
    } else if (w == 7) {
        const int blk = lane >> 4, cc = lane & 15; float x[16];
#pragma unroll
        for (int t = 0; t < 16; ++t) { float s = (t == cc) ? 1.f : 0.f; const LAS float* lr = (const LAS float*)(L + O_LABD + ((blk * 16 + t) * 16) * 4);
#pragma unroll
            for (int k = 0; k < t; ++k) s += lr[k] * x[k];
            x[t] = s; *(LAS bf16_t*)(L + O_TII + ((blk * 16 + t) * 16 + cc) * 2) = f2bf(s); }
    }
    __syncthreads();
    {
        const int c16 = lane & 15, q4 = lane >> 4;
        const LAS unsigned char* RT = L + (w < 4 ? O_ATT : O_XT) + (16 * (w & 3) + c16) * P;
        LAS unsigned char* OT = L + (w < 4 ? O_ABT : O_U0T) + (16 * (w & 3) + c16) * P;
        const LAS unsigned char* LA = L + O_LAB + c16 * P;
#define RHS(i) ({ const u32x2 r_ = *(const LAS u32x2*)(RT + (16 * (i) + 4 * q4) * 2); (f32x4){bflo(r_.x), bfhi(r_.x), bflo(r_.y), bfhi(r_.y)}; })
#define AFR(i, k1, k2) ({ const u32x2 lo_ = *(const LAS u32x2*)(LA + 16 * (i) * P + (16 * (k1) + 4 * q4) * 2); u32x2 hi_ = {0u, 0u}; if ((k2) >= 0) hi_ = *(const LAS u32x2*)(LA + 16 * (i) * P + (16 * ((k2) < 0 ? 0 : (k2)) + 4 * q4) * 2); \
        __builtin_bit_cast(bf16x8, (u32x4){lo_.x, lo_.y, hi_.x, hi_.y}); })
#define TFR(i) ({ const u32x2 lo_ = *(const LAS u32x2*)(L + O_TII + (((i) * 16 + c16) * 16 + 4 * q4) * 2); __builtin_bit_cast(bf16x8, (u32x4){lo_.x, lo_.y, 0u, 0u}); })
#define BFR(U1, U2) __builtin_bit_cast(bf16x8, (u32x4){cvt_pk_bf16(U1[0], U1[1]), cvt_pk_bf16(U1[2], U1[3]), cvt_pk_bf16(U2[0], U2[1]), cvt_pk_bf16(U2[2], U2[3])})
#define MF16(A_, B_, C_) __builtin_amdgcn_mfma_f32_16x16x32_bf16(A_, B_, C_, 0, 0, 0)
        const f32x4 zero4 = {0.f, 0.f, 0.f, 0.f};
        f32x4 U0 = MF16(TFR(0), BFR(RHS(0), zero4), zero4);
        f32x4 Z1 = MF16(AFR(1, 0, -1), BFR(U0, zero4), RHS(1));
        f32x4 U1 = MF16(TFR(1), BFR(Z1, zero4), zero4);
        f32x4 Z2 = MF16(AFR(2, 0, 1), BFR(U0, U1), RHS(2));
        f32x4 U2 = MF16(TFR(2), BFR(Z2, zero4), zero4);
        f32x4 Z3 = MF16(AFR(3, 0, 1), BFR(U0, U1), RHS(3));
        Z3 = MF16(AFR(3, 2, -1), BFR(U2, zero4), Z3);
        f32x4 U3 = MF16(TFR(3), BFR(Z3, zero4), zero4);
        st4(OT + (0 + 4 * q4) * 2, U0[0], U0[1], U0[2], U0[3]); st4(OT + (16 + 4 * q4) * 2, U1[0], U1[1], U1[2], U1[3]);
        st4(OT + (32 + 4 * q4) * 2, U2[0], U2[1], U2[2], U2[3]); st4(OT + (48 + 4 * q4) * 2, U3[0], U3[1], U3[2], U3[3]);
#undef RHS
#undef AFR
#undef TFR
#undef BFR
#undef MF16
    }
    __syncthreads();
    {
        const int mt = (w >> 1) & 1, nt = w & 1;
        if (w < 4) {
            f32x16 acc = f32x16{};
            acc = mm_ll(L + O_ABT, 32 * mt, L + O_BHT, 32 * nt, acc, r32, hi);
            if (mt == nt) { const float wc = *(const LAS float*)(L + O_WC + (32 * nt + r32) * 4);
#pragma unroll
                for (int r = 0; r < 16; ++r) if (crow(r, hi) == r32) acc[r] += wc; }
            store_native(slot + (mt * 2 + nt) * 2048, acc, lane);
            f32x16 rb;
#pragma unroll
            for (int g = 0; g < 4; ++g) { const u32x2 r_ = *(const LAS u32x2*)(L + O_RT + (32 * nt + r32) * P + (32 * mt + 8 * g + 4 * hi) * 2);
                rb[4 * g] = bflo(r_.x); rb[4 * g + 1] = bfhi(r_.x); rb[4 * g + 2] = bflo(r_.y); rb[4 * g + 3] = bfhi(r_.y); }
            rb = mm_ll(L + O_ABT, 32 * mt, L + O_ARB, 32 * nt, rb, r32, hi);
            store_native(slot + 16384 + (mt * 2 + nt) * 2048, rb, lane);
        } else {
            f32x16 acc = f32x16{};
            acc = mm_ll(L + O_BHT, 32 * mt, L + O_U0T, 32 * nt, acc, r32, hi);
            acc = mm_ll(L + O_KHT, 32 * mt, L + O_VT, 32 * nt, acc, r32, hi);
            store_native(slot + 8192 + (mt * 2 + nt) * 2048, acc, lane);
            f32x16 y0 = f32x16{};
            y0 = mm_ll(L + O_ARB, 32 * mt, L + O_U0T, 32 * nt, y0, r32, hi);
            y0 = mm_ll(L + O_ARK, 32 * mt, L + O_VT, 32 * nt, y0, r32, hi);
            store_native(slot + 24576 + (mt * 2 + nt) * 2048, y0, lane);
        }
    }
    __syncthreads();
#undef TAU
}

__device__ __forceinline__ void s23_chain(const Args& a, int d, int q, int h, int icb, const unsigned char* slots  , int lane) {
    const int r32 = lane & 31, hi = lane >> 5;
    const int row0 = seq_row0(q), NC = seq_len(q) / 64;
    bf16_t* Zy = (bf16_t*)(a.ws + WS_Z) + (size_t)row0 * ZP + (d == 0 ? ZRR : ZRK) + h * 64 + 32 * icb + r32;
    f32x16 X0 = f32x16{}, X1 = f32x16{};
#define UNPK(dst, w0, w1) do { _Pragma("unroll") for (int q_ = 0; q_ < 4; ++q_) { dst[2 * q_] = bflo(w0[q_]); dst[2 * q_ + 1] = bfhi(w0[q_]); dst[8 + 2 * q_] = bflo(w1[q_]); dst[9 + 2 * q_] = bfhi(w1[q_]); } } while (0)
    for (int cc = 0; cc < NC; ++cc) {
        const int ck = d == 0 ? cc : NC - 1 - cc;
        const unsigned char* sl = slots + (size_t)ck * SLOT_BYTES;
        u32x4 mw[4][2], rw_[4][2], dw[2][2], yw[2][2];
#pragma unroll
        for (int t = 0; t < 4; ++t) { mw[t][0] = *(const u32x4*)(sl + t * 2048 + lane * 32); mw[t][1] = *(const u32x4*)(sl + t * 2048 + lane * 32 + 16);
                                      rw_[t][0] = *(const u32x4*)(sl + 16384 + t * 2048 + lane * 32); rw_[t][1] = *(const u32x4*)(sl + 16384 + t * 2048 + lane * 32 + 16); }
#pragma unroll
        for (int t = 0; t < 2; ++t) { dw[t][0] = *(const u32x4*)(sl + 8192 + (t * 2 + icb) * 2048 + lane * 32); dw[t][1] = *(const u32x4*)(sl + 8192 + (t * 2 + icb) * 2048 + lane * 32 + 16);
                                      yw[t][0] = *(const u32x4*)(sl + 24576 + (t * 2 + icb) * 2048 + lane * 32); yw[t][1] = *(const u32x4*)(sl + 24576 + (t * 2 + icb) * 2048 + lane * 32 + 16); }
        bf16x8 xb[2][2];
#pragma unroll
        for (int s = 0; s < 2; ++s) {
            xb[0][s] = __builtin_bit_cast(bf16x8, (u32x4){cvt_pk_bf16(X0[8 * s], X0[8 * s + 1]), cvt_pk_bf16(X0[8 * s + 2], X0[8 * s + 3]), cvt_pk_bf16(X0[8 * s + 4], X0[8 * s + 5]), cvt_pk_bf16(X0[8 * s + 6], X0[8 * s + 7])});
            xb[1][s] = __builtin_bit_cast(bf16x8, (u32x4){cvt_pk_bf16(X1[8 * s], X1[8 * s + 1]), cvt_pk_bf16(X1[8 * s + 2], X1[8 * s + 3]), cvt_pk_bf16(X1[8 * s + 4], X1[8 * s + 5]), cvt_pk_bf16(X1[8 * s + 6], X1[8 * s + 7])}); }
        f32x16 N0, N1, Y0, Y1;
        UNPK(N0, dw[0][0], dw[0][1]); UNPK(N1, dw[1][0], dw[1][1]); UNPK(Y0, yw[0][0], yw[0][1]); UNPK(Y1, yw[1][0], yw[1][1]);
#pragma unroll
        for (int rb = 0; rb < 2; ++rb)
#pragma unroll
            for (int s = 0; s < 2; ++s) {
                N0 = __builtin_amdgcn_mfma_f32_32x32x16_bf16(__builtin_bit_cast(bf16x8, mw[rb * 2 + 0][s]), xb[rb][s], N0, 0, 0, 0);
                N1 = __builtin_amdgcn_mfma_f32_32x32x16_bf16(__builtin_bit_cast(bf16x8, mw[rb * 2 + 1][s]), xb[rb][s], N1, 0, 0, 0);
                Y0 = __builtin_amdgcn_mfma_f32_32x32x16_bf16(__builtin_bit_cast(bf16x8, rw_[rb * 2 + 0][s]), xb[rb][s], Y0, 0, 0, 0);
                Y1 = __builtin_amdgcn_mfma_f32_32x32x16_bf16(__builtin_bit_cast(bf16x8, rw_[rb * 2 + 1][s]), xb[rb][s], Y1, 0, 0, 0); }
        X0 = N0; X1 = N1;
        const int t0 = ck * 64;
#pragma unroll
        for (int r = 0; r < 16; ++r) { const int ta = crow(r, hi), tb = 32 + crow(r, hi);
            Zy[(size_t)(t0 + (d == 0 ? ta : 63 - ta)) * ZP] = f2bf(Y0[r]); Zy[(size_t)(t0 + (d == 0 ? tb : 63 - tb)) * ZP] = f2bf(Y1[r]); }
    }
#undef UNPK
}

__device__ __forceinline__ void post_item(const Frame& F, const Args& a, int q, int h, int blk) {
    LAS unsigned char* L = F.lds; constexpr int PS = 272, O_SG = 0, O_G = 64 * PS;
    const int lane = F.lane, w = F.wave, r32 = lane & 31, hi = lane >> 5, j = lane, tg = w;
    const int row0 = seq_row0(q), S = seq_len(q), t_lo = blk * 64 + 8 * tg;
    bf16_t* Zs = (bf16_t*)(a.ws + WS_Z) + (size_t)row0 * ZP;
    const float* mup = a.in[11]; const float* mun = a.in[12];
    {
        float z0[10], z1[10]; load10(Zs + ZGD + j, t_lo, S, z0); load10(Zs + ZGD + 64 + j, t_lo, S, z1);
        const float mp0 = mup[ZGD - ZRR + j], mn0 = mun[ZGD - ZRR + j], mp1 = mup[ZGD - ZRR + 64 + j], mn1 = mun[ZGD - ZRR + 64 + j];
#pragma unroll
        for (int u = 0; u < 8; ++u) { *(LAS bf16_t*)(L + O_SG + (8 * tg + u) * PS + j * 2) = f2bf(sigmoidf_(tshift(z0, u, mp0, mn0)));
                                      *(LAS bf16_t*)(L + O_SG + (8 * tg + u) * PS + (64 + j) * 2) = f2bf(sigmoidf_(tshift(z1, u, mp1, mn1))); }
    }
    __syncthreads();
    if (w < 4) {
        const int mt = w >> 1, nt = w & 1;
        const bf16_t* GT = (const bf16_t*)(a.ws + WS_LORA) + 4 * 512 * 64 + ((size_t)h * 64 + 32 * mt + r32) * 128;
        f32x16 acc = f32x16{};
#pragma unroll
        for (int ks = 0; ks < 8; ++ks) { const bf16x8 av = *(const bf16x8*)(GT + 16 * ks + 8 * hi), bv = *(const LAS bf16x8*)(L + O_SG + (32 * nt + r32) * PS + (16 * ks + 8 * hi) * 2);
            acc = __builtin_amdgcn_mfma_f32_32x32x16_bf16(av, bv, acc, 0, 0, 0); }
#pragma unroll
        for (int g = 0; g < 4; ++g) *(LAS f32x4*)(L + O_G + (32 * nt + r32) * PS + (32 * mt + 8 * g + 4 * hi) * 4) = (f32x4){acc[4 * g], acc[4 * g + 1], acc[4 * g + 2], acc[4 * g + 3]};
    }
    __syncthreads();
    {
        const int ch = h * 64 + j;
        float zv[10]; load10(Zs + ZRV + ch, t_lo, S, zv);
        const float mpv = mup[1024 + ch], mnv = mun[1024 + ch], lg = a.in[21][ch], lb = a.in[22][ch];
        const float* bon0 = (const float*)(a.ws + WS_BONUS) + (size_t)row0 * 8 + h; const float* bon1 = bon0 + (size_t)MTOK * 8;
#pragma unroll
        for (int u = 0; u < 8; ++u) { const int t = t_lo + u;
            const float y = bf2f(Zs[(size_t)t * ZP + ZRR + ch]) + bf2f(Zs[(size_t)t * ZP + ZRK + ch]);
            const float mean = wave_sum(y) * (1.f / 64.f); const float dv = y - mean; const float var = wave_sum(dv * dv) * (1.f / 64.f);
            const float yn = dv * (1.0f / sqrtf(var + LNX_EPS)) * lg + lb;
            const float bsum = bon0[(size_t)t * 8] + bon1[(size_t)t * 8];
            const float g = *(const LAS float*)(L + O_G + (8 * tg + u) * PS + j * 4);
            Zs[(size_t)t * ZP + ZRR + ch] = f2bf((yn + bsum * tshift(zv, u, mpv, mnv)) * g); }
    }
    __syncthreads();
}
}

#ifndef ONE_LAUNCH
#define ONE_LAUNCH 0
#endif
constexpr int NPHASE = 13;
constexpr int NOJUMP = 1 << 30;
template <int LO, int HI>
__global__ void __launch_bounds__(NTHR, 2) fwd_kernel(Args a) {
    extern __shared__ __attribute__((aligned(16))) unsigned char lds_raw[];
    Frame F; F.lds = (LAS unsigned char*)lds_raw; F.tid = threadIdx.x; F.lane = F.tid & 63; F.wave = __builtin_amdgcn_readfirstlane(F.tid >> 6);
    F.G = gridDim.x; { const int bx = blockIdx.x; F.vcu = (F.G % 8 == 0) ? (bx % 8) * (F.G / 8) + bx / 8 : bx; }
    unsigned char* ws = a.ws; bf16_t* Z = (bf16_t*)(ws + WS_Z);
    unsigned char* slots = (unsigned char*)a.out;
#pragma unroll 1
    for (int ph = LO; ph < HI; ++ph) {
        switch (ph) {
        case 0: p0_prologue(F, a); break;
        case 1: { pg8::Gemm g{(const char*)a.out, (const bf16_t*)(ws + WS_WIN), MTOK, ZP, DM, DM * 2, NOJUMP, 0}; pg8::StaticOrder S; S.init(MTOK, ZP, F.G, (int)blockIdx.x);
                  pg8::EpiZ E{Z, ZP}; pg8::gemm_phase<pg8::EpiZ, pg8::StaticOrder, true>(F.lds, g, S, E); } break;
        case 2: { qk_prep(F, a);
                  for (int it = F.vcu; it < 4096; it += F.G) { const int ck = it & 255, h = (it >> 8) & 7, d = it >> 11; rw::s1_item(F, a, d, 0, h, ck, slots + (size_t)it * SLOT_BYTES); } } break;
        case 3: { if (F.vcu < 32 && F.wave == 0) { const int chain = F.vcu >> 1, icb = F.vcu & 1, d = chain >> 3, h = chain & 7;
                      rw::s23_chain(a, d, 0, h, icb, slots + (size_t)chain * 256 * SLOT_BYTES, F.lane); } } break;
        case 4: { for (int it = F.vcu; it < 4096; it += F.G) { const int ck = it & 31, h = (it >> 5) & 7, b = (it >> 8) & 7, d = it >> 11; rw::s1_item(F, a, d, 1 + b, h, ck, slots + (size_t)it * SLOT_BYTES); } } break;
        case 5: { if (F.wave == 0) { for (int v = F.vcu; v < 256; v += F.G) { const int chain = v >> 1, icb = v & 1, h = chain & 7, b = (chain >> 3) & 7, d = chain >> 6;
                      rw::s23_chain(a, d, 1 + b, h, icb, slots + (size_t)chain * 32 * SLOT_BYTES, F.lane); } } } break;
        case 6: { for (int it = F.vcu; it < 4096; it += F.G) { if (it < 2048) rw::post_item(F, a, 0, it >> 8, it & 255); else { const int r = it - 2048; rw::post_item(F, a, 1 + (r >> 8), (r >> 5) & 7, r & 31); } } } break;
        case 7: {
                  float lam; { const float p1 = wave_sum(a.in[6][F.lane] * a.in[7][F.lane]), p2 = wave_sum(a.in[8][F.lane] * a.in[9][F.lane]); lam = __expf(p1) - __expf(p2) + LAMBDA_INIT; }
                  for (int v = F.vcu; v < 256; v += F.G) {
                      att::attn_unit(0, SP, v >> 6, v & 63, Z, F.lds, lam, a.in[10]);
                      att::attn_unit(SP + (v >> 5) * SS, SS, (v >> 3) & 3, v & 7, Z, F.lds, lam, a.in[10]); } } break;
        case 8: { pg8::Gemm g{(const char*)Z, (const bf16_t*)(ws + WS_WOUT), MTOK, DM, DM, ZP * 2, 8, 2048}; pg8::StaticOrder S; S.init(MTOK, DM, F.G, (int)blockIdx.x);
                  pg8::EpiOut E{a.in[0], a.in[1], a.out, Z, (float*)(ws + WS_ROWSQ)}; pg8::gemm_phase<pg8::EpiOut, pg8::StaticOrder, true>(F.lds, g, S, E); } break;
        case 9: case 11: { const int half = (ph - 9) >> 1;
                  pg8::Gemm g{(const char*)(Z + (size_t)half * 16384 * ZP + ZXN2), (const bf16_t*)(ws + WS_W1), 16384, DFF, DM, ZP * 2, NOJUMP, 0}; pg8::StaticOrder S; S.init(16384, DFF, F.G, (int)blockIdx.x);
                  pg8::EpiUp E{(char*)(ws + WS_Z), (const float*)(ws + WS_ROWSQ), half * 16384}; pg8::gemm_phase<pg8::EpiUp, pg8::StaticOrder, true>(F.lds, g, S, E); } break;
        case 10: case 12: { const int half = (ph - 10) >> 1;
                  pg8::Gemm g{(const char*)(ws + WS_Z), (const bf16_t*)(ws + WS_W2), 16384, DM, DFF, 13312, 32, 2560}; pg8::StaticOrder S; S.init(16384, DM, F.G, (int)blockIdx.x);
                  pg8::EpiDown E{a.out, half * 16384}; pg8::gemm_phase<pg8::EpiDown, pg8::StaticOrder, true>(F.lds, g, S, E); } break;
        default: break;
        }
#if ONE_LAUNCH
        if (ph + 1 < HI) { cg::this_grid().sync(); }
#endif
    }
}

extern "C" void kernel_launch(void* const* d_in, const int* in_sizes, int n_in, void* d_out, int out_size, void* d_ws, size_t ws_size, hipStream_t stream) {
    static int grid = 0;
    if (grid == 0) {
        if (n_in != 27 || out_size != MTOK * DM || ws_size < WS_END) { fprintf(stderr, "kernel_launch: unexpected shapes (n_in %d out %d ws %zu)\n", n_in, out_size, ws_size); grid = -1; return; }
        int dev = 0, cus = 0; (void)hipGetDevice(&dev); (void)hipDeviceGetAttribute(&cus, hipDeviceAttributeMultiprocessorCount, dev);
        bool ok = true;
#if ONE_LAUNCH
        ok = ok && hipFuncSetAttribute((const void*)fwd_kernel<0, NPHASE>, hipFuncAttributeMaxDynamicSharedMemorySize, LDS_BYTES) == hipSuccess;
        int per_cu = 0; (void)hipOccupancyMaxActiveBlocksPerMultiprocessor(&per_cu, (const void*)fwd_kernel<0, NPHASE>, NTHR, LDS_BYTES); (void)hipGetLastError();
        if (per_cu < 1) fprintf(stderr, "kernel_launch: occupancy query says %d blocks/CU\n", per_cu);
#else
#define SETA(p) ok = ok && hipFuncSetAttribute((const void*)fwd_kernel<p, p + 1>, hipFuncAttributeMaxDynamicSharedMemorySize, LDS_BYTES) == hipSuccess;
        SETA(0) SETA(1) SETA(2) SETA(3) SETA(4) SETA(5) SETA(6) SETA(7) SETA(8) SETA(9) SETA(10) SETA(11) SETA(12)
#undef SETA
#endif
        if (!ok) { fprintf(stderr, "kernel_launch: hipFuncSetAttribute failed\n"); grid = -1; return; }
        grid = cus > 256 ? 256 : cus;
    }
    if (grid < 0) return;
    Args a{};
    for (int i = 0; i < 27; ++i) a.in[i] = (const float*)d_in[i];
    a.out = (float*)d_out; a.ws = (unsigned char*)d_ws;
#if ONE_LAUNCH
    a.ph_lo = 0; a.ph_hi = NPHASE;
    void* args[] = {&a};
    hipError_t e = hipLaunchCooperativeKernel((const void*)fwd_kernel<0, NPHASE>, dim3(grid), dim3(NTHR), args, LDS_BYTES, stream);
    if (e != hipSuccess) fprintf(stderr, "cooperative launch failed: %s (grid %d)\n", hipGetErrorString(e), grid);
#else
#define LAUNCH(p) hipLaunchKernelGGL((fwd_kernel<p, p + 1>), dim3(grid), dim3(NTHR), LDS_BYTES, stream, a);
    LAUNCH(0) LAUNCH(1) LAUNCH(2) LAUNCH(3) LAUNCH(4) LAUNCH(5) LAUNCH(6) LAUNCH(7) LAUNCH(8) LAUNCH(9) LAUNCH(10) LAUNCH(11) LAUNCH(12)
#undef LAUNCH
#endif
}
```

```cpp
#include <hip/hip_runtime.h>
#include <hip/hip_cooperative_groups.h>
#include <cstdio>
#include <cstdint>
namespace cg = cooperative_groups;

#define LAS __attribute__((address_space(3)))
typedef unsigned short bf16_t;
typedef short bf16x8 __attribute__((ext_vector_type(8)));
typedef short s16x4 __attribute__((ext_vector_type(4)));
typedef float f32x4 __attribute__((ext_vector_type(4)));
typedef float f32x16 __attribute__((ext_vector_type(16)));
typedef unsigned u32x4 __attribute__((ext_vector_type(4)));
typedef unsigned u32x2 __attribute__((ext_vector_type(2)));
typedef float f32x2_t __attribute__((ext_vector_type(2)));
typedef __bf16 bf16x2_t __attribute__((ext_vector_type(2)));

constexpr int MTOK = 32768, DM = 1024, ZP = 3328, DFF = 4096;
constexpr int SP = 16384, SS = 2048;
constexpr int ZQ = 0, ZK = 512, ZV = 1024, ZRR = 1536, ZRK = 2048, ZRV = 2560, ZWD = 3072, ZAD = 3136, ZGD = 3200;
constexpr int ZXN2 = 2048;
constexpr float NORM_EPS = 1e-6f, LNX_EPS = 64e-5f;
constexpr float QSCALE = 0.125f * 1.4426950408889634f;
constexpr float LAMBDA_INIT = 0.2f;
constexpr int NCHUNK_P = SP / 64, NCHUNK_S = SS / 64;

constexpr size_t MiB = 1u << 20;
constexpr size_t WS_CTL = 0;
constexpr size_t WS_WIN = 1 * MiB, WS_WOUT = 8 * MiB, WS_W1 = 10 * MiB, WS_W2 = 18 * MiB;
constexpr size_t WS_ROPE = 26 * MiB;
constexpr size_t WS_LORA = 30 * MiB;
constexpr size_t WS_ROWSQ = 31 * MiB;
constexpr size_t WS_BONUS = 33 * MiB;
constexpr size_t WS_Z = 36 * MiB;
constexpr size_t WS_END = 244 * MiB;
static_assert(WS_Z + (size_t)MTOK * ZP * 2 <= WS_END, "ws map");
constexpr size_t SLOT_BYTES = 32768;

__device__ __forceinline__ unsigned cvt_pk_bf16(float lo, float hi) { f32x2_t v = {lo, hi}; bf16x2_t b = __builtin_convertvector(v, bf16x2_t); return __builtin_bit_cast(unsigned, b); }
__device__ __forceinline__ float bf2f(unsigned short u) { return __uint_as_float(((unsigned)u) << 16); }
__device__ __forceinline__ float bflo(unsigned u) { return __uint_as_float(u << 16); }
__device__ __forceinline__ float bfhi(unsigned u) { return __uint_as_float(u & 0xffff0000u); }
__device__ __forceinline__ unsigned short f2bf(float f) { return (unsigned short)(cvt_pk_bf16(f, 0.f) & 0xffffu); }
__device__ __forceinline__ float wave_sum(float v) {
#pragma unroll
    for (int o = 1; o < 64; o <<= 1) v += __shfl_xor(v, o);
    return v;
}
#define LDS_WAIT() asm volatile("s_waitcnt lgkmcnt(0)" ::: "memory")
#define VM_WAIT() asm volatile("s_waitcnt vmcnt(0)" ::: "memory")

namespace pg8 {
constexpr int BM = 256, BK = 64, HALF = 128, HTB = HALF * BK * 2, STAGE_BYTES = 8 * HTB, NXCD = 8, WGM = 8;
__host__ __device__ __forceinline__ int lds_byte(int r, int c) { const int st = (r >> 4) * 2 + (c >> 5), rr = r & 15, cc = c & 31, ob = rr * 64 + cc * 2; return st * 1024 + (ob ^ (((ob >> 9) & 1) << 5)); }
__host__ __device__ __forceinline__ void stage_rc(int b, int& R, int& C) { const int st = b / 1024, sb = b % 1024, swz = sb ^ (((sb >> 9) & 1) << 5); R = (st >> 1) * 16 + swz / 64; C = (st & 1) * 32 + (swz % 64) / 2; }
__host__ __device__ __forceinline__ int perm32(int rho) { const int n = rho >> 4, i = rho & 15; return 8 * (i >> 2) + 4 * n + (i & 3); }
struct Unit { int pm, pn; };
struct Gemm { const char* A; const bf16_t* Bt; int M, N, K; int lda; int jkt; int jbytes; };
struct StaticOrder {
    int nM, nN, nwg, G, c;
    __host__ __device__ void init(int M, int N, int G_, int c_) { nM = M / BM; nN = N / BM; nwg = nM * nN; G = G_; c = c_; }
    __host__ __device__ bool next(int i, Unit& u) const {
        const long L = (long)i * G + c; if (L >= nwg) return false;
        int wgid = (int)L; { const int q = nwg / NXCD, r = nwg % NXCD, xcd = wgid % NXCD, off = wgid / NXCD; wgid = (xcd < r ? xcd * (q + 1) : r * (q + 1) + (xcd - r) * q) + off; }
        const int nig = WGM * nN, gid = wgid / nig, fm = gid * WGM, gsz = (nM - fm) < WGM ? (nM - fm) : WGM;
        u.pm = fm + ((wgid % nig) % gsz); u.pn = (wgid % nig) / gsz; return true;
    }
};

struct EpiZ {
    static constexpr bool PERM = true;
    bf16_t* O; int ldc;
    __device__ __forceinline__ void operator()(const f32x4 (&acc)[2][2][4][2], const Unit& u, int wr, int wc, int fr, int fq) const {
        const int row0 = u.pm * BM + wr * 64 + fr, col0 = u.pn * BM + wc * 32 + 8 * fq;
#pragma unroll
        for (int ai = 0; ai < 2; ++ai)
#pragma unroll
            for (int m = 0; m < 4; ++m) { bf16_t* rowp = O + (size_t)(row0 + ai * HALF + m * 16) * ldc + col0;
#pragma unroll
                for (int bj = 0; bj < 2; ++bj) { const f32x4 v0 = acc[ai][bj][m][0], v1 = acc[ai][bj][m][1];
                    u32x4 w; w.x = cvt_pk_bf16(v0[0], v0[1]); w.y = cvt_pk_bf16(v0[2], v0[3]); w.z = cvt_pk_bf16(v1[0], v1[1]); w.w = cvt_pk_bf16(v1[2], v1[3]);
                    *(u32x4*)(rowp + bj * HALF) = w; } }
    }
};
struct EpiOut {
    static constexpr bool PERM = false;
    const float* xp; const float* xs; float* out; bf16_t* Z; float* rowsq;
    __device__ __forceinline__ void operator()(const f32x4 (&acc)[2][2][4][2], const Unit& u, int wr, int wc, int fr, int fq) const {
        const int col0 = u.pn * BM + wc * 32 + 4 * fq;
#pragma unroll
        for (int ai = 0; ai < 2; ++ai)
#pragma unroll
            for (int m = 0; m < 4; ++m) { const int r = u.pm * BM + ai * HALF + wr * 64 + m * 16 + fr;
                const float* xr = (r < SP ? xp + (size_t)r * DM : xs + (size_t)(r - SP) * DM) + col0; float* orow = out + (size_t)r * DM + col0; bf16_t* zr = Z + (size_t)r * ZP + ZXN2 + col0;
                float ss = 0.f;
#pragma unroll
                for (int bj = 0; bj < 2; ++bj)
#pragma unroll
                    for (int n = 0; n < 2; ++n) { const f32x4 xv = *(const f32x4*)(xr + bj * HALF + n * 16); const f32x4 o = xv + acc[ai][bj][m][n];
                        *(f32x4*)(orow + bj * HALF + n * 16) = o; ss += (o[0] * o[0] + o[1] * o[1]) + (o[2] * o[2] + o[3] * o[3]);
                        u32x2 w; w.x = cvt_pk_bf16(o[0], o[1]); w.y = cvt_pk_bf16(o[2], o[3]); *(u32x2*)(zr + bj * HALF + n * 16) = w; }
                ss += __shfl_xor(ss, 16); ss += __shfl_xor(ss, 32);
                if (fq == 0) rowsq[(size_t)r * 16 + u.pn * 4 + wc] = ss;
                if (m & 1) asm volatile("" ::: "memory"); }
    }
};
struct EpiUp {
    static constexpr bool PERM = true;
    char* H; const float* rowsq; int row_off;
    __device__ __forceinline__ void operator()(const f32x4 (&acc)[2][2][4][2], const Unit& u, int wr, int wc, int fr, int fq) const {
        const int row0 = u.pm * BM + wr * 64 + fr, col0 = u.pn * BM + wc * 32 + 8 * fq;
#pragma unroll
        for (int ai = 0; ai < 2; ++ai)
#pragma unroll
            for (int m = 0; m < 4; ++m) { const int r = row0 + ai * HALF + m * 16; const f32x4* rq = (const f32x4*)(rowsq + (size_t)(row_off + r) * 16);
                const f32x4 q0 = rq[0], q1 = rq[1], q2 = rq[2], q3 = rq[3];
                const float ssum = ((q0[0] + q0[1]) + (q0[2] + q0[3])) + ((q1[0] + q1[1]) + (q1[2] + q1[3])) + ((q2[0] + q2[1]) + (q2[2] + q2[3])) + ((q3[0] + q3[1]) + (q3[2] + q3[3]));
                const float rstd = __builtin_amdgcn_rsqf(ssum * (1.0f / DM) + NORM_EPS);
                char* rowp = H + (size_t)r * 13312;
#pragma unroll
                for (int bj = 0; bj < 2; ++bj) { const int c = col0 + bj * HALF; f32x4 v0 = acc[ai][bj][m][0] * rstd, v1 = acc[ai][bj][m][1] * rstd;
#pragma unroll
                    for (int e = 0; e < 4; ++e) { const float a = fmaxf(v0[e], 0.f), b = fmaxf(v1[e], 0.f); v0[e] = a * a; v1[e] = b * b; }
                    u32x4 w; w.x = cvt_pk_bf16(v0[0], v0[1]); w.y = cvt_pk_bf16(v0[2], v0[3]); w.z = cvt_pk_bf16(v1[0], v1[1]); w.w = cvt_pk_bf16(v1[2], v1[3]);
                    *(u32x4*)(rowp + (size_t)c * 2 + (c >= 2048 ? 2560 : 0)) = w; } }
    }
};
struct EpiDown {
    static constexpr bool PERM = false;
    float* out; int row_off;
    __device__ __forceinline__ void operator()(const f32x4 (&acc)[2][2][4][2], const Unit& u, int wr, int wc, int fr, int fq) const {
        const int col0 = u.pn * BM + wc * 32 + 4 * fq;
#pragma unroll
        for (int ai = 0; ai < 2; ++ai)
#pragma unroll
            for (int m = 0; m < 4; ++m) { const int r = row_off + u.pm * BM + ai * HALF + wr * 64 + m * 16 + fr; float* orow = out + (size_t)r * DM + col0;
#pragma unroll
                for (int bj = 0; bj < 2; ++bj)
#pragma unroll
                    for (int n = 0; n < 2; ++n) { const f32x4 xv = *(const f32x4*)(orow + bj * HALF + n * 16); *(f32x4*)(orow + bj * HALF + n * 16) = xv + acc[ai][bj][m][n]; }
                if (m & 1) asm volatile("" ::: "memory"); }
    }
};

template <class Epi, class Sched, bool ALIGN_EPI>
__device__ __forceinline__ void gemm_phase(LAS unsigned char* lds, const Gemm g, const Sched& S, const Epi& E) {
    const int tid = threadIdx.x, wid = __builtin_amdgcn_readfirstlane(tid >> 6), lane = tid & 63, wr = wid >> 2, wc = wid & 3, fr = lane & 15, fq = lane >> 4;
    const int K = g.K, nt = K / BK;
    unsigned voffA[2], voffB[2];
#pragma unroll
    for (int i = 0; i < 2; ++i) { int R, C; stage_rc(tid * 16 + i * 8192, R, C); const int Rb = Epi::PERM ? ((R & ~31) + perm32(R & 31)) : R;
        voffA[i] = (unsigned)(R * g.lda + C * 2); voffB[i] = (unsigned)(Rb * K + C) * 2u; }
    const size_t kstep = (size_t)(BK * 2);
    const size_t hstepA = (size_t)HALF * g.lda, tstepA = 2 * hstepA;
    const size_t hstepB = (size_t)HALF * K * 2, tstepB = 2 * hstepB;
    const unsigned ldsw = (unsigned)wid * 1024u;
    const int aoff = lds_byte(wr * 64 + fr, fq * 8), boff = lds_byte(wc * 32 + fr, fq * 8);
#define PG8_AOFF(kt) ((size_t)(kt) * kstep + ((kt) >= g.jkt ? (size_t)g.jbytes : (size_t)0))
#define PG8_SA(b, h) (((b) * 2 + (h)) * HTB)
#define PG8_SB(b, h) ((4 + (b) * 2 + (h)) * HTB)
#define PG8_STAGE(bufoff, gbase, voff) do { _Pragma("unroll") for (int _i = 0; _i < 2; ++_i) \
        __builtin_amdgcn_global_load_lds((const unsigned*)((const char*)(gbase) + (voff)[_i]), (LAS unsigned*)(lds + (bufoff) + ldsw + _i * 8192), 16, 0, 0); } while (0)
#define PG8_LDA(dst, b, h) do { _Pragma("unroll") for (int m = 0; m < 4; ++m) _Pragma("unroll") for (int k = 0; k < 2; ++k) dst[m][k] = *(const LAS bf16x8*)(lds + PG8_SA(b, h) + aoff + m * 2048 + k * 1024); } while (0)
#define PG8_LDB(dst, b, h) do { _Pragma("unroll") for (int n = 0; n < 2; ++n) _Pragma("unroll") for (int k = 0; k < 2; ++k) dst[n][k] = *(const LAS bf16x8*)(lds + PG8_SB(b, h) + boff + n * 2048 + k * 1024); } while (0)
#define PG8_MMA(ai, bj, At, Bt) do { __builtin_amdgcn_s_setprio(1); _Pragma("unroll") for (int m = 0; m < 4; ++m) _Pragma("unroll") for (int n = 0; n < 2; ++n) _Pragma("unroll") for (int k = 0; k < 2; ++k) \
        acc[ai][bj][m][n] = __builtin_amdgcn_mfma_f32_16x16x32_bf16(Bt[n][k], At[m][k], acc[ai][bj][m][n], 0, 0, 0); __builtin_amdgcn_s_setprio(0); } while (0)
#define PG8_WAIT_V(n) asm volatile("s_waitcnt vmcnt(" #n ")" ::: "memory")
#define PG8_WAIT_L(n) asm volatile("s_waitcnt lgkmcnt(" #n ")" ::: "memory")
#define PG8_BAR __builtin_amdgcn_s_barrier()
#define PG8_SCHED __builtin_amdgcn_sched_barrier(0)
    Unit cur, nxt; int ui = 0;
    if (!S.next(0, cur)) return;
    f32x4 acc[2][2][4][2];
#pragma unroll
    for (int a = 0; a < 2; ++a)
#pragma unroll
        for (int b = 0; b < 2; ++b)
#pragma unroll
            for (int m = 0; m < 4; ++m)
#pragma unroll
                for (int n = 0; n < 2; ++n) acc[a][b][m][n] = (f32x4){0.f, 0.f, 0.f, 0.f};
    bf16x8 At[4][2], B0[2][2], B1[2][2];
    const char* cA = g.A + (size_t)cur.pm * tstepA; const char* cB = (const char*)g.Bt + (size_t)cur.pn * tstepB;
    {
        PG8_STAGE(PG8_SB(0, 0), cB, voffB); PG8_STAGE(PG8_SB(0, 1), cB + hstepB, voffB); PG8_STAGE(PG8_SA(0, 0), cA + PG8_AOFF(0), voffA); PG8_STAGE(PG8_SA(0, 1), cA + hstepA + PG8_AOFF(0), voffA);
        if (wr == 1) PG8_BAR;
        PG8_WAIT_V(2); PG8_BAR;
        PG8_STAGE(PG8_SB(1, 0), cB + kstep, voffB); PG8_STAGE(PG8_SA(1, 0), cA + PG8_AOFF(1), voffA); PG8_STAGE(PG8_SB(1, 1), cB + hstepB + kstep, voffB);
        PG8_WAIT_V(6); PG8_BAR;
    }
    for (;;) {
        const bool has_next = S.next(ui + 1, nxt);
        const char* nA = has_next ? g.A + (size_t)nxt.pm * tstepA : cA; const char* nB = has_next ? (const char*)g.Bt + (size_t)nxt.pn * tstepB : cB;
        for (int t = 0; t < nt; t += 2) {
            const bool last = (t == nt - 2);
            const char* a1 = cA + PG8_AOFF(t + 1);
            const char* a2 = last ? nA + PG8_AOFF(0) : cA + PG8_AOFF(t + 2); const char* b2 = last ? nB : cB + (size_t)(t + 2) * kstep;
            const char* a3 = last ? nA + PG8_AOFF(1) : cA + PG8_AOFF(t + 3); const char* b3 = b2 + kstep;
            PG8_LDB(B0, 0, 0); PG8_LDB(B1, 0, 1); PG8_SCHED; PG8_LDA(At, 0, 0); PG8_STAGE(PG8_SA(1, 1), a1 + hstepA, voffA);
            PG8_WAIT_V(8); PG8_WAIT_L(0); PG8_BAR; PG8_MMA(0, 0, At, B0); PG8_MMA(0, 1, At, B1); PG8_BAR; PG8_SCHED;
            PG8_LDA(At, 0, 1); PG8_STAGE(PG8_SB(0, 0), b2, voffB); PG8_STAGE(PG8_SB(0, 1), b2 + hstepB, voffB); PG8_STAGE(PG8_SA(0, 0), a2, voffA);
            PG8_WAIT_V(8); PG8_WAIT_L(0); PG8_BAR; PG8_MMA(1, 0, At, B0); PG8_MMA(1, 1, At, B1); PG8_BAR; PG8_SCHED;
            PG8_LDB(B0, 1, 0); PG8_LDB(B1, 1, 1); PG8_SCHED; PG8_LDA(At, 1, 0); PG8_STAGE(PG8_SA(0, 1), a2 + hstepA, voffA);
            PG8_WAIT_V(8); PG8_WAIT_L(0); PG8_BAR; PG8_MMA(0, 0, At, B0); PG8_MMA(0, 1, At, B1); PG8_BAR; PG8_SCHED;
            PG8_LDA(At, 1, 1); PG8_STAGE(PG8_SB(1, 0), b3, voffB); PG8_STAGE(PG8_SB(1, 1), b3 + hstepB, voffB); PG8_STAGE(PG8_SA(1, 0), a3, voffA);
            PG8_WAIT_V(8); PG8_WAIT_L(0); PG8_BAR; PG8_MMA(1, 0, At, B0); PG8_MMA(1, 1, At, B1); PG8_BAR; PG8_SCHED;
        }
        if constexpr (ALIGN_EPI) { if (wr == 0) PG8_BAR; }
        E(acc, cur, wr, wc, fr, fq);
        if (!has_next) break;
#pragma unroll
        for (int a = 0; a < 2; ++a)
#pragma unroll
            for (int b = 0; b < 2; ++b)
#pragma unroll
                for (int m = 0; m < 4; ++m)
#pragma unroll
                    for (int n = 0; n < 2; ++n) acc[a][b][m][n] = (f32x4){0.f, 0.f, 0.f, 0.f};
        cur = nxt; cA = nA; cB = nB; ++ui;
        if constexpr (ALIGN_EPI) { if (wr == 1) PG8_BAR; }
    }
    PG8_WAIT_V(0);
    if constexpr (!ALIGN_EPI) { if (wr == 0) PG8_BAR; }
    PG8_BAR;
#undef PG8_AOFF
#undef PG8_SA
#undef PG8_SB
#undef PG8_STAGE
#undef PG8_LDA
#undef PG8_LDB
#undef PG8_MMA
#undef PG8_WAIT_V
#undef PG8_WAIT_L
#undef PG8_BAR
#undef PG8_SCHED
}
}

constexpr int NWAVES = 8, NTHR = 512;
constexpr int LDS_BYTES = 163840;
struct Args {
    const float* in[27]; float* out; unsigned char* ws; int ph_lo, ph_hi;
};
struct Frame {
    LAS unsigned char* lds; int tid, lane, wave, vcu, G;
};
constexpr int PTRS_OFF = LDS_BYTES - 256;
__device__ __forceinline__ const float* inp(LAS unsigned char* lds, int i) { return *(const float* LAS*)(lds + PTRS_OFF + i * 8); }
__device__ __forceinline__ int seq_row0(int q) { return q == 0 ? 0 : SP + (q - 1) * SS; }
__device__ __forceinline__ int seq_len(int q) { return q == 0 ? SP : SS; }

__device__ __forceinline__ void p0_transpose_item(const float* W, int K, int N, bf16_t* WT, const float* kscale, LAS float* scr, int item, int lane) {
    const int nblk = N / 32, kb = item / nblk, nb = item % nblk, k0 = 64 * kb, n0 = 32 * nb;
#pragma unroll 8
    for (int i = 0; i < 32; ++i) { const int kk = 2 * i + (lane >> 5); float v = W[(size_t)(k0 + kk) * N + n0 + (lane & 31)]; if (kscale) v *= kscale[k0 + kk]; scr[kk * 33 + (lane & 31)] = v; }
    LDS_WAIT(); asm volatile("" ::: "memory");
    const int c = lane & 7;
#pragma unroll
    for (int j = 0; j < 4; ++j) { const int n = (lane >> 3) + 8 * j; const LAS float* s = scr + (8 * c) * 33 + n;
        u32x4 o; o.x = cvt_pk_bf16(s[0 * 33], s[1 * 33]); o.y = cvt_pk_bf16(s[2 * 33], s[3 * 33]); o.z = cvt_pk_bf16(s[4 * 33], s[5 * 33]); o.w = cvt_pk_bf16(s[6 * 33], s[7 * 33]);
        *(u32x4*)(WT + (size_t)(n0 + n) * K + k0 + 8 * c) = o; }
    LDS_WAIT(); asm volatile("" ::: "memory");
}
__device__ __forceinline__ void p0_prologue(const Frame& F, const Args& a) {
    LAS float* scr = (LAS float*)(F.lds + F.wave * 16384);
    const int gw = F.vcu * NWAVES + F.wave, NGW = F.G * NWAVES;
    unsigned char* ws = a.ws;
    constexpr int I_IN = (DM / 64) * (ZP / 32), I_O = (DM / 64) * (DM / 32), I_1 = (DM / 64) * (DFF / 32), I_2 = (DFF / 64) * (DM / 32);
    for (int it = gw; it < I_IN + I_O + I_1 + I_2; it += NGW) {
        int r = it;
        if (r < I_IN) { p0_transpose_item(a.in[3], DM, ZP, (bf16_t*)(ws + WS_WIN), nullptr, scr, r, F.lane); continue; } r -= I_IN;
        if (r < I_O) { p0_transpose_item(a.in[23], DM, DM, (bf16_t*)(ws + WS_WOUT), nullptr, scr, r, F.lane); continue; } r -= I_O;
        if (r < I_1) { p0_transpose_item(a.in[25], DM, DFF, (bf16_t*)(ws + WS_W1), a.in[24], scr, r, F.lane); continue; } r -= I_1;
        p0_transpose_item(a.in[26], DFF, DM, (bf16_t*)(ws + WS_W2), nullptr, scr, r, F.lane);
    }
    bf16_t* XN = (bf16_t*)a.out; const float* g1 = a.in[2];
    for (int m = gw; m < MTOK; m += NGW) {
        const float* xrow = m < SP ? a.in[0] + (size_t)m * DM : a.in[1] + (size_t)(m - SP) * DM;
        const f32x4* xr = (const f32x4*)xrow + F.lane; f32x4 v[4]; float s = 0.f;
#pragma unroll
        for (int j = 0; j < 4; ++j) { v[j] = xr[64 * j]; s += (v[j][0] * v[j][0] + v[j][1] * v[j][1]) + (v[j][2] * v[j][2] + v[j][3] * v[j][3]); }
        const float rstd = 1.0f / sqrtf(wave_sum(s) * (1.f / DM) + NORM_EPS);
        u32x2* o8 = (u32x2*)(XN + (size_t)m * DM) + F.lane;
#pragma unroll
        for (int j = 0; j < 4; ++j) { const f32x4 gv = ((const f32x4*)g1)[F.lane + 64 * j]; u32x2 w; w.x = cvt_pk_bf16(v[j][0] * rstd * gv[0], v[j][1] * rstd * gv[1]); w.y = cvt_pk_bf16(v[j][2] * rstd * gv[2], v[j][3] * rstd * gv[3]); o8[64 * j] = w; }
    }
    const int gt = F.vcu * NTHR + F.tid, NGT = F.G * NTHR;
    float* rope = (float*)(ws + WS_ROPE);
    for (int e = gt; e < SP * 32; e += NGT) { const int pos = e >> 5, i = e & 31;
        const float invf = 1.0f / powf(10000.0f, (float)(2 * i) / 64.0f); const float ang = (float)pos * invf; float sn, cs; sincosf(ang, &sn, &cs);
        rope[2 * e] = cs; rope[2 * e + 1] = sn; }
    bf16_t* wupT = (bf16_t*)(ws + WS_LORA); bf16_t* aupT = wupT + 2 * 512 * 64; bf16_t* gupT = aupT + 2 * 512 * 64;
    for (int e = gt; e < 2 * 512 * 64; e += NGT) { const int d = e >> 15, c = (e >> 6) & 511, r = e & 63;
        wupT[e] = f2bf(a.in[14][((size_t)d * 64 + r) * 512 + c]); aupT[e] = f2bf(a.in[16][((size_t)d * 64 + r) * 512 + c]); }
    for (int e = gt; e < 512 * 128; e += NGT) { const int c = e >> 7, r = e & 127; gupT[e] = f2bf(a.in[17][(size_t)r * 512 + c]); }
}

__device__ __forceinline__ void qk_prep(const Frame& F, const Args& a) {
    const int gw = F.vcu * NWAVES + F.wave, NGW = F.G * NWAVES;
    bf16_t* Z = (bf16_t*)(a.ws + WS_Z); const float* rope = (const float*)(a.ws + WS_ROPE);
    const int g = F.lane >> 2, qd = F.lane & 3;
    const float* gain = (g < 8) ? a.in[4] : a.in[5];
    float glo[8], ghi[8];
#pragma unroll
    for (int j = 0; j < 8; ++j) { glo[j] = gain[8 * qd + j]; ghi[j] = gain[32 + 8 * qd + j]; }
    const float osc = (g < 8) ? QSCALE : 1.0f;
    for (int m = gw; m < MTOK; m += NGW) {
        const int pos = m < SP ? m : ((m - SP) & (SS - 1));
        bf16_t* p = Z + (size_t)m * ZP + g * 64 + 8 * qd;
        const u32x4 lo4 = *(const u32x4*)p, hi4 = *(const u32x4*)(p + 32);
        float lo[8], hi[8];
#pragma unroll
        for (int j = 0; j < 4; ++j) { lo[2 * j] = bflo(lo4[j]); lo[2 * j + 1] = bfhi(lo4[j]); hi[2 * j] = bflo(hi4[j]); hi[2 * j + 1] = bfhi(hi4[j]); }
        float ss = 0.f;
#pragma unroll
        for (int j = 0; j < 8; ++j) ss += lo[j] * lo[j] + hi[j] * hi[j];
        ss += __shfl_xor(ss, 1); ss += __shfl_xor(ss, 2);
        const float rstd = 1.0f / sqrtf(ss * (1.f / 64.f) + NORM_EPS);
        const f32x4* rp = (const f32x4*)(rope + ((size_t)pos * 32 + 8 * qd) * 2);
        float ol[8], oh[8];
#pragma unroll
        for (int j2 = 0; j2 < 4; ++j2) { const f32x4 cs = rp[j2];
#pragma unroll
            for (int e = 0; e < 2; ++e) { const int j = 2 * j2 + e; const float c = cs[2 * e], s = cs[2 * e + 1]; const float l = lo[j] * rstd * glo[j], h = hi[j] * rstd * ghi[j];
                ol[j] = (l * c - h * s) * osc; oh[j] = (h * c + l * s) * osc; } }
        u32x4 wl, wh;
#pragma unroll
        for (int j = 0; j < 4; ++j) { wl[j] = cvt_pk_bf16(ol[2 * j], ol[2 * j + 1]); wh[j] = cvt_pk_bf16(oh[2 * j], oh[2 * j + 1]); }
        *(u32x4*)p = wl; *(u32x4*)(p + 32) = wh;
    }
}

namespace att {
constexpr int KSLOT = 8192, VSLOT = 16384;
constexpr int L_K = 0, L_V = 2 * KSLOT, L_WS = L_V + 2 * VSLOT, L_ST = L_WS + NWAVES * 256, L_END = L_ST + NWAVES * 8192;
__device__ __forceinline__ int crow(int r, int hi) { return (r & 3) + 8 * (r >> 2) + 4 * hi; }
__device__ __forceinline__ void glds16(const void* gsrc, unsigned lds_dst) { unsigned keep;
    asm volatile("s_mov_b32 %0, m0\n\ts_mov_b32 m0, %2\n\ts_nop 0\n\tglobal_load_lds_dwordx4 %1, off\n\ts_mov_b32 m0, %0" : "=&s"(keep) : "v"(gsrc), "s"(lds_dst) : "memory"); }
typedef short v4i16_t __attribute__((ext_vector_type(4)));
__device__ __forceinline__ s16x4 vtr(const LAS char* p) { return __builtin_bit_cast(s16x4, __builtin_amdgcn_ds_read_tr16_b64_v4i16((LAS v4i16_t*)p)); }
#define ATT_WAIT_BAR() asm volatile("s_waitcnt vmcnt(0) lgkmcnt(0)\n\ts_barrier" ::: "memory")

__device__ __forceinline__ void attn_unit(int row0, int S, int h, int qb, bf16_t* Z, LAS unsigned char* shm, float lam, const float* subln_g) {
    const int tid = threadIdx.x, lane = tid & 63, r32 = lane & 31, hi = lane >> 5; const int wid = __builtin_amdgcn_readfirstlane(tid >> 6);
    const unsigned lds0 = (unsigned)(uintptr_t)shm;
    LAS float* wsf = (LAS float*)(shm + L_WS) + wid * 64;
    LAS bf16_t* stash = (LAS bf16_t*)(shm + L_ST) + wid * 4096;
    const int NT = S / 64;
    const size_t qrow = (size_t)(row0 + qb * 256 + wid * 32);
    const LAS char* kp0 = (const LAS char*)shm + L_K + hi * 1024 + r32 * 16;
    const LAS char* vp0 = (const LAS char*)shm + L_V + ((lane >> 4) & 1) * 32 + (lane & 3) * 8 + (4 * hi + ((lane & 15) >> 2)) * 64;
    f32x16 o[4];
    for (int c = 0; c < 2; ++c) {
        const bf16_t* Qw = Z + qrow * ZP + ZQ + h * 128 + c * 64;
        const bf16_t* Kh = Z + (size_t)row0 * ZP + ZK + h * 128 + c * 64;
        const bf16_t* Vh = Z + (size_t)row0 * ZP + ZV + h * 128;
        const bf16_t* ksrc = Kh + (size_t)lane * ZP + wid * 8;
        const int p0 = 2 * wid, p1 = 2 * wid + 1;
        const bf16_t* vsrc0 = Vh + (size_t)(16 * (p0 & 3) + (lane >> 2)) * ZP + (p0 >> 2) * 32 + (lane & 3) * 8;
        const bf16_t* vsrc1 = Vh + (size_t)(16 * (p1 & 3) + (lane >> 2)) * ZP + (p1 >> 2) * 32 + (lane & 3) * 8;
        bf16x8 qr[4];
#pragma unroll
        for (int d0 = 0; d0 < 4; ++d0) qr[d0] = *(const bf16x8*)(Qw + (size_t)r32 * ZP + d0 * 16 + hi * 8);
#pragma unroll
        for (int d0 = 0; d0 < 4; ++d0) o[d0] = f32x16{};
        float l_reg = 0.f;
#define ATT_DMA(t, sl) do { const size_t ro_ = (size_t)(t) * 64 * ZP; \
        glds16(ksrc + ro_, (unsigned)__builtin_amdgcn_readfirstlane(lds0 + L_K + (sl) * KSLOT + wid * 1024)); \
        glds16(vsrc0 + ro_, (unsigned)__builtin_amdgcn_readfirstlane(lds0 + L_V + (sl) * VSLOT + p0 * 1024)); \
        glds16(vsrc1 + ro_, (unsigned)__builtin_amdgcn_readfirstlane(lds0 + L_V + (sl) * VSLOT + p1 * 1024)); } while (0)
        ATT_DMA(0, 0);
        for (int t = 0; t < NT; ++t) {
            const int sl = t & 1;
            ATT_WAIT_BAR();
            if (t + 1 < NT) ATT_DMA(t + 1, sl ^ 1);
            const LAS char* kb = kp0 + sl * KSLOT;
            f32x16 pa = f32x16{}, pb = f32x16{};
#pragma unroll
            for (int d0 = 0; d0 < 4; ++d0) {
                const bf16x8 b0 = *(const LAS bf16x8*)(kb + d0 * 2048), b1 = *(const LAS bf16x8*)(kb + d0 * 2048 + 512);
                pa = __builtin_amdgcn_mfma_f32_32x32x16_bf16(b0, qr[d0], pa, 0, 0, 0); pb = __builtin_amdgcn_mfma_f32_32x32x16_bf16(b1, qr[d0], pb, 0, 0, 0); }
            float sacc = 0.f;
#pragma unroll
            for (int r = 0; r < 16; ++r) { pa[r] = __builtin_amdgcn_exp2f(pa[r]); pb[r] = __builtin_amdgcn_exp2f(pb[r]); sacc += pa[r] + pb[r]; }
            l_reg += sacc;
            u32x4 pw0, pw1, pw2, pw3;
#pragma unroll
            for (int j = 0; j < 4; ++j) { pw0[j] = cvt_pk_bf16(pa[2 * j], pa[2 * j + 1]); pw1[j] = cvt_pk_bf16(pa[8 + 2 * j], pa[9 + 2 * j]); pw2[j] = cvt_pk_bf16(pb[2 * j], pb[2 * j + 1]); pw3[j] = cvt_pk_bf16(pb[8 + 2 * j], pb[9 + 2 * j]); }
            const LAS char* vb = vp0 + sl * VSLOT;
#pragma unroll
            for (int d0 = 0; d0 < 4; ++d0) {
                s16x4 lo[4], hh[4];
#pragma unroll
                for (int ks = 0; ks < 4; ++ks) { lo[ks] = vtr(vb + d0 * 4096 + ks * 1024); hh[ks] = vtr(vb + d0 * 4096 + ks * 1024 + 512); }
#define ATT_PK(k) (bf16x8){lo[k][0], lo[k][1], lo[k][2], lo[k][3], hh[k][0], hh[k][1], hh[k][2], hh[k][3]}
                o[d0] = __builtin_amdgcn_mfma_f32_32x32x16_bf16(__builtin_bit_cast(bf16x8, pw0), ATT_PK(0), o[d0], 0, 0, 0);
                o[d0] = __builtin_amdgcn_mfma_f32_32x32x16_bf16(__builtin_bit_cast(bf16x8, pw1), ATT_PK(1), o[d0], 0, 0, 0);
                o[d0] = __builtin_amdgcn_mfma_f32_32x32x16_bf16(__builtin_bit_cast(bf16x8, pw2), ATT_PK(2), o[d0], 0, 0, 0);
                o[d0] = __builtin_amdgcn_mfma_f32_32x32x16_bf16(__builtin_bit_cast(bf16x8, pw3), ATT_PK(3), o[d0], 0, 0, 0);
#undef ATT_PK
            }
        }
#undef ATT_DMA
        { auto rr = __builtin_amdgcn_permlane32_swap(__float_as_uint(l_reg), __float_as_uint(l_reg), false, false); l_reg = __uint_as_float(rr[0]) + __uint_as_float(rr[1]); }
        if (hi == 0) wsf[r32] = l_reg;
        LDS_WAIT();
        float rli[16];
#pragma unroll
        for (int r = 0; r < 16; ++r) rli[r] = 1.0f / wsf[crow(r, hi)];
        if (c == 0) {
#pragma unroll
            for (int d0 = 0; d0 < 4; ++d0)
#pragma unroll
                for (int r = 0; r < 16; ++r) stash[(d0 * 16 + r) * 64 + lane] = f2bf(o[d0][r] * rli[r]);
            LDS_WAIT();
        } else {
#pragma unroll
            for (int d0 = 0; d0 < 4; ++d0)
#pragma unroll
                for (int r = 0; r < 16; ++r) o[d0][r] = bf2f(stash[(d0 * 16 + r) * 64 + lane]) - lam * (o[d0][r] * rli[r]);
            LDS_WAIT(); asm volatile("" ::: "memory");
#pragma unroll
            for (int d0 = 0; d0 < 4; ++d0)
#pragma unroll
                for (int r = 0; r < 16; ++r) stash[crow(r, hi) * 128 + d0 * 32 + r32] = f2bf(o[d0][r]);
            LDS_WAIT(); asm volatile("" ::: "memory");
            bf16_t* Ow = Z + qrow * ZP + ZQ + h * 128;
#pragma unroll
            for (int i = 0; i < 4; ++i) { const int row = i * 8 + (lane >> 3), ch = lane & 7;
                const u32x4 w0 = *(const LAS u32x4*)(stash + row * 128 + ch * 16), w1 = *(const LAS u32x4*)(stash + row * 128 + ch * 16 + 8);
                float v[16];
#pragma unroll
                for (int j = 0; j < 4; ++j) { v[2 * j] = bflo(w0[j]); v[2 * j + 1] = bfhi(w0[j]); v[8 + 2 * j] = bflo(w1[j]); v[9 + 2 * j] = bfhi(w1[j]); }
                float ss = 0.f;
#pragma unroll
                for (int j = 0; j < 16; ++j) ss += v[j] * v[j];
                ss += __shfl_xor(ss, 1); ss += __shfl_xor(ss, 2); ss += __shfl_xor(ss, 4);
                const float rs = (1.0f - LAMBDA_INIT) / sqrtf(ss * (1.f / 128.f) + NORM_EPS);
                u32x4 x0, x1;
#pragma unroll
                for (int j = 0; j < 4; ++j) { x0[j] = cvt_pk_bf16(v[2 * j] * rs * subln_g[ch * 16 + 2 * j], v[2 * j + 1] * rs * subln_g[ch * 16 + 2 * j + 1]);
                                              x1[j] = cvt_pk_bf16(v[8 + 2 * j] * rs * subln_g[ch * 16 + 8 + 2 * j], v[9 + 2 * j] * rs * subln_g[ch * 16 + 9 + 2 * j]); }
                *(u32x4*)(Ow + (size_t)row * ZP + ch * 16) = x0; *(u32x4*)(Ow + (size_t)row * ZP + ch * 16 + 8) = x1; }
            LDS_WAIT();
        }
    }
    asm volatile("s_waitcnt vmcnt(0) lgkmcnt(0)\n\ts_barrier" ::: "memory");
}
}

namespace rw {
constexpr int P = 144, MAT = 64 * P;
constexpr int O_AT = 0, O_RT = MAT, O_BT = 2 * MAT, O_KT = 3 * MAT, O_ATT = 4 * MAT, O_VT = 5 * MAT, O_BHT = 6 * MAT, O_KHT = 7 * MAT;
constexpr int O_LAB = 8 * MAT, O_LAK = 9 * MAT, O_ARB = 10 * MAT, O_ARK = 11 * MAT, O_XT = 12 * MAT, O_ABT = 13 * MAT, O_U0T = 14 * MAT;
constexpr int O_LABD = 15 * MAT, O_TII = O_LABD + 4096, O_WC = O_TII + 2048, O_GSUM = O_WC + 256, O_END = O_GSUM + 2048;
constexpr int O_ZS = 0;
constexpr int O_TW = O_LAB, O_ADN = O_LAK, O_WL = O_ARB, O_AR = O_XT, PF = 272;
static_assert(O_END <= LDS_BYTES && 64 * PF <= 2 * MAT, "rwkv lds");
__device__ __forceinline__ int crow(int r, int hi) { return (r & 3) + 8 * (r >> 2) + 4 * hi; }
__device__ __forceinline__ float sigmoidf_(float x) { return 1.0f / (1.0f + __expf(-x)); }
__device__ __forceinline__ void load10(const bf16_t* zc, int t_lo, int S, float (&z)[10]) {
#pragma unroll
    for (int i = 0; i < 10; ++i) { const int t = t_lo - 1 + i; z[i] = (t >= 0 && t < S) ? bf2f(zc[(size_t)t * ZP]) : 0.f; }
}
__device__ __forceinline__ float tshift(const float (&z)[10], int u, float mp, float mn) { const float c = z[u + 1]; return c + mp * (z[u] - c) + mn * (z[u + 2] - c); }
__device__ __forceinline__ f32x16 mm_ll(const LAS unsigned char* A, int rowA, const LAS unsigned char* B, int rowB, f32x16 acc, int r32, int hi) {
#pragma unroll
    for (int ks = 0; ks < 4; ++ks) { const bf16x8 a = *(const LAS bf16x8*)(A + (rowA + r32) * P + (16 * ks + 8 * hi) * 2), b = *(const LAS bf16x8*)(B + (rowB + r32) * P + (16 * ks + 8 * hi) * 2);
        acc = __builtin_amdgcn_mfma_f32_32x32x16_bf16(a, b, acc, 0, 0, 0); }
    return acc;
}
__device__ __forceinline__ void store_native(unsigned char* dst, const f32x16& acc, int lane) {
    u32x4 w0, w1;
#pragma unroll
    for (int q = 0; q < 4; ++q) { w0[q] = cvt_pk_bf16(acc[2 * q], acc[2 * q + 1]); w1[q] = cvt_pk_bf16(acc[8 + 2 * q], acc[9 + 2 * q]); }
    *(u32x4*)(dst + lane * 32) = w0; *(u32x4*)(dst + lane * 32 + 16) = w1;
}
__device__ __forceinline__ void st4(LAS unsigned char* p, float a, float b, float c, float d) { u32x2 w; w.x = cvt_pk_bf16(a, b); w.y = cvt_pk_bf16(c, d); *(LAS u32x2*)p = w; }

__device__ __forceinline__ void s1_item(const Frame& F, const Args& a, int d, int q, int h, int ck, unsigned char* slot) {
    LAS unsigned char* L = F.lds;
    int lane_ = F.lane; asm volatile("" : "+v"(lane_));
    const int lane = lane_, w = F.wave, tid = w * 64 + lane, r32 = lane & 31, hi = lane >> 5;
    const int j = lane, tg = w;
    const int row0 = seq_row0(q), S = seq_len(q), t0 = ck * 64;
    const bf16_t* Zs = (const bf16_t*)(a.ws + WS_Z) + (size_t)row0 * ZP;
    const int t_lo = d == 0 ? t0 + 8 * tg : t0 + 56 - 8 * tg;
    const int tau0 = 8 * tg;
#define TAU(u) (d == 0 ? tau0 + (u) : tau0 + 7 - (u))
    const float* mup = inp(L, 11); const float* mun = inp(L, 12);
    const int ch = h * 64 + j;
    {
#pragma unroll 1
        for (int c = tid; c < 66 * 5 * 8; c += NTHR) { const int seg = c >> 3, part = c & 7, row = seg / 5, grp = seg - row * 5, t = t0 - 1 + row;
            const int colb = grp < 3 ? ZRR + grp * 512 + h * 64 : (grp == 3 ? ZWD : ZAD);
            u32x4 v = {0u, 0u, 0u, 0u}; if (t >= 0 && t < S) v = *(const u32x4*)(Zs + (size_t)t * ZP + colb + part * 8);
            *(LAS u32x4*)(L + O_ZS + (grp * 66 + row) * P + part * 16) = v; }
    }
    __syncthreads();
    const LAS unsigned char* zsb = L + O_ZS + (t_lo - t0) * P + j * 2;
#define LD10(z, g) do { _Pragma("unroll") for (int i_ = 0; i_ < 10; ++i_) z[i_] = bf2f(*(const LAS bf16_t*)(zsb + ((g) * 66 + i_) * P)); } while (0)
    {
        float zw[10], za[10]; LD10(zw, 3); LD10(za, 4);
        const float mpw = mup[ZWD - ZRR + j], mnw = mun[ZWD - ZRR + j], mpa = mup[ZAD - ZRR + j], mna = mun[ZAD - ZRR + j];
#pragma unroll
        for (int u = 0; u < 8; ++u) { const int tau = TAU(u);
            *(LAS bf16_t*)(L + O_TW + tau * P + j * 2) = f2bf(tanhf(tshift(zw, u, mpw, mnw)));
            *(LAS bf16_t*)(L + O_ADN + tau * P + j * 2) = f2bf(tshift(za, u, mpa, mna)); }
    }
    __syncthreads();
    {
        const int which = w >> 2, mt = (w >> 1) & 1, nt = w & 1;
        const bf16_t* WT = (const bf16_t*)(a.ws + WS_LORA) + (which ? 2 * 512 * 64 : 0) + ((size_t)d * 512 + h * 64 + 32 * mt + r32) * 64;
        const LAS unsigned char* B = L + (which ? O_ADN : O_TW);
        f32x16 acc = f32x16{};
#pragma unroll
        for (int ks = 0; ks < 4; ++ks) { const bf16x8 av = *(const bf16x8*)(WT + 16 * ks + 8 * hi), bv = *(const LAS bf16x8*)(B + (32 * nt + r32) * P + (16 * ks + 8 * hi) * 2);
            acc = __builtin_amdgcn_mfma_f32_32x32x16_bf16(av, bv, acc, 0, 0, 0); }
        const float* bias = (which ? inp(L, 15) : inp(L, 13)) + d * 512 + h * 64 + 32 * mt;
        LAS unsigned char* O = L + (which ? O_AR : O_WL) + (32 * nt + r32) * PF;
#pragma unroll
        for (int g = 0; g < 4; ++g) { const int jj = 8 * g + 4 * hi; const f32x4 bv = *(const f32x4*)(bias + jj);
            *(LAS f32x4*)(O + (32 * mt + jj) * 4) = (f32x4){acc[4 * g] + bv[0], acc[4 * g + 1] + bv[1], acc[4 * g + 2] + bv[2], acc[4 * g + 3] + bv[3]}; }
    }
    __syncthreads();
    float aa[8], bb[8], rr[8], kd[8], vv[8], ld[8];
    {
        float zr[10], zk[10], zv[10]; LD10(zr, 0); LD10(zk, 1); LD10(zv, 2);
        const float mpr = mup[ch], mnr = mun[ch], mpk = mup[512 + ch], mnk = mun[512 + ch], mpv = mup[1024 + ch], mnv = mun[1024 + ch];
        const float kkc = inp(L, 18)[ch], kac = inp(L, 19)[ch], rkc = inp(L, 20)[ch];
        float* bon = (float*)(a.ws + WS_BONUS) + ((size_t)d * MTOK + row0) * 8 + h;
#pragma unroll
        for (int u = 0; u < 8; ++u) { const int tau = TAU(u);
            const float wl = *(const LAS float*)(L + O_WL + tau * PF + j * 4), ar = *(const LAS float*)(L + O_AR + tau * PF + j * 4);
            ld[u] = -0.6065306597126334f * sigmoidf_(wl); const float arate = sigmoidf_(ar);
            rr[u] = tshift(zr, u, mpr, mnr); const float k0 = tshift(zk, u, mpk, mnk); vv[u] = tshift(zv, u, mpv, mnv);
            const float kkr = k0 * kkc; const float ssq = wave_sum(kkr * kkr); const float kkn = kkr * (1.0f / sqrtf(ssq + 1e-12f));
            kd[u] = k0 * (1.0f + (arate - 1.0f) * kac); aa[u] = -kkn; bb[u] = kkn * arate;
            const float bsum = wave_sum(rr[u] * kd[u] * rkc);
            if (lane == 0) bon[(size_t)(t_lo + u) * 8] = bsum; }
        float tot = 0.f;
#pragma unroll
        for (int u = 0; u < 8; ++u) tot += ld[u];
        *(LAS float*)(L + O_GSUM + tg * 256 + j * 4) = tot;
    }
    __syncthreads();
    {
        float pre = 0.f, cC = 0.f;
#pragma unroll
        for (int g = 0; g < 8; ++g) { const float s = *(const LAS float*)(L + O_GSUM + g * 256 + j * 4); cC += s; if (g < tg) pre += s; }
        float tot = 0.f;
#pragma unroll
        for (int u = 0; u < 8; ++u) tot += ld[u];
        float At[8], Vt[8], Bh[8], Kh[8]; float pf = 0.f;
#pragma unroll
        for (int u = 0; u < 8; ++u) { pf += ld[u]; const int tau = TAU(u);
            const float cl = pre + (d == 0 ? pf : tot - pf + ld[u]);
            const float e_m1 = __expf(cl - ld[u]), e_p = __expf(cl), e_n = __expf(-cl), e_c = __expf(cC - cl);
            At[u] = aa[u] * e_m1; Vt[u] = vv[u]; Bh[u] = bb[u] * e_c; Kh[u] = kd[u] * e_c;
            *(LAS bf16_t*)(L + O_AT + tau * P + j * 2) = f2bf(At[u]); *(LAS bf16_t*)(L + O_RT + tau * P + j * 2) = f2bf(rr[u] * e_p);
            *(LAS bf16_t*)(L + O_BT + tau * P + j * 2) = f2bf(bb[u] * e_n); *(LAS bf16_t*)(L + O_KT + tau * P + j * 2) = f2bf(kd[u] * e_n); }
#define PK8(dst, X) do { u32x4 w_; _Pragma("unroll") for (int k = 0; k < 4; ++k) { const float x0 = d == 0 ? X[2 * k] : X[7 - 2 * k], x1 = d == 0 ? X[2 * k + 1] : X[6 - 2 * k]; w_[k] = cvt_pk_bf16(x0, x1); } \
            *(LAS u32x4*)(L + (dst) + j * P + tau0 * 2) = w_; } while (0)
        PK8(O_ATT, At); PK8(O_VT, Vt); PK8(O_BHT, Bh); PK8(O_KHT, Kh);
#undef PK8
        if (tg == 0) *(LAS float*)(L + O_WC + j * 4) = __expf(cC);
    }
    __syncthreads();
#pragma unroll
    for (int i = 0; i < 2; ++i) {
        const int ti = 2 * w + i, ms = ti >> 2, nl = ti & 3;
        const int sb = 32 * (ms & 1), tb = 32 * (nl & 1);
        f32x16 acc = f32x16{};
        acc = mm_ll(L + (ms < 2 ? O_BT : O_KT), sb, L + (nl < 2 ? O_AT : O_RT), tb, acc, r32, hi);
        const bool incl = nl >= 2; const int dst = ms < 2 ? (nl < 2 ? O_LAB : O_ARB) : (nl < 2 ? O_LAK : O_ARK);
        const int t = tb + r32;
#pragma unroll
        for (int g = 0; g < 4; ++g) { const int s0 = sb + 8 * g + 4 * hi; float v[4];
#pragma unroll
            for (int e = 0; e < 4; ++e) { const int s = s0 + e; v[e] = (incl ? (s <= t) : (s < t)) ? acc[4 * g + e] : 0.f; }
            st4(L + dst + t * P + s0 * 2, v[0], v[1], v[2], v[3]);
            if (dst == O_LAB && (s0 >> 4) == (t >> 4)) *(LAS f32x4*)(L + O_LABD + (((t >> 4) * 16 + (t & 15)) * 16 + (s0 & 15)) * 4) = (f32x4){v[0], v[1], v[2], v[3]}; }
    }
    __syncthreads();
    if (w < 4) {
        const int mt = w >> 1, nt = w & 1; f32x16 acc = f32x16{};
        acc = mm_ll(L + O_LAK, 32 * mt, L + O_VT, 32 * nt, acc, r32, hi);
#pragma unroll
        for (int g = 0; g < 4; ++g) st4(L + O_XT + (32 * nt + r32) * P + (32 * mt + 8 * g + 4 * hi) * 2, acc[4 * g], acc[4 * g + 1], acc[4 * g + 2], acc[4 * g + 3]);
    } else if (w == 7) {
        const int blk = lane >> 4, cc = lane & 15; float x[16];
#pragma unroll
        for (int t = 0; t < 16; ++t) { float s = (t == cc) ? 1.f : 0.f; const LAS float* lr = (const LAS float*)(L + O_LABD + ((blk * 16 + t) * 16) * 4);
#pragma unroll
            for (int k = 0; k < t; ++k) s += lr[k] * x[k];
            x[t] = s; *(LAS bf16_t*)(L + O_TII + ((blk * 16 + t) * 16 + cc) * 2) = f2bf(s); }
    }
    __syncthreads();
    {
        const int c16 = lane & 15, q4 = lane >> 4;
        const LAS unsigned char* RT = L + (w < 4 ? O_ATT : O_XT) + (16 * (w & 3) + c16) * P;
        LAS unsigned char* OT = L + (w < 4 ? O_ABT : O_U0T) + (16 * (w & 3) + c16) * P;
        const LAS unsigned char* LA = L + O_LAB + c16 * P;
#define RHS(i) ({ const u32x2 r_ = *(const LAS u32x2*)(RT + (16 * (i) + 4 * q4) * 2); (f32x4){bflo(r_.x), bfhi(r_.x), bflo(r_.y), bfhi(r_.y)}; })
#define AFR(i, k1, k2) ({ const u32x2 lo_ = *(const LAS u32x2*)(LA + 16 * (i) * P + (16 * (k1) + 4 * q4) * 2); u32x2 hi_ = {0u, 0u}; if ((k2) >= 0) hi_ = *(const LAS u32x2*)(LA + 16 * (i) * P + (16 * ((k2) < 0 ? 0 : (k2)) + 4 * q4) * 2); \
        __builtin_bit_cast(bf16x8, (u32x4){lo_.x, lo_.y, hi_.x, hi_.y}); })
#define TFR(i) ({ const u32x2 lo_ = *(const LAS u32x2*)(L + O_TII + (((i) * 16 + c16) * 16 + 4 * q4) * 2); __builtin_bit_cast(bf16x8, (u32x4){lo_.x, lo_.y, 0u, 0u}); })
#define BFR(U1, U2) __builtin_bit_cast(bf16x8, (u32x4){cvt_pk_bf16(U1[0], U1[1]), cvt_pk_bf16(U1[2], U1[3]), cvt_pk_bf16(U2[0], U2[1]), cvt_pk_bf16(U2[2], U2[3])})
#define MF16(A_, B_, C_) __builtin_amdgcn_mfma_f32_16x16x32_bf16(A_, B_, C_, 0, 0, 0)
        const f32x4 zero4 = {0.f, 0.f, 0.f, 0.f};
        f32x4 U0 = MF16(TFR(0), BFR(RHS(0), zero4), zero4);
        f32x4 Z1 = MF16(AFR(1, 0, -1), BFR(U0, zero4), RHS(1));
        f32x4 U1 = MF16(TFR(1), BFR(Z1, zero4), zero4);
        f32x4 Z2 = MF16(AFR(2, 0, 1), BFR(U0, U1), RHS(2));
        f32x4 U2 = MF16(TFR(2), BFR(Z2, zero4), zero4);
        f32x4 Z3 = MF16(AFR(3, 0, 1), BFR(U0, U1), RHS(3));
        Z3 = MF16(AFR(3, 2, -1), BFR(U2, zero4), Z3);
        f32x4 U3 = MF16(TFR(3), BFR(Z3, zero4), zero4);
        st4(OT + (0 + 4 * q4) * 2, U0[0], U0[1], U0[2], U0[3]); st4(OT + (16 + 4 * q4) * 2, U1[0], U1[1], U1[2], U1[3]);
        st4(OT + (32 + 4 * q4) * 2, U2[0], U2[1], U2[2], U2[3]); st4(OT + (48 + 4 * q4) * 2, U3[0], U3[1], U3[2], U3[3]);
#undef RHS
#undef AFR
#undef TFR
#undef BFR
#undef MF16
    }
    __syncthreads();
    {
        const int mt = (w >> 1) & 1, nt = w & 1;
        if (w < 4) {
            f32x16 acc = f32x16{};
            acc = mm_ll(L + O_ABT, 32 * mt, L + O_BHT, 32 * nt, acc, r32, hi);
            if (mt == nt) { const float wc = *(const LAS float*)(L + O_WC + (32 * nt + r32) * 4);
#pragma unroll
                for (int r = 0; r < 16; ++r) if (crow(r, hi) == r32) acc[r] += wc; }
            store_native(slot + (mt * 2 + nt) * 2048, acc, lane);
            f32x16 rb;
#pragma unroll
            for (int g = 0; g < 4; ++g) { const u32x2 r_ = *(const LAS u32x2*)(L + O_RT + (32 * nt + r32) * P + (32 * mt + 8 * g + 4 * hi) * 2);
                rb[4 * g] = bflo(r_.x); rb[4 * g + 1] = bfhi(r_.x); rb[4 * g + 2] = bflo(r_.y); rb[4 * g + 3] = bfhi(r_.y); }
            rb = mm_ll(L + O_ABT, 32 * mt, L + O_ARB, 32 * nt, rb, r32, hi);
            store_native(slot + 16384 + (mt * 2 + nt) * 2048, rb, lane);
        } else {
            f32x16 acc = f32x16{};
            acc = mm_ll(L + O_BHT, 32 * mt, L + O_U0T, 32 * nt, acc, r32, hi);
            acc = mm_ll(L + O_KHT, 32 * mt, L + O_VT, 32 * nt, acc, r32, hi);
            store_native(slot + 8192 + (mt * 2 + nt) * 2048, acc, lane);
            f32x16 y0 = f32x16{};
            y0 = mm_ll(L + O_ARB, 32 * mt, L + O_U0T, 32 * nt, y0, r32, hi);
            y0 = mm_ll(L + O_ARK, 32 * mt, L + O_VT, 32 * nt, y0, r32, hi);
            store_native(slot + 24576 + (mt * 2 + nt) * 2048, y0, lane);
        }
    }
    __syncthreads();
#undef TAU
#undef LD10
}

__device__ __forceinline__ void s23_chain(const Args& a, int d, int q, int h, int icb, const unsigned char* slots  , int lane) {
    const int r32 = lane & 31, hi = lane >> 5;
    const int row0 = seq_row0(q), NC = seq_len(q) / 64;
    bf16_t* Zy = (bf16_t*)(a.ws + WS_Z) + (size_t)row0 * ZP + (d == 0 ? ZRR : ZRK) + h * 64 + 32 * icb + r32;
    f32x16 X0 = f32x16{}, X1 = f32x16{};
#define UNPK(dst, w0, w1) do { _Pragma("unroll") for (int q_ = 0; q_ < 4; ++q_) { dst[2 * q_] = bflo(w0[q_]); dst[2 * q_ + 1] = bfhi(w0[q_]); dst[8 + 2 * q_] = bflo(w1[q_]); dst[9 + 2 * q_] = bfhi(w1[q_]); } } while (0)
    for (int cc = 0; cc < NC; ++cc) {
        const int ck = d == 0 ? cc : NC - 1 - cc;
        const unsigned char* sl = slots + (size_t)ck * SLOT_BYTES;
        u32x4 mw[4][2], dw[2][2];
#pragma unroll
        for (int t = 0; t < 4; ++t) { mw[t][0] = *(const u32x4*)(sl + t * 2048 + lane * 32); mw[t][1] = *(const u32x4*)(sl + t * 2048 + lane * 32 + 16); }
#pragma unroll
        for (int t = 0; t < 2; ++t) { dw[t][0] = *(const u32x4*)(sl + 8192 + (t * 2 + icb) * 2048 + lane * 32); dw[t][1] = *(const u32x4*)(sl + 8192 + (t * 2 + icb) * 2048 + lane * 32 + 16); }
        bf16x8 xb[2][2];
#pragma unroll
        for (int s = 0; s < 2; ++s) {
            xb[0][s] = __builtin_bit_cast(bf16x8, (u32x4){cvt_pk_bf16(X0[8 * s], X0[8 * s + 1]), cvt_pk_bf16(X0[8 * s + 2], X0[8 * s + 3]), cvt_pk_bf16(X0[8 * s + 4], X0[8 * s + 5]), cvt_pk_bf16(X0[8 * s + 6], X0[8 * s + 7])});
            xb[1][s] = __builtin_bit_cast(bf16x8, (u32x4){cvt_pk_bf16(X1[8 * s], X1[8 * s + 1]), cvt_pk_bf16(X1[8 * s + 2], X1[8 * s + 3]), cvt_pk_bf16(X1[8 * s + 4], X1[8 * s + 5]), cvt_pk_bf16(X1[8 * s + 6], X1[8 * s + 7])}); }
        f32x16 N0, N1;
        UNPK(N0, dw[0][0], dw[0][1]); UNPK(N1, dw[1][0], dw[1][1]);
#pragma unroll
        for (int rb = 0; rb < 2; ++rb)
#pragma unroll
            for (int s = 0; s < 2; ++s) {
                N0 = __builtin_amdgcn_mfma_f32_32x32x16_bf16(__builtin_bit_cast(bf16x8, mw[rb * 2 + 0][s]), xb[rb][s], N0, 0, 0, 0);
                N1 = __builtin_amdgcn_mfma_f32_32x32x16_bf16(__builtin_bit_cast(bf16x8, mw[rb * 2 + 1][s]), xb[rb][s], N1, 0, 0, 0); }
        asm volatile("" ::: "memory");
        u32x4 rw_[4][2], yw[2][2];
#pragma unroll
        for (int t = 0; t < 4; ++t) { rw_[t][0] = *(const u32x4*)(sl + 16384 + t * 2048 + lane * 32); rw_[t][1] = *(const u32x4*)(sl + 16384 + t * 2048 + lane * 32 + 16); }
#pragma unroll
        for (int t = 0; t < 2; ++t) { yw[t][0] = *(const u32x4*)(sl + 24576 + (t * 2 + icb) * 2048 + lane * 32); yw[t][1] = *(const u32x4*)(sl + 24576 + (t * 2 + icb) * 2048 + lane * 32 + 16); }
        f32x16 Y0, Y1;
        UNPK(Y0, yw[0][0], yw[0][1]); UNPK(Y1, yw[1][0], yw[1][1]);
#pragma unroll
        for (int rb = 0; rb < 2; ++rb)
#pragma unroll
            for (int s = 0; s < 2; ++s) {
                Y0 = __builtin_amdgcn_mfma_f32_32x32x16_bf16(__builtin_bit_cast(bf16x8, rw_[rb * 2 + 0][s]), xb[rb][s], Y0, 0, 0, 0);
                Y1 = __builtin_amdgcn_mfma_f32_32x32x16_bf16(__builtin_bit_cast(bf16x8, rw_[rb * 2 + 1][s]), xb[rb][s], Y1, 0, 0, 0); }
        X0 = N0; X1 = N1;
        const long rs = d == 0 ? (long)ZP : -(long)ZP;
        bf16_t* pa = Zy + (size_t)(ck * 64 + (d == 0 ? 4 * hi : 63 - 4 * hi)) * ZP; bf16_t* pb = pa + 32 * rs;
#pragma unroll
        for (int g = 0; g < 4; ++g) {
#pragma unroll
            for (int e = 0; e < 4; ++e) { pa[e * rs] = f2bf(Y0[4 * g + e]); pb[e * rs] = f2bf(Y1[4 * g + e]); }
            pa += 8 * rs; pb += 8 * rs; asm volatile("" : "+v"(pa), "+v"(pb));
        }
    }
#undef UNPK
}

__device__ __forceinline__ void post_item(const Frame& F, const Args& a, int q, int h, int blk) {
    LAS unsigned char* L = F.lds; constexpr int PS = 272, O_SG = 0, O_G = 64 * PS;
    const int lane = F.lane, w = F.wave, r32 = lane & 31, hi = lane >> 5, j = lane, tg = w;
    const int row0 = seq_row0(q), S = seq_len(q), t_lo = blk * 64 + 8 * tg;
    bf16_t* Zs = (bf16_t*)(a.ws + WS_Z) + (size_t)row0 * ZP;
    const float* mup = inp(L, 11); const float* mun = inp(L, 12);
    {
        float z0[10], z1[10]; load10(Zs + ZGD + j, t_lo, S, z0); load10(Zs + ZGD + 64 + j, t_lo, S, z1);
        const float mp0 = mup[ZGD - ZRR + j], mn0 = mun[ZGD - ZRR + j], mp1 = mup[ZGD - ZRR + 64 + j], mn1 = mun[ZGD - ZRR + 64 + j];
#pragma unroll
        for (int u = 0; u < 8; ++u) { *(LAS bf16_t*)(L + O_SG + (8 * tg + u) * PS + j * 2) = f2bf(sigmoidf_(tshift(z0, u, mp0, mn0)));
                                      *(LAS bf16_t*)(L + O_SG + (8 * tg + u) * PS + (64 + j) * 2) = f2bf(sigmoidf_(tshift(z1, u, mp1, mn1))); }
    }
    __syncthreads();
    if (w < 4) {
        const int mt = w >> 1, nt = w & 1;
        const bf16_t* GT = (const bf16_t*)(a.ws + WS_LORA) + 4 * 512 * 64 + ((size_t)h * 64 + 32 * mt + r32) * 128;
        f32x16 acc = f32x16{};
#pragma unroll
        for (int ks = 0; ks < 8; ++ks) { const bf16x8 av = *(const bf16x8*)(GT + 16 * ks + 8 * hi), bv = *(const LAS bf16x8*)(L + O_SG + (32 * nt + r32) * PS + (16 * ks + 8 * hi) * 2);
            acc = __builtin_amdgcn_mfma_f32_32x32x16_bf16(av, bv, acc, 0, 0, 0); }
#pragma unroll
        for (int g = 0; g < 4; ++g) *(LAS f32x4*)(L + O_G + (32 * nt + r32) * PS + (32 * mt + 8 * g + 4 * hi) * 4) = (f32x4){acc[4 * g], acc[4 * g + 1], acc[4 * g + 2], acc[4 * g + 3]};
    }
    __syncthreads();
    {
        const int ch = h * 64 + j;
        float zv[10]; load10(Zs + ZRV + ch, t_lo, S, zv);
        const float mpv = mup[1024 + ch], mnv = mun[1024 + ch], lg = inp(L, 21)[ch], lb = inp(L, 22)[ch];
        const float* bon0 = (const float*)(a.ws + WS_BONUS) + (size_t)row0 * 8 + h; const float* bon1 = bon0 + (size_t)MTOK * 8;
#pragma unroll
        for (int u = 0; u < 8; ++u) { const int t = t_lo + u;
            const float y = bf2f(Zs[(size_t)t * ZP + ZRR + ch]) + bf2f(Zs[(size_t)t * ZP + ZRK + ch]);
            const float mean = wave_sum(y) * (1.f / 64.f); const float dv = y - mean; const float var = wave_sum(dv * dv) * (1.f / 64.f);
            const float yn = dv * (1.0f / sqrtf(var + LNX_EPS)) * lg + lb;
            const float bsum = bon0[(size_t)t * 8] + bon1[(size_t)t * 8];
            const float g = *(const LAS float*)(L + O_G + (8 * tg + u) * PS + j * 4);
            Zs[(size_t)t * ZP + ZRR + ch] = f2bf((yn + bsum * tshift(zv, u, mpv, mnv)) * g); }
    }
    __syncthreads();
}
}

#ifndef ONE_LAUNCH
#define ONE_LAUNCH 1
#endif
constexpr int NPHASE = 10;
constexpr int NOJUMP = 1 << 30;
template <int LO, int HI>
__global__ void __launch_bounds__(NTHR, 2) fwd_kernel(Args a) {
    extern __shared__ __attribute__((aligned(16))) unsigned char lds_raw[];
    Frame F; F.lds = (LAS unsigned char*)lds_raw; F.tid = threadIdx.x; F.lane = F.tid & 63; F.wave = __builtin_amdgcn_readfirstlane(F.tid >> 6);
    F.G = gridDim.x; { const int bx = blockIdx.x; F.vcu = (F.G % 8 == 0) ? (bx % 8) * (F.G / 8) + bx / 8 : bx; }
    unsigned char* ws = a.ws; bf16_t* Z = (bf16_t*)(ws + WS_Z);
    unsigned char* slots = (unsigned char*)a.out;
    if (F.tid == 0) {
#pragma unroll
        for (int i = 0; i < 27; ++i) *(const float* LAS*)(F.lds + PTRS_OFF + i * 8) = a.in[i];
    }
    __syncthreads();
#if ONE_LAUNCH
#define SEAM(k) do { if constexpr ((k) + 1 < HI) { cg::this_grid().sync(); } } while (0)
#define RSYNC() cg::this_grid().sync()
#else
#define SEAM(k) do { } while (0)
#define RSYNC() do { } while (0)
#endif
#define IN(k) (LO <= (k) && (k) < HI)
    if constexpr (IN(0)) { p0_prologue(F, a); SEAM(0); }
    if constexpr (IN(1)) { pg8::Gemm g{(const char*)a.out, (const bf16_t*)(ws + WS_WIN), MTOK, ZP, DM, DM * 2, NOJUMP, 0}; pg8::StaticOrder S; S.init(MTOK, ZP, F.G, (int)blockIdx.x);
        pg8::EpiZ E{Z, ZP}; pg8::gemm_phase<pg8::EpiZ, pg8::StaticOrder, true>(F.lds, g, S, E); SEAM(1); }
    if constexpr (IN(2)) { qk_prep(F, a);
#pragma unroll 1
        for (int rnd = 0; rnd < 2; ++rnd) {
            for (int it = F.vcu; it < 4096; it += F.G) {
                int d, q, h, ck; if (rnd == 0) { ck = it & 255; h = (it >> 8) & 7; d = it >> 11; q = 0; } else { ck = it & 31; h = (it >> 5) & 7; q = 1 + ((it >> 8) & 7); d = it >> 11; }
                rw::s1_item(F, a, d, q, h, ck, slots + (size_t)it * SLOT_BYTES); }
            RSYNC();
            if (F.wave == 0) {
                const int nwork = rnd == 0 ? 32 : 256;
                for (int v = F.vcu; v < nwork; v += F.G) { const int chain = v >> 1, icb = v & 1; int d, q, h, nc;
                    if (rnd == 0) { d = chain >> 3; h = chain & 7; q = 0; nc = 256; } else { h = chain & 7; q = 1 + ((chain >> 3) & 7); d = chain >> 6; nc = 32; }
                    rw::s23_chain(a, d, q, h, icb, slots + (size_t)chain * nc * SLOT_BYTES, F.lane); } }
            if (rnd == 0) RSYNC();
        }
        SEAM(2); }
    if constexpr (IN(3)) { for (int it = F.vcu; it < 4096; it += F.G) { if (it < 2048) rw::post_item(F, a, 0, it >> 8, it & 255); else { const int r = it - 2048; rw::post_item(F, a, 1 + (r >> 8), (r >> 5) & 7, r & 31); } }
        SEAM(3); }
    if constexpr (IN(4)) {
        float lam; { const float p1 = wave_sum(a.in[6][F.lane] * a.in[7][F.lane]), p2 = wave_sum(a.in[8][F.lane] * a.in[9][F.lane]); lam = __expf(p1) - __expf(p2) + LAMBDA_INIT; }
        for (int v = F.vcu; v < 256; v += F.G) {
            att::attn_unit(0, SP, v >> 6, v & 63, Z, F.lds, lam, a.in[10]);
            att::attn_unit(SP + (v >> 5) * SS, SS, (v >> 3) & 3, v & 7, Z, F.lds, lam, a.in[10]); }
        SEAM(4); }
    if constexpr (IN(5)) { pg8::Gemm g{(const char*)Z, (const bf16_t*)(ws + WS_WOUT), MTOK, DM, DM, ZP * 2, 8, 2048}; pg8::StaticOrder S; S.init(MTOK, DM, F.G, (int)blockIdx.x);
        pg8::EpiOut E{a.in[0], a.in[1], a.out, Z, (float*)(ws + WS_ROWSQ)}; pg8::gemm_phase<pg8::EpiOut, pg8::StaticOrder, true>(F.lds, g, S, E); SEAM(5); }
#define FFN_UP(k, half) if constexpr (IN(k)) { pg8::Gemm g{(const char*)(Z + (size_t)(half) * 16384 * ZP + ZXN2), (const bf16_t*)(ws + WS_W1), 16384, DFF, DM, ZP * 2, NOJUMP, 0}; pg8::StaticOrder S; S.init(16384, DFF, F.G, (int)blockIdx.x); \
        pg8::EpiUp E{(char*)(ws + WS_Z), (const float*)(ws + WS_ROWSQ), (half) * 16384}; pg8::gemm_phase<pg8::EpiUp, pg8::StaticOrder, true>(F.lds, g, S, E); SEAM(k); }
#define FFN_DN(k, half) if constexpr (IN(k)) { pg8::Gemm g{(const char*)(ws + WS_Z), (const bf16_t*)(ws + WS_W2), 16384, DM, DFF, 13312, 32, 2560}; pg8::StaticOrder S; S.init(16384, DM, F.G, (int)blockIdx.x); \
        pg8::EpiDown E{a.out, (half) * 16384}; pg8::gemm_phase<pg8::EpiDown, pg8::StaticOrder, true>(F.lds, g, S, E); SEAM(k); }
    FFN_UP(6, 0) FFN_DN(7, 0) FFN_UP(8, 1) FFN_DN(9, 1)
#undef FFN_UP
#undef FFN_DN
#undef IN
#undef SEAM
#undef RSYNC
}

extern "C" void kernel_launch(void* const* d_in, const int* in_sizes, int n_in, void* d_out, int out_size, void* d_ws, size_t ws_size, hipStream_t stream) {
    static int grid = 0;
    if (grid == 0) {
        if (n_in != 27 || out_size != MTOK * DM || ws_size < WS_END) { fprintf(stderr, "kernel_launch: unexpected shapes (n_in %d out %d ws %zu)\n", n_in, out_size, ws_size); grid = -1; return; }
        int dev = 0, cus = 0; (void)hipGetDevice(&dev); (void)hipDeviceGetAttribute(&cus, hipDeviceAttributeMultiprocessorCount, dev);
        bool ok = true;
#if ONE_LAUNCH
        ok = ok && hipFuncSetAttribute((const void*)fwd_kernel<0, NPHASE>, hipFuncAttributeMaxDynamicSharedMemorySize, LDS_BYTES) == hipSuccess;
        int per_cu = 0; (void)hipOccupancyMaxActiveBlocksPerMultiprocessor(&per_cu, (const void*)fwd_kernel<0, NPHASE>, NTHR, LDS_BYTES); (void)hipGetLastError();
        if (per_cu < 1) fprintf(stderr, "kernel_launch: occupancy query says %d blocks/CU\n", per_cu);
#else
#define SETA(p) ok = ok && hipFuncSetAttribute((const void*)fwd_kernel<p, p + 1>, hipFuncAttributeMaxDynamicSharedMemorySize, LDS_BYTES) == hipSuccess;
        SETA(0) SETA(1) SETA(2) SETA(3) SETA(4) SETA(5) SETA(6) SETA(7) SETA(8) SETA(9)
#undef SETA
#endif
        if (!ok) { fprintf(stderr, "kernel_launch: hipFuncSetAttribute failed\n"); grid = -1; return; }
        grid = cus > 256 ? 256 : cus;
    }
    if (grid < 0) return;
    Args a{};
    for (int i = 0; i < 27; ++i) a.in[i] = (const float*)d_in[i];
    a.out = (float*)d_out; a.ws = (unsigned char*)d_ws;
#if ONE_LAUNCH
    a.ph_lo = 0; a.ph_hi = NPHASE;
    void* args[] = {&a};
    hipError_t e = hipLaunchCooperativeKernel((const void*)fwd_kernel<0, NPHASE>, dim3(grid), dim3(NTHR), args, LDS_BYTES, stream);
    if (e != hipSuccess) fprintf(stderr, "cooperative launch failed: %s (grid %d)\n", hipGetErrorString(e), grid);
#else
#define LAUNCH(p) hipLaunchKernelGGL((fwd_kernel<p, p + 1>), dim3(grid), dim3(NTHR), LDS_BYTES, stream, a);
    LAUNCH(0) LAUNCH(1) LAUNCH(2) LAUNCH(3) LAUNCH(4) LAUNCH(5) LAUNCH(6) LAUNCH(7) LAUNCH(8) LAUNCH(9)
#undef LAUNCH
#endif
}
```

```cpp
#include <hip/hip_runtime.h>
#include <hip/hip_cooperative_groups.h>
#include <cstdio>
#include <cstdint>
namespace cg = cooperative_groups;

#define LAS __attribute__((address_space(3)))
typedef unsigned short bf16_t;
typedef short bf16x8 __attribute__((ext_vector_type(8)));
typedef short s16x4 __attribute__((ext_vector_type(4)));
typedef float f32x4 __attribute__((ext_vector_type(4)));
typedef float f32x16 __attribute__((ext_vector_type(16)));
typedef unsigned u32x4 __attribute__((ext_vector_type(4)));
typedef unsigned u32x2 __attribute__((ext_vector_type(2)));
typedef float f32x2_t __attribute__((ext_vector_type(2)));
typedef __bf16 bf16x2_t __attribute__((ext_vector_type(2)));

constexpr int MTOK = 32768, DM = 1024, ZP = 3328, DFF = 4096;
constexpr int SP = 16384, SS = 2048;
constexpr int ZQ = 0, ZK = 512, ZV = 1024, ZRR = 1536, ZRK = 2048, ZRV = 2560, ZWD = 3072, ZAD = 3136, ZGD = 3200;
constexpr int ZXN2 = 2048;
constexpr float NORM_EPS = 1e-6f, LNX_EPS = 64e-5f;
constexpr float QSCALE = 0.125f * 1.4426950408889634f;
constexpr float LAMBDA_INIT = 0.2f;
constexpr int NCHUNK_P = SP / 64, NCHUNK_S = SS / 64;

constexpr size_t MiB = 1u << 20;
constexpr size_t WS_CTL = 0;
constexpr size_t WS_WIN = 1 * MiB, WS_WOUT = 8 * MiB, WS_W1 = 10 * MiB, WS_W2 = 18 * MiB;
constexpr size_t WS_ROPE = 26 * MiB;
constexpr size_t WS_LORA = 30 * MiB;
constexpr size_t WS_ROWSQ = 31 * MiB;
constexpr size_t WS_BONUS = 33 * MiB;
constexpr size_t WS_Z = 36 * MiB;
constexpr size_t WS_END = 244 * MiB;
static_assert(WS_Z + (size_t)MTOK * ZP * 2 <= WS_END, "ws map");
constexpr size_t SLOT_BYTES = 32768;

__device__ __forceinline__ unsigned cvt_pk_bf16(float lo, float hi) { f32x2_t v = {lo, hi}; bf16x2_t b = __builtin_convertvector(v, bf16x2_t); return __builtin_bit_cast(unsigned, b); }
__device__ __forceinline__ float bf2f(unsigned short u) { return __uint_as_float(((unsigned)u) << 16); }
__device__ __forceinline__ float bflo(unsigned u) { return __uint_as_float(u << 16); }
__device__ __forceinline__ float bfhi(unsigned u) { return __uint_as_float(u & 0xffff0000u); }
__device__ __forceinline__ unsigned short f2bf(float f) { return (unsigned short)(cvt_pk_bf16(f, 0.f) & 0xffffu); }
__device__ __forceinline__ float wave_sum(float v) {
#pragma unroll
    for (int o = 1; o < 64; o <<= 1) v += __shfl_xor(v, o);
    return v;
}
#define LDS_WAIT() asm volatile("s_waitcnt lgkmcnt(0)" ::: "memory")
#define VM_WAIT() asm volatile("s_waitcnt vmcnt(0)" ::: "memory")

namespace pg8 {
constexpr int BM = 256, BK = 64, HALF = 128, HTB = HALF * BK * 2, STAGE_BYTES = 8 * HTB, NXCD = 8, WGM = 8;
__host__ __device__ __forceinline__ int lds_byte(int r, int c) { const int st = (r >> 4) * 2 + (c >> 5), rr = r & 15, cc = c & 31, ob = rr * 64 + cc * 2; return st * 1024 + (ob ^ (((ob >> 9) & 1) << 5)); }
__host__ __device__ __forceinline__ void stage_rc(int b, int& R, int& C) { const int st = b / 1024, sb = b % 1024, swz = sb ^ (((sb >> 9) & 1) << 5); R = (st >> 1) * 16 + swz / 64; C = (st & 1) * 32 + (swz % 64) / 2; }
__host__ __device__ __forceinline__ int perm32(int rho) { const int n = rho >> 4, i = rho & 15; return 8 * (i >> 2) + 4 * n + (i & 3); }
struct Unit { int pm, pn; };
struct Gemm { const char* A; const bf16_t* Bt; int M, N, K; int lda; int jkt; int jbytes; };
struct StaticOrder {
    int nM, nN, nwg, G, c;
    __host__ __device__ void init(int M, int N, int G_, int c_) { nM = M / BM; nN = N / BM; nwg = nM * nN; G = G_; c = c_; }
    __host__ __device__ bool next(int i, Unit& u) const {
        const long L = (long)i * G + c; if (L >= nwg) return false;
        int wgid = (int)L; { const int q = nwg / NXCD, r = nwg % NXCD, xcd = wgid % NXCD, off = wgid / NXCD; wgid = (xcd < r ? xcd * (q + 1) : r * (q + 1) + (xcd - r) * q) + off; }
        const int nig = WGM * nN, gid = wgid / nig, fm = gid * WGM, gsz = (nM - fm) < WGM ? (nM - fm) : WGM;
        u.pm = fm + ((wgid % nig) % gsz); u.pn = (wgid % nig) / gsz; return true;
    }
};

struct EpiZ {
    static constexpr bool PERM = true;
    bf16_t* O; int ldc;
    __device__ __forceinline__ void operator()(const f32x4 (&acc)[2][2][4][2], const Unit& u, int wr, int wc, int fr, int fq) const {
        const int row0 = u.pm * BM + wr * 64 + fr, col0 = u.pn * BM + wc * 32 + 8 * fq;
#pragma unroll
        for (int ai = 0; ai < 2; ++ai)
#pragma unroll
            for (int m = 0; m < 4; ++m) { bf16_t* rowp = O + (size_t)(row0 + ai * HALF + m * 16) * ldc + col0;
#pragma unroll
                for (int bj = 0; bj < 2; ++bj) { const f32x4 v0 = acc[ai][bj][m][0], v1 = acc[ai][bj][m][1];
                    u32x4 w; w.x = cvt_pk_bf16(v0[0], v0[1]); w.y = cvt_pk_bf16(v0[2], v0[3]); w.z = cvt_pk_bf16(v1[0], v1[1]); w.w = cvt_pk_bf16(v1[2], v1[3]);
                    *(u32x4*)(rowp + bj * HALF) = w; } }
    }
};
struct EpiOut {
    static constexpr bool PERM = false;
    const float* xp; const float* xs; float* out; bf16_t* Z; float* rowsq;
    __device__ __forceinline__ void operator()(const f32x4 (&acc)[2][2][4][2], const Unit& u, int wr, int wc, int fr, int fq) const {
        const int col0 = u.pn * BM + wc * 32 + 4 * fq;
#pragma unroll
        for (int ai = 0; ai < 2; ++ai)
#pragma unroll
            for (int m = 0; m < 4; ++m) { const int r = u.pm * BM + ai * HALF + wr * 64 + m * 16 + fr;
                const float* xr = (r < SP ? xp + (size_t)r * DM : xs + (size_t)(r - SP) * DM) + col0; float* orow = out + (size_t)r * DM + col0; bf16_t* zr = Z + (size_t)r * ZP + ZXN2 + col0;
                float ss = 0.f;
#pragma unroll
                for (int bj = 0; bj < 2; ++bj)
#pragma unroll
                    for (int n = 0; n < 2; ++n) { const f32x4 xv = *(const f32x4*)(xr + bj * HALF + n * 16); const f32x4 o = xv + acc[ai][bj][m][n];
                        *(f32x4*)(orow + bj * HALF + n * 16) = o; ss += (o[0] * o[0] + o[1] * o[1]) + (o[2] * o[2] + o[3] * o[3]);
                        u32x2 w; w.x = cvt_pk_bf16(o[0], o[1]); w.y = cvt_pk_bf16(o[2], o[3]); *(u32x2*)(zr + bj * HALF + n * 16) = w; }
                ss += __shfl_xor(ss, 16); ss += __shfl_xor(ss, 32);
                if (fq == 0) rowsq[(size_t)r * 16 + u.pn * 4 + wc] = ss;
                if (m & 1) asm volatile("" ::: "memory"); }
    }
};
struct EpiUp {
    static constexpr bool PERM = true;
    char* H; const float* rowsq; int row_off;
    __device__ __forceinline__ void operator()(const f32x4 (&acc)[2][2][4][2], const Unit& u, int wr, int wc, int fr, int fq) const {
        const int row0 = u.pm * BM + wr * 64 + fr, col0 = u.pn * BM + wc * 32 + 8 * fq;
#pragma unroll
        for (int ai = 0; ai < 2; ++ai)
#pragma unroll
            for (int m = 0; m < 4; ++m) { const int r = row0 + ai * HALF + m * 16; const f32x4* rq = (const f32x4*)(rowsq + (size_t)(row_off + r) * 16);
                const f32x4 q0 = rq[0], q1 = rq[1], q2 = rq[2], q3 = rq[3];
                const float ssum = ((q0[0] + q0[1]) + (q0[2] + q0[3])) + ((q1[0] + q1[1]) + (q1[2] + q1[3])) + ((q2[0] + q2[1]) + (q2[2] + q2[3])) + ((q3[0] + q3[1]) + (q3[2] + q3[3]));
                const float rstd = __builtin_amdgcn_rsqf(ssum * (1.0f / DM) + NORM_EPS);
                char* rowp = H + (size_t)r * 13312;
#pragma unroll
                for (int bj = 0; bj < 2; ++bj) { const int c = col0 + bj * HALF; f32x4 v0 = acc[ai][bj][m][0] * rstd, v1 = acc[ai][bj][m][1] * rstd;
#pragma unroll
                    for (int e = 0; e < 4; ++e) { const float a = fmaxf(v0[e], 0.f), b = fmaxf(v1[e], 0.f); v0[e] = a * a; v1[e] = b * b; }
                    u32x4 w; w.x = cvt_pk_bf16(v0[0], v0[1]); w.y = cvt_pk_bf16(v0[2], v0[3]); w.z = cvt_pk_bf16(v1[0], v1[1]); w.w = cvt_pk_bf16(v1[2], v1[3]);
                    *(u32x4*)(rowp + (size_t)c * 2 + (c >= 2048 ? 2560 : 0)) = w; } }
    }
};
struct EpiDown {
    static constexpr bool PERM = false;
    float* out; int row_off;
    __device__ __forceinline__ void operator()(const f32x4 (&acc)[2][2][4][2], const Unit& u, int wr, int wc, int fr, int fq) const {
        const int col0 = u.pn * BM + wc * 32 + 4 * fq;
#pragma unroll
        for (int ai = 0; ai < 2; ++ai)
#pragma unroll
            for (int m = 0; m < 4; ++m) { const int r = row_off + u.pm * BM + ai * HALF + wr * 64 + m * 16 + fr; float* orow = out + (size_t)r * DM + col0;
#pragma unroll
                for (int bj = 0; bj < 2; ++bj)
#pragma unroll
                    for (int n = 0; n < 2; ++n) { const f32x4 xv = *(const f32x4*)(orow + bj * HALF + n * 16); *(f32x4*)(orow + bj * HALF + n * 16) = xv + acc[ai][bj][m][n]; }
                if (m & 1) asm volatile("" ::: "memory"); }
    }
};

template <class Epi, class Sched, bool ALIGN_EPI>
__device__ __forceinline__ void gemm_phase(LAS unsigned char* lds, const Gemm g, const Sched& S, const Epi& E) {
    int tid_ = threadIdx.x; asm volatile("" : "+v"(tid_));
    const int tid = tid_, wid = __builtin_amdgcn_readfirstlane(tid >> 6), lane = tid & 63, wr = wid >> 2, wc = wid & 3, fr = lane & 15, fq = lane >> 4;
    const int K = g.K, nt = K / BK;
    unsigned voffA[2], voffB[2];
#pragma unroll
    for (int i = 0; i < 2; ++i) { int R, C; stage_rc(tid * 16 + i * 8192, R, C); const int Rb = Epi::PERM ? ((R & ~31) + perm32(R & 31)) : R;
        voffA[i] = (unsigned)(R * g.lda + C * 2); voffB[i] = (unsigned)(Rb * K + C) * 2u; }
    const size_t kstep = (size_t)(BK * 2);
    const size_t hstepA = (size_t)HALF * g.lda, tstepA = 2 * hstepA;
    const size_t hstepB = (size_t)HALF * K * 2, tstepB = 2 * hstepB;
    const unsigned ldsw = (unsigned)wid * 1024u;
    const int aoff = lds_byte(wr * 64 + fr, fq * 8), boff = lds_byte(wc * 32 + fr, fq * 8);
#define PG8_AOFF(kt) ((size_t)(kt) * kstep + ((kt) >= g.jkt ? (size_t)g.jbytes : (size_t)0))
#define PG8_SA(b, h) (((b) * 2 + (h)) * HTB)
#define PG8_SB(b, h) ((4 + (b) * 2 + (h)) * HTB)
#define PG8_STAGE(bufoff, gbase, voff) do { _Pragma("unroll") for (int _i = 0; _i < 2; ++_i) \
        __builtin_amdgcn_global_load_lds((const unsigned*)((const char*)(gbase) + (voff)[_i]), (LAS unsigned*)(lds + (bufoff) + ldsw + _i * 8192), 16, 0, 0); } while (0)
#define PG8_LDA(dst, b, h) do { _Pragma("unroll") for (int m = 0; m < 4; ++m) _Pragma("unroll") for (int k = 0; k < 2; ++k) dst[m][k] = *(const LAS bf16x8*)(lds + PG8_SA(b, h) + aoff + m * 2048 + k * 1024); } while (0)
#define PG8_LDB(dst, b, h) do { _Pragma("unroll") for (int n = 0; n < 2; ++n) _Pragma("unroll") for (int k = 0; k < 2; ++k) dst[n][k] = *(const LAS bf16x8*)(lds + PG8_SB(b, h) + boff + n * 2048 + k * 1024); } while (0)
#define PG8_MMA(ai, bj, At, Bt) do { __builtin_amdgcn_s_setprio(1); _Pragma("unroll") for (int m = 0; m < 4; ++m) _Pragma("unroll") for (int n = 0; n < 2; ++n) _Pragma("unroll") for (int k = 0; k < 2; ++k) \
        acc[ai][bj][m][n] = __builtin_amdgcn_mfma_f32_16x16x32_bf16(Bt[n][k], At[m][k], acc[ai][bj][m][n], 0, 0, 0); __builtin_amdgcn_s_setprio(0); } while (0)
#define PG8_WAIT_V(n) asm volatile("s_waitcnt vmcnt(" #n ")" ::: "memory")
#define PG8_WAIT_L(n) asm volatile("s_waitcnt lgkmcnt(" #n ")" ::: "memory")
#define PG8_BAR __builtin_amdgcn_s_barrier()
#define PG8_SCHED __builtin_amdgcn_sched_barrier(0)
    Unit cur, nxt; int ui = 0;
    if (!S.next(0, cur)) return;
    f32x4 acc[2][2][4][2];
#pragma unroll
    for (int a = 0; a < 2; ++a)
#pragma unroll
        for (int b = 0; b < 2; ++b)
#pragma unroll
            for (int m = 0; m < 4; ++m)
#pragma unroll
                for (int n = 0; n < 2; ++n) acc[a][b][m][n] = (f32x4){0.f, 0.f, 0.f, 0.f};
    bf16x8 At[4][2], B0[2][2], B1[2][2];
    const char* cA = g.A + (size_t)cur.pm * tstepA; const char* cB = (const char*)g.Bt + (size_t)cur.pn * tstepB;
    {
        PG8_STAGE(PG8_SB(0, 0), cB, voffB); PG8_STAGE(PG8_SB(0, 1), cB + hstepB, voffB); PG8_STAGE(PG8_SA(0, 0), cA + PG8_AOFF(0), voffA); PG8_STAGE(PG8_SA(0, 1), cA + hstepA + PG8_AOFF(0), voffA);
        if (wr == 1) PG8_BAR;
        PG8_WAIT_V(2); PG8_BAR;
        PG8_STAGE(PG8_SB(1, 0), cB + kstep, voffB); PG8_STAGE(PG8_SA(1, 0), cA + PG8_AOFF(1), voffA); PG8_STAGE(PG8_SB(1, 1), cB + hstepB + kstep, voffB);
        PG8_WAIT_V(6); PG8_BAR;
    }
    for (;;) {
        const bool has_next = S.next(ui + 1, nxt);
        const char* nA = has_next ? g.A + (size_t)nxt.pm * tstepA : cA; const char* nB = has_next ? (const char*)g.Bt + (size_t)nxt.pn * tstepB : cB;
        for (int t = 0; t < nt; t += 2) {
            const bool last = (t == nt - 2);
            const char* a1 = cA + PG8_AOFF(t + 1);
            const char* a2 = last ? nA + PG8_AOFF(0) : cA + PG8_AOFF(t + 2); const char* b2 = last ? nB : cB + (size_t)(t + 2) * kstep;
            const char* a3 = last ? nA + PG8_AOFF(1) : cA + PG8_AOFF(t + 3); const char* b3 = b2 + kstep;
            PG8_LDB(B0, 0, 0); PG8_LDB(B1, 0, 1); PG8_SCHED; PG8_LDA(At, 0, 0); PG8_STAGE(PG8_SA(1, 1), a1 + hstepA, voffA);
            PG8_WAIT_V(8); PG8_WAIT_L(0); PG8_BAR; PG8_MMA(0, 0, At, B0); PG8_MMA(0, 1, At, B1); PG8_BAR; PG8_SCHED;
            PG8_LDA(At, 0, 1); PG8_STAGE(PG8_SB(0, 0), b2, voffB); PG8_STAGE(PG8_SB(0, 1), b2 + hstepB, voffB); PG8_STAGE(PG8_SA(0, 0), a2, voffA);
            PG8_WAIT_V(8); PG8_WAIT_L(0); PG8_BAR; PG8_MMA(1, 0, At, B0); PG8_MMA(1, 1, At, B1); PG8_BAR; PG8_SCHED;
            PG8_LDB(B0, 1, 0); PG8_LDB(B1, 1, 1); PG8_SCHED; PG8_LDA(At, 1, 0); PG8_STAGE(PG8_SA(0, 1), a2 + hstepA, voffA);
            PG8_WAIT_V(8); PG8_WAIT_L(0); PG8_BAR; PG8_MMA(0, 0, At, B0); PG8_MMA(0, 1, At, B1); PG8_BAR; PG8_SCHED;
            PG8_LDA(At, 1, 1); PG8_STAGE(PG8_SB(1, 0), b3, voffB); PG8_STAGE(PG8_SB(1, 1), b3 + hstepB, voffB); PG8_STAGE(PG8_SA(1, 0), a3, voffA);
            PG8_WAIT_V(8); PG8_WAIT_L(0); PG8_BAR; PG8_MMA(1, 0, At, B0); PG8_MMA(1, 1, At, B1); PG8_BAR; PG8_SCHED;
        }
        if constexpr (ALIGN_EPI) { if (wr == 0) PG8_BAR; }
        E(acc, cur, wr, wc, fr, fq);
        if (!has_next) break;
#pragma unroll
        for (int a = 0; a < 2; ++a)
#pragma unroll
            for (int b = 0; b < 2; ++b)
#pragma unroll
                for (int m = 0; m < 4; ++m)
#pragma unroll
                    for (int n = 0; n < 2; ++n) acc[a][b][m][n] = (f32x4){0.f, 0.f, 0.f, 0.f};
        cur = nxt; cA = nA; cB = nB; ++ui;
        if constexpr (ALIGN_EPI) { if (wr == 1) PG8_BAR; }
    }
    PG8_WAIT_V(0);
    if constexpr (!ALIGN_EPI) { if (wr == 0) PG8_BAR; }
    PG8_BAR;
#undef PG8_AOFF
#undef PG8_SA
#undef PG8_SB
#undef PG8_STAGE
#undef PG8_LDA
#undef PG8_LDB
#undef PG8_MMA
#undef PG8_WAIT_V
#undef PG8_WAIT_L
#undef PG8_BAR
#undef PG8_SCHED
}
}

constexpr int NWAVES = 8, NTHR = 512;
constexpr int LDS_BYTES = 163840;
struct Args {
    const float* in[27]; float* out; unsigned char* ws; int ph_lo, ph_hi;
};
struct Frame {
    LAS unsigned char* lds; int tid, lane, wave, vcu, G;
};
constexpr int PTRS_OFF = LDS_BYTES - 256;
__device__ __forceinline__ const float* inp(LAS unsigned char* lds, int i) { return *(const float* LAS*)(lds + PTRS_OFF + i * 8); }
__device__ __forceinline__ int seq_row0(int q) { return q == 0 ? 0 : SP + (q - 1) * SS; }
__device__ __forceinline__ int seq_len(int q) { return q == 0 ? SP : SS; }

__device__ __forceinline__ void p0_transpose_item(const float* W, int K, int N, bf16_t* WT, const float* kscale, LAS float* scr, int item, int lane) {
    const int nblk = N / 32, kb = item / nblk, nb = item % nblk, k0 = 64 * kb, n0 = 32 * nb;
#pragma unroll 8
    for (int i = 0; i < 32; ++i) { const int kk = 2 * i + (lane >> 5); float v = W[(size_t)(k0 + kk) * N + n0 + (lane & 31)]; if (kscale) v *= kscale[k0 + kk]; scr[kk * 33 + (lane & 31)] = v; }
    LDS_WAIT(); asm volatile("" ::: "memory");
    const int c = lane & 7;
#pragma unroll
    for (int j = 0; j < 4; ++j) { const int n = (lane >> 3) + 8 * j; const LAS float* s = scr + (8 * c) * 33 + n;
        u32x4 o; o.x = cvt_pk_bf16(s[0 * 33], s[1 * 33]); o.y = cvt_pk_bf16(s[2 * 33], s[3 * 33]); o.z = cvt_pk_bf16(s[4 * 33], s[5 * 33]); o.w = cvt_pk_bf16(s[6 * 33], s[7 * 33]);
        *(u32x4*)(WT + (size_t)(n0 + n) * K + k0 + 8 * c) = o; }
    LDS_WAIT(); asm volatile("" ::: "memory");
}
__device__ __forceinline__ void p0_prologue(const Frame& F, const Args& a) {
    LAS float* scr = (LAS float*)(F.lds + F.wave * 16384);
    const int gw = F.vcu * NWAVES + F.wave, NGW = F.G * NWAVES;
    unsigned char* ws = a.ws;
    constexpr int I_IN = (DM / 64) * (ZP / 32), I_O = (DM / 64) * (DM / 32), I_1 = (DM / 64) * (DFF / 32), I_2 = (DFF / 64) * (DM / 32);
    for (int it = gw; it < I_IN + I_O + I_1 + I_2; it += NGW) {
        int r = it;
        if (r < I_IN) { p0_transpose_item(a.in[3], DM, ZP, (bf16_t*)(ws + WS_WIN), nullptr, scr, r, F.lane); continue; } r -= I_IN;
        if (r < I_O) { p0_transpose_item(a.in[23], DM, DM, (bf16_t*)(ws + WS_WOUT), nullptr, scr, r, F.lane); continue; } r -= I_O;
        if (r < I_1) { p0_transpose_item(a.in[25], DM, DFF, (bf16_t*)(ws + WS_W1), a.in[24], scr, r, F.lane); continue; } r -= I_1;
        p0_transpose_item(a.in[26], DFF, DM, (bf16_t*)(ws + WS_W2), nullptr, scr, r, F.lane);
    }
    bf16_t* XN = (bf16_t*)a.out; const float* g1 = a.in[2];
    for (int m = gw; m < MTOK; m += NGW) {
        const float* xrow = m < SP ? a.in[0] + (size_t)m * DM : a.in[1] + (size_t)(m - SP) * DM;
        const f32x4* xr = (const f32x4*)xrow + F.lane; f32x4 v[4]; float s = 0.f;
#pragma unroll
        for (int j = 0; j < 4; ++j) { v[j] = xr[64 * j]; s += (v[j][0] * v[j][0] + v[j][1] * v[j][1]) + (v[j][2] * v[j][2] + v[j][3] * v[j][3]); }
        const float rstd = 1.0f / sqrtf(wave_sum(s) * (1.f / DM) + NORM_EPS);
        u32x2* o8 = (u32x2*)(XN + (size_t)m * DM) + F.lane;
#pragma unroll
        for (int j = 0; j < 4; ++j) { const f32x4 gv = ((const f32x4*)g1)[F.lane + 64 * j]; u32x2 w; w.x = cvt_pk_bf16(v[j][0] * rstd * gv[0], v[j][1] * rstd * gv[1]); w.y = cvt_pk_bf16(v[j][2] * rstd * gv[2], v[j][3] * rstd * gv[3]); o8[64 * j] = w; }
    }
    const int gt = F.vcu * NTHR + F.tid, NGT = F.G * NTHR;
    float* rope = (float*)(ws + WS_ROPE);
    for (int e = gt; e < SP * 32; e += NGT) { const int pos = e >> 5, i = e & 31;
        const float invf = 1.0f / powf(10000.0f, (float)(2 * i) / 64.0f); const float ang = (float)pos * invf; float sn, cs; sincosf(ang, &sn, &cs);
        rope[2 * e] = cs; rope[2 * e + 1] = sn; }
    bf16_t* wupT = (bf16_t*)(ws + WS_LORA); bf16_t* aupT = wupT + 2 * 512 * 64; bf16_t* gupT = aupT + 2 * 512 * 64;
    for (int e = gt; e < 2 * 512 * 64; e += NGT) { const int d = e >> 15, c = (e >> 6) & 511, r = e & 63;
        wupT[e] = f2bf(a.in[14][((size_t)d * 64 + r) * 512 + c]); aupT[e] = f2bf(a.in[16][((size_t)d * 64 + r) * 512 + c]); }
    for (int e = gt; e < 512 * 128; e += NGT) { const int c = e >> 7, r = e & 127; gupT[e] = f2bf(a.in[17][(size_t)r * 512 + c]); }
}

__device__ __forceinline__ void qk_prep(const Frame& F, const Args& a) {
    const int gw = F.vcu * NWAVES + F.wave, NGW = F.G * NWAVES;
    bf16_t* Z = (bf16_t*)(a.ws + WS_Z); const float* rope = (const float*)(a.ws + WS_ROPE);
    const int g = F.lane >> 2, qd = F.lane & 3;
    const float* gain = (g < 8) ? a.in[4] : a.in[5];
    float glo[8], ghi[8];
#pragma unroll
    for (int j = 0; j < 8; ++j) { glo[j] = gain[8 * qd + j]; ghi[j] = gain[32 + 8 * qd + j]; }
    const float osc = (g < 8) ? QSCALE : 1.0f;
    for (int m = gw; m < MTOK; m += NGW) {
        const int pos = m < SP ? m : ((m - SP) & (SS - 1));
        bf16_t* p = Z + (size_t)m * ZP + g * 64 + 8 * qd;
        const u32x4 lo4 = *(const u32x4*)p, hi4 = *(const u32x4*)(p + 32);
        float lo[8], hi[8];
#pragma unroll
        for (int j = 0; j < 4; ++j) { lo[2 * j] = bflo(lo4[j]); lo[2 * j + 1] = bfhi(lo4[j]); hi[2 * j] = bflo(hi4[j]); hi[2 * j + 1] = bfhi(hi4[j]); }
        float ss = 0.f;
#pragma unroll
        for (int j = 0; j < 8; ++j) ss += lo[j] * lo[j] + hi[j] * hi[j];
        ss += __shfl_xor(ss, 1); ss += __shfl_xor(ss, 2);
        const float rstd = 1.0f / sqrtf(ss * (1.f / 64.f) + NORM_EPS);
        const f32x4* rp = (const f32x4*)(rope + ((size_t)pos * 32 + 8 * qd) * 2);
        float ol[8], oh[8];
#pragma unroll
        for (int j2 = 0; j2 < 4; ++j2) { const f32x4 cs = rp[j2];
#pragma unroll
            for (int e = 0; e < 2; ++e) { const int j = 2 * j2 + e; const float c = cs[2 * e], s = cs[2 * e + 1]; const float l = lo[j] * rstd * glo[j], h = hi[j] * rstd * ghi[j];
                ol[j] = (l * c - h * s) * osc; oh[j] = (h * c + l * s) * osc; } }
        u32x4 wl, wh;
#pragma unroll
        for (int j = 0; j < 4; ++j) { wl[j] = cvt_pk_bf16(ol[2 * j], ol[2 * j + 1]); wh[j] = cvt_pk_bf16(oh[2 * j], oh[2 * j + 1]); }
        *(u32x4*)p = wl; *(u32x4*)(p + 32) = wh;
    }
}

namespace att {
constexpr int KSLOT = 8192, VSLOT = 16384, NKS = 4, NVS = 3;
constexpr int L_K = 0, L_V = NKS * KSLOT, L_WS = L_V + NVS * VSLOT, L_ST = L_WS + NWAVES * 256, L_END = L_ST + NWAVES * 8192;
static_assert(L_END <= PTRS_OFF, "attention lds");
__device__ __forceinline__ int crow(int r, int hi) { return (r & 3) + 8 * (r >> 2) + 4 * hi; }
__device__ __forceinline__ void glds16(const void* gsrc, unsigned lds_dst) { unsigned keep;
    asm volatile("s_mov_b32 %0, m0\n\ts_mov_b32 m0, %2\n\ts_nop 0\n\tglobal_load_lds_dwordx4 %1, off\n\ts_mov_b32 m0, %0" : "=&s"(keep) : "v"(gsrc), "s"(lds_dst) : "memory"); }
typedef short v4i16_t __attribute__((ext_vector_type(4)));
typedef const LAS char* lds_cptr;
__device__ __forceinline__ s16x4 vtr(lds_cptr p) { return __builtin_bit_cast(s16x4, __builtin_amdgcn_ds_read_tr16_b64_v4i16((LAS v4i16_t*)p)); }
#define SBAR() __builtin_amdgcn_sched_barrier(0)
#define WAIT_BAR(N) asm volatile("s_waitcnt vmcnt(" #N ") lgkmcnt(0)\n\ts_barrier" ::: "memory")
__device__ __forceinline__ void kload8(bf16x8* kf, lds_cptr kp) {
    kf[0] = *(const LAS bf16x8*)(kp);        kf[1] = *(const LAS bf16x8*)(kp + 512);
    kf[2] = *(const LAS bf16x8*)(kp + 2048); kf[3] = *(const LAS bf16x8*)(kp + 2560);
    kf[4] = *(const LAS bf16x8*)(kp + 4096); kf[5] = *(const LAS bf16x8*)(kp + 4608);
    kf[6] = *(const LAS bf16x8*)(kp + 6144); kf[7] = *(const LAS bf16x8*)(kp + 6656);
}
__device__ __forceinline__ void kload2(bf16x8* kf, lds_cptr kp, int j) { kf[2 * j] = *(const LAS bf16x8*)(kp + j * 2048); kf[2 * j + 1] = *(const LAS bf16x8*)(kp + j * 2048 + 512); }

__device__ __forceinline__ void attn_unit(int row0, int S, int h, int qb, bf16_t* Z, LAS unsigned char* shm, float lam, const float* subln_g) {
    int tid_ = threadIdx.x; asm volatile("" : "+v"(tid_));
    const int tid = tid_, lane = tid & 63, r32 = lane & 31, hi = lane >> 5; const int wid = __builtin_amdgcn_readfirstlane(tid >> 6);
    const unsigned lds0 = (unsigned)(uintptr_t)shm;
    LAS float* wsf = (LAS float*)(shm + L_WS) + wid * 64;
    LAS bf16_t* stash = (LAS bf16_t*)(shm + L_ST) + wid * 4096;
    const int NT = S / 64;
    const size_t qrow = (size_t)(row0 + qb * 256 + wid * 32);
    const lds_cptr shm3 = (lds_cptr)shm;
    const lds_cptr kp0 = shm3 + L_K + hi * 1024 + r32 * 16;
    const lds_cptr vp0 = shm3 + L_V + ((lane >> 4) & 1) * 32 + (lane & 3) * 8 + (4 * hi + ((lane & 15) >> 2)) * 64;
    f32x16 o[4];
#pragma unroll 1
    for (int c = 0; c < 2; ++c) {
        const bf16_t* Qw = Z + qrow * ZP + ZQ + h * 128 + c * 64;
        const bf16_t* Kh = Z + (size_t)row0 * ZP + ZK + h * 128 + c * 64;
        const bf16_t* Vh = Z + (size_t)row0 * ZP + ZV + h * 128;
        const int p0 = 2 * wid, p1 = 2 * wid + 1;
        const unsigned koff = (unsigned)(lane * ZP + wid * 8) * 2u;
        const unsigned voff0 = (unsigned)((16 * (p0 & 3) + (lane >> 2)) * ZP + (p0 >> 2) * 32 + (lane & 3) * 8) * 2u;
        const unsigned voff1 = (unsigned)((16 * (p1 & 3) + (lane >> 2)) * ZP + (p1 >> 2) * 32 + (lane & 3) * 8) * 2u;
        const unsigned kdst = lds0 + L_K + wid * 1024, vdst0 = lds0 + L_V + p0 * 1024, vdst1 = lds0 + L_V + p1 * 1024;
#define DMA_K(t, si) glds16((const char*)(Kh + (size_t)(t) * 64 * ZP) + koff, (unsigned)__builtin_amdgcn_readfirstlane(kdst + (si) * KSLOT))
#define DMA_V(t, si) do { const char* vb_ = (const char*)(Vh + (size_t)(t) * 64 * ZP); glds16(vb_ + voff0, (unsigned)__builtin_amdgcn_readfirstlane(vdst0 + (si) * VSLOT)); glds16(vb_ + voff1, (unsigned)__builtin_amdgcn_readfirstlane(vdst1 + (si) * VSLOT)); } while (0)
        DMA_K(0, 0); DMA_V(0, 0); DMA_K(1, 1);
        bf16x8 qr[4];
#pragma unroll
        for (int d0 = 0; d0 < 4; ++d0) qr[d0] = *(const bf16x8*)(Qw + (size_t)r32 * ZP + d0 * 16 + hi * 8);
#pragma unroll
        for (int d0 = 0; d0 < 4; ++d0) o[d0] = f32x16{};
        float l_reg = 0.f;
        bf16x8 kf[4];
        f32x16 pA0, pA1, pB0, pB1;
        int i_prev = 0, i_cur = 0, i_next = 1;
        int k_cur = 0, k_next = 1;
#define ROT() do { i_prev = i_cur; i_cur = i_next; i_next = (i_next == NVS - 1) ? 0 : i_next + 1; k_cur = k_next; k_next = (k_next + 1) & 3; } while (0)
#define KFRAG(slot, i) (*(const LAS bf16x8*)(kp0 + (slot) * KSLOT + ((i) >> 1) * 2048 + ((i) & 1) * 512))
        DMA_K(2, 2);
        WAIT_BAR(4);
        {
            const lds_cptr kb = kp0;
            pA0 = f32x16{}; pA1 = f32x16{};
#pragma unroll
            for (int d0 = 0; d0 < 4; ++d0) { const bf16x8 b0 = *(const LAS bf16x8*)(kb + d0 * 2048), b1 = *(const LAS bf16x8*)(kb + d0 * 2048 + 512);
                pA0 = __builtin_amdgcn_mfma_f32_32x32x16_bf16(b0, qr[d0], pA0, 0, 0, 0); pA1 = __builtin_amdgcn_mfma_f32_32x32x16_bf16(b1, qr[d0], pA1, 0, 0, 0); }
#pragma unroll
            for (int r = 0; r < 16; ++r) { pA0[r] = __builtin_amdgcn_exp2f(pA0[r]); pA1[r] = __builtin_amdgcn_exp2f(pA1[r]); }
        }
        WAIT_BAR(0);
        DMA_K(3, 3); DMA_V(1, 1);
        ROT();
        kf[0] = KFRAG(k_cur, 0); kf[1] = KFRAG(k_cur, 1); kf[2] = KFRAG(k_cur, 2); kf[3] = KFRAG(k_cur, 3);
        WAIT_BAR(3);
        s16x4 vlo[4], vhi[4]; u32x4 pw0, pw1, pw2, pw3;
#define PKW(P, B) cvt_pk_bf16(P[B], P[B + 1])
#define PAF(k) __builtin_bit_cast(bf16x8, pw##k)
#define VFR(i) (bf16x8){vlo[i][0], vlo[i][1], vlo[i][2], vlo[i][3], vhi[i][0], vhi[i][1], vhi[i][2], vhi[i][3]}
#define PIN(x) asm volatile("" : "+v"(x))
#define EX(v) __builtin_amdgcn_exp2f(v)
#define VRD(slot, f) do { vlo[slot] = vtr(vp_ + (((f) & 3) * 4096 + ((f) >> 2) * 1024)); vhi[slot] = vtr(vp_ + (((f) & 3) * 4096 + ((f) >> 2) * 1024 + 512)); } while (0)
#define GAPA(MF, LDX, A0, A1, A2, A3, W0, W1, PW) do { MF; LDX; sacc += A0; sacc += A1; sacc += A2; sacc += A3; PIN(sacc); W0; W1; PIN(PW); SBAR(); } while (0)
#define GAPB(MF, LDX, X, B) do { MF; LDX; X[B] = EX(X[B]); X[B + 1] = EX(X[B + 1]); PIN(X); SBAR(); } while (0)
#define PVM(f) o[(f) & 3] = __builtin_amdgcn_mfma_f32_32x32x16_bf16(__builtin_bit_cast(bf16x8, (f) < 4 ? pw0 : (f) < 8 ? pw1 : (f) < 12 ? pw2 : pw3), VFR((f) & 3), o[(f) & 3], 0, 0, 0)
#define NOP_ do { } while (0)
#define STEP(C0, C1, P0, P1, t, GK, GV, GL) do { SBAR(); \
        const lds_cptr vp_ = vp0 + i_prev * VSLOT; \
        float sacc = (P0[0] + P0[1]); \
        GAPA(C0 = __builtin_amdgcn_mfma_f32_32x32x16_bf16(kf[0], qr[0], (f32x16){}, 0, 0, 0), kf[0] = KFRAG(k_cur, 4), P0[2], P0[3], P0[4], P0[5],     pw0[0] = PKW(P0, 0), pw0[1] = PKW(P0, 2), pw0); \
        GAPA(C1 = __builtin_amdgcn_mfma_f32_32x32x16_bf16(kf[1], qr[0], (f32x16){}, 0, 0, 0), kf[1] = KFRAG(k_cur, 5), P0[6], P0[7], P0[8], P0[9],     pw0[2] = PKW(P0, 4), pw0[3] = PKW(P0, 6), pw0); \
        GAPA(C0 = __builtin_amdgcn_mfma_f32_32x32x16_bf16(kf[2], qr[1], C0, 0, 0, 0),         kf[2] = KFRAG(k_cur, 6), P0[10], P0[11], P0[12], P0[13], pw1[0] = PKW(P0, 8), pw1[1] = PKW(P0, 10), pw1); \
        GAPA(C1 = __builtin_amdgcn_mfma_f32_32x32x16_bf16(kf[3], qr[1], C1, 0, 0, 0),         kf[3] = KFRAG(k_cur, 7), P0[14], P0[15], P1[0], P1[1],   pw1[2] = PKW(P0, 12), pw1[3] = PKW(P0, 14), pw1); \
        GAPA(C0 = __builtin_amdgcn_mfma_f32_32x32x16_bf16(kf[0], qr[2], C0, 0, 0, 0),         VRD(0, 0), P1[2], P1[3], P1[4], P1[5],     pw2[0] = PKW(P1, 0), pw2[1] = PKW(P1, 2), pw2); \
        GAPA(C1 = __builtin_amdgcn_mfma_f32_32x32x16_bf16(kf[1], qr[2], C1, 0, 0, 0),         VRD(1, 1), P1[6], P1[7], P1[8], P1[9],     pw2[2] = PKW(P1, 4), pw2[3] = PKW(P1, 6), pw2); \
        GAPA(C0 = __builtin_amdgcn_mfma_f32_32x32x16_bf16(kf[2], qr[3], C0, 0, 0, 0),         VRD(2, 2), P1[10], P1[11], P1[12], P1[13], pw3[0] = PKW(P1, 8), pw3[1] = PKW(P1, 10), pw3); \
        GAPA(C1 = __builtin_amdgcn_mfma_f32_32x32x16_bf16(kf[3], qr[3], C1, 0, 0, 0),         VRD(3, 3), P1[14], P1[15], 0.f, 0.f,       pw3[2] = PKW(P1, 12), pw3[3] = PKW(P1, 14), pw3); \
        l_reg += sacc; \
        if (GK) { DMA_K((t) + 3, (k_cur + 3) & 3); } if (GV) { DMA_V((t) + 1, i_next); } \
        SBAR(); \
        GAPB(PVM(0), VRD(0, 4), C0, 0);   GAPB(PVM(1), VRD(1, 5), C0, 2);   GAPB(PVM(2), VRD(2, 6), C0, 4);    GAPB(PVM(3), VRD(3, 7), C0, 6); \
        GAPB(PVM(4), VRD(0, 8), C0, 8);   GAPB(PVM(5), VRD(1, 9), C0, 10);  GAPB(PVM(6), VRD(2, 10), C0, 12);  GAPB(PVM(7), VRD(3, 11), C0, 14); \
        GAPB(PVM(8), VRD(0, 12), C1, 0);  GAPB(PVM(9), VRD(1, 13), C1, 2);  GAPB(PVM(10), VRD(2, 14), C1, 4);  GAPB(PVM(11), VRD(3, 15), C1, 6); \
        GAPB(PVM(12), if (GL) kf[0] = KFRAG(k_next, 0), C1, 8);  GAPB(PVM(13), if (GL) kf[1] = KFRAG(k_next, 1), C1, 10); \
        GAPB(PVM(14), if (GL) kf[2] = KFRAG(k_next, 2), C1, 12); GAPB(PVM(15), if (GL) kf[3] = KFRAG(k_next, 3), C1, 14); \
        } while (0)
        int t = 1;
#pragma unroll 1
        for (; t + 5 < NT; t += 2) {
            STEP(pB0, pB1, pA0, pA1, t, true, true, true);     WAIT_BAR(3); ROT();
            STEP(pA0, pA1, pB0, pB1, t + 1, true, true, true); WAIT_BAR(3); ROT();
        }
#define ENDW(tt) do { if ((tt) + 3 < NT) { WAIT_BAR(3); } else if ((tt) + 2 < NT) { WAIT_BAR(2); } else { WAIT_BAR(0); } } while (0)
#pragma unroll 1
        for (; t + 1 < NT; t += 2) {
            STEP(pB0, pB1, pA0, pA1, t, (t + 3 < NT), (t + 1 < NT), (t + 1 < NT));         ENDW(t);     ROT();
            STEP(pA0, pA1, pB0, pB1, t + 1, (t + 4 < NT), (t + 2 < NT), (t + 2 < NT));     ENDW(t + 1); ROT();
        }
        STEP(pB0, pB1, pA0, pA1, NT - 1, false, false, false);
        {
            float sacc = pB0[0] + pB0[1];
#pragma unroll
            for (int r = 2; r < 16; ++r) sacc += pB0[r];
#pragma unroll
            for (int r = 0; r < 16; ++r) sacc += pB1[r];
            l_reg += sacc;
            pw0 = (u32x4){PKW(pB0, 0), PKW(pB0, 2), PKW(pB0, 4), PKW(pB0, 6)}; pw1 = (u32x4){PKW(pB0, 8), PKW(pB0, 10), PKW(pB0, 12), PKW(pB0, 14)};
            pw2 = (u32x4){PKW(pB1, 0), PKW(pB1, 2), PKW(pB1, 4), PKW(pB1, 6)}; pw3 = (u32x4){PKW(pB1, 8), PKW(pB1, 10), PKW(pB1, 12), PKW(pB1, 14)};
            const lds_cptr vp_ = vp0 + i_cur * VSLOT;
            VRD(0, 0); VRD(1, 1); VRD(2, 2); VRD(3, 3); PVM(0); PVM(1); PVM(2); PVM(3);
            VRD(0, 4); VRD(1, 5); VRD(2, 6); VRD(3, 7); PVM(4); PVM(5); PVM(6); PVM(7);
            VRD(0, 8); VRD(1, 9); VRD(2, 10); VRD(3, 11); PVM(8); PVM(9); PVM(10); PVM(11);
            VRD(0, 12); VRD(1, 13); VRD(2, 14); VRD(3, 15); PVM(12); PVM(13); PVM(14); PVM(15);
        }
#undef DMA_K
#undef DMA_V
#undef ROT
#undef PKW
#undef PAF
#undef VFR
#undef PIN
#undef EX
#undef VRD
#undef GAPA
#undef GAPB
#undef KFRAG
#undef NOP_
#undef PVM
#undef STEP
#undef ENDW
        { auto rr = __builtin_amdgcn_permlane32_swap(__float_as_uint(l_reg), __float_as_uint(l_reg), false, false); l_reg = __uint_as_float(rr[0]) + __uint_as_float(rr[1]); }
        if (hi == 0) wsf[r32] = l_reg;
        LDS_WAIT();
        float rli[16];
#pragma unroll
        for (int r = 0; r < 16; ++r) rli[r] = 1.0f / wsf[crow(r, hi)];
        if (c == 0) {
#pragma unroll
            for (int d0 = 0; d0 < 4; ++d0)
#pragma unroll
                for (int r = 0; r < 16; ++r) stash[(d0 * 16 + r) * 64 + lane] = f2bf(o[d0][r] * rli[r]);
            LDS_WAIT();
        } else {
#pragma unroll
            for (int d0 = 0; d0 < 4; ++d0)
#pragma unroll
                for (int r = 0; r < 16; ++r) o[d0][r] = bf2f(stash[(d0 * 16 + r) * 64 + lane]) - lam * (o[d0][r] * rli[r]);
            LDS_WAIT(); asm volatile("" ::: "memory");
#pragma unroll
            for (int d0 = 0; d0 < 4; ++d0)
#pragma unroll
                for (int r = 0; r < 16; ++r) stash[crow(r, hi) * 128 + d0 * 32 + r32] = f2bf(o[d0][r]);
            LDS_WAIT(); asm volatile("" ::: "memory");
            bf16_t* Ow = Z + qrow * ZP + ZQ + h * 128;
#pragma unroll
            for (int i = 0; i < 4; ++i) { const int row = i * 8 + (lane >> 3), ch = lane & 7;
                const u32x4 w0 = *(const LAS u32x4*)(stash + row * 128 + ch * 16), w1 = *(const LAS u32x4*)(stash + row * 128 + ch * 16 + 8);
                float v[16];
#pragma unroll
                for (int j = 0; j < 4; ++j) { v[2 * j] = bflo(w0[j]); v[2 * j + 1] = bfhi(w0[j]); v[8 + 2 * j] = bflo(w1[j]); v[9 + 2 * j] = bfhi(w1[j]); }
                float ss = 0.f;
#pragma unroll
                for (int j = 0; j < 16; ++j) ss += v[j] * v[j];
                ss += __shfl_xor(ss, 1); ss += __shfl_xor(ss, 2); ss += __shfl_xor(ss, 4);
                const float rs = (1.0f - LAMBDA_INIT) / sqrtf(ss * (1.f / 128.f) + NORM_EPS);
                u32x4 x0, x1;
#pragma unroll
                for (int j = 0; j < 4; ++j) { x0[j] = cvt_pk_bf16(v[2 * j] * rs * subln_g[ch * 16 + 2 * j], v[2 * j + 1] * rs * subln_g[ch * 16 + 2 * j + 1]);
                                              x1[j] = cvt_pk_bf16(v[8 + 2 * j] * rs * subln_g[ch * 16 + 8 + 2 * j], v[9 + 2 * j] * rs * subln_g[ch * 16 + 9 + 2 * j]); }
                *(u32x4*)(Ow + (size_t)row * ZP + ch * 16) = x0; *(u32x4*)(Ow + (size_t)row * ZP + ch * 16 + 8) = x1; }
            LDS_WAIT();
        }
        asm volatile("s_waitcnt vmcnt(0) lgkmcnt(0)\n\ts_barrier" ::: "memory");
    }
}
#undef SBAR
#undef WAIT_BAR
}

namespace rw {
constexpr int P = 144, MAT = 64 * P;
constexpr int O_AT = 0, O_RT = MAT, O_BT = 2 * MAT, O_KT = 3 * MAT, O_ATT = 4 * MAT, O_VT = 5 * MAT, O_BHT = 6 * MAT, O_KHT = 7 * MAT;
constexpr int O_LAB = 8 * MAT, O_LAK = 9 * MAT, O_ARB = 10 * MAT, O_ARK = 11 * MAT, O_XT = 12 * MAT, O_ABT = 13 * MAT, O_U0T = 14 * MAT;
constexpr int O_LABD = 15 * MAT, O_TII = O_LABD + 4096, O_WC = O_TII + 2048, O_GSUM = O_WC + 256, O_END = O_GSUM + 2048;
constexpr int O_ZS = 0;
constexpr int O_TW = O_LAB, O_ADN = O_LAK, O_WL = O_ARB, O_AR = O_XT, PF = 272;
static_assert(O_END <= LDS_BYTES && 64 * PF <= 2 * MAT, "rwkv lds");
__device__ __forceinline__ int crow(int r, int hi) { return (r & 3) + 8 * (r >> 2) + 4 * hi; }
__device__ __forceinline__ float sigmoidf_(float x) { return 1.0f / (1.0f + __expf(-x)); }
__device__ __forceinline__ void load10(const bf16_t* zc, int t_lo, int S, float (&z)[10]) {
#pragma unroll
    for (int i = 0; i < 10; ++i) { const int t = t_lo - 1 + i; z[i] = (t >= 0 && t < S) ? bf2f(zc[(size_t)t * ZP]) : 0.f; }
}
__device__ __forceinline__ float tshift(const float (&z)[10], int u, float mp, float mn) { const float c = z[u + 1]; return c + mp * (z[u] - c) + mn * (z[u + 2] - c); }
__device__ __forceinline__ f32x16 mm_ll(const LAS unsigned char* A, int rowA, const LAS unsigned char* B, int rowB, f32x16 acc, int r32, int hi) {
#pragma unroll
    for (int ks = 0; ks < 4; ++ks) { const bf16x8 a = *(const LAS bf16x8*)(A + (rowA + r32) * P + (16 * ks + 8 * hi) * 2), b = *(const LAS bf16x8*)(B + (rowB + r32) * P + (16 * ks + 8 * hi) * 2);
        acc = __builtin_amdgcn_mfma_f32_32x32x16_bf16(a, b, acc, 0, 0, 0); }
    return acc;
}
__device__ __forceinline__ void store_native(unsigned char* dst, const f32x16& acc, int lane) {
    u32x4 w0, w1;
#pragma unroll
    for (int q = 0; q < 4; ++q) { w0[q] = cvt_pk_bf16(acc[2 * q], acc[2 * q + 1]); w1[q] = cvt_pk_bf16(acc[8 + 2 * q], acc[9 + 2 * q]); }
    *(u32x4*)(dst + lane * 32) = w0; *(u32x4*)(dst + lane * 32 + 16) = w1;
}
__device__ __forceinline__ void st4(LAS unsigned char* p, float a, float b, float c, float d) { u32x2 w; w.x = cvt_pk_bf16(a, b); w.y = cvt_pk_bf16(c, d); *(LAS u32x2*)p = w; }

__device__ __forceinline__ void s1_item(const Frame& F, const Args& a, int d, int q, int h, int ck, unsigned char* slot) {
    LAS unsigned char* L = F.lds;
    int lane_ = F.lane; asm volatile("" : "+v"(lane_));
    const int lane = lane_, w = F.wave, tid = w * 64 + lane, r32 = lane & 31, hi = lane >> 5;
    const int j = lane, tg = w;
    const int row0 = seq_row0(q), S = seq_len(q), t0 = ck * 64;
    const bf16_t* Zs = (const bf16_t*)(a.ws + WS_Z) + (size_t)row0 * ZP;
    const int t_lo = d == 0 ? t0 + 8 * tg : t0 + 56 - 8 * tg;
    const int tau0 = 8 * tg;
#define TAU(u) (d == 0 ? tau0 + (u) : tau0 + 7 - (u))
    const float* mup = inp(L, 11); const float* mun = inp(L, 12);
    const int ch = h * 64 + j;
    {
#pragma unroll 1
        for (int c = tid; c < 66 * 5 * 8; c += NTHR) { const int seg = c >> 3, part = c & 7, row = seg / 5, grp = seg - row * 5, t = t0 - 1 + row;
            const int colb = grp < 3 ? ZRR + grp * 512 + h * 64 : (grp == 3 ? ZWD : ZAD);
            u32x4 v = {0u, 0u, 0u, 0u}; if (t >= 0 && t < S) v = *(const u32x4*)(Zs + (size_t)t * ZP + colb + part * 8);
            *(LAS u32x4*)(L + O_ZS + (grp * 66 + row) * P + part * 16) = v; }
    }
    __syncthreads();
    const LAS unsigned char* zsb = L + O_ZS + (t_lo - t0) * P + j * 2;
#define LD10(z, g) do { _Pragma("unroll") for (int i_ = 0; i_ < 10; ++i_) z[i_] = bf2f(*(const LAS bf16_t*)(zsb + ((g) * 66 + i_) * P)); } while (0)
    {
        float zw[10], za[10]; LD10(zw, 3); LD10(za, 4);
        const float mpw = mup[ZWD - ZRR + j], mnw = mun[ZWD - ZRR + j], mpa = mup[ZAD - ZRR + j], mna = mun[ZAD - ZRR + j];
#pragma unroll
        for (int u = 0; u < 8; ++u) { const int tau = TAU(u);
            *(LAS bf16_t*)(L + O_TW + tau * P + j * 2) = f2bf(tanhf(tshift(zw, u, mpw, mnw)));
            *(LAS bf16_t*)(L + O_ADN + tau * P + j * 2) = f2bf(tshift(za, u, mpa, mna)); }
    }
    __syncthreads();
    {
        const int which = w >> 2, mt = (w >> 1) & 1, nt = w & 1;
        const bf16_t* WT = (const bf16_t*)(a.ws + WS_LORA) + (which ? 2 * 512 * 64 : 0) + ((size_t)d * 512 + h * 64 + 32 * mt + r32) * 64;
        const LAS unsigned char* B = L + (which ? O_ADN : O_TW);
        f32x16 acc = f32x16{};
#pragma unroll
        for (int ks = 0; ks < 4; ++ks) { const bf16x8 av = *(const bf16x8*)(WT + 16 * ks + 8 * hi), bv = *(const LAS bf16x8*)(B + (32 * nt + r32) * P + (16 * ks + 8 * hi) * 2);
            acc = __builtin_amdgcn_mfma_f32_32x32x16_bf16(av, bv, acc, 0, 0, 0); }
        const float* bias = (which ? inp(L, 15) : inp(L, 13)) + d * 512 + h * 64 + 32 * mt;
        LAS unsigned char* O = L + (which ? O_AR : O_WL) + (32 * nt + r32) * PF;
#pragma unroll
        for (int g = 0; g < 4; ++g) { const int jj = 8 * g + 4 * hi; const f32x4 bv = *(const f32x4*)(bias + jj);
            *(LAS f32x4*)(O + (32 * mt + jj) * 4) = (f32x4){acc[4 * g] + bv[0], acc[4 * g + 1] + bv[1], acc[4 * g + 2] + bv[2], acc[4 * g + 3] + bv[3]}; }
    }
    __syncthreads();
    float aa[8], bb[8], rr[8], kd[8], vv[8], ld[8];
    {
        float zr[10], zk[10], zv[10]; LD10(zr, 0); LD10(zk, 1); LD10(zv, 2);
        const float mpr = mup[ch], mnr = mun[ch], mpk = mup[512 + ch], mnk = mun[512 + ch], mpv = mup[1024 + ch], mnv = mun[1024 + ch];
        const float kkc = inp(L, 18)[ch], kac = inp(L, 19)[ch], rkc = inp(L, 20)[ch];
        float* bon = (float*)(a.ws + WS_BONUS) + ((size_t)d * MTOK + row0) * 8 + h;
#pragma unroll
        for (int u = 0; u < 8; ++u) { const int tau = TAU(u);
            const float wl = *(const LAS float*)(L + O_WL + tau * PF + j * 4), ar = *(const LAS float*)(L + O_AR + tau * PF + j * 4);
            ld[u] = -0.6065306597126334f * sigmoidf_(wl); const float arate = sigmoidf_(ar);
            rr[u] = tshift(zr, u, mpr, mnr); const float k0 = tshift(zk, u, mpk, mnk); vv[u] = tshift(zv, u, mpv, mnv);
            const float kkr = k0 * kkc; const float ssq = wave_sum(kkr * kkr); const float kkn = kkr * (1.0f / sqrtf(ssq + 1e-12f));
            kd[u] = k0 * (1.0f + (arate - 1.0f) * kac); aa[u] = -kkn; bb[u] = kkn * arate;
            const float bsum = wave_sum(rr[u] * kd[u] * rkc);
            if (lane == 0) bon[(size_t)(t_lo + u) * 8] = bsum; }
        float tot = 0.f;
#pragma unroll
        for (int u = 0; u < 8; ++u) tot += ld[u];
        *(LAS float*)(L + O_GSUM + tg * 256 + j * 4) = tot;
    }
    __syncthreads();
    {
        float pre = 0.f, cC = 0.f;
#pragma unroll
        for (int g = 0; g < 8; ++g) { const float s = *(const LAS float*)(L + O_GSUM + g * 256 + j * 4); cC += s; if (g < tg) pre += s; }
        float tot = 0.f;
#pragma unroll
        for (int u = 0; u < 8; ++u) tot += ld[u];
        float At[8], Vt[8], Bh[8], Kh[8]; float pf = 0.f;
#pragma unroll
        for (int u = 0; u < 8; ++u) { pf += ld[u]; const int tau = TAU(u);
            const float cl = pre + (d == 0 ? pf : tot - pf + ld[u]);
            const float e_m1 = __expf(cl - ld[u]), e_p = __expf(cl), e_n = __expf(-cl), e_c = __expf(cC - cl);
            At[u] = aa[u] * e_m1; Vt[u] = vv[u]; Bh[u] = bb[u] * e_c; Kh[u] = kd[u] * e_c;
            *(LAS bf16_t*)(L + O_AT + tau * P + j * 2) = f2bf(At[u]); *(LAS bf16_t*)(L + O_RT + tau * P + j * 2) = f2bf(rr[u] * e_p);
            *(LAS bf16_t*)(L + O_BT + tau * P + j * 2) = f2bf(bb[u] * e_n); *(LAS bf16_t*)(L + O_KT + tau * P + j * 2) = f2bf(kd[u] * e_n); }
#define PK8(dst, X) do { u32x4 w_; _Pragma("unroll") for (int k = 0; k < 4; ++k) { const float x0 = d == 0 ? X[2 * k] : X[7 - 2 * k], x1 = d == 0 ? X[2 * k + 1] : X[6 - 2 * k]; w_[k] = cvt_pk_bf16(x0, x1); } \
            *(LAS u32x4*)(L + (dst) + j * P + tau0 * 2) = w_; } while (0)
        PK8(O_ATT, At); PK8(O_VT, Vt); PK8(O_BHT, Bh); PK8(O_KHT, Kh);
#undef PK8
        if (tg == 0) *(LAS float*)(L + O_WC + j * 4) = __expf(cC);
    }
    __syncthreads();
#pragma unroll
    for (int i = 0; i < 2; ++i) {
        const int ti = 2 * w + i, ms = ti >> 2, nl = ti & 3;
        const int sb = 32 * (ms & 1), tb = 32 * (nl & 1);
        f32x16 acc = f32x16{};
        acc = mm_ll(L + (ms < 2 ? O_BT : O_KT), sb, L + (nl < 2 ? O_AT : O_RT), tb, acc, r32, hi);
        const bool incl = nl >= 2; const int dst = ms < 2 ? (nl < 2 ? O_LAB : O_ARB) : (nl < 2 ? O_LAK : O_ARK);
        const int t = tb + r32;
#pragma unroll
        for (int g = 0; g < 4; ++g) { const int s0 = sb + 8 * g + 4 * hi; float v[4];
#pragma unroll
            for (int e = 0; e < 4; ++e) { const int s = s0 + e; v[e] = (incl ? (s <= t) : (s < t)) ? acc[4 * g + e] : 0.f; }
            st4(L + dst + t * P + s0 * 2, v[0], v[1], v[2], v[3]);
            if (dst == O_LAB && (s0 >> 4) == (t >> 4)) *(LAS f32x4*)(L + O_LABD + (((t >> 4) * 16 + (t & 15)) * 16 + (s0 & 15)) * 4) = (f32x4){v[0], v[1], v[2], v[3]}; }
    }
    __syncthreads();
    if (w < 4) {
        const int mt = w >> 1, nt = w & 1; f32x16 acc = f32x16{};
        acc = mm_ll(L + O_LAK, 32 * mt, L + O_VT, 32 * nt, acc, r32, hi);
#pragma unroll
        for (int g = 0; g < 4; ++g) st4(L + O_XT + (32 * nt + r32) * P + (32 * mt + 8 * g + 4 * hi) * 2, acc[4 * g], acc[4 * g + 1], acc[4 * g + 2], acc[4 * g + 3]);
    } else if (w == 7) {
        const int blk = lane >> 4, cc = lane & 15; float x[16];
#pragma unroll
        for (int t = 0; t < 16; ++t) { float s = (t == cc) ? 1.f : 0.f; const LAS float* lr = (const LAS float*)(L + O_LABD + ((blk * 16 + t) * 16) * 4);
#pragma unroll
            for (int k = 0; k < t; ++k) s += lr[k] * x[k];
            x[t] = s; *(LAS bf16_t*)(L + O_TII + ((blk * 16 + t) * 16 + cc) * 2) = f2bf(s); }
    }
    __syncthreads();
    {
        const int c16 = lane & 15, q4 = lane >> 4;
        const LAS unsigned char* RT = L + (w < 4 ? O_ATT : O_XT) + (16 * (w & 3) + c16) * P;
        LAS unsigned char* OT = L + (w < 4 ? O_ABT : O_U0T) + (16 * (w & 3) + c16) * P;
        const LAS unsigned char* LA = L + O_LAB + c16 * P;
#define RHS(i) ({ const u32x2 r_ = *(const LAS u32x2*)(RT + (16 * (i) + 4 * q4) * 2); (f32x4){bflo(r_.x), bfhi(r_.x), bflo(r_.y), bfhi(r_.y)}; })
#define AFR(i, k1, k2) ({ const u32x2 lo_ = *(const LAS u32x2*)(LA + 16 * (i) * P + (16 * (k1) + 4 * q4) * 2); u32x2 hi_ = {0u, 0u}; if ((k2) >= 0) hi_ = *(const LAS u32x2*)(LA + 16 * (i) * P + (16 * ((k2) < 0 ? 0 : (k2)) + 4 * q4) * 2); \
        __builtin_bit_cast(bf16x8, (u32x4){lo_.x, lo_.y, hi_.x, hi_.y}); })
#define TFR(i) ({ const u32x2 lo_ = *(const LAS u32x2*)(L + O_TII + (((i) * 16 + c16) * 16 + 4 * q4) * 2); __builtin_bit_cast(bf16x8, (u32x4){lo_.x, lo_.y, 0u, 0u}); })
#define BFR(U1, U2) __builtin_bit_cast(bf16x8, (u32x4){cvt_pk_bf16(U1[0], U1[1]), cvt_pk_bf16(U1[2], U1[3]), cvt_pk_bf16(U2[0], U2[1]), cvt_pk_bf16(U2[2], U2[3])})
#define MF16(A_, B_, C_) __builtin_amdgcn_mfma_f32_16x16x32_bf16(A_, B_, C_, 0, 0, 0)
        const f32x4 zero4 = {0.f, 0.f, 0.f, 0.f};
        f32x4 U0 = MF16(TFR(0), BFR(RHS(0), zero4), zero4);
        f32x4 Z1 = MF16(AFR(1, 0, -1), BFR(U0, zero4), RHS(1));
        f32x4 U1 = MF16(TFR(1), BFR(Z1, zero4), zero4);
        f32x4 Z2 = MF16(AFR(2, 0, 1), BFR(U0, U1), RHS(2));
        f32x4 U2 = MF16(TFR(2), BFR(Z2, zero4), zero4);
        f32x4 Z3 = MF16(AFR(3, 0, 1), BFR(U0, U1), RHS(3));
        Z3 = MF16(AFR(3, 2, -1), BFR(U2, zero4), Z3);
        f32x4 U3 = MF16(TFR(3), BFR(Z3, zero4), zero4);
        st4(OT + (0 + 4 * q4) * 2, U0[0], U0[1], U0[2], U0[3]); st4(OT + (16 + 4 * q4) * 2, U1[0], U1[1], U1[2], U1[3]);
        st4(OT + (32 + 4 * q4) * 2, U2[0], U2[1], U2[2], U2[3]); st4(OT + (48 + 4 * q4) * 2, U3[0], U3[1], U3[2], U3[3]);
#undef RHS
#undef AFR
#undef TFR
#undef BFR
#undef MF16
    }
    __syncthreads();
    {
        const int mt = (w >> 1) & 1, nt = w & 1;
        if (w < 4) {
            f32x16 acc = f32x16{};
            acc = mm_ll(L + O_ABT, 32 * mt, L + O_BHT, 32 * nt, acc, r32, hi);
            if (mt == nt) { const float wc = *(const LAS float*)(L + O_WC + (32 * nt + r32) * 4);
#pragma unroll
                for (int r = 0; r < 16; ++r) if (crow(r, hi) == r32) acc[r] += wc; }
            store_native(slot + (mt * 2 + nt) * 2048, acc, lane);
            f32x16 rb;
#pragma unroll
            for (int g = 0; g < 4; ++g) { const u32x2 r_ = *(const LAS u32x2*)(L + O_RT + (32 * nt + r32) * P + (32 * mt + 8 * g + 4 * hi) * 2);
                rb[4 * g] = bflo(r_.x); rb[4 * g + 1] = bfhi(r_.x); rb[4 * g + 2] = bflo(r_.y); rb[4 * g + 3] = bfhi(r_.y); }
            rb = mm_ll(L + O_ABT, 32 * mt, L + O_ARB, 32 * nt, rb, r32, hi);
            store_native(slot + 16384 + (mt * 2 + nt) * 2048, rb, lane);
        } else {
            f32x16 acc = f32x16{};
            acc = mm_ll(L + O_BHT, 32 * mt, L + O_U0T, 32 * nt, acc, r32, hi);
            acc = mm_ll(L + O_KHT, 32 * mt, L + O_VT, 32 * nt, acc, r32, hi);
            store_native(slot + 8192 + (mt * 2 + nt) * 2048, acc, lane);
            f32x16 y0 = f32x16{};
            y0 = mm_ll(L + O_ARB, 32 * mt, L + O_U0T, 32 * nt, y0, r32, hi);
            y0 = mm_ll(L + O_ARK, 32 * mt, L + O_VT, 32 * nt, y0, r32, hi);
            store_native(slot + 24576 + (mt * 2 + nt) * 2048, y0, lane);
        }
    }
    __syncthreads();
#undef TAU
#undef LD10
}

__device__ __forceinline__ void s23_chain_wg(const Frame& F, const Args& a, int d, int q, int h, const unsigned char* slots  ) {
    LAS unsigned char* L = F.lds;
    const int lane = F.lane, w = F.wave, r32 = lane & 31, hi = lane >> 5, icb = w & 1;
    const int row0 = seq_row0(q), NC = seq_len(q) / 64;
    bf16_t* Zy = (bf16_t*)(a.ws + WS_Z) + (size_t)row0 * ZP + (d == 0 ? ZRR : ZRK) + h * 64 + 32 * icb + r32;
    f32x16 X0 = f32x16{}, X1 = f32x16{};
    const bool loader = w >= 4, compute = w < 2;
#define CKOF(cc) (d == 0 ? (cc) : NC - 1 - (cc))
#define S23_DMA(cc) do { const unsigned char* src_ = slots + (size_t)CKOF(cc) * SLOT_BYTES + (w - 4) * 8192 + lane * 16; LAS unsigned char* dst_ = L + ((cc) & 3) * 32768 + (w - 4) * 8192; \
        _Pragma("unroll") for (int p_ = 0; p_ < 8; ++p_) __builtin_amdgcn_global_load_lds((const unsigned*)(src_ + p_ * 1024), (LAS unsigned*)(dst_ + p_ * 1024), 16, 0, 0); } while (0)
#define UNPK(dst, w0, w1) do { _Pragma("unroll") for (int q_ = 0; q_ < 4; ++q_) { dst[2 * q_] = bflo(w0[q_]); dst[2 * q_ + 1] = bfhi(w0[q_]); dst[8 + 2 * q_] = bflo(w1[q_]); dst[9 + 2 * q_] = bfhi(w1[q_]); } } while (0)
    if (loader) { S23_DMA(0); if (NC > 1) S23_DMA(1); if (NC > 2) S23_DMA(2); }
#pragma unroll 1
    for (int cc = 0; cc < NC; ++cc) {
        if (loader) { const int later = NC - 1 - cc;
            if (later >= 2) asm volatile("s_waitcnt vmcnt(16)" ::: "memory"); else if (later == 1) asm volatile("s_waitcnt vmcnt(8)" ::: "memory"); else asm volatile("s_waitcnt vmcnt(0)" ::: "memory"); }
        asm volatile("s_waitcnt lgkmcnt(0)\n\ts_barrier" ::: "memory");
        if (loader) { if (cc + 3 < NC) S23_DMA(cc + 3); }
        if (compute) {
            const LAS unsigned char* sl = L + (cc & 3) * 32768 + lane * 32;
            const int ck = CKOF(cc);
            bf16x8 xb[2][2];
#pragma unroll
            for (int s = 0; s < 2; ++s) {
                xb[0][s] = __builtin_bit_cast(bf16x8, (u32x4){cvt_pk_bf16(X0[8 * s], X0[8 * s + 1]), cvt_pk_bf16(X0[8 * s + 2], X0[8 * s + 3]), cvt_pk_bf16(X0[8 * s + 4], X0[8 * s + 5]), cvt_pk_bf16(X0[8 * s + 6], X0[8 * s + 7])});
                xb[1][s] = __builtin_bit_cast(bf16x8, (u32x4){cvt_pk_bf16(X1[8 * s], X1[8 * s + 1]), cvt_pk_bf16(X1[8 * s + 2], X1[8 * s + 3]), cvt_pk_bf16(X1[8 * s + 4], X1[8 * s + 5]), cvt_pk_bf16(X1[8 * s + 6], X1[8 * s + 7])}); }
            u32x4 dw[2][2];
#pragma unroll
            for (int t = 0; t < 2; ++t) { dw[t][0] = *(const LAS u32x4*)(sl + 8192 + (t * 2 + icb) * 2048); dw[t][1] = *(const LAS u32x4*)(sl + 8192 + (t * 2 + icb) * 2048 + 16); }
            f32x16 N0, N1;
            UNPK(N0, dw[0][0], dw[0][1]); UNPK(N1, dw[1][0], dw[1][1]);
#pragma unroll
            for (int rb = 0; rb < 2; ++rb)
#pragma unroll
                for (int s = 0; s < 2; ++s) {
                    N0 = __builtin_amdgcn_mfma_f32_32x32x16_bf16(*(const LAS bf16x8*)(sl + (rb * 2 + 0) * 2048 + s * 16), xb[rb][s], N0, 0, 0, 0);
                    N1 = __builtin_amdgcn_mfma_f32_32x32x16_bf16(*(const LAS bf16x8*)(sl + (rb * 2 + 1) * 2048 + s * 16), xb[rb][s], N1, 0, 0, 0); }
            u32x4 yw[2][2];
#pragma unroll
            for (int t = 0; t < 2; ++t) { yw[t][0] = *(const LAS u32x4*)(sl + 24576 + (t * 2 + icb) * 2048); yw[t][1] = *(const LAS u32x4*)(sl + 24576 + (t * 2 + icb) * 2048 + 16); }
            f32x16 Y0, Y1;
            UNPK(Y0, yw[0][0], yw[0][1]); UNPK(Y1, yw[1][0], yw[1][1]);
#pragma unroll
            for (int rb = 0; rb < 2; ++rb)
#pragma unroll
                for (int s = 0; s < 2; ++s) {
                    Y0 = __builtin_amdgcn_mfma_f32_32x32x16_bf16(*(const LAS bf16x8*)(sl + 16384 + (rb * 2 + 0) * 2048 + s * 16), xb[rb][s], Y0, 0, 0, 0);
                    Y1 = __builtin_amdgcn_mfma_f32_32x32x16_bf16(*(const LAS bf16x8*)(sl + 16384 + (rb * 2 + 1) * 2048 + s * 16), xb[rb][s], Y1, 0, 0, 0); }
            X0 = N0; X1 = N1;
            const long rs = d == 0 ? (long)ZP : -(long)ZP;
            bf16_t* pa = Zy + (size_t)(ck * 64 + (d == 0 ? 4 * hi : 63 - 4 * hi)) * ZP; bf16_t* pb = pa + 32 * rs;
#pragma unroll
            for (int g = 0; g < 4; ++g) {
#pragma unroll
                for (int e = 0; e < 4; ++e) { pa[e * rs] = f2bf(Y0[4 * g + e]); pb[e * rs] = f2bf(Y1[4 * g + e]); }
                pa += 8 * rs; pb += 8 * rs; asm volatile("" : "+v"(pa), "+v"(pb));
            }
        }
    }
    asm volatile("s_waitcnt vmcnt(0) lgkmcnt(0)\n\ts_barrier" ::: "memory");
#undef UNPK
#undef S23_DMA
#undef CKOF
}

__device__ __forceinline__ void post_item(const Frame& F, const Args& a, int q, int h, int blk) {
    LAS unsigned char* L = F.lds; constexpr int PS = 272, O_SG = 0, O_G = 64 * PS;
    const int lane = F.lane, w = F.wave, r32 = lane & 31, hi = lane >> 5, j = lane, tg = w;
    const int row0 = seq_row0(q), S = seq_len(q), t_lo = blk * 64 + 8 * tg;
    bf16_t* Zs = (bf16_t*)(a.ws + WS_Z) + (size_t)row0 * ZP;
    const float* mup = inp(L, 11); const float* mun = inp(L, 12);
    {
        float z0[10], z1[10]; load10(Zs + ZGD + j, t_lo, S, z0); load10(Zs + ZGD + 64 + j, t_lo, S, z1);
        const float mp0 = mup[ZGD - ZRR + j], mn0 = mun[ZGD - ZRR + j], mp1 = mup[ZGD - ZRR + 64 + j], mn1 = mun[ZGD - ZRR + 64 + j];
#pragma unroll
        for (int u = 0; u < 8; ++u) { *(LAS bf16_t*)(L + O_SG + (8 * tg + u) * PS + j * 2) = f2bf(sigmoidf_(tshift(z0, u, mp0, mn0)));
                                      *(LAS bf16_t*)(L + O_SG + (8 * tg + u) * PS + (64 + j) * 2) = f2bf(sigmoidf_(tshift(z1, u, mp1, mn1))); }
    }
    __syncthreads();
    if (w < 4) {
        const int mt = w >> 1, nt = w & 1;
        const bf16_t* GT = (const bf16_t*)(a.ws + WS_LORA) + 4 * 512 * 64 + ((size_t)h * 64 + 32 * mt + r32) * 128;
        f32x16 acc = f32x16{};
#pragma unroll
        for (int ks = 0; ks < 8; ++ks) { const bf16x8 av = *(const bf16x8*)(GT + 16 * ks + 8 * hi), bv = *(const LAS bf16x8*)(L + O_SG + (32 * nt + r32) * PS + (16 * ks + 8 * hi) * 2);
            acc = __builtin_amdgcn_mfma_f32_32x32x16_bf16(av, bv, acc, 0, 0, 0); }
#pragma unroll
        for (int g = 0; g < 4; ++g) *(LAS f32x4*)(L + O_G + (32 * nt + r32) * PS + (32 * mt + 8 * g + 4 * hi) * 4) = (f32x4){acc[4 * g], acc[4 * g + 1], acc[4 * g + 2], acc[4 * g + 3]};
    }
    __syncthreads();
    {
        const int ch = h * 64 + j;
        float zv[10]; load10(Zs + ZRV + ch, t_lo, S, zv);
        const float mpv = mup[1024 + ch], mnv = mun[1024 + ch], lg = inp(L, 21)[ch], lb = inp(L, 22)[ch];
        const float* bon0 = (const float*)(a.ws + WS_BONUS) + (size_t)row0 * 8 + h; const float* bon1 = bon0 + (size_t)MTOK * 8;
#pragma unroll
        for (int u = 0; u < 8; ++u) { const int t = t_lo + u;
            const float y = bf2f(Zs[(size_t)t * ZP + ZRR + ch]) + bf2f(Zs[(size_t)t * ZP + ZRK + ch]);
            const float mean = wave_sum(y) * (1.f / 64.f); const float dv = y - mean; const float var = wave_sum(dv * dv) * (1.f / 64.f);
            const float yn = dv * (1.0f / sqrtf(var + LNX_EPS)) * lg + lb;
            const float bsum = bon0[(size_t)t * 8] + bon1[(size_t)t * 8];
            const float g = *(const LAS float*)(L + O_G + (8 * tg + u) * PS + j * 4);
            Zs[(size_t)t * ZP + ZRR + ch] = f2bf((yn + bsum * tshift(zv, u, mpv, mnv)) * g); }
    }
    __syncthreads();
}
}


#define XB_TMO      128
#define XB_XCNT(j)  (256  + 64 * (j))
#define XB_XSUB(j)  (1280 + 64 * (j))
#define XB_XGEN(j)  (2304 + 64 * (j))
#define XB_TOP      3328
#define XB_TOPGEN   3392
#define XCD_BAR_WORDS 3456
#define XB_SPIN_CAP (1u << 20)
constexpr size_t CTL_ZERO_BYTES = 16384;
__device__ __forceinline__ unsigned xb_ld(unsigned* p)              { return __hip_atomic_load(p, __ATOMIC_RELAXED, __HIP_MEMORY_SCOPE_AGENT); }
__device__ __forceinline__ unsigned xb_add(unsigned* p, unsigned v) { return __hip_atomic_fetch_add(p, v, __ATOMIC_RELAXED, __HIP_MEMORY_SCOPE_AGENT); }
__device__ __forceinline__ unsigned xb_xcc_id() { return (unsigned)__builtin_amdgcn_s_getreg((3 << 11) | 20) & 0xFu; }
#define XB_SPIN(cond, bar) do { unsigned _sp = 0; while (cond) { __builtin_amdgcn_s_sleep(1); \
    if ((++_sp & 255u) == 0u) { if (xb_ld(&(bar)[XB_TMO])) break; if (_sp > XB_SPIN_CAP) { atomicAdd(&(bar)[XB_TMO], 1u); break; } } } } while (0)
struct XcdBarrier { unsigned* bar; unsigned x; volatile LAS unsigned* st; };
__device__ __forceinline__ XcdBarrier xcd_barrier_post(unsigned* bar, volatile LAS unsigned* st) {
    XcdBarrier b; b.bar = bar; b.x = xb_xcc_id(); b.st = st;
    if (threadIdx.x == 0) (void)xb_add(&bar[XB_XCNT(b.x)], 1u);
    return b;
}
__device__ __forceinline__ void xcd_barrier_complete(unsigned* bar, unsigned x, unsigned& nloc, unsigned& nx) {
    const unsigned G = gridDim.x * gridDim.y * gridDim.z;
    unsigned sum, cnt, mine, sp = 0u;
    for (;;) {
        sum = 0u; cnt = 0u; mine = 0u;
#pragma unroll
        for (unsigned j = 0; j < 16; ++j) { const unsigned c = xb_ld(&bar[XB_XCNT(j)]); sum += c; cnt += (c > 0u) ? 1u : 0u; mine = (j == x) ? c : mine; }
        if (sum == G) break;
        __builtin_amdgcn_s_sleep(1);
        if ((++sp & 255u) == 0u) { if (xb_ld(&bar[XB_TMO])) break; if (sp > XB_SPIN_CAP) { atomicAdd(&bar[XB_TMO], 1u); break; } }
    }
    nloc = mine > 0u ? mine : 1u; nx = cnt > 0u ? cnt : 1u;
}
__device__ __forceinline__ void xcd_barrier(const XcdBarrier& b) {
    asm volatile("s_waitcnt vmcnt(0)" ::: "memory");
    __syncthreads();
    if (threadIdx.x == 0) {
        unsigned* bar = b.bar;
        __builtin_amdgcn_s_waitcnt(0);
        unsigned nloc = b.st[0], nx = b.st[1];
        if (nloc == 0u) { xcd_barrier_complete(bar, b.x, nloc, nx); b.st[0] = nloc; b.st[1] = nx; }
        const unsigned old = xb_add(&bar[XB_XSUB(b.x)], 1u);
        const unsigned gen = old / nloc;
        if (old + 1u == (gen + 1u) * nloc) {
            __builtin_amdgcn_fence(__ATOMIC_RELEASE, "agent");
            asm volatile("s_waitcnt vmcnt(0)" ::: "memory");
            const unsigned og = xb_add(&bar[XB_TOP], 1u);
            const unsigned tg = og / nx;
            if (og + 1u == (tg + 1u) * nx) xb_add(&bar[XB_TOPGEN], 1u);
            else XB_SPIN(xb_ld(&bar[XB_TOPGEN]) == tg, bar);
            __builtin_amdgcn_fence(__ATOMIC_ACQUIRE, "agent");
            xb_add(&bar[XB_XGEN(b.x)], 1u);
            asm volatile("s_waitcnt vmcnt(0)" ::: "memory");
        } else {
            XB_SPIN(xb_ld(&bar[XB_XGEN(b.x)]) == gen, bar);
            __builtin_amdgcn_fence(__ATOMIC_ACQUIRE, "agent");
            asm volatile("s_waitcnt vmcnt(0)" ::: "memory");
        }
    }
    __syncthreads();
}

#ifndef ONE_LAUNCH
#define ONE_LAUNCH 1
#endif
#ifndef USE_CG
#define USE_CG 0
#endif
constexpr int NPHASE = 10;
constexpr int NOJUMP = 1 << 30;
template <int LO, int HI>
__global__ void __launch_bounds__(NTHR, 2) fwd_kernel(Args a) {
    extern __shared__ __attribute__((aligned(16))) unsigned char lds_raw[];
    Frame F; F.lds = (LAS unsigned char*)lds_raw; F.tid = threadIdx.x; F.lane = F.tid & 63; F.wave = __builtin_amdgcn_readfirstlane(F.tid >> 6);
    F.G = gridDim.x; { const int bx = blockIdx.x; F.vcu = (F.G % 8 == 0) ? (bx % 8) * (F.G / 8) + bx / 8 : bx; }
    unsigned char* ws = a.ws; bf16_t* Z = (bf16_t*)(ws + WS_Z);
    unsigned char* slots = (unsigned char*)a.out;
    if (F.tid == 0) {
#pragma unroll
        for (int i = 0; i < 27; ++i) *(const float* LAS*)(F.lds + PTRS_OFF + i * 8) = a.in[i];
        *(volatile LAS unsigned*)(F.lds + PTRS_OFF + 224) = 0u; *(volatile LAS unsigned*)(F.lds + PTRS_OFF + 228) = 0u;
    }
    __syncthreads();
#if ONE_LAUNCH && !USE_CG
    const XcdBarrier bar = xcd_barrier_post((unsigned*)(ws + WS_CTL), (volatile LAS unsigned*)(F.lds + PTRS_OFF + 224));
#endif
#if ONE_LAUNCH
#if USE_CG
#define SEAM(k) do { if constexpr ((k) + 1 < HI) { cg::this_grid().sync(); } } while (0)
#define RSYNC() cg::this_grid().sync()
#else
#define SEAM(k) do { if constexpr ((k) + 1 < HI) { xcd_barrier(bar); } } while (0)
#define RSYNC() xcd_barrier(bar)
#endif
#else
#define SEAM(k) do { } while (0)
#define RSYNC() do { } while (0)
#endif
#define IN(k) (LO <= (k) && (k) < HI)
    if constexpr (IN(0)) { p0_prologue(F, a); SEAM(0); }
    if constexpr (IN(1)) { pg8::Gemm g{(const char*)a.out, (const bf16_t*)(ws + WS_WIN), MTOK, ZP, DM, DM * 2, NOJUMP, 0}; pg8::StaticOrder S; S.init(MTOK, ZP, F.G, (int)blockIdx.x);
        pg8::EpiZ E{Z, ZP}; pg8::gemm_phase<pg8::EpiZ, pg8::StaticOrder, true>(F.lds, g, S, E); SEAM(1); }
    if constexpr (IN(2)) { qk_prep(F, a);
#pragma unroll 1
        for (int rnd = 0; rnd < 2; ++rnd) {
            for (int it = F.vcu; it < 4096; it += F.G) {
                int d, q, h, ck; if (rnd == 0) { ck = it & 255; h = (it >> 8) & 7; d = it >> 11; q = 0; } else { ck = it & 31; h = (it >> 5) & 7; q = 1 + ((it >> 8) & 7); d = it >> 11; }
                rw::s1_item(F, a, d, q, h, ck, slots + (size_t)it * SLOT_BYTES); }
            RSYNC();
            {
                const int nchain = rnd == 0 ? 16 : 128;
                for (int chain = F.vcu; chain < nchain; chain += F.G) { int d, q, h, nc;
                    if (rnd == 0) { d = chain >> 3; h = chain & 7; q = 0; nc = 256; } else { h = chain & 7; q = 1 + ((chain >> 3) & 7); d = chain >> 6; nc = 32; }
                    rw::s23_chain_wg(F, a, d, q, h, slots + (size_t)chain * nc * SLOT_BYTES); } }
            if (rnd == 0) RSYNC();
        }
        SEAM(2); }
    if constexpr (IN(3)) { for (int it = F.vcu; it < 4096; it += F.G) { if (it < 2048) rw::post_item(F, a, 0, it >> 8, it & 255); else { const int r = it - 2048; rw::post_item(F, a, 1 + (r >> 8), (r >> 5) & 7, r & 31); } }
        SEAM(3); }
    if constexpr (IN(4)) {
        float lam; { const float p1 = wave_sum(a.in[6][F.lane] * a.in[7][F.lane]), p2 = wave_sum(a.in[8][F.lane] * a.in[9][F.lane]); lam = __expf(p1) - __expf(p2) + LAMBDA_INIT; }
        for (int v = F.vcu; v < 256; v += F.G) {
            att::attn_unit(0, SP, v >> 6, v & 63, Z, F.lds, lam, a.in[10]);
            att::attn_unit(SP + (v >> 5) * SS, SS, (v >> 3) & 3, v & 7, Z, F.lds, lam, a.in[10]); }
        SEAM(4); }
    if constexpr (IN(5)) { pg8::Gemm g{(const char*)Z, (const bf16_t*)(ws + WS_WOUT), MTOK, DM, DM, ZP * 2, 8, 2048}; pg8::StaticOrder S; S.init(MTOK, DM, F.G, (int)blockIdx.x);
        pg8::EpiOut E{a.in[0], a.in[1], a.out, Z, (float*)(ws + WS_ROWSQ)}; pg8::gemm_phase<pg8::EpiOut, pg8::StaticOrder, true>(F.lds, g, S, E); SEAM(5); }
#define FFN_UP(k, half) if constexpr (IN(k)) { pg8::Gemm g{(const char*)(Z + (size_t)(half) * 16384 * ZP + ZXN2), (const bf16_t*)(ws + WS_W1), 16384, DFF, DM, ZP * 2, NOJUMP, 0}; pg8::StaticOrder S; S.init(16384, DFF, F.G, (int)blockIdx.x); \
        pg8::EpiUp E{(char*)(ws + WS_Z), (const float*)(ws + WS_ROWSQ), (half) * 16384}; pg8::gemm_phase<pg8::EpiUp, pg8::StaticOrder, true>(F.lds, g, S, E); SEAM(k); }
#define FFN_DN(k, half) if constexpr (IN(k)) { pg8::Gemm g{(const char*)(ws + WS_Z), (const bf16_t*)(ws + WS_W2), 16384, DM, DFF, 13312, 32, 2560}; pg8::StaticOrder S; S.init(16384, DM, F.G, (int)blockIdx.x); \
        pg8::EpiDown E{a.out, (half) * 16384}; pg8::gemm_phase<pg8::EpiDown, pg8::StaticOrder, true>(F.lds, g, S, E); SEAM(k); }
    FFN_UP(6, 0) FFN_DN(7, 0) FFN_UP(8, 1) FFN_DN(9, 1)
#undef FFN_UP
#undef FFN_DN
#undef IN
#undef SEAM
#undef RSYNC
}

extern "C" void kernel_launch(void* const* d_in, const int* in_sizes, int n_in, void* d_out, int out_size, void* d_ws, size_t ws_size, hipStream_t stream) {
    static int grid = 0;
    if (grid == 0) {
        if (n_in != 27 || out_size != MTOK * DM || ws_size < WS_END) { fprintf(stderr, "kernel_launch: unexpected shapes (n_in %d out %d ws %zu)\n", n_in, out_size, ws_size); grid = -1; return; }
        int dev = 0, cus = 0; (void)hipGetDevice(&dev); (void)hipDeviceGetAttribute(&cus, hipDeviceAttributeMultiprocessorCount, dev);
        bool ok = true;
#if ONE_LAUNCH
        ok = ok && hipFuncSetAttribute((const void*)fwd_kernel<0, NPHASE>, hipFuncAttributeMaxDynamicSharedMemorySize, LDS_BYTES) == hipSuccess;
        int per_cu = 0; (void)hipOccupancyMaxActiveBlocksPerMultiprocessor(&per_cu, (const void*)fwd_kernel<0, NPHASE>, NTHR, LDS_BYTES); (void)hipGetLastError();
        if (per_cu < 1) fprintf(stderr, "kernel_launch: occupancy query says %d blocks/CU\n", per_cu);
#else
#define SETA(p) ok = ok && hipFuncSetAttribute((const void*)fwd_kernel<p, p + 1>, hipFuncAttributeMaxDynamicSharedMemorySize, LDS_BYTES) == hipSuccess;
        SETA(0) SETA(1) SETA(2) SETA(3) SETA(4) SETA(5) SETA(6) SETA(7) SETA(8) SETA(9)
#undef SETA
#endif
        if (!ok) { fprintf(stderr, "kernel_launch: hipFuncSetAttribute failed\n"); grid = -1; return; }
        grid = cus > 256 ? 256 : cus;
    }
    if (grid < 0) return;
    Args a{};
    for (int i = 0; i < 27; ++i) a.in[i] = (const float*)d_in[i];
    a.out = (float*)d_out; a.ws = (unsigned char*)d_ws;
#if ONE_LAUNCH
    a.ph_lo = 0; a.ph_hi = NPHASE;
#if !USE_CG
    if (hipMemsetAsync((char*)d_ws + WS_CTL, 0, CTL_ZERO_BYTES, stream) != hipSuccess) { fprintf(stderr, "kernel_launch: hipMemsetAsync failed\n"); return; }
#endif
    void* args[] = {&a};
    hipError_t e = hipLaunchCooperativeKernel((const void*)fwd_kernel<0, NPHASE>, dim3(grid), dim3(NTHR), args, LDS_BYTES, stream);
    if (e != hipSuccess) fprintf(stderr, "cooperative launch failed: %s (grid %d)\n", hipGetErrorString(e), grid);
#else
#define LAUNCH(p) hipLaunchKernelGGL((fwd_kernel<p, p + 1>), dim3(grid), dim3(NTHR), LDS_BYTES, stream, a);
    LAUNCH(0) LAUNCH(1) LAUNCH(2) LAUNCH(3) LAUNCH(4) LAUNCH(5) LAUNCH(6) LAUNCH(7) LAUNCH(8) LAUNCH(9)
#undef LAUNCH
#endif
}
```

```cpp
#include <hip/hip_runtime.h>
#include <hip/hip_cooperative_groups.h>
#include <cstdio>
#include <cstdint>
namespace cg = cooperative_groups;

#define LAS __attribute__((address_space(3)))
typedef unsigned short bf16_t;
typedef short bf16x8 __attribute__((ext_vector_type(8)));
typedef short s16x4 __attribute__((ext_vector_type(4)));
typedef float f32x4 __attribute__((ext_vector_type(4)));
typedef float f32x16 __attribute__((ext_vector_type(16)));
typedef unsigned u32x4 __attribute__((ext_vector_type(4)));
typedef unsigned u32x2 __attribute__((ext_vector_type(2)));
typedef float f32x2_t __attribute__((ext_vector_type(2)));
typedef __bf16 bf16x2_t __attribute__((ext_vector_type(2)));

constexpr int MTOK = 32768, DM = 1024, ZP = 3328, DFF = 4096;
constexpr int SP = 16384, SS = 2048;
constexpr int ZQ = 0, ZK = 512, ZV = 1024, ZRR = 1536, ZRK = 2048, ZRV = 2560, ZWD = 3072, ZAD = 3136, ZGD = 3200;
constexpr int ZXN2 = 2048;
constexpr float NORM_EPS = 1e-6f, LNX_EPS = 64e-5f;
constexpr float QSCALE = 0.125f * 1.4426950408889634f;
constexpr float LAMBDA_INIT = 0.2f;
constexpr int NCHUNK_P = SP / 64, NCHUNK_S = SS / 64;

constexpr size_t MiB = 1u << 20;
constexpr size_t WS_CTL = 0;
constexpr size_t WS_WIN = 1 * MiB, WS_WOUT = 8 * MiB, WS_W1 = 10 * MiB, WS_W2 = 18 * MiB;
constexpr size_t WS_ROPE = 26 * MiB;
constexpr size_t WS_LORA = 30 * MiB;
constexpr size_t WS_ROWSQ = 31 * MiB;
constexpr size_t WS_BONUS = 33 * MiB;
constexpr size_t WS_Z = 36 * MiB;
constexpr size_t WS_END = 244 * MiB;
static_assert(WS_Z + (size_t)MTOK * ZP * 2 <= WS_END, "ws map");
constexpr size_t SLOT_BYTES = 32768;

__device__ __forceinline__ unsigned cvt_pk_bf16(float lo, float hi) { f32x2_t v = {lo, hi}; bf16x2_t b = __builtin_convertvector(v, bf16x2_t); return __builtin_bit_cast(unsigned, b); }
__device__ __forceinline__ float bf2f(unsigned short u) { return __uint_as_float(((unsigned)u) << 16); }
__device__ __forceinline__ float bflo(unsigned u) { return __uint_as_float(u << 16); }
__device__ __forceinline__ float bfhi(unsigned u) { return __uint_as_float(u & 0xffff0000u); }
__device__ __forceinline__ unsigned short f2bf(float f) { return (unsigned short)(cvt_pk_bf16(f, 0.f) & 0xffffu); }
__device__ __forceinline__ float wave_sum(float v) {
#pragma unroll
    for (int o = 1; o < 64; o <<= 1) v += __shfl_xor(v, o);
    return v;
}
__device__ __forceinline__ float wave_sum_dpp(float v) {
    int x = __float_as_int(v);
    v += __int_as_float(__builtin_amdgcn_update_dpp(0, x, 0xB1, 0xF, 0xF, true)); x = __float_as_int(v);
    v += __int_as_float(__builtin_amdgcn_update_dpp(0, x, 0x4E, 0xF, 0xF, true)); x = __float_as_int(v);
    v += __int_as_float(__builtin_amdgcn_update_dpp(0, x, 0x124, 0xF, 0xF, true)); x = __float_as_int(v);
    v += __int_as_float(__builtin_amdgcn_update_dpp(0, x, 0x128, 0xF, 0xF, true)); x = __float_as_int(v);
    const float a = __int_as_float(__builtin_amdgcn_readlane(x, 0)), b = __int_as_float(__builtin_amdgcn_readlane(x, 16)), c = __int_as_float(__builtin_amdgcn_readlane(x, 32)), d = __int_as_float(__builtin_amdgcn_readlane(x, 48));
    return (a + b) + (c + d);
}
#define LDS_WAIT() asm volatile("s_waitcnt lgkmcnt(0)" ::: "memory")
#define VM_WAIT() asm volatile("s_waitcnt vmcnt(0)" ::: "memory")

namespace pg8 {
constexpr int BM = 256, BK = 64, HALF = 128, HTB = HALF * BK * 2, STAGE_BYTES = 8 * HTB, NXCD = 8, WGM = 8;
__host__ __device__ __forceinline__ int lds_byte(int r, int c) { const int st = (r >> 4) * 2 + (c >> 5), rr = r & 15, cc = c & 31, ob = rr * 64 + cc * 2; return st * 1024 + (ob ^ (((ob >> 9) & 1) << 5)); }
__host__ __device__ __forceinline__ void stage_rc(int b, int& R, int& C) { const int st = b / 1024, sb = b % 1024, swz = sb ^ (((sb >> 9) & 1) << 5); R = (st >> 1) * 16 + swz / 64; C = (st & 1) * 32 + (swz % 64) / 2; }
__host__ __device__ __forceinline__ int perm32(int rho) { const int n = rho >> 4, i = rho & 15; return 8 * (i >> 2) + 4 * n + (i & 3); }
struct Unit { int pm, pn; };
struct Gemm { const char* A; const bf16_t* Bt; int M, N, K; int lda; int jkt; int jbytes; };
struct StaticOrder {
    int nM, nN, nwg, G, c;
    __host__ __device__ void init(int M, int N, int G_, int c_) { nM = M / BM; nN = N / BM; nwg = nM * nN; G = G_; c = c_; }
    __host__ __device__ bool next(int i, Unit& u) const {
        const long L = (long)i * G + c; if (L >= nwg) return false;
        int wgid = (int)L; { const int q = nwg / NXCD, r = nwg % NXCD, xcd = wgid % NXCD, off = wgid / NXCD; wgid = (xcd < r ? xcd * (q + 1) : r * (q + 1) + (xcd - r) * q) + off; }
        const int nig = WGM * nN, gid = wgid / nig, fm = gid * WGM, gsz = (nM - fm) < WGM ? (nM - fm) : WGM;
        u.pm = fm + ((wgid % nig) % gsz); u.pn = (wgid % nig) / gsz; return true;
    }
};

struct EpiZ {
    static constexpr bool PERM = true;
    bf16_t* O; int ldc;
    __device__ __forceinline__ void operator()(const f32x4 (&acc)[2][2][4][2], const Unit& u, int wr, int wc, int fr, int fq) const {
        const int row0 = u.pm * BM + wr * 64 + fr, col0 = u.pn * BM + wc * 32 + 8 * fq;
#pragma unroll
        for (int ai = 0; ai < 2; ++ai)
#pragma unroll
            for (int m = 0; m < 4; ++m) { bf16_t* rowp = O + (size_t)(row0 + ai * HALF + m * 16) * ldc + col0;
#pragma unroll
                for (int bj = 0; bj < 2; ++bj) { const f32x4 v0 = acc[ai][bj][m][0], v1 = acc[ai][bj][m][1];
                    u32x4 w; w.x = cvt_pk_bf16(v0[0], v0[1]); w.y = cvt_pk_bf16(v0[2], v0[3]); w.z = cvt_pk_bf16(v1[0], v1[1]); w.w = cvt_pk_bf16(v1[2], v1[3]);
                    *(u32x4*)(rowp + bj * HALF) = w; } }
    }
};
struct EpiOut {
    static constexpr bool PERM = false;
    const float* xp; const float* xs; float* out; bf16_t* Z; float* rowsq;
    __device__ __forceinline__ void operator()(const f32x4 (&acc)[2][2][4][2], const Unit& u, int wr, int wc, int fr, int fq) const {
        const int col0 = u.pn * BM + wc * 32 + 4 * fq;
#pragma unroll
        for (int ai = 0; ai < 2; ++ai)
#pragma unroll
            for (int m = 0; m < 4; ++m) { const int r = u.pm * BM + ai * HALF + wr * 64 + m * 16 + fr;
                const float* xr = (r < SP ? xp + (size_t)r * DM : xs + (size_t)(r - SP) * DM) + col0; float* orow = out + (size_t)r * DM + col0; bf16_t* zr = Z + (size_t)r * ZP + ZXN2 + col0;
                float ss = 0.f;
#pragma unroll
                for (int bj = 0; bj < 2; ++bj)
#pragma unroll
                    for (int n = 0; n < 2; ++n) { const f32x4 xv = *(const f32x4*)(xr + bj * HALF + n * 16); const f32x4 o = xv + acc[ai][bj][m][n];
                        *(f32x4*)(orow + bj * HALF + n * 16) = o; ss += (o[0] * o[0] + o[1] * o[1]) + (o[2] * o[2] + o[3] * o[3]);
                        u32x2 w; w.x = cvt_pk_bf16(o[0], o[1]); w.y = cvt_pk_bf16(o[2], o[3]); *(u32x2*)(zr + bj * HALF + n * 16) = w; }
                ss += __shfl_xor(ss, 16); ss += __shfl_xor(ss, 32);
                if (fq == 0) rowsq[(size_t)r * 16 + u.pn * 4 + wc] = ss;
                if (m & 1) asm volatile("" ::: "memory"); }
    }
};
struct EpiUp {
    static constexpr bool PERM = true;
    char* H; const float* rowsq; int row_off;
    __device__ __forceinline__ void operator()(const f32x4 (&acc)[2][2][4][2], const Unit& u, int wr, int wc, int fr, int fq) const {
        const int row0 = u.pm * BM + wr * 64 + fr, col0 = u.pn * BM + wc * 32 + 8 * fq;
#pragma unroll
        for (int ai = 0; ai < 2; ++ai)
#pragma unroll
            for (int m = 0; m < 4; ++m) { const int r = row0 + ai * HALF + m * 16; const f32x4* rq = (const f32x4*)(rowsq + (size_t)(row_off + r) * 16);
                const f32x4 q0 = rq[0], q1 = rq[1], q2 = rq[2], q3 = rq[3];
                const float ssum = ((q0[0] + q0[1]) + (q0[2] + q0[3])) + ((q1[0] + q1[1]) + (q1[2] + q1[3])) + ((q2[0] + q2[1]) + (q2[2] + q2[3])) + ((q3[0] + q3[1]) + (q3[2] + q3[3]));
                const float rstd = __builtin_amdgcn_rsqf(ssum * (1.0f / DM) + NORM_EPS);
                char* rowp = H + (size_t)r * 13312;
#pragma unroll
                for (int bj = 0; bj < 2; ++bj) { const int c = col0 + bj * HALF; f32x4 v0 = acc[ai][bj][m][0] * rstd, v1 = acc[ai][bj][m][1] * rstd;
#pragma unroll
                    for (int e = 0; e < 4; ++e) { const float a = fmaxf(v0[e], 0.f), b = fmaxf(v1[e], 0.f); v0[e] = a * a; v1[e] = b * b; }
                    u32x4 w; w.x = cvt_pk_bf16(v0[0], v0[1]); w.y = cvt_pk_bf16(v0[2], v0[3]); w.z = cvt_pk_bf16(v1[0], v1[1]); w.w = cvt_pk_bf16(v1[2], v1[3]);
                    *(u32x4*)(rowp + (size_t)c * 2 + (c >= 2048 ? 2560 : 0)) = w; } }
    }
};
struct EpiDown {
    static constexpr bool PERM = false;
    float* out; int row_off;
    __device__ __forceinline__ void operator()(const f32x4 (&acc)[2][2][4][2], const Unit& u, int wr, int wc, int fr, int fq) const {
        const int col0 = u.pn * BM + wc * 32 + 4 * fq;
#pragma unroll
        for (int ai = 0; ai < 2; ++ai)
#pragma unroll
            for (int m = 0; m < 4; ++m) { const int r = row_off + u.pm * BM + ai * HALF + wr * 64 + m * 16 + fr; float* orow = out + (size_t)r * DM + col0;
#pragma unroll
                for (int bj = 0; bj < 2; ++bj)
#pragma unroll
                    for (int n = 0; n < 2; ++n) { const f32x4 xv = *(const f32x4*)(orow + bj * HALF + n * 16); *(f32x4*)(orow + bj * HALF + n * 16) = xv + acc[ai][bj][m][n]; }
                if (m & 1) asm volatile("" ::: "memory"); }
    }
};

template <class Epi, class Sched, bool ALIGN_EPI>
__device__ __forceinline__ void gemm_phase(LAS unsigned char* lds, const Gemm g, const Sched& S, const Epi& E) {
    int tid_ = threadIdx.x; asm volatile("" : "+v"(tid_));
    const int tid = tid_, wid = __builtin_amdgcn_readfirstlane(tid >> 6), lane = tid & 63, wr = wid >> 2, wc = wid & 3, fr = lane & 15, fq = lane >> 4;
    const int K = g.K, nt = K / BK;
    unsigned voffA[2], voffB[2];
#pragma unroll
    for (int i = 0; i < 2; ++i) { int R, C; stage_rc(tid * 16 + i * 8192, R, C); const int Rb = Epi::PERM ? ((R & ~31) + perm32(R & 31)) : R;
        voffA[i] = (unsigned)(R * g.lda + C * 2); voffB[i] = (unsigned)(Rb * K + C) * 2u; }
    const size_t kstep = (size_t)(BK * 2);
    const size_t hstepA = (size_t)HALF * g.lda, tstepA = 2 * hstepA;
    const size_t hstepB = (size_t)HALF * K * 2, tstepB = 2 * hstepB;
    const unsigned ldsw = (unsigned)wid * 1024u;
    const int aoff = lds_byte(wr * 64 + fr, fq * 8), boff = lds_byte(wc * 32 + fr, fq * 8);
#define PG8_AOFF(kt) ((size_t)(kt) * kstep + ((kt) >= g.jkt ? (size_t)g.jbytes : (size_t)0))
#define PG8_SA(b, h) (((b) * 2 + (h)) * HTB)
#define PG8_SB(b, h) ((4 + (b) * 2 + (h)) * HTB)
#define PG8_STAGE(bufoff, gbase, voff) do { _Pragma("unroll") for (int _i = 0; _i < 2; ++_i) \
        __builtin_amdgcn_global_load_lds((const unsigned*)((const char*)(gbase) + (voff)[_i]), (LAS unsigned*)(lds + (bufoff) + ldsw + _i * 8192), 16, 0, 0); } while (0)
#define PG8_LDA(dst, b, h) do { _Pragma("unroll") for (int m = 0; m < 4; ++m) _Pragma("unroll") for (int k = 0; k < 2; ++k) dst[m][k] = *(const LAS bf16x8*)(lds + PG8_SA(b, h) + aoff + m * 2048 + k * 1024); } while (0)
#define PG8_LDB(dst, b, h) do { _Pragma("unroll") for (int n = 0; n < 2; ++n) _Pragma("unroll") for (int k = 0; k < 2; ++k) dst[n][k] = *(const LAS bf16x8*)(lds + PG8_SB(b, h) + boff + n * 2048 + k * 1024); } while (0)
#define PG8_MMA(ai, bj, At, Bt) do { __builtin_amdgcn_s_setprio(1); _Pragma("unroll") for (int m = 0; m < 4; ++m) _Pragma("unroll") for (int n = 0; n < 2; ++n) _Pragma("unroll") for (int k = 0; k < 2; ++k) \
        acc[ai][bj][m][n] = __builtin_amdgcn_mfma_f32_16x16x32_bf16(Bt[n][k], At[m][k], acc[ai][bj][m][n], 0, 0, 0); __builtin_amdgcn_s_setprio(0); } while (0)
#define PG8_WAIT_V(n) asm volatile("s_waitcnt vmcnt(" #n ")" ::: "memory")
#define PG8_WAIT_L(n) asm volatile("s_waitcnt lgkmcnt(" #n ")" ::: "memory")
#define PG8_BAR __builtin_amdgcn_s_barrier()
#define PG8_SCHED __builtin_amdgcn_sched_barrier(0)
    Unit cur, nxt; int ui = 0;
    if (!S.next(0, cur)) return;
    f32x4 acc[2][2][4][2];
#pragma unroll
    for (int a = 0; a < 2; ++a)
#pragma unroll
        for (int b = 0; b < 2; ++b)
#pragma unroll
            for (int m = 0; m < 4; ++m)
#pragma unroll
                for (int n = 0; n < 2; ++n) acc[a][b][m][n] = (f32x4){0.f, 0.f, 0.f, 0.f};
    bf16x8 At[4][2], B0[2][2], B1[2][2];
    const char* cA = g.A + (size_t)cur.pm * tstepA; const char* cB = (const char*)g.Bt + (size_t)cur.pn * tstepB;
    {
        PG8_STAGE(PG8_SB(0, 0), cB, voffB); PG8_STAGE(PG8_SB(0, 1), cB + hstepB, voffB); PG8_STAGE(PG8_SA(0, 0), cA + PG8_AOFF(0), voffA); PG8_STAGE(PG8_SA(0, 1), cA + hstepA + PG8_AOFF(0), voffA);
        if (wr == 1) PG8_BAR;
        PG8_WAIT_V(2); PG8_BAR;
        PG8_STAGE(PG8_SB(1, 0), cB + kstep, voffB); PG8_STAGE(PG8_SA(1, 0), cA + PG8_AOFF(1), voffA); PG8_STAGE(PG8_SB(1, 1), cB + hstepB + kstep, voffB);
        PG8_WAIT_V(6); PG8_BAR;
    }
    for (;;) {
        const bool has_next = S.next(ui + 1, nxt);
        const char* nA = has_next ? g.A + (size_t)nxt.pm * tstepA : cA; const char* nB = has_next ? (const char*)g.Bt + (size_t)nxt.pn * tstepB : cB;
        for (int t = 0; t < nt; t += 2) {
            const bool last = (t == nt - 2);
            const char* a1 = cA + PG8_AOFF(t + 1);
            const char* a2 = last ? nA + PG8_AOFF(0) : cA + PG8_AOFF(t + 2); const char* b2 = last ? nB : cB + (size_t)(t + 2) * kstep;
            const char* a3 = last ? nA + PG8_AOFF(1) : cA + PG8_AOFF(t + 3); const char* b3 = b2 + kstep;
            PG8_LDB(B0, 0, 0); PG8_LDB(B1, 0, 1); PG8_SCHED; PG8_LDA(At, 0, 0); PG8_STAGE(PG8_SA(1, 1), a1 + hstepA, voffA);
            PG8_WAIT_V(8); PG8_WAIT_L(0); PG8_BAR; PG8_MMA(0, 0, At, B0); PG8_MMA(0, 1, At, B1); PG8_BAR; PG8_SCHED;
            PG8_LDA(At, 0, 1); PG8_STAGE(PG8_SB(0, 0), b2, voffB); PG8_STAGE(PG8_SB(0, 1), b2 + hstepB, voffB); PG8_STAGE(PG8_SA(0, 0), a2, voffA);
            PG8_WAIT_V(8); PG8_WAIT_L(0); PG8_BAR; PG8_MMA(1, 0, At, B0); PG8_MMA(1, 1, At, B1); PG8_BAR; PG8_SCHED;
            PG8_LDB(B0, 1, 0); PG8_LDB(B1, 1, 1); PG8_SCHED; PG8_LDA(At, 1, 0); PG8_STAGE(PG8_SA(0, 1), a2 + hstepA, voffA);
            PG8_WAIT_V(8); PG8_WAIT_L(0); PG8_BAR; PG8_MMA(0, 0, At, B0); PG8_MMA(0, 1, At, B1); PG8_BAR; PG8_SCHED;
            PG8_LDA(At, 1, 1); PG8_STAGE(PG8_SB(1, 0), b3, voffB); PG8_STAGE(PG8_SB(1, 1), b3 + hstepB, voffB); PG8_STAGE(PG8_SA(1, 0), a3, voffA);
            PG8_WAIT_V(8); PG8_WAIT_L(0); PG8_BAR; PG8_MMA(1, 0, At, B0); PG8_MMA(1, 1, At, B1); PG8_BAR; PG8_SCHED;
        }
        if constexpr (ALIGN_EPI) { if (wr == 0) PG8_BAR; }
        E(acc, cur, wr, wc, fr, fq);
        if (!has_next) break;
#pragma unroll
        for (int a = 0; a < 2; ++a)
#pragma unroll
            for (int b = 0; b < 2; ++b)
#pragma unroll
                for (int m = 0; m < 4; ++m)
#pragma unroll
                    for (int n = 0; n < 2; ++n) acc[a][b][m][n] = (f32x4){0.f, 0.f, 0.f, 0.f};
        cur = nxt; cA = nA; cB = nB; ++ui;
        if constexpr (ALIGN_EPI) { if (wr == 1) PG8_BAR; }
    }
    PG8_WAIT_V(0);
    if constexpr (!ALIGN_EPI) { if (wr == 0) PG8_BAR; }
    PG8_BAR;
#undef PG8_AOFF
#undef PG8_SA
#undef PG8_SB
#undef PG8_STAGE
#undef PG8_LDA
#undef PG8_LDB
#undef PG8_MMA
#undef PG8_WAIT_V
#undef PG8_WAIT_L
#undef PG8_BAR
#undef PG8_SCHED
}
}

constexpr int NWAVES = 8, NTHR = 512;
constexpr int LDS_BYTES = 163840;
struct Args {
    const float* in[27]; float* out; unsigned char* ws; int ph_lo, ph_hi;
};
struct Frame {
    LAS unsigned char* lds; int tid, lane, wave, vcu, G;
};
constexpr int PTRS_OFF = LDS_BYTES - 256;
__device__ __forceinline__ const float* inp(LAS unsigned char* lds, int i) { return *(const float* LAS*)(lds + PTRS_OFF + i * 8); }
__device__ __forceinline__ int seq_row0(int q) { return q == 0 ? 0 : SP + (q - 1) * SS; }
__device__ __forceinline__ int seq_len(int q) { return q == 0 ? SP : SS; }

__device__ __forceinline__ void p0_transpose_item(const float* W, int K, int N, bf16_t* WT, const float* kscale, LAS float* scr, int item, int lane) {
    const int nblk = N / 32, kb = item / nblk, nb = item % nblk, k0 = 64 * kb, n0 = 32 * nb;
#pragma unroll 8
    for (int i = 0; i < 32; ++i) { const int kk = 2 * i + (lane >> 5); float v = W[(size_t)(k0 + kk) * N + n0 + (lane & 31)]; if (kscale) v *= kscale[k0 + kk]; scr[kk * 33 + (lane & 31)] = v; }
    LDS_WAIT(); asm volatile("" ::: "memory");
    const int c = lane & 7;
#pragma unroll
    for (int j = 0; j < 4; ++j) { const int n = (lane >> 3) + 8 * j; const LAS float* s = scr + (8 * c) * 33 + n;
        u32x4 o; o.x = cvt_pk_bf16(s[0 * 33], s[1 * 33]); o.y = cvt_pk_bf16(s[2 * 33], s[3 * 33]); o.z = cvt_pk_bf16(s[4 * 33], s[5 * 33]); o.w = cvt_pk_bf16(s[6 * 33], s[7 * 33]);
        *(u32x4*)(WT + (size_t)(n0 + n) * K + k0 + 8 * c) = o; }
    LDS_WAIT(); asm volatile("" ::: "memory");
}
__device__ __forceinline__ void p0_prologue(const Frame& F, const Args& a) {
    LAS float* scr = (LAS float*)(F.lds + F.wave * 16384);
    const int gw = F.vcu * NWAVES + F.wave, NGW = F.G * NWAVES;
    unsigned char* ws = a.ws;
    constexpr int I_IN = (DM / 64) * (ZP / 32), I_O = (DM / 64) * (DM / 32), I_1 = (DM / 64) * (DFF / 32), I_2 = (DFF / 64) * (DM / 32);
    for (int it = gw; it < I_IN + I_O + I_1 + I_2; it += NGW) {
        int r = it;
        if (r < I_IN) { p0_transpose_item(a.in[3], DM, ZP, (bf16_t*)(ws + WS_WIN), nullptr, scr, r, F.lane); continue; } r -= I_IN;
        if (r < I_O) { p0_transpose_item(a.in[23], DM, DM, (bf16_t*)(ws + WS_WOUT), nullptr, scr, r, F.lane); continue; } r -= I_O;
        if (r < I_1) { p0_transpose_item(a.in[25], DM, DFF, (bf16_t*)(ws + WS_W1), a.in[24], scr, r, F.lane); continue; } r -= I_1;
        p0_transpose_item(a.in[26], DFF, DM, (bf16_t*)(ws + WS_W2), nullptr, scr, r, F.lane);
    }
    bf16_t* XN = (bf16_t*)a.out; const float* g1 = a.in[2];
    for (int m = gw; m < MTOK; m += NGW) {
        const float* xrow = m < SP ? a.in[0] + (size_t)m * DM : a.in[1] + (size_t)(m - SP) * DM;
        const f32x4* xr = (const f32x4*)xrow + F.lane; f32x4 v[4]; float s = 0.f;
#pragma unroll
        for (int j = 0; j < 4; ++j) { v[j] = xr[64 * j]; s += (v[j][0] * v[j][0] + v[j][1] * v[j][1]) + (v[j][2] * v[j][2] + v[j][3] * v[j][3]); }
        const float rstd = 1.0f / sqrtf(wave_sum(s) * (1.f / DM) + NORM_EPS);
        u32x2* o8 = (u32x2*)(XN + (size_t)m * DM) + F.lane;
#pragma unroll
        for (int j = 0; j < 4; ++j) { const f32x4 gv = ((const f32x4*)g1)[F.lane + 64 * j]; u32x2 w; w.x = cvt_pk_bf16(v[j][0] * rstd * gv[0], v[j][1] * rstd * gv[1]); w.y = cvt_pk_bf16(v[j][2] * rstd * gv[2], v[j][3] * rstd * gv[3]); o8[64 * j] = w; }
    }
    const int gt = F.vcu * NTHR + F.tid, NGT = F.G * NTHR;
    float* rope = (float*)(ws + WS_ROPE);
    for (int e = gt; e < SP * 32; e += NGT) { const int pos = e >> 5, i = e & 31;
        const float invf = 1.0f / powf(10000.0f, (float)(2 * i) / 64.0f); const float ang = (float)pos * invf; float sn, cs; sincosf(ang, &sn, &cs);
        rope[2 * e] = cs; rope[2 * e + 1] = sn; }
    bf16_t* wupT = (bf16_t*)(ws + WS_LORA); bf16_t* aupT = wupT + 2 * 512 * 64; bf16_t* gupT = aupT + 2 * 512 * 64;
    for (int e = gt; e < 2 * 512 * 64; e += NGT) { const int d = e >> 15, c = (e >> 6) & 511, r = e & 63;
        wupT[e] = f2bf(a.in[14][((size_t)d * 64 + r) * 512 + c]); aupT[e] = f2bf(a.in[16][((size_t)d * 64 + r) * 512 + c]); }
    for (int e = gt; e < 512 * 128; e += NGT) { const int c = e >> 7, r = e & 127; gupT[e] = f2bf(a.in[17][(size_t)r * 512 + c]); }
}

__device__ __forceinline__ void qk_prep(const Frame& F, const Args& a) {
    const int gw = F.vcu * NWAVES + F.wave, NGW = F.G * NWAVES;
    bf16_t* Z = (bf16_t*)(a.ws + WS_Z); const float* rope = (const float*)(a.ws + WS_ROPE);
    const int g = F.lane >> 2, qd = F.lane & 3;
    const float* gain = (g < 8) ? a.in[4] : a.in[5];
    float glo[8], ghi[8];
#pragma unroll
    for (int j = 0; j < 8; ++j) { glo[j] = gain[8 * qd + j]; ghi[j] = gain[32 + 8 * qd + j]; }
    const float osc = (g < 8) ? QSCALE : 1.0f;
#pragma unroll 4
    for (int m = gw; m < MTOK; m += NGW) {
        const int pos = m < SP ? m : ((m - SP) & (SS - 1));
        bf16_t* p = Z + (size_t)m * ZP + g * 64 + 8 * qd;
        const u32x4 lo4 = *(const u32x4*)p, hi4 = *(const u32x4*)(p + 32);
        float lo[8], hi[8];
#pragma unroll
        for (int j = 0; j < 4; ++j) { lo[2 * j] = bflo(lo4[j]); lo[2 * j + 1] = bfhi(lo4[j]); hi[2 * j] = bflo(hi4[j]); hi[2 * j + 1] = bfhi(hi4[j]); }
        float ss = 0.f;
#pragma unroll
        for (int j = 0; j < 8; ++j) ss += lo[j] * lo[j] + hi[j] * hi[j];
        ss += __shfl_xor(ss, 1); ss += __shfl_xor(ss, 2);
        const float rstd = __builtin_amdgcn_rsqf(ss * (1.f / 64.f) + NORM_EPS);
        const f32x4* rp = (const f32x4*)(rope + ((size_t)pos * 32 + 8 * qd) * 2);
        float ol[8], oh[8];
#pragma unroll
        for (int j2 = 0; j2 < 4; ++j2) { const f32x4 cs = rp[j2];
#pragma unroll
            for (int e = 0; e < 2; ++e) { const int j = 2 * j2 + e; const float c = cs[2 * e], s = cs[2 * e + 1]; const float l = lo[j] * rstd * glo[j], h = hi[j] * rstd * ghi[j];
                ol[j] = (l * c - h * s) * osc; oh[j] = (h * c + l * s) * osc; } }
        u32x4 wl, wh;
#pragma unroll
        for (int j = 0; j < 4; ++j) { wl[j] = cvt_pk_bf16(ol[2 * j], ol[2 * j + 1]); wh[j] = cvt_pk_bf16(oh[2 * j], oh[2 * j + 1]); }
        *(u32x4*)p = wl; *(u32x4*)(p + 32) = wh;
    }
}

namespace att {
constexpr int KSLOT = 8192, VSLOT = 16384, NKS = 4, NVS = 3;
constexpr int L_K = 0, L_V = NKS * KSLOT, L_WS = L_V + NVS * VSLOT, L_ST = L_WS + NWAVES * 256, L_END = L_ST + NWAVES * 8192;
static_assert(L_END <= PTRS_OFF, "attention lds");
__device__ __forceinline__ int crow(int r, int hi) { return (r & 3) + 8 * (r >> 2) + 4 * hi; }
__device__ __forceinline__ void glds16(const void* gsrc, unsigned lds_dst) { unsigned keep;
    asm volatile("s_mov_b32 %0, m0\n\ts_mov_b32 m0, %2\n\ts_nop 0\n\tglobal_load_lds_dwordx4 %1, off\n\ts_mov_b32 m0, %0" : "=&s"(keep) : "v"(gsrc), "s"(lds_dst) : "memory"); }
typedef short v4i16_t __attribute__((ext_vector_type(4)));
typedef const LAS char* lds_cptr;
__device__ __forceinline__ s16x4 vtr(lds_cptr p) { return __builtin_bit_cast(s16x4, __builtin_amdgcn_ds_read_tr16_b64_v4i16((LAS v4i16_t*)p)); }
#define SBAR() __builtin_amdgcn_sched_barrier(0)
#define WAIT_BAR(N) asm volatile("s_waitcnt vmcnt(" #N ") lgkmcnt(0)\n\ts_barrier" ::: "memory")
__device__ __forceinline__ void kload8(bf16x8* kf, lds_cptr kp) {
    kf[0] = *(const LAS bf16x8*)(kp);        kf[1] = *(const LAS bf16x8*)(kp + 512);
    kf[2] = *(const LAS bf16x8*)(kp + 2048); kf[3] = *(const LAS bf16x8*)(kp + 2560);
    kf[4] = *(const LAS bf16x8*)(kp + 4096); kf[5] = *(const LAS bf16x8*)(kp + 4608);
    kf[6] = *(const LAS bf16x8*)(kp + 6144); kf[7] = *(const LAS bf16x8*)(kp + 6656);
}
__device__ __forceinline__ void kload2(bf16x8* kf, lds_cptr kp, int j) { kf[2 * j] = *(const LAS bf16x8*)(kp + j * 2048); kf[2 * j + 1] = *(const LAS bf16x8*)(kp + j * 2048 + 512); }

__device__ __forceinline__ void attn_unit(int row0, int S, int h, int qb, bf16_t* Z, LAS unsigned char* shm, float lam, const float* subln_g, bf16_t* Ob, int opitch) {
    int tid_ = threadIdx.x; asm volatile("" : "+v"(tid_));
    const int tid = tid_, lane = tid & 63, r32 = lane & 31, hi = lane >> 5; const int wid = __builtin_amdgcn_readfirstlane(tid >> 6);
    const unsigned lds0 = (unsigned)(uintptr_t)shm;
    LAS float* wsf = (LAS float*)(shm + L_WS) + wid * 64;
    LAS bf16_t* stash = (LAS bf16_t*)(shm + L_ST) + wid * 4096;
    const int NT = S / 64;
    const size_t qrow = (size_t)(row0 + qb * 256 + wid * 32);
    const lds_cptr shm3 = (lds_cptr)shm;
    const lds_cptr kp0 = shm3 + L_K + hi * 1024 + r32 * 16;
    const lds_cptr vp0 = shm3 + L_V + ((lane >> 4) & 1) * 32 + (lane & 3) * 8 + (4 * hi + ((lane & 15) >> 2)) * 64;
    f32x16 o[4];
#pragma unroll 1
    for (int c = 0; c < 2; ++c) {
        const bf16_t* Qw = Z + qrow * ZP + ZQ + h * 128 + c * 64;
        const bf16_t* Kh = Z + (size_t)row0 * ZP + ZK + h * 128 + c * 64;
        const bf16_t* Vh = Z + (size_t)row0 * ZP + ZV + h * 128;
        const int p0 = 2 * wid, p1 = 2 * wid + 1;
        const unsigned koff = (unsigned)(lane * ZP + wid * 8) * 2u;
        const unsigned voff0 = (unsigned)((16 * (p0 & 3) + (lane >> 2)) * ZP + (p0 >> 2) * 32 + (lane & 3) * 8) * 2u;
        const unsigned voff1 = (unsigned)((16 * (p1 & 3) + (lane >> 2)) * ZP + (p1 >> 2) * 32 + (lane & 3) * 8) * 2u;
        const unsigned kdst = lds0 + L_K + wid * 1024, vdst0 = lds0 + L_V + p0 * 1024, vdst1 = lds0 + L_V + p1 * 1024;
#define DMA_K(t, si) glds16((const char*)(Kh + (size_t)(t) * 64 * ZP) + koff, (unsigned)__builtin_amdgcn_readfirstlane(kdst + (si) * KSLOT))
#define DMA_V(t, si) do { const char* vb_ = (const char*)(Vh + (size_t)(t) * 64 * ZP); glds16(vb_ + voff0, (unsigned)__builtin_amdgcn_readfirstlane(vdst0 + (si) * VSLOT)); glds16(vb_ + voff1, (unsigned)__builtin_amdgcn_readfirstlane(vdst1 + (si) * VSLOT)); } while (0)
        DMA_K(0, 0); DMA_V(0, 0); DMA_K(1, 1);
        bf16x8 qr[4];
#pragma unroll
        for (int d0 = 0; d0 < 4; ++d0) qr[d0] = *(const bf16x8*)(Qw + (size_t)r32 * ZP + d0 * 16 + hi * 8);
#pragma unroll
        for (int d0 = 0; d0 < 4; ++d0) o[d0] = f32x16{};
        float l_reg = 0.f;
        bf16x8 kf[4];
        f32x16 pA0, pA1, pB0, pB1;
        int i_prev = 0, i_cur = 0, i_next = 1;
        int k_cur = 0, k_next = 1;
#define ROT() do { i_prev = i_cur; i_cur = i_next; i_next = (i_next == NVS - 1) ? 0 : i_next + 1; k_cur = k_next; k_next = (k_next + 1) & 3; } while (0)
#define KFRAG(slot, i) (*(const LAS bf16x8*)(kp0 + (slot) * KSLOT + ((i) >> 1) * 2048 + ((i) & 1) * 512))
        DMA_K(2, 2);
        WAIT_BAR(4);
        {
            const lds_cptr kb = kp0;
            pA0 = f32x16{}; pA1 = f32x16{};
#pragma unroll
            for (int d0 = 0; d0 < 4; ++d0) { const bf16x8 b0 = *(const LAS bf16x8*)(kb + d0 * 2048), b1 = *(const LAS bf16x8*)(kb + d0 * 2048 + 512);
                pA0 = __builtin_amdgcn_mfma_f32_32x32x16_bf16(b0, qr[d0], pA0, 0, 0, 0); pA1 = __builtin_amdgcn_mfma_f32_32x32x16_bf16(b1, qr[d0], pA1, 0, 0, 0); }
#pragma unroll
            for (int r = 0; r < 16; ++r) { pA0[r] = __builtin_amdgcn_exp2f(pA0[r]); pA1[r] = __builtin_amdgcn_exp2f(pA1[r]); }
        }
        WAIT_BAR(0);
        DMA_K(3, 3); DMA_V(1, 1);
        ROT();
        kf[0] = KFRAG(k_cur, 0); kf[1] = KFRAG(k_cur, 1); kf[2] = KFRAG(k_cur, 2); kf[3] = KFRAG(k_cur, 3);
        WAIT_BAR(3);
        s16x4 vlo[4], vhi[4]; u32x4 pw0, pw1, pw2, pw3;
#define PKW(P, B) cvt_pk_bf16(P[B], P[B + 1])
#define PAF(k) __builtin_bit_cast(bf16x8, pw##k)
#define VFR(i) (bf16x8){vlo[i][0], vlo[i][1], vlo[i][2], vlo[i][3], vhi[i][0], vhi[i][1], vhi[i][2], vhi[i][3]}
#define PIN(x) asm volatile("" : "+v"(x))
#define EX(v) __builtin_amdgcn_exp2f(v)
#define VRD(slot, f) do { vlo[slot] = vtr(vp_ + (((f) & 3) * 4096 + ((f) >> 2) * 1024)); vhi[slot] = vtr(vp_ + (((f) & 3) * 4096 + ((f) >> 2) * 1024 + 512)); } while (0)
#define GAPA(MF, LDX, A0, A1, A2, A3, W0, W1, PW) do { MF; LDX; sacc += A0; sacc += A1; sacc += A2; sacc += A3; PIN(sacc); W0; W1; PIN(PW); SBAR(); } while (0)
#define GAPB(MF, LDX, X, B) do { MF; LDX; X[B] = EX(X[B]); X[B + 1] = EX(X[B + 1]); PIN(X); SBAR(); } while (0)
#define PVM(f) o[(f) & 3] = __builtin_amdgcn_mfma_f32_32x32x16_bf16(__builtin_bit_cast(bf16x8, (f) < 4 ? pw0 : (f) < 8 ? pw1 : (f) < 12 ? pw2 : pw3), VFR((f) & 3), o[(f) & 3], 0, 0, 0)
#define NOP_ do { } while (0)
#define STEP(C0, C1, P0, P1, t, GK, GV, GL) do { SBAR(); \
        const lds_cptr vp_ = vp0 + i_prev * VSLOT; \
        float sacc = (P0[0] + P0[1]); \
        GAPA(C0 = __builtin_amdgcn_mfma_f32_32x32x16_bf16(kf[0], qr[0], (f32x16){}, 0, 0, 0), kf[0] = KFRAG(k_cur, 4), P0[2], P0[3], P0[4], P0[5],     pw0[0] = PKW(P0, 0), pw0[1] = PKW(P0, 2), pw0); \
        GAPA(C1 = __builtin_amdgcn_mfma_f32_32x32x16_bf16(kf[1], qr[0], (f32x16){}, 0, 0, 0), kf[1] = KFRAG(k_cur, 5), P0[6], P0[7], P0[8], P0[9],     pw0[2] = PKW(P0, 4), pw0[3] = PKW(P0, 6), pw0); \
        GAPA(C0 = __builtin_amdgcn_mfma_f32_32x32x16_bf16(kf[2], qr[1], C0, 0, 0, 0),         kf[2] = KFRAG(k_cur, 6), P0[10], P0[11], P0[12], P0[13], pw1[0] = PKW(P0, 8), pw1[1] = PKW(P0, 10), pw1); \
        GAPA(C1 = __builtin_amdgcn_mfma_f32_32x32x16_bf16(kf[3], qr[1], C1, 0, 0, 0),         kf[3] = KFRAG(k_cur, 7), P0[14], P0[15], P1[0], P1[1],   pw1[2] = PKW(P0, 12), pw1[3] = PKW(P0, 14), pw1); \
        GAPA(C0 = __builtin_amdgcn_mfma_f32_32x32x16_bf16(kf[0], qr[2], C0, 0, 0, 0),         VRD(0, 0), P1[2], P1[3], P1[4], P1[5],     pw2[0] = PKW(P1, 0), pw2[1] = PKW(P1, 2), pw2); \
        GAPA(C1 = __builtin_amdgcn_mfma_f32_32x32x16_bf16(kf[1], qr[2], C1, 0, 0, 0),         VRD(1, 1), P1[6], P1[7], P1[8], P1[9],     pw2[2] = PKW(P1, 4), pw2[3] = PKW(P1, 6), pw2); \
        GAPA(C0 = __builtin_amdgcn_mfma_f32_32x32x16_bf16(kf[2], qr[3], C0, 0, 0, 0),         VRD(2, 2), P1[10], P1[11], P1[12], P1[13], pw3[0] = PKW(P1, 8), pw3[1] = PKW(P1, 10), pw3); \
        GAPA(C1 = __builtin_amdgcn_mfma_f32_32x32x16_bf16(kf[3], qr[3], C1, 0, 0, 0),         VRD(3, 3), P1[14], P1[15], 0.f, 0.f,       pw3[2] = PKW(P1, 12), pw3[3] = PKW(P1, 14), pw3); \
        l_reg += sacc; \
        if (GK) { DMA_K((t) + 3, (k_cur + 3) & 3); } if (GV) { DMA_V((t) + 1, i_next); } \
        SBAR(); \
        GAPB(PVM(0), VRD(0, 4), C0, 0);   GAPB(PVM(1), VRD(1, 5), C0, 2);   GAPB(PVM(2), VRD(2, 6), C0, 4);    GAPB(PVM(3), VRD(3, 7), C0, 6); \
        GAPB(PVM(4), VRD(0, 8), C0, 8);   GAPB(PVM(5), VRD(1, 9), C0, 10);  GAPB(PVM(6), VRD(2, 10), C0, 12);  GAPB(PVM(7), VRD(3, 11), C0, 14); \
        GAPB(PVM(8), VRD(0, 12), C1, 0);  GAPB(PVM(9), VRD(1, 13), C1, 2);  GAPB(PVM(10), VRD(2, 14), C1, 4);  GAPB(PVM(11), VRD(3, 15), C1, 6); \
        GAPB(PVM(12), if (GL) kf[0] = KFRAG(k_next, 0), C1, 8);  GAPB(PVM(13), if (GL) kf[1] = KFRAG(k_next, 1), C1, 10); \
        GAPB(PVM(14), if (GL) kf[2] = KFRAG(k_next, 2), C1, 12); GAPB(PVM(15), if (GL) kf[3] = KFRAG(k_next, 3), C1, 14); \
        } while (0)
        int t = 1;
#pragma unroll 1
        for (; t + 5 < NT; t += 2) {
            STEP(pB0, pB1, pA0, pA1, t, true, true, true);     WAIT_BAR(3); ROT();
            STEP(pA0, pA1, pB0, pB1, t + 1, true, true, true); WAIT_BAR(3); ROT();
        }
#define ENDW(tt) do { if ((tt) + 3 < NT) { WAIT_BAR(3); } else if ((tt) + 2 < NT) { WAIT_BAR(2); } else { WAIT_BAR(0); } } while (0)
#pragma unroll 1
        for (; t + 1 < NT; t += 2) {
            STEP(pB0, pB1, pA0, pA1, t, (t + 3 < NT), (t + 1 < NT), (t + 1 < NT));         ENDW(t);     ROT();
            STEP(pA0, pA1, pB0, pB1, t + 1, (t + 4 < NT), (t + 2 < NT), (t + 2 < NT));     ENDW(t + 1); ROT();
        }
        STEP(pB0, pB1, pA0, pA1, NT - 1, false, false, false);
        {
            float sacc = pB0[0] + pB0[1];
#pragma unroll
            for (int r = 2; r < 16; ++r) sacc += pB0[r];
#pragma unroll
            for (int r = 0; r < 16; ++r) sacc += pB1[r];
            l_reg += sacc;
            pw0 = (u32x4){PKW(pB0, 0), PKW(pB0, 2), PKW(pB0, 4), PKW(pB0, 6)}; pw1 = (u32x4){PKW(pB0, 8), PKW(pB0, 10), PKW(pB0, 12), PKW(pB0, 14)};
            pw2 = (u32x4){PKW(pB1, 0), PKW(pB1, 2), PKW(pB1, 4), PKW(pB1, 6)}; pw3 = (u32x4){PKW(pB1, 8), PKW(pB1, 10), PKW(pB1, 12), PKW(pB1, 14)};
            const lds_cptr vp_ = vp0 + i_cur * VSLOT;
            VRD(0, 0); VRD(1, 1); VRD(2, 2); VRD(3, 3); PVM(0); PVM(1); PVM(2); PVM(3);
            VRD(0, 4); VRD(1, 5); VRD(2, 6); VRD(3, 7); PVM(4); PVM(5); PVM(6); PVM(7);
            VRD(0, 8); VRD(1, 9); VRD(2, 10); VRD(3, 11); PVM(8); PVM(9); PVM(10); PVM(11);
            VRD(0, 12); VRD(1, 13); VRD(2, 14); VRD(3, 15); PVM(12); PVM(13); PVM(14); PVM(15);
        }
#undef DMA_K
#undef DMA_V
#undef ROT
#undef PKW
#undef PAF
#undef VFR
#undef PIN
#undef EX
#undef VRD
#undef GAPA
#undef GAPB
#undef KFRAG
#undef NOP_
#undef PVM
#undef STEP
#undef ENDW
        { auto rr = __builtin_amdgcn_permlane32_swap(__float_as_uint(l_reg), __float_as_uint(l_reg), false, false); l_reg = __uint_as_float(rr[0]) + __uint_as_float(rr[1]); }
        if (hi == 0) wsf[r32] = l_reg;
        LDS_WAIT();
        float rli[16];
#pragma unroll
        for (int r = 0; r < 16; ++r) rli[r] = 1.0f / wsf[crow(r, hi)];
        if (c == 0) {
#pragma unroll
            for (int d0 = 0; d0 < 4; ++d0)
#pragma unroll
                for (int r = 0; r < 16; ++r) stash[(d0 * 16 + r) * 64 + lane] = f2bf(o[d0][r] * rli[r]);
            LDS_WAIT();
        } else {
#pragma unroll
            for (int d0 = 0; d0 < 4; ++d0)
#pragma unroll
                for (int r = 0; r < 16; ++r) o[d0][r] = bf2f(stash[(d0 * 16 + r) * 64 + lane]) - lam * (o[d0][r] * rli[r]);
            LDS_WAIT(); asm volatile("" ::: "memory");
#pragma unroll
            for (int d0 = 0; d0 < 4; ++d0)
#pragma unroll
                for (int r = 0; r < 16; ++r) stash[crow(r, hi) * 128 + d0 * 32 + r32] = f2bf(o[d0][r]);
            LDS_WAIT(); asm volatile("" ::: "memory");
            bf16_t* Ow = Ob + qrow * opitch + ZQ + h * 128;
#pragma unroll
            for (int i = 0; i < 4; ++i) { const int row = i * 8 + (lane >> 3), ch = lane & 7;
                const u32x4 w0 = *(const LAS u32x4*)(stash + row * 128 + ch * 16), w1 = *(const LAS u32x4*)(stash + row * 128 + ch * 16 + 8);
                float v[16];
#pragma unroll
                for (int j = 0; j < 4; ++j) { v[2 * j] = bflo(w0[j]); v[2 * j + 1] = bfhi(w0[j]); v[8 + 2 * j] = bflo(w1[j]); v[9 + 2 * j] = bfhi(w1[j]); }
                float ss = 0.f;
#pragma unroll
                for (int j = 0; j < 16; ++j) ss += v[j] * v[j];
                ss += __shfl_xor(ss, 1); ss += __shfl_xor(ss, 2); ss += __shfl_xor(ss, 4);
                const float rs = (1.0f - LAMBDA_INIT) / sqrtf(ss * (1.f / 128.f) + NORM_EPS);
                u32x4 x0, x1;
#pragma unroll
                for (int j = 0; j < 4; ++j) { x0[j] = cvt_pk_bf16(v[2 * j] * rs * subln_g[ch * 16 + 2 * j], v[2 * j + 1] * rs * subln_g[ch * 16 + 2 * j + 1]);
                                              x1[j] = cvt_pk_bf16(v[8 + 2 * j] * rs * subln_g[ch * 16 + 8 + 2 * j], v[9 + 2 * j] * rs * subln_g[ch * 16 + 9 + 2 * j]); }
                *(u32x4*)(Ow + (size_t)row * opitch + ch * 16) = x0; *(u32x4*)(Ow + (size_t)row * opitch + ch * 16 + 8) = x1; }
            LDS_WAIT();
        }
        asm volatile("s_waitcnt vmcnt(0) lgkmcnt(0)\n\ts_barrier" ::: "memory");
    }
}
#undef SBAR
#undef WAIT_BAR
}

namespace rw {
constexpr int P = 144, MAT = 64 * P;
constexpr int O_AT = 0, O_RT = MAT, O_BT = 2 * MAT, O_KT = 3 * MAT, O_ATT = 4 * MAT, O_VT = 5 * MAT, O_BHT = 6 * MAT, O_KHT = 7 * MAT;
constexpr int O_LAB = 8 * MAT, O_LAK = 9 * MAT, O_ARB = 10 * MAT, O_ARK = 11 * MAT, O_XT = 12 * MAT, O_ABT = 13 * MAT, O_U0T = 14 * MAT;
constexpr int O_LABD = 15 * MAT, O_TII = O_LABD + 4096, O_WC = O_TII + 2048, O_GSUM = O_WC + 256, O_END = O_GSUM + 2048;
constexpr int O_ZS = 0;
constexpr int O_TW = O_LAB, O_ADN = O_LAK, O_WL = O_ARB, O_AR = O_XT, PF = 272;
static_assert(O_END <= LDS_BYTES && 64 * PF <= 2 * MAT, "rwkv lds");
__device__ __forceinline__ int crow(int r, int hi) { return (r & 3) + 8 * (r >> 2) + 4 * hi; }
__device__ __forceinline__ float sigmoidf_(float x) { return __builtin_amdgcn_rcpf(1.0f + __expf(-x)); }
__device__ __forceinline__ float tanhf_(float x) { return 1.0f - 2.0f * __builtin_amdgcn_rcpf(__expf(2.0f * x) + 1.0f); }
__device__ __forceinline__ void load10(const bf16_t* zc, int t_lo, int S, float (&z)[10]) {
#pragma unroll
    for (int i = 0; i < 10; ++i) { const int t = t_lo - 1 + i; z[i] = (t >= 0 && t < S) ? bf2f(zc[(size_t)t * ZP]) : 0.f; }
}
__device__ __forceinline__ float tshift(const float (&z)[10], int u, float mp, float mn) { const float c = z[u + 1]; return c + mp * (z[u] - c) + mn * (z[u + 2] - c); }
__device__ __forceinline__ f32x16 mm_ll(const LAS unsigned char* A, int rowA, const LAS unsigned char* B, int rowB, f32x16 acc, int r32, int hi) {
#pragma unroll
    for (int ks = 0; ks < 4; ++ks) { const bf16x8 a = *(const LAS bf16x8*)(A + (rowA + r32) * P + (16 * ks + 8 * hi) * 2), b = *(const LAS bf16x8*)(B + (rowB + r32) * P + (16 * ks + 8 * hi) * 2);
        acc = __builtin_amdgcn_mfma_f32_32x32x16_bf16(a, b, acc, 0, 0, 0); }
    return acc;
}
__device__ __forceinline__ void store_native(unsigned char* dst, const f32x16& acc, int lane) {
    u32x4 w0, w1;
#pragma unroll
    for (int q = 0; q < 4; ++q) { w0[q] = cvt_pk_bf16(acc[2 * q], acc[2 * q + 1]); w1[q] = cvt_pk_bf16(acc[8 + 2 * q], acc[9 + 2 * q]); }
    *(u32x4*)(dst + lane * 32) = w0; *(u32x4*)(dst + lane * 32 + 16) = w1;
}
__device__ __forceinline__ void st4(LAS unsigned char* p, float a, float b, float c, float d) { u32x2 w; w.x = cvt_pk_bf16(a, b); w.y = cvt_pk_bf16(c, d); *(LAS u32x2*)p = w; }

__device__ __forceinline__ void s1_stage_load(const Args& a, int tid, int q, int h, int ck, u32x4 (&v)[6]) {
    const int row0 = seq_row0(q), S = seq_len(q), t0 = ck * 64;
    const bf16_t* Zs = (const bf16_t*)(a.ws + WS_Z) + (size_t)row0 * ZP;
#pragma unroll
    for (int k = 0; k < 6; ++k) { const int c = tid + k * NTHR; const int seg = c >> 3, part = c & 7, row = seg / 5, grp = seg - row * 5, t = t0 - 1 + row;
        const int colb = grp < 3 ? ZRR + grp * 512 + h * 64 : (grp == 3 ? ZWD : ZAD);
        v[k] = (u32x4){0u, 0u, 0u, 0u};
        if (c < 66 * 5 * 8 && t >= 0 && t < S) v[k] = *(const u32x4*)(Zs + (size_t)t * ZP + colb + part * 8); }
}
__device__ __forceinline__ void s1_item(const Frame& F, const Args& a, int d, int q, int h, int ck, unsigned char* slot, u32x4 (&stg)[6], bool has_next, int nq, int nh, int nck) {
    LAS unsigned char* L = F.lds;
    int lane_ = F.lane; asm volatile("" : "+v"(lane_));
    const int lane = lane_, w = F.wave, tid = w * 64 + lane, r32 = lane & 31, hi = lane >> 5;
    const int j = lane, tg = w;
    const int row0 = seq_row0(q), S = seq_len(q), t0 = ck * 64;
    const bf16_t* Zs = (const bf16_t*)(a.ws + WS_Z) + (size_t)row0 * ZP;
    const int t_lo = d == 0 ? t0 + 8 * tg : t0 + 56 - 8 * tg;
    const int tau0 = 8 * tg;
#define TAU(u) (d == 0 ? tau0 + (u) : tau0 + 7 - (u))
    const float* mup = inp(L, 11); const float* mun = inp(L, 12);
    const int ch = h * 64 + j;
    bf16x8 wfr[4];
    { const int which = w >> 2, mt = (w >> 1) & 1;
      const bf16_t* WT = (const bf16_t*)(a.ws + WS_LORA) + (which ? 2 * 512 * 64 : 0) + ((size_t)d * 512 + h * 64 + 32 * mt + r32) * 64;
#pragma unroll
      for (int ks = 0; ks < 4; ++ks) wfr[ks] = *(const bf16x8*)(WT + 16 * ks + 8 * hi); }
    {
#pragma unroll
        for (int k = 0; k < 6; ++k) { const int c = tid + k * NTHR; const int seg = c >> 3, part = c & 7, row = seg / 5, grp = seg - row * 5;
            if (c < 66 * 5 * 8) *(LAS u32x4*)(L + O_ZS + (grp * 66 + row) * P + part * 16) = stg[k]; }
    }
    __syncthreads();
    if (has_next) s1_stage_load(a, tid, nq, nh, nck, stg);
    const LAS unsigned char* zsb = L + O_ZS + (t_lo - t0) * P + j * 2;
#define LD10(z, g) do { _Pragma("unroll") for (int i_ = 0; i_ < 10; ++i_) z[i_] = bf2f(*(const LAS bf16_t*)(zsb + ((g) * 66 + i_) * P)); } while (0)
    {
        float zw[10], za[10]; LD10(zw, 3); LD10(za, 4);
        const float mpw = mup[ZWD - ZRR + j], mnw = mun[ZWD - ZRR + j], mpa = mup[ZAD - ZRR + j], mna = mun[ZAD - ZRR + j];
#pragma unroll
        for (int u = 0; u < 8; ++u) { const int tau = TAU(u);
            *(LAS bf16_t*)(L + O_TW + tau * P + j * 2) = f2bf(tanhf_(tshift(zw, u, mpw, mnw)));
            *(LAS bf16_t*)(L + O_ADN + tau * P + j * 2) = f2bf(tshift(za, u, mpa, mna)); }
    }
    __syncthreads();
    {
        const int which = w >> 2, mt = (w >> 1) & 1, nt = w & 1;
        const LAS unsigned char* B = L + (which ? O_ADN : O_TW);
        f32x16 acc = f32x16{};
#pragma unroll
        for (int ks = 0; ks < 4; ++ks) { const bf16x8 bv = *(const LAS bf16x8*)(B + (32 * nt + r32) * P + (16 * ks + 8 * hi) * 2);
            acc = __builtin_amdgcn_mfma_f32_32x32x16_bf16(wfr[ks], bv, acc, 0, 0, 0); }
        const float* bias = (which ? inp(L, 15) : inp(L, 13)) + d * 512 + h * 64 + 32 * mt;
        LAS unsigned char* O = L + (which ? O_AR : O_WL) + (32 * nt + r32) * PF;
#pragma unroll
        for (int g = 0; g < 4; ++g) { const int jj = 8 * g + 4 * hi; const f32x4 bv = *(const f32x4*)(bias + jj);
            *(LAS f32x4*)(O + (32 * mt + jj) * 4) = (f32x4){acc[4 * g] + bv[0], acc[4 * g + 1] + bv[1], acc[4 * g + 2] + bv[2], acc[4 * g + 3] + bv[3]}; }
    }
    __syncthreads();
    float aa[8], bb[8], rr[8], kd[8], vv[8], ld[8];
    {
        float zr[10], zk[10], zv[10]; LD10(zr, 0); LD10(zk, 1); LD10(zv, 2);
        const float mpr = mup[ch], mnr = mun[ch], mpk = mup[512 + ch], mnk = mun[512 + ch], mpv = mup[1024 + ch], mnv = mun[1024 + ch];
        const float kkc = inp(L, 18)[ch], kac = inp(L, 19)[ch], rkc = inp(L, 20)[ch];
        float* bon = (float*)(a.ws + WS_BONUS) + ((size_t)d * MTOK + row0) * 8 + h;
#pragma unroll
        for (int u = 0; u < 8; ++u) { const int tau = TAU(u);
            const float wl = *(const LAS float*)(L + O_WL + tau * PF + j * 4), ar = *(const LAS float*)(L + O_AR + tau * PF + j * 4);
            ld[u] = -0.6065306597126334f * sigmoidf_(wl); const float arate = sigmoidf_(ar);
            rr[u] = tshift(zr, u, mpr, mnr); const float k0 = tshift(zk, u, mpk, mnk); vv[u] = tshift(zv, u, mpv, mnv);
            const float kkr = k0 * kkc; const float ssq = wave_sum_dpp(kkr * kkr); const float kkn = kkr * __builtin_amdgcn_rsqf(ssq + 1e-12f);
            kd[u] = k0 * (1.0f + (arate - 1.0f) * kac); aa[u] = -kkn; bb[u] = kkn * arate;
            const float bsum = wave_sum_dpp(rr[u] * kd[u] * rkc);
            if (lane == 0) bon[(size_t)(t_lo + u) * 8] = bsum; }
        float tot = 0.f;
#pragma unroll
        for (int u = 0; u < 8; ++u) tot += ld[u];
        *(LAS float*)(L + O_GSUM + tg * 256 + j * 4) = tot;
    }
    __syncthreads();
    {
        float pre = 0.f, cC = 0.f;
#pragma unroll
        for (int g = 0; g < 8; ++g) { const float s = *(const LAS float*)(L + O_GSUM + g * 256 + j * 4); cC += s; if (g < tg) pre += s; }
        float tot = 0.f;
#pragma unroll
        for (int u = 0; u < 8; ++u) tot += ld[u];
        float At[8], Vt[8], Bh[8], Kh[8]; float pf = 0.f;
#pragma unroll
        for (int u = 0; u < 8; ++u) { pf += ld[u]; const int tau = TAU(u);
            const float cl = pre + (d == 0 ? pf : tot - pf + ld[u]);
            const float e_m1 = __expf(cl - ld[u]), e_p = __expf(cl), e_n = __expf(-cl), e_c = __expf(cC - cl);
            At[u] = aa[u] * e_m1; Vt[u] = vv[u]; Bh[u] = bb[u] * e_c; Kh[u] = kd[u] * e_c;
            *(LAS bf16_t*)(L + O_AT + tau * P + j * 2) = f2bf(At[u]); *(LAS bf16_t*)(L + O_RT + tau * P + j * 2) = f2bf(rr[u] * e_p);
            *(LAS bf16_t*)(L + O_BT + tau * P + j * 2) = f2bf(bb[u] * e_n); *(LAS bf16_t*)(L + O_KT + tau * P + j * 2) = f2bf(kd[u] * e_n); }
#define PK8(dst, X) do { u32x4 w_; _Pragma("unroll") for (int k = 0; k < 4; ++k) { const float x0 = d == 0 ? X[2 * k] : X[7 - 2 * k], x1 = d == 0 ? X[2 * k + 1] : X[6 - 2 * k]; w_[k] = cvt_pk_bf16(x0, x1); } \
            *(LAS u32x4*)(L + (dst) + j * P + tau0 * 2) = w_; } while (0)
        PK8(O_ATT, At); PK8(O_VT, Vt); PK8(O_BHT, Bh); PK8(O_KHT, Kh);
#undef PK8
        if (tg == 0) *(LAS float*)(L + O_WC + j * 4) = __expf(cC);
    }
    __syncthreads();
#pragma unroll
    for (int i = 0; i < 2; ++i) {
        const int ti = 2 * w + i, ms = ti >> 2, nl = ti & 3;
        const int sb = 32 * (ms & 1), tb = 32 * (nl & 1);
        f32x16 acc = f32x16{};
        acc = mm_ll(L + (ms < 2 ? O_BT : O_KT), sb, L + (nl < 2 ? O_AT : O_RT), tb, acc, r32, hi);
        const bool incl = nl >= 2; const int dst = ms < 2 ? (nl < 2 ? O_LAB : O_ARB) : (nl < 2 ? O_LAK : O_ARK);
        const int t = tb + r32;
#pragma unroll
        for (int g = 0; g < 4; ++g) { const int s0 = sb + 8 * g + 4 * hi; float v[4];
#pragma unroll
            for (int e = 0; e < 4; ++e) { const int s = s0 + e; v[e] = (incl ? (s <= t) : (s < t)) ? acc[4 * g + e] : 0.f; }
            st4(L + dst + t * P + s0 * 2, v[0], v[1], v[2], v[3]);
            if (dst == O_LAB && (s0 >> 4) == (t >> 4)) *(LAS f32x4*)(L + O_LABD + (((t >> 4) * 16 + (t & 15)) * 16 + (s0 & 15)) * 4) = (f32x4){v[0], v[1], v[2], v[3]}; }
    }
    __syncthreads();
    if (w < 4) {
        const int mt = w >> 1, nt = w & 1; f32x16 acc = f32x16{};
        acc = mm_ll(L + O_LAK, 32 * mt, L + O_VT, 32 * nt, acc, r32, hi);
#pragma unroll
        for (int g = 0; g < 4; ++g) st4(L + O_XT + (32 * nt + r32) * P + (32 * mt + 8 * g + 4 * hi) * 2, acc[4 * g], acc[4 * g + 1], acc[4 * g + 2], acc[4 * g + 3]);
    } else if (w == 7) {
        const int blk = lane >> 4, cc = lane & 15; float x[16];
#pragma unroll
        for (int t = 0; t < 16; ++t) { float s = (t == cc) ? 1.f : 0.f; const LAS float* lr = (const LAS float*)(L + O_LABD + ((blk * 16 + t) * 16) * 4);
#pragma unroll
            for (int k = 0; k < t; ++k) s += lr[k] * x[k];
            x[t] = s; *(LAS bf16_t*)(L + O_TII + ((blk * 16 + t) * 16 + cc) * 2) = f2bf(s); }
    }
    __syncthreads();
    {
        const int c16 = lane & 15, q4 = lane >> 4;
        const LAS unsigned char* RT = L + (w < 4 ? O_ATT : O_XT) + (16 * (w & 3) + c16) * P;
        LAS unsigned char* OT = L + (w < 4 ? O_ABT : O_U0T) + (16 * (w & 3) + c16) * P;
        const LAS unsigned char* LA = L + O_LAB + c16 * P;
#define RHS(i) ({ const u32x2 r_ = *(const LAS u32x2*)(RT + (16 * (i) + 4 * q4) * 2); (f32x4){bflo(r_.x), bfhi(r_.x), bflo(r_.y), bfhi(r_.y)}; })
#define AFR(i, k1, k2) ({ const u32x2 lo_ = *(const LAS u32x2*)(LA + 16 * (i) * P + (16 * (k1) + 4 * q4) * 2); u32x2 hi_ = {0u, 0u}; if ((k2) >= 0) hi_ = *(const LAS u32x2*)(LA + 16 * (i) * P + (16 * ((k2) < 0 ? 0 : (k2)) + 4 * q4) * 2); \
        __builtin_bit_cast(bf16x8, (u32x4){lo_.x, lo_.y, hi_.x, hi_.y}); })
#define TFR(i) ({ const u32x2 lo_ = *(const LAS u32x2*)(L + O_TII + (((i) * 16 + c16) * 16 + 4 * q4) * 2); __builtin_bit_cast(bf16x8, (u32x4){lo_.x, lo_.y, 0u, 0u}); })
#define BFR(U1, U2) __builtin_bit_cast(bf16x8, (u32x4){cvt_pk_bf16(U1[0], U1[1]), cvt_pk_bf16(U1[2], U1[3]), cvt_pk_bf16(U2[0], U2[1]), cvt_pk_bf16(U2[2], U2[3])})
#define MF16(A_, B_, C_) __builtin_amdgcn_mfma_f32_16x16x32_bf16(A_, B_, C_, 0, 0, 0)
        const f32x4 zero4 = {0.f, 0.f, 0.f, 0.f};
        f32x4 U0 = MF16(TFR(0), BFR(RHS(0), zero4), zero4);
        f32x4 Z1 = MF16(AFR(1, 0, -1), BFR(U0, zero4), RHS(1));
        f32x4 U1 = MF16(TFR(1), BFR(Z1, zero4), zero4);
        f32x4 Z2 = MF16(AFR(2, 0, 1), BFR(U0, U1), RHS(2));
        f32x4 U2 = MF16(TFR(2), BFR(Z2, zero4), zero4);
        f32x4 Z3 = MF16(AFR(3, 0, 1), BFR(U0, U1), RHS(3));
        Z3 = MF16(AFR(3, 2, -1), BFR(U2, zero4), Z3);
        f32x4 U3 = MF16(TFR(3), BFR(Z3, zero4), zero4);
        st4(OT + (0 + 4 * q4) * 2, U0[0], U0[1], U0[2], U0[3]); st4(OT + (16 + 4 * q4) * 2, U1[0], U1[1], U1[2], U1[3]);
        st4(OT + (32 + 4 * q4) * 2, U2[0], U2[1], U2[2], U2[3]); st4(OT + (48 + 4 * q4) * 2, U3[0], U3[1], U3[2], U3[3]);
#undef RHS
#undef AFR
#undef TFR
#undef BFR
#undef MF16
    }
    __syncthreads();
    {
        const int mt = (w >> 1) & 1, nt = w & 1;
        if (w < 4) {
            f32x16 acc = f32x16{};
            acc = mm_ll(L + O_ABT, 32 * mt, L + O_BHT, 32 * nt, acc, r32, hi);
            if (mt == nt) { const float wc = *(const LAS float*)(L + O_WC + (32 * nt + r32) * 4);
#pragma unroll
                for (int r = 0; r < 16; ++r) if (crow(r, hi) == r32) acc[r] += wc; }
            store_native(slot + (mt * 2 + nt) * 2048, acc, lane);
            f32x16 rb;
#pragma unroll
            for (int g = 0; g < 4; ++g) { const u32x2 r_ = *(const LAS u32x2*)(L + O_RT + (32 * nt + r32) * P + (32 * mt + 8 * g + 4 * hi) * 2);
                rb[4 * g] = bflo(r_.x); rb[4 * g + 1] = bfhi(r_.x); rb[4 * g + 2] = bflo(r_.y); rb[4 * g + 3] = bfhi(r_.y); }
            rb = mm_ll(L + O_ABT, 32 * mt, L + O_ARB, 32 * nt, rb, r32, hi);
            store_native(slot + 16384 + (mt * 2 + nt) * 2048, rb, lane);
        } else {
            f32x16 acc = f32x16{};
            acc = mm_ll(L + O_BHT, 32 * mt, L + O_U0T, 32 * nt, acc, r32, hi);
            acc = mm_ll(L + O_KHT, 32 * mt, L + O_VT, 32 * nt, acc, r32, hi);
            store_native(slot + 8192 + (mt * 2 + nt) * 2048, acc, lane);
            f32x16 y0 = f32x16{};
            y0 = mm_ll(L + O_ARB, 32 * mt, L + O_U0T, 32 * nt, y0, r32, hi);
            y0 = mm_ll(L + O_ARK, 32 * mt, L + O_VT, 32 * nt, y0, r32, hi);
            store_native(slot + 24576 + (mt * 2 + nt) * 2048, y0, lane);
        }
    }
    __syncthreads();
#undef TAU
#undef LD10
}

__device__ __forceinline__ void s23_chain_wg(const Frame& F, const Args& a, int d, int q, int h, const unsigned char* slots  ) {
    LAS unsigned char* L = F.lds;
    const int lane = F.lane, w = F.wave, r32 = lane & 31, hi = lane >> 5, icb = w & 1;
    const int row0 = seq_row0(q), NC = seq_len(q) / 64;
    bf16_t* Zy = (bf16_t*)(a.ws + WS_Z) + (size_t)row0 * ZP + (d == 0 ? ZRR : ZRK) + h * 64 + 32 * icb + r32;
    f32x16 X0 = f32x16{}, X1 = f32x16{};
    const bool loader = w >= 4, compute = w < 2;
#define CKOF(cc) (d == 0 ? (cc) : NC - 1 - (cc))
#define S23_DMA(cc) do { const unsigned char* src_ = slots + (size_t)CKOF(cc) * SLOT_BYTES + (w - 4) * 8192 + lane * 16; LAS unsigned char* dst_ = L + ((cc) & 3) * 32768 + (w - 4) * 8192; \
        _Pragma("unroll") for (int p_ = 0; p_ < 8; ++p_) __builtin_amdgcn_global_load_lds((const unsigned*)(src_ + p_ * 1024), (LAS unsigned*)(dst_ + p_ * 1024), 16, 0, 0); } while (0)
#define UNPK(dst, w0, w1) do { _Pragma("unroll") for (int q_ = 0; q_ < 4; ++q_) { dst[2 * q_] = bflo(w0[q_]); dst[2 * q_ + 1] = bfhi(w0[q_]); dst[8 + 2 * q_] = bflo(w1[q_]); dst[9 + 2 * q_] = bfhi(w1[q_]); } } while (0)
    if (loader) { S23_DMA(0); if (NC > 1) S23_DMA(1); if (NC > 2) S23_DMA(2); }
#pragma unroll 1
    for (int cc = 0; cc < NC; ++cc) {
        if (loader) { const int later = NC - 1 - cc;
            if (later >= 2) asm volatile("s_waitcnt vmcnt(16)" ::: "memory"); else if (later == 1) asm volatile("s_waitcnt vmcnt(8)" ::: "memory"); else asm volatile("s_waitcnt vmcnt(0)" ::: "memory"); }
        asm volatile("s_waitcnt lgkmcnt(0)\n\ts_barrier" ::: "memory");
        if (loader) { if (cc + 3 < NC) S23_DMA(cc + 3); }
        if (compute) {
            const LAS unsigned char* sl = L + (cc & 3) * 32768 + lane * 32;
            const int ck = CKOF(cc);
            bf16x8 xb[2][2];
#pragma unroll
            for (int s = 0; s < 2; ++s) {
                xb[0][s] = __builtin_bit_cast(bf16x8, (u32x4){cvt_pk_bf16(X0[8 * s], X0[8 * s + 1]), cvt_pk_bf16(X0[8 * s + 2], X0[8 * s + 3]), cvt_pk_bf16(X0[8 * s + 4], X0[8 * s + 5]), cvt_pk_bf16(X0[8 * s + 6], X0[8 * s + 7])});
                xb[1][s] = __builtin_bit_cast(bf16x8, (u32x4){cvt_pk_bf16(X1[8 * s], X1[8 * s + 1]), cvt_pk_bf16(X1[8 * s + 2], X1[8 * s + 3]), cvt_pk_bf16(X1[8 * s + 4], X1[8 * s + 5]), cvt_pk_bf16(X1[8 * s + 6], X1[8 * s + 7])}); }
            u32x4 dw[2][2];
#pragma unroll
            for (int t = 0; t < 2; ++t) { dw[t][0] = *(const LAS u32x4*)(sl + 8192 + (t * 2 + icb) * 2048); dw[t][1] = *(const LAS u32x4*)(sl + 8192 + (t * 2 + icb) * 2048 + 16); }
            f32x16 N0, N1;
            UNPK(N0, dw[0][0], dw[0][1]); UNPK(N1, dw[1][0], dw[1][1]);
#pragma unroll
            for (int rb = 0; rb < 2; ++rb)
#pragma unroll
                for (int s = 0; s < 2; ++s) {
                    N0 = __builtin_amdgcn_mfma_f32_32x32x16_bf16(*(const LAS bf16x8*)(sl + (rb * 2 + 0) * 2048 + s * 16), xb[rb][s], N0, 0, 0, 0);
                    N1 = __builtin_amdgcn_mfma_f32_32x32x16_bf16(*(const LAS bf16x8*)(sl + (rb * 2 + 1) * 2048 + s * 16), xb[rb][s], N1, 0, 0, 0); }
            u32x4 yw[2][2];
#pragma unroll
            for (int t = 0; t < 2; ++t) { yw[t][0] = *(const LAS u32x4*)(sl + 24576 + (t * 2 + icb) * 2048); yw[t][1] = *(const LAS u32x4*)(sl + 24576 + (t * 2 + icb) * 2048 + 16); }
            f32x16 Y0, Y1;
            UNPK(Y0, yw[0][0], yw[0][1]); UNPK(Y1, yw[1][0], yw[1][1]);
#pragma unroll
            for (int rb = 0; rb < 2; ++rb)
#pragma unroll
                for (int s = 0; s < 2; ++s) {
                    Y0 = __builtin_amdgcn_mfma_f32_32x32x16_bf16(*(const LAS bf16x8*)(sl + 16384 + (rb * 2 + 0) * 2048 + s * 16), xb[rb][s], Y0, 0, 0, 0);
                    Y1 = __builtin_amdgcn_mfma_f32_32x32x16_bf16(*(const LAS bf16x8*)(sl + 16384 + (rb * 2 + 1) * 2048 + s * 16), xb[rb][s], Y1, 0, 0, 0); }
            X0 = N0; X1 = N1;
            const long rs = d == 0 ? (long)ZP : -(long)ZP;
            bf16_t* pa = Zy + (size_t)(ck * 64 + (d == 0 ? 4 * hi : 63 - 4 * hi)) * ZP; bf16_t* pb = pa + 32 * rs;
#pragma unroll
            for (int g = 0; g < 4; ++g) {
#pragma unroll
                for (int e = 0; e < 4; ++e) { pa[e * rs] = f2bf(Y0[4 * g + e]); pb[e * rs] = f2bf(Y1[4 * g + e]); }
                pa += 8 * rs; pb += 8 * rs; asm volatile("" : "+v"(pa), "+v"(pb));
            }
        }
    }
    asm volatile("s_waitcnt vmcnt(0) lgkmcnt(0)\n\ts_barrier" ::: "memory");
#undef UNPK
#undef S23_DMA
#undef CKOF
}

constexpr int PO_V = 0, PO_G = PO_V + 66 * 144, PO_Y0 = PO_G + 66 * 272, PO_Y1 = PO_Y0 + 64 * 144, PO_SG = PO_Y1 + 64 * 144, PO_GF = PO_SG + 64 * 272, PO_END = PO_GF + 64 * 272;
static_assert(PO_END <= PTRS_OFF, "post lds");
__device__ __forceinline__ void post_decode(int c, int& reg, int& row, int& part) {
    if (c < 528) { reg = 0; row = c >> 3; part = c & 7; } else if (c < 1584) { reg = 1; row = (c - 528) >> 4; part = (c - 528) & 15; }
    else if (c < 2096) { reg = 2; row = (c - 1584) >> 3; part = (c - 1584) & 7; } else { reg = 3; row = (c - 2096) >> 3; part = (c - 2096) & 7; }
}
__device__ __forceinline__ void post_stage_load(const Args& a, int tid, int q, int h, int blk, u32x4 (&v)[6]) {
    const int row0 = seq_row0(q), S = seq_len(q), t0 = blk * 64;
    const bf16_t* Zs = (const bf16_t*)(a.ws + WS_Z) + (size_t)row0 * ZP;
#pragma unroll
    for (int k = 0; k < 6; ++k) { const int c = tid + k * NTHR; int reg, row, part; post_decode(c, reg, row, part);
        const int t = reg < 2 ? t0 - 1 + row : t0 + row; const int col = reg == 0 ? ZRV + h * 64 : reg == 1 ? ZGD : reg == 2 ? ZRR + h * 64 : ZRK + h * 64;
        v[k] = (u32x4){0u, 0u, 0u, 0u};
        if (c < 2608 && t >= 0 && t < S) v[k] = *(const u32x4*)(Zs + (size_t)t * ZP + col + part * 8); }
}
__device__ __forceinline__ void post_item(const Frame& F, const Args& a, int q, int h, int blk, u32x4 (&stg)[6], bool has_next, int nq, int nh, int nblk) {
    LAS unsigned char* L = F.lds;
    int lane_ = F.lane; asm volatile("" : "+v"(lane_));
    const int lane = lane_, w = F.wave, tid = w * 64 + lane, r32 = lane & 31, hi = lane >> 5, j = lane, tg = w;
    const int row0 = seq_row0(q), t_lo = blk * 64 + 8 * tg;
    bf16_t* Zs = (bf16_t*)(a.ws + WS_Z) + (size_t)row0 * ZP;
    const float* mup = inp(L, 11); const float* mun = inp(L, 12);
    bf16x8 gfr[8];
    { const bf16_t* GT = (const bf16_t*)(a.ws + WS_LORA) + 4 * 512 * 64 + ((size_t)h * 64 + 32 * ((w >> 1) & 1) + r32) * 128;
#pragma unroll
      for (int ks = 0; ks < 8; ++ks) gfr[ks] = *(const bf16x8*)(GT + 16 * ks + 8 * hi); }
#pragma unroll
    for (int k = 0; k < 6; ++k) { const int c = tid + k * NTHR; int reg, row, part; post_decode(c, reg, row, part);
        const int off = reg == 0 ? PO_V + row * 144 : reg == 1 ? PO_G + row * 272 : reg == 2 ? PO_Y0 + row * 144 : PO_Y1 + row * 144;
        if (c < 2608) *(LAS u32x4*)(L + off + part * 16) = stg[k]; }
    __syncthreads();
    if (has_next) post_stage_load(a, tid, nq, nh, nblk, stg);
    {
        float z0[10], z1[10];
#pragma unroll
        for (int i = 0; i < 10; ++i) { z0[i] = bf2f(*(const LAS bf16_t*)(L + PO_G + (8 * tg + i) * 272 + j * 2)); z1[i] = bf2f(*(const LAS bf16_t*)(L + PO_G + (8 * tg + i) * 272 + (64 + j) * 2)); }
        const float mp0 = mup[ZGD - ZRR + j], mn0 = mun[ZGD - ZRR + j], mp1 = mup[ZGD - ZRR + 64 + j], mn1 = mun[ZGD - ZRR + 64 + j];
#pragma unroll
        for (int u = 0; u < 8; ++u) { *(LAS bf16_t*)(L + PO_SG + (8 * tg + u) * 272 + j * 2) = f2bf(sigmoidf_(tshift(z0, u, mp0, mn0)));
                                      *(LAS bf16_t*)(L + PO_SG + (8 * tg + u) * 272 + (64 + j) * 2) = f2bf(sigmoidf_(tshift(z1, u, mp1, mn1))); }
    }
    __syncthreads();
    if (w < 4) {
        const int mt = w >> 1, nt = w & 1;
        f32x16 acc = f32x16{};
#pragma unroll
        for (int ks = 0; ks < 8; ++ks) { const bf16x8 bv = *(const LAS bf16x8*)(L + PO_SG + (32 * nt + r32) * 272 + (16 * ks + 8 * hi) * 2);
            acc = __builtin_amdgcn_mfma_f32_32x32x16_bf16(gfr[ks], bv, acc, 0, 0, 0); }
#pragma unroll
        for (int g = 0; g < 4; ++g) *(LAS f32x4*)(L + PO_GF + (32 * nt + r32) * 272 + (32 * mt + 8 * g + 4 * hi) * 4) = (f32x4){acc[4 * g], acc[4 * g + 1], acc[4 * g + 2], acc[4 * g + 3]};
    }
    __syncthreads();
    {
        const int ch = h * 64 + j;
        float zv[10];
#pragma unroll
        for (int i = 0; i < 10; ++i) zv[i] = bf2f(*(const LAS bf16_t*)(L + PO_V + (8 * tg + i) * 144 + j * 2));
        const float mpv = mup[1024 + ch], mnv = mun[1024 + ch], lg = inp(L, 21)[ch], lb = inp(L, 22)[ch];
        const float* bon0 = (const float*)(a.ws + WS_BONUS) + (size_t)row0 * 8 + h; const float* bon1 = bon0 + (size_t)MTOK * 8;
#pragma unroll
        for (int u = 0; u < 8; ++u) { const int t = t_lo + u;
            const float y = bf2f(*(const LAS bf16_t*)(L + PO_Y0 + (8 * tg + u) * 144 + j * 2)) + bf2f(*(const LAS bf16_t*)(L + PO_Y1 + (8 * tg + u) * 144 + j * 2));
            const float mean = wave_sum_dpp(y) * (1.f / 64.f); const float dv = y - mean; const float var = wave_sum_dpp(dv * dv) * (1.f / 64.f);
            const float yn = dv * __builtin_amdgcn_rsqf(var + LNX_EPS) * lg + lb;
            const float bsum = bon0[(size_t)t * 8] + bon1[(size_t)t * 8];
            const float g = *(const LAS float*)(L + PO_GF + (8 * tg + u) * 272 + j * 4);
            Zs[(size_t)t * ZP + ZRR + ch] = f2bf((yn + bsum * tshift(zv, u, mpv, mnv)) * g); }
    }
    __syncthreads();
}
}


#define XB_TMO      128
#define XB_XCNT(j)  (256  + 64 * (j))
#define XB_XSUB(j)  (1280 + 64 * (j))
#define XB_XGEN(j)  (2304 + 64 * (j))
#define XB_TOP      3328
#define XB_TOPGEN   3392
#define XCD_BAR_WORDS 3456
#define XB_SPIN_CAP (1u << 20)
constexpr size_t CTL_ZERO_BYTES = 16384;
__device__ __forceinline__ unsigned xb_ld(unsigned* p)              { return __hip_atomic_load(p, __ATOMIC_RELAXED, __HIP_MEMORY_SCOPE_AGENT); }
__device__ __forceinline__ unsigned xb_add(unsigned* p, unsigned v) { return __hip_atomic_fetch_add(p, v, __ATOMIC_RELAXED, __HIP_MEMORY_SCOPE_AGENT); }
__device__ __forceinline__ unsigned xb_xcc_id() { return (unsigned)__builtin_amdgcn_s_getreg((3 << 11) | 20) & 0xFu; }
#define XB_SPIN(cond, bar) do { unsigned _sp = 0; while (cond) { __builtin_amdgcn_s_sleep(1); \
    if ((++_sp & 255u) == 0u) { if (xb_ld(&(bar)[XB_TMO])) break; if (_sp > XB_SPIN_CAP) { atomicAdd(&(bar)[XB_TMO], 1u); break; } } } } while (0)
struct XcdBarrier { unsigned* bar; unsigned x; volatile LAS unsigned* st; };
__device__ __forceinline__ XcdBarrier xcd_barrier_post(unsigned* bar, volatile LAS unsigned* st) {
    XcdBarrier b; b.bar = bar; b.x = xb_xcc_id(); b.st = st;
    if (threadIdx.x == 0) (void)xb_add(&bar[XB_XCNT(b.x)], 1u);
    return b;
}
__device__ __forceinline__ void xcd_barrier_complete(unsigned* bar, unsigned x, unsigned& nloc, unsigned& nx) {
    const unsigned G = gridDim.x * gridDim.y * gridDim.z;
    unsigned sum, cnt, mine, sp = 0u;
    for (;;) {
        sum = 0u; cnt = 0u; mine = 0u;
#pragma unroll
        for (unsigned j = 0; j < 16; ++j) { const unsigned c = xb_ld(&bar[XB_XCNT(j)]); sum += c; cnt += (c > 0u) ? 1u : 0u; mine = (j == x) ? c : mine; }
        if (sum == G) break;
        __builtin_amdgcn_s_sleep(1);
        if ((++sp & 255u) == 0u) { if (xb_ld(&bar[XB_TMO])) break; if (sp > XB_SPIN_CAP) { atomicAdd(&bar[XB_TMO], 1u); break; } }
    }
    nloc = mine > 0u ? mine : 1u; nx = cnt > 0u ? cnt : 1u;
}
__device__ __forceinline__ void xcd_barrier(const XcdBarrier& b) {
    asm volatile("s_waitcnt vmcnt(0)" ::: "memory");
    __syncthreads();
    if (threadIdx.x == 0) {
        unsigned* bar = b.bar;
        __builtin_amdgcn_s_waitcnt(0);
        unsigned nloc = b.st[0], nx = b.st[1];
        if (nloc == 0u) { xcd_barrier_complete(bar, b.x, nloc, nx); b.st[0] = nloc; b.st[1] = nx; }
        const unsigned old = xb_add(&bar[XB_XSUB(b.x)], 1u);
        const unsigned gen = old / nloc;
        if (old + 1u == (gen + 1u) * nloc) {
            __builtin_amdgcn_fence(__ATOMIC_RELEASE, "agent");
            asm volatile("s_waitcnt vmcnt(0)" ::: "memory");
            const unsigned og = xb_add(&bar[XB_TOP], 1u);
            const unsigned tg = og / nx;
            if (og + 1u == (tg + 1u) * nx) xb_add(&bar[XB_TOPGEN], 1u);
            else XB_SPIN(xb_ld(&bar[XB_TOPGEN]) == tg, bar);
            __builtin_amdgcn_fence(__ATOMIC_ACQUIRE, "agent");
            xb_add(&bar[XB_XGEN(b.x)], 1u);
            asm volatile("s_waitcnt vmcnt(0)" ::: "memory");
        } else {
            XB_SPIN(xb_ld(&bar[XB_XGEN(b.x)]) == gen, bar);
            __builtin_amdgcn_fence(__ATOMIC_ACQUIRE, "agent");
            asm volatile("s_waitcnt vmcnt(0)" ::: "memory");
        }
    }
    __syncthreads();
}

#ifndef ONE_LAUNCH
#define ONE_LAUNCH 1
#endif
#ifndef USE_CG
#define USE_CG 0
#endif
#ifndef PROBE_DOUBLE
#define PROBE_DOUBLE 0
#endif
constexpr int NPHASE = 10;
constexpr int NOJUMP = 1 << 30;
template <int LO, int HI>
__global__ void __launch_bounds__(NTHR, 2) fwd_kernel(Args a) {
    extern __shared__ __attribute__((aligned(16))) unsigned char lds_raw[];
    Frame F; F.lds = (LAS unsigned char*)lds_raw; F.tid = threadIdx.x; F.lane = F.tid & 63; F.wave = __builtin_amdgcn_readfirstlane(F.tid >> 6);
    F.G = gridDim.x; { const int bx = blockIdx.x; F.vcu = (F.G % 8 == 0) ? (bx % 8) * (F.G / 8) + bx / 8 : bx; }
    unsigned char* ws = a.ws; bf16_t* Z = (bf16_t*)(ws + WS_Z);
    unsigned char* slots = (unsigned char*)a.out;
    if (F.tid == 0) {
#pragma unroll
        for (int i = 0; i < 27; ++i) *(const float* LAS*)(F.lds + PTRS_OFF + i * 8) = a.in[i];
        *(volatile LAS unsigned*)(F.lds + PTRS_OFF + 224) = 0u; *(volatile LAS unsigned*)(F.lds + PTRS_OFF + 228) = 0u;
    }
    __syncthreads();
#if ONE_LAUNCH && !USE_CG
    const XcdBarrier bar = xcd_barrier_post((unsigned*)(ws + WS_CTL), (volatile LAS unsigned*)(F.lds + PTRS_OFF + 224));
#endif
#if ONE_LAUNCH
#if USE_CG
#define SEAM(k) do { if constexpr ((k) + 1 < HI) { cg::this_grid().sync(); } } while (0)
#define RSYNC() cg::this_grid().sync()
#else
#define SEAM(k) do { if constexpr ((k) + 1 < HI) { xcd_barrier(bar); } } while (0)
#define RSYNC() xcd_barrier(bar)
#endif
#else
#define SEAM(k) do { } while (0)
#define RSYNC() do { } while (0)
#endif
#define IN(k) (LO <= (k) && (k) < HI)
    if constexpr (IN(0)) { p0_prologue(F, a); SEAM(0);
#if PROBE_DOUBLE == 4
        p0_prologue(F, a); RSYNC();
#endif
    }
    if constexpr (IN(1)) { pg8::Gemm g{(const char*)a.out, (const bf16_t*)(ws + WS_WIN), MTOK, ZP, DM, DM * 2, NOJUMP, 0}; pg8::StaticOrder S; S.init(MTOK, ZP, F.G, (int)blockIdx.x);
        pg8::EpiZ E{Z, ZP}; pg8::gemm_phase<pg8::EpiZ, pg8::StaticOrder, true>(F.lds, g, S, E); SEAM(1);
#if PROBE_DOUBLE == 3
        pg8::gemm_phase<pg8::EpiZ, pg8::StaticOrder, true>(F.lds, g, S, E); RSYNC();
#endif
    }
    if constexpr (IN(2)) { qk_prep(F, a);
#pragma unroll 1
        for (int rnd = 0; rnd < 2; ++rnd) {
            for (int rep = 0; rep < (PROBE_DOUBLE == 2 ? 2 : 1); ++rep) {
#define S1_DECODE(it_, d_, q_, h_, ck_) do { if (rnd == 0) { ck_ = (it_) & 255; h_ = ((it_) >> 8) & 7; d_ = (it_) >> 11; q_ = 0; } else { ck_ = (it_) & 31; h_ = ((it_) >> 5) & 7; q_ = 1 + (((it_) >> 8) & 7); d_ = (it_) >> 11; } } while (0)
                u32x4 stg[6];
                { int d, q, h, ck; S1_DECODE(F.vcu, d, q, h, ck); if (F.vcu < 4096) rw::s1_stage_load(a, F.tid, q, h, ck, stg); }
#pragma unroll 1
                for (int it = F.vcu; it < 4096; it += F.G) {
                    int d, q, h, ck, nd, nq, nh, nck; S1_DECODE(it, d, q, h, ck); const int nit = it + F.G; S1_DECODE(nit, nd, nq, nh, nck); (void)nd;
                    rw::s1_item(F, a, d, q, h, ck, slots + (size_t)it * SLOT_BYTES, stg, nit < 4096, nq, nh, nck); }
#undef S1_DECODE
            }
            RSYNC();
            {
                const int nchain = rnd == 0 ? 16 : 128;
                for (int chain = F.vcu; chain < nchain; chain += F.G) { int d, q, h, nc;
                    if (rnd == 0) { d = chain >> 3; h = chain & 7; q = 0; nc = 256; } else { h = chain & 7; q = 1 + ((chain >> 3) & 7); d = chain >> 6; nc = 32; }
                    rw::s23_chain_wg(F, a, d, q, h, slots + (size_t)chain * nc * SLOT_BYTES); } }
            if (rnd == 0) RSYNC();
        }
        SEAM(2); }
    if constexpr (IN(3)) {
#define PO_DECODE(it_, q_, h_, b_) do { if ((it_) < 2048) { q_ = 0; h_ = (it_) >> 8; b_ = (it_) & 255; } else { const int r_ = (it_) - 2048; q_ = 1 + (r_ >> 8); h_ = (r_ >> 5) & 7; b_ = r_ & 31; } } while (0)
        u32x4 stg[6];
        { int q, h, b; PO_DECODE(F.vcu, q, h, b); if (F.vcu < 4096) rw::post_stage_load(a, F.tid, q, h, b, stg); }
#pragma unroll 1
        for (int it = F.vcu; it < 4096; it += F.G) { int q, h, b, nq, nh, nb; PO_DECODE(it, q, h, b); const int nit = it + F.G; PO_DECODE(nit, nq, nh, nb);
            rw::post_item(F, a, q, h, b, stg, nit < 4096, nq, nh, nb); }
#undef PO_DECODE
        SEAM(3); }
    if constexpr (IN(4)) {
        float lam; { const float p1 = wave_sum(a.in[6][F.lane] * a.in[7][F.lane]), p2 = wave_sum(a.in[8][F.lane] * a.in[9][F.lane]); lam = __expf(p1) - __expf(p2) + LAMBDA_INIT; }
#if PROBE_DOUBLE == 1
        for (int v = F.vcu; v < 256; v += F.G) {
            att::attn_unit(0, SP, v >> 6, v & 63, Z, F.lds, lam, a.in[10], (bf16_t*)a.out, 512);
            att::attn_unit(SP + (v >> 5) * SS, SS, (v >> 3) & 3, v & 7, Z, F.lds, lam, a.in[10], (bf16_t*)a.out, 512); }
        RSYNC();
#endif
        for (int v = F.vcu; v < 256; v += F.G) {
            att::attn_unit(0, SP, v >> 6, v & 63, Z, F.lds, lam, a.in[10], Z, ZP);
            att::attn_unit(SP + (v >> 5) * SS, SS, (v >> 3) & 3, v & 7, Z, F.lds, lam, a.in[10], Z, ZP); }
        SEAM(4); }
    if constexpr (IN(5)) { pg8::Gemm g{(const char*)Z, (const bf16_t*)(ws + WS_WOUT), MTOK, DM, DM, ZP * 2, 8, 2048}; pg8::StaticOrder S; S.init(MTOK, DM, F.G, (int)blockIdx.x);
        pg8::EpiOut E{a.in[0], a.in[1], a.out, Z, (float*)(ws + WS_ROWSQ)}; pg8::gemm_phase<pg8::EpiOut, pg8::StaticOrder, true>(F.lds, g, S, E); SEAM(5); }
#define FFN_UP(k, half) if constexpr (IN(k)) { pg8::Gemm g{(const char*)(Z + (size_t)(half) * 16384 * ZP + ZXN2), (const bf16_t*)(ws + WS_W1), 16384, DFF, DM, ZP * 2, NOJUMP, 0}; pg8::StaticOrder S; S.init(16384, DFF, F.G, (int)blockIdx.x); \
        pg8::EpiUp E{(char*)(ws + WS_Z), (const float*)(ws + WS_ROWSQ), (half) * 16384}; pg8::gemm_phase<pg8::EpiUp, pg8::StaticOrder, true>(F.lds, g, S, E); SEAM(k); }
#define FFN_DN(k, half) if constexpr (IN(k)) { pg8::Gemm g{(const char*)(ws + WS_Z), (const bf16_t*)(ws + WS_W2), 16384, DM, DFF, 13312, 32, 2560}; pg8::StaticOrder S; S.init(16384, DM, F.G, (int)blockIdx.x); \
        pg8::EpiDown E{a.out, (half) * 16384}; pg8::gemm_phase<pg8::EpiDown, pg8::StaticOrder, true>(F.lds, g, S, E); SEAM(k); }
    FFN_UP(6, 0) FFN_DN(7, 0) FFN_UP(8, 1) FFN_DN(9, 1)
#undef FFN_UP
#undef FFN_DN
#undef IN
#undef SEAM
#undef RSYNC
}

extern "C" void kernel_launch(void* const* d_in, const int* in_sizes, int n_in, void* d_out, int out_size, void* d_ws, size_t ws_size, hipStream_t stream) {
    static int grid = 0;
    if (grid == 0) {
        if (n_in != 27 || out_size != MTOK * DM || ws_size < WS_END) { fprintf(stderr, "kernel_launch: unexpected shapes (n_in %d out %d ws %zu)\n", n_in, out_size, ws_size); grid = -1; return; }
        int dev = 0, cus = 0; (void)hipGetDevice(&dev); (void)hipDeviceGetAttribute(&cus, hipDeviceAttributeMultiprocessorCount, dev);
        bool ok = true;
#if ONE_LAUNCH
        ok = ok && hipFuncSetAttribute((const void*)fwd_kernel<0, NPHASE>, hipFuncAttributeMaxDynamicSharedMemorySize, LDS_BYTES) == hipSuccess;
        int per_cu = 0; (void)hipOccupancyMaxActiveBlocksPerMultiprocessor(&per_cu, (const void*)fwd_kernel<0, NPHASE>, NTHR, LDS_BYTES); (void)hipGetLastError();
        if (per_cu < 1) fprintf(stderr, "kernel_launch: occupancy query says %d blocks/CU\n", per_cu);
#else
#define SETA(p) ok = ok && hipFuncSetAttribute((const void*)fwd_kernel<p, p + 1>, hipFuncAttributeMaxDynamicSharedMemorySize, LDS_BYTES) == hipSuccess;
        SETA(0) SETA(1) SETA(2) SETA(3) SETA(4) SETA(5) SETA(6) SETA(7) SETA(8) SETA(9)
#undef SETA
#endif
        if (!ok) { fprintf(stderr, "kernel_launch: hipFuncSetAttribute failed\n"); grid = -1; return; }
        grid = cus > 256 ? 256 : cus;
    }
    if (grid < 0) return;
    Args a{};
    for (int i = 0; i < 27; ++i) a.in[i] = (const float*)d_in[i];
    a.out = (float*)d_out; a.ws = (unsigned char*)d_ws;
#if ONE_LAUNCH
    a.ph_lo = 0; a.ph_hi = NPHASE;
#if !USE_CG
    if (hipMemsetAsync((char*)d_ws + WS_CTL, 0, CTL_ZERO_BYTES, stream) != hipSuccess) { fprintf(stderr, "kernel_launch: hipMemsetAsync failed\n"); return; }
#endif
    void* args[] = {&a};
    hipError_t e = hipLaunchCooperativeKernel((const void*)fwd_kernel<0, NPHASE>, dim3(grid), dim3(NTHR), args, LDS_BYTES, stream);
    if (e != hipSuccess) fprintf(stderr, "cooperative launch failed: %s (grid %d)\n", hipGetErrorString(e), grid);
#else
#define LAUNCH(p) hipLaunchKernelGGL((fwd_kernel<p, p + 1>), dim3(grid), dim3(NTHR), LDS_BYTES, stream, a);
    LAUNCH(0) LAUNCH(1) LAUNCH(2) LAUNCH(3) LAUNCH(4) LAUNCH(5) LAUNCH(6) LAUNCH(7) LAUNCH(8) LAUNCH(9)
#undef LAUNCH
#endif
}
```

```cpp
#include <hip/hip_runtime.h>
#include <hip/hip_cooperative_groups.h>
#include <cstdio>
#include <cstdint>
namespace cg = cooperative_groups;

#ifndef ONE_LAUNCH
#define ONE_LAUNCH 1
#endif
#ifndef USE_CG
#define USE_CG 0
#endif
#ifndef PROBE_SEG
#define PROBE_SEG -1
#endif
#ifndef PROBE_S1
#define PROBE_S1 -1
#endif
#ifndef PROBE_DOUBLE
#define PROBE_DOUBLE 0
#endif

#define LAS __attribute__((address_space(3)))
typedef unsigned short bf16_t;
typedef short bf16x8 __attribute__((ext_vector_type(8)));
typedef short s16x4 __attribute__((ext_vector_type(4)));
typedef float f32x4 __attribute__((ext_vector_type(4)));
typedef float f32x16 __attribute__((ext_vector_type(16)));
typedef unsigned u32x4 __attribute__((ext_vector_type(4)));
typedef unsigned u32x2 __attribute__((ext_vector_type(2)));
typedef float f32x2_t __attribute__((ext_vector_type(2)));
typedef __bf16 bf16x2_t __attribute__((ext_vector_type(2)));

constexpr int MTOK = 32768, DM = 1024, ZP = 3328, DFF = 4096;
constexpr int SP = 16384, SS = 2048;
constexpr int ZQ = 0, ZK = 512, ZV = 1024, ZRR = 1536, ZRK = 2048, ZRV = 2560, ZWD = 3072, ZAD = 3136, ZGD = 3200;
constexpr int ZXN2 = 2048;
constexpr float NORM_EPS = 1e-6f, LNX_EPS = 64e-5f;
constexpr float QSCALE = 0.125f * 1.4426950408889634f;
constexpr float LAMBDA_INIT = 0.2f;
constexpr int NCHUNK_P = SP / 64, NCHUNK_S = SS / 64;

constexpr size_t MiB = 1u << 20;
constexpr size_t WS_CTL = 0;
constexpr size_t WS_WIN = 1 * MiB, WS_WOUT = 8 * MiB, WS_W1 = 10 * MiB, WS_W2 = 18 * MiB;
constexpr size_t WS_ROPE = 26 * MiB;
constexpr size_t WS_LORA = 30 * MiB;
constexpr size_t WS_ROWSQ = 31 * MiB;
constexpr size_t WS_BONUS = 33 * MiB;
constexpr size_t WS_Z = 36 * MiB;
constexpr size_t WS_END = 244 * MiB;
static_assert(WS_Z + (size_t)MTOK * ZP * 2 <= WS_END, "ws map");
constexpr size_t SLOT_BYTES = 32768;

__device__ __forceinline__ unsigned cvt_pk_bf16(float lo, float hi) { f32x2_t v = {lo, hi}; bf16x2_t b = __builtin_convertvector(v, bf16x2_t); return __builtin_bit_cast(unsigned, b); }
__device__ __forceinline__ float bf2f(unsigned short u) { return __uint_as_float(((unsigned)u) << 16); }
__device__ __forceinline__ float bflo(unsigned u) { return __uint_as_float(u << 16); }
__device__ __forceinline__ float bfhi(unsigned u) { return __uint_as_float(u & 0xffff0000u); }
__device__ __forceinline__ unsigned short f2bf(float f) { return (unsigned short)(cvt_pk_bf16(f, 0.f) & 0xffffu); }
__device__ __forceinline__ float wave_sum(float v) {
#pragma unroll
    for (int o = 1; o < 64; o <<= 1) v += __shfl_xor(v, o);
    return v;
}
__device__ __forceinline__ float wave_sum_dpp(float v) {
    int x = __float_as_int(v);
    v += __int_as_float(__builtin_amdgcn_update_dpp(0, x, 0xB1, 0xF, 0xF, true)); x = __float_as_int(v);
    v += __int_as_float(__builtin_amdgcn_update_dpp(0, x, 0x4E, 0xF, 0xF, true)); x = __float_as_int(v);
    v += __int_as_float(__builtin_amdgcn_update_dpp(0, x, 0x124, 0xF, 0xF, true)); x = __float_as_int(v);
    v += __int_as_float(__builtin_amdgcn_update_dpp(0, x, 0x128, 0xF, 0xF, true)); x = __float_as_int(v);
    const float a = __int_as_float(__builtin_amdgcn_readlane(x, 0)), b = __int_as_float(__builtin_amdgcn_readlane(x, 16)), c = __int_as_float(__builtin_amdgcn_readlane(x, 32)), d = __int_as_float(__builtin_amdgcn_readlane(x, 48));
    return (a + b) + (c + d);
}
#define LDS_WAIT() asm volatile("s_waitcnt lgkmcnt(0)" ::: "memory")
#define VM_WAIT() asm volatile("s_waitcnt vmcnt(0)" ::: "memory")

namespace pg8 {
constexpr int BM = 256, BK = 64, HALF = 128, HTB = HALF * BK * 2, STAGE_BYTES = 8 * HTB, NXCD = 8, WGM = 8;
__host__ __device__ __forceinline__ int lds_byte(int r, int c) { const int st = (r >> 4) * 2 + (c >> 5), rr = r & 15, cc = c & 31, ob = rr * 64 + cc * 2; return st * 1024 + (ob ^ (((ob >> 9) & 1) << 5)); }
__host__ __device__ __forceinline__ void stage_rc(int b, int& R, int& C) { const int st = b / 1024, sb = b % 1024, swz = sb ^ (((sb >> 9) & 1) << 5); R = (st >> 1) * 16 + swz / 64; C = (st & 1) * 32 + (swz % 64) / 2; }
__host__ __device__ __forceinline__ int perm32(int rho) { const int n = rho >> 4, i = rho & 15; return 8 * (i >> 2) + 4 * n + (i & 3); }
struct Unit { int pm, pn; };
struct Gemm { const char* A; const bf16_t* Bt; int M, N, K; int lda; int jkt; int jbytes; };
struct StaticOrder {
    int nM, nN, nwg, G, c;
    __host__ __device__ void init(int M, int N, int G_, int c_) { nM = M / BM; nN = N / BM; nwg = nM * nN; G = G_; c = c_; }
    __host__ __device__ bool next(int i, Unit& u) const {
        const long L = (long)i * G + c; if (L >= nwg) return false;
        int wgid = (int)L; { const int q = nwg / NXCD, r = nwg % NXCD, xcd = wgid % NXCD, off = wgid / NXCD; wgid = (xcd < r ? xcd * (q + 1) : r * (q + 1) + (xcd - r) * q) + off; }
        const int nig = WGM * nN, gid = wgid / nig, fm = gid * WGM, gsz = (nM - fm) < WGM ? (nM - fm) : WGM;
        u.pm = fm + ((wgid % nig) % gsz); u.pn = (wgid % nig) / gsz; return true;
    }
};

struct EpiZ {
    static constexpr bool PERM = true;
    bf16_t* O; int ldc;
    __device__ __forceinline__ void operator()(const f32x4 (&acc)[2][2][4][2], const Unit& u, int wr, int wc, int fr, int fq) const {
        const int row0 = u.pm * BM + wr * 64 + fr, col0 = u.pn * BM + wc * 32 + 8 * fq;
#pragma unroll
        for (int ai = 0; ai < 2; ++ai)
#pragma unroll
            for (int m = 0; m < 4; ++m) { bf16_t* rowp = O + (size_t)(row0 + ai * HALF + m * 16) * ldc + col0;
#pragma unroll
                for (int bj = 0; bj < 2; ++bj) { const f32x4 v0 = acc[ai][bj][m][0], v1 = acc[ai][bj][m][1];
                    u32x4 w; w.x = cvt_pk_bf16(v0[0], v0[1]); w.y = cvt_pk_bf16(v0[2], v0[3]); w.z = cvt_pk_bf16(v1[0], v1[1]); w.w = cvt_pk_bf16(v1[2], v1[3]);
                    *(u32x4*)(rowp + bj * HALF) = w; } }
    }
};
struct EpiOut {
    static constexpr bool PERM = false;
    const float* xp; const float* xs; float* out; bf16_t* Z; float* rowsq;
    __device__ __forceinline__ void operator()(const f32x4 (&acc)[2][2][4][2], const Unit& u, int wr, int wc, int fr, int fq) const {
        const int col0 = u.pn * BM + wc * 32 + 4 * fq;
#pragma unroll
        for (int ai = 0; ai < 2; ++ai)
#pragma unroll
            for (int m = 0; m < 4; ++m) { const int r = u.pm * BM + ai * HALF + wr * 64 + m * 16 + fr;
                const float* xr = (r < SP ? xp + (size_t)r * DM : xs + (size_t)(r - SP) * DM) + col0; float* orow = out + (size_t)r * DM + col0; bf16_t* zr = Z + (size_t)r * ZP + ZXN2 + col0;
                float ss = 0.f;
#pragma unroll
                for (int bj = 0; bj < 2; ++bj)
#pragma unroll
                    for (int n = 0; n < 2; ++n) { const f32x4 xv = *(const f32x4*)(xr + bj * HALF + n * 16); const f32x4 o = xv + acc[ai][bj][m][n];
                        *(f32x4*)(orow + bj * HALF + n * 16) = o; ss += (o[0] * o[0] + o[1] * o[1]) + (o[2] * o[2] + o[3] * o[3]);
                        u32x2 w; w.x = cvt_pk_bf16(o[0], o[1]); w.y = cvt_pk_bf16(o[2], o[3]); *(u32x2*)(zr + bj * HALF + n * 16) = w; }
                ss += __shfl_xor(ss, 16); ss += __shfl_xor(ss, 32);
                if (fq == 0) rowsq[(size_t)r * 16 + u.pn * 4 + wc] = ss;
                if (m & 1) asm volatile("" ::: "memory"); }
    }
};
struct EpiUp {
    static constexpr bool PERM = true;
    char* H; const float* rowsq; int row_off;
    __device__ __forceinline__ void operator()(const f32x4 (&acc)[2][2][4][2], const Unit& u, int wr, int wc, int fr, int fq) const {
        const int row0 = u.pm * BM + wr * 64 + fr, col0 = u.pn * BM + wc * 32 + 8 * fq;
#pragma unroll
        for (int ai = 0; ai < 2; ++ai)
#pragma unroll
            for (int m = 0; m < 4; ++m) { const int r = row0 + ai * HALF + m * 16; const f32x4* rq = (const f32x4*)(rowsq + (size_t)(row_off + r) * 16);
                const f32x4 q0 = rq[0], q1 = rq[1], q2 = rq[2], q3 = rq[3];
                const float ssum = ((q0[0] + q0[1]) + (q0[2] + q0[3])) + ((q1[0] + q1[1]) + (q1[2] + q1[3])) + ((q2[0] + q2[1]) + (q2[2] + q2[3])) + ((q3[0] + q3[1]) + (q3[2] + q3[3]));
                const float rstd = __builtin_amdgcn_rsqf(ssum * (1.0f / DM) + NORM_EPS);
                char* rowp = H + (size_t)r * 13312;
#pragma unroll
                for (int bj = 0; bj < 2; ++bj) { const int c = col0 + bj * HALF; f32x4 v0 = acc[ai][bj][m][0] * rstd, v1 = acc[ai][bj][m][1] * rstd;
#pragma unroll
                    for (int e = 0; e < 4; ++e) { const float a = fmaxf(v0[e], 0.f), b = fmaxf(v1[e], 0.f); v0[e] = a * a; v1[e] = b * b; }
                    u32x4 w; w.x = cvt_pk_bf16(v0[0], v0[1]); w.y = cvt_pk_bf16(v0[2], v0[3]); w.z = cvt_pk_bf16(v1[0], v1[1]); w.w = cvt_pk_bf16(v1[2], v1[3]);
                    *(u32x4*)(rowp + (size_t)c * 2 + (c >= 2048 ? 2560 : 0)) = w; } }
    }
};
struct EpiDown {
    static constexpr bool PERM = false;
    float* out; int row_off;
    __device__ __forceinline__ void operator()(const f32x4 (&acc)[2][2][4][2], const Unit& u, int wr, int wc, int fr, int fq) const {
        const int col0 = u.pn * BM + wc * 32 + 4 * fq;
#pragma unroll
        for (int ai = 0; ai < 2; ++ai)
#pragma unroll
            for (int m = 0; m < 4; ++m) { const int r = row_off + u.pm * BM + ai * HALF + wr * 64 + m * 16 + fr; float* orow = out + (size_t)r * DM + col0;
#pragma unroll
                for (int bj = 0; bj < 2; ++bj)
#pragma unroll
                    for (int n = 0; n < 2; ++n) { const f32x4 xv = *(const f32x4*)(orow + bj * HALF + n * 16); *(f32x4*)(orow + bj * HALF + n * 16) = xv + acc[ai][bj][m][n]; }
                if (m & 1) asm volatile("" ::: "memory"); }
    }
};

template <class Epi, class Sched, bool ALIGN_EPI>
__device__ __forceinline__ void gemm_phase(LAS unsigned char* lds, const Gemm g, const Sched& S, const Epi& E) {
    int tid_ = threadIdx.x; asm volatile("" : "+v"(tid_));
    const int tid = tid_, wid = __builtin_amdgcn_readfirstlane(tid >> 6), lane = tid & 63, wr = wid >> 2, wc = wid & 3, fr = lane & 15, fq = lane >> 4;
    const int K = g.K, nt = K / BK;
    unsigned voffA[2], voffB[2];
#pragma unroll
    for (int i = 0; i < 2; ++i) { int R, C; stage_rc(tid * 16 + i * 8192, R, C); const int Rb = Epi::PERM ? ((R & ~31) + perm32(R & 31)) : R;
        voffA[i] = (unsigned)(R * g.lda + C * 2); voffB[i] = (unsigned)(Rb * K + C) * 2u; }
    const size_t kstep = (size_t)(BK * 2);
    const size_t hstepA = (size_t)HALF * g.lda, tstepA = 2 * hstepA;
    const size_t hstepB = (size_t)HALF * K * 2, tstepB = 2 * hstepB;
    const unsigned ldsw = (unsigned)wid * 1024u;
    const int aoff = lds_byte(wr * 64 + fr, fq * 8), boff = lds_byte(wc * 32 + fr, fq * 8);
#define PG8_AOFF(kt) ((size_t)(kt) * kstep + ((kt) >= g.jkt ? (size_t)g.jbytes : (size_t)0))
#define PG8_SA(b, h) (((b) * 2 + (h)) * HTB)
#define PG8_SB(b, h) ((4 + (b) * 2 + (h)) * HTB)
#define PG8_STAGE(bufoff, gbase, voff) do { _Pragma("unroll") for (int _i = 0; _i < 2; ++_i) \
        __builtin_amdgcn_global_load_lds((const unsigned*)((const char*)(gbase) + (voff)[_i]), (LAS unsigned*)(lds + (bufoff) + ldsw + _i * 8192), 16, 0, 0); } while (0)
#define PG8_LDA(dst, b, h) do { _Pragma("unroll") for (int m = 0; m < 4; ++m) _Pragma("unroll") for (int k = 0; k < 2; ++k) dst[m][k] = *(const LAS bf16x8*)(lds + PG8_SA(b, h) + aoff + m * 2048 + k * 1024); } while (0)
#define PG8_LDB(dst, b, h) do { _Pragma("unroll") for (int n = 0; n < 2; ++n) _Pragma("unroll") for (int k = 0; k < 2; ++k) dst[n][k] = *(const LAS bf16x8*)(lds + PG8_SB(b, h) + boff + n * 2048 + k * 1024); } while (0)
#define PG8_MMA(ai, bj, At, Bt) do { __builtin_amdgcn_s_setprio(1); _Pragma("unroll") for (int m = 0; m < 4; ++m) _Pragma("unroll") for (int n = 0; n < 2; ++n) _Pragma("unroll") for (int k = 0; k < 2; ++k) \
        acc[ai][bj][m][n] = __builtin_amdgcn_mfma_f32_16x16x32_bf16(Bt[n][k], At[m][k], acc[ai][bj][m][n], 0, 0, 0); __builtin_amdgcn_s_setprio(0); } while (0)
#define PG8_WAIT_V(n) asm volatile("s_waitcnt vmcnt(" #n ")" ::: "memory")
#define PG8_WAIT_L(n) asm volatile("s_waitcnt lgkmcnt(" #n ")" ::: "memory")
#define PG8_BAR __builtin_amdgcn_s_barrier()
#define PG8_SCHED __builtin_amdgcn_sched_barrier(0)
    Unit cur, nxt; int ui = 0;
    if (!S.next(0, cur)) return;
    f32x4 acc[2][2][4][2];
#pragma unroll
    for (int a = 0; a < 2; ++a)
#pragma unroll
        for (int b = 0; b < 2; ++b)
#pragma unroll
            for (int m = 0; m < 4; ++m)
#pragma unroll
                for (int n = 0; n < 2; ++n) acc[a][b][m][n] = (f32x4){0.f, 0.f, 0.f, 0.f};
    bf16x8 At[4][2], B0[2][2], B1[2][2];
    const char* cA = g.A + (size_t)cur.pm * tstepA; const char* cB = (const char*)g.Bt + (size_t)cur.pn * tstepB;
    {
        PG8_STAGE(PG8_SB(0, 0), cB, voffB); PG8_STAGE(PG8_SB(0, 1), cB + hstepB, voffB); PG8_STAGE(PG8_SA(0, 0), cA + PG8_AOFF(0), voffA); PG8_STAGE(PG8_SA(0, 1), cA + hstepA + PG8_AOFF(0), voffA);
        if (wr == 1) PG8_BAR;
        PG8_WAIT_V(2); PG8_BAR;
        PG8_STAGE(PG8_SB(1, 0), cB + kstep, voffB); PG8_STAGE(PG8_SA(1, 0), cA + PG8_AOFF(1), voffA); PG8_STAGE(PG8_SB(1, 1), cB + hstepB + kstep, voffB);
        PG8_WAIT_V(6); PG8_BAR;
    }
    for (;;) {
        const bool has_next = S.next(ui + 1, nxt);
        const char* nA = has_next ? g.A + (size_t)nxt.pm * tstepA : cA; const char* nB = has_next ? (const char*)g.Bt + (size_t)nxt.pn * tstepB : cB;
        for (int t = 0; t < nt; t += 2) {
            const bool last = (t == nt - 2);
            const char* a1 = cA + PG8_AOFF(t + 1);
            const char* a2 = last ? nA + PG8_AOFF(0) : cA + PG8_AOFF(t + 2); const char* b2 = last ? nB : cB + (size_t)(t + 2) * kstep;
            const char* a3 = last ? nA + PG8_AOFF(1) : cA + PG8_AOFF(t + 3); const char* b3 = b2 + kstep;
            PG8_LDB(B0, 0, 0); PG8_LDB(B1, 0, 1); PG8_SCHED; PG8_LDA(At, 0, 0); PG8_STAGE(PG8_SA(1, 1), a1 + hstepA, voffA);
            PG8_WAIT_V(8); PG8_WAIT_L(0); PG8_BAR; PG8_MMA(0, 0, At, B0); PG8_MMA(0, 1, At, B1); PG8_BAR; PG8_SCHED;
            PG8_LDA(At, 0, 1); PG8_STAGE(PG8_SB(0, 0), b2, voffB); PG8_STAGE(PG8_SB(0, 1), b2 + hstepB, voffB); PG8_STAGE(PG8_SA(0, 0), a2, voffA);
            PG8_WAIT_V(8); PG8_WAIT_L(0); PG8_BAR; PG8_MMA(1, 0, At, B0); PG8_MMA(1, 1, At, B1); PG8_BAR; PG8_SCHED;
            PG8_LDB(B0, 1, 0); PG8_LDB(B1, 1, 1); PG8_SCHED; PG8_LDA(At, 1, 0); PG8_STAGE(PG8_SA(0, 1), a2 + hstepA, voffA);
            PG8_WAIT_V(8); PG8_WAIT_L(0); PG8_BAR; PG8_MMA(0, 0, At, B0); PG8_MMA(0, 1, At, B1); PG8_BAR; PG8_SCHED;
            PG8_LDA(At, 1, 1); PG8_STAGE(PG8_SB(1, 0), b3, voffB); PG8_STAGE(PG8_SB(1, 1), b3 + hstepB, voffB); PG8_STAGE(PG8_SA(1, 0), a3, voffA);
            PG8_WAIT_V(8); PG8_WAIT_L(0); PG8_BAR; PG8_MMA(1, 0, At, B0); PG8_MMA(1, 1, At, B1); PG8_BAR; PG8_SCHED;
        }
        if constexpr (ALIGN_EPI) { if (wr == 0) PG8_BAR; }
        E(acc, cur, wr, wc, fr, fq);
        if (!has_next) break;
#pragma unroll
        for (int a = 0; a < 2; ++a)
#pragma unroll
            for (int b = 0; b < 2; ++b)
#pragma unroll
                for (int m = 0; m < 4; ++m)
#pragma unroll
                    for (int n = 0; n < 2; ++n) acc[a][b][m][n] = (f32x4){0.f, 0.f, 0.f, 0.f};
        cur = nxt; cA = nA; cB = nB; ++ui;
        if constexpr (ALIGN_EPI) { if (wr == 1) PG8_BAR; }
    }
    PG8_WAIT_V(0);
    if constexpr (!ALIGN_EPI) { if (wr == 0) PG8_BAR; }
    PG8_BAR;
#undef PG8_AOFF
#undef PG8_SA
#undef PG8_SB
#undef PG8_STAGE
#undef PG8_LDA
#undef PG8_LDB
#undef PG8_MMA
#undef PG8_WAIT_V
#undef PG8_WAIT_L
#undef PG8_BAR
#undef PG8_SCHED
}
}

constexpr int NWAVES = 8, NTHR = 512;
constexpr int LDS_BYTES = 163840;
struct Args {
    const float* in[27]; float* out; unsigned char* ws; int ph_lo, ph_hi;
};
struct Frame {
    LAS unsigned char* lds; int tid, lane, wave, vcu, G;
};
constexpr int PTRS_OFF = LDS_BYTES - 256;
__device__ __forceinline__ const float* inp(LAS unsigned char* lds, int i) { return *(const float* LAS*)(lds + PTRS_OFF + i * 8); }
__device__ __forceinline__ int seq_row0(int q) { return q == 0 ? 0 : SP + (q - 1) * SS; }
__device__ __forceinline__ int seq_len(int q) { return q == 0 ? SP : SS; }

__device__ __forceinline__ void p0_transpose_item(const float* W, int K, int N, bf16_t* WT, const float* kscale, LAS float* scr, int item, int lane) {
    const int nblk = N / 32, kb = item / nblk, nb = item % nblk, k0 = 64 * kb, n0 = 32 * nb;
#pragma unroll 8
    for (int i = 0; i < 32; ++i) { const int kk = 2 * i + (lane >> 5); float v = W[(size_t)(k0 + kk) * N + n0 + (lane & 31)]; if (kscale) v *= kscale[k0 + kk]; scr[kk * 33 + (lane & 31)] = v; }
    LDS_WAIT(); asm volatile("" ::: "memory");
    const int c = lane & 7;
#pragma unroll
    for (int j = 0; j < 4; ++j) { const int n = (lane >> 3) + 8 * j; const LAS float* s = scr + (8 * c) * 33 + n;
        u32x4 o; o.x = cvt_pk_bf16(s[0 * 33], s[1 * 33]); o.y = cvt_pk_bf16(s[2 * 33], s[3 * 33]); o.z = cvt_pk_bf16(s[4 * 33], s[5 * 33]); o.w = cvt_pk_bf16(s[6 * 33], s[7 * 33]);
        *(u32x4*)(WT + (size_t)(n0 + n) * K + k0 + 8 * c) = o; }
    LDS_WAIT(); asm volatile("" ::: "memory");
}
__device__ __forceinline__ void p0_prologue(const Frame& F, const Args& a) {
    LAS float* scr = (LAS float*)(F.lds + F.wave * 16384);
    const int gw = F.vcu * NWAVES + F.wave, NGW = F.G * NWAVES;
    unsigned char* ws = a.ws;
    constexpr int I_IN = (DM / 64) * (ZP / 32), I_O = (DM / 64) * (DM / 32), I_1 = (DM / 64) * (DFF / 32), I_2 = (DFF / 64) * (DM / 32);
    for (int it = gw; it < I_IN + I_O + I_1 + I_2; it += NGW) {
        int r = it;
        if (r < I_IN) { p0_transpose_item(a.in[3], DM, ZP, (bf16_t*)(ws + WS_WIN), nullptr, scr, r, F.lane); continue; } r -= I_IN;
        if (r < I_O) { p0_transpose_item(a.in[23], DM, DM, (bf16_t*)(ws + WS_WOUT), nullptr, scr, r, F.lane); continue; } r -= I_O;
        if (r < I_1) { p0_transpose_item(a.in[25], DM, DFF, (bf16_t*)(ws + WS_W1), a.in[24], scr, r, F.lane); continue; } r -= I_1;
        p0_transpose_item(a.in[26], DFF, DM, (bf16_t*)(ws + WS_W2), nullptr, scr, r, F.lane);
    }
    bf16_t* XN = (bf16_t*)a.out; const float* g1 = a.in[2];
    for (int m = gw; m < MTOK; m += NGW) {
        const float* xrow = m < SP ? a.in[0] + (size_t)m * DM : a.in[1] + (size_t)(m - SP) * DM;
        const f32x4* xr = (const f32x4*)xrow + F.lane; f32x4 v[4]; float s = 0.f;
#pragma unroll
        for (int j = 0; j < 4; ++j) { v[j] = xr[64 * j]; s += (v[j][0] * v[j][0] + v[j][1] * v[j][1]) + (v[j][2] * v[j][2] + v[j][3] * v[j][3]); }
        const float rstd = 1.0f / sqrtf(wave_sum(s) * (1.f / DM) + NORM_EPS);
        u32x2* o8 = (u32x2*)(XN + (size_t)m * DM) + F.lane;
#pragma unroll
        for (int j = 0; j < 4; ++j) { const f32x4 gv = ((const f32x4*)g1)[F.lane + 64 * j]; u32x2 w; w.x = cvt_pk_bf16(v[j][0] * rstd * gv[0], v[j][1] * rstd * gv[1]); w.y = cvt_pk_bf16(v[j][2] * rstd * gv[2], v[j][3] * rstd * gv[3]); o8[64 * j] = w; }
    }
    const int gt = F.vcu * NTHR + F.tid, NGT = F.G * NTHR;
    float* rope = (float*)(ws + WS_ROPE);
    for (int e = gt; e < SP * 32; e += NGT) { const int pos = e >> 5, i = e & 31;
        const float invf = 1.0f / powf(10000.0f, (float)(2 * i) / 64.0f); const float ang = (float)pos * invf; float sn, cs; sincosf(ang, &sn, &cs);
        rope[2 * e] = cs; rope[2 * e + 1] = sn; }
    bf16_t* wupT = (bf16_t*)(ws + WS_LORA); bf16_t* aupT = wupT + 2 * 512 * 64; bf16_t* gupT = aupT + 2 * 512 * 64;
    for (int e = gt; e < 2 * 512 * 64; e += NGT) { const int d = e >> 15, c = (e >> 6) & 511, r = e & 63;
        wupT[e] = f2bf(a.in[14][((size_t)d * 64 + r) * 512 + c]); aupT[e] = f2bf(a.in[16][((size_t)d * 64 + r) * 512 + c]); }
    for (int e = gt; e < 512 * 128; e += NGT) { const int c = e >> 7, r = e & 127; gupT[e] = f2bf(a.in[17][(size_t)r * 512 + c]); }
}

__device__ __forceinline__ void qk_prep(const Frame& F, const Args& a) {
    const int gw = F.vcu * NWAVES + F.wave, NGW = F.G * NWAVES;
    bf16_t* Z = (bf16_t*)(a.ws + WS_Z); const float* rope = (const float*)(a.ws + WS_ROPE);
    const int g = F.lane >> 2, qd = F.lane & 3;
    const float* gain = (g < 8) ? a.in[4] : a.in[5];
    float glo[8], ghi[8];
#pragma unroll
    for (int j = 0; j < 8; ++j) { glo[j] = gain[8 * qd + j]; ghi[j] = gain[32 + 8 * qd + j]; }
    const float osc = (g < 8) ? QSCALE : 1.0f;
#pragma unroll 4
    for (int m = gw; m < MTOK; m += NGW) {
        const int pos = m < SP ? m : ((m - SP) & (SS - 1));
        bf16_t* p = Z + (size_t)m * ZP + g * 64 + 8 * qd;
        const u32x4 lo4 = *(const u32x4*)p, hi4 = *(const u32x4*)(p + 32);
        float lo[8], hi[8];
#pragma unroll
        for (int j = 0; j < 4; ++j) { lo[2 * j] = bflo(lo4[j]); lo[2 * j + 1] = bfhi(lo4[j]); hi[2 * j] = bflo(hi4[j]); hi[2 * j + 1] = bfhi(hi4[j]); }
        float ss = 0.f;
#pragma unroll
        for (int j = 0; j < 8; ++j) ss += lo[j] * lo[j] + hi[j] * hi[j];
        ss += __shfl_xor(ss, 1); ss += __shfl_xor(ss, 2);
        const float rstd = __builtin_amdgcn_rsqf(ss * (1.f / 64.f) + NORM_EPS);
        const f32x4* rp = (const f32x4*)(rope + ((size_t)pos * 32 + 8 * qd) * 2);
        float ol[8], oh[8];
#pragma unroll
        for (int j2 = 0; j2 < 4; ++j2) { const f32x4 cs = rp[j2];
#pragma unroll
            for (int e = 0; e < 2; ++e) { const int j = 2 * j2 + e; const float c = cs[2 * e], s = cs[2 * e + 1]; const float l = lo[j] * rstd * glo[j], h = hi[j] * rstd * ghi[j];
                ol[j] = (l * c - h * s) * osc; oh[j] = (h * c + l * s) * osc; } }
        u32x4 wl, wh;
#pragma unroll
        for (int j = 0; j < 4; ++j) { wl[j] = cvt_pk_bf16(ol[2 * j], ol[2 * j + 1]); wh[j] = cvt_pk_bf16(oh[2 * j], oh[2 * j + 1]); }
        *(u32x4*)p = wl; *(u32x4*)(p + 32) = wh;
    }
}

namespace att {
constexpr int KSLOT = 8192, VSLOT = 16384, NKS = 4, NVS = 3;
constexpr int L_K = 0, L_V = NKS * KSLOT, L_WS = L_V + NVS * VSLOT, L_ST = L_WS + NWAVES * 256, L_END = L_ST + NWAVES * 8192;
static_assert(L_END <= PTRS_OFF, "attention lds");
__device__ __forceinline__ int crow(int r, int hi) { return (r & 3) + 8 * (r >> 2) + 4 * hi; }
__device__ __forceinline__ void glds16(const void* gsrc, unsigned lds_dst) { unsigned keep;
    asm volatile("s_mov_b32 %0, m0\n\ts_mov_b32 m0, %2\n\ts_nop 0\n\tglobal_load_lds_dwordx4 %1, off\n\ts_mov_b32 m0, %0" : "=&s"(keep) : "v"(gsrc), "s"(lds_dst) : "memory"); }
typedef short v4i16_t __attribute__((ext_vector_type(4)));
typedef const LAS char* lds_cptr;
__device__ __forceinline__ s16x4 vtr(lds_cptr p) { return __builtin_bit_cast(s16x4, __builtin_amdgcn_ds_read_tr16_b64_v4i16((LAS v4i16_t*)p)); }
#define SBAR() __builtin_amdgcn_sched_barrier(0)
#define WAIT_BAR(N) asm volatile("s_waitcnt vmcnt(" #N ") lgkmcnt(0)\n\ts_barrier" ::: "memory")
__device__ __forceinline__ void kload8(bf16x8* kf, lds_cptr kp) {
    kf[0] = *(const LAS bf16x8*)(kp);        kf[1] = *(const LAS bf16x8*)(kp + 512);
    kf[2] = *(const LAS bf16x8*)(kp + 2048); kf[3] = *(const LAS bf16x8*)(kp + 2560);
    kf[4] = *(const LAS bf16x8*)(kp + 4096); kf[5] = *(const LAS bf16x8*)(kp + 4608);
    kf[6] = *(const LAS bf16x8*)(kp + 6144); kf[7] = *(const LAS bf16x8*)(kp + 6656);
}
__device__ __forceinline__ void kload2(bf16x8* kf, lds_cptr kp, int j) { kf[2 * j] = *(const LAS bf16x8*)(kp + j * 2048); kf[2 * j + 1] = *(const LAS bf16x8*)(kp + j * 2048 + 512); }

__device__ __forceinline__ void attn_unit(int row0, int S, int h, int qb, bf16_t* Z, LAS unsigned char* shm, float lam, const float* subln_g, bf16_t* Ob, int opitch) {
    int tid_ = threadIdx.x; asm volatile("" : "+v"(tid_));
    const int tid = tid_, lane = tid & 63, r32 = lane & 31, hi = lane >> 5; const int wid = __builtin_amdgcn_readfirstlane(tid >> 6);
    const unsigned lds0 = (unsigned)(uintptr_t)shm;
    LAS float* wsf = (LAS float*)(shm + L_WS) + wid * 64;
    LAS bf16_t* stash = (LAS bf16_t*)(shm + L_ST) + wid * 4096;
    const int NT = S / 64;
    const size_t qrow = (size_t)(row0 + qb * 256 + wid * 32);
    const lds_cptr shm3 = (lds_cptr)shm;
    const lds_cptr kp0 = shm3 + L_K + hi * 1024 + r32 * 16;
    const lds_cptr vp0 = shm3 + L_V + ((lane >> 4) & 1) * 32 + (lane & 3) * 8 + (4 * hi + ((lane & 15) >> 2)) * 64;
    f32x16 o[4];
#pragma unroll 1
    for (int c = 0; c < 2; ++c) {
        const bf16_t* Qw = Z + qrow * ZP + ZQ + h * 128 + c * 64;
        const bf16_t* Kh = Z + (size_t)row0 * ZP + ZK + h * 128 + c * 64;
        const bf16_t* Vh = Z + (size_t)row0 * ZP + ZV + h * 128;
        const int p0 = 2 * wid, p1 = 2 * wid + 1;
        const unsigned koff = (unsigned)(lane * ZP + wid * 8) * 2u;
        const unsigned voff0 = (unsigned)((16 * (p0 & 3) + (lane >> 2)) * ZP + (p0 >> 2) * 32 + (lane & 3) * 8) * 2u;
        const unsigned voff1 = (unsigned)((16 * (p1 & 3) + (lane >> 2)) * ZP + (p1 >> 2) * 32 + (lane & 3) * 8) * 2u;
        const unsigned kdst = lds0 + L_K + wid * 1024, vdst0 = lds0 + L_V + p0 * 1024, vdst1 = lds0 + L_V + p1 * 1024;
#define DMA_K(t, si) glds16((const char*)(Kh + (size_t)(t) * 64 * ZP) + koff, (unsigned)__builtin_amdgcn_readfirstlane(kdst + (si) * KSLOT))
#define DMA_V(t, si) do { const char* vb_ = (const char*)(Vh + (size_t)(t) * 64 * ZP); glds16(vb_ + voff0, (unsigned)__builtin_amdgcn_readfirstlane(vdst0 + (si) * VSLOT)); glds16(vb_ + voff1, (unsigned)__builtin_amdgcn_readfirstlane(vdst1 + (si) * VSLOT)); } while (0)
        DMA_K(0, 0); DMA_V(0, 0); DMA_K(1, 1);
        bf16x8 qr[4];
#pragma unroll
        for (int d0 = 0; d0 < 4; ++d0) qr[d0] = *(const bf16x8*)(Qw + (size_t)r32 * ZP + d0 * 16 + hi * 8);
#pragma unroll
        for (int d0 = 0; d0 < 4; ++d0) o[d0] = f32x16{};
        float l_reg = 0.f;
        bf16x8 kf[4];
        f32x16 pA0, pA1, pB0, pB1;
        int i_prev = 0, i_cur = 0, i_next = 1;
        int k_cur = 0, k_next = 1;
#define ROT() do { i_prev = i_cur; i_cur = i_next; i_next = (i_next == NVS - 1) ? 0 : i_next + 1; k_cur = k_next; k_next = (k_next + 1) & 3; } while (0)
#define KFRAG(slot, i) (*(const LAS bf16x8*)(kp0 + (slot) * KSLOT + ((i) >> 1) * 2048 + ((i) & 1) * 512))
        DMA_K(2, 2);
        WAIT_BAR(4);
        {
            const lds_cptr kb = kp0;
            pA0 = f32x16{}; pA1 = f32x16{};
#pragma unroll
            for (int d0 = 0; d0 < 4; ++d0) { const bf16x8 b0 = *(const LAS bf16x8*)(kb + d0 * 2048), b1 = *(const LAS bf16x8*)(kb + d0 * 2048 + 512);
                pA0 = __builtin_amdgcn_mfma_f32_32x32x16_bf16(b0, qr[d0], pA0, 0, 0, 0); pA1 = __builtin_amdgcn_mfma_f32_32x32x16_bf16(b1, qr[d0], pA1, 0, 0, 0); }
#pragma unroll
            for (int r = 0; r < 16; ++r) { pA0[r] = __builtin_amdgcn_exp2f(pA0[r]); pA1[r] = __builtin_amdgcn_exp2f(pA1[r]); }
        }
        WAIT_BAR(0);
        DMA_K(3, 3); DMA_V(1, 1);
        ROT();
        kf[0] = KFRAG(k_cur, 0); kf[1] = KFRAG(k_cur, 1); kf[2] = KFRAG(k_cur, 2); kf[3] = KFRAG(k_cur, 3);
        WAIT_BAR(3);
        s16x4 vlo[4], vhi[4]; u32x4 pw0, pw1, pw2, pw3;
#define PKW(P, B) cvt_pk_bf16(P[B], P[B + 1])
#define PAF(k) __builtin_bit_cast(bf16x8, pw##k)
#define VFR(i) (bf16x8){vlo[i][0], vlo[i][1], vlo[i][2], vlo[i][3], vhi[i][0], vhi[i][1], vhi[i][2], vhi[i][3]}
#define PIN(x) asm volatile("" : "+v"(x))
#define EX(v) __builtin_amdgcn_exp2f(v)
#define VRD(slot, f) do { vlo[slot] = vtr(vp_ + (((f) & 3) * 4096 + ((f) >> 2) * 1024)); vhi[slot] = vtr(vp_ + (((f) & 3) * 4096 + ((f) >> 2) * 1024 + 512)); } while (0)
#define GAPA(MF, LDX, A0, A1, A2, A3, W0, W1, PW) do { MF; LDX; sacc += A0; sacc += A1; sacc += A2; sacc += A3; PIN(sacc); W0; W1; PIN(PW); SBAR(); } while (0)
#define GAPB(MF, LDX, X, B) do { MF; LDX; X[B] = EX(X[B]); X[B + 1] = EX(X[B + 1]); PIN(X); SBAR(); } while (0)
#define PVM(f) o[(f) & 3] = __builtin_amdgcn_mfma_f32_32x32x16_bf16(__builtin_bit_cast(bf16x8, (f) < 4 ? pw0 : (f) < 8 ? pw1 : (f) < 12 ? pw2 : pw3), VFR((f) & 3), o[(f) & 3], 0, 0, 0)
#define NOP_ do { } while (0)
#define STEP(C0, C1, P0, P1, t, GK, GV, GL) do { SBAR(); \
        const lds_cptr vp_ = vp0 + i_prev * VSLOT; \
        float sacc = (P0[0] + P0[1]); \
        GAPA(C0 = __builtin_amdgcn_mfma_f32_32x32x16_bf16(kf[0], qr[0], (f32x16){}, 0, 0, 0), kf[0] = KFRAG(k_cur, 4), P0[2], P0[3], P0[4], P0[5],     pw0[0] = PKW(P0, 0), pw0[1] = PKW(P0, 2), pw0); \
        GAPA(C1 = __builtin_amdgcn_mfma_f32_32x32x16_bf16(kf[1], qr[0], (f32x16){}, 0, 0, 0), kf[1] = KFRAG(k_cur, 5), P0[6], P0[7], P0[8], P0[9],     pw0[2] = PKW(P0, 4), pw0[3] = PKW(P0, 6), pw0); \
        GAPA(C0 = __builtin_amdgcn_mfma_f32_32x32x16_bf16(kf[2], qr[1], C0, 0, 0, 0),         kf[2] = KFRAG(k_cur, 6), P0[10], P0[11], P0[12], P0[13], pw1[0] = PKW(P0, 8), pw1[1] = PKW(P0, 10), pw1); \
        GAPA(C1 = __builtin_amdgcn_mfma_f32_32x32x16_bf16(kf[3], qr[1], C1, 0, 0, 0),         kf[3] = KFRAG(k_cur, 7), P0[14], P0[15], P1[0], P1[1],   pw1[2] = PKW(P0, 12), pw1[3] = PKW(P0, 14), pw1); \
        GAPA(C0 = __builtin_amdgcn_mfma_f32_32x32x16_bf16(kf[0], qr[2], C0, 0, 0, 0),         VRD(0, 0), P1[2], P1[3], P1[4], P1[5],     pw2[0] = PKW(P1, 0), pw2[1] = PKW(P1, 2), pw2); \
        GAPA(C1 = __builtin_amdgcn_mfma_f32_32x32x16_bf16(kf[1], qr[2], C1, 0, 0, 0),         VRD(1, 1), P1[6], P1[7], P1[8], P1[9],     pw2[2] = PKW(P1, 4), pw2[3] = PKW(P1, 6), pw2); \
        GAPA(C0 = __builtin_amdgcn_mfma_f32_32x32x16_bf16(kf[2], qr[3], C0, 0, 0, 0),         VRD(2, 2), P1[10], P1[11], P1[12], P1[13], pw3[0] = PKW(P1, 8), pw3[1] = PKW(P1, 10), pw3); \
        GAPA(C1 = __builtin_amdgcn_mfma_f32_32x32x16_bf16(kf[3], qr[3], C1, 0, 0, 0),         VRD(3, 3), P1[14], P1[15], 0.f, 0.f,       pw3[2] = PKW(P1, 12), pw3[3] = PKW(P1, 14), pw3); \
        l_reg += sacc; \
        if (GK) { DMA_K((t) + 3, (k_cur + 3) & 3); } if (GV) { DMA_V((t) + 1, i_next); } \
        SBAR(); \
        GAPB(PVM(0), VRD(0, 4), C0, 0);   GAPB(PVM(1), VRD(1, 5), C0, 2);   GAPB(PVM(2), VRD(2, 6), C0, 4);    GAPB(PVM(3), VRD(3, 7), C0, 6); \
        GAPB(PVM(4), VRD(0, 8), C0, 8);   GAPB(PVM(5), VRD(1, 9), C0, 10);  GAPB(PVM(6), VRD(2, 10), C0, 12);  GAPB(PVM(7), VRD(3, 11), C0, 14); \
        GAPB(PVM(8), VRD(0, 12), C1, 0);  GAPB(PVM(9), VRD(1, 13), C1, 2);  GAPB(PVM(10), VRD(2, 14), C1, 4);  GAPB(PVM(11), VRD(3, 15), C1, 6); \
        GAPB(PVM(12), if (GL) kf[0] = KFRAG(k_next, 0), C1, 8);  GAPB(PVM(13), if (GL) kf[1] = KFRAG(k_next, 1), C1, 10); \
        GAPB(PVM(14), if (GL) kf[2] = KFRAG(k_next, 2), C1, 12); GAPB(PVM(15), if (GL) kf[3] = KFRAG(k_next, 3), C1, 14); \
        } while (0)
        int t = 1;
#pragma unroll 1
        for (; t + 5 < NT; t += 2) {
            STEP(pB0, pB1, pA0, pA1, t, true, true, true);     WAIT_BAR(3); ROT();
            STEP(pA0, pA1, pB0, pB1, t + 1, true, true, true); WAIT_BAR(3); ROT();
        }
#define ENDW(tt) do { if ((tt) + 3 < NT) { WAIT_BAR(3); } else if ((tt) + 2 < NT) { WAIT_BAR(2); } else { WAIT_BAR(0); } } while (0)
#pragma unroll 1
        for (; t + 1 < NT; t += 2) {
            STEP(pB0, pB1, pA0, pA1, t, (t + 3 < NT), (t + 1 < NT), (t + 1 < NT));         ENDW(t);     ROT();
            STEP(pA0, pA1, pB0, pB1, t + 1, (t + 4 < NT), (t + 2 < NT), (t + 2 < NT));     ENDW(t + 1); ROT();
        }
        STEP(pB0, pB1, pA0, pA1, NT - 1, false, false, false);
        {
            float sacc = pB0[0] + pB0[1];
#pragma unroll
            for (int r = 2; r < 16; ++r) sacc += pB0[r];
#pragma unroll
            for (int r = 0; r < 16; ++r) sacc += pB1[r];
            l_reg += sacc;
            pw0 = (u32x4){PKW(pB0, 0), PKW(pB0, 2), PKW(pB0, 4), PKW(pB0, 6)}; pw1 = (u32x4){PKW(pB0, 8), PKW(pB0, 10), PKW(pB0, 12), PKW(pB0, 14)};
            pw2 = (u32x4){PKW(pB1, 0), PKW(pB1, 2), PKW(pB1, 4), PKW(pB1, 6)}; pw3 = (u32x4){PKW(pB1, 8), PKW(pB1, 10), PKW(pB1, 12), PKW(pB1, 14)};
            const lds_cptr vp_ = vp0 + i_cur * VSLOT;
            VRD(0, 0); VRD(1, 1); VRD(2, 2); VRD(3, 3); PVM(0); PVM(1); PVM(2); PVM(3);
            VRD(0, 4); VRD(1, 5); VRD(2, 6); VRD(3, 7); PVM(4); PVM(5); PVM(6); PVM(7);
            VRD(0, 8); VRD(1, 9); VRD(2, 10); VRD(3, 11); PVM(8); PVM(9); PVM(10); PVM(11);
            VRD(0, 12); VRD(1, 13); VRD(2, 14); VRD(3, 15); PVM(12); PVM(13); PVM(14); PVM(15);
        }
#undef DMA_K
#undef DMA_V
#undef ROT
#undef PKW
#undef PAF
#undef VFR
#undef PIN
#undef EX
#undef VRD
#undef GAPA
#undef GAPB
#undef KFRAG
#undef NOP_
#undef PVM
#undef STEP
#undef ENDW
        { auto rr = __builtin_amdgcn_permlane32_swap(__float_as_uint(l_reg), __float_as_uint(l_reg), false, false); l_reg = __uint_as_float(rr[0]) + __uint_as_float(rr[1]); }
        if (hi == 0) wsf[r32] = l_reg;
        LDS_WAIT();
        float rli[16];
#pragma unroll
        for (int r = 0; r < 16; ++r) rli[r] = 1.0f / wsf[crow(r, hi)];
        if (c == 0) {
#pragma unroll
            for (int d0 = 0; d0 < 4; ++d0)
#pragma unroll
                for (int r = 0; r < 16; ++r) stash[(d0 * 16 + r) * 64 + lane] = f2bf(o[d0][r] * rli[r]);
            LDS_WAIT();
        } else {
#pragma unroll
            for (int d0 = 0; d0 < 4; ++d0)
#pragma unroll
                for (int r = 0; r < 16; ++r) o[d0][r] = bf2f(stash[(d0 * 16 + r) * 64 + lane]) - lam * (o[d0][r] * rli[r]);
            LDS_WAIT(); asm volatile("" ::: "memory");
#pragma unroll
            for (int d0 = 0; d0 < 4; ++d0)
#pragma unroll
                for (int r = 0; r < 16; ++r) stash[crow(r, hi) * 128 + d0 * 32 + r32] = f2bf(o[d0][r]);
            LDS_WAIT(); asm volatile("" ::: "memory");
            bf16_t* Ow = Ob + qrow * opitch + ZQ + h * 128;
#pragma unroll
            for (int i = 0; i < 4; ++i) { const int row = i * 8 + (lane >> 3), ch = lane & 7;
                const u32x4 w0 = *(const LAS u32x4*)(stash + row * 128 + ch * 16), w1 = *(const LAS u32x4*)(stash + row * 128 + ch * 16 + 8);
                float v[16];
#pragma unroll
                for (int j = 0; j < 4; ++j) { v[2 * j] = bflo(w0[j]); v[2 * j + 1] = bfhi(w0[j]); v[8 + 2 * j] = bflo(w1[j]); v[9 + 2 * j] = bfhi(w1[j]); }
                float ss = 0.f;
#pragma unroll
                for (int j = 0; j < 16; ++j) ss += v[j] * v[j];
                ss += __shfl_xor(ss, 1); ss += __shfl_xor(ss, 2); ss += __shfl_xor(ss, 4);
                const float rs = (1.0f - LAMBDA_INIT) / sqrtf(ss * (1.f / 128.f) + NORM_EPS);
                u32x4 x0, x1;
#pragma unroll
                for (int j = 0; j < 4; ++j) { x0[j] = cvt_pk_bf16(v[2 * j] * rs * subln_g[ch * 16 + 2 * j], v[2 * j + 1] * rs * subln_g[ch * 16 + 2 * j + 1]);
                                              x1[j] = cvt_pk_bf16(v[8 + 2 * j] * rs * subln_g[ch * 16 + 8 + 2 * j], v[9 + 2 * j] * rs * subln_g[ch * 16 + 9 + 2 * j]); }
                *(u32x4*)(Ow + (size_t)row * opitch + ch * 16) = x0; *(u32x4*)(Ow + (size_t)row * opitch + ch * 16 + 8) = x1; }
            LDS_WAIT();
        }
        asm volatile("s_waitcnt vmcnt(0) lgkmcnt(0)\n\ts_barrier" ::: "memory");
    }
}
#undef SBAR
#undef WAIT_BAR
}

namespace rw {
constexpr int P = 144, MAT = 64 * P;
constexpr int O_AT = 0, O_RT = MAT, O_BT = 2 * MAT, O_KT = 3 * MAT, O_ATT = 4 * MAT, O_VT = 5 * MAT, O_BHT = 6 * MAT, O_KHT = 7 * MAT;
constexpr int O_LAB = 8 * MAT, O_LAK = 9 * MAT, O_ARB = 10 * MAT, O_ARK = 11 * MAT, O_XT = 12 * MAT, O_ABT = 13 * MAT, O_U0T = 14 * MAT;
constexpr int O_LABD = 15 * MAT, O_TII = O_LABD + 4096, O_WC = O_TII + 2048, O_GSUM = O_WC + 256, O_PAR = O_GSUM + 2048, O_END = O_PAR + 960 * 4;
constexpr int O_ZS = 0;
constexpr int O_TW = O_LAB, O_ADN = O_LAK, O_WL = O_ARB, O_AR = O_XT, PF = 272;
static_assert(O_END <= PTRS_OFF - 64 && 64 * PF <= 2 * MAT, "rwkv lds");
__device__ __forceinline__ int crow(int r, int hi) { return (r & 3) + 8 * (r >> 2) + 4 * hi; }
__device__ __forceinline__ float sigmoidf_(float x) { return __builtin_amdgcn_rcpf(1.0f + __expf(-x)); }
__device__ __forceinline__ float tanhf_(float x) { return 1.0f - 2.0f * __builtin_amdgcn_rcpf(__expf(2.0f * x) + 1.0f); }
__device__ __forceinline__ void load10(const bf16_t* zc, int t_lo, int S, float (&z)[10]) {
#pragma unroll
    for (int i = 0; i < 10; ++i) { const int t = t_lo - 1 + i; z[i] = (t >= 0 && t < S) ? bf2f(zc[(size_t)t * ZP]) : 0.f; }
}
__device__ __forceinline__ float tshift(const float (&z)[10], int u, float mp, float mn) { const float c = z[u + 1]; return c + mp * (z[u] - c) + mn * (z[u + 2] - c); }
__device__ __forceinline__ f32x16 mm_ll(const LAS unsigned char* A, int rowA, const LAS unsigned char* B, int rowB, f32x16 acc, int r32, int hi) {
#pragma unroll
    for (int ks = 0; ks < 4; ++ks) { const bf16x8 a = *(const LAS bf16x8*)(A + (rowA + r32) * P + (16 * ks + 8 * hi) * 2), b = *(const LAS bf16x8*)(B + (rowB + r32) * P + (16 * ks + 8 * hi) * 2);
        acc = __builtin_amdgcn_mfma_f32_32x32x16_bf16(a, b, acc, 0, 0, 0); }
    return acc;
}
__device__ __forceinline__ void store_native(unsigned char* dst, const f32x16& acc, int lane, bool wt) {
    u32x4 w0, w1;
#pragma unroll
    for (int q = 0; q < 4; ++q) { w0[q] = cvt_pk_bf16(acc[2 * q], acc[2 * q + 1]); w1[q] = cvt_pk_bf16(acc[8 + 2 * q], acc[9 + 2 * q]); }
    if (wt) {
        asm volatile("global_store_dwordx4 %0, %1, off sc1\n\tglobal_store_dwordx4 %0, %2, off offset:16 sc1\n\ts_nop 1" :: "v"(dst + lane * 32), "v"(w0), "v"(w1) : "memory");
    } else { *(u32x4*)(dst + lane * 32) = w0; *(u32x4*)(dst + lane * 32 + 16) = w1; }
}
__device__ __forceinline__ void st4(LAS unsigned char* p, float a, float b, float c, float d) { u32x2 w; w.x = cvt_pk_bf16(a, b); w.y = cvt_pk_bf16(c, d); *(LAS u32x2*)p = w; }

__device__ __forceinline__ f32x2_t s1_param_load(LAS unsigned char* L, int tid, int d, int h) {
    const int seg = tid >> 5, off = (tid & 31) * 2; f32x2_t r = {0.f, 0.f};
    if (seg < 15) { const float* src;
        if (seg < 10) src = inp(L, 11 + (seg & 1)) + (seg < 6 ? (seg >> 1) * 512 + h * 64 : (seg < 8 ? ZWD - ZRR : ZAD - ZRR));
        else if (seg == 10) src = inp(L, 13) + d * 512 + h * 64; else if (seg == 11) src = inp(L, 15) + d * 512 + h * 64;
        else src = inp(L, 18 + (seg - 12)) + h * 64;
        r = *(const f32x2_t*)(src + off); }
    return r;
}
__device__ __forceinline__ void s1_stage_load(const Args& a, int tid, int q, int h, int ck, u32x4 (&v)[6]) {
    const int row0 = seq_row0(q), S = seq_len(q), t0 = ck * 64;
    const bf16_t* Zs = (const bf16_t*)(a.ws + WS_Z) + (size_t)row0 * ZP;
#pragma unroll
    for (int k = 0; k < 6; ++k) { const int c = tid + k * NTHR; const int seg = c >> 3, part = c & 7, row = seg / 5, grp = seg - row * 5, t = t0 - 1 + row;
        const int colb = grp < 3 ? ZRR + grp * 512 + h * 64 : (grp == 3 ? ZWD : ZAD);
        v[k] = (u32x4){0u, 0u, 0u, 0u};
        if (c < 66 * 5 * 8 && t >= 0 && t < S) v[k] = *(const u32x4*)(Zs + (size_t)t * ZP + colb + part * 8); }
}
__device__ __forceinline__ void s1_item(const Frame& F, const Args& a, int d, int q, int h, int ck, unsigned char* slot, u32x4 (&stg)[6], f32x2_t& par, bool has_next, int nd, int nq, int nh, int nck, bool wt, unsigned* publish_prev) {
    LAS unsigned char* L = F.lds;
#if PROBE_S1 >= 0
    unsigned long long pt_last = 0; int pt_n = 0;
#define PST() do { if (F.tid == 0) { const unsigned long long n_ = __builtin_amdgcn_s_memrealtime(); if (pt_n == PROBE_S1 + 1) *(LAS unsigned long long*)(L + PTRS_OFF - 64) += n_ - pt_last; pt_last = n_; } ++pt_n; } while (0)
#else
#define PST() do { } while (0)
#endif
    PST();
    int lane_ = F.lane; asm volatile("" : "+v"(lane_));
    const int lane = lane_, w = F.wave, tid = w * 64 + lane, r32 = lane & 31, hi = lane >> 5;
    const int j = lane, tg = w;
    const int row0 = seq_row0(q), S = seq_len(q), t0 = ck * 64;
    const bf16_t* Zs = (const bf16_t*)(a.ws + WS_Z) + (size_t)row0 * ZP;
    const int t_lo = d == 0 ? t0 + 8 * tg : t0 + 56 - 8 * tg;
    const int tau0 = 8 * tg;
#define TAU(u) (d == 0 ? tau0 + (u) : tau0 + 7 - (u))
    const int ch = h * 64 + j;
    bf16x8 wfr[4];
    { const int which = w >> 2, mt = (w >> 1) & 1;
      const bf16_t* WT = (const bf16_t*)(a.ws + WS_LORA) + (which ? 2 * 512 * 64 : 0) + ((size_t)d * 512 + h * 64 + 32 * mt + r32) * 64;
#pragma unroll
      for (int ks = 0; ks < 4; ++ks) wfr[ks] = *(const bf16x8*)(WT + 16 * ks + 8 * hi); }
    {
#pragma unroll
        for (int k = 0; k < 6; ++k) { const int c = tid + k * NTHR; const int seg = c >> 3, part = c & 7, row = seg / 5, grp = seg - row * 5;
            if (c < 66 * 5 * 8) *(LAS u32x4*)(L + O_ZS + (grp * 66 + row) * P + part * 16) = stg[k]; }
        if (tid < 480) *(LAS f32x2_t*)(L + O_PAR + tid * 8) = par;
    }
    if (publish_prev) asm volatile("s_waitcnt vmcnt(0)" ::: "memory");
    __syncthreads(); PST();
    if (publish_prev && tid == 0) __hip_atomic_fetch_add(publish_prev, 1u, __ATOMIC_RELAXED, __HIP_MEMORY_SCOPE_AGENT);
    if (has_next) { s1_stage_load(a, tid, nq, nh, nck, stg); par = s1_param_load(L, tid, nd, nh); }
#define PAR(seg, idx) (*(const LAS float*)(L + O_PAR + ((seg) * 64 + (idx)) * 4))
    const LAS unsigned char* zsb = L + O_ZS + (t_lo - t0) * P + j * 2;
#define LD10(z, g) do { _Pragma("unroll") for (int i_ = 0; i_ < 10; ++i_) z[i_] = bf2f(*(const LAS bf16_t*)(zsb + ((g) * 66 + i_) * P)); } while (0)
    {
        float zw[10], za[10]; LD10(zw, 3); LD10(za, 4);
        const float mpw = PAR(6, j), mnw = PAR(7, j), mpa = PAR(8, j), mna = PAR(9, j);
#pragma unroll
        for (int u = 0; u < 8; ++u) { const int tau = TAU(u);
            *(LAS bf16_t*)(L + O_TW + tau * P + j * 2) = f2bf(tanhf_(tshift(zw, u, mpw, mnw)));
            *(LAS bf16_t*)(L + O_ADN + tau * P + j * 2) = f2bf(tshift(za, u, mpa, mna)); }
    }
    __syncthreads(); PST();
    {
        const int which = w >> 2, mt = (w >> 1) & 1, nt = w & 1;
        const LAS unsigned char* B = L + (which ? O_ADN : O_TW);
        f32x16 acc = f32x16{};
#pragma unroll
        for (int ks = 0; ks < 4; ++ks) { const bf16x8 bv = *(const LAS bf16x8*)(B + (32 * nt + r32) * P + (16 * ks + 8 * hi) * 2);
            acc = __builtin_amdgcn_mfma_f32_32x32x16_bf16(wfr[ks], bv, acc, 0, 0, 0); }
        LAS unsigned char* O = L + (which ? O_AR : O_WL) + (32 * nt + r32) * PF;
#pragma unroll
        for (int g = 0; g < 4; ++g) { const int jj = 8 * g + 4 * hi; const f32x4 bv = *(const LAS f32x4*)(L + O_PAR + ((10 + which) * 64 + 32 * mt + jj) * 4);
            *(LAS f32x4*)(O + (32 * mt + jj) * 4) = (f32x4){acc[4 * g] + bv[0], acc[4 * g + 1] + bv[1], acc[4 * g + 2] + bv[2], acc[4 * g + 3] + bv[3]}; }
    }
    __syncthreads(); PST();
    float aa[8], bb[8], rr[8], kd[8], vv[8], ld[8];
    {
        float zr[10], zk[10], zv[10]; LD10(zr, 0); LD10(zk, 1); LD10(zv, 2);
        const float mpr = PAR(0, j), mnr = PAR(1, j), mpk = PAR(2, j), mnk = PAR(3, j), mpv = PAR(4, j), mnv = PAR(5, j);
        const float kkc = PAR(12, j), kac = PAR(13, j), rkc = PAR(14, j);
        float* bon = (float*)(a.ws + WS_BONUS) + ((size_t)d * MTOK + row0) * 8 + h;
#pragma unroll
        for (int u = 0; u < 8; ++u) { const int tau = TAU(u);
            const float wl = *(const LAS float*)(L + O_WL + tau * PF + j * 4), ar = *(const LAS float*)(L + O_AR + tau * PF + j * 4);
            ld[u] = -0.6065306597126334f * sigmoidf_(wl); const float arate = sigmoidf_(ar);
            rr[u] = tshift(zr, u, mpr, mnr); const float k0 = tshift(zk, u, mpk, mnk); vv[u] = tshift(zv, u, mpv, mnv);
            const float kkr = k0 * kkc; const float ssq = wave_sum_dpp(kkr * kkr); const float kkn = kkr * __builtin_amdgcn_rsqf(ssq + 1e-12f);
            kd[u] = k0 * (1.0f + (arate - 1.0f) * kac); aa[u] = -kkn; bb[u] = kkn * arate;
            const float bsum = wave_sum_dpp(rr[u] * kd[u] * rkc);
            if (lane == 0) bon[(size_t)(t_lo + u) * 8] = bsum; }
        float tot = 0.f;
#pragma unroll
        for (int u = 0; u < 8; ++u) tot += ld[u];
        *(LAS float*)(L + O_GSUM + tg * 256 + j * 4) = tot;
    }
    __syncthreads(); PST();
    {
        float pre = 0.f, cC = 0.f;
#pragma unroll
        for (int g = 0; g < 8; ++g) { const float s = *(const LAS float*)(L + O_GSUM + g * 256 + j * 4); cC += s; if (g < tg) pre += s; }
        float tot = 0.f;
#pragma unroll
        for (int u = 0; u < 8; ++u) tot += ld[u];
        float At[8], Vt[8], Bh[8], Kh[8]; float pf = 0.f;
#pragma unroll
        for (int u = 0; u < 8; ++u) { pf += ld[u]; const int tau = TAU(u);
            const float cl = pre + (d == 0 ? pf : tot - pf + ld[u]);
            const float e_m1 = __expf(cl - ld[u]), e_p = __expf(cl), e_n = __expf(-cl), e_c = __expf(cC - cl);
            At[u] = aa[u] * e_m1; Vt[u] = vv[u]; Bh[u] = bb[u] * e_c; Kh[u] = kd[u] * e_c;
            *(LAS bf16_t*)(L + O_AT + tau * P + j * 2) = f2bf(At[u]); *(LAS bf16_t*)(L + O_RT + tau * P + j * 2) = f2bf(rr[u] * e_p);
            *(LAS bf16_t*)(L + O_BT + tau * P + j * 2) = f2bf(bb[u] * e_n); *(LAS bf16_t*)(L + O_KT + tau * P + j * 2) = f2bf(kd[u] * e_n); }
#define PK8(dst, X) do { u32x4 w_; _Pragma("unroll") for (int k = 0; k < 4; ++k) { const float x0 = d == 0 ? X[2 * k] : X[7 - 2 * k], x1 = d == 0 ? X[2 * k + 1] : X[6 - 2 * k]; w_[k] = cvt_pk_bf16(x0, x1); } \
            *(LAS u32x4*)(L + (dst) + j * P + tau0 * 2) = w_; } while (0)
        PK8(O_ATT, At); PK8(O_VT, Vt); PK8(O_BHT, Bh); PK8(O_KHT, Kh);
#undef PK8
        if (tg == 0) *(LAS float*)(L + O_WC + j * 4) = __expf(cC);
    }
    __syncthreads(); PST();
#pragma unroll
    for (int i = 0; i < 2; ++i) {
        const int ti = 2 * w + i, ms = ti >> 2, nl = ti & 3;
        const int sb = 32 * (ms & 1), tb = 32 * (nl & 1);
        f32x16 acc = f32x16{};
        acc = mm_ll(L + (ms < 2 ? O_BT : O_KT), sb, L + (nl < 2 ? O_AT : O_RT), tb, acc, r32, hi);
        const bool incl = nl >= 2; const int dst = ms < 2 ? (nl < 2 ? O_LAB : O_ARB) : (nl < 2 ? O_LAK : O_ARK);
        const int t = tb + r32;
#pragma unroll
        for (int g = 0; g < 4; ++g) { const int s0 = sb + 8 * g + 4 * hi; float v[4];
#pragma unroll
            for (int e = 0; e < 4; ++e) { const int s = s0 + e; v[e] = (incl ? (s <= t) : (s < t)) ? acc[4 * g + e] : 0.f; }
            st4(L + dst + t * P + s0 * 2, v[0], v[1], v[2], v[3]);
            if (dst == O_LAB && (s0 >> 4) == (t >> 4)) *(LAS f32x4*)(L + O_LABD + (((t >> 4) * 16 + (t & 15)) * 16 + (s0 & 15)) * 4) = (f32x4){v[0], v[1], v[2], v[3]}; }
    }
    __syncthreads(); PST();
    if (w < 4) {
        const int mt = w >> 1, nt = w & 1; f32x16 acc = f32x16{};
        acc = mm_ll(L + O_LAK, 32 * mt, L + O_VT, 32 * nt, acc, r32, hi);
#pragma unroll
        for (int g = 0; g < 4; ++g) st4(L + O_XT + (32 * nt + r32) * P + (32 * mt + 8 * g + 4 * hi) * 2, acc[4 * g], acc[4 * g + 1], acc[4 * g + 2], acc[4 * g + 3]);
    } else if (w == 7) {
        const int blk = lane >> 4, cc = lane & 15; float x[16];
#pragma unroll
        for (int t = 0; t < 16; ++t) { float s = (t == cc) ? 1.f : 0.f; const LAS float* lr = (const LAS float*)(L + O_LABD + ((blk * 16 + t) * 16) * 4);
#pragma unroll
            for (int k = 0; k < t; ++k) s += lr[k] * x[k];
            x[t] = s; *(LAS bf16_t*)(L + O_TII + ((blk * 16 + t) * 16 + cc) * 2) = f2bf(s); }
    }
    __syncthreads(); PST();
    {
        const int c16 = lane & 15, q4 = lane >> 4;
        const LAS unsigned char* RT = L + (w < 4 ? O_ATT : O_XT) + (16 * (w & 3) + c16) * P;
        LAS unsigned char* OT = L + (w < 4 ? O_ABT : O_U0T) + (16 * (w & 3) + c16) * P;
        const LAS unsigned char* LA = L + O_LAB + c16 * P;
#define RHS(i) ({ const u32x2 r_ = *(const LAS u32x2*)(RT + (16 * (i) + 4 * q4) * 2); (f32x4){bflo(r_.x), bfhi(r_.x), bflo(r_.y), bfhi(r_.y)}; })
#define AFR(i, k1, k2) ({ const u32x2 lo_ = *(const LAS u32x2*)(LA + 16 * (i) * P + (16 * (k1) + 4 * q4) * 2); u32x2 hi_ = {0u, 0u}; if ((k2) >= 0) hi_ = *(const LAS u32x2*)(LA + 16 * (i) * P + (16 * ((k2) < 0 ? 0 : (k2)) + 4 * q4) * 2); \
        __builtin_bit_cast(bf16x8, (u32x4){lo_.x, lo_.y, hi_.x, hi_.y}); })
#define TFR(i) ({ const u32x2 lo_ = *(const LAS u32x2*)(L + O_TII + (((i) * 16 + c16) * 16 + 4 * q4) * 2); __builtin_bit_cast(bf16x8, (u32x4){lo_.x, lo_.y, 0u, 0u}); })
#define BFR(U1, U2) __builtin_bit_cast(bf16x8, (u32x4){cvt_pk_bf16(U1[0], U1[1]), cvt_pk_bf16(U1[2], U1[3]), cvt_pk_bf16(U2[0], U2[1]), cvt_pk_bf16(U2[2], U2[3])})
#define MF16(A_, B_, C_) __builtin_amdgcn_mfma_f32_16x16x32_bf16(A_, B_, C_, 0, 0, 0)
        const f32x4 zero4 = {0.f, 0.f, 0.f, 0.f};
        f32x4 U0 = MF16(TFR(0), BFR(RHS(0), zero4), zero4);
        f32x4 Z1 = MF16(AFR(1, 0, -1), BFR(U0, zero4), RHS(1));
        f32x4 U1 = MF16(TFR(1), BFR(Z1, zero4), zero4);
        f32x4 Z2 = MF16(AFR(2, 0, 1), BFR(U0, U1), RHS(2));
        f32x4 U2 = MF16(TFR(2), BFR(Z2, zero4), zero4);
        f32x4 Z3 = MF16(AFR(3, 0, 1), BFR(U0, U1), RHS(3));
        Z3 = MF16(AFR(3, 2, -1), BFR(U2, zero4), Z3);
        f32x4 U3 = MF16(TFR(3), BFR(Z3, zero4), zero4);
        st4(OT + (0 + 4 * q4) * 2, U0[0], U0[1], U0[2], U0[3]); st4(OT + (16 + 4 * q4) * 2, U1[0], U1[1], U1[2], U1[3]);
        st4(OT + (32 + 4 * q4) * 2, U2[0], U2[1], U2[2], U2[3]); st4(OT + (48 + 4 * q4) * 2, U3[0], U3[1], U3[2], U3[3]);
#undef RHS
#undef AFR
#undef TFR
#undef BFR
#undef MF16
    }
    __syncthreads(); PST();
    {
        const int mt = (w >> 1) & 1, nt = w & 1;
        if (w < 4) {
            f32x16 acc = f32x16{};
            acc = mm_ll(L + O_ABT, 32 * mt, L + O_BHT, 32 * nt, acc, r32, hi);
            if (mt == nt) { const float wc = *(const LAS float*)(L + O_WC + (32 * nt + r32) * 4);
#pragma unroll
                for (int r = 0; r < 16; ++r) if (crow(r, hi) == r32) acc[r] += wc; }
            store_native(slot + (mt * 2 + nt) * 2048, acc, lane, wt);
            f32x16 rb;
#pragma unroll
            for (int g = 0; g < 4; ++g) { const u32x2 r_ = *(const LAS u32x2*)(L + O_RT + (32 * nt + r32) * P + (32 * mt + 8 * g + 4 * hi) * 2);
                rb[4 * g] = bflo(r_.x); rb[4 * g + 1] = bfhi(r_.x); rb[4 * g + 2] = bflo(r_.y); rb[4 * g + 3] = bfhi(r_.y); }
            rb = mm_ll(L + O_ABT, 32 * mt, L + O_ARB, 32 * nt, rb, r32, hi);
            store_native(slot + 16384 + (mt * 2 + nt) * 2048, rb, lane, wt);
        } else {
            f32x16 acc = f32x16{};
            acc = mm_ll(L + O_BHT, 32 * mt, L + O_U0T, 32 * nt, acc, r32, hi);
            acc = mm_ll(L + O_KHT, 32 * mt, L + O_VT, 32 * nt, acc, r32, hi);
            store_native(slot + 8192 + (mt * 2 + nt) * 2048, acc, lane, wt);
            f32x16 y0 = f32x16{};
            y0 = mm_ll(L + O_ARB, 32 * mt, L + O_U0T, 32 * nt, y0, r32, hi);
            y0 = mm_ll(L + O_ARK, 32 * mt, L + O_VT, 32 * nt, y0, r32, hi);
            store_native(slot + 24576 + (mt * 2 + nt) * 2048, y0, lane, wt);
        }
    }
    __syncthreads(); PST();
#undef PAR
#undef TAU
#undef LD10
#undef PST
}

__device__ __forceinline__ void s23_wait_round(unsigned* ready, int r, int lane) {
    unsigned spins = 0;
    while ((unsigned)__builtin_amdgcn_readfirstlane(__hip_atomic_load(ready + r, __ATOMIC_RELAXED, __HIP_MEMORY_SCOPE_AGENT)) < 16u) { __builtin_amdgcn_s_sleep(8); if (++spins > (1u << 22)) break; }
    __builtin_amdgcn_fence(__ATOMIC_ACQUIRE, "agent");
    asm volatile("s_waitcnt vmcnt(0)" ::: "memory");
}
__device__ __forceinline__ void s23_chain_wg(const Frame& F, const Args& a, int d, int q, int h, unsigned char* slots  , unsigned* ready) {
    LAS unsigned char* L = F.lds;
    const int lane = F.lane, w = F.wave, r32 = lane & 31, hi = lane >> 5, icb = w & 1;
    const int row0 = seq_row0(q), NC = seq_len(q) / 64;
    bf16_t* Zy = (bf16_t*)(a.ws + WS_Z) + (size_t)row0 * ZP + (d == 0 ? ZRR : ZRK) + h * 64 + 32 * icb + r32;
    f32x16 X0 = f32x16{}, X1 = f32x16{};
    const bool loader = w >= 4, compute = w < 2;
#define CKOF(cc) (d == 0 ? (cc) : NC - 1 - (cc))
#define S23_DMA(cc) do { const unsigned char* src_ = slots + (size_t)CKOF(cc) * SLOT_BYTES + (w - 4) * 8192 + lane * 16; LAS unsigned char* dst_ = L + ((cc) & 3) * 32768 + (w - 4) * 8192; \
        _Pragma("unroll") for (int p_ = 0; p_ < 8; ++p_) __builtin_amdgcn_global_load_lds((const unsigned*)(src_ + p_ * 1024), (LAS unsigned*)(dst_ + p_ * 1024), 16, 0, 0); } while (0)
#define UNPK(dst, w0, w1) do { _Pragma("unroll") for (int q_ = 0; q_ < 4; ++q_) { dst[2 * q_] = bflo(w0[q_]); dst[2 * q_ + 1] = bfhi(w0[q_]); dst[8 + 2 * q_] = bflo(w1[q_]); dst[9 + 2 * q_] = bfhi(w1[q_]); } } while (0)
    if (ready) { if (w == 4) s23_wait_round(ready, 0, lane); asm volatile("s_waitcnt lgkmcnt(0)\n\ts_barrier" ::: "memory"); }
    if (loader) { S23_DMA(0); if (NC > 1) S23_DMA(1); if (NC > 2) S23_DMA(2); }
#pragma unroll 1
    for (int cc = 0; cc < NC; ++cc) {
        if (ready && w == 4 && ((cc + 3) & 15) == 0 && cc + 3 < NC) s23_wait_round(ready, (cc + 3) >> 4, lane);
        if (loader) { const int later = NC - 1 - cc;
            if (later >= 2) asm volatile("s_waitcnt vmcnt(16)" ::: "memory"); else if (later == 1) asm volatile("s_waitcnt vmcnt(8)" ::: "memory"); else asm volatile("s_waitcnt vmcnt(0)" ::: "memory"); }
        asm volatile("s_waitcnt lgkmcnt(0)\n\ts_barrier" ::: "memory");
        if (loader) { if (cc + 3 < NC) S23_DMA(cc + 3); }
        if (compute) {
            const LAS unsigned char* sl = L + (cc & 3) * 32768 + lane * 32;
            const int ck = CKOF(cc);
            bf16x8 xb[2][2];
#pragma unroll
            for (int s = 0; s < 2; ++s) {
                xb[0][s] = __builtin_bit_cast(bf16x8, (u32x4){cvt_pk_bf16(X0[8 * s], X0[8 * s + 1]), cvt_pk_bf16(X0[8 * s + 2], X0[8 * s + 3]), cvt_pk_bf16(X0[8 * s + 4], X0[8 * s + 5]), cvt_pk_bf16(X0[8 * s + 6], X0[8 * s + 7])});
                xb[1][s] = __builtin_bit_cast(bf16x8, (u32x4){cvt_pk_bf16(X1[8 * s], X1[8 * s + 1]), cvt_pk_bf16(X1[8 * s + 2], X1[8 * s + 3]), cvt_pk_bf16(X1[8 * s + 4], X1[8 * s + 5]), cvt_pk_bf16(X1[8 * s + 6], X1[8 * s + 7])}); }
            u32x4 dw[2][2];
#pragma unroll
            for (int t = 0; t < 2; ++t) { dw[t][0] = *(const LAS u32x4*)(sl + 8192 + (t * 2 + icb) * 2048); dw[t][1] = *(const LAS u32x4*)(sl + 8192 + (t * 2 + icb) * 2048 + 16); }
            f32x16 N0, N1;
            UNPK(N0, dw[0][0], dw[0][1]); UNPK(N1, dw[1][0], dw[1][1]);
#pragma unroll
            for (int rb = 0; rb < 2; ++rb)
#pragma unroll
                for (int s = 0; s < 2; ++s) {
                    N0 = __builtin_amdgcn_mfma_f32_32x32x16_bf16(*(const LAS bf16x8*)(sl + (rb * 2 + 0) * 2048 + s * 16), xb[rb][s], N0, 0, 0, 0);
                    N1 = __builtin_amdgcn_mfma_f32_32x32x16_bf16(*(const LAS bf16x8*)(sl + (rb * 2 + 1) * 2048 + s * 16), xb[rb][s], N1, 0, 0, 0); }
            u32x4 yw[2][2];
#pragma unroll
            for (int t = 0; t < 2; ++t) { yw[t][0] = *(const LAS u32x4*)(sl + 24576 + (t * 2 + icb) * 2048); yw[t][1] = *(const LAS u32x4*)(sl + 24576 + (t * 2 + icb) * 2048 + 16); }
            f32x16 Y0, Y1;
            UNPK(Y0, yw[0][0], yw[0][1]); UNPK(Y1, yw[1][0], yw[1][1]);
#pragma unroll
            for (int rb = 0; rb < 2; ++rb)
#pragma unroll
                for (int s = 0; s < 2; ++s) {
                    Y0 = __builtin_amdgcn_mfma_f32_32x32x16_bf16(*(const LAS bf16x8*)(sl + 16384 + (rb * 2 + 0) * 2048 + s * 16), xb[rb][s], Y0, 0, 0, 0);
                    Y1 = __builtin_amdgcn_mfma_f32_32x32x16_bf16(*(const LAS bf16x8*)(sl + 16384 + (rb * 2 + 1) * 2048 + s * 16), xb[rb][s], Y1, 0, 0, 0); }
            X0 = N0; X1 = N1;
            const long rs = (d == 0 ? 1L : -1L) * (ready ? 64L : (long)ZP);
            bf16_t* pa = ready ? (bf16_t*)(slots + (size_t)ck * SLOT_BYTES) + (d == 0 ? 4 * hi : 63 - 4 * hi) * 64 + 32 * icb + r32 : Zy + (size_t)(ck * 64 + (d == 0 ? 4 * hi : 63 - 4 * hi)) * ZP;
            bf16_t* pb = pa + 32 * rs;
#pragma unroll
            for (int g = 0; g < 4; ++g) {
#pragma unroll
                for (int e = 0; e < 4; ++e) { pa[e * rs] = f2bf(Y0[4 * g + e]); pb[e * rs] = f2bf(Y1[4 * g + e]); }
                pa += 8 * rs; pb += 8 * rs; asm volatile("" : "+v"(pa), "+v"(pb));
            }
        }
    }
    asm volatile("s_waitcnt vmcnt(0) lgkmcnt(0)\n\ts_barrier" ::: "memory");
#undef UNPK
#undef S23_DMA
#undef CKOF
}

constexpr int PO_V = 0, PO_G = PO_V + 66 * 144, PO_Y0 = PO_G + 66 * 272, PO_Y1 = PO_Y0 + 64 * 144, PO_SG = PO_Y1 + 64 * 144, PO_GF = PO_SG + 64 * 272, PO_END = PO_GF + 64 * 272;
static_assert(PO_END <= PTRS_OFF, "post lds");
__device__ __forceinline__ void post_decode(int c, int& reg, int& row, int& part) {
    if (c < 528) { reg = 0; row = c >> 3; part = c & 7; } else if (c < 1584) { reg = 1; row = (c - 528) >> 4; part = (c - 528) & 15; }
    else if (c < 2096) { reg = 2; row = (c - 1584) >> 3; part = (c - 1584) & 7; } else { reg = 3; row = (c - 2096) >> 3; part = (c - 2096) & 7; }
}
__device__ __forceinline__ void post_stage_load(const Args& a, int tid, int q, int h, int blk, u32x4 (&v)[6]) {
    const int row0 = seq_row0(q), S = seq_len(q), t0 = blk * 64;
    const bf16_t* Zs = (const bf16_t*)(a.ws + WS_Z) + (size_t)row0 * ZP;
#pragma unroll
    for (int k = 0; k < 6; ++k) { const int c = tid + k * NTHR; int reg, row, part; post_decode(c, reg, row, part);
        const int t = reg < 2 ? t0 - 1 + row : t0 + row; const int col = reg == 0 ? ZRV + h * 64 : reg == 1 ? ZGD : reg == 2 ? ZRR + h * 64 : ZRK + h * 64;
        v[k] = (u32x4){0u, 0u, 0u, 0u};
        if (q == 0 && reg >= 2) { if (c < 2608) v[k] = *(const u32x4*)((const unsigned char*)a.out + ((size_t)((reg - 2) * 8 + h) * 256 + blk) * SLOT_BYTES + row * 128 + part * 16); }
        else if (c < 2608 && t >= 0 && t < S) v[k] = *(const u32x4*)(Zs + (size_t)t * ZP + col + part * 8); }
}
__device__ __forceinline__ void post_item(const Frame& F, const Args& a, int q, int h, int blk, u32x4 (&stg)[6], bool has_next, int nq, int nh, int nblk) {
    LAS unsigned char* L = F.lds;
    int lane_ = F.lane; asm volatile("" : "+v"(lane_));
    const int lane = lane_, w = F.wave, tid = w * 64 + lane, r32 = lane & 31, hi = lane >> 5, j = lane, tg = w;
    const int row0 = seq_row0(q), t_lo = blk * 64 + 8 * tg;
    bf16_t* Zs = (bf16_t*)(a.ws + WS_Z) + (size_t)row0 * ZP;
    const float* mup = inp(L, 11); const float* mun = inp(L, 12);
    bf16x8 gfr[8];
    { const bf16_t* GT = (const bf16_t*)(a.ws + WS_LORA) + 4 * 512 * 64 + ((size_t)h * 64 + 32 * ((w >> 1) & 1) + r32) * 128;
#pragma unroll
      for (int ks = 0; ks < 8; ++ks) gfr[ks] = *(const bf16x8*)(GT + 16 * ks + 8 * hi); }
#pragma unroll
    for (int k = 0; k < 6; ++k) { const int c = tid + k * NTHR; int reg, row, part; post_decode(c, reg, row, part);
        const int off = reg == 0 ? PO_V + row * 144 : reg == 1 ? PO_G + row * 272 : reg == 2 ? PO_Y0 + row * 144 : PO_Y1 + row * 144;
        if (c < 2608) *(LAS u32x4*)(L + off + part * 16) = stg[k]; }
    __syncthreads();
    if (has_next) post_stage_load(a, tid, nq, nh, nblk, stg);
    {
        float z0[10], z1[10];
#pragma unroll
        for (int i = 0; i < 10; ++i) { z0[i] = bf2f(*(const LAS bf16_t*)(L + PO_G + (8 * tg + i) * 272 + j * 2)); z1[i] = bf2f(*(const LAS bf16_t*)(L + PO_G + (8 * tg + i) * 272 + (64 + j) * 2)); }
        const float mp0 = mup[ZGD - ZRR + j], mn0 = mun[ZGD - ZRR + j], mp1 = mup[ZGD - ZRR + 64 + j], mn1 = mun[ZGD - ZRR + 64 + j];
#pragma unroll
        for (int u = 0; u < 8; ++u) { *(LAS bf16_t*)(L + PO_SG + (8 * tg + u) * 272 + j * 2) = f2bf(sigmoidf_(tshift(z0, u, mp0, mn0)));
                                      *(LAS bf16_t*)(L + PO_SG + (8 * tg + u) * 272 + (64 + j) * 2) = f2bf(sigmoidf_(tshift(z1, u, mp1, mn1))); }
    }
    __syncthreads();
    if (w < 4) {
        const int mt = w >> 1, nt = w & 1;
        f32x16 acc = f32x16{};
#pragma unroll
        for (int ks = 0; ks < 8; ++ks) { const bf16x8 bv = *(const LAS bf16x8*)(L + PO_SG + (32 * nt + r32) * 272 + (16 * ks + 8 * hi) * 2);
            acc = __builtin_amdgcn_mfma_f32_32x32x16_bf16(gfr[ks], bv, acc, 0, 0, 0); }
#pragma unroll
        for (int g = 0; g < 4; ++g) *(LAS f32x4*)(L + PO_GF + (32 * nt + r32) * 272 + (32 * mt + 8 * g + 4 * hi) * 4) = (f32x4){acc[4 * g], acc[4 * g + 1], acc[4 * g + 2], acc[4 * g + 3]};
    }
    __syncthreads();
    {
        const int ch = h * 64 + j;
        float zv[10];
#pragma unroll
        for (int i = 0; i < 10; ++i) zv[i] = bf2f(*(const LAS bf16_t*)(L + PO_V + (8 * tg + i) * 144 + j * 2));
        const float mpv = mup[1024 + ch], mnv = mun[1024 + ch], lg = inp(L, 21)[ch], lb = inp(L, 22)[ch];
        const float* bon0 = (const float*)(a.ws + WS_BONUS) + (size_t)row0 * 8 + h; const float* bon1 = bon0 + (size_t)MTOK * 8;
#pragma unroll
        for (int u = 0; u < 8; ++u) { const int t = t_lo + u;
            const float y = bf2f(*(const LAS bf16_t*)(L + PO_Y0 + (8 * tg + u) * 144 + j * 2)) + bf2f(*(const LAS bf16_t*)(L + PO_Y1 + (8 * tg + u) * 144 + j * 2));
            const float mean = wave_sum_dpp(y) * (1.f / 64.f); const float dv = y - mean; const float var = wave_sum_dpp(dv * dv) * (1.f / 64.f);
            const float yn = dv * __builtin_amdgcn_rsqf(var + LNX_EPS) * lg + lb;
            const float bsum = bon0[(size_t)t * 8] + bon1[(size_t)t * 8];
            const float g = *(const LAS float*)(L + PO_GF + (8 * tg + u) * 272 + j * 4);
            Zs[(size_t)t * ZP + ZRR + ch] = f2bf((yn + bsum * tshift(zv, u, mpv, mnv)) * g); }
    }
    __syncthreads();
}
}


#define XB_TMO      128
#define XB_XCNT(j)  (256  + 64 * (j))
#define XB_XSUB(j)  (1280 + 64 * (j))
#define XB_XGEN(j)  (2304 + 64 * (j))
#define XB_TOP      3328
#define XB_TOPGEN   3392
#define XCD_BAR_WORDS 3456
#define XB_SPIN_CAP (1u << 20)
constexpr size_t CTL_ZERO_BYTES = 16384;
__device__ __forceinline__ unsigned xb_ld(unsigned* p)              { return __hip_atomic_load(p, __ATOMIC_RELAXED, __HIP_MEMORY_SCOPE_AGENT); }
__device__ __forceinline__ unsigned xb_add(unsigned* p, unsigned v) { return __hip_atomic_fetch_add(p, v, __ATOMIC_RELAXED, __HIP_MEMORY_SCOPE_AGENT); }
__device__ __forceinline__ unsigned xb_xcc_id() { return (unsigned)__builtin_amdgcn_s_getreg((3 << 11) | 20) & 0xFu; }
#define XB_SPIN(cond, bar) do { unsigned _sp = 0; while (cond) { __builtin_amdgcn_s_sleep(1); \
    if ((++_sp & 255u) == 0u) { if (xb_ld(&(bar)[XB_TMO])) break; if (_sp > XB_SPIN_CAP) { atomicAdd(&(bar)[XB_TMO], 1u); break; } } } } while (0)
struct XcdBarrier { unsigned* bar; unsigned x; volatile LAS unsigned* st; };
__device__ __forceinline__ XcdBarrier xcd_barrier_post(unsigned* bar, volatile LAS unsigned* st) {
    XcdBarrier b; b.bar = bar; b.x = xb_xcc_id(); b.st = st;
    if (threadIdx.x == 0) (void)xb_add(&bar[XB_XCNT(b.x)], 1u);
    return b;
}
__device__ __forceinline__ void xcd_barrier_complete(unsigned* bar, unsigned x, unsigned& nloc, unsigned& nx) {
    const unsigned G = gridDim.x * gridDim.y * gridDim.z;
    unsigned sum, cnt, mine, sp = 0u;
    for (;;) {
        sum = 0u; cnt = 0u; mine = 0u;
#pragma unroll
        for (unsigned j = 0; j < 16; ++j) { const unsigned c = xb_ld(&bar[XB_XCNT(j)]); sum += c; cnt += (c > 0u) ? 1u : 0u; mine = (j == x) ? c : mine; }
        if (sum == G) break;
        __builtin_amdgcn_s_sleep(1);
        if ((++sp & 255u) == 0u) { if (xb_ld(&bar[XB_TMO])) break; if (sp > XB_SPIN_CAP) { atomicAdd(&bar[XB_TMO], 1u); break; } }
    }
    nloc = mine > 0u ? mine : 1u; nx = cnt > 0u ? cnt : 1u;
}
__device__ __forceinline__ void xcd_barrier(const XcdBarrier& b) {
    asm volatile("s_waitcnt vmcnt(0)" ::: "memory");
    __syncthreads();
    if (threadIdx.x == 0) {
        unsigned* bar = b.bar;
        __builtin_amdgcn_s_waitcnt(0);
        unsigned nloc = b.st[0], nx = b.st[1];
        if (nloc == 0u) { xcd_barrier_complete(bar, b.x, nloc, nx); b.st[0] = nloc; b.st[1] = nx; }
        const unsigned old = xb_add(&bar[XB_XSUB(b.x)], 1u);
        const unsigned gen = old / nloc;
        if (old + 1u == (gen + 1u) * nloc) {
            __builtin_amdgcn_fence(__ATOMIC_RELEASE, "agent");
            asm volatile("s_waitcnt vmcnt(0)" ::: "memory");
            const unsigned og = xb_add(&bar[XB_TOP], 1u);
            const unsigned tg = og / nx;
            if (og + 1u == (tg + 1u) * nx) xb_add(&bar[XB_TOPGEN], 1u);
            else XB_SPIN(xb_ld(&bar[XB_TOPGEN]) == tg, bar);
            __builtin_amdgcn_fence(__ATOMIC_ACQUIRE, "agent");
            xb_add(&bar[XB_XGEN(b.x)], 1u);
            asm volatile("s_waitcnt vmcnt(0)" ::: "memory");
        } else {
            XB_SPIN(xb_ld(&bar[XB_XGEN(b.x)]) == gen, bar);
            __builtin_amdgcn_fence(__ATOMIC_ACQUIRE, "agent");
            asm volatile("s_waitcnt vmcnt(0)" ::: "memory");
        }
    }
    __syncthreads();
}

constexpr int NPHASE = 10;
constexpr int NOJUMP = 1 << 30;
template <int LO, int HI>
__global__ void __launch_bounds__(NTHR, 2) fwd_kernel(Args a) {
    extern __shared__ __attribute__((aligned(16))) unsigned char lds_raw[];
    Frame F; F.lds = (LAS unsigned char*)lds_raw; F.tid = threadIdx.x; F.lane = F.tid & 63; F.wave = __builtin_amdgcn_readfirstlane(F.tid >> 6);
    F.G = gridDim.x; { const int bx = blockIdx.x; F.vcu = (F.G % 8 == 0) ? (bx % 8) * (F.G / 8) + bx / 8 : bx; }
    unsigned char* ws = a.ws; bf16_t* Z = (bf16_t*)(ws + WS_Z);
    unsigned char* slots = (unsigned char*)a.out;
    if (F.tid == 0) {
#pragma unroll
        for (int i = 0; i < 27; ++i) *(const float* LAS*)(F.lds + PTRS_OFF + i * 8) = a.in[i];
        *(volatile LAS unsigned*)(F.lds + PTRS_OFF + 224) = 0u; *(volatile LAS unsigned*)(F.lds + PTRS_OFF + 228) = 0u;
        *(LAS unsigned long long*)(F.lds + PTRS_OFF - 64) = 0ull;
    }
    __syncthreads();
#if ONE_LAUNCH && !USE_CG
    const XcdBarrier bar = xcd_barrier_post((unsigned*)(ws + WS_CTL), (volatile LAS unsigned*)(F.lds + PTRS_OFF + 224));
#endif
#if ONE_LAUNCH
#if PROBE_SEG >= 0
    unsigned long long* tsb = (unsigned long long*)(ws + WS_CTL + 15872); int nts = 0;
#define STAMP() do { if (blockIdx.x == 0 && F.tid == 0) { tsb[nts] = __builtin_amdgcn_s_memrealtime(); } ++nts; } while (0)
    STAMP();
#else
#define STAMP() do { } while (0)
#endif
#if USE_CG
#define SEAM(k) do { if constexpr ((k) + 1 < HI) { cg::this_grid().sync(); STAMP(); } } while (0)
#define RSYNC() do { cg::this_grid().sync(); STAMP(); } while (0)
#else
#define SEAM(k) do { if constexpr ((k) + 1 < HI) { xcd_barrier(bar); STAMP(); } } while (0)
#define RSYNC() do { xcd_barrier(bar); STAMP(); } while (0)
#endif
#else
#define SEAM(k) do { } while (0)
#define RSYNC() do { } while (0)
#endif
#define IN(k) (LO <= (k) && (k) < HI)
    if constexpr (IN(0)) { p0_prologue(F, a); SEAM(0);
#if PROBE_DOUBLE == 4
        p0_prologue(F, a); RSYNC();
#endif
    }
    if constexpr (IN(1)) { pg8::Gemm g{(const char*)a.out, (const bf16_t*)(ws + WS_WIN), MTOK, ZP, DM, DM * 2, NOJUMP, 0}; pg8::StaticOrder S; S.init(MTOK, ZP, F.G, (int)blockIdx.x);
        pg8::EpiZ E{Z, ZP}; pg8::gemm_phase<pg8::EpiZ, pg8::StaticOrder, true>(F.lds, g, S, E); SEAM(1);
#if PROBE_DOUBLE == 3
        pg8::gemm_phase<pg8::EpiZ, pg8::StaticOrder, true>(F.lds, g, S, E); RSYNC();
#endif
    }
    if constexpr (IN(2)) { qk_prep(F, a);
        unsigned* rdy = (unsigned*)(ws + WS_CTL) + 3584;
#pragma unroll 1
        for (int rnd = 0; rnd < 2; ++rnd) {
            const int nprod = rnd == 1 ? F.G - 16 : F.G;
            if (F.vcu < nprod) {
#define S1_DECODE(i_, d_, q_, h_, ck_, it_, pub_) do { if (rnd == 1) { const int c_ = ((i_) >> 4) & 15, cc_ = (((i_) >> 8) << 4) + ((i_) & 15); d_ = c_ >> 3; h_ = c_ & 7; q_ = 0; ck_ = d_ ? 255 - cc_ : cc_; it_ = c_ * 256 + ck_; pub_ = rdy + c_ * 16 + ((i_) >> 8); } \
                    else { ck_ = (i_) & 31; h_ = ((i_) >> 5) & 7; q_ = 1 + (((i_) >> 8) & 7); d_ = (i_) >> 11; it_ = (i_); pub_ = nullptr; } } while (0)
                u32x4 stg[6]; f32x2_t par;
                { int d, q, h, ck, it; unsigned* pub; S1_DECODE(F.vcu, d, q, h, ck, it, pub); (void)it; (void)pub; rw::s1_stage_load(a, F.tid, q, h, ck, stg); par = rw::s1_param_load(F.lds, F.tid, d, h); }
                unsigned* pub_prev = nullptr;
#pragma unroll 1
                for (int i = F.vcu; i < 4096; i += nprod) {
                    int d, q, h, ck, it, nd, nq, nh, nck, nit; unsigned* pub; unsigned* npub; S1_DECODE(i, d, q, h, ck, it, pub); const int ni = i + nprod; S1_DECODE(ni, nd, nq, nh, nck, nit, npub); (void)nit; (void)npub;
                    rw::s1_item(F, a, d, q, h, ck, slots + (size_t)it * SLOT_BYTES, stg, par, ni < 4096, nd, nq, nh, nck, rnd == 1, pub_prev); pub_prev = pub; }
                if (pub_prev) { asm volatile("s_waitcnt vmcnt(0)" ::: "memory"); __syncthreads(); if (F.tid == 0) __hip_atomic_fetch_add(pub_prev, 1u, __ATOMIC_RELAXED, __HIP_MEMORY_SCOPE_AGENT); }
#undef S1_DECODE
            } else {
                const int c = F.vcu - nprod;
                rw::s23_chain_wg(F, a, c >> 3, 0, c & 7, slots + (size_t)c * 256 * SLOT_BYTES, rdy + c * 16);
            }
            if (rnd == 0) {
                RSYNC();
                for (int chain = F.vcu; chain < 128; chain += F.G) { const int h = chain & 7, q = 1 + ((chain >> 3) & 7), d = chain >> 6;
                    rw::s23_chain_wg(F, a, d, q, h, slots + (size_t)chain * 32 * SLOT_BYTES, nullptr); }
                RSYNC();
            }
        }
        SEAM(2); }
    if constexpr (IN(3)) {
#define PO_DECODE(it_, q_, h_, b_) do { if ((it_) < 2048) { q_ = 0; h_ = (it_) >> 8; b_ = (it_) & 255; } else { const int r_ = (it_) - 2048; q_ = 1 + (r_ >> 8); h_ = (r_ >> 5) & 7; b_ = r_ & 31; } } while (0)
        u32x4 stg[6];
        { int q, h, b; PO_DECODE(F.vcu, q, h, b); if (F.vcu < 4096) rw::post_stage_load(a, F.tid, q, h, b, stg); }
#pragma unroll 1
        for (int it = F.vcu; it < 4096; it += F.G) { int q, h, b, nq, nh, nb; PO_DECODE(it, q, h, b); const int nit = it + F.G; PO_DECODE(nit, nq, nh, nb);
            rw::post_item(F, a, q, h, b, stg, nit < 4096, nq, nh, nb); }
#undef PO_DECODE
        SEAM(3); }
    if constexpr (IN(4)) {
        float lam; { const float p1 = wave_sum(a.in[6][F.lane] * a.in[7][F.lane]), p2 = wave_sum(a.in[8][F.lane] * a.in[9][F.lane]); lam = __expf(p1) - __expf(p2) + LAMBDA_INIT; }
#if PROBE_DOUBLE == 1
        for (int v = F.vcu; v < 256; v += F.G) {
            att::attn_unit(0, SP, v >> 6, v & 63, Z, F.lds, lam, a.in[10], (bf16_t*)a.out, 512);
            att::attn_unit(SP + (v >> 5) * SS, SS, (v >> 3) & 3, v & 7, Z, F.lds, lam, a.in[10], (bf16_t*)a.out, 512); }
        RSYNC();
#endif
        for (int v = F.vcu; v < 256; v += F.G) {
            att::attn_unit(0, SP, v >> 6, v & 63, Z, F.lds, lam, a.in[10], Z, ZP);
            att::attn_unit(SP + (v >> 5) * SS, SS, (v >> 3) & 3, v & 7, Z, F.lds, lam, a.in[10], Z, ZP); }
        SEAM(4); }
    if constexpr (IN(5)) { pg8::Gemm g{(const char*)Z, (const bf16_t*)(ws + WS_WOUT), MTOK, DM, DM, ZP * 2, 8, 2048}; pg8::StaticOrder S; S.init(MTOK, DM, F.G, (int)blockIdx.x);
        pg8::EpiOut E{a.in[0], a.in[1], a.out, Z, (float*)(ws + WS_ROWSQ)}; pg8::gemm_phase<pg8::EpiOut, pg8::StaticOrder, true>(F.lds, g, S, E); SEAM(5); }
#define FFN_UP(k, half) if constexpr (IN(k)) { pg8::Gemm g{(const char*)(Z + (size_t)(half) * 16384 * ZP + ZXN2), (const bf16_t*)(ws + WS_W1), 16384, DFF, DM, ZP * 2, NOJUMP, 0}; pg8::StaticOrder S; S.init(16384, DFF, F.G, (int)blockIdx.x); \
        pg8::EpiUp E{(char*)(ws + WS_Z), (const float*)(ws + WS_ROWSQ), (half) * 16384}; pg8::gemm_phase<pg8::EpiUp, pg8::StaticOrder, true>(F.lds, g, S, E); SEAM(k); }
#define FFN_DN(k, half) if constexpr (IN(k)) { pg8::Gemm g{(const char*)(ws + WS_Z), (const bf16_t*)(ws + WS_W2), 16384, DM, DFF, 13312, 32, 2560}; pg8::StaticOrder S; S.init(16384, DM, F.G, (int)blockIdx.x); \
        pg8::EpiDown E{a.out, (half) * 16384}; pg8::gemm_phase<pg8::EpiDown, pg8::StaticOrder, true>(F.lds, g, S, E); SEAM(k); }
    FFN_UP(6, 0) FFN_DN(7, 0) FFN_UP(8, 1) FFN_DN(9, 1)
#if PROBE_S1 >= 0
    if (F.tid == 0) { const unsigned long long dt = *(LAS unsigned long long*)(F.lds + PTRS_OFF - 64), t0_ = __builtin_amdgcn_s_memrealtime();
        while (__builtin_amdgcn_s_memrealtime() - t0_ < dt) __builtin_amdgcn_s_sleep(16); }
#endif
#if PROBE_SEG >= 0
    STAMP();
    if (blockIdx.x == 0 && F.tid == 0) { asm volatile("s_waitcnt vmcnt(0)" ::: "memory"); const unsigned long long dt = tsb[PROBE_SEG + 1] - tsb[PROBE_SEG], t0_ = __builtin_amdgcn_s_memrealtime();
        while (__builtin_amdgcn_s_memrealtime() - t0_ < dt) __builtin_amdgcn_s_sleep(16); }
#endif
#undef FFN_UP
#undef FFN_DN
#undef IN
#undef SEAM
#undef RSYNC
}

extern "C" void kernel_launch(void* const* d_in, const int* in_sizes, int n_in, void* d_out, int out_size, void* d_ws, size_t ws_size, hipStream_t stream) {
    static int grid = 0;
    if (grid == 0) {
        if (n_in != 27 || out_size != MTOK * DM || ws_size < WS_END) { fprintf(stderr, "kernel_launch: unexpected shapes (n_in %d out %d ws %zu)\n", n_in, out_size, ws_size); grid = -1; return; }
        int dev = 0, cus = 0; (void)hipGetDevice(&dev); (void)hipDeviceGetAttribute(&cus, hipDeviceAttributeMultiprocessorCount, dev);
        bool ok = true;
#if ONE_LAUNCH
        ok = ok && hipFuncSetAttribute((const void*)fwd_kernel<0, NPHASE>, hipFuncAttributeMaxDynamicSharedMemorySize, LDS_BYTES) == hipSuccess;
        int per_cu = 0; (void)hipOccupancyMaxActiveBlocksPerMultiprocessor(&per_cu, (const void*)fwd_kernel<0, NPHASE>, NTHR, LDS_BYTES); (void)hipGetLastError();
        if (per_cu < 1) fprintf(stderr, "kernel_launch: occupancy query says %d blocks/CU\n", per_cu);
#else
#define SETA(p) ok = ok && hipFuncSetAttribute((const void*)fwd_kernel<p, p + 1>, hipFuncAttributeMaxDynamicSharedMemorySize, LDS_BYTES) == hipSuccess;
        SETA(0) SETA(1) SETA(2) SETA(3) SETA(4) SETA(5) SETA(6) SETA(7) SETA(8) SETA(9)
#undef SETA
#endif
        if (!ok) { fprintf(stderr, "kernel_launch: hipFuncSetAttribute failed\n"); grid = -1; return; }
        grid = cus > 256 ? 256 : cus;
    }
    if (grid < 0) return;
    Args a{};
    for (int i = 0; i < 27; ++i) a.in[i] = (const float*)d_in[i];
    a.out = (float*)d_out; a.ws = (unsigned char*)d_ws;
#if ONE_LAUNCH
    a.ph_lo = 0; a.ph_hi = NPHASE;
#if !USE_CG
    if (hipMemsetAsync((char*)d_ws + WS_CTL, 0, CTL_ZERO_BYTES, stream) != hipSuccess) { fprintf(stderr, "kernel_launch: hipMemsetAsync failed\n"); return; }
#endif
    void* args[] = {&a};
    hipError_t e = hipLaunchCooperativeKernel((const void*)fwd_kernel<0, NPHASE>, dim3(grid), dim3(NTHR), args, LDS_BYTES, stream);
    if (e != hipSuccess) fprintf(stderr, "cooperative launch failed: %s (grid %d)\n", hipGetErrorString(e), grid);
#else
#define LAUNCH(p) hipLaunchKernelGGL((fwd_kernel<p, p + 1>), dim3(grid), dim3(NTHR), LDS_BYTES, stream, a);
    LAUNCH(0) LAUNCH(1) LAUNCH(2) LAUNCH(3) LAUNCH(4) LAUNCH(5) LAUNCH(6) LAUNCH(7) LAUNCH(8) LAUNCH(9)
#undef LAUNCH
#endif
}
```

```cpp
#include <hip/hip_runtime.h>
#include <hip/hip_cooperative_groups.h>
#include <cstdio>
#include <cstdint>
namespace cg = cooperative_groups;

#ifndef ONE_LAUNCH
#define ONE_LAUNCH 1
#endif
#ifndef USE_CG
#define USE_CG 0
#endif
#ifndef PROBE_SEG
#define PROBE_SEG -1
#endif
#ifndef PROBE_S1
#define PROBE_S1 -1
#endif
#ifndef PROBE_ATT
#define PROBE_ATT 0
#endif
#ifndef PROBE_CLK
#define PROBE_CLK -1
#endif
#ifndef PROBE_DOUBLE
#define PROBE_DOUBLE 0
#endif

#define LAS __attribute__((address_space(3)))
typedef unsigned short bf16_t;
typedef short bf16x8 __attribute__((ext_vector_type(8)));
typedef short s16x4 __attribute__((ext_vector_type(4)));
typedef float f32x4 __attribute__((ext_vector_type(4)));
typedef float f32x16 __attribute__((ext_vector_type(16)));
typedef unsigned u32x4 __attribute__((ext_vector_type(4)));
typedef unsigned u32x2 __attribute__((ext_vector_type(2)));
typedef float f32x2_t __attribute__((ext_vector_type(2)));
typedef __bf16 bf16x2_t __attribute__((ext_vector_type(2)));

constexpr int MTOK = 32768, DM = 1024, ZP = 3328, DFF = 4096;
constexpr int SP = 16384, SS = 2048;
constexpr int ZQ = 0, ZK = 512, ZV = 1024, ZRR = 1536, ZRK = 2048, ZRV = 2560, ZWD = 3072, ZAD = 3136, ZGD = 3200;
constexpr int ZXN2 = 2048;
constexpr float NORM_EPS = 1e-6f, LNX_EPS = 64e-5f;
constexpr float QSCALE = 0.125f * 1.4426950408889634f;
constexpr float LAMBDA_INIT = 0.2f;
constexpr int NCHUNK_P = SP / 64, NCHUNK_S = SS / 64;

constexpr size_t MiB = 1u << 20;
constexpr size_t WS_CTL = 0;
constexpr size_t WS_WIN = 1 * MiB, WS_WOUT = 8 * MiB, WS_W1 = 10 * MiB, WS_W2 = 18 * MiB;
constexpr size_t WS_ROPE = 26 * MiB;
constexpr size_t WS_LORA = 30 * MiB;
constexpr size_t WS_ROWSQ = 31 * MiB;
constexpr size_t WS_BONUS = 33 * MiB;
constexpr size_t WS_Z = 36 * MiB;
constexpr size_t WS_END = 244 * MiB;
static_assert(WS_Z + (size_t)MTOK * ZP * 2 <= WS_END, "ws map");
constexpr size_t SLOT_BYTES = 32768;

__device__ __forceinline__ unsigned cvt_pk_bf16(float lo, float hi) { f32x2_t v = {lo, hi}; bf16x2_t b = __builtin_convertvector(v, bf16x2_t); return __builtin_bit_cast(unsigned, b); }
__device__ __forceinline__ float bf2f(unsigned short u) { return __uint_as_float(((unsigned)u) << 16); }
__device__ __forceinline__ float bflo(unsigned u) { return __uint_as_float(u << 16); }
__device__ __forceinline__ float bfhi(unsigned u) { return __uint_as_float(u & 0xffff0000u); }
__device__ __forceinline__ unsigned short f2bf(float f) { return (unsigned short)(cvt_pk_bf16(f, 0.f) & 0xffffu); }
__device__ __forceinline__ float wave_sum(float v) {
#pragma unroll
    for (int o = 1; o < 64; o <<= 1) v += __shfl_xor(v, o);
    return v;
}
__device__ __forceinline__ float wave_sum_dpp(float v) {
    int x = __float_as_int(v);
    v += __int_as_float(__builtin_amdgcn_update_dpp(0, x, 0xB1, 0xF, 0xF, true)); x = __float_as_int(v);
    v += __int_as_float(__builtin_amdgcn_update_dpp(0, x, 0x4E, 0xF, 0xF, true)); x = __float_as_int(v);
    v += __int_as_float(__builtin_amdgcn_update_dpp(0, x, 0x124, 0xF, 0xF, true)); x = __float_as_int(v);
    v += __int_as_float(__builtin_amdgcn_update_dpp(0, x, 0x128, 0xF, 0xF, true)); x = __float_as_int(v);
    const float a = __int_as_float(__builtin_amdgcn_readlane(x, 0)), b = __int_as_float(__builtin_amdgcn_readlane(x, 16)), c = __int_as_float(__builtin_amdgcn_readlane(x, 32)), d = __int_as_float(__builtin_amdgcn_readlane(x, 48));
    return (a + b) + (c + d);
}
#define LDS_WAIT() asm volatile("s_waitcnt lgkmcnt(0)" ::: "memory")
#define VM_WAIT() asm volatile("s_waitcnt vmcnt(0)" ::: "memory")
#define LBAR() asm volatile("s_waitcnt lgkmcnt(0)\n\ts_barrier" ::: "memory")

namespace pg8 {
constexpr int BM = 256, BK = 64, HALF = 128, HTB = HALF * BK * 2, STAGE_BYTES = 8 * HTB, NXCD = 8, WGM = 8;
__host__ __device__ __forceinline__ int lds_byte(int r, int c) { const int st = (r >> 4) * 2 + (c >> 5), rr = r & 15, cc = c & 31, ob = rr * 64 + cc * 2; return st * 1024 + (ob ^ (((ob >> 9) & 1) << 5)); }
__host__ __device__ __forceinline__ void stage_rc(int b, int& R, int& C) { const int st = b / 1024, sb = b % 1024, swz = sb ^ (((sb >> 9) & 1) << 5); R = (st >> 1) * 16 + swz / 64; C = (st & 1) * 32 + (swz % 64) / 2; }
__host__ __device__ __forceinline__ int perm32(int rho) { const int n = rho >> 4, i = rho & 15; return 8 * (i >> 2) + 4 * n + (i & 3); }
struct Unit { int pm, pn; };
struct Gemm { const char* A; const bf16_t* Bt; int M, N, K; int lda; int jkt; int jbytes; };
struct StaticOrder {
    int nM, nN, nwg, G, c;
    __host__ __device__ void init(int M, int N, int G_, int c_) { nM = M / BM; nN = N / BM; nwg = nM * nN; G = G_; c = c_; }
    __host__ __device__ bool next(int i, Unit& u) const {
        const long L = (long)i * G + c; if (L >= nwg) return false;
        int wgid = (int)L; { const int q = nwg / NXCD, r = nwg % NXCD, xcd = wgid % NXCD, off = wgid / NXCD; wgid = (xcd < r ? xcd * (q + 1) : r * (q + 1) + (xcd - r) * q) + off; }
        const int nig = WGM * nN, gid = wgid / nig, fm = gid * WGM, gsz = (nM - fm) < WGM ? (nM - fm) : WGM;
        u.pm = fm + ((wgid % nig) % gsz); u.pn = (wgid % nig) / gsz; return true;
    }
};

struct EpiZ {
    static constexpr bool PERM = true;
    bf16_t* O; int ldc;
    __device__ __forceinline__ void operator()(const f32x4 (&acc)[2][2][4][2], const Unit& u, int wr, int wc, int fr, int fq) const {
        const int row0 = u.pm * BM + wr * 64 + fr, col0 = u.pn * BM + wc * 32 + 8 * fq;
#pragma unroll
        for (int ai = 0; ai < 2; ++ai)
#pragma unroll
            for (int m = 0; m < 4; ++m) { bf16_t* rowp = O + (size_t)(row0 + ai * HALF + m * 16) * ldc + col0;
#pragma unroll
                for (int bj = 0; bj < 2; ++bj) { const f32x4 v0 = acc[ai][bj][m][0], v1 = acc[ai][bj][m][1];
                    u32x4 w; w.x = cvt_pk_bf16(v0[0], v0[1]); w.y = cvt_pk_bf16(v0[2], v0[3]); w.z = cvt_pk_bf16(v1[0], v1[1]); w.w = cvt_pk_bf16(v1[2], v1[3]);
                    *(u32x4*)(rowp + bj * HALF) = w; } }
    }
};
struct EpiOut {
    static constexpr bool PERM = true;
    const float* xp; const float* xs; float* out; bf16_t* Z; float* rowsq;
    __device__ __forceinline__ void operator()(const f32x4 (&acc)[2][2][4][2], const Unit& u, int wr, int wc, int fr, int fq) const {
        const int col0 = u.pn * BM + wc * 32 + 8 * fq;
#pragma unroll
        for (int ai = 0; ai < 2; ++ai)
#pragma unroll
            for (int m = 0; m < 4; ++m) { const int r = u.pm * BM + ai * HALF + wr * 64 + m * 16 + fr;
                const float* xr = (r < SP ? xp + (size_t)r * DM : xs + (size_t)(r - SP) * DM) + col0; float* orow = out + (size_t)r * DM + col0; bf16_t* zr = Z + (size_t)r * ZP + ZXN2 + col0;
                float ss = 0.f;
#pragma unroll
                for (int bj = 0; bj < 2; ++bj) { const f32x4 x0 = *(const f32x4*)(xr + bj * HALF), x1 = *(const f32x4*)(xr + bj * HALF + 4);
                    const f32x4 o0 = x0 + acc[ai][bj][m][0], o1 = x1 + acc[ai][bj][m][1];
                    *(f32x4*)(orow + bj * HALF) = o0; *(f32x4*)(orow + bj * HALF + 4) = o1;
                    ss += ((o0[0] * o0[0] + o0[1] * o0[1]) + (o0[2] * o0[2] + o0[3] * o0[3])) + ((o1[0] * o1[0] + o1[1] * o1[1]) + (o1[2] * o1[2] + o1[3] * o1[3]));
                    u32x4 w; w.x = cvt_pk_bf16(o0[0], o0[1]); w.y = cvt_pk_bf16(o0[2], o0[3]); w.z = cvt_pk_bf16(o1[0], o1[1]); w.w = cvt_pk_bf16(o1[2], o1[3]); *(u32x4*)(zr + bj * HALF) = w; }
                ss += __shfl_xor(ss, 16); ss += __shfl_xor(ss, 32);
                if (fq == 0) rowsq[(size_t)r * 16 + u.pn * 4 + wc] = ss;
                if (m & 1) asm volatile("" ::: "memory"); }
    }
};
struct EpiUp {
    static constexpr bool PERM = true;
    char* H; const float* rowsq; int row_off;
    __device__ __forceinline__ void operator()(const f32x4 (&acc)[2][2][4][2], const Unit& u, int wr, int wc, int fr, int fq) const {
        const int row0 = u.pm * BM + wr * 64 + fr, col0 = u.pn * BM + wc * 32 + 8 * fq;
#pragma unroll
        for (int ai = 0; ai < 2; ++ai)
#pragma unroll
            for (int m = 0; m < 4; ++m) { const int r = row0 + ai * HALF + m * 16; const f32x4* rq = (const f32x4*)(rowsq + (size_t)(row_off + r) * 16);
                const f32x4 q0 = rq[0], q1 = rq[1], q2 = rq[2], q3 = rq[3];
                const float ssum = ((q0[0] + q0[1]) + (q0[2] + q0[3])) + ((q1[0] + q1[1]) + (q1[2] + q1[3])) + ((q2[0] + q2[1]) + (q2[2] + q2[3])) + ((q3[0] + q3[1]) + (q3[2] + q3[3]));
                const float rstd = __builtin_amdgcn_rsqf(ssum * (1.0f / DM) + NORM_EPS);
                char* rowp = H + (size_t)r * 13312;
#pragma unroll
                for (int bj = 0; bj < 2; ++bj) { const int c = col0 + bj * HALF; f32x4 v0 = acc[ai][bj][m][0] * rstd, v1 = acc[ai][bj][m][1] * rstd;
#pragma unroll
                    for (int e = 0; e < 4; ++e) { const float a = fmaxf(v0[e], 0.f), b = fmaxf(v1[e], 0.f); v0[e] = a * a; v1[e] = b * b; }
                    u32x4 w; w.x = cvt_pk_bf16(v0[0], v0[1]); w.y = cvt_pk_bf16(v0[2], v0[3]); w.z = cvt_pk_bf16(v1[0], v1[1]); w.w = cvt_pk_bf16(v1[2], v1[3]);
                    *(u32x4*)(rowp + (size_t)c * 2 + (c >= 2048 ? 2560 : 0)) = w; } }
    }
};
struct EpiDown {
    static constexpr bool PERM = true;
    float* out; int row_off;
    __device__ __forceinline__ void operator()(const f32x4 (&acc)[2][2][4][2], const Unit& u, int wr, int wc, int fr, int fq) const {
        const int col0 = u.pn * BM + wc * 32 + 8 * fq;
#pragma unroll
        for (int ai = 0; ai < 2; ++ai)
#pragma unroll
            for (int m = 0; m < 4; ++m) { const int r = row_off + u.pm * BM + ai * HALF + wr * 64 + m * 16 + fr; float* orow = out + (size_t)r * DM + col0;
#pragma unroll
                for (int bj = 0; bj < 2; ++bj) { const f32x4 x0 = *(const f32x4*)(orow + bj * HALF), x1 = *(const f32x4*)(orow + bj * HALF + 4);
                    *(f32x4*)(orow + bj * HALF) = x0 + acc[ai][bj][m][0]; *(f32x4*)(orow + bj * HALF + 4) = x1 + acc[ai][bj][m][1]; }
                if (m & 1) asm volatile("" ::: "memory"); }
    }
};

template <class Epi, class Sched, bool ALIGN_EPI>
__device__ __forceinline__ void gemm_phase(LAS unsigned char* lds, const Gemm g, const Sched& S, const Epi& E) {
    int tid_ = threadIdx.x; asm volatile("" : "+v"(tid_));
    const int tid = tid_, wid = __builtin_amdgcn_readfirstlane(tid >> 6), lane = tid & 63, wr = wid >> 2, wc = wid & 3, fr = lane & 15, fq = lane >> 4;
    const int K = g.K, nt = K / BK;
    unsigned voffA[2], voffB[2];
#pragma unroll
    for (int i = 0; i < 2; ++i) { int R, C; stage_rc(tid * 16 + i * 8192, R, C); const int Rb = Epi::PERM ? ((R & ~31) + perm32(R & 31)) : R;
        voffA[i] = (unsigned)(R * g.lda + C * 2); voffB[i] = (unsigned)(Rb * K + C) * 2u; }
    const size_t kstep = (size_t)(BK * 2);
    const size_t hstepA = (size_t)HALF * g.lda, tstepA = 2 * hstepA;
    const size_t hstepB = (size_t)HALF * K * 2, tstepB = 2 * hstepB;
    const unsigned ldsw = (unsigned)wid * 1024u;
    const int aoff = lds_byte(wr * 64 + fr, fq * 8), boff = lds_byte(wc * 32 + fr, fq * 8);
#define PG8_AOFF(kt) ((size_t)(kt) * kstep + ((kt) >= g.jkt ? (size_t)g.jbytes : (size_t)0))
#define PG8_SA(b, h) (((b) * 2 + (h)) * HTB)
#define PG8_SB(b, h) ((4 + (b) * 2 + (h)) * HTB)
#define PG8_STAGE(bufoff, gbase, voff) do { _Pragma("unroll") for (int _i = 0; _i < 2; ++_i) \
        __builtin_amdgcn_global_load_lds((const unsigned*)((const char*)(gbase) + (voff)[_i]), (LAS unsigned*)(lds + (bufoff) + ldsw + _i * 8192), 16, 0, 0); } while (0)
#define PG8_LDA(dst, b, h) do { _Pragma("unroll") for (int m = 0; m < 4; ++m) _Pragma("unroll") for (int k = 0; k < 2; ++k) dst[m][k] = *(const LAS bf16x8*)(lds + PG8_SA(b, h) + aoff + m * 2048 + k * 1024); } while (0)
#define PG8_LDB(dst, b, h) do { _Pragma("unroll") for (int n = 0; n < 2; ++n) _Pragma("unroll") for (int k = 0; k < 2; ++k) dst[n][k] = *(const LAS bf16x8*)(lds + PG8_SB(b, h) + boff + n * 2048 + k * 1024); } while (0)
#define PG8_MMA(ai, bj, At, Bt) do { __builtin_amdgcn_s_setprio(1); _Pragma("unroll") for (int m = 0; m < 4; ++m) _Pragma("unroll") for (int n = 0; n < 2; ++n) _Pragma("unroll") for (int k = 0; k < 2; ++k) \
        acc[ai][bj][m][n] = __builtin_amdgcn_mfma_f32_16x16x32_bf16(Bt[n][k], At[m][k], acc[ai][bj][m][n], 0, 0, 0); __builtin_amdgcn_s_setprio(0); } while (0)
#define PG8_WAIT_V(n) asm volatile("s_waitcnt vmcnt(" #n ")" ::: "memory")
#define PG8_WAIT_L(n) asm volatile("s_waitcnt lgkmcnt(" #n ")" ::: "memory")
#define PG8_BAR __builtin_amdgcn_s_barrier()
#define PG8_SCHED __builtin_amdgcn_sched_barrier(0)
    Unit cur, nxt; int ui = 0;
    if (!S.next(0, cur)) return;
    f32x4 acc[2][2][4][2];
#pragma unroll
    for (int a = 0; a < 2; ++a)
#pragma unroll
        for (int b = 0; b < 2; ++b)
#pragma unroll
            for (int m = 0; m < 4; ++m)
#pragma unroll
                for (int n = 0; n < 2; ++n) acc[a][b][m][n] = (f32x4){0.f, 0.f, 0.f, 0.f};
    bf16x8 At[4][2], B0[2][2], B1[2][2];
    const char* cA = g.A + (size_t)cur.pm * tstepA; const char* cB = (const char*)g.Bt + (size_t)cur.pn * tstepB;
    {
        PG8_STAGE(PG8_SB(0, 0), cB, voffB); PG8_STAGE(PG8_SB(0, 1), cB + hstepB, voffB); PG8_STAGE(PG8_SA(0, 0), cA + PG8_AOFF(0), voffA); PG8_STAGE(PG8_SA(0, 1), cA + hstepA + PG8_AOFF(0), voffA);
        if (wr == 1) PG8_BAR;
        PG8_WAIT_V(2); PG8_BAR;
        PG8_STAGE(PG8_SB(1, 0), cB + kstep, voffB); PG8_STAGE(PG8_SA(1, 0), cA + PG8_AOFF(1), voffA); PG8_STAGE(PG8_SB(1, 1), cB + hstepB + kstep, voffB);
        PG8_WAIT_V(6); PG8_BAR;
    }
    for (;;) {
        const bool has_next = S.next(ui + 1, nxt);
        const char* nA = has_next ? g.A + (size_t)nxt.pm * tstepA : cA; const char* nB = has_next ? (const char*)g.Bt + (size_t)nxt.pn * tstepB : cB;
        for (int t = 0; t < nt; t += 2) {
            const bool last = (t == nt - 2);
            const char* a1 = cA + PG8_AOFF(t + 1);
            const char* a2 = last ? nA + PG8_AOFF(0) : cA + PG8_AOFF(t + 2); const char* b2 = last ? nB : cB + (size_t)(t + 2) * kstep;
            const char* a3 = last ? nA + PG8_AOFF(1) : cA + PG8_AOFF(t + 3); const char* b3 = b2 + kstep;
            PG8_LDB(B0, 0, 0); PG8_LDB(B1, 0, 1); PG8_SCHED; PG8_LDA(At, 0, 0); PG8_STAGE(PG8_SA(1, 1), a1 + hstepA, voffA);
            PG8_WAIT_V(8); PG8_WAIT_L(0); PG8_BAR; PG8_MMA(0, 0, At, B0); PG8_MMA(0, 1, At, B1); PG8_BAR; PG8_SCHED;
            PG8_LDA(At, 0, 1); PG8_STAGE(PG8_SB(0, 0), b2, voffB); PG8_STAGE(PG8_SB(0, 1), b2 + hstepB, voffB); PG8_STAGE(PG8_SA(0, 0), a2, voffA);
            PG8_WAIT_V(8); PG8_WAIT_L(0); PG8_BAR; PG8_MMA(1, 0, At, B0); PG8_MMA(1, 1, At, B1); PG8_BAR; PG8_SCHED;
            PG8_LDB(B0, 1, 0); PG8_LDB(B1, 1, 1); PG8_SCHED; PG8_LDA(At, 1, 0); PG8_STAGE(PG8_SA(0, 1), a2 + hstepA, voffA);
            PG8_WAIT_V(8); PG8_WAIT_L(0); PG8_BAR; PG8_MMA(0, 0, At, B0); PG8_MMA(0, 1, At, B1); PG8_BAR; PG8_SCHED;
            PG8_LDA(At, 1, 1); PG8_STAGE(PG8_SB(1, 0), b3, voffB); PG8_STAGE(PG8_SB(1, 1), b3 + hstepB, voffB); PG8_STAGE(PG8_SA(1, 0), a3, voffA);
            PG8_WAIT_V(8); PG8_WAIT_L(0); PG8_BAR; PG8_MMA(1, 0, At, B0); PG8_MMA(1, 1, At, B1); PG8_BAR; PG8_SCHED;
        }
        if constexpr (ALIGN_EPI) { if (wr == 0) PG8_BAR; }
        E(acc, cur, wr, wc, fr, fq);
        if (!has_next) break;
#pragma unroll
        for (int a = 0; a < 2; ++a)
#pragma unroll
            for (int b = 0; b < 2; ++b)
#pragma unroll
                for (int m = 0; m < 4; ++m)
#pragma unroll
                    for (int n = 0; n < 2; ++n) acc[a][b][m][n] = (f32x4){0.f, 0.f, 0.f, 0.f};
        cur = nxt; cA = nA; cB = nB; ++ui;
        if constexpr (ALIGN_EPI) { if (wr == 1) PG8_BAR; }
    }
    PG8_WAIT_V(0);
    if constexpr (!ALIGN_EPI) { if (wr == 0) PG8_BAR; }
    PG8_BAR;
#undef PG8_AOFF
#undef PG8_SA
#undef PG8_SB
#undef PG8_STAGE
#undef PG8_LDA
#undef PG8_LDB
#undef PG8_MMA
#undef PG8_WAIT_V
#undef PG8_WAIT_L
#undef PG8_BAR
#undef PG8_SCHED
}
}

constexpr int NWAVES = 8, NTHR = 512;
constexpr int LDS_BYTES = 163840;
struct Args {
    const float* in[27]; float* out; unsigned char* ws; int ph_lo, ph_hi;
};
struct Frame {
    LAS unsigned char* lds; int tid, lane, wave, vcu, G;
};
constexpr int PTRS_OFF = LDS_BYTES - 256;
__device__ __forceinline__ const float* inp(LAS unsigned char* lds, int i) { return *(const float* LAS*)(lds + PTRS_OFF + i * 8); }
__device__ __forceinline__ int seq_row0(int q) { return q == 0 ? 0 : SP + (q - 1) * SS; }
__device__ __forceinline__ int seq_len(int q) { return q == 0 ? SP : SS; }

__device__ __forceinline__ void p0_transpose_item(const float* W, int K, int N, bf16_t* WT, const float* kscale, LAS float* scr, int item, int lane) {
    const int nblk = N / 32, kb = item / nblk, nb = item % nblk, k0 = 64 * kb, n0 = 32 * nb;
#pragma unroll 8
    for (int i = 0; i < 32; ++i) { const int kk = 2 * i + (lane >> 5); float v = W[(size_t)(k0 + kk) * N + n0 + (lane & 31)]; if (kscale) v *= kscale[k0 + kk]; scr[kk * 33 + (lane & 31)] = v; }
    LDS_WAIT(); asm volatile("" ::: "memory");
    const int c = lane & 7;
#pragma unroll
    for (int j = 0; j < 4; ++j) { const int n = (lane >> 3) + 8 * j; const LAS float* s = scr + (8 * c) * 33 + n;
        u32x4 o; o.x = cvt_pk_bf16(s[0 * 33], s[1 * 33]); o.y = cvt_pk_bf16(s[2 * 33], s[3 * 33]); o.z = cvt_pk_bf16(s[4 * 33], s[5 * 33]); o.w = cvt_pk_bf16(s[6 * 33], s[7 * 33]);
        *(u32x4*)(WT + (size_t)(n0 + n) * K + k0 + 8 * c) = o; }
    LDS_WAIT(); asm volatile("" ::: "memory");
}
__device__ __forceinline__ void p0_prologue(const Frame& F, const Args& a) {
    LAS float* scr = (LAS float*)(F.lds + F.wave * 16384);
    const int gw = F.vcu * NWAVES + F.wave, NGW = F.G * NWAVES;
    unsigned char* ws = a.ws;
    constexpr int I_IN = (DM / 64) * (ZP / 32), I_O = (DM / 64) * (DM / 32), I_1 = (DM / 64) * (DFF / 32), I_2 = (DFF / 64) * (DM / 32);
    for (int it = gw; it < I_IN + I_O + I_1 + I_2; it += NGW) {
        int r = it;
        if (r < I_IN) { p0_transpose_item(a.in[3], DM, ZP, (bf16_t*)(ws + WS_WIN), nullptr, scr, r, F.lane); continue; } r -= I_IN;
        if (r < I_O) { p0_transpose_item(a.in[23], DM, DM, (bf16_t*)(ws + WS_WOUT), nullptr, scr, r, F.lane); continue; } r -= I_O;
        if (r < I_1) { p0_transpose_item(a.in[25], DM, DFF, (bf16_t*)(ws + WS_W1), a.in[24], scr, r, F.lane); continue; } r -= I_1;
        p0_transpose_item(a.in[26], DFF, DM, (bf16_t*)(ws + WS_W2), nullptr, scr, r, F.lane);
    }
    bf16_t* XN = (bf16_t*)a.out; const float* g1 = a.in[2];
    for (int m = gw; m < MTOK; m += NGW) {
        const float* xrow = m < SP ? a.in[0] + (size_t)m * DM : a.in[1] + (size_t)(m - SP) * DM;
        const f32x4* xr = (const f32x4*)xrow + F.lane; f32x4 v[4]; float s = 0.f;
#pragma unroll
        for (int j = 0; j < 4; ++j) { v[j] = xr[64 * j]; s += (v[j][0] * v[j][0] + v[j][1] * v[j][1]) + (v[j][2] * v[j][2] + v[j][3] * v[j][3]); }
        const float rstd = 1.0f / sqrtf(wave_sum(s) * (1.f / DM) + NORM_EPS);
        u32x2* o8 = (u32x2*)(XN + (size_t)m * DM) + F.lane;
#pragma unroll
        for (int j = 0; j < 4; ++j) { const f32x4 gv = ((const f32x4*)g1)[F.lane + 64 * j]; u32x2 w; w.x = cvt_pk_bf16(v[j][0] * rstd * gv[0], v[j][1] * rstd * gv[1]); w.y = cvt_pk_bf16(v[j][2] * rstd * gv[2], v[j][3] * rstd * gv[3]); o8[64 * j] = w; }
    }
    const int gt = F.vcu * NTHR + F.tid, NGT = F.G * NTHR;
    float* rope = (float*)(ws + WS_ROPE);
    for (int e = gt; e < SP * 32; e += NGT) { const int pos = e >> 5, i = e & 31;
        const float invf = 1.0f / powf(10000.0f, (float)(2 * i) / 64.0f); const float ang = (float)pos * invf; float sn, cs; sincosf(ang, &sn, &cs);
        rope[2 * e] = cs; rope[2 * e + 1] = sn; }
    bf16_t* wupT = (bf16_t*)(ws + WS_LORA); bf16_t* aupT = wupT + 2 * 512 * 64; bf16_t* gupT = aupT + 2 * 512 * 64;
    for (int e = gt; e < 2 * 512 * 64; e += NGT) { const int d = e >> 15, c = (e >> 6) & 511, r = e & 63;
        wupT[e] = f2bf(a.in[14][((size_t)d * 64 + r) * 512 + c]); aupT[e] = f2bf(a.in[16][((size_t)d * 64 + r) * 512 + c]); }
    for (int e = gt; e < 512 * 128; e += NGT) { const int c = e >> 7, r = e & 127; gupT[e] = f2bf(a.in[17][(size_t)r * 512 + c]); }
}

__device__ __forceinline__ void qk_prep(const Frame& F, const Args& a) {
    const int gw = F.vcu * NWAVES + F.wave, NGW = F.G * NWAVES;
    bf16_t* Z = (bf16_t*)(a.ws + WS_Z); const float* rope = (const float*)(a.ws + WS_ROPE);
    const int g = F.lane >> 2, qd = F.lane & 3;
    const float* gain = (g < 8) ? a.in[4] : a.in[5];
    float glo[8], ghi[8];
#pragma unroll
    for (int j = 0; j < 8; ++j) { glo[j] = gain[8 * qd + j]; ghi[j] = gain[32 + 8 * qd + j]; }
    const float osc = (g < 8) ? QSCALE : 1.0f;
#pragma unroll 4
    for (int m = gw; m < MTOK; m += NGW) {
        const int pos = m < SP ? m : ((m - SP) & (SS - 1));
        bf16_t* p = Z + (size_t)m * ZP + g * 64 + 8 * qd;
        const u32x4 lo4 = *(const u32x4*)p, hi4 = *(const u32x4*)(p + 32);
        float lo[8], hi[8];
#pragma unroll
        for (int j = 0; j < 4; ++j) { lo[2 * j] = bflo(lo4[j]); lo[2 * j + 1] = bfhi(lo4[j]); hi[2 * j] = bflo(hi4[j]); hi[2 * j + 1] = bfhi(hi4[j]); }
        float ss = 0.f;
#pragma unroll
        for (int j = 0; j < 8; ++j) ss += lo[j] * lo[j] + hi[j] * hi[j];
        ss += __shfl_xor(ss, 1); ss += __shfl_xor(ss, 2);
        const float rstd = __builtin_amdgcn_rsqf(ss * (1.f / 64.f) + NORM_EPS);
        const f32x4* rp = (const f32x4*)(rope + ((size_t)pos * 32 + 8 * qd) * 2);
        float ol[8], oh[8];
#pragma unroll
        for (int j2 = 0; j2 < 4; ++j2) { const f32x4 cs = rp[j2];
#pragma unroll
            for (int e = 0; e < 2; ++e) { const int j = 2 * j2 + e; const float c = cs[2 * e], s = cs[2 * e + 1]; const float l = lo[j] * rstd * glo[j], h = hi[j] * rstd * ghi[j];
                ol[j] = (l * c - h * s) * osc; oh[j] = (h * c + l * s) * osc; } }
        u32x4 wl, wh;
#pragma unroll
        for (int j = 0; j < 4; ++j) { wl[j] = cvt_pk_bf16(ol[2 * j], ol[2 * j + 1]); wh[j] = cvt_pk_bf16(oh[2 * j], oh[2 * j + 1]); }
        *(u32x4*)p = wl; *(u32x4*)(p + 32) = wh;
    }
}

namespace att {
constexpr int KSLOT = 8192, VSLOT = 16384, NKS = 4, NVS = 3;
constexpr int L_K = 0, L_V = NKS * KSLOT, L_WS = L_V + NVS * VSLOT, L_ST = L_WS + NWAVES * 256, L_END = L_ST + NWAVES * 8192;
static_assert(L_END <= PTRS_OFF, "attention lds");
__device__ __forceinline__ int crow(int r, int hi) { return (r & 3) + 8 * (r >> 2) + 4 * hi; }
__device__ __forceinline__ void glds16(const void* gsrc, unsigned lds_dst) { unsigned keep;
    asm volatile("s_mov_b32 %0, m0\n\ts_mov_b32 m0, %2\n\ts_nop 0\n\tglobal_load_lds_dwordx4 %1, off\n\ts_mov_b32 m0, %0" : "=&s"(keep) : "v"(gsrc), "s"(lds_dst) : "memory"); }
typedef short v4i16_t __attribute__((ext_vector_type(4)));
typedef const LAS char* lds_cptr;
__device__ __forceinline__ s16x4 vtr(lds_cptr p) { return __builtin_bit_cast(s16x4, __builtin_amdgcn_ds_read_tr16_b64_v4i16((LAS v4i16_t*)p)); }
#define SBAR() __builtin_amdgcn_sched_barrier(0)
#define WAIT_BAR(N) asm volatile("s_waitcnt vmcnt(" #N ") lgkmcnt(0)\n\ts_barrier" ::: "memory")
__device__ __forceinline__ void kload8(bf16x8* kf, lds_cptr kp) {
    kf[0] = *(const LAS bf16x8*)(kp);        kf[1] = *(const LAS bf16x8*)(kp + 512);
    kf[2] = *(const LAS bf16x8*)(kp + 2048); kf[3] = *(const LAS bf16x8*)(kp + 2560);
    kf[4] = *(const LAS bf16x8*)(kp + 4096); kf[5] = *(const LAS bf16x8*)(kp + 4608);
    kf[6] = *(const LAS bf16x8*)(kp + 6144); kf[7] = *(const LAS bf16x8*)(kp + 6656);
}
__device__ __forceinline__ void kload2(bf16x8* kf, lds_cptr kp, int j) { kf[2 * j] = *(const LAS bf16x8*)(kp + j * 2048); kf[2 * j + 1] = *(const LAS bf16x8*)(kp + j * 2048 + 512); }

__device__ __forceinline__ void attn_unit(int row0, int S, int h, int qb, bf16_t* Z, LAS unsigned char* shm, float lam, const float* subln_g, bf16_t* Ob, int opitch) {
    int tid_ = threadIdx.x; asm volatile("" : "+v"(tid_));
    const int tid = tid_, lane = tid & 63, r32 = lane & 31, hi = lane >> 5; const int wid = __builtin_amdgcn_readfirstlane(tid >> 6);
    const unsigned lds0 = (unsigned)(uintptr_t)shm;
    LAS float* wsf = (LAS float*)(shm + L_WS) + wid * 64;
    LAS bf16_t* stash = (LAS bf16_t*)(shm + L_ST) + wid * 4096;
    const int NT = S / 64;
    const size_t qrow = (size_t)(row0 + qb * 256 + wid * 32);
    const lds_cptr shm3 = (lds_cptr)shm;
    const lds_cptr kp0 = shm3 + L_K + hi * 1024 + r32 * 16;
    const lds_cptr vp0 = shm3 + L_V + ((lane >> 4) & 1) * 32 + (lane & 3) * 8 + (4 * hi + ((lane & 15) >> 2)) * 64;
    f32x16 o[4];
#pragma unroll 1
    for (int c = 0; c < 2; ++c) {
        const bf16_t* Qw = Z + qrow * ZP + ZQ + h * 128 + c * 64;
        const bf16_t* Kh = Z + (size_t)row0 * ZP + ZK + h * 128 + c * 64;
        const bf16_t* Vh = Z + (size_t)row0 * ZP + ZV + h * 128;
        const int p0 = 2 * wid, p1 = 2 * wid + 1;
        const unsigned koff = (unsigned)(lane * ZP + wid * 8) * 2u;
        const unsigned voff0 = (unsigned)((16 * (p0 & 3) + (lane >> 2)) * ZP + (p0 >> 2) * 32 + (lane & 3) * 8) * 2u;
        const unsigned voff1 = (unsigned)((16 * (p1 & 3) + (lane >> 2)) * ZP + (p1 >> 2) * 32 + (lane & 3) * 8) * 2u;
        const unsigned kdst = lds0 + L_K + wid * 1024, vdst0 = lds0 + L_V + p0 * 1024, vdst1 = lds0 + L_V + p1 * 1024;
#define DMA_K(t, si) glds16((const char*)(Kh + (size_t)(t) * 64 * ZP) + koff, (unsigned)__builtin_amdgcn_readfirstlane(kdst + (si) * KSLOT))
#define DMA_V(t, si) do { const char* vb_ = (const char*)(Vh + (size_t)(t) * 64 * ZP); glds16(vb_ + voff0, (unsigned)__builtin_amdgcn_readfirstlane(vdst0 + (si) * VSLOT)); glds16(vb_ + voff1, (unsigned)__builtin_amdgcn_readfirstlane(vdst1 + (si) * VSLOT)); } while (0)
        DMA_K(0, 0); DMA_V(0, 0); DMA_K(1, 1);
        bf16x8 qr[4];
#pragma unroll
        for (int d0 = 0; d0 < 4; ++d0) qr[d0] = *(const bf16x8*)(Qw + (size_t)r32 * ZP + d0 * 16 + hi * 8);
#pragma unroll
        for (int d0 = 0; d0 < 4; ++d0) o[d0] = f32x16{};
        float l_reg = 0.f;
        bf16x8 kf[4];
        f32x16 pA0, pA1, pB0, pB1;
        int i_prev = 0, i_cur = 0, i_next = 1;
        int k_cur = 0, k_next = 1;
#define ROT() do { i_prev = i_cur; i_cur = i_next; i_next = (i_next == NVS - 1) ? 0 : i_next + 1; k_cur = k_next; k_next = (k_next + 1) & 3; } while (0)
#define KFRAG(slot, i) (*(const LAS bf16x8*)(kp0 + (slot) * KSLOT + ((i) >> 1) * 2048 + ((i) & 1) * 512))
        DMA_K(2, 2);
        WAIT_BAR(4);
        {
            const lds_cptr kb = kp0;
            pA0 = f32x16{}; pA1 = f32x16{};
#pragma unroll
            for (int d0 = 0; d0 < 4; ++d0) { const bf16x8 b0 = *(const LAS bf16x8*)(kb + d0 * 2048), b1 = *(const LAS bf16x8*)(kb + d0 * 2048 + 512);
                pA0 = __builtin_amdgcn_mfma_f32_32x32x16_bf16(b0, qr[d0], pA0, 0, 0, 0); pA1 = __builtin_amdgcn_mfma_f32_32x32x16_bf16(b1, qr[d0], pA1, 0, 0, 0); }
#pragma unroll
            for (int r = 0; r < 16; ++r) { pA0[r] = __builtin_amdgcn_exp2f(pA0[r]); pA1[r] = __builtin_amdgcn_exp2f(pA1[r]); }
        }
        WAIT_BAR(0);
        DMA_K(3, 3); DMA_V(1, 1);
        ROT();
        kf[0] = KFRAG(k_cur, 0); kf[1] = KFRAG(k_cur, 1); kf[2] = KFRAG(k_cur, 2); kf[3] = KFRAG(k_cur, 3);
        WAIT_BAR(3);
        s16x4 vlo[4], vhi[4]; u32x4 pw0, pw1, pw2, pw3;
#define PKW(P, B) cvt_pk_bf16(P[B], P[B + 1])
#define PAF(k) __builtin_bit_cast(bf16x8, pw##k)
#define VFR(i) (bf16x8){vlo[i][0], vlo[i][1], vlo[i][2], vlo[i][3], vhi[i][0], vhi[i][1], vhi[i][2], vhi[i][3]}
#define PIN(x) asm volatile("" : "+v"(x))
#define EX(v) __builtin_amdgcn_exp2f(v)
#define VRD(slot, f) do { vlo[slot] = vtr(vp_ + (((f) & 3) * 4096 + ((f) >> 2) * 1024)); vhi[slot] = vtr(vp_ + (((f) & 3) * 4096 + ((f) >> 2) * 1024 + 512)); } while (0)
#define GAPA(MF, LDX, A0, A1, A2, A3, W0, W1, PW) do { MF; LDX; sacc += A0; sacc += A1; sacc += A2; sacc += A3; PIN(sacc); W0; W1; PIN(PW); SBAR(); } while (0)
#define GAPB(MF, LDX, X, B) do { MF; LDX; X[B] = EX(X[B]); X[B + 1] = EX(X[B + 1]); PIN(X); SBAR(); } while (0)
#define PVM(f) o[(f) & 3] = __builtin_amdgcn_mfma_f32_32x32x16_bf16(__builtin_bit_cast(bf16x8, (f) < 4 ? pw0 : (f) < 8 ? pw1 : (f) < 12 ? pw2 : pw3), VFR((f) & 3), o[(f) & 3], 0, 0, 0)
#define NOP_ do { } while (0)
#if PROBE_ATT
#define ATT_T(k) do { if (PROBE_ATT == (k)) { const unsigned long long n_ = __builtin_amdgcn_s_memrealtime(); if (tid == 0) *(LAS unsigned long long*)(shm + PTRS_OFF - 64) += n_ - att_t0; } } while (0)
#define ATT_T0() const unsigned long long att_t0 = __builtin_amdgcn_s_memrealtime()
#else
#define ATT_T(k) do { } while (0)
#define ATT_T0() do { } while (0)
#endif
#define STEP(C0, C1, P0, P1, t, GK, GV, GL) do { SBAR(); \
        const lds_cptr vp_ = vp0 + i_prev * VSLOT; \
        float sacc = (P0[0] + P0[1]); \
        GAPA(C0 = __builtin_amdgcn_mfma_f32_32x32x16_bf16(kf[0], qr[0], (f32x16){}, 0, 0, 0), kf[0] = KFRAG(k_cur, 4), P0[2], P0[3], P0[4], P0[5],     pw0[0] = PKW(P0, 0), pw0[1] = PKW(P0, 2), pw0); \
        GAPA(C1 = __builtin_amdgcn_mfma_f32_32x32x16_bf16(kf[1], qr[0], (f32x16){}, 0, 0, 0), kf[1] = KFRAG(k_cur, 5), P0[6], P0[7], P0[8], P0[9],     pw0[2] = PKW(P0, 4), pw0[3] = PKW(P0, 6), pw0); \
        GAPA(C0 = __builtin_amdgcn_mfma_f32_32x32x16_bf16(kf[2], qr[1], C0, 0, 0, 0),         kf[2] = KFRAG(k_cur, 6), P0[10], P0[11], P0[12], P0[13], pw1[0] = PKW(P0, 8), pw1[1] = PKW(P0, 10), pw1); \
        GAPA(C1 = __builtin_amdgcn_mfma_f32_32x32x16_bf16(kf[3], qr[1], C1, 0, 0, 0),         kf[3] = KFRAG(k_cur, 7), P0[14], P0[15], P1[0], P1[1],   pw1[2] = PKW(P0, 12), pw1[3] = PKW(P0, 14), pw1); \
        GAPA(C0 = __builtin_amdgcn_mfma_f32_32x32x16_bf16(kf[0], qr[2], C0, 0, 0, 0),         VRD(0, 0), P1[2], P1[3], P1[4], P1[5],     pw2[0] = PKW(P1, 0), pw2[1] = PKW(P1, 2), pw2); \
        GAPA(C1 = __builtin_amdgcn_mfma_f32_32x32x16_bf16(kf[1], qr[2], C1, 0, 0, 0),         VRD(1, 1), P1[6], P1[7], P1[8], P1[9],     pw2[2] = PKW(P1, 4), pw2[3] = PKW(P1, 6), pw2); \
        GAPA(C0 = __builtin_amdgcn_mfma_f32_32x32x16_bf16(kf[2], qr[3], C0, 0, 0, 0),         VRD(2, 2), P1[10], P1[11], P1[12], P1[13], pw3[0] = PKW(P1, 8), pw3[1] = PKW(P1, 10), pw3); \
        GAPA(C1 = __builtin_amdgcn_mfma_f32_32x32x16_bf16(kf[3], qr[3], C1, 0, 0, 0),         VRD(3, 3), P1[14], P1[15], 0.f, 0.f,       pw3[2] = PKW(P1, 12), pw3[3] = PKW(P1, 14), pw3); \
        l_reg += sacc; \
        if (GK) { DMA_K((t) + 3, (k_cur + 3) & 3); } if (GV) { DMA_V((t) + 1, i_next); } \
        SBAR(); \
        GAPB(PVM(0), VRD(0, 4), C0, 0);   GAPB(PVM(1), VRD(1, 5), C0, 2);   GAPB(PVM(2), VRD(2, 6), C0, 4);    GAPB(PVM(3), VRD(3, 7), C0, 6); \
        GAPB(PVM(4), VRD(0, 8), C0, 8);   GAPB(PVM(5), VRD(1, 9), C0, 10);  GAPB(PVM(6), VRD(2, 10), C0, 12);  GAPB(PVM(7), VRD(3, 11), C0, 14); \
        GAPB(PVM(8), VRD(0, 12), C1, 0);  GAPB(PVM(9), VRD(1, 13), C1, 2);  GAPB(PVM(10), VRD(2, 14), C1, 4);  GAPB(PVM(11), VRD(3, 15), C1, 6); \
        GAPB(PVM(12), if (GL) kf[0] = KFRAG(k_next, 0), C1, 8);  GAPB(PVM(13), if (GL) kf[1] = KFRAG(k_next, 1), C1, 10); \
        GAPB(PVM(14), if (GL) kf[2] = KFRAG(k_next, 2), C1, 12); GAPB(PVM(15), if (GL) kf[3] = KFRAG(k_next, 3), C1, 14); \
        } while (0)
        int t = 1;
#pragma unroll 1
        for (; t + 5 < NT; t += 2) {
#if PROBE_ATT == 1
            STEP(pB0, pB1, pA0, pA1, t, true, true, true);     { ATT_T0(); WAIT_BAR(3); ATT_T(1); } ROT();
            STEP(pA0, pA1, pB0, pB1, t + 1, true, true, true); { ATT_T0(); WAIT_BAR(3); ATT_T(1); } ROT();
#elif PROBE_ATT >= 2
            { ATT_T0(); STEP(pB0, pB1, pA0, pA1, t, true, true, true); ATT_T(2); }    WAIT_BAR(3); ROT();
            { ATT_T0(); STEP(pA0, pA1, pB0, pB1, t + 1, true, true, true); ATT_T(2); } WAIT_BAR(3); ROT();
#else
            STEP(pB0, pB1, pA0, pA1, t, true, true, true);     WAIT_BAR(3); ROT();
            STEP(pA0, pA1, pB0, pB1, t + 1, true, true, true); WAIT_BAR(3); ROT();
#endif
        }
#define ENDW(tt) do { if ((tt) + 3 < NT) { WAIT_BAR(3); } else if ((tt) + 2 < NT) { WAIT_BAR(2); } else { WAIT_BAR(0); } } while (0)
#pragma unroll 1
        for (; t + 1 < NT; t += 2) {
            STEP(pB0, pB1, pA0, pA1, t, (t + 3 < NT), (t + 1 < NT), (t + 1 < NT));         ENDW(t);     ROT();
            STEP(pA0, pA1, pB0, pB1, t + 1, (t + 4 < NT), (t + 2 < NT), (t + 2 < NT));     ENDW(t + 1); ROT();
        }
        STEP(pB0, pB1, pA0, pA1, NT - 1, false, false, false);
        {
            float sacc = pB0[0] + pB0[1];
#pragma unroll
            for (int r = 2; r < 16; ++r) sacc += pB0[r];
#pragma unroll
            for (int r = 0; r < 16; ++r) sacc += pB1[r];
            l_reg += sacc;
            pw0 = (u32x4){PKW(pB0, 0), PKW(pB0, 2), PKW(pB0, 4), PKW(pB0, 6)}; pw1 = (u32x4){PKW(pB0, 8), PKW(pB0, 10), PKW(pB0, 12), PKW(pB0, 14)};
            pw2 = (u32x4){PKW(pB1, 0), PKW(pB1, 2), PKW(pB1, 4), PKW(pB1, 6)}; pw3 = (u32x4){PKW(pB1, 8), PKW(pB1, 10), PKW(pB1, 12), PKW(pB1, 14)};
            const lds_cptr vp_ = vp0 + i_cur * VSLOT;
            VRD(0, 0); VRD(1, 1); VRD(2, 2); VRD(3, 3); PVM(0); PVM(1); PVM(2); PVM(3);
            VRD(0, 4); VRD(1, 5); VRD(2, 6); VRD(3, 7); PVM(4); PVM(5); PVM(6); PVM(7);
            VRD(0, 8); VRD(1, 9); VRD(2, 10); VRD(3, 11); PVM(8); PVM(9); PVM(10); PVM(11);
            VRD(0, 12); VRD(1, 13); VRD(2, 14); VRD(3, 15); PVM(12); PVM(13); PVM(14); PVM(15);
        }
#undef DMA_K
#undef DMA_V
#undef ROT
#undef PKW
#undef PAF
#undef VFR
#undef PIN
#undef EX
#undef VRD
#undef GAPA
#undef GAPB
#undef KFRAG
#undef NOP_
#undef PVM
#undef STEP
#undef ENDW
        { auto rr = __builtin_amdgcn_permlane32_swap(__float_as_uint(l_reg), __float_as_uint(l_reg), false, false); l_reg = __uint_as_float(rr[0]) + __uint_as_float(rr[1]); }
        if (hi == 0) wsf[r32] = l_reg;
        LDS_WAIT();
        float rli[16];
#pragma unroll
        for (int r = 0; r < 16; ++r) rli[r] = 1.0f / wsf[crow(r, hi)];
        if (c == 0) {
#pragma unroll
            for (int d0 = 0; d0 < 4; ++d0)
#pragma unroll
                for (int r = 0; r < 16; ++r) stash[(d0 * 16 + r) * 64 + lane] = f2bf(o[d0][r] * rli[r]);
            LDS_WAIT();
        } else {
#pragma unroll
            for (int d0 = 0; d0 < 4; ++d0)
#pragma unroll
                for (int r = 0; r < 16; ++r) o[d0][r] = bf2f(stash[(d0 * 16 + r) * 64 + lane]) - lam * (o[d0][r] * rli[r]);
            LDS_WAIT(); asm volatile("" ::: "memory");
#pragma unroll
            for (int d0 = 0; d0 < 4; ++d0)
#pragma unroll
                for (int r = 0; r < 16; ++r) stash[crow(r, hi) * 128 + d0 * 32 + r32] = f2bf(o[d0][r]);
            LDS_WAIT(); asm volatile("" ::: "memory");
            bf16_t* Ow = Ob + qrow * opitch + ZQ + h * 128;
#pragma unroll
            for (int i = 0; i < 4; ++i) { const int row = i * 8 + (lane >> 3), ch = lane & 7;
                const u32x4 w0 = *(const LAS u32x4*)(stash + row * 128 + ch * 16), w1 = *(const LAS u32x4*)(stash + row * 128 + ch * 16 + 8);
                float v[16];
#pragma unroll
                for (int j = 0; j < 4; ++j) { v[2 * j] = bflo(w0[j]); v[2 * j + 1] = bfhi(w0[j]); v[8 + 2 * j] = bflo(w1[j]); v[9 + 2 * j] = bfhi(w1[j]); }
                float ss = 0.f;
#pragma unroll
                for (int j = 0; j < 16; ++j) ss += v[j] * v[j];
                ss += __shfl_xor(ss, 1); ss += __shfl_xor(ss, 2); ss += __shfl_xor(ss, 4);
                const float rs = (1.0f - LAMBDA_INIT) / sqrtf(ss * (1.f / 128.f) + NORM_EPS);
                u32x4 x0, x1;
#pragma unroll
                for (int j = 0; j < 4; ++j) { x0[j] = cvt_pk_bf16(v[2 * j] * rs * subln_g[ch * 16 + 2 * j], v[2 * j + 1] * rs * subln_g[ch * 16 + 2 * j + 1]);
                                              x1[j] = cvt_pk_bf16(v[8 + 2 * j] * rs * subln_g[ch * 16 + 8 + 2 * j], v[9 + 2 * j] * rs * subln_g[ch * 16 + 9 + 2 * j]); }
                *(u32x4*)(Ow + (size_t)row * opitch + ch * 16) = x0; *(u32x4*)(Ow + (size_t)row * opitch + ch * 16 + 8) = x1; }
            LDS_WAIT();
        }
        asm volatile("s_waitcnt vmcnt(0) lgkmcnt(0)\n\ts_barrier" ::: "memory");
    }
}
#undef SBAR
#undef WAIT_BAR
}

namespace rw {
constexpr int P = 144, MAT = 64 * P;
constexpr int O_AT = 0, O_RT = MAT, O_BT = 2 * MAT, O_KT = 3 * MAT, O_ATT = 4 * MAT, O_VT = 5 * MAT, O_BHT = 6 * MAT, O_KHT = 7 * MAT;
constexpr int O_LAB = 8 * MAT, O_LAK = 9 * MAT, O_ARB = 10 * MAT, O_ARK = 11 * MAT, O_XT = 12 * MAT, O_ABT = 13 * MAT, O_U0T = 14 * MAT;
constexpr int O_LABD = 15 * MAT, O_TII = O_LABD + 4096, O_WC = O_TII + 2048, O_GSUM = O_WC + 256, O_PAR = O_GSUM + 2048, O_END = O_PAR + 960 * 4;
constexpr int O_ZS = 0;
constexpr int O_TW = O_LAB, O_ADN = O_LAK, O_WL = O_ARB, O_AR = O_XT, PF = 272;
static_assert(O_END <= PTRS_OFF - 64 && 64 * PF <= 2 * MAT, "rwkv lds");
__device__ __forceinline__ int crow(int r, int hi) { return (r & 3) + 8 * (r >> 2) + 4 * hi; }
__device__ __forceinline__ float sigmoidf_(float x) { return __builtin_amdgcn_rcpf(1.0f + __expf(-x)); }
__device__ __forceinline__ float tanhf_(float x) { return 1.0f - 2.0f * __builtin_amdgcn_rcpf(__expf(2.0f * x) + 1.0f); }
__device__ __forceinline__ void load10(const bf16_t* zc, int t_lo, int S, float (&z)[10]) {
#pragma unroll
    for (int i = 0; i < 10; ++i) { const int t = t_lo - 1 + i; z[i] = (t >= 0 && t < S) ? bf2f(zc[(size_t)t * ZP]) : 0.f; }
}
__device__ __forceinline__ float tshift(const float (&z)[10], int u, float mp, float mn) { const float c = z[u + 1]; return c + mp * (z[u] - c) + mn * (z[u + 2] - c); }
__device__ __forceinline__ f32x16 mm_ll(const LAS unsigned char* A, int rowA, const LAS unsigned char* B, int rowB, f32x16 acc, int r32, int hi) {
#pragma unroll
    for (int ks = 0; ks < 4; ++ks) { const bf16x8 a = *(const LAS bf16x8*)(A + (rowA + r32) * P + (16 * ks + 8 * hi) * 2), b = *(const LAS bf16x8*)(B + (rowB + r32) * P + (16 * ks + 8 * hi) * 2);
        acc = __builtin_amdgcn_mfma_f32_32x32x16_bf16(a, b, acc, 0, 0, 0); }
    return acc;
}
__device__ __forceinline__ void store_native(unsigned char* dst, const f32x16& acc, int lane, bool wt) {
    u32x4 w0, w1;
#pragma unroll
    for (int q = 0; q < 4; ++q) { w0[q] = cvt_pk_bf16(acc[2 * q], acc[2 * q + 1]); w1[q] = cvt_pk_bf16(acc[8 + 2 * q], acc[9 + 2 * q]); }
    if (wt) {
        asm volatile("global_store_dwordx4 %0, %1, off sc1\n\tglobal_store_dwordx4 %0, %2, off offset:16 sc1\n\ts_nop 1" :: "v"(dst + lane * 32), "v"(w0), "v"(w1) : "memory");
    } else { *(u32x4*)(dst + lane * 32) = w0; *(u32x4*)(dst + lane * 32 + 16) = w1; }
}
__device__ __forceinline__ void st4(LAS unsigned char* p, float a, float b, float c, float d) { u32x2 w; w.x = cvt_pk_bf16(a, b); w.y = cvt_pk_bf16(c, d); *(LAS u32x2*)p = w; }

__device__ __forceinline__ f32x2_t s1_param_load(LAS unsigned char* L, int tid, int d, int h) {
    const int seg = tid >> 5, off = (tid & 31) * 2; f32x2_t r = {0.f, 0.f};
    if (seg < 15) { const float* src;
        if (seg < 10) src = inp(L, 11 + (seg & 1)) + (seg < 6 ? (seg >> 1) * 512 + h * 64 : (seg < 8 ? ZWD - ZRR : ZAD - ZRR));
        else if (seg == 10) src = inp(L, 13) + d * 512 + h * 64; else if (seg == 11) src = inp(L, 15) + d * 512 + h * 64;
        else src = inp(L, 18 + (seg - 12)) + h * 64;
        r = *(const f32x2_t*)(src + off); }
    return r;
}
__device__ __forceinline__ void s1_stage_load(const Args& a, int tid, int q, int h, int ck, u32x4 (&v)[6]) {
    const int row0 = seq_row0(q), S = seq_len(q), t0 = ck * 64;
    const bf16_t* Zs = (const bf16_t*)(a.ws + WS_Z) + (size_t)row0 * ZP;
#pragma unroll
    for (int k = 0; k < 6; ++k) { const int c = tid + k * NTHR; const int seg = c >> 3, part = c & 7, row = seg / 5, grp = seg - row * 5, t = t0 - 1 + row;
        const int colb = grp < 3 ? ZRR + grp * 512 + h * 64 : (grp == 3 ? ZWD : ZAD);
        v[k] = (u32x4){0u, 0u, 0u, 0u};
        if (c < 66 * 5 * 8 && t >= 0 && t < S) v[k] = *(const u32x4*)(Zs + (size_t)t * ZP + colb + part * 8); }
}
__device__ __forceinline__ void s1_item(const Frame& F, const Args& a, int d, int q, int h, int ck, unsigned char* slot, u32x4 (&stg)[6], f32x2_t& par, bool has_next, int nd, int nq, int nh, int nck, bool wt, unsigned* publish_prev) {
    LAS unsigned char* L = F.lds;
#if PROBE_S1 >= 0
    unsigned long long pt_last = 0; int pt_n = 0;
#define PST() do { if (F.tid == 0) { const unsigned long long n_ = __builtin_amdgcn_s_memrealtime(); if (pt_n == PROBE_S1 + 1) *(LAS unsigned long long*)(L + PTRS_OFF - 64) += n_ - pt_last; pt_last = n_; } ++pt_n; } while (0)
#else
#define PST() do { } while (0)
#endif
    PST();
    int lane_ = F.lane; asm volatile("" : "+v"(lane_));
    const int lane = lane_, w = F.wave, tid = w * 64 + lane, r32 = lane & 31, hi = lane >> 5;
    const int j = lane, tg = w;
    const int row0 = seq_row0(q), S = seq_len(q), t0 = ck * 64;
    const bf16_t* Zs = (const bf16_t*)(a.ws + WS_Z) + (size_t)row0 * ZP;
    const int t_lo = d == 0 ? t0 + 8 * tg : t0 + 56 - 8 * tg;
    const int tau0 = 8 * tg;
#define TAU(u) (d == 0 ? tau0 + (u) : tau0 + 7 - (u))
    const int ch = h * 64 + j;
    bf16x8 wfr[4];
    { const int which = w >> 2, mt = (w >> 1) & 1;
      const bf16_t* WT = (const bf16_t*)(a.ws + WS_LORA) + (which ? 2 * 512 * 64 : 0) + ((size_t)d * 512 + h * 64 + 32 * mt + r32) * 64;
#pragma unroll
      for (int ks = 0; ks < 4; ++ks) wfr[ks] = *(const bf16x8*)(WT + 16 * ks + 8 * hi); }
    {
#pragma unroll
        for (int k = 0; k < 6; ++k) { const int c = tid + k * NTHR; const int seg = c >> 3, part = c & 7, row = seg / 5, grp = seg - row * 5;
            if (c < 66 * 5 * 8) *(LAS u32x4*)(L + O_ZS + (grp * 66 + row) * P + part * 16) = stg[k]; }
        if (tid < 480) *(LAS f32x2_t*)(L + O_PAR + tid * 8) = par;
    }
    LBAR(); PST();
    if (has_next) { s1_stage_load(a, tid, nq, nh, nck, stg); par = s1_param_load(L, tid, nd, nh); }
#define PAR(seg, idx) (*(const LAS float*)(L + O_PAR + ((seg) * 64 + (idx)) * 4))
    const LAS unsigned char* zsb = L + O_ZS + (t_lo - t0) * P + j * 2;
#define LD10(z, g) do { _Pragma("unroll") for (int i_ = 0; i_ < 10; ++i_) z[i_] = bf2f(*(const LAS bf16_t*)(zsb + ((g) * 66 + i_) * P)); } while (0)
    {
        float zw[10], za[10]; LD10(zw, 3); LD10(za, 4);
        const float mpw = PAR(6, j), mnw = PAR(7, j), mpa = PAR(8, j), mna = PAR(9, j);
#pragma unroll
        for (int u = 0; u < 8; ++u) { const int tau = TAU(u);
            *(LAS bf16_t*)(L + O_TW + tau * P + j * 2) = f2bf(tanhf_(tshift(zw, u, mpw, mnw)));
            *(LAS bf16_t*)(L + O_ADN + tau * P + j * 2) = f2bf(tshift(za, u, mpa, mna)); }
    }
    LBAR(); PST();
    {
        const int which = w >> 2, mt = (w >> 1) & 1, nt = w & 1;
        const LAS unsigned char* B = L + (which ? O_ADN : O_TW);
        f32x16 acc = f32x16{};
#pragma unroll
        for (int ks = 0; ks < 4; ++ks) { const bf16x8 bv = *(const LAS bf16x8*)(B + (32 * nt + r32) * P + (16 * ks + 8 * hi) * 2);
            acc = __builtin_amdgcn_mfma_f32_32x32x16_bf16(wfr[ks], bv, acc, 0, 0, 0); }
        LAS unsigned char* O = L + (which ? O_AR : O_WL) + (32 * nt + r32) * PF;
#pragma unroll
        for (int g = 0; g < 4; ++g) { const int jj = 8 * g + 4 * hi; const f32x4 bv = *(const LAS f32x4*)(L + O_PAR + ((10 + which) * 64 + 32 * mt + jj) * 4);
            *(LAS f32x4*)(O + (32 * mt + jj) * 4) = (f32x4){acc[4 * g] + bv[0], acc[4 * g + 1] + bv[1], acc[4 * g + 2] + bv[2], acc[4 * g + 3] + bv[3]}; }
    }
    LBAR(); PST();
    float aa[8], bb[8], rr[8], kd[8], vv[8], ld[8];
    {
        float zr[10], zk[10], zv[10]; LD10(zr, 0); LD10(zk, 1); LD10(zv, 2);
        const float mpr = PAR(0, j), mnr = PAR(1, j), mpk = PAR(2, j), mnk = PAR(3, j), mpv = PAR(4, j), mnv = PAR(5, j);
        const float kkc = PAR(12, j), kac = PAR(13, j), rkc = PAR(14, j);
        float* bon = (float*)(a.ws + WS_BONUS) + ((size_t)d * MTOK + row0) * 8 + h;
#pragma unroll
        for (int u = 0; u < 8; ++u) { const int tau = TAU(u);
            const float wl = *(const LAS float*)(L + O_WL + tau * PF + j * 4), ar = *(const LAS float*)(L + O_AR + tau * PF + j * 4);
            ld[u] = -0.6065306597126334f * sigmoidf_(wl); const float arate = sigmoidf_(ar);
            rr[u] = tshift(zr, u, mpr, mnr); const float k0 = tshift(zk, u, mpk, mnk); vv[u] = tshift(zv, u, mpv, mnv);
            const float kkr = k0 * kkc; const float ssq = wave_sum_dpp(kkr * kkr); const float kkn = kkr * __builtin_amdgcn_rsqf(ssq + 1e-12f);
            kd[u] = k0 * (1.0f + (arate - 1.0f) * kac); aa[u] = -kkn; bb[u] = kkn * arate;
            const float bsum = wave_sum_dpp(rr[u] * kd[u] * rkc);
            if (lane == 0) bon[(size_t)(t_lo + u) * 8] = bsum; }
        float tot = 0.f;
#pragma unroll
        for (int u = 0; u < 8; ++u) tot += ld[u];
        *(LAS float*)(L + O_GSUM + tg * 256 + j * 4) = tot;
    }
    LBAR(); PST();
    {
        float pre = 0.f, cC = 0.f;
#pragma unroll
        for (int g = 0; g < 8; ++g) { const float s = *(const LAS float*)(L + O_GSUM + g * 256 + j * 4); cC += s; if (g < tg) pre += s; }
        float tot = 0.f;
#pragma unroll
        for (int u = 0; u < 8; ++u) tot += ld[u];
        float At[8], Vt[8], Bh[8], Kh[8]; float pf = 0.f;
#pragma unroll
        for (int u = 0; u < 8; ++u) { pf += ld[u]; const int tau = TAU(u);
            const float cl = pre + (d == 0 ? pf : tot - pf + ld[u]);
            const float e_m1 = __expf(cl - ld[u]), e_p = __expf(cl), e_n = __expf(-cl), e_c = __expf(cC - cl);
            At[u] = aa[u] * e_m1; Vt[u] = vv[u]; Bh[u] = bb[u] * e_c; Kh[u] = kd[u] * e_c;
            *(LAS bf16_t*)(L + O_AT + tau * P + j * 2) = f2bf(At[u]); *(LAS bf16_t*)(L + O_RT + tau * P + j * 2) = f2bf(rr[u] * e_p);
            *(LAS bf16_t*)(L + O_BT + tau * P + j * 2) = f2bf(bb[u] * e_n); *(LAS bf16_t*)(L + O_KT + tau * P + j * 2) = f2bf(kd[u] * e_n); }
#define PK8(dst, X) do { u32x4 w_; _Pragma("unroll") for (int k = 0; k < 4; ++k) { const float x0 = d == 0 ? X[2 * k] : X[7 - 2 * k], x1 = d == 0 ? X[2 * k + 1] : X[6 - 2 * k]; w_[k] = cvt_pk_bf16(x0, x1); } \
            *(LAS u32x4*)(L + (dst) + j * P + tau0 * 2) = w_; } while (0)
        PK8(O_ATT, At); PK8(O_VT, Vt); PK8(O_BHT, Bh); PK8(O_KHT, Kh);
#undef PK8
        if (tg == 0) *(LAS float*)(L + O_WC + j * 4) = __expf(cC);
    }
    LBAR(); PST();
#pragma unroll
    for (int i = 0; i < 2; ++i) {
        const int ti = 2 * w + i, ms = ti >> 2, nl = ti & 3;
        const int sb = 32 * (ms & 1), tb = 32 * (nl & 1);
        f32x16 acc = f32x16{};
        if (sb <= tb) acc = mm_ll(L + (ms < 2 ? O_BT : O_KT), sb, L + (nl < 2 ? O_AT : O_RT), tb, acc, r32, hi);
        const bool incl = nl >= 2; const int dst = ms < 2 ? (nl < 2 ? O_LAB : O_ARB) : (nl < 2 ? O_LAK : O_ARK);
        const int t = tb + r32;
#pragma unroll
        for (int g = 0; g < 4; ++g) { const int s0 = sb + 8 * g + 4 * hi; float v[4];
#pragma unroll
            for (int e = 0; e < 4; ++e) { const int s = s0 + e; v[e] = (incl ? (s <= t) : (s < t)) ? acc[4 * g + e] : 0.f; }
            st4(L + dst + t * P + s0 * 2, v[0], v[1], v[2], v[3]);
            if (dst == O_LAB && (s0 >> 4) == (t >> 4)) *(LAS f32x4*)(L + O_LABD + (((t >> 4) * 16 + (t & 15)) * 16 + (s0 & 15)) * 4) = (f32x4){v[0], v[1], v[2], v[3]}; }
    }
    LBAR(); PST();
    if (w < 4) {
        const int mt = w >> 1, nt = w & 1; f32x16 acc = f32x16{};
        acc = mm_ll(L + O_LAK, 32 * mt, L + O_VT, 32 * nt, acc, r32, hi);
#pragma unroll
        for (int g = 0; g < 4; ++g) st4(L + O_XT + (32 * nt + r32) * P + (32 * mt + 8 * g + 4 * hi) * 2, acc[4 * g], acc[4 * g + 1], acc[4 * g + 2], acc[4 * g + 3]);
    } else if (w == 7) {
        const int blk = lane >> 4, cc = lane & 15; float x[16];
#pragma unroll
        for (int t = 0; t < 16; ++t) { float s = (t == cc) ? 1.f : 0.f; const LAS float* lr = (const LAS float*)(L + O_LABD + ((blk * 16 + t) * 16) * 4);
#pragma unroll
            for (int k = 0; k < t; ++k) s += lr[k] * x[k];
            x[t] = s; *(LAS bf16_t*)(L + O_TII + ((blk * 16 + t) * 16 + cc) * 2) = f2bf(s); }
    }
    LBAR(); PST();
    {
        const int c16 = lane & 15, q4 = lane >> 4;
        const LAS unsigned char* RT = L + (w < 4 ? O_ATT : O_XT) + (16 * (w & 3) + c16) * P;
        LAS unsigned char* OT = L + (w < 4 ? O_ABT : O_U0T) + (16 * (w & 3) + c16) * P;
        const LAS unsigned char* LA = L + O_LAB + c16 * P;
#define RHS(i) ({ const u32x2 r_ = *(const LAS u32x2*)(RT + (16 * (i) + 4 * q4) * 2); (f32x4){bflo(r_.x), bfhi(r_.x), bflo(r_.y), bfhi(r_.y)}; })
#define AFR(i, k1, k2) ({ const u32x2 lo_ = *(const LAS u32x2*)(LA + 16 * (i) * P + (16 * (k1) + 4 * q4) * 2); u32x2 hi_ = {0u, 0u}; if ((k2) >= 0) hi_ = *(const LAS u32x2*)(LA + 16 * (i) * P + (16 * ((k2) < 0 ? 0 : (k2)) + 4 * q4) * 2); \
        __builtin_bit_cast(bf16x8, (u32x4){lo_.x, lo_.y, hi_.x, hi_.y}); })
#define TFR(i) ({ const u32x2 lo_ = *(const LAS u32x2*)(L + O_TII + (((i) * 16 + c16) * 16 + 4 * q4) * 2); __builtin_bit_cast(bf16x8, (u32x4){lo_.x, lo_.y, 0u, 0u}); })
#define BFR(U1, U2) __builtin_bit_cast(bf16x8, (u32x4){cvt_pk_bf16(U1[0], U1[1]), cvt_pk_bf16(U1[2], U1[3]), cvt_pk_bf16(U2[0], U2[1]), cvt_pk_bf16(U2[2], U2[3])})
#define MF16(A_, B_, C_) __builtin_amdgcn_mfma_f32_16x16x32_bf16(A_, B_, C_, 0, 0, 0)
        const f32x4 zero4 = {0.f, 0.f, 0.f, 0.f};
        f32x4 U0 = MF16(TFR(0), BFR(RHS(0), zero4), zero4);
        f32x4 Z1 = MF16(AFR(1, 0, -1), BFR(U0, zero4), RHS(1));
        f32x4 U1 = MF16(TFR(1), BFR(Z1, zero4), zero4);
        f32x4 Z2 = MF16(AFR(2, 0, 1), BFR(U0, U1), RHS(2));
        f32x4 U2 = MF16(TFR(2), BFR(Z2, zero4), zero4);
        f32x4 Z3 = MF16(AFR(3, 0, 1), BFR(U0, U1), RHS(3));
        Z3 = MF16(AFR(3, 2, -1), BFR(U2, zero4), Z3);
        f32x4 U3 = MF16(TFR(3), BFR(Z3, zero4), zero4);
        st4(OT + (0 + 4 * q4) * 2, U0[0], U0[1], U0[2], U0[3]); st4(OT + (16 + 4 * q4) * 2, U1[0], U1[1], U1[2], U1[3]);
        st4(OT + (32 + 4 * q4) * 2, U2[0], U2[1], U2[2], U2[3]); st4(OT + (48 + 4 * q4) * 2, U3[0], U3[1], U3[2], U3[3]);
#undef RHS
#undef AFR
#undef TFR
#undef BFR
#undef MF16
    }
    if (publish_prev) asm volatile("s_waitcnt vmcnt(0)" ::: "memory");
    LBAR(); PST();
    if (publish_prev && tid == 0) __hip_atomic_fetch_add(publish_prev, 1u, __ATOMIC_RELAXED, __HIP_MEMORY_SCOPE_AGENT);
    {
        const int mt = (w >> 1) & 1, nt = w & 1;
        if (w < 4) {
            f32x16 acc = f32x16{};
            acc = mm_ll(L + O_ABT, 32 * mt, L + O_BHT, 32 * nt, acc, r32, hi);
            if (mt == nt) { const float wc = *(const LAS float*)(L + O_WC + (32 * nt + r32) * 4);
#pragma unroll
                for (int r = 0; r < 16; ++r) if (crow(r, hi) == r32) acc[r] += wc; }
            store_native(slot + (mt * 2 + nt) * 2048, acc, lane, wt);
            f32x16 rb;
#pragma unroll
            for (int g = 0; g < 4; ++g) { const u32x2 r_ = *(const LAS u32x2*)(L + O_RT + (32 * nt + r32) * P + (32 * mt + 8 * g + 4 * hi) * 2);
                rb[4 * g] = bflo(r_.x); rb[4 * g + 1] = bfhi(r_.x); rb[4 * g + 2] = bflo(r_.y); rb[4 * g + 3] = bfhi(r_.y); }
            rb = mm_ll(L + O_ABT, 32 * mt, L + O_ARB, 32 * nt, rb, r32, hi);
            store_native(slot + 16384 + (mt * 2 + nt) * 2048, rb, lane, wt);
        } else {
            f32x16 acc = f32x16{};
            acc = mm_ll(L + O_BHT, 32 * mt, L + O_U0T, 32 * nt, acc, r32, hi);
            acc = mm_ll(L + O_KHT, 32 * mt, L + O_VT, 32 * nt, acc, r32, hi);
            store_native(slot + 8192 + (mt * 2 + nt) * 2048, acc, lane, wt);
            f32x16 y0 = f32x16{};
            y0 = mm_ll(L + O_ARB, 32 * mt, L + O_U0T, 32 * nt, y0, r32, hi);
            y0 = mm_ll(L + O_ARK, 32 * mt, L + O_VT, 32 * nt, y0, r32, hi);
            store_native(slot + 24576 + (mt * 2 + nt) * 2048, y0, lane, wt);
        }
    }
    LBAR(); PST();
#undef PAR
#undef TAU
#undef LD10
#undef PST
}

__device__ __forceinline__ void s23_wait_round(unsigned* ready, int r, int lane) {
    unsigned spins = 0;
    while ((unsigned)__builtin_amdgcn_readfirstlane(__hip_atomic_load(ready + r, __ATOMIC_RELAXED, __HIP_MEMORY_SCOPE_AGENT)) < 16u) { __builtin_amdgcn_s_sleep(8); if (++spins > (1u << 22)) break; }
    __builtin_amdgcn_fence(__ATOMIC_ACQUIRE, "agent");
    asm volatile("s_waitcnt vmcnt(0)" ::: "memory");
}
__device__ __forceinline__ void s23_chain_wg(const Frame& F, const Args& a, int d, int q, int h, unsigned char* slots  , unsigned* ready) {
    LAS unsigned char* L = F.lds;
    const int lane = F.lane, w = F.wave, icb = w & 1;
    const int NC = seq_len(q) / 64;
    f32x16 X0 = f32x16{}, X1 = f32x16{};
    const bool loader = w >= 4, compute = w < 2;
    constexpr int D = 6;
#define CKOF(cc) (d == 0 ? (cc) : NC - 1 - (cc))
#define S23_DMA(cc) do { const unsigned char* src_ = slots + (size_t)CKOF(cc) * SLOT_BYTES + (w - 4) * 4096 + lane * 16; LAS unsigned char* dst_ = L + ((cc) & 7) * 16384 + (w - 4) * 4096; \
        _Pragma("unroll") for (int p_ = 0; p_ < 4; ++p_) __builtin_amdgcn_global_load_lds((const unsigned*)(src_ + p_ * 1024), (LAS unsigned*)(dst_ + p_ * 1024), 16, 0, 0); } while (0)
#define UNPK(dst, w0, w1) do { _Pragma("unroll") for (int q_ = 0; q_ < 4; ++q_) { dst[2 * q_] = bflo(w0[q_]); dst[2 * q_ + 1] = bfhi(w0[q_]); dst[8 + 2 * q_] = bflo(w1[q_]); dst[9 + 2 * q_] = bfhi(w1[q_]); } } while (0)
    if (ready) { if (w == 4) s23_wait_round(ready, 0, lane); asm volatile("s_waitcnt lgkmcnt(0)\n\ts_barrier" ::: "memory"); }
    if (loader) {
#pragma unroll
        for (int c0 = 0; c0 < D; ++c0) if (c0 < NC) S23_DMA(c0); }
#pragma unroll 1
    for (int cc = 0; cc < NC; ++cc) {
        if (ready && w == 4 && ((cc + D) & 15) == 0 && cc + D < NC) s23_wait_round(ready, (cc + D) >> 4, lane);
        if (loader) { const int later = NC - 1 - cc;
            if (later >= 5) asm volatile("s_waitcnt vmcnt(20)" ::: "memory"); else if (later == 4) asm volatile("s_waitcnt vmcnt(16)" ::: "memory"); else if (later == 3) asm volatile("s_waitcnt vmcnt(12)" ::: "memory");
            else if (later == 2) asm volatile("s_waitcnt vmcnt(8)" ::: "memory"); else if (later == 1) asm volatile("s_waitcnt vmcnt(4)" ::: "memory"); else asm volatile("s_waitcnt vmcnt(0)" ::: "memory"); }
        asm volatile("s_waitcnt lgkmcnt(0)\n\ts_barrier" ::: "memory");
        if (loader) { if (cc + D < NC) S23_DMA(cc + D); }
        if (compute) {
            const LAS unsigned char* sl = L + (cc & 7) * 16384 + lane * 32;
            u32x4 mw[4][2], dw[2][2];
#pragma unroll
            for (int t = 0; t < 4; ++t) { mw[t][0] = *(const LAS u32x4*)(sl + t * 2048); mw[t][1] = *(const LAS u32x4*)(sl + t * 2048 + 16); }
#pragma unroll
            for (int t = 0; t < 2; ++t) { dw[t][0] = *(const LAS u32x4*)(sl + 8192 + (t * 2 + icb) * 2048); dw[t][1] = *(const LAS u32x4*)(sl + 8192 + (t * 2 + icb) * 2048 + 16); }
            __builtin_amdgcn_sched_barrier(0);
            u32x4 xw[2][2];
#pragma unroll
            for (int s = 0; s < 2; ++s) {
                xw[0][s] = (u32x4){cvt_pk_bf16(X0[8 * s], X0[8 * s + 1]), cvt_pk_bf16(X0[8 * s + 2], X0[8 * s + 3]), cvt_pk_bf16(X0[8 * s + 4], X0[8 * s + 5]), cvt_pk_bf16(X0[8 * s + 6], X0[8 * s + 7])};
                xw[1][s] = (u32x4){cvt_pk_bf16(X1[8 * s], X1[8 * s + 1]), cvt_pk_bf16(X1[8 * s + 2], X1[8 * s + 3]), cvt_pk_bf16(X1[8 * s + 4], X1[8 * s + 5]), cvt_pk_bf16(X1[8 * s + 6], X1[8 * s + 7])}; }
            { unsigned char* xo = slots + (size_t)CKOF(cc) * SLOT_BYTES + ((icb * 2) * 64 + lane) * 32;
              *(u32x4*)(xo) = xw[0][0]; *(u32x4*)(xo + 16) = xw[0][1]; *(u32x4*)(xo + 2048) = xw[1][0]; *(u32x4*)(xo + 2048 + 16) = xw[1][1]; }
            asm volatile("s_waitcnt lgkmcnt(0)" ::: "memory");
            __builtin_amdgcn_sched_barrier(0);
            f32x16 N0, N1;
            UNPK(N0, dw[0][0], dw[0][1]); UNPK(N1, dw[1][0], dw[1][1]);
#pragma unroll
            for (int rb = 0; rb < 2; ++rb)
#pragma unroll
                for (int s = 0; s < 2; ++s) {
                    N0 = __builtin_amdgcn_mfma_f32_32x32x16_bf16(__builtin_bit_cast(bf16x8, mw[rb * 2 + 0][s]), __builtin_bit_cast(bf16x8, xw[rb][s]), N0, 0, 0, 0);
                    N1 = __builtin_amdgcn_mfma_f32_32x32x16_bf16(__builtin_bit_cast(bf16x8, mw[rb * 2 + 1][s]), __builtin_bit_cast(bf16x8, xw[rb][s]), N1, 0, 0, 0); }
            X0 = N0; X1 = N1;
        }
    }
    asm volatile("s_waitcnt vmcnt(0) lgkmcnt(0)\n\ts_barrier" ::: "memory");
#undef UNPK
#undef S23_DMA
#undef CKOF
}

constexpr int PO_V = 0, PO_G = PO_V + 66 * 144, PO_Y = PO_G + 66 * 272, PO_SG = PO_Y + 2 * 64 * 272, PO_GF = PO_SG + 64 * 272, PO_END = PO_GF + 64 * 272;
static_assert(PO_END <= PTRS_OFF - 64, "post lds");
struct PostPre { u32x4 stg[4]; u32x4 ra[2][2], xb[2][2], yc[2]; };
__device__ __forceinline__ void post_decode(int c, int& reg, int& row, int& part) {
    if (c < 528) { reg = 0; row = c >> 3; part = c & 7; } else { reg = 1; row = (c - 528) >> 4; part = (c - 528) & 15; }
}
__device__ __forceinline__ void post_stage_load(const Args& a, int tid, int q, int h, int blk, PostPre& pp) {
    const int row0 = seq_row0(q), S = seq_len(q), t0 = blk * 64;
    const bf16_t* Zs = (const bf16_t*)(a.ws + WS_Z) + (size_t)row0 * ZP;
#pragma unroll
    for (int k = 0; k < 4; ++k) { const int c = tid + k * NTHR; int reg, row, part; post_decode(c, reg, row, part);
        const int t = t0 - 1 + row; const int col = reg == 0 ? ZRV + h * 64 : ZGD;
        pp.stg[k] = (u32x4){0u, 0u, 0u, 0u};
        if (c < 1584 && t >= 0 && t < S) pp.stg[k] = *(const u32x4*)(Zs + (size_t)t * ZP + col + part * 8); }
    const int w = tid >> 6, lane = tid & 63, dd = w >> 2, tb = (w >> 1) & 1, icb = w & 1;
    const size_t si = q == 0 ? (size_t)(dd * 8 + h) * 256 + blk : (size_t)((dd * 8 + (q - 1)) * 8 + h) * 32 + blk;
    const unsigned char* sl = (const unsigned char*)a.out + si * SLOT_BYTES + lane * 32;
#pragma unroll
    for (int rb = 0; rb < 2; ++rb) { pp.ra[rb][0] = *(const u32x4*)(sl + 16384 + (rb * 2 + tb) * 2048); pp.ra[rb][1] = *(const u32x4*)(sl + 16384 + (rb * 2 + tb) * 2048 + 16);
                                     pp.xb[rb][0] = *(const u32x4*)(sl + (icb * 2 + rb) * 2048); pp.xb[rb][1] = *(const u32x4*)(sl + (icb * 2 + rb) * 2048 + 16); }
    pp.yc[0] = *(const u32x4*)(sl + 24576 + (tb * 2 + icb) * 2048); pp.yc[1] = *(const u32x4*)(sl + 24576 + (tb * 2 + icb) * 2048 + 16);
}
__device__ __forceinline__ void post_item(const Frame& F, const Args& a, int q, int h, int blk, PostPre& pp, bool has_next, int nq, int nh, int nblk) {
    LAS unsigned char* L = F.lds;
    int lane_ = F.lane; asm volatile("" : "+v"(lane_));
    const int lane = lane_, w = F.wave, tid = w * 64 + lane, r32 = lane & 31, hi = lane >> 5, j = lane, tg = w;
    const int row0 = seq_row0(q), t_lo = blk * 64 + 8 * tg;
    bf16_t* Zs = (bf16_t*)(a.ws + WS_Z) + (size_t)row0 * ZP;
    const float* mup = inp(L, 11); const float* mun = inp(L, 12);
    const int chp = h * 64 + j;
    const float mp0 = mup[ZGD - ZRR + j], mn0 = mun[ZGD - ZRR + j], mp1 = mup[ZGD - ZRR + 64 + j], mn1 = mun[ZGD - ZRR + 64 + j];
    const float mpv = mup[1024 + chp], mnv = mun[1024 + chp], lg = inp(L, 21)[chp], lb = inp(L, 22)[chp];
    float bsum[8];
    { const float* bon0 = (const float*)(a.ws + WS_BONUS) + (size_t)row0 * 8 + h; const float* bon1 = bon0 + (size_t)MTOK * 8;
#pragma unroll
      for (int u = 0; u < 8; ++u) bsum[u] = bon0[(size_t)(t_lo + u) * 8] + bon1[(size_t)(t_lo + u) * 8]; }
    bf16x8 gfr[8];
    { const bf16_t* GT = (const bf16_t*)(a.ws + WS_LORA) + 4 * 512 * 64 + ((size_t)h * 64 + 32 * ((w >> 1) & 1) + r32) * 128;
#pragma unroll
      for (int ks = 0; ks < 8; ++ks) gfr[ks] = *(const bf16x8*)(GT + 16 * ks + 8 * hi); }
#pragma unroll
    for (int k = 0; k < 4; ++k) { const int c = tid + k * NTHR; int reg, row, part; post_decode(c, reg, row, part);
        const int off = reg == 0 ? PO_V + row * 144 : PO_G + row * 272;
        if (c < 1584) *(LAS u32x4*)(L + off + part * 16) = pp.stg[k]; }
    {
        const int dd = w >> 2, tb = (w >> 1) & 1, icb = w & 1;
        f32x16 Y;
#pragma unroll
        for (int q_ = 0; q_ < 4; ++q_) { Y[2 * q_] = bflo(pp.yc[0][q_]); Y[2 * q_ + 1] = bfhi(pp.yc[0][q_]); Y[8 + 2 * q_] = bflo(pp.yc[1][q_]); Y[9 + 2 * q_] = bfhi(pp.yc[1][q_]); }
#pragma unroll
        for (int rb = 0; rb < 2; ++rb)
#pragma unroll
            for (int s2 = 0; s2 < 2; ++s2) Y = __builtin_amdgcn_mfma_f32_32x32x16_bf16(__builtin_bit_cast(bf16x8, pp.ra[rb][s2]), __builtin_bit_cast(bf16x8, pp.xb[rb][s2]), Y, 0, 0, 0);
#pragma unroll
        for (int r = 0; r < 16; ++r) { const int tau = 32 * tb + (r & 3) + 8 * (r >> 2) + 4 * hi; const int t = dd == 0 ? tau : 63 - tau;
            *(LAS float*)(L + PO_Y + (dd * 64 + t) * 272 + (32 * icb + r32) * 4) = Y[r]; }
    }
    LBAR();
    if (has_next) post_stage_load(a, tid, nq, nh, nblk, pp);
    {
        float z0[10], z1[10];
#pragma unroll
        for (int i = 0; i < 10; ++i) { z0[i] = bf2f(*(const LAS bf16_t*)(L + PO_G + (8 * tg + i) * 272 + j * 2)); z1[i] = bf2f(*(const LAS bf16_t*)(L + PO_G + (8 * tg + i) * 272 + (64 + j) * 2)); }
#pragma unroll
        for (int u = 0; u < 8; ++u) { *(LAS bf16_t*)(L + PO_SG + (8 * tg + u) * 272 + j * 2) = f2bf(sigmoidf_(tshift(z0, u, mp0, mn0)));
                                      *(LAS bf16_t*)(L + PO_SG + (8 * tg + u) * 272 + (64 + j) * 2) = f2bf(sigmoidf_(tshift(z1, u, mp1, mn1))); }
    }
    LBAR();
    if (w < 4) {
        const int mt = w >> 1, nt = w & 1;
        f32x16 acc = f32x16{};
#pragma unroll
        for (int ks = 0; ks < 8; ++ks) { const bf16x8 bv = *(const LAS bf16x8*)(L + PO_SG + (32 * nt + r32) * 272 + (16 * ks + 8 * hi) * 2);
            acc = __builtin_amdgcn_mfma_f32_32x32x16_bf16(gfr[ks], bv, acc, 0, 0, 0); }
#pragma unroll
        for (int g = 0; g < 4; ++g) *(LAS f32x4*)(L + PO_GF + (32 * nt + r32) * 272 + (32 * mt + 8 * g + 4 * hi) * 4) = (f32x4){acc[4 * g], acc[4 * g + 1], acc[4 * g + 2], acc[4 * g + 3]};
    }
    LBAR();
    {
        const int ch = h * 64 + j;
        float zv[10];
#pragma unroll
        for (int i = 0; i < 10; ++i) zv[i] = bf2f(*(const LAS bf16_t*)(L + PO_V + (8 * tg + i) * 144 + j * 2));
#pragma unroll
        for (int u = 0; u < 8; ++u) { const int t = t_lo + u;
            const float y = *(const LAS float*)(L + PO_Y + (8 * tg + u) * 272 + j * 4) + *(const LAS float*)(L + PO_Y + (64 + 8 * tg + u) * 272 + j * 4);
            const float mean = wave_sum_dpp(y) * (1.f / 64.f); const float dv = y - mean; const float var = wave_sum_dpp(dv * dv) * (1.f / 64.f);
            const float yn = dv * __builtin_amdgcn_rsqf(var + LNX_EPS) * lg + lb;
            const float g = *(const LAS float*)(L + PO_GF + (8 * tg + u) * 272 + j * 4);
            Zs[(size_t)t * ZP + ZRR + ch] = f2bf((yn + bsum[u] * tshift(zv, u, mpv, mnv)) * g); }
    }
    LBAR();
}
}


#define XB_TMO      128
#define XB_XCNT(j)  (256  + 64 * (j))
#define XB_XSUB(j)  (1280 + 64 * (j))
#define XB_XGEN(j)  (2304 + 64 * (j))
#define XB_TOP      3328
#define XB_TOPGEN   3392
#define XCD_BAR_WORDS 3456
#define XB_SPIN_CAP (1u << 20)
constexpr size_t CTL_ZERO_BYTES = 16384;
__device__ __forceinline__ unsigned xb_ld(unsigned* p)              { return __hip_atomic_load(p, __ATOMIC_RELAXED, __HIP_MEMORY_SCOPE_AGENT); }
__device__ __forceinline__ unsigned xb_add(unsigned* p, unsigned v) { return __hip_atomic_fetch_add(p, v, __ATOMIC_RELAXED, __HIP_MEMORY_SCOPE_AGENT); }
__device__ __forceinline__ unsigned xb_xcc_id() { return (unsigned)__builtin_amdgcn_s_getreg((3 << 11) | 20) & 0xFu; }
#define XB_SPIN(cond, bar) do { unsigned _sp = 0; while (cond) { __builtin_amdgcn_s_sleep(1); \
    if ((++_sp & 255u) == 0u) { if (xb_ld(&(bar)[XB_TMO])) break; if (_sp > XB_SPIN_CAP) { atomicAdd(&(bar)[XB_TMO], 1u); break; } } } } while (0)
struct XcdBarrier { unsigned* bar; unsigned x; volatile LAS unsigned* st; };
__device__ __forceinline__ XcdBarrier xcd_barrier_post(unsigned* bar, volatile LAS unsigned* st) {
    XcdBarrier b; b.bar = bar; b.x = xb_xcc_id(); b.st = st;
    if (threadIdx.x == 0) (void)xb_add(&bar[XB_XCNT(b.x)], 1u);
    return b;
}
__device__ __forceinline__ void xcd_barrier_complete(unsigned* bar, unsigned x, unsigned& nloc, unsigned& nx) {
    const unsigned G = gridDim.x * gridDim.y * gridDim.z;
    unsigned sum, cnt, mine, sp = 0u;
    for (;;) {
        sum = 0u; cnt = 0u; mine = 0u;
#pragma unroll
        for (unsigned j = 0; j < 16; ++j) { const unsigned c = xb_ld(&bar[XB_XCNT(j)]); sum += c; cnt += (c > 0u) ? 1u : 0u; mine = (j == x) ? c : mine; }
        if (sum == G) break;
        __builtin_amdgcn_s_sleep(1);
        if ((++sp & 255u) == 0u) { if (xb_ld(&bar[XB_TMO])) break; if (sp > XB_SPIN_CAP) { atomicAdd(&bar[XB_TMO], 1u); break; } }
    }
    nloc = mine > 0u ? mine : 1u; nx = cnt > 0u ? cnt : 1u;
}
__device__ __forceinline__ void xcd_barrier(const XcdBarrier& b) {
    asm volatile("s_waitcnt vmcnt(0)" ::: "memory");
    __syncthreads();
    if (threadIdx.x == 0) {
        unsigned* bar = b.bar;
        __builtin_amdgcn_s_waitcnt(0);
        unsigned nloc = b.st[0], nx = b.st[1];
        if (nloc == 0u) { xcd_barrier_complete(bar, b.x, nloc, nx); b.st[0] = nloc; b.st[1] = nx; }
        const unsigned old = xb_add(&bar[XB_XSUB(b.x)], 1u);
        const unsigned gen = old / nloc;
        if (old + 1u == (gen + 1u) * nloc) {
            __builtin_amdgcn_fence(__ATOMIC_RELEASE, "agent");
            asm volatile("s_waitcnt vmcnt(0)" ::: "memory");
            const unsigned og = xb_add(&bar[XB_TOP], 1u);
            const unsigned tg = og / nx;
            if (og + 1u == (tg + 1u) * nx) xb_add(&bar[XB_TOPGEN], 1u);
            else XB_SPIN(xb_ld(&bar[XB_TOPGEN]) == tg, bar);
            __builtin_amdgcn_fence(__ATOMIC_ACQUIRE, "agent");
            xb_add(&bar[XB_XGEN(b.x)], 1u);
            asm volatile("s_waitcnt vmcnt(0)" ::: "memory");
        } else {
            XB_SPIN(xb_ld(&bar[XB_XGEN(b.x)]) == gen, bar);
            __builtin_amdgcn_fence(__ATOMIC_ACQUIRE, "agent");
            asm volatile("s_waitcnt vmcnt(0)" ::: "memory");
        }
    }
    __syncthreads();
}

constexpr int NPHASE = 10;
constexpr int NOJUMP = 1 << 30;
template <int LO, int HI>
__global__ void __launch_bounds__(NTHR, 2) fwd_kernel(Args a) {
    extern __shared__ __attribute__((aligned(16))) unsigned char lds_raw[];
    Frame F; F.lds = (LAS unsigned char*)lds_raw; F.tid = threadIdx.x; F.lane = F.tid & 63; F.wave = __builtin_amdgcn_readfirstlane(F.tid >> 6);
    F.G = gridDim.x; { const int bx = blockIdx.x; F.vcu = (F.G % 8 == 0) ? (bx % 8) * (F.G / 8) + bx / 8 : bx; }
    unsigned char* ws = a.ws; bf16_t* Z = (bf16_t*)(ws + WS_Z);
    unsigned char* slots = (unsigned char*)a.out;
    if (F.tid == 0) {
#pragma unroll
        for (int i = 0; i < 27; ++i) *(const float* LAS*)(F.lds + PTRS_OFF + i * 8) = a.in[i];
        *(volatile LAS unsigned*)(F.lds + PTRS_OFF + 224) = 0u; *(volatile LAS unsigned*)(F.lds + PTRS_OFF + 228) = 0u;
        *(LAS unsigned long long*)(F.lds + PTRS_OFF - 64) = 0ull;
    }
    __syncthreads();
#if ONE_LAUNCH && !USE_CG
    const XcdBarrier bar = xcd_barrier_post((unsigned*)(ws + WS_CTL), (volatile LAS unsigned*)(F.lds + PTRS_OFF + 224));
#endif
#if ONE_LAUNCH
#if PROBE_SEG >= 0 || PROBE_CLK >= 0
    unsigned long long* tsb = (unsigned long long*)(ws + WS_CTL + 15872); int nts = 0;
#define STAMP() do { if (blockIdx.x == 0 && F.tid == 0) { tsb[nts] = __builtin_amdgcn_s_memrealtime(); tsb[32 + nts] = __builtin_amdgcn_s_memtime(); } ++nts; } while (0)
    STAMP();
#else
#define STAMP() do { } while (0)
#endif
#if USE_CG
#define SEAM(k) do { if constexpr ((k) + 1 < HI) { cg::this_grid().sync(); STAMP(); } } while (0)
#define RSYNC() do { cg::this_grid().sync(); STAMP(); } while (0)
#else
#define SEAM(k) do { if constexpr ((k) + 1 < HI) { xcd_barrier(bar); STAMP(); } } while (0)
#define RSYNC() do { xcd_barrier(bar); STAMP(); } while (0)
#endif
#else
#define SEAM(k) do { } while (0)
#define RSYNC() do { } while (0)
#endif
#define IN(k) (LO <= (k) && (k) < HI)
    if constexpr (IN(0)) { p0_prologue(F, a); SEAM(0);
#if PROBE_DOUBLE == 4
        p0_prologue(F, a); RSYNC();
#endif
    }
    if constexpr (IN(1)) { pg8::Gemm g{(const char*)a.out, (const bf16_t*)(ws + WS_WIN), MTOK, ZP, DM, DM * 2, NOJUMP, 0}; pg8::StaticOrder S; S.init(MTOK, ZP, F.G, (int)blockIdx.x);
        pg8::EpiZ E{Z, ZP}; pg8::gemm_phase<pg8::EpiZ, pg8::StaticOrder, true>(F.lds, g, S, E); SEAM(1);
#if PROBE_DOUBLE == 3
        pg8::gemm_phase<pg8::EpiZ, pg8::StaticOrder, true>(F.lds, g, S, E); RSYNC();
#endif
    }
    if constexpr (IN(2)) { qk_prep(F, a);
        unsigned* rdy = (unsigned*)(ws + WS_CTL) + 3584;
#pragma unroll 1
        for (int rnd = 0; rnd < 2; ++rnd) {
            const int nprod = rnd == 1 ? F.G - 16 : F.G;
            if (F.vcu < nprod) {
#define S1_DECODE(i_, d_, q_, h_, ck_, it_, pub_) do { if (rnd == 1) { const int c_ = ((i_) >> 4) & 15, cc_ = (((i_) >> 8) << 4) + ((i_) & 15); d_ = c_ >> 3; h_ = c_ & 7; q_ = 0; ck_ = d_ ? 255 - cc_ : cc_; it_ = c_ * 256 + ck_; pub_ = rdy + c_ * 16 + ((i_) >> 8); } \
                    else { ck_ = (i_) & 31; h_ = ((i_) >> 5) & 7; q_ = 1 + (((i_) >> 8) & 7); d_ = (i_) >> 11; it_ = (i_); pub_ = nullptr; } } while (0)
                u32x4 stg[6]; f32x2_t par;
                { int d, q, h, ck, it; unsigned* pub; S1_DECODE(F.vcu, d, q, h, ck, it, pub); (void)it; (void)pub; rw::s1_stage_load(a, F.tid, q, h, ck, stg); par = rw::s1_param_load(F.lds, F.tid, d, h); }
                unsigned* pub_prev = nullptr;
#pragma unroll 1
                for (int i = F.vcu; i < 4096; i += nprod) {
                    int d, q, h, ck, it, nd, nq, nh, nck, nit; unsigned* pub; unsigned* npub; S1_DECODE(i, d, q, h, ck, it, pub); const int ni = i + nprod; S1_DECODE(ni, nd, nq, nh, nck, nit, npub); (void)nit; (void)npub;
                    rw::s1_item(F, a, d, q, h, ck, slots + (size_t)it * SLOT_BYTES, stg, par, ni < 4096, nd, nq, nh, nck, rnd == 1, pub_prev); pub_prev = pub; }
                if (pub_prev) { asm volatile("s_waitcnt vmcnt(0)" ::: "memory"); __syncthreads(); if (F.tid == 0) __hip_atomic_fetch_add(pub_prev, 1u, __ATOMIC_RELAXED, __HIP_MEMORY_SCOPE_AGENT); }
#undef S1_DECODE
            } else {
                const int c = F.vcu - nprod;
                rw::s23_chain_wg(F, a, c >> 3, 0, c & 7, slots + (size_t)c * 256 * SLOT_BYTES, rdy + c * 16);
            }
            if (rnd == 0) {
                RSYNC();
                for (int chain = F.vcu; chain < 128; chain += F.G) { const int h = chain & 7, q = 1 + ((chain >> 3) & 7), d = chain >> 6;
                    rw::s23_chain_wg(F, a, d, q, h, slots + (size_t)chain * 32 * SLOT_BYTES, nullptr); }
            }
            RSYNC();
            {
#define PO_DECODE(it_, q_, h_, b_) do { if (rnd == 1) { q_ = 0; h_ = ((it_) >> 8) & 7; b_ = (it_) & 255; } else { q_ = 1 + (((it_) >> 8) & 7); h_ = ((it_) >> 5) & 7; b_ = (it_) & 31; } } while (0)
                rw::PostPre pp;
                { int q, h, b; PO_DECODE(F.vcu, q, h, b); rw::post_stage_load(a, F.tid, q, h, b, pp); }
#pragma unroll 1
                for (int it = F.vcu; it < 2048; it += F.G) { int q, h, b, nq, nh, nb; PO_DECODE(it, q, h, b); const int nit = it + F.G; PO_DECODE(nit, nq, nh, nb);
                    rw::post_item(F, a, q, h, b, pp, nit < 2048, nq, nh, nb); }
#undef PO_DECODE
            }
            if (rnd == 0) RSYNC();
        }
        SEAM(2); }
    if constexpr (IN(4)) {
        float lam; { const float p1 = wave_sum(a.in[6][F.lane] * a.in[7][F.lane]), p2 = wave_sum(a.in[8][F.lane] * a.in[9][F.lane]); lam = __expf(p1) - __expf(p2) + LAMBDA_INIT; }
#if PROBE_DOUBLE == 1
        for (int v = F.vcu; v < 256; v += F.G) {
            att::attn_unit(0, SP, v >> 6, v & 63, Z, F.lds, lam, a.in[10], (bf16_t*)a.out, 512);
            att::attn_unit(SP + (v >> 5) * SS, SS, (v >> 3) & 3, v & 7, Z, F.lds, lam, a.in[10], (bf16_t*)a.out, 512); }
        RSYNC();
#endif
        for (int v = F.vcu; v < 256; v += F.G) {
            att::attn_unit(0, SP, v >> 6, v & 63, Z, F.lds, lam, a.in[10], Z, ZP);
            att::attn_unit(SP + (v >> 5) * SS, SS, (v >> 3) & 3, v & 7, Z, F.lds, lam, a.in[10], Z, ZP); }
        SEAM(4); }
    if constexpr (IN(5)) { pg8::Gemm g{(const char*)Z, (const bf16_t*)(ws + WS_WOUT), MTOK, DM, DM, ZP * 2, 8, 2048}; pg8::StaticOrder S; S.init(MTOK, DM, F.G, (int)blockIdx.x);
        pg8::EpiOut E{a.in[0], a.in[1], a.out, Z, (float*)(ws + WS_ROWSQ)}; pg8::gemm_phase<pg8::EpiOut, pg8::StaticOrder, true>(F.lds, g, S, E); SEAM(5); }
#define FFN_UP(k, half) if constexpr (IN(k)) { pg8::Gemm g{(const char*)(Z + (size_t)(half) * 16384 * ZP + ZXN2), (const bf16_t*)(ws + WS_W1), 16384, DFF, DM, ZP * 2, NOJUMP, 0}; pg8::StaticOrder S; S.init(16384, DFF, F.G, (int)blockIdx.x); \
        pg8::EpiUp E{(char*)(ws + WS_Z), (const float*)(ws + WS_ROWSQ), (half) * 16384}; pg8::gemm_phase<pg8::EpiUp, pg8::StaticOrder, true>(F.lds, g, S, E); SEAM(k); }
#define FFN_DN(k, half) if constexpr (IN(k)) { pg8::Gemm g{(const char*)(ws + WS_Z), (const bf16_t*)(ws + WS_W2), 16384, DM, DFF, 13312, 32, 2560}; pg8::StaticOrder S; S.init(16384, DM, F.G, (int)blockIdx.x); \
        pg8::EpiDown E{a.out, (half) * 16384}; pg8::gemm_phase<pg8::EpiDown, pg8::StaticOrder, true>(F.lds, g, S, E); SEAM(k); }
    FFN_UP(6, 0) FFN_DN(7, 0) FFN_UP(8, 1) FFN_DN(9, 1)
#if PROBE_S1 >= 0 || PROBE_ATT
    if (F.tid == 0) { const unsigned long long dt = *(LAS unsigned long long*)(F.lds + PTRS_OFF - 64), t0_ = __builtin_amdgcn_s_memrealtime();
        while (__builtin_amdgcn_s_memrealtime() - t0_ < dt) __builtin_amdgcn_s_sleep(16); }
#endif
#if PROBE_SEG >= 0 || PROBE_CLK >= 0
    STAMP();
#if PROBE_CLK >= 0
    if (blockIdx.x == 0 && F.tid == 0) { asm volatile("s_waitcnt vmcnt(0)" ::: "memory"); const unsigned long long wt_ = tsb[PROBE_CLK + 1] - tsb[PROBE_CLK], cy_ = tsb[32 + PROBE_CLK + 1] - tsb[32 + PROBE_CLK];
        const unsigned long long dt = cy_ * 1000ull / (wt_ ? wt_ : 1ull), t0_ = __builtin_amdgcn_s_memrealtime();
        while (__builtin_amdgcn_s_memrealtime() - t0_ < dt) __builtin_amdgcn_s_sleep(16); }
#endif
    if (PROBE_CLK < 0 && blockIdx.x == 0 && F.tid == 0) { asm volatile("s_waitcnt vmcnt(0)" ::: "memory"); const unsigned long long dt = tsb[PROBE_SEG + 1] - tsb[PROBE_SEG], t0_ = __builtin_amdgcn_s_memrealtime();
        while (__builtin_amdgcn_s_memrealtime() - t0_ < dt) __builtin_amdgcn_s_sleep(16); }
#endif
#undef FFN_UP
#undef FFN_DN
#undef IN
#undef SEAM
#undef RSYNC
}

extern "C" void kernel_launch(void* const* d_in, const int* in_sizes, int n_in, void* d_out, int out_size, void* d_ws, size_t ws_size, hipStream_t stream) {
    static int grid = 0;
    if (grid == 0) {
        if (n_in != 27 || out_size != MTOK * DM || ws_size < WS_END) { fprintf(stderr, "kernel_launch: unexpected shapes (n_in %d out %d ws %zu)\n", n_in, out_size, ws_size); grid = -1; return; }
        int dev = 0, cus = 0; (void)hipGetDevice(&dev); (void)hipDeviceGetAttribute(&cus, hipDeviceAttributeMultiprocessorCount, dev);
        bool ok = true;
#if ONE_LAUNCH
        ok = ok && hipFuncSetAttribute((const void*)fwd_kernel<0, NPHASE>, hipFuncAttributeMaxDynamicSharedMemorySize, LDS_BYTES) == hipSuccess;
        int per_cu = 0; (void)hipOccupancyMaxActiveBlocksPerMultiprocessor(&per_cu, (const void*)fwd_kernel<0, NPHASE>, NTHR, LDS_BYTES); (void)hipGetLastError();
        if (per_cu < 1) fprintf(stderr, "kernel_launch: occupancy query says %d blocks/CU\n", per_cu);
#else
#define SETA(p) ok = ok && hipFuncSetAttribute((const void*)fwd_kernel<p, p + 1>, hipFuncAttributeMaxDynamicSharedMemorySize, LDS_BYTES) == hipSuccess;
        SETA(0) SETA(1) SETA(2) SETA(3) SETA(4) SETA(5) SETA(6) SETA(7) SETA(8) SETA(9)
#undef SETA
#endif
        if (!ok) { fprintf(stderr, "kernel_launch: hipFuncSetAttribute failed\n"); grid = -1; return; }
        grid = cus > 256 ? 256 : cus;
    }
    if (grid < 0) return;
    Args a{};
    for (int i = 0; i < 27; ++i) a.in[i] = (const float*)d_in[i];
    a.out = (float*)d_out; a.ws = (unsigned char*)d_ws;
#if ONE_LAUNCH
    a.ph_lo = 0; a.ph_hi = NPHASE;
#if !USE_CG
    if (hipMemsetAsync((char*)d_ws + WS_CTL, 0, CTL_ZERO_BYTES, stream) != hipSuccess) { fprintf(stderr, "kernel_launch: hipMemsetAsync failed\n"); return; }
#endif
    void* args[] = {&a};
    hipError_t e = hipLaunchCooperativeKernel((const void*)fwd_kernel<0, NPHASE>, dim3(grid), dim3(NTHR), args, LDS_BYTES, stream);
    if (e != hipSuccess) fprintf(stderr, "cooperative launch failed: %s (grid %d)\n", hipGetErrorString(e), grid);
#else
#define LAUNCH(p) hipLaunchKernelGGL((fwd_kernel<p, p + 1>), dim3(grid), dim3(NTHR), LDS_BYTES, stream, a);
    LAUNCH(0) LAUNCH(1) LAUNCH(2) LAUNCH(3) LAUNCH(4) LAUNCH(5) LAUNCH(6) LAUNCH(7) LAUNCH(8) LAUNCH(9)
#undef LAUNCH
#endif
}
```

```cpp
#include <hip/hip_runtime.h>
#include <hip/hip_cooperative_groups.h>
#include <cstdio>
#include <cstdint>
namespace cg = cooperative_groups;

#ifndef ONE_LAUNCH
#define ONE_LAUNCH 1
#endif
#ifndef USE_CG
#define USE_CG 0
#endif
#ifndef PROBE_SEG
#define PROBE_SEG -1
#endif
#ifndef PROBE_S1
#define PROBE_S1 -1
#endif
#ifndef PROBE_ATT
#define PROBE_ATT 0
#endif
#ifndef PROBE_CLK
#define PROBE_CLK -1
#endif
#ifndef PROBE_DOUBLE
#define PROBE_DOUBLE 0
#endif

#define LAS __attribute__((address_space(3)))
#define GAS __attribute__((address_space(1)))
typedef unsigned short bf16_t;
typedef short bf16x8 __attribute__((ext_vector_type(8)));
typedef short s16x4 __attribute__((ext_vector_type(4)));
typedef float f32x4 __attribute__((ext_vector_type(4)));
typedef float f32x16 __attribute__((ext_vector_type(16)));
typedef unsigned u32x4 __attribute__((ext_vector_type(4)));
typedef unsigned u32x2 __attribute__((ext_vector_type(2)));
typedef float f32x2_t __attribute__((ext_vector_type(2)));
typedef __bf16 bf16x2_t __attribute__((ext_vector_type(2)));

constexpr int MTOK = 32768, DM = 1024, ZP = 3328, DFF = 4096;
constexpr int SP = 16384, SS = 2048;
constexpr int ZQ = 0, ZK = 512, ZV = 1024, ZRR = 1536, ZRK = 2048, ZRV = 2560, ZWD = 3072, ZAD = 3136, ZGD = 3200;
constexpr int ZXN2 = 2048;
constexpr float NORM_EPS = 1e-6f, LNX_EPS = 64e-5f;
constexpr float QSCALE = 0.125f * 1.4426950408889634f;
constexpr float LAMBDA_INIT = 0.2f;
constexpr int NCHUNK_P = SP / 64, NCHUNK_S = SS / 64;

constexpr size_t MiB = 1u << 20;
constexpr size_t WS_CTL = 0;
constexpr size_t WS_WIN = 1 * MiB, WS_WOUT = 8 * MiB, WS_W1 = 10 * MiB, WS_W2 = 18 * MiB;
constexpr size_t WS_ROPE = 26 * MiB;
constexpr size_t WS_LORA = 30 * MiB;
constexpr size_t WS_ROWSQ = 31 * MiB;
constexpr size_t WS_BONUS = 33 * MiB;
constexpr size_t WS_Z = 36 * MiB;
constexpr size_t WS_END = 244 * MiB;
constexpr size_t WS_E1 = 244 * MiB;
constexpr size_t WS_TOTAL = 252 * MiB;
static_assert(WS_Z + (size_t)MTOK * ZP * 2 <= WS_END, "ws map");
constexpr size_t SLOT_BYTES = 32768;

__device__ __forceinline__ unsigned cvt_pk_bf16(float lo, float hi) { f32x2_t v = {lo, hi}; bf16x2_t b = __builtin_convertvector(v, bf16x2_t); return __builtin_bit_cast(unsigned, b); }
__device__ __forceinline__ float bf2f(unsigned short u) { return __uint_as_float(((unsigned)u) << 16); }
__device__ __forceinline__ float bflo(unsigned u) { return __uint_as_float(u << 16); }
__device__ __forceinline__ float bfhi(unsigned u) { return __uint_as_float(u & 0xffff0000u); }
__device__ __forceinline__ unsigned short f2bf(float f) { return (unsigned short)(cvt_pk_bf16(f, 0.f) & 0xffffu); }
__device__ __forceinline__ float wave_sum(float v) {
#pragma unroll
    for (int o = 1; o < 64; o <<= 1) v += __shfl_xor(v, o);
    return v;
}
__device__ __forceinline__ float wave_sum_dpp(float v) {
    int x = __float_as_int(v);
    v += __int_as_float(__builtin_amdgcn_update_dpp(0, x, 0xB1, 0xF, 0xF, true)); x = __float_as_int(v);
    v += __int_as_float(__builtin_amdgcn_update_dpp(0, x, 0x4E, 0xF, 0xF, true)); x = __float_as_int(v);
    v += __int_as_float(__builtin_amdgcn_update_dpp(0, x, 0x124, 0xF, 0xF, true)); x = __float_as_int(v);
    v += __int_as_float(__builtin_amdgcn_update_dpp(0, x, 0x128, 0xF, 0xF, true)); x = __float_as_int(v);
    const float a = __int_as_float(__builtin_amdgcn_readlane(x, 0)), b = __int_as_float(__builtin_amdgcn_readlane(x, 16)), c = __int_as_float(__builtin_amdgcn_readlane(x, 32)), d = __int_as_float(__builtin_amdgcn_readlane(x, 48));
    return (a + b) + (c + d);
}
#define LDS_WAIT() asm volatile("s_waitcnt lgkmcnt(0)" ::: "memory")
#define VM_WAIT() asm volatile("s_waitcnt vmcnt(0)" ::: "memory")
#define LBAR() asm volatile("s_waitcnt lgkmcnt(0)\n\ts_barrier" ::: "memory")

namespace pg8 {
constexpr int BM = 256, BK = 64, HALF = 128, HTB = HALF * BK * 2, STAGE_BYTES = 8 * HTB, NXCD = 8, WGM = 8;
__host__ __device__ __forceinline__ int lds_byte(int r, int c) { const int st = (r >> 4) * 2 + (c >> 5), rr = r & 15, cc = c & 31, ob = rr * 64 + cc * 2; return st * 1024 + (ob ^ (((ob >> 9) & 1) << 5)); }
__host__ __device__ __forceinline__ void stage_rc(int b, int& R, int& C) { const int st = b / 1024, sb = b % 1024, swz = sb ^ (((sb >> 9) & 1) << 5); R = (st >> 1) * 16 + swz / 64; C = (st & 1) * 32 + (swz % 64) / 2; }
__host__ __device__ __forceinline__ int perm32(int rho) { const int n = rho >> 4, i = rho & 15; return 8 * (i >> 2) + 4 * n + (i & 3); }
struct Unit { int pm, pn; };
struct Gemm { const char* A; const bf16_t* Bt; int M, N, K; int lda; int jkt; int jbytes; };
struct StaticOrder {
    int nM, nN, nwg, G, c;
    __host__ __device__ void init(int M, int N, int G_, int c_) { nM = M / BM; nN = N / BM; nwg = nM * nN; G = G_; c = c_; }
    __host__ __device__ bool next(int i, Unit& u) const {
        const long L = (long)i * G + c; if (L >= nwg) return false;
        int wgid = (int)L; { const int q = nwg / NXCD, r = nwg % NXCD, xcd = wgid % NXCD, off = wgid / NXCD; wgid = (xcd < r ? xcd * (q + 1) : r * (q + 1) + (xcd - r) * q) + off; }
        const int nig = WGM * nN, gid = wgid / nig, fm = gid * WGM, gsz = (nM - fm) < WGM ? (nM - fm) : WGM;
        u.pm = fm + ((wgid % nig) % gsz); u.pn = (wgid % nig) / gsz; return true;
    }
};

struct EpiZ {
    static constexpr bool PERM = true;
    bf16_t* O; int ldc;
    __device__ __forceinline__ void operator()(const f32x4 (&acc)[2][2][4][2], const Unit& u, int wr, int wc, int fr, int fq) const {
        const int row0 = u.pm * BM + wr * 64 + fr, col0 = u.pn * BM + wc * 32 + 8 * fq;
#pragma unroll
        for (int ai = 0; ai < 2; ++ai)
#pragma unroll
            for (int m = 0; m < 4; ++m) { bf16_t* rowp = O + (size_t)(row0 + ai * HALF + m * 16) * ldc + col0;
#pragma unroll
                for (int bj = 0; bj < 2; ++bj) { const f32x4 v0 = acc[ai][bj][m][0], v1 = acc[ai][bj][m][1];
                    u32x4 w; w.x = cvt_pk_bf16(v0[0], v0[1]); w.y = cvt_pk_bf16(v0[2], v0[3]); w.z = cvt_pk_bf16(v1[0], v1[1]); w.w = cvt_pk_bf16(v1[2], v1[3]);
                    *(u32x4*)(rowp + bj * HALF) = w; } }
    }
};
struct EpiOut {
    static constexpr bool PERM = true;
    const float* xp; const float* xs; float* out; bf16_t* Z; float* rowsq;
    __device__ __forceinline__ void operator()(const f32x4 (&acc)[2][2][4][2], const Unit& u, int wr, int wc, int fr, int fq) const {
        const int col0 = u.pn * BM + wc * 32 + 8 * fq;
#pragma unroll
        for (int ai = 0; ai < 2; ++ai)
#pragma unroll
            for (int m = 0; m < 4; ++m) { const int r = u.pm * BM + ai * HALF + wr * 64 + m * 16 + fr;
                const float* xr = (r < SP ? xp + (size_t)r * DM : xs + (size_t)(r - SP) * DM) + col0; float* orow = out + (size_t)r * DM + col0; bf16_t* zr = Z + (size_t)r * ZP + ZXN2 + col0;
                float ss = 0.f;
#pragma unroll
                for (int bj = 0; bj < 2; ++bj) { const f32x4 x0 = *(const f32x4*)(xr + bj * HALF), x1 = *(const f32x4*)(xr + bj * HALF + 4);
                    const f32x4 o0 = x0 + acc[ai][bj][m][0], o1 = x1 + acc[ai][bj][m][1];
                    *(f32x4*)(orow + bj * HALF) = o0; *(f32x4*)(orow + bj * HALF + 4) = o1;
                    ss += ((o0[0] * o0[0] + o0[1] * o0[1]) + (o0[2] * o0[2] + o0[3] * o0[3])) + ((o1[0] * o1[0] + o1[1] * o1[1]) + (o1[2] * o1[2] + o1[3] * o1[3]));
                    u32x4 w; w.x = cvt_pk_bf16(o0[0], o0[1]); w.y = cvt_pk_bf16(o0[2], o0[3]); w.z = cvt_pk_bf16(o1[0], o1[1]); w.w = cvt_pk_bf16(o1[2], o1[3]); *(u32x4*)(zr + bj * HALF) = w; }
                ss += __shfl_xor(ss, 16); ss += __shfl_xor(ss, 32);
                if (fq == 0) rowsq[(size_t)r * 16 + u.pn * 4 + wc] = ss;
                if (m & 1) asm volatile("" ::: "memory"); }
    }
};
struct EpiUp {
    static constexpr bool PERM = true;
    char* H; const float* rowsq; int row_off;
    __device__ __forceinline__ void operator()(const f32x4 (&acc)[2][2][4][2], const Unit& u, int wr, int wc, int fr, int fq) const {
        const int row0 = u.pm * BM + wr * 64 + fr, col0 = u.pn * BM + wc * 32 + 8 * fq;
#pragma unroll
        for (int ai = 0; ai < 2; ++ai)
#pragma unroll
            for (int m = 0; m < 4; ++m) { const int r = row0 + ai * HALF + m * 16; const f32x4* rq = (const f32x4*)(rowsq + (size_t)(row_off + r) * 16);
                const f32x4 q0 = rq[0], q1 = rq[1], q2 = rq[2], q3 = rq[3];
                const float ssum = ((q0[0] + q0[1]) + (q0[2] + q0[3])) + ((q1[0] + q1[1]) + (q1[2] + q1[3])) + ((q2[0] + q2[1]) + (q2[2] + q2[3])) + ((q3[0] + q3[1]) + (q3[2] + q3[3]));
                const float rstd = __builtin_amdgcn_rsqf(ssum * (1.0f / DM) + NORM_EPS);
                char* rowp = H + (size_t)r * 13312;
#pragma unroll
                for (int bj = 0; bj < 2; ++bj) { const int c = col0 + bj * HALF; f32x4 v0 = acc[ai][bj][m][0] * rstd, v1 = acc[ai][bj][m][1] * rstd;
#pragma unroll
                    for (int e = 0; e < 4; ++e) { const float a = fmaxf(v0[e], 0.f), b = fmaxf(v1[e], 0.f); v0[e] = a * a; v1[e] = b * b; }
                    u32x4 w; w.x = cvt_pk_bf16(v0[0], v0[1]); w.y = cvt_pk_bf16(v0[2], v0[3]); w.z = cvt_pk_bf16(v1[0], v1[1]); w.w = cvt_pk_bf16(v1[2], v1[3]);
                    *(u32x4*)(rowp + (size_t)c * 2 + (c >= 2048 ? 2560 : 0)) = w; } }
    }
};
struct EpiDown {
    static constexpr bool PERM = true;
    float* out; int row_off;
    __device__ __forceinline__ void operator()(const f32x4 (&acc)[2][2][4][2], const Unit& u, int wr, int wc, int fr, int fq) const {
        const int col0 = u.pn * BM + wc * 32 + 8 * fq;
#pragma unroll
        for (int ai = 0; ai < 2; ++ai)
#pragma unroll
            for (int m = 0; m < 4; ++m) { const int r = row_off + u.pm * BM + ai * HALF + wr * 64 + m * 16 + fr; float* orow = out + (size_t)r * DM + col0;
#pragma unroll
                for (int bj = 0; bj < 2; ++bj) { const f32x4 x0 = *(const f32x4*)(orow + bj * HALF), x1 = *(const f32x4*)(orow + bj * HALF + 4);
                    *(f32x4*)(orow + bj * HALF) = x0 + acc[ai][bj][m][0]; *(f32x4*)(orow + bj * HALF + 4) = x1 + acc[ai][bj][m][1]; }
                if (m & 1) asm volatile("" ::: "memory"); }
    }
};

template <class Epi, class Sched, bool ALIGN_EPI>
__device__ __forceinline__ void gemm_phase(LAS unsigned char* lds, const Gemm g, const Sched& S, const Epi& E) {
    int tid_ = threadIdx.x; asm volatile("" : "+v"(tid_));
    const int tid = tid_, wid = __builtin_amdgcn_readfirstlane(tid >> 6), lane = tid & 63, wr = wid >> 2, wc = wid & 3, fr = lane & 15, fq = lane >> 4;
    const int K = g.K, nt = K / BK;
    unsigned voffA[2], voffB[2];
#pragma unroll
    for (int i = 0; i < 2; ++i) { int R, C; stage_rc(tid * 16 + i * 8192, R, C); const int Rb = Epi::PERM ? ((R & ~31) + perm32(R & 31)) : R;
        voffA[i] = (unsigned)(R * g.lda + C * 2); voffB[i] = (unsigned)(Rb * K + C) * 2u; }
    const size_t kstep = (size_t)(BK * 2);
    const size_t hstepA = (size_t)HALF * g.lda, tstepA = 2 * hstepA;
    const size_t hstepB = (size_t)HALF * K * 2, tstepB = 2 * hstepB;
    const unsigned ldsw = (unsigned)wid * 1024u;
    const int aoff = lds_byte(wr * 64 + fr, fq * 8), boff = lds_byte(wc * 32 + fr, fq * 8);
#define PG8_AOFF(kt) ((size_t)(kt) * kstep + ((kt) >= g.jkt ? (size_t)g.jbytes : (size_t)0))
#define PG8_SA(b, h) (((b) * 2 + (h)) * HTB)
#define PG8_SB(b, h) ((4 + (b) * 2 + (h)) * HTB)
#define PG8_STAGE(bufoff, gbase, voff) do { _Pragma("unroll") for (int _i = 0; _i < 2; ++_i) \
        __builtin_amdgcn_global_load_lds((const unsigned*)((const char*)(gbase) + (voff)[_i]), (LAS unsigned*)(lds + (bufoff) + ldsw + _i * 8192), 16, 0, 0); } while (0)
#define PG8_LDA(dst, b, h) do { _Pragma("unroll") for (int m = 0; m < 4; ++m) _Pragma("unroll") for (int k = 0; k < 2; ++k) dst[m][k] = *(const LAS bf16x8*)(lds + PG8_SA(b, h) + aoff + m * 2048 + k * 1024); } while (0)
#define PG8_LDB(dst, b, h) do { _Pragma("unroll") for (int n = 0; n < 2; ++n) _Pragma("unroll") for (int k = 0; k < 2; ++k) dst[n][k] = *(const LAS bf16x8*)(lds + PG8_SB(b, h) + boff + n * 2048 + k * 1024); } while (0)
#define PG8_MMA(ai, bj, At, Bt) do { __builtin_amdgcn_s_setprio(1); _Pragma("unroll") for (int m = 0; m < 4; ++m) _Pragma("unroll") for (int n = 0; n < 2; ++n) _Pragma("unroll") for (int k = 0; k < 2; ++k) \
        acc[ai][bj][m][n] = __builtin_amdgcn_mfma_f32_16x16x32_bf16(Bt[n][k], At[m][k], acc[ai][bj][m][n], 0, 0, 0); __builtin_amdgcn_s_setprio(0); } while (0)
#define PG8_WAIT_V(n) asm volatile("s_waitcnt vmcnt(" #n ")" ::: "memory")
#define PG8_WAIT_L(n) asm volatile("s_waitcnt lgkmcnt(" #n ")" ::: "memory")
#define PG8_BAR __builtin_amdgcn_s_barrier()
#define PG8_SCHED __builtin_amdgcn_sched_barrier(0)
    Unit cur, nxt; int ui = 0;
    if (!S.next(0, cur)) return;
    f32x4 acc[2][2][4][2];
#pragma unroll
    for (int a = 0; a < 2; ++a)
#pragma unroll
        for (int b = 0; b < 2; ++b)
#pragma unroll
            for (int m = 0; m < 4; ++m)
#pragma unroll
                for (int n = 0; n < 2; ++n) acc[a][b][m][n] = (f32x4){0.f, 0.f, 0.f, 0.f};
    bf16x8 At[4][2], B0[2][2], B1[2][2];
    const char* cA = g.A + (size_t)cur.pm * tstepA; const char* cB = (const char*)g.Bt + (size_t)cur.pn * tstepB;
    {
        PG8_STAGE(PG8_SB(0, 0), cB, voffB); PG8_STAGE(PG8_SB(0, 1), cB + hstepB, voffB); PG8_STAGE(PG8_SA(0, 0), cA + PG8_AOFF(0), voffA); PG8_STAGE(PG8_SA(0, 1), cA + hstepA + PG8_AOFF(0), voffA);
        if (wr == 1) PG8_BAR;
        PG8_WAIT_V(2); PG8_BAR;
        PG8_STAGE(PG8_SB(1, 0), cB + kstep, voffB); PG8_STAGE(PG8_SA(1, 0), cA + PG8_AOFF(1), voffA); PG8_STAGE(PG8_SB(1, 1), cB + hstepB + kstep, voffB);
        PG8_WAIT_V(6); PG8_BAR;
    }
    for (;;) {
        const bool has_next = S.next(ui + 1, nxt);
        const char* nA = has_next ? g.A + (size_t)nxt.pm * tstepA : cA; const char* nB = has_next ? (const char*)g.Bt + (size_t)nxt.pn * tstepB : cB;
        for (int t = 0; t < nt; t += 2) {
            const bool last = (t == nt - 2);
            const char* a1 = cA + PG8_AOFF(t + 1);
            const char* a2 = last ? nA + PG8_AOFF(0) : cA + PG8_AOFF(t + 2); const char* b2 = last ? nB : cB + (size_t)(t + 2) * kstep;
            const char* a3 = last ? nA + PG8_AOFF(1) : cA + PG8_AOFF(t + 3); const char* b3 = b2 + kstep;
            PG8_LDB(B0, 0, 0); PG8_LDB(B1, 0, 1); PG8_SCHED; PG8_LDA(At, 0, 0); PG8_STAGE(PG8_SA(1, 1), a1 + hstepA, voffA);
            PG8_WAIT_V(8); PG8_WAIT_L(0); PG8_BAR; PG8_MMA(0, 0, At, B0); PG8_MMA(0, 1, At, B1); PG8_BAR; PG8_SCHED;
            PG8_LDA(At, 0, 1); PG8_STAGE(PG8_SB(0, 0), b2, voffB); PG8_STAGE(PG8_SB(0, 1), b2 + hstepB, voffB); PG8_STAGE(PG8_SA(0, 0), a2, voffA);
            PG8_WAIT_V(8); PG8_WAIT_L(0); PG8_BAR; PG8_MMA(1, 0, At, B0); PG8_MMA(1, 1, At, B1); PG8_BAR; PG8_SCHED;
            PG8_LDB(B0, 1, 0); PG8_LDB(B1, 1, 1); PG8_SCHED; PG8_LDA(At, 1, 0); PG8_STAGE(PG8_SA(0, 1), a2 + hstepA, voffA);
            PG8_WAIT_V(8); PG8_WAIT_L(0); PG8_BAR; PG8_MMA(0, 0, At, B0); PG8_MMA(0, 1, At, B1); PG8_BAR; PG8_SCHED;
            PG8_LDA(At, 1, 1); PG8_STAGE(PG8_SB(1, 0), b3, voffB); PG8_STAGE(PG8_SB(1, 1), b3 + hstepB, voffB); PG8_STAGE(PG8_SA(1, 0), a3, voffA);
            PG8_WAIT_V(8); PG8_WAIT_L(0); PG8_BAR; PG8_MMA(1, 0, At, B0); PG8_MMA(1, 1, At, B1); PG8_BAR; PG8_SCHED;
        }
        if constexpr (ALIGN_EPI) { if (wr == 0) PG8_BAR; }
        E(acc, cur, wr, wc, fr, fq);
        if (!has_next) break;
#pragma unroll
        for (int a = 0; a < 2; ++a)
#pragma unroll
            for (int b = 0; b < 2; ++b)
#pragma unroll
                for (int m = 0; m < 4; ++m)
#pragma unroll
                    for (int n = 0; n < 2; ++n) acc[a][b][m][n] = (f32x4){0.f, 0.f, 0.f, 0.f};
        cur = nxt; cA = nA; cB = nB; ++ui;
        if constexpr (ALIGN_EPI) { if (wr == 1) PG8_BAR; }
    }
    PG8_WAIT_V(0);
    if constexpr (!ALIGN_EPI) { if (wr == 0) PG8_BAR; }
    PG8_BAR;
#undef PG8_AOFF
#undef PG8_SA
#undef PG8_SB
#undef PG8_STAGE
#undef PG8_LDA
#undef PG8_LDB
#undef PG8_MMA
#undef PG8_WAIT_V
#undef PG8_WAIT_L
#undef PG8_BAR
#undef PG8_SCHED
}
}

constexpr int NWAVES = 8, NTHR = 512;
constexpr int LDS_BYTES = 163840;
struct Args {
    const float* in[27]; float* out; unsigned char* ws; int ph_lo, ph_hi;
};
struct Frame {
    LAS unsigned char* lds; int tid, lane, wave, vcu, G;
};
constexpr int PTRS_OFF = LDS_BYTES - 256;
__device__ __forceinline__ const float* inp(LAS unsigned char* lds, int i) { return *(const float* LAS*)(lds + PTRS_OFF + i * 8); }
__device__ __forceinline__ float gld(const float* p) { return *(const GAS float*)p; }
__device__ __forceinline__ int seq_row0(int q) { return q == 0 ? 0 : SP + (q - 1) * SS; }
__device__ __forceinline__ int seq_len(int q) { return q == 0 ? SP : SS; }

__device__ __forceinline__ void p0_transpose_item(const float* W, int K, int N, bf16_t* WT, const float* kscale, LAS float* scr, int item, int lane) {
    const int nblk = N / 32, kb = item / nblk, nb = item % nblk, k0 = 64 * kb, n0 = 32 * nb;
#pragma unroll 8
    for (int i = 0; i < 32; ++i) { const int kk = 2 * i + (lane >> 5); float v = W[(size_t)(k0 + kk) * N + n0 + (lane & 31)]; if (kscale) v *= kscale[k0 + kk]; scr[kk * 33 + (lane & 31)] = v; }
    LDS_WAIT(); asm volatile("" ::: "memory");
    const int c = lane & 7;
#pragma unroll
    for (int j = 0; j < 4; ++j) { const int n = (lane >> 3) + 8 * j; const LAS float* s = scr + (8 * c) * 33 + n;
        u32x4 o; o.x = cvt_pk_bf16(s[0 * 33], s[1 * 33]); o.y = cvt_pk_bf16(s[2 * 33], s[3 * 33]); o.z = cvt_pk_bf16(s[4 * 33], s[5 * 33]); o.w = cvt_pk_bf16(s[6 * 33], s[7 * 33]);
        *(u32x4*)(WT + (size_t)(n0 + n) * K + k0 + 8 * c) = o; }
    LDS_WAIT(); asm volatile("" ::: "memory");
}
__device__ __forceinline__ void p0_prologue(const Frame& F, const Args& a) {
    LAS float* scr = (LAS float*)(F.lds + F.wave * 16384);
    const int gw = F.vcu * NWAVES + F.wave, NGW = F.G * NWAVES;
    unsigned char* ws = a.ws;
    constexpr int I_IN = (DM / 64) * (ZP / 32), I_O = (DM / 64) * (DM / 32), I_1 = (DM / 64) * (DFF / 32), I_2 = (DFF / 64) * (DM / 32);
    for (int it = gw; it < I_IN + I_O + I_1 + I_2; it += NGW) {
        int r = it;
        if (r < I_IN) { p0_transpose_item(a.in[3], DM, ZP, (bf16_t*)(ws + WS_WIN), nullptr, scr, r, F.lane); continue; } r -= I_IN;
        if (r < I_O) { p0_transpose_item(a.in[23], DM, DM, (bf16_t*)(ws + WS_WOUT), nullptr, scr, r, F.lane); continue; } r -= I_O;
        if (r < I_1) { p0_transpose_item(a.in[25], DM, DFF, (bf16_t*)(ws + WS_W1), a.in[24], scr, r, F.lane); continue; } r -= I_1;
        p0_transpose_item(a.in[26], DFF, DM, (bf16_t*)(ws + WS_W2), nullptr, scr, r, F.lane);
    }
    bf16_t* XN = (bf16_t*)a.out; const float* g1 = a.in[2];
    for (int m = gw; m < MTOK; m += NGW) {
        const float* xrow = m < SP ? a.in[0] + (size_t)m * DM : a.in[1] + (size_t)(m - SP) * DM;
        const f32x4* xr = (const f32x4*)xrow + F.lane; f32x4 v[4]; float s = 0.f;
#pragma unroll
        for (int j = 0; j < 4; ++j) { v[j] = xr[64 * j]; s += (v[j][0] * v[j][0] + v[j][1] * v[j][1]) + (v[j][2] * v[j][2] + v[j][3] * v[j][3]); }
        const float rstd = 1.0f / sqrtf(wave_sum(s) * (1.f / DM) + NORM_EPS);
        u32x2* o8 = (u32x2*)(XN + (size_t)m * DM) + F.lane;
#pragma unroll
        for (int j = 0; j < 4; ++j) { const f32x4 gv = ((const f32x4*)g1)[F.lane + 64 * j]; u32x2 w; w.x = cvt_pk_bf16(v[j][0] * rstd * gv[0], v[j][1] * rstd * gv[1]); w.y = cvt_pk_bf16(v[j][2] * rstd * gv[2], v[j][3] * rstd * gv[3]); o8[64 * j] = w; }
    }
    const int gt = F.vcu * NTHR + F.tid, NGT = F.G * NTHR;
    float* rope = (float*)(ws + WS_ROPE);
    for (int e = gt; e < SP * 32; e += NGT) { const int pos = e >> 5, i = e & 31;
        const float invf = 1.0f / powf(10000.0f, (float)(2 * i) / 64.0f); const float ang = (float)pos * invf; float sn, cs; sincosf(ang, &sn, &cs);
        rope[2 * e] = cs; rope[2 * e + 1] = sn; }
    bf16_t* wupT = (bf16_t*)(ws + WS_LORA); bf16_t* aupT = wupT + 2 * 512 * 64; bf16_t* gupT = aupT + 2 * 512 * 64;
    for (int e = gt; e < 2 * 512 * 64; e += NGT) { const int d = e >> 15, c = (e >> 6) & 511, r = e & 63;
        wupT[e] = f2bf(a.in[14][((size_t)d * 64 + r) * 512 + c]); aupT[e] = f2bf(a.in[16][((size_t)d * 64 + r) * 512 + c]); }
    for (int e = gt; e < 512 * 128; e += NGT) { const int c = e >> 7, r = e & 127; gupT[e] = f2bf(a.in[17][(size_t)r * 512 + c]); }
}

__device__ __forceinline__ void qk_prep(const Frame& F, const Args& a) {
    const int gw = F.vcu * NWAVES + F.wave, NGW = F.G * NWAVES;
    bf16_t* Z = (bf16_t*)(a.ws + WS_Z); const float* rope = (const float*)(a.ws + WS_ROPE);
    const int g = F.lane >> 2, qd = F.lane & 3;
    const float* gain = (g < 8) ? a.in[4] : a.in[5];
    float glo[8], ghi[8];
#pragma unroll
    for (int j = 0; j < 8; ++j) { glo[j] = gain[8 * qd + j]; ghi[j] = gain[32 + 8 * qd + j]; }
    const float osc = (g < 8) ? QSCALE : 1.0f;
    const float mpw = a.in[11][ZWD - ZRR + F.lane], mnw = a.in[12][ZWD - ZRR + F.lane], mpa = a.in[11][ZAD - ZRR + F.lane], mna = a.in[12][ZAD - ZRR + F.lane];
#pragma unroll 4
    for (int m = gw; m < MTOK; m += NGW) {
        const int pos = m < SP ? m : ((m - SP) & (SS - 1));
        bf16_t* p = Z + (size_t)m * ZP + g * 64 + 8 * qd;
        const u32x4 lo4 = *(const u32x4*)p, hi4 = *(const u32x4*)(p + 32);
        float lo[8], hi[8];
#pragma unroll
        for (int j = 0; j < 4; ++j) { lo[2 * j] = bflo(lo4[j]); lo[2 * j + 1] = bfhi(lo4[j]); hi[2 * j] = bflo(hi4[j]); hi[2 * j + 1] = bfhi(hi4[j]); }
        float ss = 0.f;
#pragma unroll
        for (int j = 0; j < 8; ++j) ss += lo[j] * lo[j] + hi[j] * hi[j];
        ss += __shfl_xor(ss, 1); ss += __shfl_xor(ss, 2);
        const float rstd = __builtin_amdgcn_rsqf(ss * (1.f / 64.f) + NORM_EPS);
        const f32x4* rp = (const f32x4*)(rope + ((size_t)pos * 32 + 8 * qd) * 2);
        float ol[8], oh[8];
#pragma unroll
        for (int j2 = 0; j2 < 4; ++j2) { const f32x4 cs = rp[j2];
#pragma unroll
            for (int e = 0; e < 2; ++e) { const int j = 2 * j2 + e; const float c = cs[2 * e], s = cs[2 * e + 1]; const float l = lo[j] * rstd * glo[j], h = hi[j] * rstd * ghi[j];
                ol[j] = (l * c - h * s) * osc; oh[j] = (h * c + l * s) * osc; } }
        u32x4 wl, wh;
#pragma unroll
        for (int j = 0; j < 4; ++j) { wl[j] = cvt_pk_bf16(ol[2 * j], ol[2 * j + 1]); wh[j] = cvt_pk_bf16(oh[2 * j], oh[2 * j + 1]); }
        *(u32x4*)p = wl; *(u32x4*)(p + 32) = wh;
        { const int S = m < SP ? SP : SS; const bf16_t* zr = Z + (size_t)m * ZP; const int j = F.lane;
          const float wc = bf2f(zr[ZWD + j]), ac = bf2f(zr[ZAD + j]);
          const float wp = pos > 0 ? bf2f(zr[ZWD + j - ZP]) : 0.f, ap = pos > 0 ? bf2f(zr[ZAD + j - ZP]) : 0.f;
          const float wn = pos + 1 < S ? bf2f(zr[ZWD + j + ZP]) : 0.f, an = pos + 1 < S ? bf2f(zr[ZAD + j + ZP]) : 0.f;
          const float ws_ = wc + mpw * (wp - wc) + mnw * (wn - wc), as_ = ac + mpa * (ap - ac) + mna * (an - ac);
          bf16_t* e1 = (bf16_t*)(a.ws + WS_E1) + (size_t)m * 128;
          e1[j] = f2bf(1.0f - 2.0f * __builtin_amdgcn_rcpf(__expf(2.0f * ws_) + 1.0f)); e1[64 + j] = f2bf(as_); }
    }
}

namespace att {
constexpr int KSLOT = 8192, VSLOT = 16384, NKS = 4, NVS = 3;
constexpr int L_K = 0, L_V = NKS * KSLOT, L_WS = L_V + NVS * VSLOT, L_ST = L_WS + NWAVES * 256, L_END = L_ST + NWAVES * 8192;
static_assert(L_END <= PTRS_OFF, "attention lds");
__device__ __forceinline__ int crow(int r, int hi) { return (r & 3) + 8 * (r >> 2) + 4 * hi; }
__device__ __forceinline__ void glds16(const void* gsrc, unsigned lds_dst) { unsigned keep;
    asm volatile("s_mov_b32 %0, m0\n\ts_mov_b32 m0, %2\n\ts_nop 0\n\tglobal_load_lds_dwordx4 %1, off\n\ts_mov_b32 m0, %0" : "=&s"(keep) : "v"(gsrc), "s"(lds_dst) : "memory"); }
typedef short v4i16_t __attribute__((ext_vector_type(4)));
typedef const LAS char* lds_cptr;
__device__ __forceinline__ s16x4 vtr(lds_cptr p) { return __builtin_bit_cast(s16x4, __builtin_amdgcn_ds_read_tr16_b64_v4i16((LAS v4i16_t*)p)); }
#define SBAR() __builtin_amdgcn_sched_barrier(0)
#define WAIT_BAR(N) asm volatile("s_waitcnt vmcnt(" #N ") lgkmcnt(0)\n\ts_barrier" ::: "memory")
__device__ __forceinline__ void kload8(bf16x8* kf, lds_cptr kp) {
    kf[0] = *(const LAS bf16x8*)(kp);        kf[1] = *(const LAS bf16x8*)(kp + 512);
    kf[2] = *(const LAS bf16x8*)(kp + 2048); kf[3] = *(const LAS bf16x8*)(kp + 2560);
    kf[4] = *(const LAS bf16x8*)(kp + 4096); kf[5] = *(const LAS bf16x8*)(kp + 4608);
    kf[6] = *(const LAS bf16x8*)(kp + 6144); kf[7] = *(const LAS bf16x8*)(kp + 6656);
}
__device__ __forceinline__ void kload2(bf16x8* kf, lds_cptr kp, int j) { kf[2 * j] = *(const LAS bf16x8*)(kp + j * 2048); kf[2 * j + 1] = *(const LAS bf16x8*)(kp + j * 2048 + 512); }

__device__ __forceinline__ void attn_unit(int row0, int S, int h, int qb, bf16_t* Z, LAS unsigned char* shm, float lam, const float* subln_g, bf16_t* Ob, int opitch) {
    int tid_ = threadIdx.x; asm volatile("" : "+v"(tid_));
    const int tid = tid_, lane = tid & 63, r32 = lane & 31, hi = lane >> 5; const int wid = __builtin_amdgcn_readfirstlane(tid >> 6);
    const unsigned lds0 = (unsigned)(uintptr_t)shm;
    LAS float* wsf = (LAS float*)(shm + L_WS) + wid * 64;
    LAS bf16_t* stash = (LAS bf16_t*)(shm + L_ST) + wid * 4096;
    const int NT = S / 64;
    const size_t qrow = (size_t)(row0 + qb * 256 + wid * 32);
    const lds_cptr shm3 = (lds_cptr)shm;
    const lds_cptr kp0 = shm3 + L_K + hi * 1024 + r32 * 16;
    const lds_cptr vp0 = shm3 + L_V + ((lane >> 4) & 1) * 32 + (lane & 3) * 8 + (4 * hi + ((lane & 15) >> 2)) * 64;
    f32x16 o[4];
#pragma unroll 1
    for (int c = 0; c < 2; ++c) {
        const bf16_t* Qw = Z + qrow * ZP + ZQ + h * 128 + c * 64;
        const bf16_t* Kh = Z + (size_t)row0 * ZP + ZK + h * 128 + c * 64;
        const bf16_t* Vh = Z + (size_t)row0 * ZP + ZV + h * 128;
        const int p0 = 2 * wid, p1 = 2 * wid + 1;
        const unsigned koff = (unsigned)(lane * ZP + wid * 8) * 2u;
        const unsigned voff0 = (unsigned)((16 * (p0 & 3) + (lane >> 2)) * ZP + (p0 >> 2) * 32 + (lane & 3) * 8) * 2u;
        const unsigned voff1 = (unsigned)((16 * (p1 & 3) + (lane >> 2)) * ZP + (p1 >> 2) * 32 + (lane & 3) * 8) * 2u;
        const unsigned kdst = lds0 + L_K + wid * 1024, vdst0 = lds0 + L_V + p0 * 1024, vdst1 = lds0 + L_V + p1 * 1024;
#define DMA_K(t, si) glds16((const char*)(Kh + (size_t)(t) * 64 * ZP) + koff, (unsigned)__builtin_amdgcn_readfirstlane(kdst + (si) * KSLOT))
#define DMA_V(t, si) do { const char* vb_ = (const char*)(Vh + (size_t)(t) * 64 * ZP); glds16(vb_ + voff0, (unsigned)__builtin_amdgcn_readfirstlane(vdst0 + (si) * VSLOT)); glds16(vb_ + voff1, (unsigned)__builtin_amdgcn_readfirstlane(vdst1 + (si) * VSLOT)); } while (0)
        DMA_K(0, 0); DMA_V(0, 0); DMA_K(1, 1);
        bf16x8 qr[4];
#pragma unroll
        for (int d0 = 0; d0 < 4; ++d0) qr[d0] = *(const bf16x8*)(Qw + (size_t)r32 * ZP + d0 * 16 + hi * 8);
#pragma unroll
        for (int d0 = 0; d0 < 4; ++d0) o[d0] = f32x16{};
        float l_reg = 0.f;
        bf16x8 kf[4];
        f32x16 pA0, pA1, pB0, pB1;
        int i_prev = 0, i_cur = 0, i_next = 1;
        int k_cur = 0, k_next = 1;
#define ROT() do { i_prev = i_cur; i_cur = i_next; i_next = (i_next == NVS - 1) ? 0 : i_next + 1; k_cur = k_next; k_next = (k_next + 1) & 3; } while (0)
#define KFRAG(slot, i) (*(const LAS bf16x8*)(kp0 + (slot) * KSLOT + ((i) >> 1) * 2048 + ((i) & 1) * 512))
        DMA_K(2, 2);
        WAIT_BAR(4);
        {
            const lds_cptr kb = kp0;
            pA0 = f32x16{}; pA1 = f32x16{};
#pragma unroll
            for (int d0 = 0; d0 < 4; ++d0) { const bf16x8 b0 = *(const LAS bf16x8*)(kb + d0 * 2048), b1 = *(const LAS bf16x8*)(kb + d0 * 2048 + 512);
                pA0 = __builtin_amdgcn_mfma_f32_32x32x16_bf16(b0, qr[d0], pA0, 0, 0, 0); pA1 = __builtin_amdgcn_mfma_f32_32x32x16_bf16(b1, qr[d0], pA1, 0, 0, 0); }
#pragma unroll
            for (int r = 0; r < 16; ++r) { pA0[r] = __builtin_amdgcn_exp2f(pA0[r]); pA1[r] = __builtin_amdgcn_exp2f(pA1[r]); }
        }
        WAIT_BAR(0);
        DMA_K(3, 3); DMA_V(1, 1);
        ROT();
        kf[0] = KFRAG(k_cur, 0); kf[1] = KFRAG(k_cur, 1); kf[2] = KFRAG(k_cur, 2); kf[3] = KFRAG(k_cur, 3);
        WAIT_BAR(3);
        s16x4 vlo[4], vhi[4]; u32x4 pw0, pw1, pw2, pw3;
#define PKW(P, B) cvt_pk_bf16(P[B], P[B + 1])
#define PAF(k) __builtin_bit_cast(bf16x8, pw##k)
#define VFR(i) (bf16x8){vlo[i][0], vlo[i][1], vlo[i][2], vlo[i][3], vhi[i][0], vhi[i][1], vhi[i][2], vhi[i][3]}
#define PIN(x) asm volatile("" : "+v"(x))
#define EX(v) __builtin_amdgcn_exp2f(v)
#define VRD(slot, f) do { vlo[slot] = vtr(vp_ + (((f) & 3) * 4096 + ((f) >> 2) * 1024)); vhi[slot] = vtr(vp_ + (((f) & 3) * 4096 + ((f) >> 2) * 1024 + 512)); } while (0)
#define GAPA(MF, LDX, A0, A1, A2, A3, W0, W1, PW) do { MF; LDX; sacc += A0; sacc += A1; sacc += A2; sacc += A3; PIN(sacc); W0; W1; PIN(PW); SBAR(); } while (0)
#define GAPB(MF, LDX, X, B) do { MF; LDX; X[B] = EX(X[B]); X[B + 1] = EX(X[B + 1]); PIN(X); SBAR(); } while (0)
#define PVM(f) o[(f) & 3] = __builtin_amdgcn_mfma_f32_32x32x16_bf16(__builtin_bit_cast(bf16x8, (f) < 4 ? pw0 : (f) < 8 ? pw1 : (f) < 12 ? pw2 : pw3), VFR((f) & 3), o[(f) & 3], 0, 0, 0)
#define NOP_ do { } while (0)
#if PROBE_ATT
#define ATT_T(k) do { if (PROBE_ATT == (k)) { const unsigned long long n_ = __builtin_amdgcn_s_memrealtime(); if (tid == 0) *(LAS unsigned long long*)(shm + PTRS_OFF - 64) += n_ - att_t0; } } while (0)
#define ATT_T0() const unsigned long long att_t0 = __builtin_amdgcn_s_memrealtime()
#else
#define ATT_T(k) do { } while (0)
#define ATT_T0() do { } while (0)
#endif
#define STEP(C0, C1, P0, P1, t, GK, GV, GL) do { SBAR(); \
        const lds_cptr vp_ = vp0 + i_prev * VSLOT; \
        float sacc = (P0[0] + P0[1]); \
        GAPA(C0 = __builtin_amdgcn_mfma_f32_32x32x16_bf16(kf[0], qr[0], (f32x16){}, 0, 0, 0), kf[0] = KFRAG(k_cur, 4), P0[2], P0[3], P0[4], P0[5],     pw0[0] = PKW(P0, 0), pw0[1] = PKW(P0, 2), pw0); \
        GAPA(C1 = __builtin_amdgcn_mfma_f32_32x32x16_bf16(kf[1], qr[0], (f32x16){}, 0, 0, 0), kf[1] = KFRAG(k_cur, 5), P0[6], P0[7], P0[8], P0[9],     pw0[2] = PKW(P0, 4), pw0[3] = PKW(P0, 6), pw0); \
        GAPA(C0 = __builtin_amdgcn_mfma_f32_32x32x16_bf16(kf[2], qr[1], C0, 0, 0, 0),         kf[2] = KFRAG(k_cur, 6), P0[10], P0[11], P0[12], P0[13], pw1[0] = PKW(P0, 8), pw1[1] = PKW(P0, 10), pw1); \
        GAPA(C1 = __builtin_amdgcn_mfma_f32_32x32x16_bf16(kf[3], qr[1], C1, 0, 0, 0),         kf[3] = KFRAG(k_cur, 7), P0[14], P0[15], P1[0], P1[1],   pw1[2] = PKW(P0, 12), pw1[3] = PKW(P0, 14), pw1); \
        GAPA(C0 = __builtin_amdgcn_mfma_f32_32x32x16_bf16(kf[0], qr[2], C0, 0, 0, 0),         VRD(0, 0), P1[2], P1[3], P1[4], P1[5],     pw2[0] = PKW(P1, 0), pw2[1] = PKW(P1, 2), pw2); \
        GAPA(C1 = __builtin_amdgcn_mfma_f32_32x32x16_bf16(kf[1], qr[2], C1, 0, 0, 0),         VRD(1, 1), P1[6], P1[7], P1[8], P1[9],     pw2[2] = PKW(P1, 4), pw2[3] = PKW(P1, 6), pw2); \
        GAPA(C0 = __builtin_amdgcn_mfma_f32_32x32x16_bf16(kf[2], qr[3], C0, 0, 0, 0),         VRD(2, 2), P1[10], P1[11], P1[12], P1[13], pw3[0] = PKW(P1, 8), pw3[1] = PKW(P1, 10), pw3); \
        GAPA(C1 = __builtin_amdgcn_mfma_f32_32x32x16_bf16(kf[3], qr[3], C1, 0, 0, 0),         VRD(3, 3), P1[14], P1[15], 0.f, 0.f,       pw3[2] = PKW(P1, 12), pw3[3] = PKW(P1, 14), pw3); \
        l_reg += sacc; \
        if (GK) { DMA_K((t) + 3, (k_cur + 3) & 3); } if (GV) { DMA_V((t) + 1, i_next); } \
        SBAR(); \
        GAPB(PVM(0), VRD(0, 4), C0, 0);   GAPB(PVM(1), VRD(1, 5), C0, 2);   GAPB(PVM(2), VRD(2, 6), C0, 4);    GAPB(PVM(3), VRD(3, 7), C0, 6); \
        GAPB(PVM(4), VRD(0, 8), C0, 8);   GAPB(PVM(5), VRD(1, 9), C0, 10);  GAPB(PVM(6), VRD(2, 10), C0, 12);  GAPB(PVM(7), VRD(3, 11), C0, 14); \
        GAPB(PVM(8), VRD(0, 12), C1, 0);  GAPB(PVM(9), VRD(1, 13), C1, 2);  GAPB(PVM(10), VRD(2, 14), C1, 4);  GAPB(PVM(11), VRD(3, 15), C1, 6); \
        GAPB(PVM(12), if (GL) kf[0] = KFRAG(k_next, 0), C1, 8);  GAPB(PVM(13), if (GL) kf[1] = KFRAG(k_next, 1), C1, 10); \
        GAPB(PVM(14), if (GL) kf[2] = KFRAG(k_next, 2), C1, 12); GAPB(PVM(15), if (GL) kf[3] = KFRAG(k_next, 3), C1, 14); \
        } while (0)
        int t = 1;
#pragma unroll 1
        for (; t + 5 < NT; t += 2) {
#if PROBE_ATT == 1
            STEP(pB0, pB1, pA0, pA1, t, true, true, true);     { ATT_T0(); WAIT_BAR(3); ATT_T(1); } ROT();
            STEP(pA0, pA1, pB0, pB1, t + 1, true, true, true); { ATT_T0(); WAIT_BAR(3); ATT_T(1); } ROT();
#elif PROBE_ATT >= 2
            { ATT_T0(); STEP(pB0, pB1, pA0, pA1, t, true, true, true); ATT_T(2); }    WAIT_BAR(3); ROT();
            { ATT_T0(); STEP(pA0, pA1, pB0, pB1, t + 1, true, true, true); ATT_T(2); } WAIT_BAR(3); ROT();
#else
            STEP(pB0, pB1, pA0, pA1, t, true, true, true);     WAIT_BAR(3); ROT();
            STEP(pA0, pA1, pB0, pB1, t + 1, true, true, true); WAIT_BAR(3); ROT();
#endif
        }
#define ENDW(tt) do { if ((tt) + 3 < NT) { WAIT_BAR(3); } else if ((tt) + 2 < NT) { WAIT_BAR(2); } else { WAIT_BAR(0); } } while (0)
#pragma unroll 1
        for (; t + 1 < NT; t += 2) {
            STEP(pB0, pB1, pA0, pA1, t, (t + 3 < NT), (t + 1 < NT), (t + 1 < NT));         ENDW(t);     ROT();
            STEP(pA0, pA1, pB0, pB1, t + 1, (t + 4 < NT), (t + 2 < NT), (t + 2 < NT));     ENDW(t + 1); ROT();
        }
        STEP(pB0, pB1, pA0, pA1, NT - 1, false, false, false);
        {
            float sacc = pB0[0] + pB0[1];
#pragma unroll
            for (int r = 2; r < 16; ++r) sacc += pB0[r];
#pragma unroll
            for (int r = 0; r < 16; ++r) sacc += pB1[r];
            l_reg += sacc;
            pw0 = (u32x4){PKW(pB0, 0), PKW(pB0, 2), PKW(pB0, 4), PKW(pB0, 6)}; pw1 = (u32x4){PKW(pB0, 8), PKW(pB0, 10), PKW(pB0, 12), PKW(pB0, 14)};
            pw2 = (u32x4){PKW(pB1, 0), PKW(pB1, 2), PKW(pB1, 4), PKW(pB1, 6)}; pw3 = (u32x4){PKW(pB1, 8), PKW(pB1, 10), PKW(pB1, 12), PKW(pB1, 14)};
            const lds_cptr vp_ = vp0 + i_cur * VSLOT;
            VRD(0, 0); VRD(1, 1); VRD(2, 2); VRD(3, 3); PVM(0); PVM(1); PVM(2); PVM(3);
            VRD(0, 4); VRD(1, 5); VRD(2, 6); VRD(3, 7); PVM(4); PVM(5); PVM(6); PVM(7);
            VRD(0, 8); VRD(1, 9); VRD(2, 10); VRD(3, 11); PVM(8); PVM(9); PVM(10); PVM(11);
            VRD(0, 12); VRD(1, 13); VRD(2, 14); VRD(3, 15); PVM(12); PVM(13); PVM(14); PVM(15);
        }
#undef DMA_K
#undef DMA_V
#undef ROT
#undef PKW
#undef PAF
#undef VFR
#undef PIN
#undef EX
#undef VRD
#undef GAPA
#undef GAPB
#undef KFRAG
#undef NOP_
#undef PVM
#undef STEP
#undef ENDW
        { auto rr = __builtin_amdgcn_permlane32_swap(__float_as_uint(l_reg), __float_as_uint(l_reg), false, false); l_reg = __uint_as_float(rr[0]) + __uint_as_float(rr[1]); }
        if (hi == 0) wsf[r32] = l_reg;
        LDS_WAIT();
        float rli[16];
#pragma unroll
        for (int r = 0; r < 16; ++r) rli[r] = 1.0f / wsf[crow(r, hi)];
        if (c == 0) {
#pragma unroll
            for (int d0 = 0; d0 < 4; ++d0)
#pragma unroll
                for (int r = 0; r < 16; ++r) stash[(d0 * 16 + r) * 64 + lane] = f2bf(o[d0][r] * rli[r]);
            LDS_WAIT();
        } else {
#pragma unroll
            for (int d0 = 0; d0 < 4; ++d0)
#pragma unroll
                for (int r = 0; r < 16; ++r) o[d0][r] = bf2f(stash[(d0 * 16 + r) * 64 + lane]) - lam * (o[d0][r] * rli[r]);
            LDS_WAIT(); asm volatile("" ::: "memory");
#pragma unroll
            for (int d0 = 0; d0 < 4; ++d0)
#pragma unroll
                for (int r = 0; r < 16; ++r) stash[crow(r, hi) * 128 + d0 * 32 + r32] = f2bf(o[d0][r]);
            LDS_WAIT(); asm volatile("" ::: "memory");
            bf16_t* Ow = Ob + qrow * opitch + ZQ + h * 128;
#pragma unroll
            for (int i = 0; i < 4; ++i) { const int row = i * 8 + (lane >> 3), ch = lane & 7;
                const u32x4 w0 = *(const LAS u32x4*)(stash + row * 128 + ch * 16), w1 = *(const LAS u32x4*)(stash + row * 128 + ch * 16 + 8);
                float v[16];
#pragma unroll
                for (int j = 0; j < 4; ++j) { v[2 * j] = bflo(w0[j]); v[2 * j + 1] = bfhi(w0[j]); v[8 + 2 * j] = bflo(w1[j]); v[9 + 2 * j] = bfhi(w1[j]); }
                float ss = 0.f;
#pragma unroll
                for (int j = 0; j < 16; ++j) ss += v[j] * v[j];
                ss += __shfl_xor(ss, 1); ss += __shfl_xor(ss, 2); ss += __shfl_xor(ss, 4);
                const float rs = (1.0f - LAMBDA_INIT) / sqrtf(ss * (1.f / 128.f) + NORM_EPS);
                u32x4 x0, x1;
#pragma unroll
                for (int j = 0; j < 4; ++j) { x0[j] = cvt_pk_bf16(v[2 * j] * rs * subln_g[ch * 16 + 2 * j], v[2 * j + 1] * rs * subln_g[ch * 16 + 2 * j + 1]);
                                              x1[j] = cvt_pk_bf16(v[8 + 2 * j] * rs * subln_g[ch * 16 + 8 + 2 * j], v[9 + 2 * j] * rs * subln_g[ch * 16 + 9 + 2 * j]); }
                *(u32x4*)(Ow + (size_t)row * opitch + ch * 16) = x0; *(u32x4*)(Ow + (size_t)row * opitch + ch * 16 + 8) = x1; }
            LDS_WAIT();
        }
        asm volatile("s_waitcnt vmcnt(0) lgkmcnt(0)\n\ts_barrier" ::: "memory");
    }
}
#undef SBAR
#undef WAIT_BAR
}

namespace rw {
constexpr int P = 144, MAT = 64 * P;
constexpr int O_AT = 0, O_BT = MAT, O_KT = 2 * MAT, O_RT = 3 * MAT, O_ATT = 4 * MAT, O_VT = 5 * MAT, O_BHT = 6 * MAT, O_KHT = 7 * MAT;
constexpr int O_LAB = 8 * MAT, O_LAK = 9 * MAT, O_ARB = 10 * MAT, O_ARK = 11 * MAT, O_XT = 12 * MAT, O_ABT = 13 * MAT, O_U0T = 14 * MAT;
constexpr int O_LABD = 15 * MAT, O_TII = O_LABD + 4096, O_WC = O_TII + 2048, O_GSUM = O_WC + 256, O_PAR = O_GSUM + 2048, O_END = O_PAR + 960 * 4;
constexpr int O_ZS = 0, PZ = 128;
static_assert(3 * 66 * PZ <= 3 * MAT, "ZS fits At|Bt|Kt");
constexpr int O_TW = O_LAB, O_ADN = O_LAK, O_WL = O_ARB, O_AR = O_XT, PF = 272;
static_assert(O_END <= PTRS_OFF - 64 && 64 * PF <= 2 * MAT, "rwkv lds");
__device__ __forceinline__ int crow(int r, int hi) { return (r & 3) + 8 * (r >> 2) + 4 * hi; }
__device__ __forceinline__ float sigmoidf_(float x) { return __builtin_amdgcn_rcpf(1.0f + __expf(-x)); }
__device__ __forceinline__ float tanhf_(float x) { return 1.0f - 2.0f * __builtin_amdgcn_rcpf(__expf(2.0f * x) + 1.0f); }
__device__ __forceinline__ void load10(const bf16_t* zc, int t_lo, int S, float (&z)[10]) {
#pragma unroll
    for (int i = 0; i < 10; ++i) { const int t = t_lo - 1 + i; z[i] = (t >= 0 && t < S) ? bf2f(zc[(size_t)t * ZP]) : 0.f; }
}
__device__ __forceinline__ float tshift(const float (&z)[10], int u, float mp, float mn) { const float c = z[u + 1]; return c + mp * (z[u] - c) + mn * (z[u + 2] - c); }
__device__ __forceinline__ f32x16 mm_ll(const LAS unsigned char* A, int rowA, const LAS unsigned char* B, int rowB, f32x16 acc, int r32, int hi) {
#pragma unroll
    for (int ks = 0; ks < 4; ++ks) { const bf16x8 a = *(const LAS bf16x8*)(A + (rowA + r32) * P + (16 * ks + 8 * hi) * 2), b = *(const LAS bf16x8*)(B + (rowB + r32) * P + (16 * ks + 8 * hi) * 2);
        acc = __builtin_amdgcn_mfma_f32_32x32x16_bf16(a, b, acc, 0, 0, 0); }
    return acc;
}
__device__ __forceinline__ void store_native(unsigned char* dst, const f32x16& acc, int lane, bool wt) {
    u32x4 w0, w1;
#pragma unroll
    for (int q = 0; q < 4; ++q) { w0[q] = cvt_pk_bf16(acc[2 * q], acc[2 * q + 1]); w1[q] = cvt_pk_bf16(acc[8 + 2 * q], acc[9 + 2 * q]); }
    if (wt) {
        asm volatile("global_store_dwordx4 %0, %1, off sc1\n\tglobal_store_dwordx4 %0, %2, off offset:16 sc1\n\ts_nop 1" :: "v"(dst + lane * 32), "v"(w0), "v"(w1) : "memory");
    } else { *(u32x4*)(dst + lane * 32) = w0; *(u32x4*)(dst + lane * 32 + 16) = w1; }
}
__device__ __forceinline__ void st4(LAS unsigned char* p, float a, float b, float c, float d) { u32x2 w; w.x = cvt_pk_bf16(a, b); w.y = cvt_pk_bf16(c, d); *(LAS u32x2*)p = w; }

__device__ __forceinline__ f32x2_t s1_param_load(LAS unsigned char* L, int tid, int d, int h) {
    const int sg = tid >> 5, seg = sg < 15 ? sg : 14, off = (tid & 31) * 2;
    const int ti = seg < 10 ? 11 + (seg & 1) : (seg == 10 ? 13 : (seg == 11 ? 15 : 6 + seg));
    const int eo = seg < 6 ? (seg >> 1) * 512 + h * 64 : (seg < 8 ? ZWD - ZRR : (seg < 10 ? ZAD - ZRR : (seg < 12 ? d * 512 + h * 64 : h * 64)));
    const float* src = *(const float* LAS*)(L + PTRS_OFF + ti * 8) + eo + off;
    return *(const GAS f32x2_t*)src;
}
__device__ __forceinline__ void s1_stage_load(const Args& a, int tid, int q, int h, int ck, u32x4 (&v)[6]) {
    const int row0 = seq_row0(q), S = seq_len(q), t0 = ck * 64;
#pragma unroll
    for (int k = 0; k < 6; ++k) { const int c = tid + k * NTHR;
        const int seg = c >> 3, part = c & 7, row = seg / 3, grp = seg - row * 3; int t = t0 - 1 + row; t = t < 0 ? 0 : (t >= S ? S - 1 : t);
        const int e = c - 1584 < 0 ? 0 : (c - 1584 > 1023 ? 1023 : c - 1584);
        const size_t offz = WS_Z + ((size_t)(row0 + t) * ZP + ZRR + grp * 512 + h * 64 + part * 8) * 2, offe = WS_E1 + ((size_t)(row0 + t0) * 128 + (size_t)e * 8) * 2;
        v[k] = *(const GAS u32x4*)(a.ws + (c < 1584 ? offz : offe)); }
}
__device__ __forceinline__ void s1_stage_store(LAS unsigned char* L, int tid, int d, int q, int ck, const u32x4 (&stg)[6], f32x2_t par) {
    const int S = seq_len(q), t0 = ck * 64;
#pragma unroll
    for (int k = 0; k < 6; ++k) { const int c = tid + k * NTHR;
        if (c < 1584) { const int seg = c >> 3, part = c & 7, row = seg / 3, grp = seg - row * 3, t = t0 - 1 + row; const bool ok = t >= 0 && t < S;
            *(LAS u32x4*)(L + O_ZS + (grp * 66 + row) * PZ + part * 16) = ok ? stg[k] : (u32x4){0u, 0u, 0u, 0u}; }
        else if (c < 2608) { const int e = c - 1584, tr = e >> 4, part = e & 15, tau = d == 0 ? tr : 63 - tr;
            *(LAS u32x4*)(L + (part < 8 ? O_TW : O_ADN) + tau * P + (part & 7) * 16) = stg[k]; } }
    if (tid < 480) *(LAS f32x2_t*)(L + O_PAR + tid * 8) = par;
}
__device__ __forceinline__ void s1_item(const Frame& F, const Args& a, int d, int q, int h, int ck, unsigned char* slot, int nd, int nq, int nh, int nck, bool wt, unsigned* publish_prev) {
    LAS unsigned char* L = F.lds;
#if PROBE_S1 >= 0
    unsigned long long pt_last = 0; int pt_n = 0;
#define PST() do { if (F.tid == 0) { const unsigned long long n_ = __builtin_amdgcn_s_memrealtime(); if (pt_n == PROBE_S1 + 1) *(LAS unsigned long long*)(L + PTRS_OFF - 64) += n_ - pt_last; pt_last = n_; } ++pt_n; } while (0)
#else
#define PST() do { } while (0)
#endif
    PST();
    int lane_ = F.lane; asm volatile("" : "+v"(lane_));
    const int lane = lane_, w = F.wave, tid = w * 64 + lane, r32 = lane & 31, hi = lane >> 5;
    const int j = lane, tg = w;
    const int row0 = seq_row0(q), S = seq_len(q), t0 = ck * 64;
    const bf16_t* Zs = (const bf16_t*)(a.ws + WS_Z) + (size_t)row0 * ZP; (void)Zs; (void)S;
    const int t_lo = d == 0 ? t0 + 8 * tg : t0 + 56 - 8 * tg;
    const int tau0 = 8 * tg;
#define TAU(u) (d == 0 ? tau0 + (u) : tau0 + 7 - (u))
    const int ch = h * 64 + j; (void)ch;
    bf16x8 wfr[4];
    { const int which = w >> 2, mt = (w >> 1) & 1;
      const bf16_t* WT = (const bf16_t*)(a.ws + WS_LORA) + (which ? 2 * 512 * 64 : 0) + ((size_t)d * 512 + h * 64 + 32 * mt + r32) * 64;
#pragma unroll
      for (int ks = 0; ks < 4; ++ks) wfr[ks] = *(const bf16x8*)(WT + 16 * ks + 8 * hi); }
    u32x4 stg[6]; s1_stage_load(a, tid, nq, nh, nck, stg); const f32x2_t par = s1_param_load(L, tid, nd, nh);
#define PAR(seg, idx) (*(const LAS float*)(L + O_PAR + ((seg) * 64 + (idx)) * 4))
    const LAS unsigned char* zsb = L + O_ZS + (t_lo - t0) * PZ + j * 2;
#define LD10(z, g) do { _Pragma("unroll") for (int i_ = 0; i_ < 10; ++i_) z[i_] = bf2f(*(const LAS bf16_t*)(zsb + ((g) * 66 + i_) * PZ)); } while (0)
    {
        const int which = w >> 2, mt = (w >> 1) & 1, nt = w & 1;
        const LAS unsigned char* B = L + (which ? O_ADN : O_TW);
        f32x16 acc = f32x16{};
#pragma unroll
        for (int ks = 0; ks < 4; ++ks) { const bf16x8 bv = *(const LAS bf16x8*)(B + (32 * nt + r32) * P + (16 * ks + 8 * hi) * 2);
            acc = __builtin_amdgcn_mfma_f32_32x32x16_bf16(wfr[ks], bv, acc, 0, 0, 0); }
        LAS unsigned char* O = L + (which ? O_AR : O_WL) + (32 * nt + r32) * PF;
#pragma unroll
        for (int g = 0; g < 4; ++g) { const int jj = 8 * g + 4 * hi; const f32x4 bv = *(const LAS f32x4*)(L + O_PAR + ((10 + which) * 64 + 32 * mt + jj) * 4);
            *(LAS f32x4*)(O + (32 * mt + jj) * 4) = (f32x4){acc[4 * g] + bv[0], acc[4 * g + 1] + bv[1], acc[4 * g + 2] + bv[2], acc[4 * g + 3] + bv[3]}; }
    }
    LBAR(); PST();
    float aa[8], bb[8], rr[8], kd[8], vv[8], ld[8];
    {
        float zr[10], zk[10], zv[10]; LD10(zr, 0); LD10(zk, 1); LD10(zv, 2);
        const float mpr = PAR(0, j), mnr = PAR(1, j), mpk = PAR(2, j), mnk = PAR(3, j), mpv = PAR(4, j), mnv = PAR(5, j);
        const float kkc = PAR(12, j), kac = PAR(13, j), rkc = PAR(14, j);
        float* bon = (float*)(a.ws + WS_BONUS) + ((size_t)d * MTOK + row0) * 8 + h;
#pragma unroll
        for (int u = 0; u < 8; ++u) { const int tau = TAU(u);
            const float wl = *(const LAS float*)(L + O_WL + tau * PF + j * 4), ar = *(const LAS float*)(L + O_AR + tau * PF + j * 4);
            ld[u] = -0.6065306597126334f * sigmoidf_(wl); const float arate = sigmoidf_(ar);
            rr[u] = tshift(zr, u, mpr, mnr); const float k0 = tshift(zk, u, mpk, mnk); vv[u] = tshift(zv, u, mpv, mnv);
            const float kkr = k0 * kkc; const float ssq = wave_sum_dpp(kkr * kkr); const float kkn = kkr * __builtin_amdgcn_rsqf(ssq + 1e-12f);
            kd[u] = k0 * (1.0f + (arate - 1.0f) * kac); aa[u] = -kkn; bb[u] = kkn * arate;
            const float bsum = wave_sum_dpp(rr[u] * kd[u] * rkc);
            if (lane == 0) bon[(size_t)(t_lo + u) * 8] = bsum; }
        float tot = 0.f;
#pragma unroll
        for (int u = 0; u < 8; ++u) tot += ld[u];
        *(LAS float*)(L + O_GSUM + tg * 256 + j * 4) = tot;
    }
    LBAR(); PST();
    {
        float pre = 0.f, cC = 0.f;
#pragma unroll
        for (int g = 0; g < 8; ++g) { const float s = *(const LAS float*)(L + O_GSUM + g * 256 + j * 4); cC += s; if (g < tg) pre += s; }
        float tot = 0.f;
#pragma unroll
        for (int u = 0; u < 8; ++u) tot += ld[u];
        float At[8], Vt[8], Bh[8], Kh[8]; float pf = 0.f;
#pragma unroll
        for (int u = 0; u < 8; ++u) { pf += ld[u]; const int tau = TAU(u);
            const float cl = pre + (d == 0 ? pf : tot - pf + ld[u]);
            const float e_m1 = __expf(cl - ld[u]), e_p = __expf(cl), e_n = __expf(-cl), e_c = __expf(cC - cl);
            At[u] = aa[u] * e_m1; Vt[u] = vv[u]; Bh[u] = bb[u] * e_c; Kh[u] = kd[u] * e_c;
            *(LAS bf16_t*)(L + O_AT + tau * P + j * 2) = f2bf(At[u]); *(LAS bf16_t*)(L + O_RT + tau * P + j * 2) = f2bf(rr[u] * e_p);
            *(LAS bf16_t*)(L + O_BT + tau * P + j * 2) = f2bf(bb[u] * e_n); *(LAS bf16_t*)(L + O_KT + tau * P + j * 2) = f2bf(kd[u] * e_n); }
#define PK8(dst, X) do { u32x4 w_; _Pragma("unroll") for (int k = 0; k < 4; ++k) { const float x0 = d == 0 ? X[2 * k] : X[7 - 2 * k], x1 = d == 0 ? X[2 * k + 1] : X[6 - 2 * k]; w_[k] = cvt_pk_bf16(x0, x1); } \
            *(LAS u32x4*)(L + (dst) + j * P + tau0 * 2) = w_; } while (0)
        PK8(O_ATT, At); PK8(O_VT, Vt); PK8(O_BHT, Bh); PK8(O_KHT, Kh);
#undef PK8
        if (tg == 0) *(LAS float*)(L + O_WC + j * 4) = __expf(cC);
    }
    LBAR(); PST();
#pragma unroll
    for (int i = 0; i < 2; ++i) {
        const int ti = 2 * w + i, ms = ti >> 2, nl = ti & 3;
        const int sb = 32 * (ms & 1), tb = 32 * (nl & 1);
        f32x16 acc = f32x16{};
        if (sb <= tb) acc = mm_ll(L + (ms < 2 ? O_BT : O_KT), sb, L + (nl < 2 ? O_AT : O_RT), tb, acc, r32, hi);
        const bool incl = nl >= 2; const int dst = ms < 2 ? (nl < 2 ? O_LAB : O_ARB) : (nl < 2 ? O_LAK : O_ARK);
        const int t = tb + r32;
#pragma unroll
        for (int g = 0; g < 4; ++g) { const int s0 = sb + 8 * g + 4 * hi; float v[4];
#pragma unroll
            for (int e = 0; e < 4; ++e) { const int s = s0 + e; v[e] = (incl ? (s <= t) : (s < t)) ? acc[4 * g + e] : 0.f; }
            st4(L + dst + t * P + s0 * 2, v[0], v[1], v[2], v[3]);
            if (dst == O_LAB && (s0 >> 4) == (t >> 4)) *(LAS f32x4*)(L + O_LABD + (((t >> 4) * 16 + (t & 15)) * 16 + (s0 & 15)) * 4) = (f32x4){v[0], v[1], v[2], v[3]}; }
    }
    LBAR(); PST();
    if (w < 4) {
        const int mt = w >> 1, nt = w & 1; f32x16 acc = f32x16{};
        acc = mm_ll(L + O_LAK, 32 * mt, L + O_VT, 32 * nt, acc, r32, hi);
#pragma unroll
        for (int g = 0; g < 4; ++g) st4(L + O_XT + (32 * nt + r32) * P + (32 * mt + 8 * g + 4 * hi) * 2, acc[4 * g], acc[4 * g + 1], acc[4 * g + 2], acc[4 * g + 3]);
    } else if (w == 7) {
        const int blk = lane >> 4, cc = lane & 15; float x[16];
#pragma unroll
        for (int t = 0; t < 16; ++t) { float s = (t == cc) ? 1.f : 0.f; const LAS float* lr = (const LAS float*)(L + O_LABD + ((blk * 16 + t) * 16) * 4);
#pragma unroll
            for (int k = 0; k < t; ++k) s += lr[k] * x[k];
            x[t] = s; *(LAS bf16_t*)(L + O_TII + ((blk * 16 + t) * 16 + cc) * 2) = f2bf(s); }
    }
    LBAR(); PST();
    {
        const int c16 = lane & 15, q4 = lane >> 4;
        const LAS unsigned char* RT = L + (w < 4 ? O_ATT : O_XT) + (16 * (w & 3) + c16) * P;
        LAS unsigned char* OT = L + (w < 4 ? O_ABT : O_U0T) + (16 * (w & 3) + c16) * P;
        const LAS unsigned char* LA = L + O_LAB + c16 * P;
#define RHS(i) ({ const u32x2 r_ = *(const LAS u32x2*)(RT + (16 * (i) + 4 * q4) * 2); (f32x4){bflo(r_.x), bfhi(r_.x), bflo(r_.y), bfhi(r_.y)}; })
#define AFR(i, k1, k2) ({ const u32x2 lo_ = *(const LAS u32x2*)(LA + 16 * (i) * P + (16 * (k1) + 4 * q4) * 2); u32x2 hi_ = {0u, 0u}; if ((k2) >= 0) hi_ = *(const LAS u32x2*)(LA + 16 * (i) * P + (16 * ((k2) < 0 ? 0 : (k2)) + 4 * q4) * 2); \
        __builtin_bit_cast(bf16x8, (u32x4){lo_.x, lo_.y, hi_.x, hi_.y}); })
#define TFR(i) ({ const u32x2 lo_ = *(const LAS u32x2*)(L + O_TII + (((i) * 16 + c16) * 16 + 4 * q4) * 2); __builtin_bit_cast(bf16x8, (u32x4){lo_.x, lo_.y, 0u, 0u}); })
#define BFR(U1, U2) __builtin_bit_cast(bf16x8, (u32x4){cvt_pk_bf16(U1[0], U1[1]), cvt_pk_bf16(U1[2], U1[3]), cvt_pk_bf16(U2[0], U2[1]), cvt_pk_bf16(U2[2], U2[3])})
#define MF16(A_, B_, C_) __builtin_amdgcn_mfma_f32_16x16x32_bf16(A_, B_, C_, 0, 0, 0)
        const f32x4 zero4 = {0.f, 0.f, 0.f, 0.f};
        f32x4 U0 = MF16(TFR(0), BFR(RHS(0), zero4), zero4);
        f32x4 Z1 = MF16(AFR(1, 0, -1), BFR(U0, zero4), RHS(1));
        f32x4 U1 = MF16(TFR(1), BFR(Z1, zero4), zero4);
        f32x4 Z2 = MF16(AFR(2, 0, 1), BFR(U0, U1), RHS(2));
        f32x4 U2 = MF16(TFR(2), BFR(Z2, zero4), zero4);
        f32x4 Z3 = MF16(AFR(3, 0, 1), BFR(U0, U1), RHS(3));
        Z3 = MF16(AFR(3, 2, -1), BFR(U2, zero4), Z3);
        f32x4 U3 = MF16(TFR(3), BFR(Z3, zero4), zero4);
        st4(OT + (0 + 4 * q4) * 2, U0[0], U0[1], U0[2], U0[3]); st4(OT + (16 + 4 * q4) * 2, U1[0], U1[1], U1[2], U1[3]);
        st4(OT + (32 + 4 * q4) * 2, U2[0], U2[1], U2[2], U2[3]); st4(OT + (48 + 4 * q4) * 2, U3[0], U3[1], U3[2], U3[3]);
#undef RHS
#undef AFR
#undef TFR
#undef BFR
#undef MF16
    }
    if (publish_prev) asm volatile("s_waitcnt vmcnt(0)" ::: "memory");
    LBAR(); PST();
    if (publish_prev && tid == 0) __hip_atomic_fetch_add(publish_prev, 1u, __ATOMIC_RELAXED, __HIP_MEMORY_SCOPE_AGENT);
    {
        const int mt = (w >> 1) & 1, nt = w & 1;
        if (w < 4) {
            f32x16 acc = f32x16{};
            acc = mm_ll(L + O_ABT, 32 * mt, L + O_BHT, 32 * nt, acc, r32, hi);
            if (mt == nt) { const float wc = *(const LAS float*)(L + O_WC + (32 * nt + r32) * 4);
#pragma unroll
                for (int r = 0; r < 16; ++r) if (crow(r, hi) == r32) acc[r] += wc; }
            store_native(slot + (mt * 2 + nt) * 2048, acc, lane, wt);
            f32x16 rb;
#pragma unroll
            for (int g = 0; g < 4; ++g) { const u32x2 r_ = *(const LAS u32x2*)(L + O_RT + (32 * nt + r32) * P + (32 * mt + 8 * g + 4 * hi) * 2);
                rb[4 * g] = bflo(r_.x); rb[4 * g + 1] = bfhi(r_.x); rb[4 * g + 2] = bflo(r_.y); rb[4 * g + 3] = bfhi(r_.y); }
            rb = mm_ll(L + O_ABT, 32 * mt, L + O_ARB, 32 * nt, rb, r32, hi);
            store_native(slot + 16384 + (mt * 2 + nt) * 2048, rb, lane, wt);
        } else {
            f32x16 acc = f32x16{};
            acc = mm_ll(L + O_BHT, 32 * mt, L + O_U0T, 32 * nt, acc, r32, hi);
            acc = mm_ll(L + O_KHT, 32 * mt, L + O_VT, 32 * nt, acc, r32, hi);
            store_native(slot + 8192 + (mt * 2 + nt) * 2048, acc, lane, wt);
            f32x16 y0 = f32x16{};
            y0 = mm_ll(L + O_ARB, 32 * mt, L + O_U0T, 32 * nt, y0, r32, hi);
            y0 = mm_ll(L + O_ARK, 32 * mt, L + O_VT, 32 * nt, y0, r32, hi);
            store_native(slot + 24576 + (mt * 2 + nt) * 2048, y0, lane, wt);
        }
    }
    LBAR(); PST();
    s1_stage_store(L, tid, nd, nq, nck, stg, par);
    LBAR(); PST();
#undef PAR
#undef TAU
#undef LD10
#undef PST
}

__device__ __forceinline__ void s23_wait_round(unsigned* ready, int r, int lane) {
    unsigned spins = 0;
    while ((unsigned)__builtin_amdgcn_readfirstlane(__hip_atomic_load(ready + r, __ATOMIC_RELAXED, __HIP_MEMORY_SCOPE_AGENT)) < 16u) { __builtin_amdgcn_s_sleep(8); if (++spins > (1u << 22)) break; }
    __builtin_amdgcn_fence(__ATOMIC_ACQUIRE, "agent");
    asm volatile("s_waitcnt vmcnt(0)" ::: "memory");
}
__device__ __forceinline__ void s23_chain_wg(const Frame& F, const Args& a, int d, int q, int h, unsigned char* slots  , unsigned* ready) {
    LAS unsigned char* L = F.lds;
    const int lane = F.lane, w = F.wave, icb = w & 1;
    const int NC = seq_len(q) / 64;
    f32x16 X0 = f32x16{}, X1 = f32x16{};
    const bool loader = w >= 4, compute = w < 2;
    constexpr int D = 6;
#define CKOF(cc) (d == 0 ? (cc) : NC - 1 - (cc))
#define S23_DMA(cc) do { const unsigned char* src_ = slots + (size_t)CKOF(cc) * SLOT_BYTES + (w - 4) * 4096 + lane * 16; LAS unsigned char* dst_ = L + ((cc) & 7) * 16384 + (w - 4) * 4096; \
        _Pragma("unroll") for (int p_ = 0; p_ < 4; ++p_) __builtin_amdgcn_global_load_lds((const unsigned*)(src_ + p_ * 1024), (LAS unsigned*)(dst_ + p_ * 1024), 16, 0, 0); } while (0)
#define UNPK(dst, w0, w1) do { _Pragma("unroll") for (int q_ = 0; q_ < 4; ++q_) { dst[2 * q_] = bflo(w0[q_]); dst[2 * q_ + 1] = bfhi(w0[q_]); dst[8 + 2 * q_] = bflo(w1[q_]); dst[9 + 2 * q_] = bfhi(w1[q_]); } } while (0)
    if (ready) { if (w == 4) s23_wait_round(ready, 0, lane); asm volatile("s_waitcnt lgkmcnt(0)\n\ts_barrier" ::: "memory"); }
    if (loader) {
#pragma unroll
        for (int c0 = 0; c0 < D; ++c0) if (c0 < NC) S23_DMA(c0); }
#pragma unroll 1
    for (int cc = 0; cc < NC; ++cc) {
        if (ready && w == 4 && ((cc + D) & 15) == 0 && cc + D < NC) s23_wait_round(ready, (cc + D) >> 4, lane);
        if (loader) { const int later = NC - 1 - cc;
            if (later >= 5) asm volatile("s_waitcnt vmcnt(20)" ::: "memory"); else if (later == 4) asm volatile("s_waitcnt vmcnt(16)" ::: "memory"); else if (later == 3) asm volatile("s_waitcnt vmcnt(12)" ::: "memory");
            else if (later == 2) asm volatile("s_waitcnt vmcnt(8)" ::: "memory"); else if (later == 1) asm volatile("s_waitcnt vmcnt(4)" ::: "memory"); else asm volatile("s_waitcnt vmcnt(0)" ::: "memory"); }
        asm volatile("s_waitcnt lgkmcnt(0)\n\ts_barrier" ::: "memory");
        if (loader) { if (cc + D < NC) S23_DMA(cc + D); }
        if (compute) {
            const LAS unsigned char* sl = L + (cc & 7) * 16384 + lane * 32;
            u32x4 mw[4][2], dw[2][2];
#pragma unroll
            for (int t = 0; t < 4; ++t) { mw[t][0] = *(const LAS u32x4*)(sl + t * 2048); mw[t][1] = *(const LAS u32x4*)(sl + t * 2048 + 16); }
#pragma unroll
            for (int t = 0; t < 2; ++t) { dw[t][0] = *(const LAS u32x4*)(sl + 8192 + (t * 2 + icb) * 2048); dw[t][1] = *(const LAS u32x4*)(sl + 8192 + (t * 2 + icb) * 2048 + 16); }
            __builtin_amdgcn_sched_barrier(0);
            u32x4 xw[2][2];
#pragma unroll
            for (int s = 0; s < 2; ++s) {
                xw[0][s] = (u32x4){cvt_pk_bf16(X0[8 * s], X0[8 * s + 1]), cvt_pk_bf16(X0[8 * s + 2], X0[8 * s + 3]), cvt_pk_bf16(X0[8 * s + 4], X0[8 * s + 5]), cvt_pk_bf16(X0[8 * s + 6], X0[8 * s + 7])};
                xw[1][s] = (u32x4){cvt_pk_bf16(X1[8 * s], X1[8 * s + 1]), cvt_pk_bf16(X1[8 * s + 2], X1[8 * s + 3]), cvt_pk_bf16(X1[8 * s + 4], X1[8 * s + 5]), cvt_pk_bf16(X1[8 * s + 6], X1[8 * s + 7])}; }
            { unsigned char* xo = slots + (size_t)CKOF(cc) * SLOT_BYTES + ((icb * 2) * 64 + lane) * 32;
              *(u32x4*)(xo) = xw[0][0]; *(u32x4*)(xo + 16) = xw[0][1]; *(u32x4*)(xo + 2048) = xw[1][0]; *(u32x4*)(xo + 2048 + 16) = xw[1][1]; }
            asm volatile("s_waitcnt lgkmcnt(0)" ::: "memory");
            __builtin_amdgcn_sched_barrier(0);
            f32x16 N0, N1;
            UNPK(N0, dw[0][0], dw[0][1]); UNPK(N1, dw[1][0], dw[1][1]);
#pragma unroll
            for (int rb = 0; rb < 2; ++rb)
#pragma unroll
                for (int s = 0; s < 2; ++s) {
                    N0 = __builtin_amdgcn_mfma_f32_32x32x16_bf16(__builtin_bit_cast(bf16x8, mw[rb * 2 + 0][s]), __builtin_bit_cast(bf16x8, xw[rb][s]), N0, 0, 0, 0);
                    N1 = __builtin_amdgcn_mfma_f32_32x32x16_bf16(__builtin_bit_cast(bf16x8, mw[rb * 2 + 1][s]), __builtin_bit_cast(bf16x8, xw[rb][s]), N1, 0, 0, 0); }
            X0 = N0; X1 = N1;
        }
    }
    asm volatile("s_waitcnt vmcnt(0) lgkmcnt(0)\n\ts_barrier" ::: "memory");
#undef UNPK
#undef S23_DMA
#undef CKOF
}

constexpr int PO_V = 0, PO_G = PO_V + 66 * 144, PO_Y = PO_G + 66 * 272, PO_SG = PO_Y + 2 * 64 * 272, PO_GF = PO_SG + 64 * 272, PO_END = PO_GF + 64 * 272;
static_assert(PO_END <= PTRS_OFF - 64, "post lds");
struct PostPre { u32x4 stg[4]; u32x4 ra[2][2], xb[2][2], yc[2]; };
__device__ __forceinline__ void post_decode(int c, int& reg, int& row, int& part) {
    if (c < 528) { reg = 0; row = c >> 3; part = c & 7; } else { reg = 1; row = (c - 528) >> 4; part = (c - 528) & 15; }
}
__device__ __forceinline__ void post_stage_load(const Args& a, int tid, int q, int h, int blk, PostPre& pp) {
    const int row0 = seq_row0(q), S = seq_len(q), t0 = blk * 64;
    const bf16_t* Zs = (const bf16_t*)(a.ws + WS_Z) + (size_t)row0 * ZP;
#pragma unroll
    for (int k = 0; k < 4; ++k) { const int c = tid + k * NTHR; int reg, row, part; post_decode(c, reg, row, part);
        const int t = t0 - 1 + row; const int col = reg == 0 ? ZRV + h * 64 : ZGD;
        pp.stg[k] = (u32x4){0u, 0u, 0u, 0u};
        if (c < 1584 && t >= 0 && t < S) pp.stg[k] = *(const u32x4*)(Zs + (size_t)t * ZP + col + part * 8); }
    const int w = tid >> 6, lane = tid & 63, dd = w >> 2, tb = (w >> 1) & 1, icb = w & 1;
    const size_t si = q == 0 ? (size_t)(dd * 8 + h) * 256 + blk : (size_t)((dd * 8 + (q - 1)) * 8 + h) * 32 + blk;
    const unsigned char* sl = (const unsigned char*)a.out + si * SLOT_BYTES + lane * 32;
#pragma unroll
    for (int rb = 0; rb < 2; ++rb) { pp.ra[rb][0] = *(const u32x4*)(sl + 16384 + (rb * 2 + tb) * 2048); pp.ra[rb][1] = *(const u32x4*)(sl + 16384 + (rb * 2 + tb) * 2048 + 16);
                                     pp.xb[rb][0] = *(const u32x4*)(sl + (icb * 2 + rb) * 2048); pp.xb[rb][1] = *(const u32x4*)(sl + (icb * 2 + rb) * 2048 + 16); }
    pp.yc[0] = *(const u32x4*)(sl + 24576 + (tb * 2 + icb) * 2048); pp.yc[1] = *(const u32x4*)(sl + 24576 + (tb * 2 + icb) * 2048 + 16);
}
__device__ __forceinline__ void post_item(const Frame& F, const Args& a, int q, int h, int blk, PostPre& pp, int nq, int nh, int nblk) {
    LAS unsigned char* L = F.lds;
    int lane_ = F.lane; asm volatile("" : "+v"(lane_));
    const int lane = lane_, w = F.wave, tid = w * 64 + lane, r32 = lane & 31, hi = lane >> 5, j = lane, tg = w;
    const int row0 = seq_row0(q), t_lo = blk * 64 + 8 * tg;
    bf16_t* Zs = (bf16_t*)(a.ws + WS_Z) + (size_t)row0 * ZP;
    const float* mup = inp(L, 11); const float* mun = inp(L, 12);
    const int chp = h * 64 + j;
    const float mp0 = gld(mup + ZGD - ZRR + j), mn0 = gld(mun + ZGD - ZRR + j), mp1 = gld(mup + ZGD - ZRR + 64 + j), mn1 = gld(mun + ZGD - ZRR + 64 + j);
    const float mpv = gld(mup + 1024 + chp), mnv = gld(mun + 1024 + chp), lg = gld(inp(L, 21) + chp), lb = gld(inp(L, 22) + chp);
    float bsum[8];
    { const float* bon0 = (const float*)(a.ws + WS_BONUS) + (size_t)row0 * 8 + h; const float* bon1 = bon0 + (size_t)MTOK * 8;
#pragma unroll
      for (int u = 0; u < 8; ++u) bsum[u] = bon0[(size_t)(t_lo + u) * 8] + bon1[(size_t)(t_lo + u) * 8]; }
    bf16x8 gfr[8];
    { const bf16_t* GT = (const bf16_t*)(a.ws + WS_LORA) + 4 * 512 * 64 + ((size_t)h * 64 + 32 * ((w >> 1) & 1) + r32) * 128;
#pragma unroll
      for (int ks = 0; ks < 8; ++ks) gfr[ks] = *(const bf16x8*)(GT + 16 * ks + 8 * hi); }
#pragma unroll
    for (int k = 0; k < 4; ++k) { const int c = tid + k * NTHR; int reg, row, part; post_decode(c, reg, row, part);
        const int off = reg == 0 ? PO_V + row * 144 : PO_G + row * 272;
        if (c < 1584) *(LAS u32x4*)(L + off + part * 16) = pp.stg[k]; }
    {
        const int dd = w >> 2, tb = (w >> 1) & 1, icb = w & 1;
        f32x16 Y;
#pragma unroll
        for (int q_ = 0; q_ < 4; ++q_) { Y[2 * q_] = bflo(pp.yc[0][q_]); Y[2 * q_ + 1] = bfhi(pp.yc[0][q_]); Y[8 + 2 * q_] = bflo(pp.yc[1][q_]); Y[9 + 2 * q_] = bfhi(pp.yc[1][q_]); }
#pragma unroll
        for (int rb = 0; rb < 2; ++rb)
#pragma unroll
            for (int s2 = 0; s2 < 2; ++s2) Y = __builtin_amdgcn_mfma_f32_32x32x16_bf16(__builtin_bit_cast(bf16x8, pp.ra[rb][s2]), __builtin_bit_cast(bf16x8, pp.xb[rb][s2]), Y, 0, 0, 0);
#pragma unroll
        for (int r = 0; r < 16; ++r) { const int tau = 32 * tb + (r & 3) + 8 * (r >> 2) + 4 * hi; const int t = dd == 0 ? tau : 63 - tau;
            *(LAS float*)(L + PO_Y + (dd * 64 + t) * 272 + (32 * icb + r32) * 4) = Y[r]; }
    }
    LBAR();
    post_stage_load(a, tid, nq, nh, nblk, pp);
    {
        float z0[10], z1[10];
#pragma unroll
        for (int i = 0; i < 10; ++i) { z0[i] = bf2f(*(const LAS bf16_t*)(L + PO_G + (8 * tg + i) * 272 + j * 2)); z1[i] = bf2f(*(const LAS bf16_t*)(L + PO_G + (8 * tg + i) * 272 + (64 + j) * 2)); }
#pragma unroll
        for (int u = 0; u < 8; ++u) { *(LAS bf16_t*)(L + PO_SG + (8 * tg + u) * 272 + j * 2) = f2bf(sigmoidf_(tshift(z0, u, mp0, mn0)));
                                      *(LAS bf16_t*)(L + PO_SG + (8 * tg + u) * 272 + (64 + j) * 2) = f2bf(sigmoidf_(tshift(z1, u, mp1, mn1))); }
    }
    LBAR();
    if (w < 4) {
        const int mt = w >> 1, nt = w & 1;
        f32x16 acc = f32x16{};
#pragma unroll
        for (int ks = 0; ks < 8; ++ks) { const bf16x8 bv = *(const LAS bf16x8*)(L + PO_SG + (32 * nt + r32) * 272 + (16 * ks + 8 * hi) * 2);
            acc = __builtin_amdgcn_mfma_f32_32x32x16_bf16(gfr[ks], bv, acc, 0, 0, 0); }
#pragma unroll
        for (int g = 0; g < 4; ++g) *(LAS f32x4*)(L + PO_GF + (32 * nt + r32) * 272 + (32 * mt + 8 * g + 4 * hi) * 4) = (f32x4){acc[4 * g], acc[4 * g + 1], acc[4 * g + 2], acc[4 * g + 3]};
    }
    LBAR();
    {
        const int ch = h * 64 + j;
        float zv[10];
#pragma unroll
        for (int i = 0; i < 10; ++i) zv[i] = bf2f(*(const LAS bf16_t*)(L + PO_V + (8 * tg + i) * 144 + j * 2));
#pragma unroll
        for (int u = 0; u < 8; ++u) { const int t = t_lo + u;
            const float y = *(const LAS float*)(L + PO_Y + (8 * tg + u) * 272 + j * 4) + *(const LAS float*)(L + PO_Y + (64 + 8 * tg + u) * 272 + j * 4);
            const float mean = wave_sum_dpp(y) * (1.f / 64.f); const float dv = y - mean; const float var = wave_sum_dpp(dv * dv) * (1.f / 64.f);
            const float yn = dv * __builtin_amdgcn_rsqf(var + LNX_EPS) * lg + lb;
            const float g = *(const LAS float*)(L + PO_GF + (8 * tg + u) * 272 + j * 4);
            Zs[(size_t)t * ZP + ZRR + ch] = f2bf((yn + bsum[u] * tshift(zv, u, mpv, mnv)) * g); }
    }
    LBAR();
}
}


#define XB_TMO      128
#define XB_XCNT(j)  (256  + 64 * (j))
#define XB_XSUB(j)  (1280 + 64 * (j))
#define XB_XGEN(j)  (2304 + 64 * (j))
#define XB_TOP      3328
#define XB_TOPGEN   3392
#define XCD_BAR_WORDS 3456
#define XB_SPIN_CAP (1u << 20)
constexpr size_t CTL_ZERO_BYTES = 16384;
__device__ __forceinline__ unsigned xb_ld(unsigned* p)              { return __hip_atomic_load(p, __ATOMIC_RELAXED, __HIP_MEMORY_SCOPE_AGENT); }
__device__ __forceinline__ unsigned xb_add(unsigned* p, unsigned v) { return __hip_atomic_fetch_add(p, v, __ATOMIC_RELAXED, __HIP_MEMORY_SCOPE_AGENT); }
__device__ __forceinline__ unsigned xb_xcc_id() { return (unsigned)__builtin_amdgcn_s_getreg((3 << 11) | 20) & 0xFu; }
#define XB_SPIN(cond, bar) do { unsigned _sp = 0; while (cond) { __builtin_amdgcn_s_sleep(1); \
    if ((++_sp & 255u) == 0u) { if (xb_ld(&(bar)[XB_TMO])) break; if (_sp > XB_SPIN_CAP) { atomicAdd(&(bar)[XB_TMO], 1u); break; } } } } while (0)
struct XcdBarrier { unsigned* bar; unsigned x; volatile LAS unsigned* st; };
__device__ __forceinline__ XcdBarrier xcd_barrier_post(unsigned* bar, volatile LAS unsigned* st) {
    XcdBarrier b; b.bar = bar; b.x = xb_xcc_id(); b.st = st;
    if (threadIdx.x == 0) (void)xb_add(&bar[XB_XCNT(b.x)], 1u);
    return b;
}
__device__ __forceinline__ void xcd_barrier_complete(unsigned* bar, unsigned x, unsigned& nloc, unsigned& nx) {
    const unsigned G = gridDim.x * gridDim.y * gridDim.z;
    unsigned sum, cnt, mine, sp = 0u;
    for (;;) {
        sum = 0u; cnt = 0u; mine = 0u;
#pragma unroll
        for (unsigned j = 0; j < 16; ++j) { const unsigned c = xb_ld(&bar[XB_XCNT(j)]); sum += c; cnt += (c > 0u) ? 1u : 0u; mine = (j == x) ? c : mine; }
        if (sum == G) break;
        __builtin_amdgcn_s_sleep(1);
        if ((++sp & 255u) == 0u) { if (xb_ld(&bar[XB_TMO])) break; if (sp > XB_SPIN_CAP) { atomicAdd(&bar[XB_TMO], 1u); break; } }
    }
    nloc = mine > 0u ? mine : 1u; nx = cnt > 0u ? cnt : 1u;
}
__device__ __forceinline__ void xcd_barrier(const XcdBarrier& b) {
    asm volatile("s_waitcnt vmcnt(0)" ::: "memory");
    __syncthreads();
    if (threadIdx.x == 0) {
        unsigned* bar = b.bar;
        __builtin_amdgcn_s_waitcnt(0);
        unsigned nloc = b.st[0], nx = b.st[1];
        if (nloc == 0u) { xcd_barrier_complete(bar, b.x, nloc, nx); b.st[0] = nloc; b.st[1] = nx; }
        const unsigned old = xb_add(&bar[XB_XSUB(b.x)], 1u);
        const unsigned gen = old / nloc;
        if (old + 1u == (gen + 1u) * nloc) {
            __builtin_amdgcn_fence(__ATOMIC_RELEASE, "agent");
            asm volatile("s_waitcnt vmcnt(0)" ::: "memory");
            const unsigned og = xb_add(&bar[XB_TOP], 1u);
            const unsigned tg = og / nx;
            if (og + 1u == (tg + 1u) * nx) xb_add(&bar[XB_TOPGEN], 1u);
            else XB_SPIN(xb_ld(&bar[XB_TOPGEN]) == tg, bar);
            __builtin_amdgcn_fence(__ATOMIC_ACQUIRE, "agent");
            xb_add(&bar[XB_XGEN(b.x)], 1u);
            asm volatile("s_waitcnt vmcnt(0)" ::: "memory");
        } else {
            XB_SPIN(xb_ld(&bar[XB_XGEN(b.x)]) == gen, bar);
            __builtin_amdgcn_fence(__ATOMIC_ACQUIRE, "agent");
            asm volatile("s_waitcnt vmcnt(0)" ::: "memory");
        }
    }
    __syncthreads();
}

constexpr int NPHASE = 10;
constexpr int NOJUMP = 1 << 30;
template <int LO, int HI>
__global__ void __launch_bounds__(NTHR, 2) fwd_kernel(Args a) {
    extern __shared__ __attribute__((aligned(16))) unsigned char lds_raw[];
    Frame F; F.lds = (LAS unsigned char*)lds_raw; F.tid = threadIdx.x; F.lane = F.tid & 63; F.wave = __builtin_amdgcn_readfirstlane(F.tid >> 6);
    F.G = gridDim.x; { const int bx = blockIdx.x; F.vcu = (F.G % 8 == 0) ? (bx % 8) * (F.G / 8) + bx / 8 : bx; }
    unsigned char* ws = a.ws; bf16_t* Z = (bf16_t*)(ws + WS_Z);
    unsigned char* slots = (unsigned char*)a.out;
    if (F.tid == 0) {
#pragma unroll
        for (int i = 0; i < 27; ++i) *(const float* LAS*)(F.lds + PTRS_OFF + i * 8) = a.in[i];
        *(volatile LAS unsigned*)(F.lds + PTRS_OFF + 224) = 0u; *(volatile LAS unsigned*)(F.lds + PTRS_OFF + 228) = 0u;
        *(LAS unsigned long long*)(F.lds + PTRS_OFF - 64) = 0ull;
    }
    __syncthreads();
#if ONE_LAUNCH && !USE_CG
    const XcdBarrier bar = xcd_barrier_post((unsigned*)(ws + WS_CTL), (volatile LAS unsigned*)(F.lds + PTRS_OFF + 224));
#endif
#if ONE_LAUNCH
#if PROBE_SEG >= 0 || PROBE_CLK >= 0
    unsigned long long* tsb = (unsigned long long*)(ws + WS_CTL + 15872); int nts = 0;
#define STAMP() do { if (blockIdx.x == 0 && F.tid == 0) { tsb[nts] = __builtin_amdgcn_s_memrealtime(); tsb[32 + nts] = __builtin_amdgcn_s_memtime(); } ++nts; } while (0)
    STAMP();
#else
#define STAMP() do { } while (0)
#endif
#if USE_CG
#define SEAM(k) do { if constexpr ((k) + 1 < HI) { cg::this_grid().sync(); STAMP(); } } while (0)
#define RSYNC() do { cg::this_grid().sync(); STAMP(); } while (0)
#else
#define SEAM(k) do { if constexpr ((k) + 1 < HI) { xcd_barrier(bar); STAMP(); } } while (0)
#define RSYNC() do { xcd_barrier(bar); STAMP(); } while (0)
#endif
#else
#define SEAM(k) do { } while (0)
#define RSYNC() do { } while (0)
#endif
#define IN(k) (LO <= (k) && (k) < HI)
    if constexpr (IN(0)) { p0_prologue(F, a); SEAM(0);
#if PROBE_DOUBLE == 4
        p0_prologue(F, a); RSYNC();
#endif
    }
    if constexpr (IN(1)) { pg8::Gemm g{(const char*)a.out, (const bf16_t*)(ws + WS_WIN), MTOK, ZP, DM, DM * 2, NOJUMP, 0}; pg8::StaticOrder S; S.init(MTOK, ZP, F.G, (int)blockIdx.x);
        pg8::EpiZ E{Z, ZP}; pg8::gemm_phase<pg8::EpiZ, pg8::StaticOrder, true>(F.lds, g, S, E); SEAM(1);
#if PROBE_DOUBLE == 3
        pg8::gemm_phase<pg8::EpiZ, pg8::StaticOrder, true>(F.lds, g, S, E); RSYNC();
#endif
    }
    if constexpr (IN(2)) { qk_prep(F, a);
        unsigned* rdy = (unsigned*)(ws + WS_CTL) + 3584;
#pragma unroll 1
        for (int rnd = 0; rnd < 2; ++rnd) {
            const int nprod = rnd == 1 ? F.G - 16 : F.G;
            if (F.vcu < nprod) {
#define S1_DECODE(i_, d_, q_, h_, ck_, it_, pub_) do { if (rnd == 1) { const int c_ = ((i_) >> 4) & 15, cc_ = (((i_) >> 8) << 4) + ((i_) & 15); d_ = c_ >> 3; h_ = c_ & 7; q_ = 0; ck_ = d_ ? 255 - cc_ : cc_; it_ = c_ * 256 + ck_; pub_ = rdy + c_ * 16 + ((i_) >> 8); } \
                    else { ck_ = (i_) & 31; h_ = ((i_) >> 5) & 7; q_ = 1 + (((i_) >> 8) & 7); d_ = (i_) >> 11; it_ = (i_); pub_ = nullptr; } } while (0)
                { int d, q, h, ck, it; unsigned* pub; S1_DECODE(F.vcu, d, q, h, ck, it, pub); (void)it; (void)pub;
                  u32x4 stg[6]; rw::s1_stage_load(a, F.tid, q, h, ck, stg); const f32x2_t par = rw::s1_param_load(F.lds, F.tid, d, h);
                  rw::s1_stage_store(F.lds, F.tid, d, q, ck, stg, par); LBAR(); }
                unsigned* pub_prev = nullptr;
#pragma unroll 1
                for (int i = F.vcu; i < 4096; i += nprod) {
                    int d, q, h, ck, it, nd, nq, nh, nck, nit; unsigned* pub; unsigned* npub; S1_DECODE(i, d, q, h, ck, it, pub); const int ni = i + nprod < 4096 ? i + nprod : i; S1_DECODE(ni, nd, nq, nh, nck, nit, npub); (void)nit; (void)npub;
                    rw::s1_item(F, a, d, q, h, ck, slots + (size_t)it * SLOT_BYTES, nd, nq, nh, nck, rnd == 1, pub_prev); pub_prev = pub; }
                if (pub_prev) { asm volatile("s_waitcnt vmcnt(0)" ::: "memory"); __syncthreads(); if (F.tid == 0) __hip_atomic_fetch_add(pub_prev, 1u, __ATOMIC_RELAXED, __HIP_MEMORY_SCOPE_AGENT); }
#undef S1_DECODE
            } else {
                const int c = F.vcu - nprod;
                rw::s23_chain_wg(F, a, c >> 3, 0, c & 7, slots + (size_t)c * 256 * SLOT_BYTES, rdy + c * 16);
            }
            if (rnd == 0) {
                RSYNC();
                for (int chain = F.vcu; chain < 128; chain += F.G) { const int h = chain & 7, q = 1 + ((chain >> 3) & 7), d = chain >> 6;
                    rw::s23_chain_wg(F, a, d, q, h, slots + (size_t)chain * 32 * SLOT_BYTES, nullptr); }
            }
            RSYNC();
            {
#define PO_DECODE(it_, q_, h_, b_) do { if (rnd == 1) { q_ = 0; h_ = ((it_) >> 8) & 7; b_ = (it_) & 255; } else { q_ = 1 + (((it_) >> 8) & 7); h_ = ((it_) >> 5) & 7; b_ = (it_) & 31; } } while (0)
                rw::PostPre pp;
                { int q, h, b; PO_DECODE(F.vcu, q, h, b); rw::post_stage_load(a, F.tid, q, h, b, pp); }
#pragma unroll 1
                for (int it = F.vcu; it < 2048; it += F.G) { int q, h, b, nq, nh, nb; PO_DECODE(it, q, h, b); const int nit = it + F.G < 2048 ? it + F.G : it; PO_DECODE(nit, nq, nh, nb);
                    rw::post_item(F, a, q, h, b, pp, nq, nh, nb); }
#undef PO_DECODE
            }
            if (rnd == 0) RSYNC();
        }
        SEAM(2); }
    if constexpr (IN(4)) {
        float lam; { const float p1 = wave_sum(a.in[6][F.lane] * a.in[7][F.lane]), p2 = wave_sum(a.in[8][F.lane] * a.in[9][F.lane]); lam = __expf(p1) - __expf(p2) + LAMBDA_INIT; }
#if PROBE_DOUBLE == 1
        for (int v = F.vcu; v < 256; v += F.G) {
            att::attn_unit(0, SP, v >> 6, v & 63, Z, F.lds, lam, a.in[10], (bf16_t*)a.out, 512);
            att::attn_unit(SP + (v >> 5) * SS, SS, (v >> 3) & 3, v & 7, Z, F.lds, lam, a.in[10], (bf16_t*)a.out, 512); }
        RSYNC();
#endif
        for (int v = F.vcu; v < 256; v += F.G) {
            att::attn_unit(0, SP, v >> 6, v & 63, Z, F.lds, lam, a.in[10], Z, ZP);
            att::attn_unit(SP + (v >> 5) * SS, SS, (v >> 3) & 3, v & 7, Z, F.lds, lam, a.in[10], Z, ZP); }
        SEAM(4); }
    if constexpr (IN(5)) { pg8::Gemm g{(const char*)Z, (const bf16_t*)(ws + WS_WOUT), MTOK, DM, DM, ZP * 2, 8, 2048}; pg8::StaticOrder S; S.init(MTOK, DM, F.G, (int)blockIdx.x);
        pg8::EpiOut E{a.in[0], a.in[1], a.out, Z, (float*)(ws + WS_ROWSQ)}; pg8::gemm_phase<pg8::EpiOut, pg8::StaticOrder, true>(F.lds, g, S, E); SEAM(5); }
#define FFN_UP(k, half) if constexpr (IN(k)) { pg8::Gemm g{(const char*)(Z + (size_t)(half) * 16384 * ZP + ZXN2), (const bf16_t*)(ws + WS_W1), 16384, DFF, DM, ZP * 2, NOJUMP, 0}; pg8::StaticOrder S; S.init(16384, DFF, F.G, (int)blockIdx.x); \
        pg8::EpiUp E{(char*)(ws + WS_Z), (const float*)(ws + WS_ROWSQ), (half) * 16384}; pg8::gemm_phase<pg8::EpiUp, pg8::StaticOrder, true>(F.lds, g, S, E); SEAM(k); }
#define FFN_DN(k, half) if constexpr (IN(k)) { pg8::Gemm g{(const char*)(ws + WS_Z), (const bf16_t*)(ws + WS_W2), 16384, DM, DFF, 13312, 32, 2560}; pg8::StaticOrder S; S.init(16384, DM, F.G, (int)blockIdx.x); \
        pg8::EpiDown E{a.out, (half) * 16384}; pg8::gemm_phase<pg8::EpiDown, pg8::StaticOrder, true>(F.lds, g, S, E); SEAM(k); }
    FFN_UP(6, 0) FFN_DN(7, 0) FFN_UP(8, 1) FFN_DN(9, 1)
#if PROBE_S1 >= 0 || PROBE_ATT
    if (F.tid == 0) { const unsigned long long dt = *(LAS unsigned long long*)(F.lds + PTRS_OFF - 64), t0_ = __builtin_amdgcn_s_memrealtime();
        while (__builtin_amdgcn_s_memrealtime() - t0_ < dt) __builtin_amdgcn_s_sleep(16); }
#endif
#if PROBE_SEG >= 0 || PROBE_CLK >= 0
    STAMP();
#if PROBE_CLK >= 0
    if (blockIdx.x == 0 && F.tid == 0) { asm volatile("s_waitcnt vmcnt(0)" ::: "memory"); const unsigned long long wt_ = tsb[PROBE_CLK + 1] - tsb[PROBE_CLK], cy_ = tsb[32 + PROBE_CLK + 1] - tsb[32 + PROBE_CLK];
        const unsigned long long dt = cy_ * 1000ull / (wt_ ? wt_ : 1ull), t0_ = __builtin_amdgcn_s_memrealtime();
        while (__builtin_amdgcn_s_memrealtime() - t0_ < dt) __builtin_amdgcn_s_sleep(16); }
#endif
    if (PROBE_CLK < 0 && blockIdx.x == 0 && F.tid == 0) { asm volatile("s_waitcnt vmcnt(0)" ::: "memory"); const unsigned long long dt = tsb[PROBE_SEG + 1] - tsb[PROBE_SEG], t0_ = __builtin_amdgcn_s_memrealtime();
        while (__builtin_amdgcn_s_memrealtime() - t0_ < dt) __builtin_amdgcn_s_sleep(16); }
#endif
#undef FFN_UP
#undef FFN_DN
#undef IN
#undef SEAM
#undef RSYNC
}

extern "C" void kernel_launch(void* const* d_in, const int* in_sizes, int n_in, void* d_out, int out_size, void* d_ws, size_t ws_size, hipStream_t stream) {
    static int grid = 0;
    if (grid == 0) {
        if (n_in != 27 || out_size != MTOK * DM || ws_size < WS_TOTAL) { fprintf(stderr, "kernel_launch: unexpected shapes (n_in %d out %d ws %zu)\n", n_in, out_size, ws_size); grid = -1; return; }
        int dev = 0, cus = 0; (void)hipGetDevice(&dev); (void)hipDeviceGetAttribute(&cus, hipDeviceAttributeMultiprocessorCount, dev);
        bool ok = true;
#if ONE_LAUNCH
        ok = ok && hipFuncSetAttribute((const void*)fwd_kernel<0, NPHASE>, hipFuncAttributeMaxDynamicSharedMemorySize, LDS_BYTES) == hipSuccess;
        int per_cu = 0; (void)hipOccupancyMaxActiveBlocksPerMultiprocessor(&per_cu, (const void*)fwd_kernel<0, NPHASE>, NTHR, LDS_BYTES); (void)hipGetLastError();
        if (per_cu < 1) fprintf(stderr, "kernel_launch: occupancy query says %d blocks/CU\n", per_cu);
#else
#define SETA(p) ok = ok && hipFuncSetAttribute((const void*)fwd_kernel<p, p + 1>, hipFuncAttributeMaxDynamicSharedMemorySize, LDS_BYTES) == hipSuccess;
        SETA(0) SETA(1) SETA(2) SETA(3) SETA(4) SETA(5) SETA(6) SETA(7) SETA(8) SETA(9)
#undef SETA
#endif
        if (!ok) { fprintf(stderr, "kernel_launch: hipFuncSetAttribute failed\n"); grid = -1; return; }
        grid = cus > 256 ? 256 : cus;
    }
    if (grid < 0) return;
    Args a{};
    for (int i = 0; i < 27; ++i) a.in[i] = (const float*)d_in[i];
    a.out = (float*)d_out; a.ws = (unsigned char*)d_ws;
#if ONE_LAUNCH
    a.ph_lo = 0; a.ph_hi = NPHASE;
#if !USE_CG
    if (hipMemsetAsync((char*)d_ws + WS_CTL, 0, CTL_ZERO_BYTES, stream) != hipSuccess) { fprintf(stderr, "kernel_launch: hipMemsetAsync failed\n"); return; }
#endif
    void* args[] = {&a};
    hipError_t e = hipLaunchCooperativeKernel((const void*)fwd_kernel<0, NPHASE>, dim3(grid), dim3(NTHR), args, LDS_BYTES, stream);
    if (e != hipSuccess) fprintf(stderr, "cooperative launch failed: %s (grid %d)\n", hipGetErrorString(e), grid);
#else
#define LAUNCH(p) hipLaunchKernelGGL((fwd_kernel<p, p + 1>), dim3(grid), dim3(NTHR), LDS_BYTES, stream, a);
    LAUNCH(0) LAUNCH(1) LAUNCH(2) LAUNCH(3) LAUNCH(4) LAUNCH(5) LAUNCH(6) LAUNCH(7) LAUNCH(8) LAUNCH(9)
#undef LAUNCH
#endif
}
```

```cpp
#include <hip/hip_runtime.h>
#include <hip/hip_cooperative_groups.h>
#include <cstdio>
#include <cstdint>
namespace cg = cooperative_groups;

#ifndef ONE_LAUNCH
#define ONE_LAUNCH 1
#endif
#ifndef USE_CG
#define USE_CG 0
#endif
#ifndef PROBE_SEG
#define PROBE_SEG -1
#endif
#ifndef PROBE_S1
#define PROBE_S1 -1
#endif
#ifndef PROBE_ATT
#define PROBE_ATT 0
#endif
#ifndef PROBE_CLK
#define PROBE_CLK -1
#endif
#ifndef PROBE_DOUBLE
#define PROBE_DOUBLE 0
#endif

#define LAS __attribute__((address_space(3)))
#define GAS __attribute__((address_space(1)))
typedef unsigned short bf16_t;
typedef short bf16x8 __attribute__((ext_vector_type(8)));
typedef short s16x4 __attribute__((ext_vector_type(4)));
typedef float f32x4 __attribute__((ext_vector_type(4)));
typedef float f32x16 __attribute__((ext_vector_type(16)));
typedef unsigned u32x4 __attribute__((ext_vector_type(4)));
typedef unsigned u32x2 __attribute__((ext_vector_type(2)));
typedef float f32x2_t __attribute__((ext_vector_type(2)));
typedef __bf16 bf16x2_t __attribute__((ext_vector_type(2)));

constexpr int MTOK = 32768, DM = 1024, ZP = 3328, DFF = 4096;
constexpr int SP = 16384, SS = 2048;
constexpr int ZQ = 0, ZK = 512, ZV = 1024, ZRR = 1536, ZRK = 2048, ZRV = 2560, ZWD = 3072, ZAD = 3136, ZGD = 3200;
constexpr int ZXN2 = 2048;
constexpr float NORM_EPS = 1e-6f, LNX_EPS = 64e-5f;
constexpr float QSCALE = 0.125f * 1.4426950408889634f;
constexpr float LAMBDA_INIT = 0.2f;
constexpr int NCHUNK_P = SP / 64, NCHUNK_S = SS / 64;

constexpr size_t MiB = 1u << 20;
constexpr size_t WS_CTL = 0;
constexpr size_t WS_WIN = 1 * MiB, WS_WOUT = 8 * MiB, WS_W1 = 10 * MiB, WS_W2 = 18 * MiB;
constexpr size_t WS_ROPE = 26 * MiB;
constexpr size_t WS_LORA = 30 * MiB;
constexpr size_t WS_ROWSQ = 31 * MiB;
constexpr size_t WS_BONUS = 33 * MiB;
constexpr size_t WS_Z = 36 * MiB;
constexpr size_t WS_END = 244 * MiB;
constexpr size_t WS_E1 = 244 * MiB;
constexpr size_t WS_TOTAL = 252 * MiB;
static_assert(WS_Z + (size_t)MTOK * ZP * 2 <= WS_END, "ws map");
constexpr size_t SLOT_BYTES = 32768;

__device__ __forceinline__ unsigned cvt_pk_bf16(float lo, float hi) { f32x2_t v = {lo, hi}; bf16x2_t b = __builtin_convertvector(v, bf16x2_t); return __builtin_bit_cast(unsigned, b); }
__device__ __forceinline__ float bf2f(unsigned short u) { return __uint_as_float(((unsigned)u) << 16); }
__device__ __forceinline__ float bflo(unsigned u) { return __uint_as_float(u << 16); }
__device__ __forceinline__ float bfhi(unsigned u) { return __uint_as_float(u & 0xffff0000u); }
__device__ __forceinline__ unsigned short f2bf(float f) { return (unsigned short)(cvt_pk_bf16(f, 0.f) & 0xffffu); }
__device__ __forceinline__ float wave_sum(float v) {
#pragma unroll
    for (int o = 1; o < 64; o <<= 1) v += __shfl_xor(v, o);
    return v;
}
__device__ __forceinline__ float wave_sum_dpp(float v) {
    int x = __float_as_int(v);
    v += __int_as_float(__builtin_amdgcn_update_dpp(0, x, 0xB1, 0xF, 0xF, true)); x = __float_as_int(v);
    v += __int_as_float(__builtin_amdgcn_update_dpp(0, x, 0x4E, 0xF, 0xF, true)); x = __float_as_int(v);
    v += __int_as_float(__builtin_amdgcn_update_dpp(0, x, 0x124, 0xF, 0xF, true)); x = __float_as_int(v);
    v += __int_as_float(__builtin_amdgcn_update_dpp(0, x, 0x128, 0xF, 0xF, true)); x = __float_as_int(v);
    const float a = __int_as_float(__builtin_amdgcn_readlane(x, 0)), b = __int_as_float(__builtin_amdgcn_readlane(x, 16)), c = __int_as_float(__builtin_amdgcn_readlane(x, 32)), d = __int_as_float(__builtin_amdgcn_readlane(x, 48));
    return (a + b) + (c + d);
}
#define LDS_WAIT() asm volatile("s_waitcnt lgkmcnt(0)" ::: "memory")
#define VM_WAIT() asm volatile("s_waitcnt vmcnt(0)" ::: "memory")
#define LBAR() asm volatile("s_waitcnt lgkmcnt(0)\n\ts_barrier" ::: "memory")

namespace pg8 {
constexpr int BM = 256, BK = 64, HALF = 128, HTB = HALF * BK * 2, STAGE_BYTES = 8 * HTB, NXCD = 8, WGM = 8;
__host__ __device__ __forceinline__ int lds_byte(int r, int c) { const int st = (r >> 4) * 2 + (c >> 5), rr = r & 15, cc = c & 31, ob = rr * 64 + cc * 2; return st * 1024 + (ob ^ (((ob >> 9) & 1) << 5)); }
__host__ __device__ __forceinline__ void stage_rc(int b, int& R, int& C) { const int st = b / 1024, sb = b % 1024, swz = sb ^ (((sb >> 9) & 1) << 5); R = (st >> 1) * 16 + swz / 64; C = (st & 1) * 32 + (swz % 64) / 2; }
__host__ __device__ __forceinline__ int perm32(int rho) { const int n = rho >> 4, i = rho & 15; return 8 * (i >> 2) + 4 * n + (i & 3); }
struct Unit { int pm, pn; };
struct Gemm { const char* A; const bf16_t* Bt; int M, N, K; int lda; int jkt; int jbytes; };
struct StaticOrder {
    int nM, nN, nwg, G, c;
    __host__ __device__ void init(int M, int N, int G_, int c_) { nM = M / BM; nN = N / BM; nwg = nM * nN; G = G_; c = c_; }
    __host__ __device__ bool next(int i, Unit& u) const {
        const long L = (long)i * G + c; if (L >= nwg) return false;
        int wgid = (int)L; { const int q = nwg / NXCD, r = nwg % NXCD, xcd = wgid % NXCD, off = wgid / NXCD; wgid = (xcd < r ? xcd * (q + 1) : r * (q + 1) + (xcd - r) * q) + off; }
        const int nig = WGM * nN, gid = wgid / nig, fm = gid * WGM, gsz = (nM - fm) < WGM ? (nM - fm) : WGM;
        u.pm = fm + ((wgid % nig) % gsz); u.pn = (wgid % nig) / gsz; return true;
    }
};

struct EpiZ {
    static constexpr bool PERM = true;
    bf16_t* O; int ldc;
    __device__ __forceinline__ void operator()(const f32x4 (&acc)[2][2][4][2], const Unit& u, int wr, int wc, int fr, int fq) const {
        const int row0 = u.pm * BM + wr * 64 + fr, col0 = u.pn * BM + wc * 32 + 8 * fq;
#pragma unroll
        for (int ai = 0; ai < 2; ++ai)
#pragma unroll
            for (int m = 0; m < 4; ++m) { bf16_t* rowp = O + (size_t)(row0 + ai * HALF + m * 16) * ldc + col0;
#pragma unroll
                for (int bj = 0; bj < 2; ++bj) { const f32x4 v0 = acc[ai][bj][m][0], v1 = acc[ai][bj][m][1];
                    u32x4 w; w.x = cvt_pk_bf16(v0[0], v0[1]); w.y = cvt_pk_bf16(v0[2], v0[3]); w.z = cvt_pk_bf16(v1[0], v1[1]); w.w = cvt_pk_bf16(v1[2], v1[3]);
                    *(u32x4*)(rowp + bj * HALF) = w; } }
    }
};
struct EpiOut {
    static constexpr bool PERM = true;
    const float* xp; const float* xs; float* out; bf16_t* Z; float* rowsq;
    __device__ __forceinline__ void operator()(const f32x4 (&acc)[2][2][4][2], const Unit& u, int wr, int wc, int fr, int fq) const {
        const int col0 = u.pn * BM + wc * 32 + 8 * fq;
#pragma unroll
        for (int ai = 0; ai < 2; ++ai)
#pragma unroll
            for (int m = 0; m < 4; ++m) { const int r = u.pm * BM + ai * HALF + wr * 64 + m * 16 + fr;
                const float* xr = (r < SP ? xp + (size_t)r * DM : xs + (size_t)(r - SP) * DM) + col0; float* orow = out + (size_t)r * DM + col0; bf16_t* zr = Z + (size_t)r * ZP + ZXN2 + col0;
                float ss = 0.f;
#pragma unroll
                for (int bj = 0; bj < 2; ++bj) { const f32x4 x0 = *(const f32x4*)(xr + bj * HALF), x1 = *(const f32x4*)(xr + bj * HALF + 4);
                    const f32x4 o0 = x0 + acc[ai][bj][m][0], o1 = x1 + acc[ai][bj][m][1];
                    *(f32x4*)(orow + bj * HALF) = o0; *(f32x4*)(orow + bj * HALF + 4) = o1;
                    ss += ((o0[0] * o0[0] + o0[1] * o0[1]) + (o0[2] * o0[2] + o0[3] * o0[3])) + ((o1[0] * o1[0] + o1[1] * o1[1]) + (o1[2] * o1[2] + o1[3] * o1[3]));
                    u32x4 w; w.x = cvt_pk_bf16(o0[0], o0[1]); w.y = cvt_pk_bf16(o0[2], o0[3]); w.z = cvt_pk_bf16(o1[0], o1[1]); w.w = cvt_pk_bf16(o1[2], o1[3]); *(u32x4*)(zr + bj * HALF) = w; }
                ss += __shfl_xor(ss, 16); ss += __shfl_xor(ss, 32);
                if (fq == 0) rowsq[(size_t)r * 16 + u.pn * 4 + wc] = ss;
                if (m & 1) asm volatile("" ::: "memory"); }
    }
};
struct EpiUp {
    static constexpr bool PERM = true;
    char* H; const float* rowsq; int row_off;
    __device__ __forceinline__ void operator()(const f32x4 (&acc)[2][2][4][2], const Unit& u, int wr, int wc, int fr, int fq) const {
        const int row0 = u.pm * BM + wr * 64 + fr, col0 = u.pn * BM + wc * 32 + 8 * fq;
#pragma unroll
        for (int ai = 0; ai < 2; ++ai)
#pragma unroll
            for (int m = 0; m < 4; ++m) { const int r = row0 + ai * HALF + m * 16; const f32x4* rq = (const f32x4*)(rowsq + (size_t)(row_off + r) * 16);
                const f32x4 q0 = rq[0], q1 = rq[1], q2 = rq[2], q3 = rq[3];
                const float ssum = ((q0[0] + q0[1]) + (q0[2] + q0[3])) + ((q1[0] + q1[1]) + (q1[2] + q1[3])) + ((q2[0] + q2[1]) + (q2[2] + q2[3])) + ((q3[0] + q3[1]) + (q3[2] + q3[3]));
                const float rstd = __builtin_amdgcn_rsqf(ssum * (1.0f / DM) + NORM_EPS);
                char* rowp = H + (size_t)r * 13312;
#pragma unroll
                for (int bj = 0; bj < 2; ++bj) { const int c = col0 + bj * HALF; f32x4 v0 = acc[ai][bj][m][0] * rstd, v1 = acc[ai][bj][m][1] * rstd;
#pragma unroll
                    for (int e = 0; e < 4; ++e) { const float a = fmaxf(v0[e], 0.f), b = fmaxf(v1[e], 0.f); v0[e] = a * a; v1[e] = b * b; }
                    u32x4 w; w.x = cvt_pk_bf16(v0[0], v0[1]); w.y = cvt_pk_bf16(v0[2], v0[3]); w.z = cvt_pk_bf16(v1[0], v1[1]); w.w = cvt_pk_bf16(v1[2], v1[3]);
                    *(u32x4*)(rowp + (size_t)c * 2 + (c >= 2048 ? 2560 : 0)) = w; } }
    }
};
struct EpiDown {
    static constexpr bool PERM = true;
    float* out; int row_off;
    __device__ __forceinline__ void operator()(const f32x4 (&acc)[2][2][4][2], const Unit& u, int wr, int wc, int fr, int fq) const {
        const int col0 = u.pn * BM + wc * 32 + 8 * fq;
#pragma unroll
        for (int ai = 0; ai < 2; ++ai)
#pragma unroll
            for (int m = 0; m < 4; ++m) { const int r = row_off + u.pm * BM + ai * HALF + wr * 64 + m * 16 + fr; float* orow = out + (size_t)r * DM + col0;
#pragma unroll
                for (int bj = 0; bj < 2; ++bj) { const f32x4 x0 = *(const f32x4*)(orow + bj * HALF), x1 = *(const f32x4*)(orow + bj * HALF + 4);
                    *(f32x4*)(orow + bj * HALF) = x0 + acc[ai][bj][m][0]; *(f32x4*)(orow + bj * HALF + 4) = x1 + acc[ai][bj][m][1]; }
                if (m & 1) asm volatile("" ::: "memory"); }
    }
};

template <class Epi, class Sched, bool ALIGN_EPI>
__device__ __forceinline__ void gemm_phase(LAS unsigned char* lds, const Gemm g, const Sched& S, const Epi& E) {
    int tid_ = threadIdx.x; asm volatile("" : "+v"(tid_));
    const int tid = tid_, wid = __builtin_amdgcn_readfirstlane(tid >> 6), lane = tid & 63, wr = wid >> 2, wc = wid & 3, fr = lane & 15, fq = lane >> 4;
    const int K = g.K, nt = K / BK;
    unsigned voffA[2], voffB[2];
#pragma unroll
    for (int i = 0; i < 2; ++i) { int R, C; stage_rc(tid * 16 + i * 8192, R, C); const int Rb = Epi::PERM ? ((R & ~31) + perm32(R & 31)) : R;
        voffA[i] = (unsigned)(R * g.lda + C * 2); voffB[i] = (unsigned)(Rb * K + C) * 2u; }
    const size_t kstep = (size_t)(BK * 2);
    const size_t hstepA = (size_t)HALF * g.lda, tstepA = 2 * hstepA;
    const size_t hstepB = (size_t)HALF * K * 2, tstepB = 2 * hstepB;
    const unsigned ldsw = (unsigned)wid * 1024u;
    const int aoff = lds_byte(wr * 64 + fr, fq * 8), boff = lds_byte(wc * 32 + fr, fq * 8);
#define PG8_AOFF(kt) ((size_t)(kt) * kstep + ((kt) >= g.jkt ? (size_t)g.jbytes : (size_t)0))
#define PG8_SA(b, h) (((b) * 2 + (h)) * HTB)
#define PG8_SB(b, h) ((4 + (b) * 2 + (h)) * HTB)
#define PG8_STAGE(bufoff, gbase, voff) do { _Pragma("unroll") for (int _i = 0; _i < 2; ++_i) \
        __builtin_amdgcn_global_load_lds((const unsigned*)((const char*)(gbase) + (voff)[_i]), (LAS unsigned*)(lds + (bufoff) + ldsw + _i * 8192), 16, 0, 0); } while (0)
#define PG8_LDA(dst, b, h) do { _Pragma("unroll") for (int m = 0; m < 4; ++m) _Pragma("unroll") for (int k = 0; k < 2; ++k) dst[m][k] = *(const LAS bf16x8*)(lds + PG8_SA(b, h) + aoff + m * 2048 + k * 1024); } while (0)
#define PG8_LDB(dst, b, h) do { _Pragma("unroll") for (int n = 0; n < 2; ++n) _Pragma("unroll") for (int k = 0; k < 2; ++k) dst[n][k] = *(const LAS bf16x8*)(lds + PG8_SB(b, h) + boff + n * 2048 + k * 1024); } while (0)
#define PG8_MMA(ai, bj, At, Bt) do { __builtin_amdgcn_s_setprio(1); _Pragma("unroll") for (int m = 0; m < 4; ++m) _Pragma("unroll") for (int n = 0; n < 2; ++n) _Pragma("unroll") for (int k = 0; k < 2; ++k) \
        acc[ai][bj][m][n] = __builtin_amdgcn_mfma_f32_16x16x32_bf16(Bt[n][k], At[m][k], acc[ai][bj][m][n], 0, 0, 0); __builtin_amdgcn_s_setprio(0); } while (0)
#define PG8_WAIT_V(n) asm volatile("s_waitcnt vmcnt(" #n ")" ::: "memory")
#define PG8_WAIT_L(n) asm volatile("s_waitcnt lgkmcnt(" #n ")" ::: "memory")
#define PG8_BAR __builtin_amdgcn_s_barrier()
#define PG8_SCHED __builtin_amdgcn_sched_barrier(0)
    Unit cur, nxt; int ui = 0;
    if (!S.next(0, cur)) return;
    f32x4 acc[2][2][4][2];
#pragma unroll
    for (int a = 0; a < 2; ++a)
#pragma unroll
        for (int b = 0; b < 2; ++b)
#pragma unroll
            for (int m = 0; m < 4; ++m)
#pragma unroll
                for (int n = 0; n < 2; ++n) acc[a][b][m][n] = (f32x4){0.f, 0.f, 0.f, 0.f};
    bf16x8 At[4][2], B0[2][2], B1[2][2];
    const char* cA = g.A + (size_t)cur.pm * tstepA; const char* cB = (const char*)g.Bt + (size_t)cur.pn * tstepB;
    {
        PG8_STAGE(PG8_SB(0, 0), cB, voffB); PG8_STAGE(PG8_SB(0, 1), cB + hstepB, voffB); PG8_STAGE(PG8_SA(0, 0), cA + PG8_AOFF(0), voffA); PG8_STAGE(PG8_SA(0, 1), cA + hstepA + PG8_AOFF(0), voffA);
        if (wr == 1) PG8_BAR;
        PG8_WAIT_V(2); PG8_BAR;
        PG8_STAGE(PG8_SB(1, 0), cB + kstep, voffB); PG8_STAGE(PG8_SA(1, 0), cA + PG8_AOFF(1), voffA); PG8_STAGE(PG8_SB(1, 1), cB + hstepB + kstep, voffB);
        PG8_WAIT_V(6); PG8_BAR;
    }
    for (;;) {
        const bool has_next = S.next(ui + 1, nxt);
        const char* nA = has_next ? g.A + (size_t)nxt.pm * tstepA : cA; const char* nB = has_next ? (const char*)g.Bt + (size_t)nxt.pn * tstepB : cB;
        for (int t = 0; t < nt; t += 2) {
            const bool last = (t == nt - 2);
            const char* a1 = cA + PG8_AOFF(t + 1);
            const char* a2 = last ? nA + PG8_AOFF(0) : cA + PG8_AOFF(t + 2); const char* b2 = last ? nB : cB + (size_t)(t + 2) * kstep;
            const char* a3 = last ? nA + PG8_AOFF(1) : cA + PG8_AOFF(t + 3); const char* b3 = b2 + kstep;
            PG8_LDB(B0, 0, 0); PG8_LDB(B1, 0, 1); PG8_SCHED; PG8_LDA(At, 0, 0); PG8_STAGE(PG8_SA(1, 1), a1 + hstepA, voffA);
            PG8_WAIT_V(8); PG8_WAIT_L(0); PG8_BAR; PG8_MMA(0, 0, At, B0); PG8_MMA(0, 1, At, B1); PG8_BAR; PG8_SCHED;
            PG8_LDA(At, 0, 1); PG8_STAGE(PG8_SB(0, 0), b2, voffB); PG8_STAGE(PG8_SB(0, 1), b2 + hstepB, voffB); PG8_STAGE(PG8_SA(0, 0), a2, voffA);
            PG8_WAIT_V(8); PG8_WAIT_L(0); PG8_BAR; PG8_MMA(1, 0, At, B0); PG8_MMA(1, 1, At, B1); PG8_BAR; PG8_SCHED;
            PG8_LDB(B0, 1, 0); PG8_LDB(B1, 1, 1); PG8_SCHED; PG8_LDA(At, 1, 0); PG8_STAGE(PG8_SA(0, 1), a2 + hstepA, voffA);
            PG8_WAIT_V(8); PG8_WAIT_L(0); PG8_BAR; PG8_MMA(0, 0, At, B0); PG8_MMA(0, 1, At, B1); PG8_BAR; PG8_SCHED;
            PG8_LDA(At, 1, 1); PG8_STAGE(PG8_SB(1, 0), b3, voffB); PG8_STAGE(PG8_SB(1, 1), b3 + hstepB, voffB); PG8_STAGE(PG8_SA(1, 0), a3, voffA);
            PG8_WAIT_V(8); PG8_WAIT_L(0); PG8_BAR; PG8_MMA(1, 0, At, B0); PG8_MMA(1, 1, At, B1); PG8_BAR; PG8_SCHED;
        }
        if constexpr (ALIGN_EPI) { if (wr == 0) PG8_BAR; }
        E(acc, cur, wr, wc, fr, fq);
        if (!has_next) break;
#pragma unroll
        for (int a = 0; a < 2; ++a)
#pragma unroll
            for (int b = 0; b < 2; ++b)
#pragma unroll
                for (int m = 0; m < 4; ++m)
#pragma unroll
                    for (int n = 0; n < 2; ++n) acc[a][b][m][n] = (f32x4){0.f, 0.f, 0.f, 0.f};
        cur = nxt; cA = nA; cB = nB; ++ui;
        if constexpr (ALIGN_EPI) { if (wr == 1) PG8_BAR; }
    }
    PG8_WAIT_V(0);
    if constexpr (!ALIGN_EPI) { if (wr == 0) PG8_BAR; }
    PG8_BAR;
#undef PG8_AOFF
#undef PG8_SA
#undef PG8_SB
#undef PG8_STAGE
#undef PG8_LDA
#undef PG8_LDB
#undef PG8_MMA
#undef PG8_WAIT_V
#undef PG8_WAIT_L
#undef PG8_BAR
#undef PG8_SCHED
}
}

constexpr int NWAVES = 8, NTHR = 512;
constexpr int LDS_BYTES = 163840;
struct Args {
    const float* in[27]; float* out; unsigned char* ws; int ph_lo, ph_hi;
};
struct Frame {
    LAS unsigned char* lds; int tid, lane, wave, vcu, G;
};
constexpr int PTRS_OFF = LDS_BYTES - 256;
__device__ __forceinline__ const float* inp(LAS unsigned char* lds, int i) { return *(const float* LAS*)(lds + PTRS_OFF + i * 8); }
__device__ __forceinline__ float gld(const float* p) { return *(const GAS float*)p; }
__device__ __forceinline__ int seq_row0(int q) { return q == 0 ? 0 : SP + (q - 1) * SS; }
__device__ __forceinline__ int seq_len(int q) { return q == 0 ? SP : SS; }

__device__ __forceinline__ void p0_transpose_item(const float* W, int K, int N, bf16_t* WT, const float* kscale, LAS float* scr, int item, int lane) {
    const int nblk = N / 32, kb = item / nblk, nb = item % nblk, k0 = 64 * kb, n0 = 32 * nb;
#pragma unroll 8
    for (int i = 0; i < 32; ++i) { const int kk = 2 * i + (lane >> 5); float v = W[(size_t)(k0 + kk) * N + n0 + (lane & 31)]; if (kscale) v *= kscale[k0 + kk]; scr[kk * 33 + (lane & 31)] = v; }
    LDS_WAIT(); asm volatile("" ::: "memory");
    const int c = lane & 7;
#pragma unroll
    for (int j = 0; j < 4; ++j) { const int n = (lane >> 3) + 8 * j; const LAS float* s = scr + (8 * c) * 33 + n;
        u32x4 o; o.x = cvt_pk_bf16(s[0 * 33], s[1 * 33]); o.y = cvt_pk_bf16(s[2 * 33], s[3 * 33]); o.z = cvt_pk_bf16(s[4 * 33], s[5 * 33]); o.w = cvt_pk_bf16(s[6 * 33], s[7 * 33]);
        *(u32x4*)(WT + (size_t)(n0 + n) * K + k0 + 8 * c) = o; }
    LDS_WAIT(); asm volatile("" ::: "memory");
}
__device__ __forceinline__ void p0_prologue(const Frame& F, const Args& a) {
    LAS float* scr = (LAS float*)(F.lds + F.wave * 16384);
    const int gw = F.vcu * NWAVES + F.wave, NGW = F.G * NWAVES;
    unsigned char* ws = a.ws;
    constexpr int I_IN = (DM / 64) * (ZP / 32), I_O = (DM / 64) * (DM / 32), I_1 = (DM / 64) * (DFF / 32), I_2 = (DFF / 64) * (DM / 32);
    for (int it = gw; it < I_IN + I_O + I_1 + I_2; it += NGW) {
        int r = it;
        if (r < I_IN) { p0_transpose_item(a.in[3], DM, ZP, (bf16_t*)(ws + WS_WIN), nullptr, scr, r, F.lane); continue; } r -= I_IN;
        if (r < I_O) { p0_transpose_item(a.in[23], DM, DM, (bf16_t*)(ws + WS_WOUT), nullptr, scr, r, F.lane); continue; } r -= I_O;
        if (r < I_1) { p0_transpose_item(a.in[25], DM, DFF, (bf16_t*)(ws + WS_W1), a.in[24], scr, r, F.lane); continue; } r -= I_1;
        p0_transpose_item(a.in[26], DFF, DM, (bf16_t*)(ws + WS_W2), nullptr, scr, r, F.lane);
    }
    bf16_t* XN = (bf16_t*)a.out; const float* g1 = a.in[2];
    for (int m = gw; m < MTOK; m += NGW) {
        const float* xrow = m < SP ? a.in[0] + (size_t)m * DM : a.in[1] + (size_t)(m - SP) * DM;
        const f32x4* xr = (const f32x4*)xrow + F.lane; f32x4 v[4]; float s = 0.f;
#pragma unroll
        for (int j = 0; j < 4; ++j) { v[j] = xr[64 * j]; s += (v[j][0] * v[j][0] + v[j][1] * v[j][1]) + (v[j][2] * v[j][2] + v[j][3] * v[j][3]); }
        const float rstd = 1.0f / sqrtf(wave_sum(s) * (1.f / DM) + NORM_EPS);
        u32x2* o8 = (u32x2*)(XN + (size_t)m * DM) + F.lane;
#pragma unroll
        for (int j = 0; j < 4; ++j) { const f32x4 gv = ((const f32x4*)g1)[F.lane + 64 * j]; u32x2 w; w.x = cvt_pk_bf16(v[j][0] * rstd * gv[0], v[j][1] * rstd * gv[1]); w.y = cvt_pk_bf16(v[j][2] * rstd * gv[2], v[j][3] * rstd * gv[3]); o8[64 * j] = w; }
    }
    const int gt = F.vcu * NTHR + F.tid, NGT = F.G * NTHR;
    float* rope = (float*)(ws + WS_ROPE);
    for (int e = gt; e < SP * 32; e += NGT) { const int pos = e >> 5, i = e & 31;
        const float invf = 1.0f / powf(10000.0f, (float)(2 * i) / 64.0f); const float ang = (float)pos * invf; float sn, cs; sincosf(ang, &sn, &cs);
        rope[2 * e] = cs; rope[2 * e + 1] = sn; }
    bf16_t* wupT = (bf16_t*)(ws + WS_LORA); bf16_t* aupT = wupT + 2 * 512 * 64; bf16_t* gupT = aupT + 2 * 512 * 64;
    for (int e = gt; e < 2 * 512 * 64; e += NGT) { const int d = e >> 15, c = (e >> 6) & 511, r = e & 63;
        wupT[e] = f2bf(a.in[14][((size_t)d * 64 + r) * 512 + c]); aupT[e] = f2bf(a.in[16][((size_t)d * 64 + r) * 512 + c]); }
    for (int e = gt; e < 512 * 128; e += NGT) { const int c = e >> 7, r = e & 127; gupT[e] = f2bf(a.in[17][(size_t)r * 512 + c]); }
}

__device__ __forceinline__ void qk_prep(const Frame& F, const Args& a) {
    const int gw = F.vcu * NWAVES + F.wave, NGW = F.G * NWAVES;
    bf16_t* Z = (bf16_t*)(a.ws + WS_Z); const float* rope = (const float*)(a.ws + WS_ROPE);
    const int g = F.lane >> 2, qd = F.lane & 3;
    const float* gain = (g < 8) ? a.in[4] : a.in[5];
    float glo[8], ghi[8];
#pragma unroll
    for (int j = 0; j < 8; ++j) { glo[j] = gain[8 * qd + j]; ghi[j] = gain[32 + 8 * qd + j]; }
    const float osc = (g < 8) ? QSCALE : 1.0f;
    const float mpw = a.in[11][ZWD - ZRR + F.lane], mnw = a.in[12][ZWD - ZRR + F.lane], mpa = a.in[11][ZAD - ZRR + F.lane], mna = a.in[12][ZAD - ZRR + F.lane];
    for (int blk = gw; blk < MTOK / 16; blk += NGW) {
        const int m0 = blk * 16;
        const int pos0 = m0 < SP ? m0 : ((m0 - SP) & (SS - 1)); const int S = m0 < SP ? SP : SS;
        {
            float zw[18], za[18]; const bf16_t* zr = Z + (size_t)m0 * ZP; const int j = F.lane;
#pragma unroll
            for (int i = 0; i < 18; ++i) { const int pp = pos0 - 1 + i; const bool ok = pp >= 0 && pp < S; const long ro = (long)(ok ? i - 1 : 0) * ZP;
                const float w_ = bf2f(zr[ro + ZWD + j]), a_ = bf2f(zr[ro + ZAD + j]); zw[i] = ok ? w_ : 0.f; za[i] = ok ? a_ : 0.f; }
            bf16_t* e1 = (bf16_t*)(a.ws + WS_E1) + (size_t)m0 * 128;
#pragma unroll
            for (int i = 0; i < 16; ++i) { const float wc = zw[i + 1], ac = za[i + 1];
                const float ws_ = wc + mpw * (zw[i] - wc) + mnw * (zw[i + 2] - wc), as_ = ac + mpa * (za[i] - ac) + mna * (za[i + 2] - ac);
                e1[i * 128 + j] = f2bf(1.0f - 2.0f * __builtin_amdgcn_rcpf(__expf(2.0f * ws_) + 1.0f)); e1[i * 128 + 64 + j] = f2bf(as_); }
        }
#pragma unroll 4
        for (int i = 0; i < 16; ++i) {
            const int m = m0 + i, pos = pos0 + i;
            bf16_t* p = Z + (size_t)m * ZP + g * 64 + 8 * qd;
            const u32x4 lo4 = *(const u32x4*)p, hi4 = *(const u32x4*)(p + 32);
            float lo[8], hi[8];
#pragma unroll
            for (int j = 0; j < 4; ++j) { lo[2 * j] = bflo(lo4[j]); lo[2 * j + 1] = bfhi(lo4[j]); hi[2 * j] = bflo(hi4[j]); hi[2 * j + 1] = bfhi(hi4[j]); }
            float ss = 0.f;
#pragma unroll
            for (int j = 0; j < 8; ++j) ss += lo[j] * lo[j] + hi[j] * hi[j];
            ss += __shfl_xor(ss, 1); ss += __shfl_xor(ss, 2);
            const float rstd = __builtin_amdgcn_rsqf(ss * (1.f / 64.f) + NORM_EPS);
            const f32x4* rp = (const f32x4*)(rope + ((size_t)pos * 32 + 8 * qd) * 2);
            float ol[8], oh[8];
#pragma unroll
            for (int j2 = 0; j2 < 4; ++j2) { const f32x4 cs = rp[j2];
#pragma unroll
                for (int e = 0; e < 2; ++e) { const int j = 2 * j2 + e; const float c = cs[2 * e], sn = cs[2 * e + 1]; const float l = lo[j] * rstd * glo[j], h = hi[j] * rstd * ghi[j];
                    ol[j] = (l * c - h * sn) * osc; oh[j] = (h * c + l * sn) * osc; } }
            u32x4 wl, wh;
#pragma unroll
            for (int j = 0; j < 4; ++j) { wl[j] = cvt_pk_bf16(ol[2 * j], ol[2 * j + 1]); wh[j] = cvt_pk_bf16(oh[2 * j], oh[2 * j + 1]); }
            *(u32x4*)p = wl; *(u32x4*)(p + 32) = wh;
        }
    }
}

namespace att {
constexpr int KSLOT = 8192, VSLOT = 16384, NKS = 4, NVS = 3;
constexpr int L_K = 0, L_V = NKS * KSLOT, L_WS = L_V + NVS * VSLOT, L_ST = L_WS + NWAVES * 256, L_END = L_ST + NWAVES * 8192;
static_assert(L_END <= PTRS_OFF, "attention lds");
__device__ __forceinline__ int crow(int r, int hi) { return (r & 3) + 8 * (r >> 2) + 4 * hi; }
__device__ __forceinline__ void glds16(const void* gsrc, unsigned lds_dst) { unsigned keep;
    asm volatile("s_mov_b32 %0, m0\n\ts_mov_b32 m0, %2\n\ts_nop 0\n\tglobal_load_lds_dwordx4 %1, off\n\ts_mov_b32 m0, %0" : "=&s"(keep) : "v"(gsrc), "s"(lds_dst) : "memory"); }
typedef short v4i16_t __attribute__((ext_vector_type(4)));
typedef const LAS char* lds_cptr;
__device__ __forceinline__ s16x4 vtr(lds_cptr p) { return __builtin_bit_cast(s16x4, __builtin_amdgcn_ds_read_tr16_b64_v4i16((LAS v4i16_t*)p)); }
#define SBAR() __builtin_amdgcn_sched_barrier(0)
#define WAIT_BAR(N) asm volatile("s_waitcnt vmcnt(" #N ") lgkmcnt(0)\n\ts_barrier" ::: "memory")
__device__ __forceinline__ void kload8(bf16x8* kf, lds_cptr kp) {
    kf[0] = *(const LAS bf16x8*)(kp);        kf[1] = *(const LAS bf16x8*)(kp + 512);
    kf[2] = *(const LAS bf16x8*)(kp + 2048); kf[3] = *(const LAS bf16x8*)(kp + 2560);
    kf[4] = *(const LAS bf16x8*)(kp + 4096); kf[5] = *(const LAS bf16x8*)(kp + 4608);
    kf[6] = *(const LAS bf16x8*)(kp + 6144); kf[7] = *(const LAS bf16x8*)(kp + 6656);
}
__device__ __forceinline__ void kload2(bf16x8* kf, lds_cptr kp, int j) { kf[2 * j] = *(const LAS bf16x8*)(kp + j * 2048); kf[2 * j + 1] = *(const LAS bf16x8*)(kp + j * 2048 + 512); }

__device__ __forceinline__ void attn_unit(int row0, int S, int h, int qb, bf16_t* Z, LAS unsigned char* shm, float lam, const float* subln_g, bf16_t* Ob, int opitch) {
    int tid_ = threadIdx.x; asm volatile("" : "+v"(tid_));
    const int tid = tid_, lane = tid & 63, r32 = lane & 31, hi = lane >> 5; const int wid = __builtin_amdgcn_readfirstlane(tid >> 6);
    const unsigned lds0 = (unsigned)(uintptr_t)shm;
    LAS float* wsf = (LAS float*)(shm + L_WS) + wid * 64;
    LAS bf16_t* stash = (LAS bf16_t*)(shm + L_ST) + wid * 4096;
    const int NT = S / 64;
    const size_t qrow = (size_t)(row0 + qb * 256 + wid * 32);
    const lds_cptr shm3 = (lds_cptr)shm;
    const lds_cptr kp0 = shm3 + L_K + hi * 1024 + r32 * 16;
    const lds_cptr vp0 = shm3 + L_V + ((lane >> 4) & 1) * 32 + (lane & 3) * 8 + (4 * hi + ((lane & 15) >> 2)) * 64;
    f32x16 o[4];
#pragma unroll 1
    for (int c = 0; c < 2; ++c) {
        const bf16_t* Qw = Z + qrow * ZP + ZQ + h * 128 + c * 64;
        const bf16_t* Kh = Z + (size_t)row0 * ZP + ZK + h * 128 + c * 64;
        const bf16_t* Vh = Z + (size_t)row0 * ZP + ZV + h * 128;
        const int p0 = 2 * wid, p1 = 2 * wid + 1;
        const unsigned koff = (unsigned)(lane * ZP + wid * 8) * 2u;
        const unsigned voff0 = (unsigned)((16 * (p0 & 3) + (lane >> 2)) * ZP + (p0 >> 2) * 32 + (lane & 3) * 8) * 2u;
        const unsigned voff1 = (unsigned)((16 * (p1 & 3) + (lane >> 2)) * ZP + (p1 >> 2) * 32 + (lane & 3) * 8) * 2u;
        const unsigned kdst = lds0 + L_K + wid * 1024, vdst0 = lds0 + L_V + p0 * 1024, vdst1 = lds0 + L_V + p1 * 1024;
#define DMA_K(t, si) glds16((const char*)(Kh + (size_t)(t) * 64 * ZP) + koff, (unsigned)__builtin_amdgcn_readfirstlane(kdst + (si) * KSLOT))
#define DMA_V(t, si) do { const char* vb_ = (const char*)(Vh + (size_t)(t) * 64 * ZP); glds16(vb_ + voff0, (unsigned)__builtin_amdgcn_readfirstlane(vdst0 + (si) * VSLOT)); glds16(vb_ + voff1, (unsigned)__builtin_amdgcn_readfirstlane(vdst1 + (si) * VSLOT)); } while (0)
        DMA_K(0, 0); DMA_V(0, 0); DMA_K(1, 1);
        bf16x8 qr[4];
#pragma unroll
        for (int d0 = 0; d0 < 4; ++d0) qr[d0] = *(const bf16x8*)(Qw + (size_t)r32 * ZP + d0 * 16 + hi * 8);
#pragma unroll
        for (int d0 = 0; d0 < 4; ++d0) o[d0] = f32x16{};
        float l_reg = 0.f;
        bf16x8 kf[4];
        f32x16 pA0, pA1, pB0, pB1;
        int i_prev = 0, i_cur = 0, i_next = 1;
        int k_cur = 0, k_next = 1;
#define ROT() do { i_prev = i_cur; i_cur = i_next; i_next = (i_next == NVS - 1) ? 0 : i_next + 1; k_cur = k_next; k_next = (k_next + 1) & 3; } while (0)
#define KFRAG(slot, i) (*(const LAS bf16x8*)(kp0 + (slot) * KSLOT + ((i) >> 1) * 2048 + ((i) & 1) * 512))
        DMA_K(2, 2);
        WAIT_BAR(4);
        {
            const lds_cptr kb = kp0;
            pA0 = f32x16{}; pA1 = f32x16{};
#pragma unroll
            for (int d0 = 0; d0 < 4; ++d0) { const bf16x8 b0 = *(const LAS bf16x8*)(kb + d0 * 2048), b1 = *(const LAS bf16x8*)(kb + d0 * 2048 + 512);
                pA0 = __builtin_amdgcn_mfma_f32_32x32x16_bf16(b0, qr[d0], pA0, 0, 0, 0); pA1 = __builtin_amdgcn_mfma_f32_32x32x16_bf16(b1, qr[d0], pA1, 0, 0, 0); }
#pragma unroll
            for (int r = 0; r < 16; ++r) { pA0[r] = __builtin_amdgcn_exp2f(pA0[r]); pA1[r] = __builtin_amdgcn_exp2f(pA1[r]); }
        }
        WAIT_BAR(0);
        DMA_K(3, 3); DMA_V(1, 1);
        ROT();
        kf[0] = KFRAG(k_cur, 0); kf[1] = KFRAG(k_cur, 1); kf[2] = KFRAG(k_cur, 2); kf[3] = KFRAG(k_cur, 3);
        WAIT_BAR(3);
        s16x4 vlo[4], vhi[4]; u32x4 pw0, pw1, pw2, pw3;
#define PKW(P, B) cvt_pk_bf16(P[B], P[B + 1])
#define PAF(k) __builtin_bit_cast(bf16x8, pw##k)
#define VFR(i) (bf16x8){vlo[i][0], vlo[i][1], vlo[i][2], vlo[i][3], vhi[i][0], vhi[i][1], vhi[i][2], vhi[i][3]}
#define PIN(x) asm volatile("" : "+v"(x))
#define EX(v) __builtin_amdgcn_exp2f(v)
#define VRD(slot, f) do { vlo[slot] = vtr(vp_ + (((f) & 3) * 4096 + ((f) >> 2) * 1024)); vhi[slot] = vtr(vp_ + (((f) & 3) * 4096 + ((f) >> 2) * 1024 + 512)); } while (0)
#define GAPA(MF, LDX, A0, A1, A2, A3, W0, W1, PW) do { MF; LDX; sacc += A0; sacc += A1; sacc += A2; sacc += A3; PIN(sacc); W0; W1; PIN(PW); SBAR(); } while (0)
#define GAPB(MF, LDX, X, B) do { MF; LDX; X[B] = EX(X[B]); X[B + 1] = EX(X[B + 1]); PIN(X); SBAR(); } while (0)
#define PVM(f) o[(f) & 3] = __builtin_amdgcn_mfma_f32_32x32x16_bf16(__builtin_bit_cast(bf16x8, (f) < 4 ? pw0 : (f) < 8 ? pw1 : (f) < 12 ? pw2 : pw3), VFR((f) & 3), o[(f) & 3], 0, 0, 0)
#define NOP_ do { } while (0)
#if PROBE_ATT
#define ATT_T(k) do { if (PROBE_ATT == (k)) { const unsigned long long n_ = __builtin_amdgcn_s_memrealtime(); if (tid == 0) *(LAS unsigned long long*)(shm + PTRS_OFF - 64) += n_ - att_t0; } } while (0)
#define ATT_T0() const unsigned long long att_t0 = __builtin_amdgcn_s_memrealtime()
#else
#define ATT_T(k) do { } while (0)
#define ATT_T0() do { } while (0)
#endif
#define STEP(C0, C1, P0, P1, t, GK, GV, GL) do { SBAR(); \
        const lds_cptr vp_ = vp0 + i_prev * VSLOT; \
        float sacc = (P0[0] + P0[1]); \
        GAPA(C0 = __builtin_amdgcn_mfma_f32_32x32x16_bf16(kf[0], qr[0], (f32x16){}, 0, 0, 0), kf[0] = KFRAG(k_cur, 4), P0[2], P0[3], P0[4], P0[5],     pw0[0] = PKW(P0, 0), pw0[1] = PKW(P0, 2), pw0); \
        GAPA(C1 = __builtin_amdgcn_mfma_f32_32x32x16_bf16(kf[1], qr[0], (f32x16){}, 0, 0, 0), kf[1] = KFRAG(k_cur, 5), P0[6], P0[7], P0[8], P0[9],     pw0[2] = PKW(P0, 4), pw0[3] = PKW(P0, 6), pw0); \
        GAPA(C0 = __builtin_amdgcn_mfma_f32_32x32x16_bf16(kf[2], qr[1], C0, 0, 0, 0),         kf[2] = KFRAG(k_cur, 6), P0[10], P0[11], P0[12], P0[13], pw1[0] = PKW(P0, 8), pw1[1] = PKW(P0, 10), pw1); \
        GAPA(C1 = __builtin_amdgcn_mfma_f32_32x32x16_bf16(kf[3], qr[1], C1, 0, 0, 0),         kf[3] = KFRAG(k_cur, 7), P0[14], P0[15], P1[0], P1[1],   pw1[2] = PKW(P0, 12), pw1[3] = PKW(P0, 14), pw1); \
        GAPA(C0 = __builtin_amdgcn_mfma_f32_32x32x16_bf16(kf[0], qr[2], C0, 0, 0, 0),         VRD(0, 0), P1[2], P1[3], P1[4], P1[5],     pw2[0] = PKW(P1, 0), pw2[1] = PKW(P1, 2), pw2); \
        GAPA(C1 = __builtin_amdgcn_mfma_f32_32x32x16_bf16(kf[1], qr[2], C1, 0, 0, 0),         VRD(1, 1), P1[6], P1[7], P1[8], P1[9],     pw2[2] = PKW(P1, 4), pw2[3] = PKW(P1, 6), pw2); \
        GAPA(C0 = __builtin_amdgcn_mfma_f32_32x32x16_bf16(kf[2], qr[3], C0, 0, 0, 0),         VRD(2, 2), P1[10], P1[11], P1[12], P1[13], pw3[0] = PKW(P1, 8), pw3[1] = PKW(P1, 10), pw3); \
        GAPA(C1 = __builtin_amdgcn_mfma_f32_32x32x16_bf16(kf[3], qr[3], C1, 0, 0, 0),         VRD(3, 3), P1[14], P1[15], 0.f, 0.f,       pw3[2] = PKW(P1, 12), pw3[3] = PKW(P1, 14), pw3); \
        l_reg += sacc; \
        if (GK) { DMA_K((t) + 3, (k_cur + 3) & 3); } if (GV) { DMA_V((t) + 1, i_next); } \
        SBAR(); \
        GAPB(PVM(0), VRD(0, 4), C0, 0);   GAPB(PVM(1), VRD(1, 5), C0, 2);   GAPB(PVM(2), VRD(2, 6), C0, 4);    GAPB(PVM(3), VRD(3, 7), C0, 6); \
        GAPB(PVM(4), VRD(0, 8), C0, 8);   GAPB(PVM(5), VRD(1, 9), C0, 10);  GAPB(PVM(6), VRD(2, 10), C0, 12);  GAPB(PVM(7), VRD(3, 11), C0, 14); \
        GAPB(PVM(8), VRD(0, 12), C1, 0);  GAPB(PVM(9), VRD(1, 13), C1, 2);  GAPB(PVM(10), VRD(2, 14), C1, 4);  GAPB(PVM(11), VRD(3, 15), C1, 6); \
        GAPB(PVM(12), if (GL) kf[0] = KFRAG(k_next, 0), C1, 8);  GAPB(PVM(13), if (GL) kf[1] = KFRAG(k_next, 1), C1, 10); \
        GAPB(PVM(14), if (GL) kf[2] = KFRAG(k_next, 2), C1, 12); GAPB(PVM(15), if (GL) kf[3] = KFRAG(k_next, 3), C1, 14); \
        } while (0)
        int t = 1;
#pragma unroll 1
        for (; t + 5 < NT; t += 2) {
#if PROBE_ATT == 1
            STEP(pB0, pB1, pA0, pA1, t, true, true, true);     { ATT_T0(); WAIT_BAR(3); ATT_T(1); } ROT();
            STEP(pA0, pA1, pB0, pB1, t + 1, true, true, true); { ATT_T0(); WAIT_BAR(3); ATT_T(1); } ROT();
#elif PROBE_ATT >= 2
            { ATT_T0(); STEP(pB0, pB1, pA0, pA1, t, true, true, true); ATT_T(2); }    WAIT_BAR(3); ROT();
            { ATT_T0(); STEP(pA0, pA1, pB0, pB1, t + 1, true, true, true); ATT_T(2); } WAIT_BAR(3); ROT();
#else
            STEP(pB0, pB1, pA0, pA1, t, true, true, true);     WAIT_BAR(3); ROT();
            STEP(pA0, pA1, pB0, pB1, t + 1, true, true, true); WAIT_BAR(3); ROT();
#endif
        }
#define ENDW(tt) do { if ((tt) + 3 < NT) { WAIT_BAR(3); } else if ((tt) + 2 < NT) { WAIT_BAR(2); } else { WAIT_BAR(0); } } while (0)
#pragma unroll 1
        for (; t + 1 < NT; t += 2) {
            STEP(pB0, pB1, pA0, pA1, t, (t + 3 < NT), (t + 1 < NT), (t + 1 < NT));         ENDW(t);     ROT();
            STEP(pA0, pA1, pB0, pB1, t + 1, (t + 4 < NT), (t + 2 < NT), (t + 2 < NT));     ENDW(t + 1); ROT();
        }
        STEP(pB0, pB1, pA0, pA1, NT - 1, false, false, false);
        {
            float sacc = pB0[0] + pB0[1];
#pragma unroll
            for (int r = 2; r < 16; ++r) sacc += pB0[r];
#pragma unroll
            for (int r = 0; r < 16; ++r) sacc += pB1[r];
            l_reg += sacc;
            pw0 = (u32x4){PKW(pB0, 0), PKW(pB0, 2), PKW(pB0, 4), PKW(pB0, 6)}; pw1 = (u32x4){PKW(pB0, 8), PKW(pB0, 10), PKW(pB0, 12), PKW(pB0, 14)};
            pw2 = (u32x4){PKW(pB1, 0), PKW(pB1, 2), PKW(pB1, 4), PKW(pB1, 6)}; pw3 = (u32x4){PKW(pB1, 8), PKW(pB1, 10), PKW(pB1, 12), PKW(pB1, 14)};
            const lds_cptr vp_ = vp0 + i_cur * VSLOT;
            VRD(0, 0); VRD(1, 1); VRD(2, 2); VRD(3, 3); PVM(0); PVM(1); PVM(2); PVM(3);
            VRD(0, 4); VRD(1, 5); VRD(2, 6); VRD(3, 7); PVM(4); PVM(5); PVM(6); PVM(7);
            VRD(0, 8); VRD(1, 9); VRD(2, 10); VRD(3, 11); PVM(8); PVM(9); PVM(10); PVM(11);
            VRD(0, 12); VRD(1, 13); VRD(2, 14); VRD(3, 15); PVM(12); PVM(13); PVM(14); PVM(15);
        }
#undef DMA_K
#undef DMA_V
#undef ROT
#undef PKW
#undef PAF
#undef VFR
#undef PIN
#undef EX
#undef VRD
#undef GAPA
#undef GAPB
#undef KFRAG
#undef NOP_
#undef PVM
#undef STEP
#undef ENDW
        { auto rr = __builtin_amdgcn_permlane32_swap(__float_as_uint(l_reg), __float_as_uint(l_reg), false, false); l_reg = __uint_as_float(rr[0]) + __uint_as_float(rr[1]); }
        if (hi == 0) wsf[r32] = l_reg;
        LDS_WAIT();
        float rli[16];
#pragma unroll
        for (int r = 0; r < 16; ++r) rli[r] = 1.0f / wsf[crow(r, hi)];
        if (c == 0) {
#pragma unroll
            for (int d0 = 0; d0 < 4; ++d0)
#pragma unroll
                for (int r = 0; r < 16; ++r) stash[(d0 * 16 + r) * 64 + lane] = f2bf(o[d0][r] * rli[r]);
            LDS_WAIT();
        } else {
#pragma unroll
            for (int d0 = 0; d0 < 4; ++d0)
#pragma unroll
                for (int r = 0; r < 16; ++r) o[d0][r] = bf2f(stash[(d0 * 16 + r) * 64 + lane]) - lam * (o[d0][r] * rli[r]);
            LDS_WAIT(); asm volatile("" ::: "memory");
#pragma unroll
            for (int d0 = 0; d0 < 4; ++d0)
#pragma unroll
                for (int r = 0; r < 16; ++r) stash[crow(r, hi) * 128 + d0 * 32 + r32] = f2bf(o[d0][r]);
            LDS_WAIT(); asm volatile("" ::: "memory");
            bf16_t* Ow = Ob + qrow * opitch + ZQ + h * 128;
#pragma unroll
            for (int i = 0; i < 4; ++i) { const int row = i * 8 + (lane >> 3), ch = lane & 7;
                const u32x4 w0 = *(const LAS u32x4*)(stash + row * 128 + ch * 16), w1 = *(const LAS u32x4*)(stash + row * 128 + ch * 16 + 8);
                float v[16];
#pragma unroll
                for (int j = 0; j < 4; ++j) { v[2 * j] = bflo(w0[j]); v[2 * j + 1] = bfhi(w0[j]); v[8 + 2 * j] = bflo(w1[j]); v[9 + 2 * j] = bfhi(w1[j]); }
                float ss = 0.f;
#pragma unroll
                for (int j = 0; j < 16; ++j) ss += v[j] * v[j];
                ss += __shfl_xor(ss, 1); ss += __shfl_xor(ss, 2); ss += __shfl_xor(ss, 4);
                const float rs = (1.0f - LAMBDA_INIT) / sqrtf(ss * (1.f / 128.f) + NORM_EPS);
                u32x4 x0, x1;
#pragma unroll
                for (int j = 0; j < 4; ++j) { x0[j] = cvt_pk_bf16(v[2 * j] * rs * subln_g[ch * 16 + 2 * j], v[2 * j + 1] * rs * subln_g[ch * 16 + 2 * j + 1]);
                                              x1[j] = cvt_pk_bf16(v[8 + 2 * j] * rs * subln_g[ch * 16 + 8 + 2 * j], v[9 + 2 * j] * rs * subln_g[ch * 16 + 9 + 2 * j]); }
                *(u32x4*)(Ow + (size_t)row * opitch + ch * 16) = x0; *(u32x4*)(Ow + (size_t)row * opitch + ch * 16 + 8) = x1; }
            LDS_WAIT();
        }
        asm volatile("s_waitcnt vmcnt(0) lgkmcnt(0)\n\ts_barrier" ::: "memory");
    }
}
#undef SBAR
#undef WAIT_BAR
}

namespace rw {
constexpr int P = 144, MAT = 64 * P;
constexpr int O_AT = 0, O_BT = MAT, O_KT = 2 * MAT, O_RT = 3 * MAT, O_ATT = 4 * MAT, O_VT = 5 * MAT, O_BHT = 6 * MAT, O_KHT = 7 * MAT;
constexpr int O_LAB = 8 * MAT, O_LAK = 9 * MAT, O_ARB = 10 * MAT, O_ARK = 11 * MAT, O_XT = 12 * MAT, O_ABT = 13 * MAT, O_U0T = 14 * MAT;
constexpr int O_LABD = 15 * MAT, O_TII = O_LABD + 4096, O_WC = O_TII + 2048, O_GSUM = O_WC + 256, O_PAR = O_GSUM + 2048, O_END = O_PAR + 960 * 4;
constexpr int O_ZS = 0, PZ = 128;
static_assert(3 * 66 * PZ <= 3 * MAT, "ZS fits At|Bt|Kt");
constexpr int O_TW = O_LAB, O_ADN = O_LAK, O_WL = O_ARB, O_AR = O_XT, PF = 272;
static_assert(O_END <= PTRS_OFF - 64 && 64 * PF <= 2 * MAT, "rwkv lds");
__device__ __forceinline__ int crow(int r, int hi) { return (r & 3) + 8 * (r >> 2) + 4 * hi; }
__device__ __forceinline__ float sigmoidf_(float x) { return __builtin_amdgcn_rcpf(1.0f + __expf(-x)); }
__device__ __forceinline__ float tanhf_(float x) { return 1.0f - 2.0f * __builtin_amdgcn_rcpf(__expf(2.0f * x) + 1.0f); }
__device__ __forceinline__ void load10(const bf16_t* zc, int t_lo, int S, float (&z)[10]) {
#pragma unroll
    for (int i = 0; i < 10; ++i) { const int t = t_lo - 1 + i; z[i] = (t >= 0 && t < S) ? bf2f(zc[(size_t)t * ZP]) : 0.f; }
}
__device__ __forceinline__ float tshift(const float (&z)[10], int u, float mp, float mn) { const float c = z[u + 1]; return c + mp * (z[u] - c) + mn * (z[u + 2] - c); }
__device__ __forceinline__ f32x16 mm_ll(const LAS unsigned char* A, int rowA, const LAS unsigned char* B, int rowB, f32x16 acc, int r32, int hi) {
#pragma unroll
    for (int ks = 0; ks < 4; ++ks) { const bf16x8 a = *(const LAS bf16x8*)(A + (rowA + r32) * P + (16 * ks + 8 * hi) * 2), b = *(const LAS bf16x8*)(B + (rowB + r32) * P + (16 * ks + 8 * hi) * 2);
        acc = __builtin_amdgcn_mfma_f32_32x32x16_bf16(a, b, acc, 0, 0, 0); }
    return acc;
}
__device__ __forceinline__ void store_native(unsigned char* dst, const f32x16& acc, int lane, bool wt) {
    u32x4 w0, w1;
#pragma unroll
    for (int q = 0; q < 4; ++q) { w0[q] = cvt_pk_bf16(acc[2 * q], acc[2 * q + 1]); w1[q] = cvt_pk_bf16(acc[8 + 2 * q], acc[9 + 2 * q]); }
    if (wt) {
        asm volatile("global_store_dwordx4 %0, %1, off sc1\n\tglobal_store_dwordx4 %0, %2, off offset:16 sc1\n\ts_nop 1" :: "v"(dst + lane * 32), "v"(w0), "v"(w1) : "memory");
    } else { *(u32x4*)(dst + lane * 32) = w0; *(u32x4*)(dst + lane * 32 + 16) = w1; }
}
__device__ __forceinline__ void st4(LAS unsigned char* p, float a, float b, float c, float d) { u32x2 w; w.x = cvt_pk_bf16(a, b); w.y = cvt_pk_bf16(c, d); *(LAS u32x2*)p = w; }

__device__ __forceinline__ f32x2_t s1_param_load(LAS unsigned char* L, int tid, int d, int h) {
    const int sg = tid >> 5, seg = sg < 15 ? sg : 14, off = (tid & 31) * 2;
    const int ti = seg < 10 ? 11 + (seg & 1) : (seg == 10 ? 13 : (seg == 11 ? 15 : 6 + seg));
    const int eo = seg < 6 ? (seg >> 1) * 512 + h * 64 : (seg < 8 ? ZWD - ZRR : (seg < 10 ? ZAD - ZRR : (seg < 12 ? d * 512 + h * 64 : h * 64)));
    const float* src = *(const float* LAS*)(L + PTRS_OFF + ti * 8) + eo + off;
    return *(const GAS f32x2_t*)src;
}
__device__ __forceinline__ void s1_stage_load(const Args& a, int tid, int q, int h, int ck, u32x4 (&v)[6]) {
    const int row0 = seq_row0(q), S = seq_len(q), t0 = ck * 64;
#pragma unroll
    for (int k = 0; k < 6; ++k) { const int c = tid + k * NTHR;
        const int seg = c >> 3, part = c & 7, row = seg / 3, grp = seg - row * 3; int t = t0 - 1 + row; t = t < 0 ? 0 : (t >= S ? S - 1 : t);
        const int e = c - 1584 < 0 ? 0 : (c - 1584 > 1023 ? 1023 : c - 1584);
        const size_t offz = WS_Z + ((size_t)(row0 + t) * ZP + ZRR + grp * 512 + h * 64 + part * 8) * 2, offe = WS_E1 + ((size_t)(row0 + t0) * 128 + (size_t)e * 8) * 2;
        v[k] = *(const GAS u32x4*)(a.ws + (c < 1584 ? offz : offe)); }
}
__device__ __forceinline__ void s1_stage_store(LAS unsigned char* L, int tid, int d, int q, int ck, const u32x4 (&stg)[6], f32x2_t par) {
    const int S = seq_len(q), t0 = ck * 64;
#pragma unroll
    for (int k = 0; k < 6; ++k) { const int c = tid + k * NTHR;
        if (c < 1584) { const int seg = c >> 3, part = c & 7, row = seg / 3, grp = seg - row * 3, t = t0 - 1 + row; const bool ok = t >= 0 && t < S;
            *(LAS u32x4*)(L + O_ZS + (grp * 66 + row) * PZ + part * 16) = ok ? stg[k] : (u32x4){0u, 0u, 0u, 0u}; }
        else if (c < 2608) { const int e = c - 1584, tr = e >> 4, part = e & 15, tau = d == 0 ? tr : 63 - tr;
            *(LAS u32x4*)(L + (part < 8 ? O_TW : O_ADN) + tau * P + (part & 7) * 16) = stg[k]; } }
    if (tid < 480) *(LAS f32x2_t*)(L + O_PAR + tid * 8) = par;
}
__device__ __forceinline__ void s1_item(const Frame& F, const Args& a, int d, int q, int h, int ck, unsigned char* slot, int nd, int nq, int nh, int nck, bool wt, unsigned* publish_prev) {
    LAS unsigned char* L = F.lds;
#if PROBE_S1 >= 0
    unsigned long long pt_last = 0; int pt_n = 0;
#define PST() do { if (F.tid == 0) { const unsigned long long n_ = __builtin_amdgcn_s_memrealtime(); if (pt_n == PROBE_S1 + 1) *(LAS unsigned long long*)(L + PTRS_OFF - 64) += n_ - pt_last; pt_last = n_; } ++pt_n; } while (0)
#else
#define PST() do { } while (0)
#endif
    PST();
    int lane_ = F.lane; asm volatile("" : "+v"(lane_));
    const int lane = lane_, w = F.wave, tid = w * 64 + lane, r32 = lane & 31, hi = lane >> 5;
    const int j = lane, tg = w;
    const int row0 = seq_row0(q), S = seq_len(q), t0 = ck * 64;
    const bf16_t* Zs = (const bf16_t*)(a.ws + WS_Z) + (size_t)row0 * ZP; (void)Zs; (void)S;
    const int t_lo = d == 0 ? t0 + 8 * tg : t0 + 56 - 8 * tg;
    const int tau0 = 8 * tg;
#define TAU(u) (d == 0 ? tau0 + (u) : tau0 + 7 - (u))
    const int ch = h * 64 + j; (void)ch;
    bf16x8 wfr[4];
    { const int which = w >> 2, mt = (w >> 1) & 1;
      const bf16_t* WT = (const bf16_t*)(a.ws + WS_LORA) + (which ? 2 * 512 * 64 : 0) + ((size_t)d * 512 + h * 64 + 32 * mt + r32) * 64;
#pragma unroll
      for (int ks = 0; ks < 4; ++ks) wfr[ks] = *(const bf16x8*)(WT + 16 * ks + 8 * hi); }
    u32x4 stg[6]; s1_stage_load(a, tid, nq, nh, nck, stg); const f32x2_t par = s1_param_load(L, tid, nd, nh);
#define PAR(seg, idx) (*(const LAS float*)(L + O_PAR + ((seg) * 64 + (idx)) * 4))
    const LAS unsigned char* zsb = L + O_ZS + (t_lo - t0) * PZ + j * 2;
#define LD10(z, g) do { _Pragma("unroll") for (int i_ = 0; i_ < 10; ++i_) z[i_] = bf2f(*(const LAS bf16_t*)(zsb + ((g) * 66 + i_) * PZ)); } while (0)
    {
        const int which = w >> 2, mt = (w >> 1) & 1, nt = w & 1;
        const LAS unsigned char* B = L + (which ? O_ADN : O_TW);
        f32x16 acc = f32x16{};
#pragma unroll
        for (int ks = 0; ks < 4; ++ks) { const bf16x8 bv = *(const LAS bf16x8*)(B + (32 * nt + r32) * P + (16 * ks + 8 * hi) * 2);
            acc = __builtin_amdgcn_mfma_f32_32x32x16_bf16(wfr[ks], bv, acc, 0, 0, 0); }
        LAS unsigned char* O = L + (which ? O_AR : O_WL) + (32 * nt + r32) * PF;
#pragma unroll
        for (int g = 0; g < 4; ++g) { const int jj = 8 * g + 4 * hi; const f32x4 bv = *(const LAS f32x4*)(L + O_PAR + ((10 + which) * 64 + 32 * mt + jj) * 4);
            *(LAS f32x4*)(O + (32 * mt + jj) * 4) = (f32x4){acc[4 * g] + bv[0], acc[4 * g + 1] + bv[1], acc[4 * g + 2] + bv[2], acc[4 * g + 3] + bv[3]}; }
    }
    LBAR(); PST();
    float aa[8], bb[8], rr[8], kd[8], vv[8], ld[8];
    {
        float zr[10], zk[10], zv[10]; LD10(zr, 0); LD10(zk, 1); LD10(zv, 2);
        const float mpr = PAR(0, j), mnr = PAR(1, j), mpk = PAR(2, j), mnk = PAR(3, j), mpv = PAR(4, j), mnv = PAR(5, j);
        const float kkc = PAR(12, j), kac = PAR(13, j), rkc = PAR(14, j);
        float* bon = (float*)(a.ws + WS_BONUS) + ((size_t)d * MTOK + row0) * 8 + h;
#pragma unroll
        for (int u = 0; u < 8; ++u) { const int tau = TAU(u);
            const float wl = *(const LAS float*)(L + O_WL + tau * PF + j * 4), ar = *(const LAS float*)(L + O_AR + tau * PF + j * 4);
            ld[u] = -0.6065306597126334f * sigmoidf_(wl); const float arate = sigmoidf_(ar);
            rr[u] = tshift(zr, u, mpr, mnr); const float k0 = tshift(zk, u, mpk, mnk); vv[u] = tshift(zv, u, mpv, mnv);
            const float kkr = k0 * kkc; const float ssq = wave_sum_dpp(kkr * kkr); const float kkn = kkr * __builtin_amdgcn_rsqf(ssq + 1e-12f);
            kd[u] = k0 * (1.0f + (arate - 1.0f) * kac); aa[u] = -kkn; bb[u] = kkn * arate;
            const float bsum = wave_sum_dpp(rr[u] * kd[u] * rkc);
            if (lane == 0) bon[(size_t)(t_lo + u) * 8] = bsum; }
        float tot = 0.f;
#pragma unroll
        for (int u = 0; u < 8; ++u) tot += ld[u];
        *(LAS float*)(L + O_GSUM + tg * 256 + j * 4) = tot;
    }
    LBAR(); PST();
    {
        float pre = 0.f, cC = 0.f;
#pragma unroll
        for (int g = 0; g < 8; ++g) { const float s = *(const LAS float*)(L + O_GSUM + g * 256 + j * 4); cC += s; if (g < tg) pre += s; }
        float tot = 0.f;
#pragma unroll
        for (int u = 0; u < 8; ++u) tot += ld[u];
        float At[8], Vt[8], Bh[8], Kh[8]; float pf = 0.f;
#pragma unroll
        for (int u = 0; u < 8; ++u) { pf += ld[u]; const int tau = TAU(u);
            const float cl = pre + (d == 0 ? pf : tot - pf + ld[u]);
            const float e_m1 = __expf(cl - ld[u]), e_p = __expf(cl), e_n = __expf(-cl), e_c = __expf(cC - cl);
            At[u] = aa[u] * e_m1; Vt[u] = vv[u]; Bh[u] = bb[u] * e_c; Kh[u] = kd[u] * e_c;
            *(LAS bf16_t*)(L + O_AT + tau * P + j * 2) = f2bf(At[u]); *(LAS bf16_t*)(L + O_RT + tau * P + j * 2) = f2bf(rr[u] * e_p);
            *(LAS bf16_t*)(L + O_BT + tau * P + j * 2) = f2bf(bb[u] * e_n); *(LAS bf16_t*)(L + O_KT + tau * P + j * 2) = f2bf(kd[u] * e_n); }
#define PK8(dst, X) do { u32x4 w_; _Pragma("unroll") for (int k = 0; k < 4; ++k) { const float x0 = d == 0 ? X[2 * k] : X[7 - 2 * k], x1 = d == 0 ? X[2 * k + 1] : X[6 - 2 * k]; w_[k] = cvt_pk_bf16(x0, x1); } \
            *(LAS u32x4*)(L + (dst) + j * P + tau0 * 2) = w_; } while (0)
        PK8(O_ATT, At); PK8(O_VT, Vt); PK8(O_BHT, Bh); PK8(O_KHT, Kh);
#undef PK8
        if (tg == 0) *(LAS float*)(L + O_WC + j * 4) = __expf(cC);
    }
    LBAR(); PST();
#pragma unroll
    for (int i = 0; i < 2; ++i) {
        const int ti = 2 * w + i, ms = ti >> 2, nl = ti & 3;
        const int sb = 32 * (ms & 1), tb = 32 * (nl & 1);
        f32x16 acc = f32x16{};
        if (sb <= tb) acc = mm_ll(L + (ms < 2 ? O_BT : O_KT), sb, L + (nl < 2 ? O_AT : O_RT), tb, acc, r32, hi);
        const bool incl = nl >= 2; const int dst = ms < 2 ? (nl < 2 ? O_LAB : O_ARB) : (nl < 2 ? O_LAK : O_ARK);
        const int t = tb + r32;
#pragma unroll
        for (int g = 0; g < 4; ++g) { const int s0 = sb + 8 * g + 4 * hi; float v[4];
#pragma unroll
            for (int e = 0; e < 4; ++e) { const int s = s0 + e; v[e] = (incl ? (s <= t) : (s < t)) ? acc[4 * g + e] : 0.f; }
            st4(L + dst + t * P + s0 * 2, v[0], v[1], v[2], v[3]);
            if (dst == O_LAB && (s0 >> 4) == (t >> 4)) *(LAS f32x4*)(L + O_LABD + (((t >> 4) * 16 + (t & 15)) * 16 + (s0 & 15)) * 4) = (f32x4){v[0], v[1], v[2], v[3]}; }
    }
    LBAR(); PST();
    if (w < 4) {
        const int mt = w >> 1, nt = w & 1; f32x16 acc = f32x16{};
        acc = mm_ll(L + O_LAK, 32 * mt, L + O_VT, 32 * nt, acc, r32, hi);
#pragma unroll
        for (int g = 0; g < 4; ++g) st4(L + O_XT + (32 * nt + r32) * P + (32 * mt + 8 * g + 4 * hi) * 2, acc[4 * g], acc[4 * g + 1], acc[4 * g + 2], acc[4 * g + 3]);
    } else if (w == 7) {
        const int blk = lane >> 4, cc = lane & 15; float x[16];
#pragma unroll
        for (int t = 0; t < 16; ++t) { float s = (t == cc) ? 1.f : 0.f; const LAS float* lr = (const LAS float*)(L + O_LABD + ((blk * 16 + t) * 16) * 4);
#pragma unroll
            for (int k = 0; k < t; ++k) s += lr[k] * x[k];
            x[t] = s; *(LAS bf16_t*)(L + O_TII + ((blk * 16 + t) * 16 + cc) * 2) = f2bf(s); }
    }
    LBAR(); PST();
    {
        const int c16 = lane & 15, q4 = lane >> 4;
        const LAS unsigned char* RT = L + (w < 4 ? O_ATT : O_XT) + (16 * (w & 3) + c16) * P;
        LAS unsigned char* OT = L + (w < 4 ? O_ABT : O_U0T) + (16 * (w & 3) + c16) * P;
        const LAS unsigned char* LA = L + O_LAB + c16 * P;
#define RHS(i) ({ const u32x2 r_ = *(const LAS u32x2*)(RT + (16 * (i) + 4 * q4) * 2); (f32x4){bflo(r_.x), bfhi(r_.x), bflo(r_.y), bfhi(r_.y)}; })
#define AFR(i, k1, k2) ({ const u32x2 lo_ = *(const LAS u32x2*)(LA + 16 * (i) * P + (16 * (k1) + 4 * q4) * 2); u32x2 hi_ = {0u, 0u}; if ((k2) >= 0) hi_ = *(const LAS u32x2*)(LA + 16 * (i) * P + (16 * ((k2) < 0 ? 0 : (k2)) + 4 * q4) * 2); \
        __builtin_bit_cast(bf16x8, (u32x4){lo_.x, lo_.y, hi_.x, hi_.y}); })
#define TFR(i) ({ const u32x2 lo_ = *(const LAS u32x2*)(L + O_TII + (((i) * 16 + c16) * 16 + 4 * q4) * 2); __builtin_bit_cast(bf16x8, (u32x4){lo_.x, lo_.y, 0u, 0u}); })
#define BFR(U1, U2) __builtin_bit_cast(bf16x8, (u32x4){cvt_pk_bf16(U1[0], U1[1]), cvt_pk_bf16(U1[2], U1[3]), cvt_pk_bf16(U2[0], U2[1]), cvt_pk_bf16(U2[2], U2[3])})
#define MF16(A_, B_, C_) __builtin_amdgcn_mfma_f32_16x16x32_bf16(A_, B_, C_, 0, 0, 0)
        const f32x4 zero4 = {0.f, 0.f, 0.f, 0.f};
        f32x4 U0 = MF16(TFR(0), BFR(RHS(0), zero4), zero4);
        f32x4 Z1 = MF16(AFR(1, 0, -1), BFR(U0, zero4), RHS(1));
        f32x4 U1 = MF16(TFR(1), BFR(Z1, zero4), zero4);
        f32x4 Z2 = MF16(AFR(2, 0, 1), BFR(U0, U1), RHS(2));
        f32x4 U2 = MF16(TFR(2), BFR(Z2, zero4), zero4);
        f32x4 Z3 = MF16(AFR(3, 0, 1), BFR(U0, U1), RHS(3));
        Z3 = MF16(AFR(3, 2, -1), BFR(U2, zero4), Z3);
        f32x4 U3 = MF16(TFR(3), BFR(Z3, zero4), zero4);
        st4(OT + (0 + 4 * q4) * 2, U0[0], U0[1], U0[2], U0[3]); st4(OT + (16 + 4 * q4) * 2, U1[0], U1[1], U1[2], U1[3]);
        st4(OT + (32 + 4 * q4) * 2, U2[0], U2[1], U2[2], U2[3]); st4(OT + (48 + 4 * q4) * 2, U3[0], U3[1], U3[2], U3[3]);
#undef RHS
#undef AFR
#undef TFR
#undef BFR
#undef MF16
    }
    if (publish_prev) asm volatile("s_waitcnt vmcnt(0)" ::: "memory");
    LBAR(); PST();
    if (publish_prev && tid == 0) __hip_atomic_fetch_add(publish_prev, 1u, __ATOMIC_RELAXED, __HIP_MEMORY_SCOPE_AGENT);
    {
        const int mt = (w >> 1) & 1, nt = w & 1;
        if (w < 4) {
            f32x16 acc = f32x16{};
            acc = mm_ll(L + O_ABT, 32 * mt, L + O_BHT, 32 * nt, acc, r32, hi);
            if (mt == nt) { const float wc = *(const LAS float*)(L + O_WC + (32 * nt + r32) * 4);
#pragma unroll
                for (int r = 0; r < 16; ++r) if (crow(r, hi) == r32) acc[r] += wc; }
            store_native(slot + (mt * 2 + nt) * 2048, acc, lane, wt);
            f32x16 rb;
#pragma unroll
            for (int g = 0; g < 4; ++g) { const u32x2 r_ = *(const LAS u32x2*)(L + O_RT + (32 * nt + r32) * P + (32 * mt + 8 * g + 4 * hi) * 2);
                rb[4 * g] = bflo(r_.x); rb[4 * g + 1] = bfhi(r_.x); rb[4 * g + 2] = bflo(r_.y); rb[4 * g + 3] = bfhi(r_.y); }
            rb = mm_ll(L + O_ABT, 32 * mt, L + O_ARB, 32 * nt, rb, r32, hi);
            store_native(slot + 16384 + (mt * 2 + nt) * 2048, rb, lane, wt);
        } else {
            f32x16 acc = f32x16{};
            acc = mm_ll(L + O_BHT, 32 * mt, L + O_U0T, 32 * nt, acc, r32, hi);
            acc = mm_ll(L + O_KHT, 32 * mt, L + O_VT, 32 * nt, acc, r32, hi);
            store_native(slot + 8192 + (mt * 2 + nt) * 2048, acc, lane, wt);
            f32x16 y0 = f32x16{};
            y0 = mm_ll(L + O_ARB, 32 * mt, L + O_U0T, 32 * nt, y0, r32, hi);
            y0 = mm_ll(L + O_ARK, 32 * mt, L + O_VT, 32 * nt, y0, r32, hi);
            store_native(slot + 24576 + (mt * 2 + nt) * 2048, y0, lane, wt);
        }
    }
    LBAR(); PST();
    s1_stage_store(L, tid, nd, nq, nck, stg, par);
    LBAR(); PST();
#undef PAR
#undef TAU
#undef LD10
#undef PST
}

__device__ __forceinline__ void s23_wait_round(unsigned* ready, int r, int lane) {
    unsigned spins = 0;
    while ((unsigned)__builtin_amdgcn_readfirstlane(__hip_atomic_load(ready + r, __ATOMIC_RELAXED, __HIP_MEMORY_SCOPE_AGENT)) < 16u) { __builtin_amdgcn_s_sleep(8); if (++spins > (1u << 22)) break; }
    __builtin_amdgcn_fence(__ATOMIC_ACQUIRE, "agent");
    asm volatile("s_waitcnt vmcnt(0)" ::: "memory");
}
__device__ __forceinline__ void s23_chain_wg(const Frame& F, const Args& a, int d, int q, int h, unsigned char* slots  , unsigned* ready) {
    LAS unsigned char* L = F.lds;
    const int lane = F.lane, w = F.wave, icb = w & 1;
    const int NC = seq_len(q) / 64;
    f32x16 X0 = f32x16{}, X1 = f32x16{};
    const bool loader = w >= 4, compute = w < 2;
    constexpr int D = 6;
#define CKOF(cc) (d == 0 ? (cc) : NC - 1 - (cc))
#define S23_DMA(cc) do { const unsigned char* src_ = slots + (size_t)CKOF(cc) * SLOT_BYTES + (w - 4) * 4096 + lane * 16; LAS unsigned char* dst_ = L + ((cc) & 7) * 16384 + (w - 4) * 4096; \
        _Pragma("unroll") for (int p_ = 0; p_ < 4; ++p_) __builtin_amdgcn_global_load_lds((const unsigned*)(src_ + p_ * 1024), (LAS unsigned*)(dst_ + p_ * 1024), 16, 0, 0); } while (0)
#define UNPK(dst, w0, w1) do { _Pragma("unroll") for (int q_ = 0; q_ < 4; ++q_) { dst[2 * q_] = bflo(w0[q_]); dst[2 * q_ + 1] = bfhi(w0[q_]); dst[8 + 2 * q_] = bflo(w1[q_]); dst[9 + 2 * q_] = bfhi(w1[q_]); } } while (0)
    if (ready) { if (w == 4) s23_wait_round(ready, 0, lane); asm volatile("s_waitcnt lgkmcnt(0)\n\ts_barrier" ::: "memory"); }
    if (loader) {
#pragma unroll
        for (int c0 = 0; c0 < D; ++c0) if (c0 < NC) S23_DMA(c0); }
#pragma unroll 1
    for (int cc = 0; cc < NC; ++cc) {
        if (ready && w == 4 && ((cc + D) & 15) == 0 && cc + D < NC) s23_wait_round(ready, (cc + D) >> 4, lane);
        if (loader) { const int later = NC - 1 - cc;
            if (later >= 5) asm volatile("s_waitcnt vmcnt(20)" ::: "memory"); else if (later == 4) asm volatile("s_waitcnt vmcnt(16)" ::: "memory"); else if (later == 3) asm volatile("s_waitcnt vmcnt(12)" ::: "memory");
            else if (later == 2) asm volatile("s_waitcnt vmcnt(8)" ::: "memory"); else if (later == 1) asm volatile("s_waitcnt vmcnt(4)" ::: "memory"); else asm volatile("s_waitcnt vmcnt(0)" ::: "memory"); }
        asm volatile("s_waitcnt lgkmcnt(0)\n\ts_barrier" ::: "memory");
        if (loader) { if (cc + D < NC) S23_DMA(cc + D); }
        if (compute) {
            const LAS unsigned char* sl = L + (cc & 7) * 16384 + lane * 32;
            u32x4 mw[4][2], dw[2][2];
#pragma unroll
            for (int t = 0; t < 4; ++t) { mw[t][0] = *(const LAS u32x4*)(sl + t * 2048); mw[t][1] = *(const LAS u32x4*)(sl + t * 2048 + 16); }
#pragma unroll
            for (int t = 0; t < 2; ++t) { dw[t][0] = *(const LAS u32x4*)(sl + 8192 + (t * 2 + icb) * 2048); dw[t][1] = *(const LAS u32x4*)(sl + 8192 + (t * 2 + icb) * 2048 + 16); }
            __builtin_amdgcn_sched_barrier(0);
            u32x4 xw[2][2];
#pragma unroll
            for (int s = 0; s < 2; ++s) {
                xw[0][s] = (u32x4){cvt_pk_bf16(X0[8 * s], X0[8 * s + 1]), cvt_pk_bf16(X0[8 * s + 2], X0[8 * s + 3]), cvt_pk_bf16(X0[8 * s + 4], X0[8 * s + 5]), cvt_pk_bf16(X0[8 * s + 6], X0[8 * s + 7])};
                xw[1][s] = (u32x4){cvt_pk_bf16(X1[8 * s], X1[8 * s + 1]), cvt_pk_bf16(X1[8 * s + 2], X1[8 * s + 3]), cvt_pk_bf16(X1[8 * s + 4], X1[8 * s + 5]), cvt_pk_bf16(X1[8 * s + 6], X1[8 * s + 7])}; }
            { unsigned char* xo = slots + (size_t)CKOF(cc) * SLOT_BYTES + ((icb * 2) * 64 + lane) * 32;
              *(u32x4*)(xo) = xw[0][0]; *(u32x4*)(xo + 16) = xw[0][1]; *(u32x4*)(xo + 2048) = xw[1][0]; *(u32x4*)(xo + 2048 + 16) = xw[1][1]; }
            asm volatile("s_waitcnt lgkmcnt(0)" ::: "memory");
            __builtin_amdgcn_sched_barrier(0);
            f32x16 N0, N1;
            UNPK(N0, dw[0][0], dw[0][1]); UNPK(N1, dw[1][0], dw[1][1]);
#pragma unroll
            for (int rb = 0; rb < 2; ++rb)
#pragma unroll
                for (int s = 0; s < 2; ++s) {
                    N0 = __builtin_amdgcn_mfma_f32_32x32x16_bf16(__builtin_bit_cast(bf16x8, mw[rb * 2 + 0][s]), __builtin_bit_cast(bf16x8, xw[rb][s]), N0, 0, 0, 0);
                    N1 = __builtin_amdgcn_mfma_f32_32x32x16_bf16(__builtin_bit_cast(bf16x8, mw[rb * 2 + 1][s]), __builtin_bit_cast(bf16x8, xw[rb][s]), N1, 0, 0, 0); }
            X0 = N0; X1 = N1;
        }
    }
    asm volatile("s_waitcnt vmcnt(0) lgkmcnt(0)\n\ts_barrier" ::: "memory");
#undef UNPK
#undef S23_DMA
#undef CKOF
}

constexpr int PO_V = 0, PO_G = PO_V + 66 * 144, PO_Y = PO_G + 66 * 272, PO_SG = PO_Y + 2 * 64 * 272, PO_GF = PO_SG + 64 * 272, PO_END = PO_GF + 64 * 272;
static_assert(PO_END <= PTRS_OFF - 64, "post lds");
struct PostPre { u32x4 stg[4]; u32x4 ra[2][2], xb[2][2], yc[2]; };
__device__ __forceinline__ void post_decode(int c, int& reg, int& row, int& part) {
    if (c < 528) { reg = 0; row = c >> 3; part = c & 7; } else { reg = 1; row = (c - 528) >> 4; part = (c - 528) & 15; }
}
__device__ __forceinline__ void post_stage_load(const Args& a, int tid, int q, int h, int blk, PostPre& pp) {
    const int row0 = seq_row0(q), S = seq_len(q), t0 = blk * 64;
    const bf16_t* Zs = (const bf16_t*)(a.ws + WS_Z) + (size_t)row0 * ZP;
#pragma unroll
    for (int k = 0; k < 4; ++k) { const int c = tid + k * NTHR; int reg, row, part; post_decode(c, reg, row, part);
        const int t = t0 - 1 + row; const int col = reg == 0 ? ZRV + h * 64 : ZGD;
        pp.stg[k] = (u32x4){0u, 0u, 0u, 0u};
        if (c < 1584 && t >= 0 && t < S) pp.stg[k] = *(const u32x4*)(Zs + (size_t)t * ZP + col + part * 8); }
    const int w = tid >> 6, lane = tid & 63, dd = w >> 2, tb = (w >> 1) & 1, icb = w & 1;
    const size_t si = q == 0 ? (size_t)(dd * 8 + h) * 256 + blk : (size_t)((dd * 8 + (q - 1)) * 8 + h) * 32 + blk;
    const unsigned char* sl = (const unsigned char*)a.out + si * SLOT_BYTES + lane * 32;
#pragma unroll
    for (int rb = 0; rb < 2; ++rb) { pp.ra[rb][0] = *(const u32x4*)(sl + 16384 + (rb * 2 + tb) * 2048); pp.ra[rb][1] = *(const u32x4*)(sl + 16384 + (rb * 2 + tb) * 2048 + 16);
                                     pp.xb[rb][0] = *(const u32x4*)(sl + (icb * 2 + rb) * 2048); pp.xb[rb][1] = *(const u32x4*)(sl + (icb * 2 + rb) * 2048 + 16); }
    pp.yc[0] = *(const u32x4*)(sl + 24576 + (tb * 2 + icb) * 2048); pp.yc[1] = *(const u32x4*)(sl + 24576 + (tb * 2 + icb) * 2048 + 16);
}
__device__ __forceinline__ void post_item(const Frame& F, const Args& a, int q, int h, int blk, PostPre& pp, int nq, int nh, int nblk) {
    LAS unsigned char* L = F.lds;
    int lane_ = F.lane; asm volatile("" : "+v"(lane_));
    const int lane = lane_, w = F.wave, tid = w * 64 + lane, r32 = lane & 31, hi = lane >> 5, j = lane, tg = w;
    const int row0 = seq_row0(q), t_lo = blk * 64 + 8 * tg;
    bf16_t* Zs = (bf16_t*)(a.ws + WS_Z) + (size_t)row0 * ZP;
    const float* mup = inp(L, 11); const float* mun = inp(L, 12);
    const int chp = h * 64 + j;
    const float mp0 = gld(mup + ZGD - ZRR + j), mn0 = gld(mun + ZGD - ZRR + j), mp1 = gld(mup + ZGD - ZRR + 64 + j), mn1 = gld(mun + ZGD - ZRR + 64 + j);
    const float mpv = gld(mup + 1024 + chp), mnv = gld(mun + 1024 + chp), lg = gld(inp(L, 21) + chp), lb = gld(inp(L, 22) + chp);
    float bsum[8];
    { const float* bon0 = (const float*)(a.ws + WS_BONUS) + (size_t)row0 * 8 + h; const float* bon1 = bon0 + (size_t)MTOK * 8;
#pragma unroll
      for (int u = 0; u < 8; ++u) bsum[u] = bon0[(size_t)(t_lo + u) * 8] + bon1[(size_t)(t_lo + u) * 8]; }
    bf16x8 gfr[8];
    { const bf16_t* GT = (const bf16_t*)(a.ws + WS_LORA) + 4 * 512 * 64 + ((size_t)h * 64 + 32 * ((w >> 1) & 1) + r32) * 128;
#pragma unroll
      for (int ks = 0; ks < 8; ++ks) gfr[ks] = *(const bf16x8*)(GT + 16 * ks + 8 * hi); }
#pragma unroll
    for (int k = 0; k < 4; ++k) { const int c = tid + k * NTHR; int reg, row, part; post_decode(c, reg, row, part);
        const int off = reg == 0 ? PO_V + row * 144 : PO_G + row * 272;
        if (c < 1584) *(LAS u32x4*)(L + off + part * 16) = pp.stg[k]; }
    {
        const int dd = w >> 2, tb = (w >> 1) & 1, icb = w & 1;
        f32x16 Y;
#pragma unroll
        for (int q_ = 0; q_ < 4; ++q_) { Y[2 * q_] = bflo(pp.yc[0][q_]); Y[2 * q_ + 1] = bfhi(pp.yc[0][q_]); Y[8 + 2 * q_] = bflo(pp.yc[1][q_]); Y[9 + 2 * q_] = bfhi(pp.yc[1][q_]); }
#pragma unroll
        for (int rb = 0; rb < 2; ++rb)
#pragma unroll
            for (int s2 = 0; s2 < 2; ++s2) Y = __builtin_amdgcn_mfma_f32_32x32x16_bf16(__builtin_bit_cast(bf16x8, pp.ra[rb][s2]), __builtin_bit_cast(bf16x8, pp.xb[rb][s2]), Y, 0, 0, 0);
#pragma unroll
        for (int r = 0; r < 16; ++r) { const int tau = 32 * tb + (r & 3) + 8 * (r >> 2) + 4 * hi; const int t = dd == 0 ? tau : 63 - tau;
            *(LAS float*)(L + PO_Y + (dd * 64 + t) * 272 + (32 * icb + r32) * 4) = Y[r]; }
    }
    LBAR();
    post_stage_load(a, tid, nq, nh, nblk, pp);
    {
        float z0[10], z1[10];
#pragma unroll
        for (int i = 0; i < 10; ++i) { z0[i] = bf2f(*(const LAS bf16_t*)(L + PO_G + (8 * tg + i) * 272 + j * 2)); z1[i] = bf2f(*(const LAS bf16_t*)(L + PO_G + (8 * tg + i) * 272 + (64 + j) * 2)); }
#pragma unroll
        for (int u = 0; u < 8; ++u) { *(LAS bf16_t*)(L + PO_SG + (8 * tg + u) * 272 + j * 2) = f2bf(sigmoidf_(tshift(z0, u, mp0, mn0)));
                                      *(LAS bf16_t*)(L + PO_SG + (8 * tg + u) * 272 + (64 + j) * 2) = f2bf(sigmoidf_(tshift(z1, u, mp1, mn1))); }
    }
    LBAR();
    if (w < 4) {
        const int mt = w >> 1, nt = w & 1;
        f32x16 acc = f32x16{};
#pragma unroll
        for (int ks = 0; ks < 8; ++ks) { const bf16x8 bv = *(const LAS bf16x8*)(L + PO_SG + (32 * nt + r32) * 272 + (16 * ks + 8 * hi) * 2);
            acc = __builtin_amdgcn_mfma_f32_32x32x16_bf16(gfr[ks], bv, acc, 0, 0, 0); }
#pragma unroll
        for (int g = 0; g < 4; ++g) *(LAS f32x4*)(L + PO_GF + (32 * nt + r32) * 272 + (32 * mt + 8 * g + 4 * hi) * 4) = (f32x4){acc[4 * g], acc[4 * g + 1], acc[4 * g + 2], acc[4 * g + 3]};
    }
    LBAR();
    {
        const int ch = h * 64 + j;
        float zv[10];
#pragma unroll
        for (int i = 0; i < 10; ++i) zv[i] = bf2f(*(const LAS bf16_t*)(L + PO_V + (8 * tg + i) * 144 + j * 2));
#pragma unroll
        for (int u = 0; u < 8; ++u) { const int t = t_lo + u;
            const float y = *(const LAS float*)(L + PO_Y + (8 * tg + u) * 272 + j * 4) + *(const LAS float*)(L + PO_Y + (64 + 8 * tg + u) * 272 + j * 4);
            const float mean = wave_sum_dpp(y) * (1.f / 64.f); const float dv = y - mean; const float var = wave_sum_dpp(dv * dv) * (1.f / 64.f);
            const float yn = dv * __builtin_amdgcn_rsqf(var + LNX_EPS) * lg + lb;
            const float g = *(const LAS float*)(L + PO_GF + (8 * tg + u) * 272 + j * 4);
            Zs[(size_t)t * ZP + ZRR + ch] = f2bf((yn + bsum[u] * tshift(zv, u, mpv, mnv)) * g); }
    }
    LBAR();
}
}


#define XB_TMO      128
#define XB_XCNT(j)  (256  + 64 * (j))
#define XB_XSUB(j)  (1280 + 64 * (j))
#define XB_XGEN(j)  (2304 + 64 * (j))
#define XB_TOP      3328
#define XB_TOPGEN   3392
#define XCD_BAR_WORDS 3456
#define XB_SPIN_CAP (1u << 20)
constexpr size_t CTL_ZERO_BYTES = 16384;
__device__ __forceinline__ unsigned xb_ld(unsigned* p)              { return __hip_atomic_load(p, __ATOMIC_RELAXED, __HIP_MEMORY_SCOPE_AGENT); }
__device__ __forceinline__ unsigned xb_add(unsigned* p, unsigned v) { return __hip_atomic_fetch_add(p, v, __ATOMIC_RELAXED, __HIP_MEMORY_SCOPE_AGENT); }
__device__ __forceinline__ unsigned xb_xcc_id() { return (unsigned)__builtin_amdgcn_s_getreg((3 << 11) | 20) & 0xFu; }
#define XB_SPIN(cond, bar) do { unsigned _sp = 0; while (cond) { __builtin_amdgcn_s_sleep(1); \
    if ((++_sp & 255u) == 0u) { if (xb_ld(&(bar)[XB_TMO])) break; if (_sp > XB_SPIN_CAP) { atomicAdd(&(bar)[XB_TMO], 1u); break; } } } } while (0)
struct XcdBarrier { unsigned* bar; unsigned x; volatile LAS unsigned* st; };
__device__ __forceinline__ XcdBarrier xcd_barrier_post(unsigned* bar, volatile LAS unsigned* st) {
    XcdBarrier b; b.bar = bar; b.x = xb_xcc_id(); b.st = st;
    if (threadIdx.x == 0) (void)xb_add(&bar[XB_XCNT(b.x)], 1u);
    return b;
}
__device__ __forceinline__ void xcd_barrier_complete(unsigned* bar, unsigned x, unsigned& nloc, unsigned& nx) {
    const unsigned G = gridDim.x * gridDim.y * gridDim.z;
    unsigned sum, cnt, mine, sp = 0u;
    for (;;) {
        sum = 0u; cnt = 0u; mine = 0u;
#pragma unroll
        for (unsigned j = 0; j < 16; ++j) { const unsigned c = xb_ld(&bar[XB_XCNT(j)]); sum += c; cnt += (c > 0u) ? 1u : 0u; mine = (j == x) ? c : mine; }
        if (sum == G) break;
        __builtin_amdgcn_s_sleep(1);
        if ((++sp & 255u) == 0u) { if (xb_ld(&bar[XB_TMO])) break; if (sp > XB_SPIN_CAP) { atomicAdd(&bar[XB_TMO], 1u); break; } }
    }
    nloc = mine > 0u ? mine : 1u; nx = cnt > 0u ? cnt : 1u;
}
__device__ __forceinline__ void xcd_barrier(const XcdBarrier& b) {
    asm volatile("s_waitcnt vmcnt(0)" ::: "memory");
    __syncthreads();
    if (threadIdx.x == 0) {
        unsigned* bar = b.bar;
        __builtin_amdgcn_s_waitcnt(0);
        unsigned nloc = b.st[0], nx = b.st[1];
        if (nloc == 0u) { xcd_barrier_complete(bar, b.x, nloc, nx); b.st[0] = nloc; b.st[1] = nx; }
        const unsigned old = xb_add(&bar[XB_XSUB(b.x)], 1u);
        const unsigned gen = old / nloc;
        if (old + 1u == (gen + 1u) * nloc) {
            __builtin_amdgcn_fence(__ATOMIC_RELEASE, "agent");
            asm volatile("s_waitcnt vmcnt(0)" ::: "memory");
            const unsigned og = xb_add(&bar[XB_TOP], 1u);
            const unsigned tg = og / nx;
            if (og + 1u == (tg + 1u) * nx) xb_add(&bar[XB_TOPGEN], 1u);
            else XB_SPIN(xb_ld(&bar[XB_TOPGEN]) == tg, bar);
            __builtin_amdgcn_fence(__ATOMIC_ACQUIRE, "agent");
            xb_add(&bar[XB_XGEN(b.x)], 1u);
            asm volatile("s_waitcnt vmcnt(0)" ::: "memory");
        } else {
            XB_SPIN(xb_ld(&bar[XB_XGEN(b.x)]) == gen, bar);
            __builtin_amdgcn_fence(__ATOMIC_ACQUIRE, "agent");
            asm volatile("s_waitcnt vmcnt(0)" ::: "memory");
        }
    }
    __syncthreads();
}

constexpr int NPHASE = 10;
constexpr int NOJUMP = 1 << 30;
template <int LO, int HI>
__global__ void __launch_bounds__(NTHR, 2) fwd_kernel(Args a) {
    extern __shared__ __attribute__((aligned(16))) unsigned char lds_raw[];
    Frame F; F.lds = (LAS unsigned char*)lds_raw; F.tid = threadIdx.x; F.lane = F.tid & 63; F.wave = __builtin_amdgcn_readfirstlane(F.tid >> 6);
    F.G = gridDim.x; { const int bx = blockIdx.x; F.vcu = (F.G % 8 == 0) ? (bx % 8) * (F.G / 8) + bx / 8 : bx; }
    unsigned char* ws = a.ws; bf16_t* Z = (bf16_t*)(ws + WS_Z);
    unsigned char* slots = (unsigned char*)a.out;
    if (F.tid == 0) {
#pragma unroll
        for (int i = 0; i < 27; ++i) *(const float* LAS*)(F.lds + PTRS_OFF + i * 8) = a.in[i];
        *(volatile LAS unsigned*)(F.lds + PTRS_OFF + 224) = 0u; *(volatile LAS unsigned*)(F.lds + PTRS_OFF + 228) = 0u;
        *(LAS unsigned long long*)(F.lds + PTRS_OFF - 64) = 0ull;
    }
    __syncthreads();
#if ONE_LAUNCH && !USE_CG
    const XcdBarrier bar = xcd_barrier_post((unsigned*)(ws + WS_CTL), (volatile LAS unsigned*)(F.lds + PTRS_OFF + 224));
#endif
#if ONE_LAUNCH
#if PROBE_SEG >= 0 || PROBE_CLK >= 0
    unsigned long long* tsb = (unsigned long long*)(ws + WS_CTL + 15872); int nts = 0;
#define STAMP() do { if (blockIdx.x == 0 && F.tid == 0) { tsb[nts] = __builtin_amdgcn_s_memrealtime(); tsb[32 + nts] = __builtin_amdgcn_s_memtime(); } ++nts; } while (0)
    STAMP();
#else
#define STAMP() do { } while (0)
#endif
#if USE_CG
#define SEAM(k) do { if constexpr ((k) + 1 < HI) { cg::this_grid().sync(); STAMP(); } } while (0)
#define RSYNC() do { cg::this_grid().sync(); STAMP(); } while (0)
#else
#define SEAM(k) do { if constexpr ((k) + 1 < HI) { xcd_barrier(bar); STAMP(); } } while (0)
#define RSYNC() do { xcd_barrier(bar); STAMP(); } while (0)
#endif
#else
#define SEAM(k) do { } while (0)
#define RSYNC() do { } while (0)
#endif
#define IN(k) (LO <= (k) && (k) < HI)
    if constexpr (IN(0)) { p0_prologue(F, a); SEAM(0);
#if PROBE_DOUBLE == 4
        p0_prologue(F, a); RSYNC();
#endif
    }
    if constexpr (IN(1)) { pg8::Gemm g{(const char*)a.out, (const bf16_t*)(ws + WS_WIN), MTOK, ZP, DM, DM * 2, NOJUMP, 0}; pg8::StaticOrder S; S.init(MTOK, ZP, F.G, (int)blockIdx.x);
        pg8::EpiZ E{Z, ZP}; pg8::gemm_phase<pg8::EpiZ, pg8::StaticOrder, true>(F.lds, g, S, E); SEAM(1);
#if PROBE_DOUBLE == 3
        pg8::gemm_phase<pg8::EpiZ, pg8::StaticOrder, true>(F.lds, g, S, E); RSYNC();
#endif
    }
    if constexpr (IN(2)) { qk_prep(F, a);
        unsigned* rdy = (unsigned*)(ws + WS_CTL) + 3584;
#pragma unroll 1
        for (int rnd = 0; rnd < 2; ++rnd) {
            const int nprod = rnd == 1 ? F.G - 16 : F.G;
            if (F.vcu < nprod) {
#define S1_DECODE(i_, d_, q_, h_, ck_, it_, pub_) do { if (rnd == 1) { const int c_ = ((i_) >> 4) & 15, cc_ = (((i_) >> 8) << 4) + ((i_) & 15); d_ = c_ >> 3; h_ = c_ & 7; q_ = 0; ck_ = d_ ? 255 - cc_ : cc_; it_ = c_ * 256 + ck_; pub_ = rdy + c_ * 16 + ((i_) >> 8); } \
                    else { ck_ = (i_) & 31; h_ = ((i_) >> 5) & 7; q_ = 1 + (((i_) >> 8) & 7); d_ = (i_) >> 11; it_ = (i_); pub_ = nullptr; } } while (0)
                { int d, q, h, ck, it; unsigned* pub; S1_DECODE(F.vcu, d, q, h, ck, it, pub); (void)it; (void)pub;
                  u32x4 stg[6]; rw::s1_stage_load(a, F.tid, q, h, ck, stg); const f32x2_t par = rw::s1_param_load(F.lds, F.tid, d, h);
                  rw::s1_stage_store(F.lds, F.tid, d, q, ck, stg, par); LBAR(); }
                unsigned* pub_prev = nullptr;
#pragma unroll 1
                for (int i = F.vcu; i < 4096; i += nprod) {
                    int d, q, h, ck, it, nd, nq, nh, nck, nit; unsigned* pub; unsigned* npub; S1_DECODE(i, d, q, h, ck, it, pub); const int ni = i + nprod < 4096 ? i + nprod : i; S1_DECODE(ni, nd, nq, nh, nck, nit, npub); (void)nit; (void)npub;
                    rw::s1_item(F, a, d, q, h, ck, slots + (size_t)it * SLOT_BYTES, nd, nq, nh, nck, rnd == 1, pub_prev); pub_prev = pub; }
                if (pub_prev) { asm volatile("s_waitcnt vmcnt(0)" ::: "memory"); __syncthreads(); if (F.tid == 0) __hip_atomic_fetch_add(pub_prev, 1u, __ATOMIC_RELAXED, __HIP_MEMORY_SCOPE_AGENT); }
#undef S1_DECODE
            } else {
                const int c = F.vcu - nprod;
                rw::s23_chain_wg(F, a, c >> 3, 0, c & 7, slots + (size_t)c * 256 * SLOT_BYTES, rdy + c * 16);
            }
            if (rnd == 0) {
                RSYNC();
                for (int chain = F.vcu; chain < 128; chain += F.G) { const int h = chain & 7, q = 1 + ((chain >> 3) & 7), d = chain >> 6;
                    rw::s23_chain_wg(F, a, d, q, h, slots + (size_t)chain * 32 * SLOT_BYTES, nullptr); }
            }
            RSYNC();
            {
#define PO_DECODE(it_, q_, h_, b_) do { if (rnd == 1) { q_ = 0; h_ = ((it_) >> 8) & 7; b_ = (it_) & 255; } else { q_ = 1 + (((it_) >> 8) & 7); h_ = ((it_) >> 5) & 7; b_ = (it_) & 31; } } while (0)
                rw::PostPre pp;
                { int q, h, b; PO_DECODE(F.vcu, q, h, b); rw::post_stage_load(a, F.tid, q, h, b, pp); }
#pragma unroll 1
                for (int it = F.vcu; it < 2048; it += F.G) { int q, h, b, nq, nh, nb; PO_DECODE(it, q, h, b); const int nit = it + F.G < 2048 ? it + F.G : it; PO_DECODE(nit, nq, nh, nb);
                    rw::post_item(F, a, q, h, b, pp, nq, nh, nb); }
#undef PO_DECODE
            }
            if (rnd == 0) RSYNC();
        }
        SEAM(2); }
    if constexpr (IN(4)) {
        float lam; { const float p1 = wave_sum(a.in[6][F.lane] * a.in[7][F.lane]), p2 = wave_sum(a.in[8][F.lane] * a.in[9][F.lane]); lam = __expf(p1) - __expf(p2) + LAMBDA_INIT; }
#if PROBE_DOUBLE == 1
        for (int v = F.vcu; v < 256; v += F.G) {
            att::attn_unit(0, SP, v >> 6, v & 63, Z, F.lds, lam, a.in[10], (bf16_t*)a.out, 512);
            att::attn_unit(SP + (v >> 5) * SS, SS, (v >> 3) & 3, v & 7, Z, F.lds, lam, a.in[10], (bf16_t*)a.out, 512); }
        RSYNC();
#endif
        for (int v = F.vcu; v < 256; v += F.G) {
            att::attn_unit(0, SP, v >> 6, v & 63, Z, F.lds, lam, a.in[10], Z, ZP);
            att::attn_unit(SP + (v >> 5) * SS, SS, (v >> 3) & 3, v & 7, Z, F.lds, lam, a.in[10], Z, ZP); }
        SEAM(4); }
    if constexpr (IN(5)) { pg8::Gemm g{(const char*)Z, (const bf16_t*)(ws + WS_WOUT), MTOK, DM, DM, ZP * 2, 8, 2048}; pg8::StaticOrder S; S.init(MTOK, DM, F.G, (int)blockIdx.x);
        pg8::EpiOut E{a.in[0], a.in[1], a.out, Z, (float*)(ws + WS_ROWSQ)}; pg8::gemm_phase<pg8::EpiOut, pg8::StaticOrder, true>(F.lds, g, S, E); SEAM(5); }
#define FFN_UP(k, half) if constexpr (IN(k)) { pg8::Gemm g{(const char*)(Z + (size_t)(half) * 16384 * ZP + ZXN2), (const bf16_t*)(ws + WS_W1), 16384, DFF, DM, ZP * 2, NOJUMP, 0}; pg8::StaticOrder S; S.init(16384, DFF, F.G, (int)blockIdx.x); \
        pg8::EpiUp E{(char*)(ws + WS_Z), (const float*)(ws + WS_ROWSQ), (half) * 16384}; pg8::gemm_phase<pg8::EpiUp, pg8::StaticOrder, true>(F.lds, g, S, E); SEAM(k); }
#define FFN_DN(k, half) if constexpr (IN(k)) { pg8::Gemm g{(const char*)(ws + WS_Z), (const bf16_t*)(ws + WS_W2), 16384, DM, DFF, 13312, 32, 2560}; pg8::StaticOrder S; S.init(16384, DM, F.G, (int)blockIdx.x); \
        pg8::EpiDown E{a.out, (half) * 16384}; pg8::gemm_phase<pg8::EpiDown, pg8::StaticOrder, true>(F.lds, g, S, E); SEAM(k); }
    FFN_UP(6, 0) FFN_DN(7, 0) FFN_UP(8, 1) FFN_DN(9, 1)
#if PROBE_S1 >= 0 || PROBE_ATT
    if (F.tid == 0) { const unsigned long long dt = *(LAS unsigned long long*)(F.lds + PTRS_OFF - 64), t0_ = __builtin_amdgcn_s_memrealtime();
        while (__builtin_amdgcn_s_memrealtime() - t0_ < dt) __builtin_amdgcn_s_sleep(16); }
#endif
#if PROBE_SEG >= 0 || PROBE_CLK >= 0
    STAMP();
#if PROBE_CLK >= 0
    if (blockIdx.x == 0 && F.tid == 0) { asm volatile("s_waitcnt vmcnt(0)" ::: "memory"); const unsigned long long wt_ = tsb[PROBE_CLK + 1] - tsb[PROBE_CLK], cy_ = tsb[32 + PROBE_CLK + 1] - tsb[32 + PROBE_CLK];
        const unsigned long long dt = cy_ * 1000ull / (wt_ ? wt_ : 1ull), t0_ = __builtin_amdgcn_s_memrealtime();
        while (__builtin_amdgcn_s_memrealtime() - t0_ < dt) __builtin_amdgcn_s_sleep(16); }
#endif
    if (PROBE_CLK < 0 && blockIdx.x == 0 && F.tid == 0) { asm volatile("s_waitcnt vmcnt(0)" ::: "memory"); const unsigned long long dt = tsb[PROBE_SEG + 1] - tsb[PROBE_SEG], t0_ = __builtin_amdgcn_s_memrealtime();
        while (__builtin_amdgcn_s_memrealtime() - t0_ < dt) __builtin_amdgcn_s_sleep(16); }
#endif
#undef FFN_UP
#undef FFN_DN
#undef IN
#undef SEAM
#undef RSYNC
}

extern "C" void kernel_launch(void* const* d_in, const int* in_sizes, int n_in, void* d_out, int out_size, void* d_ws, size_t ws_size, hipStream_t stream) {
    static int grid = 0;
    if (grid == 0) {
        if (n_in != 27 || out_size != MTOK * DM || ws_size < WS_TOTAL) { fprintf(stderr, "kernel_launch: unexpected shapes (n_in %d out %d ws %zu)\n", n_in, out_size, ws_size); grid = -1; return; }
        int dev = 0, cus = 0; (void)hipGetDevice(&dev); (void)hipDeviceGetAttribute(&cus, hipDeviceAttributeMultiprocessorCount, dev);
        bool ok = true;
#if ONE_LAUNCH
        ok = ok && hipFuncSetAttribute((const void*)fwd_kernel<0, NPHASE>, hipFuncAttributeMaxDynamicSharedMemorySize, LDS_BYTES) == hipSuccess;
        int per_cu = 0; (void)hipOccupancyMaxActiveBlocksPerMultiprocessor(&per_cu, (const void*)fwd_kernel<0, NPHASE>, NTHR, LDS_BYTES); (void)hipGetLastError();
        if (per_cu < 1) fprintf(stderr, "kernel_launch: occupancy query says %d blocks/CU\n", per_cu);
#else
#define SETA(p) ok = ok && hipFuncSetAttribute((const void*)fwd_kernel<p, p + 1>, hipFuncAttributeMaxDynamicSharedMemorySize, LDS_BYTES) == hipSuccess;
        SETA(0) SETA(1) SETA(2) SETA(3) SETA(4) SETA(5) SETA(6) SETA(7) SETA(8) SETA(9)
#undef SETA
#endif
        if (!ok) { fprintf(stderr, "kernel_launch: hipFuncSetAttribute failed\n"); grid = -1; return; }
        grid = cus > 256 ? 256 : cus;
    }
    if (grid < 0) return;
    Args a{};
    for (int i = 0; i < 27; ++i) a.in[i] = (const float*)d_in[i];
    a.out = (float*)d_out; a.ws = (unsigned char*)d_ws;
#if ONE_LAUNCH
    a.ph_lo = 0; a.ph_hi = NPHASE;
#if !USE_CG
    if (hipMemsetAsync((char*)d_ws + WS_CTL, 0, CTL_ZERO_BYTES, stream) != hipSuccess) { fprintf(stderr, "kernel_launch: hipMemsetAsync failed\n"); return; }
#endif
    void* args[] = {&a};
    hipError_t e = hipLaunchCooperativeKernel((const void*)fwd_kernel<0, NPHASE>, dim3(grid), dim3(NTHR), args, LDS_BYTES, stream);
    if (e != hipSuccess) fprintf(stderr, "cooperative launch failed: %s (grid %d)\n", hipGetErrorString(e), grid);
#else
#define LAUNCH(p) hipLaunchKernelGGL((fwd_kernel<p, p + 1>), dim3(grid), dim3(NTHR), LDS_BYTES, stream, a);
    LAUNCH(0) LAUNCH(1) LAUNCH(2) LAUNCH(3) LAUNCH(4) LAUNCH(5) LAUNCH(6) LAUNCH(7) LAUNCH(8) LAUNCH(9)
#undef LAUNCH
#endif
}
```

```cpp
#include <hip/hip_runtime.h>
#include <hip/hip_cooperative_groups.h>
#include <cstdio>
#include <cstdint>
namespace cg = cooperative_groups;

#ifndef ONE_LAUNCH
#define ONE_LAUNCH 1
#endif
#ifndef USE_CG
#define USE_CG 0
#endif
#ifndef PROBE_SEG
#define PROBE_SEG -1
#endif
#ifndef PROBE_S1
#define PROBE_S1 -1
#endif
#ifndef PROBE_ATT
#define PROBE_ATT 0
#endif
#ifndef PROBE_CLK
#define PROBE_CLK -1
#endif
#ifndef PROBE_DOUBLE
#define PROBE_DOUBLE 0
#endif

#define LAS __attribute__((address_space(3)))
#define GAS __attribute__((address_space(1)))
typedef unsigned short bf16_t;
typedef short bf16x8 __attribute__((ext_vector_type(8)));
typedef short s16x4 __attribute__((ext_vector_type(4)));
typedef float f32x4 __attribute__((ext_vector_type(4)));
typedef float f32x16 __attribute__((ext_vector_type(16)));
typedef unsigned u32x4 __attribute__((ext_vector_type(4)));
typedef unsigned u32x2 __attribute__((ext_vector_type(2)));
typedef float f32x2_t __attribute__((ext_vector_type(2)));
typedef __bf16 bf16x2_t __attribute__((ext_vector_type(2)));

constexpr int MTOK = 32768, DM = 1024, ZP = 3328, DFF = 4096;
constexpr int SP = 16384, SS = 2048;
constexpr int ZQ = 0, ZK = 512, ZV = 1024, ZRR = 1536, ZRK = 2048, ZRV = 2560, ZWD = 3072, ZAD = 3136, ZGD = 3200;
constexpr int ZXN2 = 2048;
constexpr float NORM_EPS = 1e-6f, LNX_EPS = 64e-5f;
constexpr float QSCALE = 0.125f * 1.4426950408889634f;
constexpr float LAMBDA_INIT = 0.2f;
constexpr int NCHUNK_P = SP / 64, NCHUNK_S = SS / 64;

constexpr size_t MiB = 1u << 20;
constexpr size_t WS_CTL = 0;
constexpr size_t WS_WIN = 1 * MiB, WS_WOUT = 8 * MiB, WS_W1 = 10 * MiB, WS_W2 = 18 * MiB;
constexpr size_t WS_ROPE = 26 * MiB;
constexpr size_t WS_LORA = 30 * MiB;
constexpr size_t WS_ROWSQ = 31 * MiB;
constexpr size_t WS_BONUS = 33 * MiB;
constexpr size_t WS_Z = 36 * MiB;
constexpr size_t WS_END = 244 * MiB;
constexpr size_t WS_E1 = 244 * MiB;
constexpr size_t WS_TOTAL = 252 * MiB;
static_assert(WS_Z + (size_t)MTOK * ZP * 2 <= WS_END, "ws map");
constexpr size_t SLOT_BYTES = 32768;

__device__ __forceinline__ unsigned cvt_pk_bf16(float lo, float hi) { f32x2_t v = {lo, hi}; bf16x2_t b = __builtin_convertvector(v, bf16x2_t); return __builtin_bit_cast(unsigned, b); }
__device__ __forceinline__ float bf2f(unsigned short u) { return __uint_as_float(((unsigned)u) << 16); }
__device__ __forceinline__ float bflo(unsigned u) { return __uint_as_float(u << 16); }
__device__ __forceinline__ float bfhi(unsigned u) { return __uint_as_float(u & 0xffff0000u); }
__device__ __forceinline__ unsigned short f2bf(float f) { return (unsigned short)(cvt_pk_bf16(f, 0.f) & 0xffffu); }
__device__ __forceinline__ float wave_sum(float v) {
#pragma unroll
    for (int o = 1; o < 64; o <<= 1) v += __shfl_xor(v, o);
    return v;
}
__device__ __forceinline__ float wave_sum_dpp(float v) {
    int x = __float_as_int(v);
    v += __int_as_float(__builtin_amdgcn_update_dpp(0, x, 0xB1, 0xF, 0xF, true)); x = __float_as_int(v);
    v += __int_as_float(__builtin_amdgcn_update_dpp(0, x, 0x4E, 0xF, 0xF, true)); x = __float_as_int(v);
    v += __int_as_float(__builtin_amdgcn_update_dpp(0, x, 0x124, 0xF, 0xF, true)); x = __float_as_int(v);
    v += __int_as_float(__builtin_amdgcn_update_dpp(0, x, 0x128, 0xF, 0xF, true)); x = __float_as_int(v);
    const float a = __int_as_float(__builtin_amdgcn_readlane(x, 0)), b = __int_as_float(__builtin_amdgcn_readlane(x, 16)), c = __int_as_float(__builtin_amdgcn_readlane(x, 32)), d = __int_as_float(__builtin_amdgcn_readlane(x, 48));
    return (a + b) + (c + d);
}
__device__ __forceinline__ void wave_sum8(float (&s)[8], int lane) {
    float f[4];
#pragma unroll
    for (int i = 0; i < 4; ++i) { auto rr = __builtin_amdgcn_permlane32_swap(__float_as_uint(s[i]), __float_as_uint(s[i + 4]), false, false); f[i] = __uint_as_float(rr[0]) + __uint_as_float(rr[1]); }
    const bool b4 = (lane >> 4) & 1, b3 = (lane >> 3) & 1;
    float g[2];
#pragma unroll
    for (int i = 0; i < 2; ++i) { const float keep = b4 ? f[i + 2] : f[i], send = b4 ? f[i] : f[i + 2];
        g[i] = keep + __int_as_float(__builtin_amdgcn_ds_swizzle(__float_as_int(send), 0x401F)); }
    const float keep = b3 ? g[1] : g[0], send = b3 ? g[0] : g[1];
    float h = keep + __int_as_float(__builtin_amdgcn_update_dpp(0, __float_as_int(send), 0x128, 0xF, 0xF, true));
    h += __int_as_float(__builtin_amdgcn_update_dpp(0, __float_as_int(h), 0x141, 0xF, 0xF, true));
    h += __int_as_float(__builtin_amdgcn_update_dpp(0, __float_as_int(h), 0xB1, 0xF, 0xF, true));
    h += __int_as_float(__builtin_amdgcn_update_dpp(0, __float_as_int(h), 0x4E, 0xF, 0xF, true));
    const int hx = __float_as_int(h);
#pragma unroll
    for (int k = 0; k < 8; ++k) s[k] = __int_as_float(__builtin_amdgcn_readlane(hx, 8 * k));
}
#define LDS_WAIT() asm volatile("s_waitcnt lgkmcnt(0)" ::: "memory")
#define VM_WAIT() asm volatile("s_waitcnt vmcnt(0)" ::: "memory")
#define LBAR() asm volatile("s_waitcnt lgkmcnt(0)\n\ts_barrier" ::: "memory")

namespace pg8 {
constexpr int BM = 256, BK = 64, HALF = 128, HTB = HALF * BK * 2, STAGE_BYTES = 8 * HTB, NXCD = 8, WGM = 8;
__host__ __device__ __forceinline__ int lds_byte(int r, int c) { const int st = (r >> 4) * 2 + (c >> 5), rr = r & 15, cc = c & 31, ob = rr * 64 + cc * 2; return st * 1024 + (ob ^ (((ob >> 9) & 1) << 5)); }
__host__ __device__ __forceinline__ void stage_rc(int b, int& R, int& C) { const int st = b / 1024, sb = b % 1024, swz = sb ^ (((sb >> 9) & 1) << 5); R = (st >> 1) * 16 + swz / 64; C = (st & 1) * 32 + (swz % 64) / 2; }
__host__ __device__ __forceinline__ int perm32(int rho) { const int n = rho >> 4, i = rho & 15; return 8 * (i >> 2) + 4 * n + (i & 3); }
struct Unit { int pm, pn; };
struct Gemm { const char* A; const bf16_t* Bt; int M, N, K; int lda; int jkt; int jbytes; };
struct StaticOrder {
    int nM, nN, nwg, G, c;
    __host__ __device__ void init(int M, int N, int G_, int c_) { nM = M / BM; nN = N / BM; nwg = nM * nN; G = G_; c = c_; }
    __host__ __device__ bool next(int i, Unit& u) const {
        const long L = (long)i * G + c; if (L >= nwg) return false;
        int wgid = (int)L; { const int q = nwg / NXCD, r = nwg % NXCD, xcd = wgid % NXCD, off = wgid / NXCD; wgid = (xcd < r ? xcd * (q + 1) : r * (q + 1) + (xcd - r) * q) + off; }
        const int nig = WGM * nN, gid = wgid / nig, fm = gid * WGM, gsz = (nM - fm) < WGM ? (nM - fm) : WGM;
        u.pm = fm + ((wgid % nig) % gsz); u.pn = (wgid % nig) / gsz; return true;
    }
};

struct EpiZ {
    static constexpr bool PERM = true;
    bf16_t* O; int ldc;
    __device__ __forceinline__ void operator()(const f32x4 (&acc)[2][2][4][2], const Unit& u, int wr, int wc, int fr, int fq) const {
        const int row0 = u.pm * BM + wr * 64 + fr, col0 = u.pn * BM + wc * 32 + 8 * fq;
#pragma unroll
        for (int ai = 0; ai < 2; ++ai)
#pragma unroll
            for (int m = 0; m < 4; ++m) { bf16_t* rowp = O + (size_t)(row0 + ai * HALF + m * 16) * ldc + col0;
#pragma unroll
                for (int bj = 0; bj < 2; ++bj) { const f32x4 v0 = acc[ai][bj][m][0], v1 = acc[ai][bj][m][1];
                    u32x4 w; w.x = cvt_pk_bf16(v0[0], v0[1]); w.y = cvt_pk_bf16(v0[2], v0[3]); w.z = cvt_pk_bf16(v1[0], v1[1]); w.w = cvt_pk_bf16(v1[2], v1[3]);
                    *(u32x4*)(rowp + bj * HALF) = w; } }
    }
};
struct EpiOut {
    static constexpr bool PERM = true;
    const float* xp; const float* xs; float* out; bf16_t* Z; float* rowsq;
    __device__ __forceinline__ void operator()(const f32x4 (&acc)[2][2][4][2], const Unit& u, int wr, int wc, int fr, int fq) const {
        const int col0 = u.pn * BM + wc * 32 + 8 * fq;
#pragma unroll
        for (int ai = 0; ai < 2; ++ai)
#pragma unroll
            for (int m = 0; m < 4; ++m) { const int r = u.pm * BM + ai * HALF + wr * 64 + m * 16 + fr;
                const float* xr = (r < SP ? xp + (size_t)r * DM : xs + (size_t)(r - SP) * DM) + col0; float* orow = out + (size_t)r * DM + col0; bf16_t* zr = Z + (size_t)r * ZP + ZXN2 + col0;
                float ss = 0.f;
#pragma unroll
                for (int bj = 0; bj < 2; ++bj) { const f32x4 x0 = *(const f32x4*)(xr + bj * HALF), x1 = *(const f32x4*)(xr + bj * HALF + 4);
                    const f32x4 o0 = x0 + acc[ai][bj][m][0], o1 = x1 + acc[ai][bj][m][1];
                    *(f32x4*)(orow + bj * HALF) = o0; *(f32x4*)(orow + bj * HALF + 4) = o1;
                    ss += ((o0[0] * o0[0] + o0[1] * o0[1]) + (o0[2] * o0[2] + o0[3] * o0[3])) + ((o1[0] * o1[0] + o1[1] * o1[1]) + (o1[2] * o1[2] + o1[3] * o1[3]));
                    u32x4 w; w.x = cvt_pk_bf16(o0[0], o0[1]); w.y = cvt_pk_bf16(o0[2], o0[3]); w.z = cvt_pk_bf16(o1[0], o1[1]); w.w = cvt_pk_bf16(o1[2], o1[3]); *(u32x4*)(zr + bj * HALF) = w; }
                ss += __shfl_xor(ss, 16); ss += __shfl_xor(ss, 32);
                if (fq == 0) rowsq[(size_t)r * 16 + u.pn * 4 + wc] = ss;
                if (m & 1) asm volatile("" ::: "memory"); }
    }
};
struct EpiUp {
    static constexpr bool PERM = true;
    char* H; const float* rowsq; int row_off;
    __device__ __forceinline__ void operator()(const f32x4 (&acc)[2][2][4][2], const Unit& u, int wr, int wc, int fr, int fq) const {
        const int row0 = u.pm * BM + wr * 64 + fr, col0 = u.pn * BM + wc * 32 + 8 * fq;
#pragma unroll
        for (int ai = 0; ai < 2; ++ai)
#pragma unroll
            for (int m = 0; m < 4; ++m) { const int r = row0 + ai * HALF + m * 16; const f32x4* rq = (const f32x4*)(rowsq + (size_t)(row_off + r) * 16);
                const f32x4 q0 = rq[0], q1 = rq[1], q2 = rq[2], q3 = rq[3];
                const float ssum = ((q0[0] + q0[1]) + (q0[2] + q0[3])) + ((q1[0] + q1[1]) + (q1[2] + q1[3])) + ((q2[0] + q2[1]) + (q2[2] + q2[3])) + ((q3[0] + q3[1]) + (q3[2] + q3[3]));
                const float rstd = __builtin_amdgcn_rsqf(ssum * (1.0f / DM) + NORM_EPS);
                char* rowp = H + (size_t)r * 13312;
#pragma unroll
                for (int bj = 0; bj < 2; ++bj) { const int c = col0 + bj * HALF; f32x4 v0 = acc[ai][bj][m][0] * rstd, v1 = acc[ai][bj][m][1] * rstd;
#pragma unroll
                    for (int e = 0; e < 4; ++e) { const float a = fmaxf(v0[e], 0.f), b = fmaxf(v1[e], 0.f); v0[e] = a * a; v1[e] = b * b; }
                    u32x4 w; w.x = cvt_pk_bf16(v0[0], v0[1]); w.y = cvt_pk_bf16(v0[2], v0[3]); w.z = cvt_pk_bf16(v1[0], v1[1]); w.w = cvt_pk_bf16(v1[2], v1[3]);
                    *(u32x4*)(rowp + (size_t)c * 2 + (c >= 2048 ? 2560 : 0)) = w; } }
    }
};
struct EpiDown {
    static constexpr bool PERM = true;
    float* out; int row_off;
    __device__ __forceinline__ void operator()(const f32x4 (&acc)[2][2][4][2], const Unit& u, int wr, int wc, int fr, int fq) const {
        const int col0 = u.pn * BM + wc * 32 + 8 * fq;
#pragma unroll
        for (int ai = 0; ai < 2; ++ai)
#pragma unroll
            for (int m = 0; m < 4; ++m) { const int r = row_off + u.pm * BM + ai * HALF + wr * 64 + m * 16 + fr; float* orow = out + (size_t)r * DM + col0;
#pragma unroll
                for (int bj = 0; bj < 2; ++bj) { const f32x4 x0 = *(const f32x4*)(orow + bj * HALF), x1 = *(const f32x4*)(orow + bj * HALF + 4);
                    *(f32x4*)(orow + bj * HALF) = x0 + acc[ai][bj][m][0]; *(f32x4*)(orow + bj * HALF + 4) = x1 + acc[ai][bj][m][1]; }
                if (m & 1) asm volatile("" ::: "memory"); }
    }
};

template <class Epi, class Sched, bool ALIGN_EPI>
__device__ __forceinline__ void gemm_phase(LAS unsigned char* lds, const Gemm g, const Sched& S, const Epi& E) {
    int tid_ = threadIdx.x; asm volatile("" : "+v"(tid_));
    const int tid = tid_, wid = __builtin_amdgcn_readfirstlane(tid >> 6), lane = tid & 63, wr = wid >> 2, wc = wid & 3, fr = lane & 15, fq = lane >> 4;
    const int K = g.K, nt = K / BK;
    unsigned voffA[2], voffB[2];
#pragma unroll
    for (int i = 0; i < 2; ++i) { int R, C; stage_rc(tid * 16 + i * 8192, R, C); const int Rb = Epi::PERM ? ((R & ~31) + perm32(R & 31)) : R;
        voffA[i] = (unsigned)(R * g.lda + C * 2); voffB[i] = (unsigned)(Rb * K + C) * 2u; }
    const size_t kstep = (size_t)(BK * 2);
    const size_t hstepA = (size_t)HALF * g.lda, tstepA = 2 * hstepA;
    const size_t hstepB = (size_t)HALF * K * 2, tstepB = 2 * hstepB;
    const unsigned ldsw = (unsigned)wid * 1024u;
    const int aoff = lds_byte(wr * 64 + fr, fq * 8), boff = lds_byte(wc * 32 + fr, fq * 8);
#define PG8_AOFF(kt) ((size_t)(kt) * kstep + ((kt) >= g.jkt ? (size_t)g.jbytes : (size_t)0))
#define PG8_SA(b, h) (((b) * 2 + (h)) * HTB)
#define PG8_SB(b, h) ((4 + (b) * 2 + (h)) * HTB)
#define PG8_STAGE(bufoff, gbase, voff) do { _Pragma("unroll") for (int _i = 0; _i < 2; ++_i) \
        __builtin_amdgcn_global_load_lds((const unsigned*)((const char*)(gbase) + (voff)[_i]), (LAS unsigned*)(lds + (bufoff) + ldsw + _i * 8192), 16, 0, 0); } while (0)
#define PG8_LDA(dst, b, h) do { _Pragma("unroll") for (int m = 0; m < 4; ++m) _Pragma("unroll") for (int k = 0; k < 2; ++k) dst[m][k] = *(const LAS bf16x8*)(lds + PG8_SA(b, h) + aoff + m * 2048 + k * 1024); } while (0)
#define PG8_LDB(dst, b, h) do { _Pragma("unroll") for (int n = 0; n < 2; ++n) _Pragma("unroll") for (int k = 0; k < 2; ++k) dst[n][k] = *(const LAS bf16x8*)(lds + PG8_SB(b, h) + boff + n * 2048 + k * 1024); } while (0)
#define PG8_MMA(ai, bj, At, Bt) do { __builtin_amdgcn_s_setprio(1); _Pragma("unroll") for (int m = 0; m < 4; ++m) _Pragma("unroll") for (int n = 0; n < 2; ++n) _Pragma("unroll") for (int k = 0; k < 2; ++k) \
        acc[ai][bj][m][n] = __builtin_amdgcn_mfma_f32_16x16x32_bf16(Bt[n][k], At[m][k], acc[ai][bj][m][n], 0, 0, 0); __builtin_amdgcn_s_setprio(0); } while (0)
#define PG8_WAIT_V(n) asm volatile("s_waitcnt vmcnt(" #n ")" ::: "memory")
#define PG8_WAIT_L(n) asm volatile("s_waitcnt lgkmcnt(" #n ")" ::: "memory")
#define PG8_BAR __builtin_amdgcn_s_barrier()
#define PG8_SCHED __builtin_amdgcn_sched_barrier(0)
    Unit cur, nxt; int ui = 0;
    if (!S.next(0, cur)) return;
    f32x4 acc[2][2][4][2];
#pragma unroll
    for (int a = 0; a < 2; ++a)
#pragma unroll
        for (int b = 0; b < 2; ++b)
#pragma unroll
            for (int m = 0; m < 4; ++m)
#pragma unroll
                for (int n = 0; n < 2; ++n) acc[a][b][m][n] = (f32x4){0.f, 0.f, 0.f, 0.f};
    bf16x8 At[4][2], B0[2][2], B1[2][2];
    const char* cA = g.A + (size_t)cur.pm * tstepA; const char* cB = (const char*)g.Bt + (size_t)cur.pn * tstepB;
    {
        PG8_STAGE(PG8_SB(0, 0), cB, voffB); PG8_STAGE(PG8_SB(0, 1), cB + hstepB, voffB); PG8_STAGE(PG8_SA(0, 0), cA + PG8_AOFF(0), voffA); PG8_STAGE(PG8_SA(0, 1), cA + hstepA + PG8_AOFF(0), voffA);
        if (wr == 1) PG8_BAR;
        PG8_WAIT_V(2); PG8_BAR;
        PG8_STAGE(PG8_SB(1, 0), cB + kstep, voffB); PG8_STAGE(PG8_SA(1, 0), cA + PG8_AOFF(1), voffA); PG8_STAGE(PG8_SB(1, 1), cB + hstepB + kstep, voffB);
        PG8_WAIT_V(6); PG8_BAR;
    }
    for (;;) {
        const bool has_next = S.next(ui + 1, nxt);
        const char* nA = has_next ? g.A + (size_t)nxt.pm * tstepA : cA; const char* nB = has_next ? (const char*)g.Bt + (size_t)nxt.pn * tstepB : cB;
        for (int t = 0; t < nt; t += 2) {
            const bool last = (t == nt - 2);
            const char* a1 = cA + PG8_AOFF(t + 1);
            const char* a2 = last ? nA + PG8_AOFF(0) : cA + PG8_AOFF(t + 2); const char* b2 = last ? nB : cB + (size_t)(t + 2) * kstep;
            const char* a3 = last ? nA + PG8_AOFF(1) : cA + PG8_AOFF(t + 3); const char* b3 = b2 + kstep;
            PG8_LDB(B0, 0, 0); PG8_LDB(B1, 0, 1); PG8_SCHED; PG8_LDA(At, 0, 0); PG8_STAGE(PG8_SA(1, 1), a1 + hstepA, voffA);
            PG8_WAIT_V(8); PG8_WAIT_L(0); PG8_BAR; PG8_MMA(0, 0, At, B0); PG8_MMA(0, 1, At, B1); PG8_BAR; PG8_SCHED;
            PG8_LDA(At, 0, 1); PG8_STAGE(PG8_SB(0, 0), b2, voffB); PG8_STAGE(PG8_SB(0, 1), b2 + hstepB, voffB); PG8_STAGE(PG8_SA(0, 0), a2, voffA);
            PG8_WAIT_V(8); PG8_WAIT_L(0); PG8_BAR; PG8_MMA(1, 0, At, B0); PG8_MMA(1, 1, At, B1); PG8_BAR; PG8_SCHED;
            PG8_LDB(B0, 1, 0); PG8_LDB(B1, 1, 1); PG8_SCHED; PG8_LDA(At, 1, 0); PG8_STAGE(PG8_SA(0, 1), a2 + hstepA, voffA);
            PG8_WAIT_V(8); PG8_WAIT_L(0); PG8_BAR; PG8_MMA(0, 0, At, B0); PG8_MMA(0, 1, At, B1); PG8_BAR; PG8_SCHED;
            PG8_LDA(At, 1, 1); PG8_STAGE(PG8_SB(1, 0), b3, voffB); PG8_STAGE(PG8_SB(1, 1), b3 + hstepB, voffB); PG8_STAGE(PG8_SA(1, 0), a3, voffA);
            PG8_WAIT_V(8); PG8_WAIT_L(0); PG8_BAR; PG8_MMA(1, 0, At, B0); PG8_MMA(1, 1, At, B1); PG8_BAR; PG8_SCHED;
        }
        if constexpr (ALIGN_EPI) { if (wr == 0) PG8_BAR; }
        E(acc, cur, wr, wc, fr, fq);
        if (!has_next) break;
#pragma unroll
        for (int a = 0; a < 2; ++a)
#pragma unroll
            for (int b = 0; b < 2; ++b)
#pragma unroll
                for (int m = 0; m < 4; ++m)
#pragma unroll
                    for (int n = 0; n < 2; ++n) acc[a][b][m][n] = (f32x4){0.f, 0.f, 0.f, 0.f};
        cur = nxt; cA = nA; cB = nB; ++ui;
        if constexpr (ALIGN_EPI) { if (wr == 1) PG8_BAR; }
    }
    PG8_WAIT_V(0);
    if constexpr (!ALIGN_EPI) { if (wr == 0) PG8_BAR; }
    PG8_BAR;
#undef PG8_AOFF
#undef PG8_SA
#undef PG8_SB
#undef PG8_STAGE
#undef PG8_LDA
#undef PG8_LDB
#undef PG8_MMA
#undef PG8_WAIT_V
#undef PG8_WAIT_L
#undef PG8_BAR
#undef PG8_SCHED
}
}

constexpr int NWAVES = 8, NTHR = 512;
constexpr int LDS_BYTES = 163840;
struct Args {
    const float* in[27]; float* out; unsigned char* ws; int ph_lo, ph_hi;
};
struct Frame {
    LAS unsigned char* lds; int tid, lane, wave, vcu, G;
};
constexpr int PTRS_OFF = LDS_BYTES - 256;
__device__ __forceinline__ const float* inp(LAS unsigned char* lds, int i) { return *(const float* LAS*)(lds + PTRS_OFF + i * 8); }
__device__ __forceinline__ float gld(const float* p) { return *(const GAS float*)p; }
__device__ __forceinline__ int seq_row0(int q) { return q == 0 ? 0 : SP + (q - 1) * SS; }
__device__ __forceinline__ int seq_len(int q) { return q == 0 ? SP : SS; }

__device__ __forceinline__ void p0_transpose_item(const float* W, int K, int N, bf16_t* WT, const float* kscale, LAS float* scr, int item, int lane) {
    const int nblk = N / 32, kb = item / nblk, nb = item % nblk, k0 = 64 * kb, n0 = 32 * nb;
#pragma unroll 8
    for (int i = 0; i < 32; ++i) { const int kk = 2 * i + (lane >> 5); float v = W[(size_t)(k0 + kk) * N + n0 + (lane & 31)]; if (kscale) v *= kscale[k0 + kk]; scr[kk * 33 + (lane & 31)] = v; }
    LDS_WAIT(); asm volatile("" ::: "memory");
    const int c = lane & 7;
#pragma unroll
    for (int j = 0; j < 4; ++j) { const int n = (lane >> 3) + 8 * j; const LAS float* s = scr + (8 * c) * 33 + n;
        u32x4 o; o.x = cvt_pk_bf16(s[0 * 33], s[1 * 33]); o.y = cvt_pk_bf16(s[2 * 33], s[3 * 33]); o.z = cvt_pk_bf16(s[4 * 33], s[5 * 33]); o.w = cvt_pk_bf16(s[6 * 33], s[7 * 33]);
        *(u32x4*)(WT + (size_t)(n0 + n) * K + k0 + 8 * c) = o; }
    LDS_WAIT(); asm volatile("" ::: "memory");
}
__device__ __forceinline__ void p0_prologue(const Frame& F, const Args& a) {
    LAS float* scr = (LAS float*)(F.lds + F.wave * 16384);
    const int gw = F.vcu * NWAVES + F.wave, NGW = F.G * NWAVES;
    unsigned char* ws = a.ws;
    constexpr int I_IN = (DM / 64) * (ZP / 32), I_O = (DM / 64) * (DM / 32), I_1 = (DM / 64) * (DFF / 32), I_2 = (DFF / 64) * (DM / 32);
    for (int it = gw; it < I_IN + I_O + I_1 + I_2; it += NGW) {
        int r = it;
        if (r < I_IN) { p0_transpose_item(a.in[3], DM, ZP, (bf16_t*)(ws + WS_WIN), nullptr, scr, r, F.lane); continue; } r -= I_IN;
        if (r < I_O) { p0_transpose_item(a.in[23], DM, DM, (bf16_t*)(ws + WS_WOUT), nullptr, scr, r, F.lane); continue; } r -= I_O;
        if (r < I_1) { p0_transpose_item(a.in[25], DM, DFF, (bf16_t*)(ws + WS_W1), a.in[24], scr, r, F.lane); continue; } r -= I_1;
        p0_transpose_item(a.in[26], DFF, DM, (bf16_t*)(ws + WS_W2), nullptr, scr, r, F.lane);
    }
    bf16_t* XN = (bf16_t*)a.out; const float* g1 = a.in[2];
    for (int m = gw; m < MTOK; m += NGW) {
        const float* xrow = m < SP ? a.in[0] + (size_t)m * DM : a.in[1] + (size_t)(m - SP) * DM;
        const f32x4* xr = (const f32x4*)xrow + F.lane; f32x4 v[4]; float s = 0.f;
#pragma unroll
        for (int j = 0; j < 4; ++j) { v[j] = xr[64 * j]; s += (v[j][0] * v[j][0] + v[j][1] * v[j][1]) + (v[j][2] * v[j][2] + v[j][3] * v[j][3]); }
        const float rstd = 1.0f / sqrtf(wave_sum(s) * (1.f / DM) + NORM_EPS);
        u32x2* o8 = (u32x2*)(XN + (size_t)m * DM) + F.lane;
#pragma unroll
        for (int j = 0; j < 4; ++j) { const f32x4 gv = ((const f32x4*)g1)[F.lane + 64 * j]; u32x2 w; w.x = cvt_pk_bf16(v[j][0] * rstd * gv[0], v[j][1] * rstd * gv[1]); w.y = cvt_pk_bf16(v[j][2] * rstd * gv[2], v[j][3] * rstd * gv[3]); o8[64 * j] = w; }
    }
    const int gt = F.vcu * NTHR + F.tid, NGT = F.G * NTHR;
    float* rope = (float*)(ws + WS_ROPE);
    for (int e = gt; e < SP * 32; e += NGT) { const int pos = e >> 5, i = e & 31;
        const float invf = 1.0f / powf(10000.0f, (float)(2 * i) / 64.0f); const float ang = (float)pos * invf; float sn, cs; sincosf(ang, &sn, &cs);
        rope[2 * e] = cs; rope[2 * e + 1] = sn; }
    bf16_t* wupT = (bf16_t*)(ws + WS_LORA); bf16_t* aupT = wupT + 2 * 512 * 64; bf16_t* gupT = aupT + 2 * 512 * 64;
    for (int e = gt; e < 2 * 512 * 64; e += NGT) { const int d = e >> 15, c = (e >> 6) & 511, r = e & 63;
        wupT[e] = f2bf(a.in[14][((size_t)d * 64 + r) * 512 + c]); aupT[e] = f2bf(a.in[16][((size_t)d * 64 + r) * 512 + c]); }
    for (int e = gt; e < 512 * 128; e += NGT) { const int c = e >> 7, r = e & 127; gupT[e] = f2bf(a.in[17][(size_t)r * 512 + c]); }
}

__device__ __forceinline__ void qk_prep(const Frame& F, const Args& a) {
    const int gw = F.vcu * NWAVES + F.wave, NGW = F.G * NWAVES;
    bf16_t* Z = (bf16_t*)(a.ws + WS_Z); const float* rope = (const float*)(a.ws + WS_ROPE);
    const int g = F.lane >> 2, qd = F.lane & 3;
    const float* gain = (g < 8) ? a.in[4] : a.in[5];
    float glo[8], ghi[8];
#pragma unroll
    for (int j = 0; j < 8; ++j) { glo[j] = gain[8 * qd + j]; ghi[j] = gain[32 + 8 * qd + j]; }
    const float osc = (g < 8) ? QSCALE : 1.0f;
    const float mpw = a.in[11][ZWD - ZRR + F.lane], mnw = a.in[12][ZWD - ZRR + F.lane], mpa = a.in[11][ZAD - ZRR + F.lane], mna = a.in[12][ZAD - ZRR + F.lane];
    for (int blk = gw; blk < MTOK / 16; blk += NGW) {
        const int m0 = blk * 16;
        const int pos0 = m0 < SP ? m0 : ((m0 - SP) & (SS - 1)); const int S = m0 < SP ? SP : SS;
        {
            float zw[18], za[18]; const bf16_t* zr = Z + (size_t)m0 * ZP; const int j = F.lane;
#pragma unroll
            for (int i = 0; i < 18; ++i) { const int pp = pos0 - 1 + i; const bool ok = pp >= 0 && pp < S; const long ro = (long)(ok ? i - 1 : 0) * ZP;
                const float w_ = bf2f(zr[ro + ZWD + j]), a_ = bf2f(zr[ro + ZAD + j]); zw[i] = ok ? w_ : 0.f; za[i] = ok ? a_ : 0.f; }
            bf16_t* e1 = (bf16_t*)(a.ws + WS_E1) + (size_t)m0 * 128;
#pragma unroll
            for (int i = 0; i < 16; ++i) { const float wc = zw[i + 1], ac = za[i + 1];
                const float ws_ = wc + mpw * (zw[i] - wc) + mnw * (zw[i + 2] - wc), as_ = ac + mpa * (za[i] - ac) + mna * (za[i + 2] - ac);
                e1[i * 128 + j] = f2bf(1.0f - 2.0f * __builtin_amdgcn_rcpf(__expf(2.0f * ws_) + 1.0f)); e1[i * 128 + 64 + j] = f2bf(as_); }
        }
#pragma unroll 4
        for (int i = 0; i < 16; ++i) {
            const int m = m0 + i, pos = pos0 + i;
            bf16_t* p = Z + (size_t)m * ZP + g * 64 + 8 * qd;
            const u32x4 lo4 = *(const u32x4*)p, hi4 = *(const u32x4*)(p + 32);
            float lo[8], hi[8];
#pragma unroll
            for (int j = 0; j < 4; ++j) { lo[2 * j] = bflo(lo4[j]); lo[2 * j + 1] = bfhi(lo4[j]); hi[2 * j] = bflo(hi4[j]); hi[2 * j + 1] = bfhi(hi4[j]); }
            float ss = 0.f;
#pragma unroll
            for (int j = 0; j < 8; ++j) ss += lo[j] * lo[j] + hi[j] * hi[j];
            ss += __shfl_xor(ss, 1); ss += __shfl_xor(ss, 2);
            const float rstd = __builtin_amdgcn_rsqf(ss * (1.f / 64.f) + NORM_EPS);
            const f32x4* rp = (const f32x4*)(rope + ((size_t)pos * 32 + 8 * qd) * 2);
            float ol[8], oh[8];
#pragma unroll
            for (int j2 = 0; j2 < 4; ++j2) { const f32x4 cs = rp[j2];
#pragma unroll
                for (int e = 0; e < 2; ++e) { const int j = 2 * j2 + e; const float c = cs[2 * e], sn = cs[2 * e + 1]; const float l = lo[j] * rstd * glo[j], h = hi[j] * rstd * ghi[j];
                    ol[j] = (l * c - h * sn) * osc; oh[j] = (h * c + l * sn) * osc; } }
            u32x4 wl, wh;
#pragma unroll
            for (int j = 0; j < 4; ++j) { wl[j] = cvt_pk_bf16(ol[2 * j], ol[2 * j + 1]); wh[j] = cvt_pk_bf16(oh[2 * j], oh[2 * j + 1]); }
            *(u32x4*)p = wl; *(u32x4*)(p + 32) = wh;
        }
    }
}

namespace att {
constexpr int KSLOT = 8192, VSLOT = 16384, NKS = 4, NVS = 3;
constexpr int L_K = 0, L_V = NKS * KSLOT, L_WS = L_V + NVS * VSLOT, L_ST = L_WS + NWAVES * 256, L_END = L_ST + NWAVES * 8192;
static_assert(L_END <= PTRS_OFF, "attention lds");
__device__ __forceinline__ int crow(int r, int hi) { return (r & 3) + 8 * (r >> 2) + 4 * hi; }
__device__ __forceinline__ void glds16(const void* gsrc, unsigned lds_dst) { unsigned keep;
    asm volatile("s_mov_b32 %0, m0\n\ts_mov_b32 m0, %2\n\ts_nop 0\n\tglobal_load_lds_dwordx4 %1, off\n\ts_mov_b32 m0, %0" : "=&s"(keep) : "v"(gsrc), "s"(lds_dst) : "memory"); }
typedef short v4i16_t __attribute__((ext_vector_type(4)));
typedef const LAS char* lds_cptr;
__device__ __forceinline__ s16x4 vtr(lds_cptr p) { return __builtin_bit_cast(s16x4, __builtin_amdgcn_ds_read_tr16_b64_v4i16((LAS v4i16_t*)p)); }
#define SBAR() __builtin_amdgcn_sched_barrier(0)
#define WAIT_BAR(N) asm volatile("s_waitcnt vmcnt(" #N ") lgkmcnt(0)\n\ts_barrier" ::: "memory")
__device__ __forceinline__ void kload8(bf16x8* kf, lds_cptr kp) {
    kf[0] = *(const LAS bf16x8*)(kp);        kf[1] = *(const LAS bf16x8*)(kp + 512);
    kf[2] = *(const LAS bf16x8*)(kp + 2048); kf[3] = *(const LAS bf16x8*)(kp + 2560);
    kf[4] = *(const LAS bf16x8*)(kp + 4096); kf[5] = *(const LAS bf16x8*)(kp + 4608);
    kf[6] = *(const LAS bf16x8*)(kp + 6144); kf[7] = *(const LAS bf16x8*)(kp + 6656);
}
__device__ __forceinline__ void kload2(bf16x8* kf, lds_cptr kp, int j) { kf[2 * j] = *(const LAS bf16x8*)(kp + j * 2048); kf[2 * j + 1] = *(const LAS bf16x8*)(kp + j * 2048 + 512); }

__device__ __forceinline__ void attn_unit(int row0, int S, int h, int qb, bf16_t* Z, LAS unsigned char* shm, float lam, const float* subln_g, bf16_t* Ob, int opitch) {
    int tid_ = threadIdx.x; asm volatile("" : "+v"(tid_));
    const int tid = tid_, lane = tid & 63, r32 = lane & 31, hi = lane >> 5; const int wid = __builtin_amdgcn_readfirstlane(tid >> 6);
    const unsigned lds0 = (unsigned)(uintptr_t)shm;
    LAS float* wsf = (LAS float*)(shm + L_WS) + wid * 64;
    LAS bf16_t* stash = (LAS bf16_t*)(shm + L_ST) + wid * 4096;
    const int NT = S / 64;
    const size_t qrow = (size_t)(row0 + qb * 256 + wid * 32);
    const lds_cptr shm3 = (lds_cptr)shm;
    const lds_cptr kp0 = shm3 + L_K + hi * 1024 + r32 * 16;
    const lds_cptr vp0 = shm3 + L_V + ((lane >> 4) & 1) * 32 + (lane & 3) * 8 + (4 * hi + ((lane & 15) >> 2)) * 64;
    f32x16 o[4];
#pragma unroll 1
    for (int c = 0; c < 2; ++c) {
        const bf16_t* Qw = Z + qrow * ZP + ZQ + h * 128 + c * 64;
        const bf16_t* Kh = Z + (size_t)row0 * ZP + ZK + h * 128 + c * 64;
        const bf16_t* Vh = Z + (size_t)row0 * ZP + ZV + h * 128;
        const int p0 = 2 * wid, p1 = 2 * wid + 1;
        const unsigned koff = (unsigned)(lane * ZP + wid * 8) * 2u;
        const unsigned voff0 = (unsigned)((16 * (p0 & 3) + (lane >> 2)) * ZP + (p0 >> 2) * 32 + (lane & 3) * 8) * 2u;
        const unsigned voff1 = (unsigned)((16 * (p1 & 3) + (lane >> 2)) * ZP + (p1 >> 2) * 32 + (lane & 3) * 8) * 2u;
        const unsigned kdst = lds0 + L_K + wid * 1024, vdst0 = lds0 + L_V + p0 * 1024, vdst1 = lds0 + L_V + p1 * 1024;
#define DMA_K(t, si) glds16((const char*)(Kh + (size_t)(t) * 64 * ZP) + koff, (unsigned)__builtin_amdgcn_readfirstlane(kdst + (si) * KSLOT))
#define DMA_V(t, si) do { const char* vb_ = (const char*)(Vh + (size_t)(t) * 64 * ZP); glds16(vb_ + voff0, (unsigned)__builtin_amdgcn_readfirstlane(vdst0 + (si) * VSLOT)); glds16(vb_ + voff1, (unsigned)__builtin_amdgcn_readfirstlane(vdst1 + (si) * VSLOT)); } while (0)
        DMA_K(0, 0); DMA_V(0, 0); DMA_K(1, 1);
        bf16x8 qr[4];
#pragma unroll
        for (int d0 = 0; d0 < 4; ++d0) qr[d0] = *(const bf16x8*)(Qw + (size_t)r32 * ZP + d0 * 16 + hi * 8);
#pragma unroll
        for (int d0 = 0; d0 < 4; ++d0) o[d0] = f32x16{};
        float l_reg = 0.f;
        bf16x8 kf[4];
        f32x16 pA0, pA1, pB0, pB1;
        int i_prev = 0, i_cur = 0, i_next = 1;
        int k_cur = 0, k_next = 1;
#define ROT() do { i_prev = i_cur; i_cur = i_next; i_next = (i_next == NVS - 1) ? 0 : i_next + 1; k_cur = k_next; k_next = (k_next + 1) & 3; } while (0)
#define KFRAG(slot, i) (*(const LAS bf16x8*)(kp0 + (slot) * KSLOT + ((i) >> 1) * 2048 + ((i) & 1) * 512))
        DMA_K(2, 2);
        WAIT_BAR(4);
        {
            const lds_cptr kb = kp0;
            pA0 = f32x16{}; pA1 = f32x16{};
#pragma unroll
            for (int d0 = 0; d0 < 4; ++d0) { const bf16x8 b0 = *(const LAS bf16x8*)(kb + d0 * 2048), b1 = *(const LAS bf16x8*)(kb + d0 * 2048 + 512);
                pA0 = __builtin_amdgcn_mfma_f32_32x32x16_bf16(b0, qr[d0], pA0, 0, 0, 0); pA1 = __builtin_amdgcn_mfma_f32_32x32x16_bf16(b1, qr[d0], pA1, 0, 0, 0); }
#pragma unroll
            for (int r = 0; r < 16; ++r) { pA0[r] = __builtin_amdgcn_exp2f(pA0[r]); pA1[r] = __builtin_amdgcn_exp2f(pA1[r]); }
        }
        WAIT_BAR(0);
        DMA_K(3, 3); DMA_V(1, 1);
        ROT();
        kf[0] = KFRAG(k_cur, 0); kf[1] = KFRAG(k_cur, 1); kf[2] = KFRAG(k_cur, 2); kf[3] = KFRAG(k_cur, 3);
        WAIT_BAR(3);
        s16x4 vlo[4], vhi[4]; u32x4 pw0, pw1, pw2, pw3;
#define PKW(P, B) cvt_pk_bf16(P[B], P[B + 1])
#define PAF(k) __builtin_bit_cast(bf16x8, pw##k)
#define VFR(i) (bf16x8){vlo[i][0], vlo[i][1], vlo[i][2], vlo[i][3], vhi[i][0], vhi[i][1], vhi[i][2], vhi[i][3]}
#define PIN(x) asm volatile("" : "+v"(x))
#define EX(v) __builtin_amdgcn_exp2f(v)
#define VRD(slot, f) do { vlo[slot] = vtr(vp_ + (((f) & 3) * 4096 + ((f) >> 2) * 1024)); vhi[slot] = vtr(vp_ + (((f) & 3) * 4096 + ((f) >> 2) * 1024 + 512)); } while (0)
#define GAPA(MF, LDX, A0, A1, A2, A3, W0, W1, PW) do { MF; LDX; sacc += A0; sacc += A1; sacc += A2; sacc += A3; PIN(sacc); W0; W1; PIN(PW); SBAR(); } while (0)
#define GAPB(MF, LDX, X, B) do { MF; LDX; X[B] = EX(X[B]); X[B + 1] = EX(X[B + 1]); PIN(X); SBAR(); } while (0)
#define PVM(f) o[(f) & 3] = __builtin_amdgcn_mfma_f32_32x32x16_bf16(__builtin_bit_cast(bf16x8, (f) < 4 ? pw0 : (f) < 8 ? pw1 : (f) < 12 ? pw2 : pw3), VFR((f) & 3), o[(f) & 3], 0, 0, 0)
#define NOP_ do { } while (0)
#if PROBE_ATT
#define ATT_T(k) do { if (PROBE_ATT == (k)) { const unsigned long long n_ = __builtin_amdgcn_s_memrealtime(); if (tid == 0) *(LAS unsigned long long*)(shm + PTRS_OFF - 64) += n_ - att_t0; } } while (0)
#define ATT_T0() const unsigned long long att_t0 = __builtin_amdgcn_s_memrealtime()
#else
#define ATT_T(k) do { } while (0)
#define ATT_T0() do { } while (0)
#endif
#define STEP(C0, C1, P0, P1, t, GK, GV, GL) do { SBAR(); \
        const lds_cptr vp_ = vp0 + i_prev * VSLOT; \
        float sacc = (P0[0] + P0[1]); \
        GAPA(C0 = __builtin_amdgcn_mfma_f32_32x32x16_bf16(kf[0], qr[0], (f32x16){}, 0, 0, 0), kf[0] = KFRAG(k_cur, 4), P0[2], P0[3], P0[4], P0[5],     pw0[0] = PKW(P0, 0), pw0[1] = PKW(P0, 2), pw0); \
        GAPA(C1 = __builtin_amdgcn_mfma_f32_32x32x16_bf16(kf[1], qr[0], (f32x16){}, 0, 0, 0), kf[1] = KFRAG(k_cur, 5), P0[6], P0[7], P0[8], P0[9],     pw0[2] = PKW(P0, 4), pw0[3] = PKW(P0, 6), pw0); \
        GAPA(C0 = __builtin_amdgcn_mfma_f32_32x32x16_bf16(kf[2], qr[1], C0, 0, 0, 0),         kf[2] = KFRAG(k_cur, 6), P0[10], P0[11], P0[12], P0[13], pw1[0] = PKW(P0, 8), pw1[1] = PKW(P0, 10), pw1); \
        GAPA(C1 = __builtin_amdgcn_mfma_f32_32x32x16_bf16(kf[3], qr[1], C1, 0, 0, 0),         kf[3] = KFRAG(k_cur, 7), P0[14], P0[15], P1[0], P1[1],   pw1[2] = PKW(P0, 12), pw1[3] = PKW(P0, 14), pw1); \
        GAPA(C0 = __builtin_amdgcn_mfma_f32_32x32x16_bf16(kf[0], qr[2], C0, 0, 0, 0),         VRD(0, 0), P1[2], P1[3], P1[4], P1[5],     pw2[0] = PKW(P1, 0), pw2[1] = PKW(P1, 2), pw2); \
        GAPA(C1 = __builtin_amdgcn_mfma_f32_32x32x16_bf16(kf[1], qr[2], C1, 0, 0, 0),         VRD(1, 1), P1[6], P1[7], P1[8], P1[9],     pw2[2] = PKW(P1, 4), pw2[3] = PKW(P1, 6), pw2); \
        GAPA(C0 = __builtin_amdgcn_mfma_f32_32x32x16_bf16(kf[2], qr[3], C0, 0, 0, 0),         VRD(2, 2), P1[10], P1[11], P1[12], P1[13], pw3[0] = PKW(P1, 8), pw3[1] = PKW(P1, 10), pw3); \
        GAPA(C1 = __builtin_amdgcn_mfma_f32_32x32x16_bf16(kf[3], qr[3], C1, 0, 0, 0),         VRD(3, 3), P1[14], P1[15], 0.f, 0.f,       pw3[2] = PKW(P1, 12), pw3[3] = PKW(P1, 14), pw3); \
        l_reg += sacc; \
        if (GK) { DMA_K((t) + 3, (k_cur + 3) & 3); } if (GV) { DMA_V((t) + 1, i_next); } \
        SBAR(); \
        GAPB(PVM(0), VRD(0, 4), C0, 0);   GAPB(PVM(1), VRD(1, 5), C0, 2);   GAPB(PVM(2), VRD(2, 6), C0, 4);    GAPB(PVM(3), VRD(3, 7), C0, 6); \
        GAPB(PVM(4), VRD(0, 8), C0, 8);   GAPB(PVM(5), VRD(1, 9), C0, 10);  GAPB(PVM(6), VRD(2, 10), C0, 12);  GAPB(PVM(7), VRD(3, 11), C0, 14); \
        GAPB(PVM(8), VRD(0, 12), C1, 0);  GAPB(PVM(9), VRD(1, 13), C1, 2);  GAPB(PVM(10), VRD(2, 14), C1, 4);  GAPB(PVM(11), VRD(3, 15), C1, 6); \
        GAPB(PVM(12), if (GL) kf[0] = KFRAG(k_next, 0), C1, 8);  GAPB(PVM(13), if (GL) kf[1] = KFRAG(k_next, 1), C1, 10); \
        GAPB(PVM(14), if (GL) kf[2] = KFRAG(k_next, 2), C1, 12); GAPB(PVM(15), if (GL) kf[3] = KFRAG(k_next, 3), C1, 14); \
        } while (0)
        int t = 1;
#pragma unroll 1
        for (; t + 5 < NT; t += 2) {
#if PROBE_ATT == 1
            STEP(pB0, pB1, pA0, pA1, t, true, true, true);     { ATT_T0(); WAIT_BAR(3); ATT_T(1); } ROT();
            STEP(pA0, pA1, pB0, pB1, t + 1, true, true, true); { ATT_T0(); WAIT_BAR(3); ATT_T(1); } ROT();
#elif PROBE_ATT >= 2
            { ATT_T0(); STEP(pB0, pB1, pA0, pA1, t, true, true, true); ATT_T(2); }    WAIT_BAR(3); ROT();
            { ATT_T0(); STEP(pA0, pA1, pB0, pB1, t + 1, true, true, true); ATT_T(2); } WAIT_BAR(3); ROT();
#else
            STEP(pB0, pB1, pA0, pA1, t, true, true, true);     WAIT_BAR(3); ROT();
            STEP(pA0, pA1, pB0, pB1, t + 1, true, true, true); WAIT_BAR(3); ROT();
#endif
        }
#define ENDW(tt) do { if ((tt) + 3 < NT) { WAIT_BAR(3); } else if ((tt) + 2 < NT) { WAIT_BAR(2); } else { WAIT_BAR(0); } } while (0)
#pragma unroll 1
        for (; t + 1 < NT; t += 2) {
            STEP(pB0, pB1, pA0, pA1, t, (t + 3 < NT), (t + 1 < NT), (t + 1 < NT));         ENDW(t);     ROT();
            STEP(pA0, pA1, pB0, pB1, t + 1, (t + 4 < NT), (t + 2 < NT), (t + 2 < NT));     ENDW(t + 1); ROT();
        }
        STEP(pB0, pB1, pA0, pA1, NT - 1, false, false, false);
        {
            float sacc = pB0[0] + pB0[1];
#pragma unroll
            for (int r = 2; r < 16; ++r) sacc += pB0[r];
#pragma unroll
            for (int r = 0; r < 16; ++r) sacc += pB1[r];
            l_reg += sacc;
            pw0 = (u32x4){PKW(pB0, 0), PKW(pB0, 2), PKW(pB0, 4), PKW(pB0, 6)}; pw1 = (u32x4){PKW(pB0, 8), PKW(pB0, 10), PKW(pB0, 12), PKW(pB0, 14)};
            pw2 = (u32x4){PKW(pB1, 0), PKW(pB1, 2), PKW(pB1, 4), PKW(pB1, 6)}; pw3 = (u32x4){PKW(pB1, 8), PKW(pB1, 10), PKW(pB1, 12), PKW(pB1, 14)};
            const lds_cptr vp_ = vp0 + i_cur * VSLOT;
            VRD(0, 0); VRD(1, 1); VRD(2, 2); VRD(3, 3); PVM(0); PVM(1); PVM(2); PVM(3);
            VRD(0, 4); VRD(1, 5); VRD(2, 6); VRD(3, 7); PVM(4); PVM(5); PVM(6); PVM(7);
            VRD(0, 8); VRD(1, 9); VRD(2, 10); VRD(3, 11); PVM(8); PVM(9); PVM(10); PVM(11);
            VRD(0, 12); VRD(1, 13); VRD(2, 14); VRD(3, 15); PVM(12); PVM(13); PVM(14); PVM(15);
        }
#undef DMA_K
#undef DMA_V
#undef ROT
#undef PKW
#undef PAF
#undef VFR
#undef PIN
#undef EX
#undef VRD
#undef GAPA
#undef GAPB
#undef KFRAG
#undef NOP_
#undef PVM
#undef STEP
#undef ENDW
        { auto rr = __builtin_amdgcn_permlane32_swap(__float_as_uint(l_reg), __float_as_uint(l_reg), false, false); l_reg = __uint_as_float(rr[0]) + __uint_as_float(rr[1]); }
        if (hi == 0) wsf[r32] = l_reg;
        LDS_WAIT();
        float rli[16];
#pragma unroll
        for (int r = 0; r < 16; ++r) rli[r] = 1.0f / wsf[crow(r, hi)];
        if (c == 0) {
#pragma unroll
            for (int d0 = 0; d0 < 4; ++d0)
#pragma unroll
                for (int r = 0; r < 16; ++r) stash[(d0 * 16 + r) * 64 + lane] = f2bf(o[d0][r] * rli[r]);
            LDS_WAIT();
        } else {
#pragma unroll
            for (int d0 = 0; d0 < 4; ++d0)
#pragma unroll
                for (int r = 0; r < 16; ++r) o[d0][r] = bf2f(stash[(d0 * 16 + r) * 64 + lane]) - lam * (o[d0][r] * rli[r]);
            LDS_WAIT(); asm volatile("" ::: "memory");
#pragma unroll
            for (int d0 = 0; d0 < 4; ++d0)
#pragma unroll
                for (int r = 0; r < 16; ++r) stash[crow(r, hi) * 128 + d0 * 32 + r32] = f2bf(o[d0][r]);
            LDS_WAIT(); asm volatile("" ::: "memory");
            bf16_t* Ow = Ob + qrow * opitch + ZQ + h * 128;
#pragma unroll
            for (int i = 0; i < 4; ++i) { const int row = i * 8 + (lane >> 3), ch = lane & 7;
                const u32x4 w0 = *(const LAS u32x4*)(stash + row * 128 + ch * 16), w1 = *(const LAS u32x4*)(stash + row * 128 + ch * 16 + 8);
                float v[16];
#pragma unroll
                for (int j = 0; j < 4; ++j) { v[2 * j] = bflo(w0[j]); v[2 * j + 1] = bfhi(w0[j]); v[8 + 2 * j] = bflo(w1[j]); v[9 + 2 * j] = bfhi(w1[j]); }
                float ss = 0.f;
#pragma unroll
                for (int j = 0; j < 16; ++j) ss += v[j] * v[j];
                ss += __shfl_xor(ss, 1); ss += __shfl_xor(ss, 2); ss += __shfl_xor(ss, 4);
                const float rs = (1.0f - LAMBDA_INIT) / sqrtf(ss * (1.f / 128.f) + NORM_EPS);
                u32x4 x0, x1;
#pragma unroll
                for (int j = 0; j < 4; ++j) { x0[j] = cvt_pk_bf16(v[2 * j] * rs * subln_g[ch * 16 + 2 * j], v[2 * j + 1] * rs * subln_g[ch * 16 + 2 * j + 1]);
                                              x1[j] = cvt_pk_bf16(v[8 + 2 * j] * rs * subln_g[ch * 16 + 8 + 2 * j], v[9 + 2 * j] * rs * subln_g[ch * 16 + 9 + 2 * j]); }
                *(u32x4*)(Ow + (size_t)row * opitch + ch * 16) = x0; *(u32x4*)(Ow + (size_t)row * opitch + ch * 16 + 8) = x1; }
            LDS_WAIT();
        }
        asm volatile("s_waitcnt vmcnt(0) lgkmcnt(0)\n\ts_barrier" ::: "memory");
    }
}
#undef SBAR
#undef WAIT_BAR
}

namespace rw {
constexpr int P = 144, MAT = 64 * P;
constexpr int O_AT = 0, O_BT = MAT, O_KT = 2 * MAT, O_RT = 3 * MAT, O_ATT = 4 * MAT, O_VT = 5 * MAT, O_BHT = 6 * MAT, O_KHT = 7 * MAT;
constexpr int O_LAB = 8 * MAT, O_LAK = 9 * MAT, O_ARB = 10 * MAT, O_ARK = 11 * MAT, O_XT = 12 * MAT, O_ABT = 13 * MAT, O_U0T = 14 * MAT;
constexpr int O_LABD = 15 * MAT, O_TII = O_LABD + 4096, O_WC = O_TII + 2048, O_GSUM = O_WC + 256, O_PAR = O_GSUM + 2048, O_END = O_PAR + 960 * 4;
constexpr int O_ZS = 0, PZ = 128;
static_assert(3 * 66 * PZ <= 3 * MAT, "ZS fits At|Bt|Kt");
constexpr int O_TW = O_LAB, O_ADN = O_LAK, O_WL = O_ARB, O_AR = O_XT, PF = 272;
static_assert(O_END <= PTRS_OFF - 64 && 64 * PF <= 2 * MAT, "rwkv lds");
__device__ __forceinline__ int crow(int r, int hi) { return (r & 3) + 8 * (r >> 2) + 4 * hi; }
__device__ __forceinline__ float sigmoidf_(float x) { return __builtin_amdgcn_rcpf(1.0f + __expf(-x)); }
__device__ __forceinline__ float tanhf_(float x) { return 1.0f - 2.0f * __builtin_amdgcn_rcpf(__expf(2.0f * x) + 1.0f); }
__device__ __forceinline__ void load10(const bf16_t* zc, int t_lo, int S, float (&z)[10]) {
#pragma unroll
    for (int i = 0; i < 10; ++i) { const int t = t_lo - 1 + i; z[i] = (t >= 0 && t < S) ? bf2f(zc[(size_t)t * ZP]) : 0.f; }
}
__device__ __forceinline__ float tshift(const float (&z)[10], int u, float mp, float mn) { const float c = z[u + 1]; return c + mp * (z[u] - c) + mn * (z[u + 2] - c); }
__device__ __forceinline__ f32x16 mm_ll(const LAS unsigned char* A, int rowA, const LAS unsigned char* B, int rowB, f32x16 acc, int r32, int hi) {
#pragma unroll
    for (int ks = 0; ks < 4; ++ks) { const bf16x8 a = *(const LAS bf16x8*)(A + (rowA + r32) * P + (16 * ks + 8 * hi) * 2), b = *(const LAS bf16x8*)(B + (rowB + r32) * P + (16 * ks + 8 * hi) * 2);
        acc = __builtin_amdgcn_mfma_f32_32x32x16_bf16(a, b, acc, 0, 0, 0); }
    return acc;
}
__device__ __forceinline__ void store_native(unsigned char* dst, const f32x16& acc, int lane, bool wt) {
    u32x4 w0, w1;
#pragma unroll
    for (int q = 0; q < 4; ++q) { w0[q] = cvt_pk_bf16(acc[2 * q], acc[2 * q + 1]); w1[q] = cvt_pk_bf16(acc[8 + 2 * q], acc[9 + 2 * q]); }
    if (wt) {
        asm volatile("global_store_dwordx4 %0, %1, off sc1\n\tglobal_store_dwordx4 %0, %2, off offset:16 sc1\n\ts_nop 1" :: "v"(dst + lane * 32), "v"(w0), "v"(w1) : "memory");
    } else { *(u32x4*)(dst + lane * 32) = w0; *(u32x4*)(dst + lane * 32 + 16) = w1; }
}
__device__ __forceinline__ void st4(LAS unsigned char* p, float a, float b, float c, float d) { u32x2 w; w.x = cvt_pk_bf16(a, b); w.y = cvt_pk_bf16(c, d); *(LAS u32x2*)p = w; }

__device__ __forceinline__ f32x2_t s1_param_load(LAS unsigned char* L, int tid, int d, int h) {
    const int sg = tid >> 5, seg = sg < 15 ? sg : 14, off = (tid & 31) * 2;
    const int ti = seg < 10 ? 11 + (seg & 1) : (seg == 10 ? 13 : (seg == 11 ? 15 : 6 + seg));
    const int eo = seg < 6 ? (seg >> 1) * 512 + h * 64 : (seg < 8 ? ZWD - ZRR : (seg < 10 ? ZAD - ZRR : (seg < 12 ? d * 512 + h * 64 : h * 64)));
    const float* src = *(const float* LAS*)(L + PTRS_OFF + ti * 8) + eo + off;
    return *(const GAS f32x2_t*)src;
}
__device__ __forceinline__ void s1_stage_load(const Args& a, int tid, int q, int h, int ck, u32x4 (&v)[6]) {
    const int row0 = seq_row0(q), S = seq_len(q), t0 = ck * 64;
#pragma unroll
    for (int k = 0; k < 6; ++k) { const int c = tid + k * NTHR;
        const int seg = c >> 3, part = c & 7, row = seg / 3, grp = seg - row * 3; int t = t0 - 1 + row; t = t < 0 ? 0 : (t >= S ? S - 1 : t);
        const int e = c - 1584 < 0 ? 0 : (c - 1584 > 1023 ? 1023 : c - 1584);
        const size_t offz = WS_Z + ((size_t)(row0 + t) * ZP + ZRR + grp * 512 + h * 64 + part * 8) * 2, offe = WS_E1 + ((size_t)(row0 + t0) * 128 + (size_t)e * 8) * 2;
        v[k] = *(const GAS u32x4*)(a.ws + (c < 1584 ? offz : offe)); }
}
__device__ __forceinline__ void s1_stage_store(LAS unsigned char* L, int tid, int d, int q, int ck, const u32x4 (&stg)[6], f32x2_t par) {
    const int S = seq_len(q), t0 = ck * 64;
#pragma unroll
    for (int k = 0; k < 6; ++k) { const int c = tid + k * NTHR;
        if (c < 1584) { const int seg = c >> 3, part = c & 7, row = seg / 3, grp = seg - row * 3, t = t0 - 1 + row; const bool ok = t >= 0 && t < S;
            *(LAS u32x4*)(L + O_ZS + (grp * 66 + row) * PZ + part * 16) = ok ? stg[k] : (u32x4){0u, 0u, 0u, 0u}; }
        else if (c < 2608) { const int e = c - 1584, tr = e >> 4, part = e & 15, tau = d == 0 ? tr : 63 - tr;
            *(LAS u32x4*)(L + (part < 8 ? O_TW : O_ADN) + tau * P + (part & 7) * 16) = stg[k]; } }
    if (tid < 480) *(LAS f32x2_t*)(L + O_PAR + tid * 8) = par;
}
__device__ __forceinline__ void s1_item(const Frame& F, const Args& a, int d, int q, int h, int ck, unsigned char* slot, int nd, int nq, int nh, int nck, bool wt, unsigned* publish_prev) {
    LAS unsigned char* L = F.lds;
#if PROBE_S1 >= 0
    unsigned long long pt_last = 0; int pt_n = 0;
#define PST() do { if (F.tid == 0) { const unsigned long long n_ = __builtin_amdgcn_s_memrealtime(); if (pt_n == PROBE_S1 + 1) *(LAS unsigned long long*)(L + PTRS_OFF - 64) += n_ - pt_last; pt_last = n_; } ++pt_n; } while (0)
#else
#define PST() do { } while (0)
#endif
    PST();
    int lane_ = F.lane; asm volatile("" : "+v"(lane_));
    const int lane = lane_, w = F.wave, tid = w * 64 + lane, r32 = lane & 31, hi = lane >> 5;
    const int j = lane, tg = w;
    const int row0 = seq_row0(q), S = seq_len(q), t0 = ck * 64;
    const bf16_t* Zs = (const bf16_t*)(a.ws + WS_Z) + (size_t)row0 * ZP; (void)Zs; (void)S;
    const int t_lo = d == 0 ? t0 + 8 * tg : t0 + 56 - 8 * tg;
    const int tau0 = 8 * tg;
#define TAU(u) (d == 0 ? tau0 + (u) : tau0 + 7 - (u))
    const int ch = h * 64 + j; (void)ch;
    bf16x8 wfr[4];
    { const int which = w >> 2, mt = (w >> 1) & 1;
      const bf16_t* WT = (const bf16_t*)(a.ws + WS_LORA) + (which ? 2 * 512 * 64 : 0) + ((size_t)d * 512 + h * 64 + 32 * mt + r32) * 64;
#pragma unroll
      for (int ks = 0; ks < 4; ++ks) wfr[ks] = *(const bf16x8*)(WT + 16 * ks + 8 * hi); }
    u32x4 stg[6]; s1_stage_load(a, tid, nq, nh, nck, stg); const f32x2_t par = s1_param_load(L, tid, nd, nh);
#define PAR(seg, idx) (*(const LAS float*)(L + O_PAR + ((seg) * 64 + (idx)) * 4))
    const LAS unsigned char* zsb = L + O_ZS + (t_lo - t0) * PZ + j * 2;
#define LD10(z, g) do { _Pragma("unroll") for (int i_ = 0; i_ < 10; ++i_) z[i_] = bf2f(*(const LAS bf16_t*)(zsb + ((g) * 66 + i_) * PZ)); } while (0)
    {
        const int which = w >> 2, mt = (w >> 1) & 1, nt = w & 1;
        const LAS unsigned char* B = L + (which ? O_ADN : O_TW);
        f32x16 acc = f32x16{};
#pragma unroll
        for (int ks = 0; ks < 4; ++ks) { const bf16x8 bv = *(const LAS bf16x8*)(B + (32 * nt + r32) * P + (16 * ks + 8 * hi) * 2);
            acc = __builtin_amdgcn_mfma_f32_32x32x16_bf16(wfr[ks], bv, acc, 0, 0, 0); }
        LAS unsigned char* O = L + (which ? O_AR : O_WL) + (32 * nt + r32) * PF;
#pragma unroll
        for (int g = 0; g < 4; ++g) { const int jj = 8 * g + 4 * hi; const f32x4 bv = *(const LAS f32x4*)(L + O_PAR + ((10 + which) * 64 + 32 * mt + jj) * 4);
            *(LAS f32x4*)(O + (32 * mt + jj) * 4) = (f32x4){acc[4 * g] + bv[0], acc[4 * g + 1] + bv[1], acc[4 * g + 2] + bv[2], acc[4 * g + 3] + bv[3]}; }
    }
    LBAR(); PST();
    float aa[8], bb[8], rr[8], kd[8], vv[8], ld[8];
    {
        float zr[10], zk[10], zv[10]; LD10(zr, 0); LD10(zk, 1); LD10(zv, 2);
        const float mpr = PAR(0, j), mnr = PAR(1, j), mpk = PAR(2, j), mnk = PAR(3, j), mpv = PAR(4, j), mnv = PAR(5, j);
        const float kkc = PAR(12, j), kac = PAR(13, j), rkc = PAR(14, j);
        float* bon = (float*)(a.ws + WS_BONUS) + ((size_t)d * MTOK + row0) * 8 + h;
        float k0[8], ar8[8], red[8];
#pragma unroll
        for (int u = 0; u < 8; ++u) { const int tau = TAU(u);
            const float wl = *(const LAS float*)(L + O_WL + tau * PF + j * 4), ar = *(const LAS float*)(L + O_AR + tau * PF + j * 4);
            ld[u] = -0.6065306597126334f * sigmoidf_(wl); ar8[u] = sigmoidf_(ar);
            rr[u] = tshift(zr, u, mpr, mnr); k0[u] = tshift(zk, u, mpk, mnk); vv[u] = tshift(zv, u, mpv, mnv);
            aa[u] = k0[u] * kkc; red[u] = aa[u] * aa[u]; }
        wave_sum8(red, lane);
#pragma unroll
        for (int u = 0; u < 8; ++u) { const float kkn = aa[u] * __builtin_amdgcn_rsqf(red[u] + 1e-12f);
            kd[u] = k0[u] * (1.0f + (ar8[u] - 1.0f) * kac); aa[u] = -kkn; bb[u] = kkn * ar8[u];
            red[u] = rr[u] * kd[u] * rkc; }
        wave_sum8(red, lane);
        if (lane == 0) {
#pragma unroll
            for (int u = 0; u < 8; ++u) bon[(size_t)(t_lo + u) * 8] = red[u]; }
        float tot = 0.f;
#pragma unroll
        for (int u = 0; u < 8; ++u) tot += ld[u];
        *(LAS float*)(L + O_GSUM + tg * 256 + j * 4) = tot;
    }
    LBAR(); PST();
    {
        float pre = 0.f, cC = 0.f;
#pragma unroll
        for (int g = 0; g < 8; ++g) { const float s = *(const LAS float*)(L + O_GSUM + g * 256 + j * 4); cC += s; if (g < tg) pre += s; }
        float tot = 0.f;
#pragma unroll
        for (int u = 0; u < 8; ++u) tot += ld[u];
        float At[8], Vt[8], Bh[8], Kh[8]; float pf = 0.f;
#pragma unroll
        for (int u = 0; u < 8; ++u) { pf += ld[u]; const int tau = TAU(u);
            const float cl = pre + (d == 0 ? pf : tot - pf + ld[u]);
            const float e_m1 = __expf(cl - ld[u]), e_p = __expf(cl), e_n = __expf(-cl), e_c = __expf(cC - cl);
            At[u] = aa[u] * e_m1; Vt[u] = vv[u]; Bh[u] = bb[u] * e_c; Kh[u] = kd[u] * e_c;
            const float rt_ = rr[u] * e_p, bt_ = bb[u] * e_n, kt_ = kd[u] * e_n;
#define NBR(x) __int_as_float(__builtin_amdgcn_update_dpp(0, __float_as_int(x), 0xB1, 0xF, 0xF, true))
            const unsigned pa_ = cvt_pk_bf16(At[u], NBR(At[u])), pr_ = cvt_pk_bf16(rt_, NBR(rt_)), pb_ = cvt_pk_bf16(bt_, NBR(bt_)), pk_ = cvt_pk_bf16(kt_, NBR(kt_));
#undef NBR
            if (!(lane & 1)) { *(LAS unsigned*)(L + O_AT + tau * P + j * 2) = pa_; *(LAS unsigned*)(L + O_RT + tau * P + j * 2) = pr_;
                               *(LAS unsigned*)(L + O_BT + tau * P + j * 2) = pb_; *(LAS unsigned*)(L + O_KT + tau * P + j * 2) = pk_; } }
#define PK8(dst, X) do { u32x4 w_; _Pragma("unroll") for (int k = 0; k < 4; ++k) { const float x0 = d == 0 ? X[2 * k] : X[7 - 2 * k], x1 = d == 0 ? X[2 * k + 1] : X[6 - 2 * k]; w_[k] = cvt_pk_bf16(x0, x1); } \
            *(LAS u32x4*)(L + (dst) + j * P + tau0 * 2) = w_; } while (0)
        PK8(O_ATT, At); PK8(O_VT, Vt); PK8(O_BHT, Bh); PK8(O_KHT, Kh);
#undef PK8
        if (tg == 0) *(LAS float*)(L + O_WC + j * 4) = __expf(cC);
    }
    LBAR(); PST();
#pragma unroll
    for (int i = 0; i < 2; ++i) {
        const int ti = 2 * w + i, ms = ti >> 2, nl = ti & 3;
        const int sb = 32 * (ms & 1), tb = 32 * (nl & 1);
        f32x16 acc = f32x16{};
        if (sb <= tb) acc = mm_ll(L + (ms < 2 ? O_BT : O_KT), sb, L + (nl < 2 ? O_AT : O_RT), tb, acc, r32, hi);
        const bool incl = nl >= 2; const int dst = ms < 2 ? (nl < 2 ? O_LAB : O_ARB) : (nl < 2 ? O_LAK : O_ARK);
        const int t = tb + r32;
#pragma unroll
        for (int g = 0; g < 4; ++g) { const int s0 = sb + 8 * g + 4 * hi; float v[4];
#pragma unroll
            for (int e = 0; e < 4; ++e) { const int s = s0 + e; v[e] = (incl ? (s <= t) : (s < t)) ? acc[4 * g + e] : 0.f; }
            st4(L + dst + t * P + s0 * 2, v[0], v[1], v[2], v[3]);
            if (dst == O_LAB && (s0 >> 4) == (t >> 4)) *(LAS f32x4*)(L + O_LABD + (((t >> 4) * 16 + (t & 15)) * 16 + (s0 & 15)) * 4) = (f32x4){v[0], v[1], v[2], v[3]}; }
    }
    LBAR(); PST();
    if (w < 4) {
        const int mt = w >> 1, nt = w & 1; f32x16 acc = f32x16{};
        acc = mm_ll(L + O_LAK, 32 * mt, L + O_VT, 32 * nt, acc, r32, hi);
#pragma unroll
        for (int g = 0; g < 4; ++g) st4(L + O_XT + (32 * nt + r32) * P + (32 * mt + 8 * g + 4 * hi) * 2, acc[4 * g], acc[4 * g + 1], acc[4 * g + 2], acc[4 * g + 3]);
    } else if (w == 7) {
        const int blk = lane >> 4, cc = lane & 15; float x[16];
#pragma unroll
        for (int t = 0; t < 16; ++t) { float s = (t == cc) ? 1.f : 0.f; const LAS float* lr = (const LAS float*)(L + O_LABD + ((blk * 16 + t) * 16) * 4);
#pragma unroll
            for (int k = 0; k < t; ++k) s += lr[k] * x[k];
            x[t] = s; *(LAS bf16_t*)(L + O_TII + ((blk * 16 + t) * 16 + cc) * 2) = f2bf(s); }
    }
    LBAR(); PST();
    {
        const int c16 = lane & 15, q4 = lane >> 4;
        const LAS unsigned char* RT = L + (w < 4 ? O_ATT : O_XT) + (16 * (w & 3) + c16) * P;
        LAS unsigned char* OT = L + (w < 4 ? O_ABT : O_U0T) + (16 * (w & 3) + c16) * P;
        const LAS unsigned char* LA = L + O_LAB + c16 * P;
#define RHS(i) ({ const u32x2 r_ = *(const LAS u32x2*)(RT + (16 * (i) + 4 * q4) * 2); (f32x4){bflo(r_.x), bfhi(r_.x), bflo(r_.y), bfhi(r_.y)}; })
#define AFR(i, k1, k2) ({ const u32x2 lo_ = *(const LAS u32x2*)(LA + 16 * (i) * P + (16 * (k1) + 4 * q4) * 2); u32x2 hi_ = {0u, 0u}; if ((k2) >= 0) hi_ = *(const LAS u32x2*)(LA + 16 * (i) * P + (16 * ((k2) < 0 ? 0 : (k2)) + 4 * q4) * 2); \
        __builtin_bit_cast(bf16x8, (u32x4){lo_.x, lo_.y, hi_.x, hi_.y}); })
#define TFR(i) ({ const u32x2 lo_ = *(const LAS u32x2*)(L + O_TII + (((i) * 16 + c16) * 16 + 4 * q4) * 2); __builtin_bit_cast(bf16x8, (u32x4){lo_.x, lo_.y, 0u, 0u}); })
#define BFR(U1, U2) __builtin_bit_cast(bf16x8, (u32x4){cvt_pk_bf16(U1[0], U1[1]), cvt_pk_bf16(U1[2], U1[3]), cvt_pk_bf16(U2[0], U2[1]), cvt_pk_bf16(U2[2], U2[3])})
#define MF16(A_, B_, C_) __builtin_amdgcn_mfma_f32_16x16x32_bf16(A_, B_, C_, 0, 0, 0)
        const f32x4 zero4 = {0.f, 0.f, 0.f, 0.f};
        f32x4 U0 = MF16(TFR(0), BFR(RHS(0), zero4), zero4);
        f32x4 Z1 = MF16(AFR(1, 0, -1), BFR(U0, zero4), RHS(1));
        f32x4 U1 = MF16(TFR(1), BFR(Z1, zero4), zero4);
        f32x4 Z2 = MF16(AFR(2, 0, 1), BFR(U0, U1), RHS(2));
        f32x4 U2 = MF16(TFR(2), BFR(Z2, zero4), zero4);
        f32x4 Z3 = MF16(AFR(3, 0, 1), BFR(U0, U1), RHS(3));
        Z3 = MF16(AFR(3, 2, -1), BFR(U2, zero4), Z3);
        f32x4 U3 = MF16(TFR(3), BFR(Z3, zero4), zero4);
        st4(OT + (0 + 4 * q4) * 2, U0[0], U0[1], U0[2], U0[3]); st4(OT + (16 + 4 * q4) * 2, U1[0], U1[1], U1[2], U1[3]);
        st4(OT + (32 + 4 * q4) * 2, U2[0], U2[1], U2[2], U2[3]); st4(OT + (48 + 4 * q4) * 2, U3[0], U3[1], U3[2], U3[3]);
#undef RHS
#undef AFR
#undef TFR
#undef BFR
#undef MF16
    }
    if (publish_prev) asm volatile("s_waitcnt vmcnt(0)" ::: "memory");
    LBAR(); PST();
    if (publish_prev && tid == 0) __hip_atomic_fetch_add(publish_prev, 1u, __ATOMIC_RELAXED, __HIP_MEMORY_SCOPE_AGENT);
    {
        const int mt = (w >> 1) & 1, nt = w & 1;
        if (w < 4) {
            f32x16 acc = f32x16{};
            acc = mm_ll(L + O_ABT, 32 * mt, L + O_BHT, 32 * nt, acc, r32, hi);
            if (mt == nt) { const float wc = *(const LAS float*)(L + O_WC + (32 * nt + r32) * 4);
#pragma unroll
                for (int r = 0; r < 16; ++r) if (crow(r, hi) == r32) acc[r] += wc; }
            store_native(slot + (mt * 2 + nt) * 2048, acc, lane, wt);
            f32x16 rb;
#pragma unroll
            for (int g = 0; g < 4; ++g) { const u32x2 r_ = *(const LAS u32x2*)(L + O_RT + (32 * nt + r32) * P + (32 * mt + 8 * g + 4 * hi) * 2);
                rb[4 * g] = bflo(r_.x); rb[4 * g + 1] = bfhi(r_.x); rb[4 * g + 2] = bflo(r_.y); rb[4 * g + 3] = bfhi(r_.y); }
            rb = mm_ll(L + O_ABT, 32 * mt, L + O_ARB, 32 * nt, rb, r32, hi);
            store_native(slot + 16384 + (mt * 2 + nt) * 2048, rb, lane, wt);
        } else {
            f32x16 acc = f32x16{};
            acc = mm_ll(L + O_BHT, 32 * mt, L + O_U0T, 32 * nt, acc, r32, hi);
            acc = mm_ll(L + O_KHT, 32 * mt, L + O_VT, 32 * nt, acc, r32, hi);
            store_native(slot + 8192 + (mt * 2 + nt) * 2048, acc, lane, wt);
            f32x16 y0 = f32x16{};
            y0 = mm_ll(L + O_ARB, 32 * mt, L + O_U0T, 32 * nt, y0, r32, hi);
            y0 = mm_ll(L + O_ARK, 32 * mt, L + O_VT, 32 * nt, y0, r32, hi);
            store_native(slot + 24576 + (mt * 2 + nt) * 2048, y0, lane, wt);
        }
    }
    LBAR(); PST();
    s1_stage_store(L, tid, nd, nq, nck, stg, par);
    LBAR(); PST();
#undef PAR
#undef TAU
#undef LD10
#undef PST
}

__device__ __forceinline__ void s23_wait_round(unsigned* ready, int r, int lane) {
    unsigned spins = 0;
    while ((unsigned)__builtin_amdgcn_readfirstlane(__hip_atomic_load(ready + r, __ATOMIC_RELAXED, __HIP_MEMORY_SCOPE_AGENT)) < 16u) { __builtin_amdgcn_s_sleep(8); if (++spins > (1u << 22)) break; }
    __builtin_amdgcn_fence(__ATOMIC_ACQUIRE, "agent");
    asm volatile("s_waitcnt vmcnt(0)" ::: "memory");
}
__device__ __forceinline__ void s23_chain_wg(const Frame& F, const Args& a, int d, int q, int h, unsigned char* slots  , unsigned* ready) {
    LAS unsigned char* L = F.lds;
    const int lane = F.lane, w = F.wave, icb = w & 1;
    const int NC = seq_len(q) / 64;
    f32x16 X0 = f32x16{}, X1 = f32x16{};
    const bool loader = w >= 4, compute = w < 2;
    constexpr int D = 6;
#define CKOF(cc) (d == 0 ? (cc) : NC - 1 - (cc))
#define S23_DMA(cc) do { const unsigned char* src_ = slots + (size_t)CKOF(cc) * SLOT_BYTES + (w - 4) * 4096 + lane * 16; LAS unsigned char* dst_ = L + ((cc) & 7) * 16384 + (w - 4) * 4096; \
        _Pragma("unroll") for (int p_ = 0; p_ < 4; ++p_) __builtin_amdgcn_global_load_lds((const unsigned*)(src_ + p_ * 1024), (LAS unsigned*)(dst_ + p_ * 1024), 16, 0, 0); } while (0)
#define UNPK(dst, w0, w1) do { _Pragma("unroll") for (int q_ = 0; q_ < 4; ++q_) { dst[2 * q_] = bflo(w0[q_]); dst[2 * q_ + 1] = bfhi(w0[q_]); dst[8 + 2 * q_] = bflo(w1[q_]); dst[9 + 2 * q_] = bfhi(w1[q_]); } } while (0)
    if (ready) { if (w == 4) s23_wait_round(ready, 0, lane); asm volatile("s_waitcnt lgkmcnt(0)\n\ts_barrier" ::: "memory"); }
    if (loader) {
#pragma unroll
        for (int c0 = 0; c0 < D; ++c0) if (c0 < NC) S23_DMA(c0); }
#pragma unroll 1
    for (int cc = 0; cc < NC; ++cc) {
        if (ready && w == 4 && ((cc + D) & 15) == 0 && cc + D < NC) s23_wait_round(ready, (cc + D) >> 4, lane);
        if (loader) { const int later = NC - 1 - cc;
            if (later >= 5) asm volatile("s_waitcnt vmcnt(20)" ::: "memory"); else if (later == 4) asm volatile("s_waitcnt vmcnt(16)" ::: "memory"); else if (later == 3) asm volatile("s_waitcnt vmcnt(12)" ::: "memory");
            else if (later == 2) asm volatile("s_waitcnt vmcnt(8)" ::: "memory"); else if (later == 1) asm volatile("s_waitcnt vmcnt(4)" ::: "memory"); else asm volatile("s_waitcnt vmcnt(0)" ::: "memory"); }
        asm volatile("s_waitcnt lgkmcnt(0)\n\ts_barrier" ::: "memory");
        if (loader) { if (cc + D < NC) S23_DMA(cc + D); }
        if (compute) {
            const LAS unsigned char* sl = L + (cc & 7) * 16384 + lane * 32;
            u32x4 mw[4][2], dw[2][2];
#pragma unroll
            for (int t = 0; t < 4; ++t) { mw[t][0] = *(const LAS u32x4*)(sl + t * 2048); mw[t][1] = *(const LAS u32x4*)(sl + t * 2048 + 16); }
#pragma unroll
            for (int t = 0; t < 2; ++t) { dw[t][0] = *(const LAS u32x4*)(sl + 8192 + (t * 2 + icb) * 2048); dw[t][1] = *(const LAS u32x4*)(sl + 8192 + (t * 2 + icb) * 2048 + 16); }
            __builtin_amdgcn_sched_barrier(0);
            u32x4 xw[2][2];
#pragma unroll
            for (int s = 0; s < 2; ++s) {
                xw[0][s] = (u32x4){cvt_pk_bf16(X0[8 * s], X0[8 * s + 1]), cvt_pk_bf16(X0[8 * s + 2], X0[8 * s + 3]), cvt_pk_bf16(X0[8 * s + 4], X0[8 * s + 5]), cvt_pk_bf16(X0[8 * s + 6], X0[8 * s + 7])};
                xw[1][s] = (u32x4){cvt_pk_bf16(X1[8 * s], X1[8 * s + 1]), cvt_pk_bf16(X1[8 * s + 2], X1[8 * s + 3]), cvt_pk_bf16(X1[8 * s + 4], X1[8 * s + 5]), cvt_pk_bf16(X1[8 * s + 6], X1[8 * s + 7])}; }
            { unsigned char* xo = slots + (size_t)CKOF(cc) * SLOT_BYTES + ((icb * 2) * 64 + lane) * 32;
              *(u32x4*)(xo) = xw[0][0]; *(u32x4*)(xo + 16) = xw[0][1]; *(u32x4*)(xo + 2048) = xw[1][0]; *(u32x4*)(xo + 2048 + 16) = xw[1][1]; }
            asm volatile("s_waitcnt lgkmcnt(0)" ::: "memory");
            __builtin_amdgcn_sched_barrier(0);
            f32x16 N0, N1;
            UNPK(N0, dw[0][0], dw[0][1]); UNPK(N1, dw[1][0], dw[1][1]);
#pragma unroll
            for (int rb = 0; rb < 2; ++rb)
#pragma unroll
                for (int s = 0; s < 2; ++s) {
                    N0 = __builtin_amdgcn_mfma_f32_32x32x16_bf16(__builtin_bit_cast(bf16x8, mw[rb * 2 + 0][s]), __builtin_bit_cast(bf16x8, xw[rb][s]), N0, 0, 0, 0);
                    N1 = __builtin_amdgcn_mfma_f32_32x32x16_bf16(__builtin_bit_cast(bf16x8, mw[rb * 2 + 1][s]), __builtin_bit_cast(bf16x8, xw[rb][s]), N1, 0, 0, 0); }
            X0 = N0; X1 = N1;
        }
    }
    asm volatile("s_waitcnt vmcnt(0) lgkmcnt(0)\n\ts_barrier" ::: "memory");
#undef UNPK
#undef S23_DMA
#undef CKOF
}

constexpr int PO_V = 0, PO_G = PO_V + 66 * 144, PO_Y = PO_G + 66 * 272, PO_SG = PO_Y + 2 * 64 * 272, PO_GF = PO_SG + 64 * 272, PO_END = PO_GF + 64 * 272;
static_assert(PO_END <= PTRS_OFF - 64, "post lds");
struct PostPre { u32x4 stg[4]; u32x4 ra[2][2], xb[2][2], yc[2]; };
__device__ __forceinline__ void post_decode(int c, int& reg, int& row, int& part) {
    if (c < 528) { reg = 0; row = c >> 3; part = c & 7; } else { reg = 1; row = (c - 528) >> 4; part = (c - 528) & 15; }
}
__device__ __forceinline__ void post_stage_load(const Args& a, int tid, int q, int h, int blk, PostPre& pp) {
    const int row0 = seq_row0(q), S = seq_len(q), t0 = blk * 64;
    const bf16_t* Zs = (const bf16_t*)(a.ws + WS_Z) + (size_t)row0 * ZP;
#pragma unroll
    for (int k = 0; k < 4; ++k) { const int c = tid + k * NTHR; int reg, row, part; post_decode(c, reg, row, part);
        const int t = t0 - 1 + row; const int col = reg == 0 ? ZRV + h * 64 : ZGD;
        pp.stg[k] = (u32x4){0u, 0u, 0u, 0u};
        if (c < 1584 && t >= 0 && t < S) pp.stg[k] = *(const u32x4*)(Zs + (size_t)t * ZP + col + part * 8); }
    const int w = tid >> 6, lane = tid & 63, dd = w >> 2, tb = (w >> 1) & 1, icb = w & 1;
    const size_t si = q == 0 ? (size_t)(dd * 8 + h) * 256 + blk : (size_t)((dd * 8 + (q - 1)) * 8 + h) * 32 + blk;
    const unsigned char* sl = (const unsigned char*)a.out + si * SLOT_BYTES + lane * 32;
#pragma unroll
    for (int rb = 0; rb < 2; ++rb) { pp.ra[rb][0] = *(const u32x4*)(sl + 16384 + (rb * 2 + tb) * 2048); pp.ra[rb][1] = *(const u32x4*)(sl + 16384 + (rb * 2 + tb) * 2048 + 16);
                                     pp.xb[rb][0] = *(const u32x4*)(sl + (icb * 2 + rb) * 2048); pp.xb[rb][1] = *(const u32x4*)(sl + (icb * 2 + rb) * 2048 + 16); }
    pp.yc[0] = *(const u32x4*)(sl + 24576 + (tb * 2 + icb) * 2048); pp.yc[1] = *(const u32x4*)(sl + 24576 + (tb * 2 + icb) * 2048 + 16);
}
__device__ __forceinline__ void post_item(const Frame& F, const Args& a, int q, int h, int blk, PostPre& pp, int nq, int nh, int nblk) {
    LAS unsigned char* L = F.lds;
    int lane_ = F.lane; asm volatile("" : "+v"(lane_));
    const int lane = lane_, w = F.wave, tid = w * 64 + lane, r32 = lane & 31, hi = lane >> 5, j = lane, tg = w;
    const int row0 = seq_row0(q), t_lo = blk * 64 + 8 * tg;
    bf16_t* Zs = (bf16_t*)(a.ws + WS_Z) + (size_t)row0 * ZP;
    const float* mup = inp(L, 11); const float* mun = inp(L, 12);
    const int chp = h * 64 + j;
    const float mp0 = gld(mup + ZGD - ZRR + j), mn0 = gld(mun + ZGD - ZRR + j), mp1 = gld(mup + ZGD - ZRR + 64 + j), mn1 = gld(mun + ZGD - ZRR + 64 + j);
    const float mpv = gld(mup + 1024 + chp), mnv = gld(mun + 1024 + chp), lg = gld(inp(L, 21) + chp), lb = gld(inp(L, 22) + chp);
    float bsum[8];
    { const float* bon0 = (const float*)(a.ws + WS_BONUS) + (size_t)row0 * 8 + h; const float* bon1 = bon0 + (size_t)MTOK * 8;
#pragma unroll
      for (int u = 0; u < 8; ++u) bsum[u] = bon0[(size_t)(t_lo + u) * 8] + bon1[(size_t)(t_lo + u) * 8]; }
    bf16x8 gfr[8];
    { const bf16_t* GT = (const bf16_t*)(a.ws + WS_LORA) + 4 * 512 * 64 + ((size_t)h * 64 + 32 * ((w >> 1) & 1) + r32) * 128;
#pragma unroll
      for (int ks = 0; ks < 8; ++ks) gfr[ks] = *(const bf16x8*)(GT + 16 * ks + 8 * hi); }
#pragma unroll
    for (int k = 0; k < 4; ++k) { const int c = tid + k * NTHR; int reg, row, part; post_decode(c, reg, row, part);
        const int off = reg == 0 ? PO_V + row * 144 : PO_G + row * 272;
        if (c < 1584) *(LAS u32x4*)(L + off + part * 16) = pp.stg[k]; }
    {
        const int dd = w >> 2, tb = (w >> 1) & 1, icb = w & 1;
        f32x16 Y;
#pragma unroll
        for (int q_ = 0; q_ < 4; ++q_) { Y[2 * q_] = bflo(pp.yc[0][q_]); Y[2 * q_ + 1] = bfhi(pp.yc[0][q_]); Y[8 + 2 * q_] = bflo(pp.yc[1][q_]); Y[9 + 2 * q_] = bfhi(pp.yc[1][q_]); }
#pragma unroll
        for (int rb = 0; rb < 2; ++rb)
#pragma unroll
            for (int s2 = 0; s2 < 2; ++s2) Y = __builtin_amdgcn_mfma_f32_32x32x16_bf16(__builtin_bit_cast(bf16x8, pp.ra[rb][s2]), __builtin_bit_cast(bf16x8, pp.xb[rb][s2]), Y, 0, 0, 0);
#pragma unroll
        for (int r = 0; r < 16; ++r) { const int tau = 32 * tb + (r & 3) + 8 * (r >> 2) + 4 * hi; const int t = dd == 0 ? tau : 63 - tau;
            *(LAS float*)(L + PO_Y + (dd * 64 + t) * 272 + (32 * icb + r32) * 4) = Y[r]; }
    }
    LBAR();
    post_stage_load(a, tid, nq, nh, nblk, pp);
    {
        float z0[10], z1[10];
#pragma unroll
        for (int i = 0; i < 10; ++i) { z0[i] = bf2f(*(const LAS bf16_t*)(L + PO_G + (8 * tg + i) * 272 + j * 2)); z1[i] = bf2f(*(const LAS bf16_t*)(L + PO_G + (8 * tg + i) * 272 + (64 + j) * 2)); }
#pragma unroll
        for (int u = 0; u < 8; ++u) { const float s0_ = sigmoidf_(tshift(z0, u, mp0, mn0)), s1_ = sigmoidf_(tshift(z1, u, mp1, mn1));
#define NBR(x) __int_as_float(__builtin_amdgcn_update_dpp(0, __float_as_int(x), 0xB1, 0xF, 0xF, true))
            const unsigned p0_ = cvt_pk_bf16(s0_, NBR(s0_)), p1_ = cvt_pk_bf16(s1_, NBR(s1_));
#undef NBR
            if (!(lane & 1)) { *(LAS unsigned*)(L + PO_SG + (8 * tg + u) * 272 + j * 2) = p0_; *(LAS unsigned*)(L + PO_SG + (8 * tg + u) * 272 + (64 + j) * 2) = p1_; } }
    }
    LBAR();
    if (w < 4) {
        const int mt = w >> 1, nt = w & 1;
        f32x16 acc = f32x16{};
#pragma unroll
        for (int ks = 0; ks < 8; ++ks) { const bf16x8 bv = *(const LAS bf16x8*)(L + PO_SG + (32 * nt + r32) * 272 + (16 * ks + 8 * hi) * 2);
            acc = __builtin_amdgcn_mfma_f32_32x32x16_bf16(gfr[ks], bv, acc, 0, 0, 0); }
#pragma unroll
        for (int g = 0; g < 4; ++g) *(LAS f32x4*)(L + PO_GF + (32 * nt + r32) * 272 + (32 * mt + 8 * g + 4 * hi) * 4) = (f32x4){acc[4 * g], acc[4 * g + 1], acc[4 * g + 2], acc[4 * g + 3]};
    }
    LBAR();
    {
        const int ch = h * 64 + j;
        float zv[10];
#pragma unroll
        for (int i = 0; i < 10; ++i) zv[i] = bf2f(*(const LAS bf16_t*)(L + PO_V + (8 * tg + i) * 144 + j * 2));
        float y8[8], m8[8], v8[8];
#pragma unroll
        for (int u = 0; u < 8; ++u) { y8[u] = *(const LAS float*)(L + PO_Y + (8 * tg + u) * 272 + j * 4) + *(const LAS float*)(L + PO_Y + (64 + 8 * tg + u) * 272 + j * 4); m8[u] = y8[u]; }
        wave_sum8(m8, lane);
#pragma unroll
        for (int u = 0; u < 8; ++u) { y8[u] -= m8[u] * (1.f / 64.f); v8[u] = y8[u] * y8[u]; }
        wave_sum8(v8, lane);
#pragma unroll
        for (int u = 0; u < 8; ++u) { const int t = t_lo + u;
            const float yn = y8[u] * __builtin_amdgcn_rsqf(v8[u] * (1.f / 64.f) + LNX_EPS) * lg + lb;
            const float g = *(const LAS float*)(L + PO_GF + (8 * tg + u) * 272 + j * 4);
            Zs[(size_t)t * ZP + ZRR + ch] = f2bf((yn + bsum[u] * tshift(zv, u, mpv, mnv)) * g); }
    }
    LBAR();
}
}


#define XB_TMO      128
#define XB_XCNT(j)  (256  + 64 * (j))
#define XB_XSUB(j)  (1280 + 64 * (j))
#define XB_XGEN(j)  (2304 + 64 * (j))
#define XB_TOP      3328
#define XB_TOPGEN   3392
#define XCD_BAR_WORDS 3456
#define XB_SPIN_CAP (1u << 20)
constexpr size_t CTL_ZERO_BYTES = 16384;
__device__ __forceinline__ unsigned xb_ld(unsigned* p)              { return __hip_atomic_load(p, __ATOMIC_RELAXED, __HIP_MEMORY_SCOPE_AGENT); }
__device__ __forceinline__ unsigned xb_add(unsigned* p, unsigned v) { return __hip_atomic_fetch_add(p, v, __ATOMIC_RELAXED, __HIP_MEMORY_SCOPE_AGENT); }
__device__ __forceinline__ unsigned xb_xcc_id() { return (unsigned)__builtin_amdgcn_s_getreg((3 << 11) | 20) & 0xFu; }
#define XB_SPIN(cond, bar) do { unsigned _sp = 0; while (cond) { __builtin_amdgcn_s_sleep(1); \
    if ((++_sp & 255u) == 0u) { if (xb_ld(&(bar)[XB_TMO])) break; if (_sp > XB_SPIN_CAP) { atomicAdd(&(bar)[XB_TMO], 1u); break; } } } } while (0)
struct XcdBarrier { unsigned* bar; unsigned x; volatile LAS unsigned* st; };
__device__ __forceinline__ XcdBarrier xcd_barrier_post(unsigned* bar, volatile LAS unsigned* st) {
    XcdBarrier b; b.bar = bar; b.x = xb_xcc_id(); b.st = st;
    if (threadIdx.x == 0) (void)xb_add(&bar[XB_XCNT(b.x)], 1u);
    return b;
}
__device__ __forceinline__ void xcd_barrier_complete(unsigned* bar, unsigned x, unsigned& nloc, unsigned& nx) {
    const unsigned G = gridDim.x * gridDim.y * gridDim.z;
    unsigned sum, cnt, mine, sp = 0u;
    for (;;) {
        sum = 0u; cnt = 0u; mine = 0u;
#pragma unroll
        for (unsigned j = 0; j < 16; ++j) { const unsigned c = xb_ld(&bar[XB_XCNT(j)]); sum += c; cnt += (c > 0u) ? 1u : 0u; mine = (j == x) ? c : mine; }
        if (sum == G) break;
        __builtin_amdgcn_s_sleep(1);
        if ((++sp & 255u) == 0u) { if (xb_ld(&bar[XB_TMO])) break; if (sp > XB_SPIN_CAP) { atomicAdd(&bar[XB_TMO], 1u); break; } }
    }
    nloc = mine > 0u ? mine : 1u; nx = cnt > 0u ? cnt : 1u;
}
__device__ __forceinline__ void xcd_barrier(const XcdBarrier& b) {
    asm volatile("s_waitcnt vmcnt(0)" ::: "memory");
    __syncthreads();
    if (threadIdx.x == 0) {
        unsigned* bar = b.bar;
        __builtin_amdgcn_s_waitcnt(0);
        unsigned nloc = b.st[0], nx = b.st[1];
        if (nloc == 0u) { xcd_barrier_complete(bar, b.x, nloc, nx); b.st[0] = nloc; b.st[1] = nx; }
        const unsigned old = xb_add(&bar[XB_XSUB(b.x)], 1u);
        const unsigned gen = old / nloc;
        if (old + 1u == (gen + 1u) * nloc) {
            __builtin_amdgcn_fence(__ATOMIC_RELEASE, "agent");
            asm volatile("s_waitcnt vmcnt(0)" ::: "memory");
            const unsigned og = xb_add(&bar[XB_TOP], 1u);
            const unsigned tg = og / nx;
            if (og + 1u == (tg + 1u) * nx) xb_add(&bar[XB_TOPGEN], 1u);
            else XB_SPIN(xb_ld(&bar[XB_TOPGEN]) == tg, bar);
            __builtin_amdgcn_fence(__ATOMIC_ACQUIRE, "agent");
            xb_add(&bar[XB_XGEN(b.x)], 1u);
            asm volatile("s_waitcnt vmcnt(0)" ::: "memory");
        } else {
            XB_SPIN(xb_ld(&bar[XB_XGEN(b.x)]) == gen, bar);
            __builtin_amdgcn_fence(__ATOMIC_ACQUIRE, "agent");
            asm volatile("s_waitcnt vmcnt(0)" ::: "memory");
        }
    }
    __syncthreads();
}

constexpr int NPHASE = 10;
constexpr int NOJUMP = 1 << 30;
template <int LO, int HI>
__global__ void __launch_bounds__(NTHR, 2) fwd_kernel(Args a) {
    extern __shared__ __attribute__((aligned(16))) unsigned char lds_raw[];
    Frame F; F.lds = (LAS unsigned char*)lds_raw; F.tid = threadIdx.x; F.lane = F.tid & 63; F.wave = __builtin_amdgcn_readfirstlane(F.tid >> 6);
    F.G = gridDim.x; { const int bx = blockIdx.x; F.vcu = (F.G % 8 == 0) ? (bx % 8) * (F.G / 8) + bx / 8 : bx; }
    unsigned char* ws = a.ws; bf16_t* Z = (bf16_t*)(ws + WS_Z);
    unsigned char* slots = (unsigned char*)a.out;
    if (F.tid == 0) {
#pragma unroll
        for (int i = 0; i < 27; ++i) *(const float* LAS*)(F.lds + PTRS_OFF + i * 8) = a.in[i];
        *(volatile LAS unsigned*)(F.lds + PTRS_OFF + 224) = 0u; *(volatile LAS unsigned*)(F.lds + PTRS_OFF + 228) = 0u;
        *(LAS unsigned long long*)(F.lds + PTRS_OFF - 64) = 0ull;
    }
    __syncthreads();
#if ONE_LAUNCH && !USE_CG
    const XcdBarrier bar = xcd_barrier_post((unsigned*)(ws + WS_CTL), (volatile LAS unsigned*)(F.lds + PTRS_OFF + 224));
#endif
#if ONE_LAUNCH
#if PROBE_SEG >= 0 || PROBE_CLK >= 0
    unsigned long long* tsb = (unsigned long long*)(ws + WS_CTL + 15872); int nts = 0;
#define STAMP() do { if (blockIdx.x == 0 && F.tid == 0) { tsb[nts] = __builtin_amdgcn_s_memrealtime(); tsb[32 + nts] = __builtin_amdgcn_s_memtime(); } ++nts; } while (0)
    STAMP();
#else
#define STAMP() do { } while (0)
#endif
#if USE_CG
#define SEAM(k) do { if constexpr ((k) + 1 < HI) { cg::this_grid().sync(); STAMP(); } } while (0)
#define RSYNC() do { cg::this_grid().sync(); STAMP(); } while (0)
#else
#define SEAM(k) do { if constexpr ((k) + 1 < HI) { xcd_barrier(bar); STAMP(); } } while (0)
#define RSYNC() do { xcd_barrier(bar); STAMP(); } while (0)
#endif
#else
#define SEAM(k) do { } while (0)
#define RSYNC() do { } while (0)
#endif
#define IN(k) (LO <= (k) && (k) < HI)
    if constexpr (IN(0)) { p0_prologue(F, a); SEAM(0);
#if PROBE_DOUBLE == 4
        p0_prologue(F, a); RSYNC();
#endif
    }
    if constexpr (IN(1)) { pg8::Gemm g{(const char*)a.out, (const bf16_t*)(ws + WS_WIN), MTOK, ZP, DM, DM * 2, NOJUMP, 0}; pg8::StaticOrder S; S.init(MTOK, ZP, F.G, (int)blockIdx.x);
        pg8::EpiZ E{Z, ZP}; pg8::gemm_phase<pg8::EpiZ, pg8::StaticOrder, true>(F.lds, g, S, E); SEAM(1);
#if PROBE_DOUBLE == 3
        pg8::gemm_phase<pg8::EpiZ, pg8::StaticOrder, true>(F.lds, g, S, E); RSYNC();
#endif
    }
    if constexpr (IN(2)) { qk_prep(F, a);
        unsigned* rdy = (unsigned*)(ws + WS_CTL) + 3584;
#pragma unroll 1
        for (int rnd = 0; rnd < 2; ++rnd) {
            const int nprod = rnd == 1 ? F.G - 16 : F.G;
            if (F.vcu < nprod) {
#define S1_DECODE(i_, d_, q_, h_, ck_, it_, pub_) do { if (rnd == 1) { const int c_ = ((i_) >> 4) & 15, cc_ = (((i_) >> 8) << 4) + ((i_) & 15); d_ = c_ >> 3; h_ = c_ & 7; q_ = 0; ck_ = d_ ? 255 - cc_ : cc_; it_ = c_ * 256 + ck_; pub_ = rdy + c_ * 16 + ((i_) >> 8); } \
                    else { ck_ = (i_) & 31; h_ = ((i_) >> 5) & 7; q_ = 1 + (((i_) >> 8) & 7); d_ = (i_) >> 11; it_ = (i_); pub_ = nullptr; } } while (0)
                { int d, q, h, ck, it; unsigned* pub; S1_DECODE(F.vcu, d, q, h, ck, it, pub); (void)it; (void)pub;
                  u32x4 stg[6]; rw::s1_stage_load(a, F.tid, q, h, ck, stg); const f32x2_t par = rw::s1_param_load(F.lds, F.tid, d, h);
                  rw::s1_stage_store(F.lds, F.tid, d, q, ck, stg, par); LBAR(); }
                unsigned* pub_prev = nullptr;
#pragma unroll 1
                for (int i = F.vcu; i < 4096; i += nprod) {
                    int d, q, h, ck, it, nd, nq, nh, nck, nit; unsigned* pub; unsigned* npub; S1_DECODE(i, d, q, h, ck, it, pub); const int ni = i + nprod < 4096 ? i + nprod : i; S1_DECODE(ni, nd, nq, nh, nck, nit, npub); (void)nit; (void)npub;
                    rw::s1_item(F, a, d, q, h, ck, slots + (size_t)it * SLOT_BYTES, nd, nq, nh, nck, rnd == 1, pub_prev); pub_prev = pub; }
                if (pub_prev) { asm volatile("s_waitcnt vmcnt(0)" ::: "memory"); __syncthreads(); if (F.tid == 0) __hip_atomic_fetch_add(pub_prev, 1u, __ATOMIC_RELAXED, __HIP_MEMORY_SCOPE_AGENT); }
#undef S1_DECODE
            } else {
                const int c = F.vcu - nprod;
                rw::s23_chain_wg(F, a, c >> 3, 0, c & 7, slots + (size_t)c * 256 * SLOT_BYTES, rdy + c * 16);
            }
            if (rnd == 0) {
                RSYNC();
                for (int chain = F.vcu; chain < 128; chain += F.G) { const int h = chain & 7, q = 1 + ((chain >> 3) & 7), d = chain >> 6;
                    rw::s23_chain_wg(F, a, d, q, h, slots + (size_t)chain * 32 * SLOT_BYTES, nullptr); }
            }
            RSYNC();
            {
#define PO_DECODE(it_, q_, h_, b_) do { if (rnd == 1) { q_ = 0; h_ = ((it_) >> 8) & 7; b_ = (it_) & 255; } else { q_ = 1 + (((it_) >> 8) & 7); h_ = ((it_) >> 5) & 7; b_ = (it_) & 31; } } while (0)
                rw::PostPre pp;
                { int q, h, b; PO_DECODE(F.vcu, q, h, b); rw::post_stage_load(a, F.tid, q, h, b, pp); }
#pragma unroll 1
                for (int it = F.vcu; it < 2048; it += F.G) { int q, h, b, nq, nh, nb; PO_DECODE(it, q, h, b); const int nit = it + F.G < 2048 ? it + F.G : it; PO_DECODE(nit, nq, nh, nb);
                    rw::post_item(F, a, q, h, b, pp, nq, nh, nb); }
#undef PO_DECODE
            }
            if (rnd == 0) RSYNC();
        }
        SEAM(2); }
    if constexpr (IN(4)) {
        float lam; { const float p1 = wave_sum(a.in[6][F.lane] * a.in[7][F.lane]), p2 = wave_sum(a.in[8][F.lane] * a.in[9][F.lane]); lam = __expf(p1) - __expf(p2) + LAMBDA_INIT; }
#if PROBE_DOUBLE == 1
        for (int v = F.vcu; v < 256; v += F.G) {
            att::attn_unit(0, SP, v >> 6, v & 63, Z, F.lds, lam, a.in[10], (bf16_t*)a.out, 512);
            att::attn_unit(SP + (v >> 5) * SS, SS, (v >> 3) & 3, v & 7, Z, F.lds, lam, a.in[10], (bf16_t*)a.out, 512); }
        RSYNC();
#endif
        for (int v = F.vcu; v < 256; v += F.G) {
            att::attn_unit(0, SP, v >> 6, v & 63, Z, F.lds, lam, a.in[10], Z, ZP);
            att::attn_unit(SP + (v >> 5) * SS, SS, (v >> 3) & 3, v & 7, Z, F.lds, lam, a.in[10], Z, ZP); }
        SEAM(4); }
    if constexpr (IN(5)) { pg8::Gemm g{(const char*)Z, (const bf16_t*)(ws + WS_WOUT), MTOK, DM, DM, ZP * 2, 8, 2048}; pg8::StaticOrder S; S.init(MTOK, DM, F.G, (int)blockIdx.x);
        pg8::EpiOut E{a.in[0], a.in[1], a.out, Z, (float*)(ws + WS_ROWSQ)}; pg8::gemm_phase<pg8::EpiOut, pg8::StaticOrder, true>(F.lds, g, S, E); SEAM(5); }
#define FFN_UP(k, half) if constexpr (IN(k)) { pg8::Gemm g{(const char*)(Z + (size_t)(half) * 16384 * ZP + ZXN2), (const bf16_t*)(ws + WS_W1), 16384, DFF, DM, ZP * 2, NOJUMP, 0}; pg8::StaticOrder S; S.init(16384, DFF, F.G, (int)blockIdx.x); \
        pg8::EpiUp E{(char*)(ws + WS_Z), (const float*)(ws + WS_ROWSQ), (half) * 16384}; pg8::gemm_phase<pg8::EpiUp, pg8::StaticOrder, true>(F.lds, g, S, E); SEAM(k); }
#define FFN_DN(k, half) if constexpr (IN(k)) { pg8::Gemm g{(const char*)(ws + WS_Z), (const bf16_t*)(ws + WS_W2), 16384, DM, DFF, 13312, 32, 2560}; pg8::StaticOrder S; S.init(16384, DM, F.G, (int)blockIdx.x); \
        pg8::EpiDown E{a.out, (half) * 16384}; pg8::gemm_phase<pg8::EpiDown, pg8::StaticOrder, true>(F.lds, g, S, E); SEAM(k); }
    FFN_UP(6, 0) FFN_DN(7, 0) FFN_UP(8, 1) FFN_DN(9, 1)
#if PROBE_S1 >= 0 || PROBE_ATT
    if (F.tid == 0) { const unsigned long long dt = *(LAS unsigned long long*)(F.lds + PTRS_OFF - 64), t0_ = __builtin_amdgcn_s_memrealtime();
        while (__builtin_amdgcn_s_memrealtime() - t0_ < dt) __builtin_amdgcn_s_sleep(16); }
#endif
#if PROBE_SEG >= 0 || PROBE_CLK >= 0
    STAMP();
#if PROBE_CLK >= 0
    if (blockIdx.x == 0 && F.tid == 0) { asm volatile("s_waitcnt vmcnt(0)" ::: "memory"); const unsigned long long wt_ = tsb[PROBE_CLK + 1] - tsb[PROBE_CLK], cy_ = tsb[32 + PROBE_CLK + 1] - tsb[32 + PROBE_CLK];
        const unsigned long long dt = cy_ * 1000ull / (wt_ ? wt_ : 1ull), t0_ = __builtin_amdgcn_s_memrealtime();
        while (__builtin_amdgcn_s_memrealtime() - t0_ < dt) __builtin_amdgcn_s_sleep(16); }
#endif
    if (PROBE_CLK < 0 && blockIdx.x == 0 && F.tid == 0) { asm volatile("s_waitcnt vmcnt(0)" ::: "memory"); const unsigned long long dt = tsb[PROBE_SEG + 1] - tsb[PROBE_SEG], t0_ = __builtin_amdgcn_s_memrealtime();
        while (__builtin_amdgcn_s_memrealtime() - t0_ < dt) __builtin_amdgcn_s_sleep(16); }
#endif
#undef FFN_UP
#undef FFN_DN
#undef IN
#undef SEAM
#undef RSYNC
}

extern "C" void kernel_launch(void* const* d_in, const int* in_sizes, int n_in, void* d_out, int out_size, void* d_ws, size_t ws_size, hipStream_t stream) {
    static int grid = 0;
    if (grid == 0) {
        if (n_in != 27 || out_size != MTOK * DM || ws_size < WS_TOTAL) { fprintf(stderr, "kernel_launch: unexpected shapes (n_in %d out %d ws %zu)\n", n_in, out_size, ws_size); grid = -1; return; }
        int dev = 0, cus = 0; (void)hipGetDevice(&dev); (void)hipDeviceGetAttribute(&cus, hipDeviceAttributeMultiprocessorCount, dev);
        bool ok = true;
#if ONE_LAUNCH
        ok = ok && hipFuncSetAttribute((const void*)fwd_kernel<0, NPHASE>, hipFuncAttributeMaxDynamicSharedMemorySize, LDS_BYTES) == hipSuccess;
        int per_cu = 0; (void)hipOccupancyMaxActiveBlocksPerMultiprocessor(&per_cu, (const void*)fwd_kernel<0, NPHASE>, NTHR, LDS_BYTES); (void)hipGetLastError();
        if (per_cu < 1) fprintf(stderr, "kernel_launch: occupancy query says %d blocks/CU\n", per_cu);
#else
#define SETA(p) ok = ok && hipFuncSetAttribute((const void*)fwd_kernel<p, p + 1>, hipFuncAttributeMaxDynamicSharedMemorySize, LDS_BYTES) == hipSuccess;
        SETA(0) SETA(1) SETA(2) SETA(3) SETA(4) SETA(5) SETA(6) SETA(7) SETA(8) SETA(9)
#undef SETA
#endif
        if (!ok) { fprintf(stderr, "kernel_launch: hipFuncSetAttribute failed\n"); grid = -1; return; }
        grid = cus > 256 ? 256 : cus;
    }
    if (grid < 0) return;
    Args a{};
    for (int i = 0; i < 27; ++i) a.in[i] = (const float*)d_in[i];
    a.out = (float*)d_out; a.ws = (unsigned char*)d_ws;
#if ONE_LAUNCH
    a.ph_lo = 0; a.ph_hi = NPHASE;
#if !USE_CG
    if (hipMemsetAsync((char*)d_ws + WS_CTL, 0, CTL_ZERO_BYTES, stream) != hipSuccess) { fprintf(stderr, "kernel_launch: hipMemsetAsync failed\n"); return; }
#endif
    void* args[] = {&a};
    hipError_t e = hipLaunchCooperativeKernel((const void*)fwd_kernel<0, NPHASE>, dim3(grid), dim3(NTHR), args, LDS_BYTES, stream);
    if (e != hipSuccess) fprintf(stderr, "cooperative launch failed: %s (grid %d)\n", hipGetErrorString(e), grid);
#else
#define LAUNCH(p) hipLaunchKernelGGL((fwd_kernel<p, p + 1>), dim3(grid), dim3(NTHR), LDS_BYTES, stream, a);
    LAUNCH(0) LAUNCH(1) LAUNCH(2) LAUNCH(3) LAUNCH(4) LAUNCH(5) LAUNCH(6) LAUNCH(7) LAUNCH(8) LAUNCH(9)
#undef LAUNCH
#endif
}
```

```cpp
#include <hip/hip_runtime.h>
#include <hip/hip_cooperative_groups.h>
#include <cstdio>
#include <cstdint>
namespace cg = cooperative_groups;

#ifndef ONE_LAUNCH
#define ONE_LAUNCH 1
#endif
#ifndef USE_CG
#define USE_CG 0
#endif
#ifndef PROBE_SEG
#define PROBE_SEG -1
#endif
#ifndef PROBE_S1
#define PROBE_S1 -1
#endif
#ifndef PROBE_ATT
#define PROBE_ATT 0
#endif
#ifndef PROBE_CLK
#define PROBE_CLK -1
#endif
#ifndef PROBE_DOUBLE
#define PROBE_DOUBLE 0
#endif

#define LAS __attribute__((address_space(3)))
#define GAS __attribute__((address_space(1)))
typedef unsigned short bf16_t;
typedef short bf16x8 __attribute__((ext_vector_type(8)));
typedef short s16x4 __attribute__((ext_vector_type(4)));
typedef float f32x4 __attribute__((ext_vector_type(4)));
typedef float f32x16 __attribute__((ext_vector_type(16)));
typedef unsigned u32x4 __attribute__((ext_vector_type(4)));
typedef unsigned u32x2 __attribute__((ext_vector_type(2)));
typedef float f32x2_t __attribute__((ext_vector_type(2)));
typedef __bf16 bf16x2_t __attribute__((ext_vector_type(2)));

constexpr int MTOK = 32768, DM = 1024, ZP = 3328, DFF = 4096;
constexpr int SP = 16384, SS = 2048;
constexpr int ZQ = 0, ZK = 512, ZV = 1024, ZRR = 1536, ZRK = 2048, ZRV = 2560, ZWD = 3072, ZAD = 3136, ZGD = 3200;
constexpr int ZXN2 = 2048;
constexpr float NORM_EPS = 1e-6f, LNX_EPS = 64e-5f;
constexpr float QSCALE = 0.125f * 1.4426950408889634f;
constexpr float LAMBDA_INIT = 0.2f;
constexpr int NCHUNK_P = SP / 64, NCHUNK_S = SS / 64;

constexpr size_t MiB = 1u << 20;
constexpr size_t WS_CTL = 0;
constexpr size_t WS_WIN = 1 * MiB, WS_WOUT = 8 * MiB, WS_W1 = 10 * MiB, WS_W2 = 18 * MiB;
constexpr size_t WS_ROPE = 26 * MiB;
constexpr size_t WS_LORA = 30 * MiB;
constexpr size_t WS_ROWSQ = 31 * MiB;
constexpr size_t WS_BONUS = 33 * MiB;
constexpr size_t WS_Z = 36 * MiB;
constexpr size_t WS_END = 244 * MiB;
constexpr size_t WS_E1 = 244 * MiB;
constexpr size_t WS_TOTAL = 252 * MiB;
static_assert(WS_Z + (size_t)MTOK * ZP * 2 <= WS_END, "ws map");
constexpr size_t SLOT_BYTES = 32768;

__device__ __forceinline__ unsigned cvt_pk_bf16(float lo, float hi) { f32x2_t v = {lo, hi}; bf16x2_t b = __builtin_convertvector(v, bf16x2_t); return __builtin_bit_cast(unsigned, b); }
__device__ __forceinline__ float bf2f(unsigned short u) { return __uint_as_float(((unsigned)u) << 16); }
__device__ __forceinline__ float bflo(unsigned u) { return __uint_as_float(u << 16); }
__device__ __forceinline__ float bfhi(unsigned u) { return __uint_as_float(u & 0xffff0000u); }
__device__ __forceinline__ unsigned short f2bf(float f) { return (unsigned short)(cvt_pk_bf16(f, 0.f) & 0xffffu); }
__device__ __forceinline__ float wave_sum(float v) {
#pragma unroll
    for (int o = 1; o < 64; o <<= 1) v += __shfl_xor(v, o);
    return v;
}
__device__ __forceinline__ float wave_sum_dpp(float v) {
    int x = __float_as_int(v);
    v += __int_as_float(__builtin_amdgcn_update_dpp(0, x, 0xB1, 0xF, 0xF, true)); x = __float_as_int(v);
    v += __int_as_float(__builtin_amdgcn_update_dpp(0, x, 0x4E, 0xF, 0xF, true)); x = __float_as_int(v);
    v += __int_as_float(__builtin_amdgcn_update_dpp(0, x, 0x124, 0xF, 0xF, true)); x = __float_as_int(v);
    v += __int_as_float(__builtin_amdgcn_update_dpp(0, x, 0x128, 0xF, 0xF, true)); x = __float_as_int(v);
    const float a = __int_as_float(__builtin_amdgcn_readlane(x, 0)), b = __int_as_float(__builtin_amdgcn_readlane(x, 16)), c = __int_as_float(__builtin_amdgcn_readlane(x, 32)), d = __int_as_float(__builtin_amdgcn_readlane(x, 48));
    return (a + b) + (c + d);
}
__device__ __forceinline__ void wave_sum8(float (&s)[8], int lane) {
    float f[4];
#pragma unroll
    for (int i = 0; i < 4; ++i) { auto rr = __builtin_amdgcn_permlane32_swap(__float_as_uint(s[i]), __float_as_uint(s[i + 4]), false, false); f[i] = __uint_as_float(rr[0]) + __uint_as_float(rr[1]); }
    const bool b4 = (lane >> 4) & 1, b3 = (lane >> 3) & 1;
    float g[2];
#pragma unroll
    for (int i = 0; i < 2; ++i) { const float keep = b4 ? f[i + 2] : f[i], send = b4 ? f[i] : f[i + 2];
        g[i] = keep + __int_as_float(__builtin_amdgcn_ds_swizzle(__float_as_int(send), 0x401F)); }
    const float keep = b3 ? g[1] : g[0], send = b3 ? g[0] : g[1];
    float h = keep + __int_as_float(__builtin_amdgcn_update_dpp(0, __float_as_int(send), 0x128, 0xF, 0xF, true));
    h += __int_as_float(__builtin_amdgcn_update_dpp(0, __float_as_int(h), 0x141, 0xF, 0xF, true));
    h += __int_as_float(__builtin_amdgcn_update_dpp(0, __float_as_int(h), 0xB1, 0xF, 0xF, true));
    h += __int_as_float(__builtin_amdgcn_update_dpp(0, __float_as_int(h), 0x4E, 0xF, 0xF, true));
    const int hx = __float_as_int(h);
#pragma unroll
    for (int k = 0; k < 8; ++k) s[k] = __int_as_float(__builtin_amdgcn_readlane(hx, 8 * k));
}
#define LDS_WAIT() asm volatile("s_waitcnt lgkmcnt(0)" ::: "memory")
#define VM_WAIT() asm volatile("s_waitcnt vmcnt(0)" ::: "memory")
#define LBAR() asm volatile("s_waitcnt lgkmcnt(0)\n\ts_barrier" ::: "memory")

namespace pg8 {
constexpr int BM = 256, BK = 64, HALF = 128, HTB = HALF * BK * 2, STAGE_BYTES = 8 * HTB, NXCD = 8, WGM = 8;
__host__ __device__ __forceinline__ int lds_byte(int r, int c) { const int st = (r >> 4) * 2 + (c >> 5), rr = r & 15, cc = c & 31, ob = rr * 64 + cc * 2; return st * 1024 + (ob ^ (((ob >> 9) & 1) << 5)); }
__host__ __device__ __forceinline__ void stage_rc(int b, int& R, int& C) { const int st = b / 1024, sb = b % 1024, swz = sb ^ (((sb >> 9) & 1) << 5); R = (st >> 1) * 16 + swz / 64; C = (st & 1) * 32 + (swz % 64) / 2; }
__host__ __device__ __forceinline__ int perm32(int rho) { const int n = rho >> 4, i = rho & 15; return 8 * (i >> 2) + 4 * n + (i & 3); }
struct Unit { int pm, pn; };
struct Gemm { const char* A; const bf16_t* Bt; int M, N, K; int lda; int jkt; int jbytes; };
struct StaticOrder {
    int nM, nN, nwg, G, c;
    __host__ __device__ void init(int M, int N, int G_, int c_) { nM = M / BM; nN = N / BM; nwg = nM * nN; G = G_; c = c_; }
    __host__ __device__ bool next(int i, Unit& u) const {
        const long L = (long)i * G + c; if (L >= nwg) return false;
        int wgid = (int)L; { const int q = nwg / NXCD, r = nwg % NXCD, xcd = wgid % NXCD, off = wgid / NXCD; wgid = (xcd < r ? xcd * (q + 1) : r * (q + 1) + (xcd - r) * q) + off; }
        const int nig = WGM * nN, gid = wgid / nig, fm = gid * WGM, gsz = (nM - fm) < WGM ? (nM - fm) : WGM;
        u.pm = fm + ((wgid % nig) % gsz); u.pn = (wgid % nig) / gsz; return true;
    }
};

struct EpiZ {
    static constexpr bool PERM = true;
    bf16_t* O; int ldc;
    __device__ __forceinline__ void operator()(const f32x4 (&acc)[2][2][4][2], const Unit& u, int wr, int wc, int fr, int fq) const {
        const int row0 = u.pm * BM + wr * 64 + fr, col0 = u.pn * BM + wc * 32 + 8 * fq;
#pragma unroll
        for (int ai = 0; ai < 2; ++ai)
#pragma unroll
            for (int m = 0; m < 4; ++m) { bf16_t* rowp = O + (size_t)(row0 + ai * HALF + m * 16) * ldc + col0;
#pragma unroll
                for (int bj = 0; bj < 2; ++bj) { const f32x4 v0 = acc[ai][bj][m][0], v1 = acc[ai][bj][m][1];
                    u32x4 w; w.x = cvt_pk_bf16(v0[0], v0[1]); w.y = cvt_pk_bf16(v0[2], v0[3]); w.z = cvt_pk_bf16(v1[0], v1[1]); w.w = cvt_pk_bf16(v1[2], v1[3]);
                    *(u32x4*)(rowp + bj * HALF) = w; } }
    }
};
struct EpiOut {
    static constexpr bool PERM = true;
    const float* xp; const float* xs; float* out; bf16_t* Z; float* rowsq;
    __device__ __forceinline__ void operator()(const f32x4 (&acc)[2][2][4][2], const Unit& u, int wr, int wc, int fr, int fq) const {
        const int col0 = u.pn * BM + wc * 32 + 8 * fq;
#pragma unroll
        for (int ai = 0; ai < 2; ++ai)
#pragma unroll
            for (int m = 0; m < 4; ++m) { const int r = u.pm * BM + ai * HALF + wr * 64 + m * 16 + fr;
                const float* xr = (r < SP ? xp + (size_t)r * DM : xs + (size_t)(r - SP) * DM) + col0; float* orow = out + (size_t)r * DM + col0; bf16_t* zr = Z + (size_t)r * ZP + ZXN2 + col0;
                float ss = 0.f;
#pragma unroll
                for (int bj = 0; bj < 2; ++bj) { const f32x4 x0 = *(const f32x4*)(xr + bj * HALF), x1 = *(const f32x4*)(xr + bj * HALF + 4);
                    const f32x4 o0 = x0 + acc[ai][bj][m][0], o1 = x1 + acc[ai][bj][m][1];
                    *(f32x4*)(orow + bj * HALF) = o0; *(f32x4*)(orow + bj * HALF + 4) = o1;
                    ss += ((o0[0] * o0[0] + o0[1] * o0[1]) + (o0[2] * o0[2] + o0[3] * o0[3])) + ((o1[0] * o1[0] + o1[1] * o1[1]) + (o1[2] * o1[2] + o1[3] * o1[3]));
                    u32x4 w; w.x = cvt_pk_bf16(o0[0], o0[1]); w.y = cvt_pk_bf16(o0[2], o0[3]); w.z = cvt_pk_bf16(o1[0], o1[1]); w.w = cvt_pk_bf16(o1[2], o1[3]); *(u32x4*)(zr + bj * HALF) = w; }
                ss += __shfl_xor(ss, 16); ss += __shfl_xor(ss, 32);
                if (fq == 0) rowsq[(size_t)r * 16 + u.pn * 4 + wc] = ss;
                if (m & 1) asm volatile("" ::: "memory"); }
    }
};
struct EpiUp {
    static constexpr bool PERM = true;
    char* H; const float* rowsq; int row_off;
    __device__ __forceinline__ void operator()(const f32x4 (&acc)[2][2][4][2], const Unit& u, int wr, int wc, int fr, int fq) const {
        const int row0 = u.pm * BM + wr * 64 + fr, col0 = u.pn * BM + wc * 32 + 8 * fq;
#pragma unroll
        for (int ai = 0; ai < 2; ++ai)
#pragma unroll
            for (int m = 0; m < 4; ++m) { const int r = row0 + ai * HALF + m * 16; const f32x4* rq = (const f32x4*)(rowsq + (size_t)(row_off + r) * 16);
                const f32x4 q0 = rq[0], q1 = rq[1], q2 = rq[2], q3 = rq[3];
                const float ssum = ((q0[0] + q0[1]) + (q0[2] + q0[3])) + ((q1[0] + q1[1]) + (q1[2] + q1[3])) + ((q2[0] + q2[1]) + (q2[2] + q2[3])) + ((q3[0] + q3[1]) + (q3[2] + q3[3]));
                const float rstd = __builtin_amdgcn_rsqf(ssum * (1.0f / DM) + NORM_EPS);
                char* rowp = H + (size_t)r * 13312;
#pragma unroll
                for (int bj = 0; bj < 2; ++bj) { const int c = col0 + bj * HALF; f32x4 v0 = acc[ai][bj][m][0] * rstd, v1 = acc[ai][bj][m][1] * rstd;
#pragma unroll
                    for (int e = 0; e < 4; ++e) { const float a = fmaxf(v0[e], 0.f), b = fmaxf(v1[e], 0.f); v0[e] = a * a; v1[e] = b * b; }
                    u32x4 w; w.x = cvt_pk_bf16(v0[0], v0[1]); w.y = cvt_pk_bf16(v0[2], v0[3]); w.z = cvt_pk_bf16(v1[0], v1[1]); w.w = cvt_pk_bf16(v1[2], v1[3]);
                    *(u32x4*)(rowp + (size_t)c * 2 + (c >= 2048 ? 2560 : 0)) = w; } }
    }
};
struct EpiDown {
    static constexpr bool PERM = true;
    float* out; int row_off;
    __device__ __forceinline__ void operator()(const f32x4 (&acc)[2][2][4][2], const Unit& u, int wr, int wc, int fr, int fq) const {
        const int col0 = u.pn * BM + wc * 32 + 8 * fq;
#pragma unroll
        for (int ai = 0; ai < 2; ++ai)
#pragma unroll
            for (int m = 0; m < 4; ++m) { const int r = row_off + u.pm * BM + ai * HALF + wr * 64 + m * 16 + fr; float* orow = out + (size_t)r * DM + col0;
#pragma unroll
                for (int bj = 0; bj < 2; ++bj) { const f32x4 x0 = *(const f32x4*)(orow + bj * HALF), x1 = *(const f32x4*)(orow + bj * HALF + 4);
                    *(f32x4*)(orow + bj * HALF) = x0 + acc[ai][bj][m][0]; *(f32x4*)(orow + bj * HALF + 4) = x1 + acc[ai][bj][m][1]; }
                if (m & 1) asm volatile("" ::: "memory"); }
    }
};

template <class Epi, class Sched, bool ALIGN_EPI>
__device__ __forceinline__ void gemm_phase(LAS unsigned char* lds, const Gemm g, const Sched& S, const Epi& E) {
    int tid_ = threadIdx.x; asm volatile("" : "+v"(tid_));
    const int tid = tid_, wid = __builtin_amdgcn_readfirstlane(tid >> 6), lane = tid & 63, wr = wid >> 2, wc = wid & 3, fr = lane & 15, fq = lane >> 4;
    const int K = g.K, nt = K / BK;
    unsigned voffA[2], voffB[2];
#pragma unroll
    for (int i = 0; i < 2; ++i) { int R, C; stage_rc(tid * 16 + i * 8192, R, C); const int Rb = Epi::PERM ? ((R & ~31) + perm32(R & 31)) : R;
        voffA[i] = (unsigned)(R * g.lda + C * 2); voffB[i] = (unsigned)(Rb * K + C) * 2u; }
    const size_t kstep = (size_t)(BK * 2);
    const size_t hstepA = (size_t)HALF * g.lda, tstepA = 2 * hstepA;
    const size_t hstepB = (size_t)HALF * K * 2, tstepB = 2 * hstepB;
    const unsigned ldsw = (unsigned)wid * 1024u;
    const int aoff = lds_byte(wr * 64 + fr, fq * 8), boff = lds_byte(wc * 32 + fr, fq * 8);
#define PG8_AOFF(kt) ((size_t)(kt) * kstep + ((kt) >= g.jkt ? (size_t)g.jbytes : (size_t)0))
#define PG8_SA(b, h) (((b) * 2 + (h)) * HTB)
#define PG8_SB(b, h) ((4 + (b) * 2 + (h)) * HTB)
#define PG8_STAGE(bufoff, gbase, voff) do { _Pragma("unroll") for (int _i = 0; _i < 2; ++_i) \
        __builtin_amdgcn_global_load_lds((const unsigned*)((const char*)(gbase) + (voff)[_i]), (LAS unsigned*)(lds + (bufoff) + ldsw + _i * 8192), 16, 0, 0); } while (0)
#define PG8_LDA(dst, b, h) do { _Pragma("unroll") for (int m = 0; m < 4; ++m) _Pragma("unroll") for (int k = 0; k < 2; ++k) dst[m][k] = *(const LAS bf16x8*)(lds + PG8_SA(b, h) + aoff + m * 2048 + k * 1024); } while (0)
#define PG8_LDB(dst, b, h) do { _Pragma("unroll") for (int n = 0; n < 2; ++n) _Pragma("unroll") for (int k = 0; k < 2; ++k) dst[n][k] = *(const LAS bf16x8*)(lds + PG8_SB(b, h) + boff + n * 2048 + k * 1024); } while (0)
#define PG8_MMA(ai, bj, At, Bt) do { __builtin_amdgcn_s_setprio(1); _Pragma("unroll") for (int m = 0; m < 4; ++m) _Pragma("unroll") for (int n = 0; n < 2; ++n) _Pragma("unroll") for (int k = 0; k < 2; ++k) \
        acc[ai][bj][m][n] = __builtin_amdgcn_mfma_f32_16x16x32_bf16(Bt[n][k], At[m][k], acc[ai][bj][m][n], 0, 0, 0); __builtin_amdgcn_s_setprio(0); } while (0)
#define PG8_WAIT_V(n) asm volatile("s_waitcnt vmcnt(" #n ")" ::: "memory")
#define PG8_WAIT_L(n) asm volatile("s_waitcnt lgkmcnt(" #n ")" ::: "memory")
#define PG8_BAR __builtin_amdgcn_s_barrier()
#define PG8_SCHED __builtin_amdgcn_sched_barrier(0)
    Unit cur, nxt; int ui = 0;
    if (!S.next(0, cur)) return;
    f32x4 acc[2][2][4][2];
#pragma unroll
    for (int a = 0; a < 2; ++a)
#pragma unroll
        for (int b = 0; b < 2; ++b)
#pragma unroll
            for (int m = 0; m < 4; ++m)
#pragma unroll
                for (int n = 0; n < 2; ++n) acc[a][b][m][n] = (f32x4){0.f, 0.f, 0.f, 0.f};
    bf16x8 At[4][2], B0[2][2], B1[2][2];
    const char* cA = g.A + (size_t)cur.pm * tstepA; const char* cB = (const char*)g.Bt + (size_t)cur.pn * tstepB;
    {
        PG8_STAGE(PG8_SB(0, 0), cB, voffB); PG8_STAGE(PG8_SB(0, 1), cB + hstepB, voffB); PG8_STAGE(PG8_SA(0, 0), cA + PG8_AOFF(0), voffA); PG8_STAGE(PG8_SA(0, 1), cA + hstepA + PG8_AOFF(0), voffA);
        if (wr == 1) PG8_BAR;
        PG8_WAIT_V(2); PG8_BAR;
        PG8_STAGE(PG8_SB(1, 0), cB + kstep, voffB); PG8_STAGE(PG8_SA(1, 0), cA + PG8_AOFF(1), voffA); PG8_STAGE(PG8_SB(1, 1), cB + hstepB + kstep, voffB);
        PG8_WAIT_V(6); PG8_BAR;
    }
    for (;;) {
        const bool has_next = S.next(ui + 1, nxt);
        const char* nA = has_next ? g.A + (size_t)nxt.pm * tstepA : cA; const char* nB = has_next ? (const char*)g.Bt + (size_t)nxt.pn * tstepB : cB;
        for (int t = 0; t < nt; t += 2) {
            const bool last = (t == nt - 2);
            const char* a1 = cA + PG8_AOFF(t + 1);
            const char* a2 = last ? nA + PG8_AOFF(0) : cA + PG8_AOFF(t + 2); const char* b2 = last ? nB : cB + (size_t)(t + 2) * kstep;
            const char* a3 = last ? nA + PG8_AOFF(1) : cA + PG8_AOFF(t + 3); const char* b3 = b2 + kstep;
            PG8_LDB(B0, 0, 0); PG8_LDB(B1, 0, 1); PG8_SCHED; PG8_LDA(At, 0, 0); PG8_STAGE(PG8_SA(1, 1), a1 + hstepA, voffA);
            PG8_WAIT_V(8); PG8_WAIT_L(0); PG8_BAR; PG8_MMA(0, 0, At, B0); PG8_MMA(0, 1, At, B1); PG8_BAR; PG8_SCHED;
            PG8_LDA(At, 0, 1); PG8_STAGE(PG8_SB(0, 0), b2, voffB); PG8_STAGE(PG8_SB(0, 1), b2 + hstepB, voffB); PG8_STAGE(PG8_SA(0, 0), a2, voffA);
            PG8_WAIT_V(8); PG8_WAIT_L(0); PG8_BAR; PG8_MMA(1, 0, At, B0); PG8_MMA(1, 1, At, B1); PG8_BAR; PG8_SCHED;
            PG8_LDB(B0, 1, 0); PG8_LDB(B1, 1, 1); PG8_SCHED; PG8_LDA(At, 1, 0); PG8_STAGE(PG8_SA(0, 1), a2 + hstepA, voffA);
            PG8_WAIT_V(8); PG8_WAIT_L(0); PG8_BAR; PG8_MMA(0, 0, At, B0); PG8_MMA(0, 1, At, B1); PG8_BAR; PG8_SCHED;
            PG8_LDA(At, 1, 1); PG8_STAGE(PG8_SB(1, 0), b3, voffB); PG8_STAGE(PG8_SB(1, 1), b3 + hstepB, voffB); PG8_STAGE(PG8_SA(1, 0), a3, voffA);
            PG8_WAIT_V(8); PG8_WAIT_L(0); PG8_BAR; PG8_MMA(1, 0, At, B0); PG8_MMA(1, 1, At, B1); PG8_BAR; PG8_SCHED;
        }
        if constexpr (ALIGN_EPI) { if (wr == 0) PG8_BAR; }
        E(acc, cur, wr, wc, fr, fq);
        if (!has_next) break;
#pragma unroll
        for (int a = 0; a < 2; ++a)
#pragma unroll
            for (int b = 0; b < 2; ++b)
#pragma unroll
                for (int m = 0; m < 4; ++m)
#pragma unroll
                    for (int n = 0; n < 2; ++n) acc[a][b][m][n] = (f32x4){0.f, 0.f, 0.f, 0.f};
        cur = nxt; cA = nA; cB = nB; ++ui;
        if constexpr (ALIGN_EPI) { if (wr == 1) PG8_BAR; }
    }
    PG8_WAIT_V(0);
    if constexpr (!ALIGN_EPI) { if (wr == 0) PG8_BAR; }
    PG8_BAR;
#undef PG8_AOFF
#undef PG8_SA
#undef PG8_SB
#undef PG8_STAGE
#undef PG8_LDA
#undef PG8_LDB
#undef PG8_MMA
#undef PG8_WAIT_V
#undef PG8_WAIT_L
#undef PG8_BAR
#undef PG8_SCHED
}
}

constexpr int NWAVES = 8, NTHR = 512;
constexpr int LDS_BYTES = 163840;
struct Args {
    const float* in[27]; float* out; unsigned char* ws; int ph_lo, ph_hi;
};
struct Frame {
    LAS unsigned char* lds; int tid, lane, wave, vcu, G;
};
constexpr int PTRS_OFF = LDS_BYTES - 256;
__device__ __forceinline__ const float* inp(LAS unsigned char* lds, int i) { return *(const float* LAS*)(lds + PTRS_OFF + i * 8); }
__device__ __forceinline__ float gld(const float* p) { return *(const GAS float*)p; }
__device__ __forceinline__ int seq_row0(int q) { return q == 0 ? 0 : SP + (q - 1) * SS; }
__device__ __forceinline__ int seq_len(int q) { return q == 0 ? SP : SS; }

__device__ __forceinline__ void p0_transpose_item(const float* W, int K, int N, bf16_t* WT, const float* kscale, LAS float* scr, int item, int lane) {
    const int nblk = N / 32, kb = item / nblk, nb = item % nblk, k0 = 64 * kb, n0 = 32 * nb;
#pragma unroll 8
    for (int i = 0; i < 32; ++i) { const int kk = 2 * i + (lane >> 5); float v = W[(size_t)(k0 + kk) * N + n0 + (lane & 31)]; if (kscale) v *= kscale[k0 + kk]; scr[kk * 33 + (lane & 31)] = v; }
    LDS_WAIT(); asm volatile("" ::: "memory");
    const int c = lane & 7;
#pragma unroll
    for (int j = 0; j < 4; ++j) { const int n = (lane >> 3) + 8 * j; const LAS float* s = scr + (8 * c) * 33 + n;
        u32x4 o; o.x = cvt_pk_bf16(s[0 * 33], s[1 * 33]); o.y = cvt_pk_bf16(s[2 * 33], s[3 * 33]); o.z = cvt_pk_bf16(s[4 * 33], s[5 * 33]); o.w = cvt_pk_bf16(s[6 * 33], s[7 * 33]);
        *(u32x4*)(WT + (size_t)(n0 + n) * K + k0 + 8 * c) = o; }
    LDS_WAIT(); asm volatile("" ::: "memory");
}
__device__ __forceinline__ void p0_prologue(const Frame& F, const Args& a) {
    LAS float* scr = (LAS float*)(F.lds + F.wave * 16384);
    const int gw = F.vcu * NWAVES + F.wave, NGW = F.G * NWAVES;
    unsigned char* ws = a.ws;
    constexpr int I_IN = (DM / 64) * (ZP / 32), I_O = (DM / 64) * (DM / 32), I_1 = (DM / 64) * (DFF / 32), I_2 = (DFF / 64) * (DM / 32);
    for (int it = gw; it < I_IN + I_O + I_1 + I_2; it += NGW) {
        int r = it;
        if (r < I_IN) { p0_transpose_item(a.in[3], DM, ZP, (bf16_t*)(ws + WS_WIN), nullptr, scr, r, F.lane); continue; } r -= I_IN;
        if (r < I_O) { p0_transpose_item(a.in[23], DM, DM, (bf16_t*)(ws + WS_WOUT), nullptr, scr, r, F.lane); continue; } r -= I_O;
        if (r < I_1) { p0_transpose_item(a.in[25], DM, DFF, (bf16_t*)(ws + WS_W1), a.in[24], scr, r, F.lane); continue; } r -= I_1;
        p0_transpose_item(a.in[26], DFF, DM, (bf16_t*)(ws + WS_W2), nullptr, scr, r, F.lane);
    }
    bf16_t* XN = (bf16_t*)a.out; const float* g1 = a.in[2];
    for (int m = gw; m < MTOK; m += NGW) {
        const float* xrow = m < SP ? a.in[0] + (size_t)m * DM : a.in[1] + (size_t)(m - SP) * DM;
        const f32x4* xr = (const f32x4*)xrow + F.lane; f32x4 v[4]; float s = 0.f;
#pragma unroll
        for (int j = 0; j < 4; ++j) { v[j] = xr[64 * j]; s += (v[j][0] * v[j][0] + v[j][1] * v[j][1]) + (v[j][2] * v[j][2] + v[j][3] * v[j][3]); }
        const float rstd = 1.0f / sqrtf(wave_sum(s) * (1.f / DM) + NORM_EPS);
        u32x2* o8 = (u32x2*)(XN + (size_t)m * DM) + F.lane;
#pragma unroll
        for (int j = 0; j < 4; ++j) { const f32x4 gv = ((const f32x4*)g1)[F.lane + 64 * j]; u32x2 w; w.x = cvt_pk_bf16(v[j][0] * rstd * gv[0], v[j][1] * rstd * gv[1]); w.y = cvt_pk_bf16(v[j][2] * rstd * gv[2], v[j][3] * rstd * gv[3]); o8[64 * j] = w; }
    }
    const int gt = F.vcu * NTHR + F.tid, NGT = F.G * NTHR;
    float* rope = (float*)(ws + WS_ROPE);
    for (int e = gt; e < SP * 32; e += NGT) { const int pos = e >> 5, i = e & 31;
        const float invf = 1.0f / powf(10000.0f, (float)(2 * i) / 64.0f); const float ang = (float)pos * invf; float sn, cs; sincosf(ang, &sn, &cs);
        rope[2 * e] = cs; rope[2 * e + 1] = sn; }
    bf16_t* wupT = (bf16_t*)(ws + WS_LORA); bf16_t* aupT = wupT + 2 * 512 * 64; bf16_t* gupT = aupT + 2 * 512 * 64;
    for (int e = gt; e < 2 * 512 * 64; e += NGT) { const int d = e >> 15, c = (e >> 6) & 511, r = e & 63;
        wupT[e] = f2bf(a.in[14][((size_t)d * 64 + r) * 512 + c]); aupT[e] = f2bf(a.in[16][((size_t)d * 64 + r) * 512 + c]); }
    for (int e = gt; e < 512 * 128; e += NGT) { const int c = e >> 7, r = e & 127; gupT[e] = f2bf(a.in[17][(size_t)r * 512 + c]); }
}

__device__ __forceinline__ void qk_prep(const Frame& F, const Args& a) {
    const int gw = F.vcu * NWAVES + F.wave, NGW = F.G * NWAVES;
    bf16_t* Z = (bf16_t*)(a.ws + WS_Z); const float* rope = (const float*)(a.ws + WS_ROPE);
    const int g = F.lane >> 2, qd = F.lane & 3;
    const float* gain = (g < 8) ? a.in[4] : a.in[5];
    float glo[8], ghi[8];
#pragma unroll
    for (int j = 0; j < 8; ++j) { glo[j] = gain[8 * qd + j]; ghi[j] = gain[32 + 8 * qd + j]; }
    const float osc = (g < 8) ? QSCALE : 1.0f;
    const float mpw = a.in[11][ZWD - ZRR + F.lane], mnw = a.in[12][ZWD - ZRR + F.lane], mpa = a.in[11][ZAD - ZRR + F.lane], mna = a.in[12][ZAD - ZRR + F.lane];
    for (int blk = gw; blk < MTOK / 16; blk += NGW) {
        const int m0 = blk * 16;
        const int pos0 = m0 < SP ? m0 : ((m0 - SP) & (SS - 1)); const int S = m0 < SP ? SP : SS;
        {
            float zw[18], za[18]; const bf16_t* zr = Z + (size_t)m0 * ZP; const int j = F.lane;
#pragma unroll
            for (int i = 0; i < 18; ++i) { const int pp = pos0 - 1 + i; const bool ok = pp >= 0 && pp < S; const long ro = (long)(ok ? i - 1 : 0) * ZP;
                const float w_ = bf2f(zr[ro + ZWD + j]), a_ = bf2f(zr[ro + ZAD + j]); zw[i] = ok ? w_ : 0.f; za[i] = ok ? a_ : 0.f; }
            bf16_t* e1 = (bf16_t*)(a.ws + WS_E1) + (size_t)m0 * 128;
#pragma unroll
            for (int i = 0; i < 16; ++i) { const float wc = zw[i + 1], ac = za[i + 1];
                const float ws_ = wc + mpw * (zw[i] - wc) + mnw * (zw[i + 2] - wc), as_ = ac + mpa * (za[i] - ac) + mna * (za[i + 2] - ac);
                e1[i * 128 + j] = f2bf(1.0f - 2.0f * __builtin_amdgcn_rcpf(__expf(2.0f * ws_) + 1.0f)); e1[i * 128 + 64 + j] = f2bf(as_); }
        }
#pragma unroll 4
        for (int i = 0; i < 16; ++i) {
            const int m = m0 + i, pos = pos0 + i;
            bf16_t* p = Z + (size_t)m * ZP + g * 64 + 8 * qd;
            const u32x4 lo4 = *(const u32x4*)p, hi4 = *(const u32x4*)(p + 32);
            float lo[8], hi[8];
#pragma unroll
            for (int j = 0; j < 4; ++j) { lo[2 * j] = bflo(lo4[j]); lo[2 * j + 1] = bfhi(lo4[j]); hi[2 * j] = bflo(hi4[j]); hi[2 * j + 1] = bfhi(hi4[j]); }
            float ss = 0.f;
#pragma unroll
            for (int j = 0; j < 8; ++j) ss += lo[j] * lo[j] + hi[j] * hi[j];
            ss += __shfl_xor(ss, 1); ss += __shfl_xor(ss, 2);
            const float rstd = __builtin_amdgcn_rsqf(ss * (1.f / 64.f) + NORM_EPS);
            const f32x4* rp = (const f32x4*)(rope + ((size_t)pos * 32 + 8 * qd) * 2);
            float ol[8], oh[8];
#pragma unroll
            for (int j2 = 0; j2 < 4; ++j2) { const f32x4 cs = rp[j2];
#pragma unroll
                for (int e = 0; e < 2; ++e) { const int j = 2 * j2 + e; const float c = cs[2 * e], sn = cs[2 * e + 1]; const float l = lo[j] * rstd * glo[j], h = hi[j] * rstd * ghi[j];
                    ol[j] = (l * c - h * sn) * osc; oh[j] = (h * c + l * sn) * osc; } }
            u32x4 wl, wh;
#pragma unroll
            for (int j = 0; j < 4; ++j) { wl[j] = cvt_pk_bf16(ol[2 * j], ol[2 * j + 1]); wh[j] = cvt_pk_bf16(oh[2 * j], oh[2 * j + 1]); }
            *(u32x4*)p = wl; *(u32x4*)(p + 32) = wh;
        }
    }
}

namespace att {
constexpr int KSLOT = 8192, VSLOT = 16384, NKS = 4, NVS = 3;
constexpr int L_K = 0, L_V = NKS * KSLOT, L_WS = L_V + NVS * VSLOT, L_ST = L_WS + NWAVES * 256, L_END = L_ST + NWAVES * 8192;
static_assert(L_END <= PTRS_OFF, "attention lds");
__device__ __forceinline__ int crow(int r, int hi) { return (r & 3) + 8 * (r >> 2) + 4 * hi; }
__device__ __forceinline__ void glds16(const void* gsrc, unsigned lds_dst) { unsigned keep;
    asm volatile("s_mov_b32 %0, m0\n\ts_mov_b32 m0, %2\n\ts_nop 0\n\tglobal_load_lds_dwordx4 %1, off\n\ts_mov_b32 m0, %0" : "=&s"(keep) : "v"(gsrc), "s"(lds_dst) : "memory"); }
typedef short v4i16_t __attribute__((ext_vector_type(4)));
typedef const LAS char* lds_cptr;
__device__ __forceinline__ s16x4 vtr(lds_cptr p) { return __builtin_bit_cast(s16x4, __builtin_amdgcn_ds_read_tr16_b64_v4i16((LAS v4i16_t*)p)); }
#define SBAR() __builtin_amdgcn_sched_barrier(0)
#define WAIT_BAR(N) asm volatile("s_waitcnt vmcnt(" #N ") lgkmcnt(0)\n\ts_barrier" ::: "memory")
__device__ __forceinline__ void kload8(bf16x8* kf, lds_cptr kp) {
    kf[0] = *(const LAS bf16x8*)(kp);        kf[1] = *(const LAS bf16x8*)(kp + 512);
    kf[2] = *(const LAS bf16x8*)(kp + 2048); kf[3] = *(const LAS bf16x8*)(kp + 2560);
    kf[4] = *(const LAS bf16x8*)(kp + 4096); kf[5] = *(const LAS bf16x8*)(kp + 4608);
    kf[6] = *(const LAS bf16x8*)(kp + 6144); kf[7] = *(const LAS bf16x8*)(kp + 6656);
}
__device__ __forceinline__ void kload2(bf16x8* kf, lds_cptr kp, int j) { kf[2 * j] = *(const LAS bf16x8*)(kp + j * 2048); kf[2 * j + 1] = *(const LAS bf16x8*)(kp + j * 2048 + 512); }

__device__ __forceinline__ void attn_unit(int row0, int S, int h, int qb, bf16_t* Z, LAS unsigned char* shm, float lam, const float* subln_g, bf16_t* Ob, int opitch) {
    int tid_ = threadIdx.x; asm volatile("" : "+v"(tid_));
    const int tid = tid_, lane = tid & 63, r32 = lane & 31, hi = lane >> 5; const int wid = __builtin_amdgcn_readfirstlane(tid >> 6);
    const unsigned lds0 = (unsigned)(uintptr_t)shm;
    LAS float* wsf = (LAS float*)(shm + L_WS) + wid * 64;
    LAS bf16_t* stash = (LAS bf16_t*)(shm + L_ST) + wid * 4096;
    const int NT = S / 64;
    const size_t qrow = (size_t)(row0 + qb * 256 + wid * 32);
    const lds_cptr shm3 = (lds_cptr)shm;
    const lds_cptr kp0 = shm3 + L_K + hi * 1024 + r32 * 16;
    const lds_cptr vp0 = shm3 + L_V + ((lane >> 4) & 1) * 32 + (lane & 3) * 8 + (4 * hi + ((lane & 15) >> 2)) * 64;
    f32x16 o[4];
#pragma unroll 1
    for (int c = 0; c < 2; ++c) {
        const bf16_t* Qw = Z + qrow * ZP + ZQ + h * 128 + c * 64;
        const bf16_t* Kh = Z + (size_t)row0 * ZP + ZK + h * 128 + c * 64;
        const bf16_t* Vh = Z + (size_t)row0 * ZP + ZV + h * 128;
        const int p0 = 2 * wid, p1 = 2 * wid + 1;
        const unsigned koff = (unsigned)(lane * ZP + wid * 8) * 2u;
        const unsigned voff0 = (unsigned)((16 * (p0 & 3) + (lane >> 2)) * ZP + (p0 >> 2) * 32 + (lane & 3) * 8) * 2u;
        const unsigned voff1 = (unsigned)((16 * (p1 & 3) + (lane >> 2)) * ZP + (p1 >> 2) * 32 + (lane & 3) * 8) * 2u;
        const unsigned kdst = lds0 + L_K + wid * 1024, vdst0 = lds0 + L_V + p0 * 1024, vdst1 = lds0 + L_V + p1 * 1024;
#define DMA_K(t, si) glds16((const char*)(Kh + (size_t)(t) * 64 * ZP) + koff, (unsigned)__builtin_amdgcn_readfirstlane(kdst + (si) * KSLOT))
#define DMA_V(t, si) do { const char* vb_ = (const char*)(Vh + (size_t)(t) * 64 * ZP); glds16(vb_ + voff0, (unsigned)__builtin_amdgcn_readfirstlane(vdst0 + (si) * VSLOT)); glds16(vb_ + voff1, (unsigned)__builtin_amdgcn_readfirstlane(vdst1 + (si) * VSLOT)); } while (0)
        DMA_K(0, 0); DMA_V(0, 0); DMA_K(1, 1);
        bf16x8 qr[4];
#pragma unroll
        for (int d0 = 0; d0 < 4; ++d0) qr[d0] = *(const bf16x8*)(Qw + (size_t)r32 * ZP + d0 * 16 + hi * 8);
#pragma unroll
        for (int d0 = 0; d0 < 4; ++d0) o[d0] = f32x16{};
        float l_reg = 0.f;
        bf16x8 kf[4];
        f32x16 pA0, pA1, pB0, pB1;
        int i_prev = 0, i_cur = 0, i_next = 1;
        int k_cur = 0, k_next = 1;
#define ROT() do { i_prev = i_cur; i_cur = i_next; i_next = (i_next == NVS - 1) ? 0 : i_next + 1; k_cur = k_next; k_next = (k_next + 1) & 3; } while (0)
#define KFRAG(slot, i) (*(const LAS bf16x8*)(kp0 + (slot) * KSLOT + ((i) >> 1) * 2048 + ((i) & 1) * 512))
        DMA_K(2, 2);
        WAIT_BAR(4);
        {
            const lds_cptr kb = kp0;
            pA0 = f32x16{}; pA1 = f32x16{};
#pragma unroll
            for (int d0 = 0; d0 < 4; ++d0) { const bf16x8 b0 = *(const LAS bf16x8*)(kb + d0 * 2048), b1 = *(const LAS bf16x8*)(kb + d0 * 2048 + 512);
                pA0 = __builtin_amdgcn_mfma_f32_32x32x16_bf16(b0, qr[d0], pA0, 0, 0, 0); pA1 = __builtin_amdgcn_mfma_f32_32x32x16_bf16(b1, qr[d0], pA1, 0, 0, 0); }
#pragma unroll
            for (int r = 0; r < 16; ++r) { pA0[r] = __builtin_amdgcn_exp2f(pA0[r]); pA1[r] = __builtin_amdgcn_exp2f(pA1[r]); }
        }
        WAIT_BAR(0);
        DMA_K(3, 3); DMA_V(1, 1);
        ROT();
        kf[0] = KFRAG(k_cur, 0); kf[1] = KFRAG(k_cur, 1); kf[2] = KFRAG(k_cur, 2); kf[3] = KFRAG(k_cur, 3);
        WAIT_BAR(3);
        s16x4 vlo[4], vhi[4]; u32x4 pw0, pw1, pw2, pw3;
#define PKW(P, B) cvt_pk_bf16(P[B], P[B + 1])
#define PAF(k) __builtin_bit_cast(bf16x8, pw##k)
#define VFR(i) (bf16x8){vlo[i][0], vlo[i][1], vlo[i][2], vlo[i][3], vhi[i][0], vhi[i][1], vhi[i][2], vhi[i][3]}
#define PIN(x) asm volatile("" : "+v"(x))
#define EX(v) __builtin_amdgcn_exp2f(v)
#define VRD(slot, f) do { vlo[slot] = vtr(vp_ + (((f) & 3) * 4096 + ((f) >> 2) * 1024)); vhi[slot] = vtr(vp_ + (((f) & 3) * 4096 + ((f) >> 2) * 1024 + 512)); } while (0)
#define GAPA(MF, LDX, A0, A1, A2, A3, W0, W1, PW) do { MF; LDX; sacc += A0; sacc += A1; sacc += A2; sacc += A3; PIN(sacc); W0; W1; PIN(PW); SBAR(); } while (0)
#define GAPB(MF, LDX, X, B) do { MF; LDX; X[B] = EX(X[B]); X[B + 1] = EX(X[B + 1]); PIN(X); SBAR(); } while (0)
#define PVM(f) o[(f) & 3] = __builtin_amdgcn_mfma_f32_32x32x16_bf16(__builtin_bit_cast(bf16x8, (f) < 4 ? pw0 : (f) < 8 ? pw1 : (f) < 12 ? pw2 : pw3), VFR((f) & 3), o[(f) & 3], 0, 0, 0)
#define NOP_ do { } while (0)
#if PROBE_ATT
#define ATT_T(k) do { if (PROBE_ATT == (k)) { const unsigned long long n_ = __builtin_amdgcn_s_memrealtime(); if (tid == 0) *(LAS unsigned long long*)(shm + PTRS_OFF - 64) += n_ - att_t0; } } while (0)
#define ATT_T0() const unsigned long long att_t0 = __builtin_amdgcn_s_memrealtime()
#else
#define ATT_T(k) do { } while (0)
#define ATT_T0() do { } while (0)
#endif
#define STEP(C0, C1, P0, P1, t, GK, GV, GL) do { SBAR(); \
        const lds_cptr vp_ = vp0 + i_prev * VSLOT; \
        float sacc = (P0[0] + P0[1]); \
        GAPA(C0 = __builtin_amdgcn_mfma_f32_32x32x16_bf16(kf[0], qr[0], (f32x16){}, 0, 0, 0), kf[0] = KFRAG(k_cur, 4), P0[2], P0[3], P0[4], P0[5],     pw0[0] = PKW(P0, 0), pw0[1] = PKW(P0, 2), pw0); \
        GAPA(C1 = __builtin_amdgcn_mfma_f32_32x32x16_bf16(kf[1], qr[0], (f32x16){}, 0, 0, 0), kf[1] = KFRAG(k_cur, 5), P0[6], P0[7], P0[8], P0[9],     pw0[2] = PKW(P0, 4), pw0[3] = PKW(P0, 6), pw0); \
        GAPA(C0 = __builtin_amdgcn_mfma_f32_32x32x16_bf16(kf[2], qr[1], C0, 0, 0, 0),         kf[2] = KFRAG(k_cur, 6), P0[10], P0[11], P0[12], P0[13], pw1[0] = PKW(P0, 8), pw1[1] = PKW(P0, 10), pw1); \
        GAPA(C1 = __builtin_amdgcn_mfma_f32_32x32x16_bf16(kf[3], qr[1], C1, 0, 0, 0),         kf[3] = KFRAG(k_cur, 7), P0[14], P0[15], P1[0], P1[1],   pw1[2] = PKW(P0, 12), pw1[3] = PKW(P0, 14), pw1); \
        GAPA(C0 = __builtin_amdgcn_mfma_f32_32x32x16_bf16(kf[0], qr[2], C0, 0, 0, 0),         VRD(0, 0), P1[2], P1[3], P1[4], P1[5],     pw2[0] = PKW(P1, 0), pw2[1] = PKW(P1, 2), pw2); \
        GAPA(C1 = __builtin_amdgcn_mfma_f32_32x32x16_bf16(kf[1], qr[2], C1, 0, 0, 0),         VRD(1, 1), P1[6], P1[7], P1[8], P1[9],     pw2[2] = PKW(P1, 4), pw2[3] = PKW(P1, 6), pw2); \
        GAPA(C0 = __builtin_amdgcn_mfma_f32_32x32x16_bf16(kf[2], qr[3], C0, 0, 0, 0),         VRD(2, 2), P1[10], P1[11], P1[12], P1[13], pw3[0] = PKW(P1, 8), pw3[1] = PKW(P1, 10), pw3); \
        GAPA(C1 = __builtin_amdgcn_mfma_f32_32x32x16_bf16(kf[3], qr[3], C1, 0, 0, 0),         VRD(3, 3), P1[14], P1[15], 0.f, 0.f,       pw3[2] = PKW(P1, 12), pw3[3] = PKW(P1, 14), pw3); \
        l_reg += sacc; \
        if (GK) { DMA_K((t) + 3, (k_cur + 3) & 3); } if (GV) { DMA_V((t) + 1, i_next); } \
        SBAR(); \
        GAPB(PVM(0), VRD(0, 4), C0, 0);   GAPB(PVM(1), VRD(1, 5), C0, 2);   GAPB(PVM(2), VRD(2, 6), C0, 4);    GAPB(PVM(3), VRD(3, 7), C0, 6); \
        GAPB(PVM(4), VRD(0, 8), C0, 8);   GAPB(PVM(5), VRD(1, 9), C0, 10);  GAPB(PVM(6), VRD(2, 10), C0, 12);  GAPB(PVM(7), VRD(3, 11), C0, 14); \
        GAPB(PVM(8), VRD(0, 12), C1, 0);  GAPB(PVM(9), VRD(1, 13), C1, 2);  GAPB(PVM(10), VRD(2, 14), C1, 4);  GAPB(PVM(11), VRD(3, 15), C1, 6); \
        GAPB(PVM(12), if (GL) kf[0] = KFRAG(k_next, 0), C1, 8);  GAPB(PVM(13), if (GL) kf[1] = KFRAG(k_next, 1), C1, 10); \
        GAPB(PVM(14), if (GL) kf[2] = KFRAG(k_next, 2), C1, 12); GAPB(PVM(15), if (GL) kf[3] = KFRAG(k_next, 3), C1, 14); \
        } while (0)
        int t = 1;
#pragma unroll 1
        for (; t + 5 < NT; t += 2) {
#if PROBE_ATT == 1
            STEP(pB0, pB1, pA0, pA1, t, true, true, true);     { ATT_T0(); WAIT_BAR(3); ATT_T(1); } ROT();
            STEP(pA0, pA1, pB0, pB1, t + 1, true, true, true); { ATT_T0(); WAIT_BAR(3); ATT_T(1); } ROT();
#elif PROBE_ATT >= 2
            { ATT_T0(); STEP(pB0, pB1, pA0, pA1, t, true, true, true); ATT_T(2); }    WAIT_BAR(3); ROT();
            { ATT_T0(); STEP(pA0, pA1, pB0, pB1, t + 1, true, true, true); ATT_T(2); } WAIT_BAR(3); ROT();
#else
            STEP(pB0, pB1, pA0, pA1, t, true, true, true);     WAIT_BAR(3); ROT();
            STEP(pA0, pA1, pB0, pB1, t + 1, true, true, true); WAIT_BAR(3); ROT();
#endif
        }
#define ENDW(tt) do { if ((tt) + 3 < NT) { WAIT_BAR(3); } else if ((tt) + 2 < NT) { WAIT_BAR(2); } else { WAIT_BAR(0); } } while (0)
#pragma unroll 1
        for (; t + 1 < NT; t += 2) {
            STEP(pB0, pB1, pA0, pA1, t, (t + 3 < NT), (t + 1 < NT), (t + 1 < NT));         ENDW(t);     ROT();
            STEP(pA0, pA1, pB0, pB1, t + 1, (t + 4 < NT), (t + 2 < NT), (t + 2 < NT));     ENDW(t + 1); ROT();
        }
        STEP(pB0, pB1, pA0, pA1, NT - 1, false, false, false);
        {
            float sacc = pB0[0] + pB0[1];
#pragma unroll
            for (int r = 2; r < 16; ++r) sacc += pB0[r];
#pragma unroll
            for (int r = 0; r < 16; ++r) sacc += pB1[r];
            l_reg += sacc;
            pw0 = (u32x4){PKW(pB0, 0), PKW(pB0, 2), PKW(pB0, 4), PKW(pB0, 6)}; pw1 = (u32x4){PKW(pB0, 8), PKW(pB0, 10), PKW(pB0, 12), PKW(pB0, 14)};
            pw2 = (u32x4){PKW(pB1, 0), PKW(pB1, 2), PKW(pB1, 4), PKW(pB1, 6)}; pw3 = (u32x4){PKW(pB1, 8), PKW(pB1, 10), PKW(pB1, 12), PKW(pB1, 14)};
            const lds_cptr vp_ = vp0 + i_cur * VSLOT;
            VRD(0, 0); VRD(1, 1); VRD(2, 2); VRD(3, 3); PVM(0); PVM(1); PVM(2); PVM(3);
            VRD(0, 4); VRD(1, 5); VRD(2, 6); VRD(3, 7); PVM(4); PVM(5); PVM(6); PVM(7);
            VRD(0, 8); VRD(1, 9); VRD(2, 10); VRD(3, 11); PVM(8); PVM(9); PVM(10); PVM(11);
            VRD(0, 12); VRD(1, 13); VRD(2, 14); VRD(3, 15); PVM(12); PVM(13); PVM(14); PVM(15);
        }
#undef DMA_K
#undef DMA_V
#undef ROT
#undef PKW
#undef PAF
#undef VFR
#undef PIN
#undef EX
#undef VRD
#undef GAPA
#undef GAPB
#undef KFRAG
#undef NOP_
#undef PVM
#undef STEP
#undef ENDW
        { auto rr = __builtin_amdgcn_permlane32_swap(__float_as_uint(l_reg), __float_as_uint(l_reg), false, false); l_reg = __uint_as_float(rr[0]) + __uint_as_float(rr[1]); }
        if (hi == 0) wsf[r32] = l_reg;
        LDS_WAIT();
        float rli[16];
#pragma unroll
        for (int r = 0; r < 16; ++r) rli[r] = 1.0f / wsf[crow(r, hi)];
        if (c == 0) {
#pragma unroll
            for (int d0 = 0; d0 < 4; ++d0)
#pragma unroll
                for (int r = 0; r < 16; ++r) stash[(d0 * 16 + r) * 64 + lane] = f2bf(o[d0][r] * rli[r]);
            LDS_WAIT();
        } else {
#pragma unroll
            for (int d0 = 0; d0 < 4; ++d0)
#pragma unroll
                for (int r = 0; r < 16; ++r) o[d0][r] = bf2f(stash[(d0 * 16 + r) * 64 + lane]) - lam * (o[d0][r] * rli[r]);
            LDS_WAIT(); asm volatile("" ::: "memory");
#pragma unroll
            for (int d0 = 0; d0 < 4; ++d0)
#pragma unroll
                for (int r = 0; r < 16; ++r) stash[crow(r, hi) * 128 + d0 * 32 + r32] = f2bf(o[d0][r]);
            LDS_WAIT(); asm volatile("" ::: "memory");
            bf16_t* Ow = Ob + qrow * opitch + ZQ + h * 128;
#pragma unroll
            for (int i = 0; i < 4; ++i) { const int row = i * 8 + (lane >> 3), ch = lane & 7;
                const u32x4 w0 = *(const LAS u32x4*)(stash + row * 128 + ch * 16), w1 = *(const LAS u32x4*)(stash + row * 128 + ch * 16 + 8);
                float v[16];
#pragma unroll
                for (int j = 0; j < 4; ++j) { v[2 * j] = bflo(w0[j]); v[2 * j + 1] = bfhi(w0[j]); v[8 + 2 * j] = bflo(w1[j]); v[9 + 2 * j] = bfhi(w1[j]); }
                float ss = 0.f;
#pragma unroll
                for (int j = 0; j < 16; ++j) ss += v[j] * v[j];
                ss += __shfl_xor(ss, 1); ss += __shfl_xor(ss, 2); ss += __shfl_xor(ss, 4);
                const float rs = (1.0f - LAMBDA_INIT) / sqrtf(ss * (1.f / 128.f) + NORM_EPS);
                u32x4 x0, x1;
#pragma unroll
                for (int j = 0; j < 4; ++j) { x0[j] = cvt_pk_bf16(v[2 * j] * rs * subln_g[ch * 16 + 2 * j], v[2 * j + 1] * rs * subln_g[ch * 16 + 2 * j + 1]);
                                              x1[j] = cvt_pk_bf16(v[8 + 2 * j] * rs * subln_g[ch * 16 + 8 + 2 * j], v[9 + 2 * j] * rs * subln_g[ch * 16 + 9 + 2 * j]); }
                *(u32x4*)(Ow + (size_t)row * opitch + ch * 16) = x0; *(u32x4*)(Ow + (size_t)row * opitch + ch * 16 + 8) = x1; }
            LDS_WAIT();
        }
        asm volatile("s_waitcnt vmcnt(0) lgkmcnt(0)\n\ts_barrier" ::: "memory");
    }
}
#undef SBAR
#undef WAIT_BAR
}

namespace rw {
constexpr int P = 144, MAT = 64 * P;
constexpr int O_AT = 0, O_BT = MAT, O_KT = 2 * MAT, O_RT = 3 * MAT, O_ATT = 4 * MAT, O_VT = 5 * MAT, O_BHT = 6 * MAT, O_KHT = 7 * MAT;
constexpr int O_LAB = 8 * MAT, O_LAK = 9 * MAT, O_ARB = 10 * MAT, O_ARK = 11 * MAT, O_XT = 12 * MAT, O_ABT = 13 * MAT, O_U0T = 14 * MAT;
constexpr int O_LABD = 15 * MAT, O_TII = O_LABD + 4096, O_WC = O_TII + 2048, O_GSUM = O_WC + 256, O_PAR = O_GSUM + 2048, O_END = O_PAR + 960 * 4;
constexpr int O_ZS = 0, PZ = 128;
static_assert(3 * 66 * PZ <= 3 * MAT, "ZS fits At|Bt|Kt");
constexpr int O_TW = O_LAB, O_ADN = O_LAK, O_WL = O_ARB, O_AR = O_XT, PF = 272;
static_assert(O_END <= PTRS_OFF - 64 && 64 * PF <= 2 * MAT, "rwkv lds");
__device__ __forceinline__ int crow(int r, int hi) { return (r & 3) + 8 * (r >> 2) + 4 * hi; }
__device__ __forceinline__ float sigmoidf_(float x) { return __builtin_amdgcn_rcpf(1.0f + __expf(-x)); }
__device__ __forceinline__ float tanhf_(float x) { return 1.0f - 2.0f * __builtin_amdgcn_rcpf(__expf(2.0f * x) + 1.0f); }
__device__ __forceinline__ void load10(const bf16_t* zc, int t_lo, int S, float (&z)[10]) {
#pragma unroll
    for (int i = 0; i < 10; ++i) { const int t = t_lo - 1 + i; z[i] = (t >= 0 && t < S) ? bf2f(zc[(size_t)t * ZP]) : 0.f; }
}
__device__ __forceinline__ float tshift(const float (&z)[10], int u, float mp, float mn) { const float c = z[u + 1]; return c + mp * (z[u] - c) + mn * (z[u + 2] - c); }
__device__ __forceinline__ f32x16 mm_ll(const LAS unsigned char* A, int rowA, const LAS unsigned char* B, int rowB, f32x16 acc, int r32, int hi) {
#pragma unroll
    for (int ks = 0; ks < 4; ++ks) { const bf16x8 a = *(const LAS bf16x8*)(A + (rowA + r32) * P + (16 * ks + 8 * hi) * 2), b = *(const LAS bf16x8*)(B + (rowB + r32) * P + (16 * ks + 8 * hi) * 2);
        acc = __builtin_amdgcn_mfma_f32_32x32x16_bf16(a, b, acc, 0, 0, 0); }
    return acc;
}
__device__ __forceinline__ void store_native(unsigned char* dst, const f32x16& acc, int lane, bool wt) {
    u32x4 w0, w1;
#pragma unroll
    for (int q = 0; q < 4; ++q) { w0[q] = cvt_pk_bf16(acc[2 * q], acc[2 * q + 1]); w1[q] = cvt_pk_bf16(acc[8 + 2 * q], acc[9 + 2 * q]); }
    if (wt) {
        asm volatile("global_store_dwordx4 %0, %1, off sc1\n\tglobal_store_dwordx4 %0, %2, off offset:16 sc1\n\ts_nop 1" :: "v"(dst + lane * 32), "v"(w0), "v"(w1) : "memory");
    } else { *(u32x4*)(dst + lane * 32) = w0; *(u32x4*)(dst + lane * 32 + 16) = w1; }
}
__device__ __forceinline__ void st4(LAS unsigned char* p, float a, float b, float c, float d) { u32x2 w; w.x = cvt_pk_bf16(a, b); w.y = cvt_pk_bf16(c, d); *(LAS u32x2*)p = w; }

__device__ __forceinline__ f32x2_t s1_param_load(LAS unsigned char* L, int tid, int d, int h) {
    const int sg = tid >> 5, seg = sg < 15 ? sg : 14, off = (tid & 31) * 2;
    const int ti = seg < 10 ? 11 + (seg & 1) : (seg == 10 ? 13 : (seg == 11 ? 15 : 6 + seg));
    const int eo = seg < 6 ? (seg >> 1) * 512 + h * 64 : (seg < 8 ? ZWD - ZRR : (seg < 10 ? ZAD - ZRR : (seg < 12 ? d * 512 + h * 64 : h * 64)));
    const float* src = *(const float* LAS*)(L + PTRS_OFF + ti * 8) + eo + off;
    return *(const GAS f32x2_t*)src;
}
__device__ __forceinline__ void s1_stage_load(const Args& a, int tid, int q, int h, int ck, u32x4 (&v)[6]) {
    const int row0 = seq_row0(q), S = seq_len(q), t0 = ck * 64;
#pragma unroll
    for (int k = 0; k < 6; ++k) { const int c = tid + k * NTHR;
        const int seg = c >> 3, part = c & 7, row = seg / 3, grp = seg - row * 3; int t = t0 - 1 + row; t = t < 0 ? 0 : (t >= S ? S - 1 : t);
        const int e = c - 1584 < 0 ? 0 : (c - 1584 > 1023 ? 1023 : c - 1584);
        const size_t offz = WS_Z + ((size_t)(row0 + t) * ZP + ZRR + grp * 512 + h * 64 + part * 8) * 2, offe = WS_E1 + ((size_t)(row0 + t0) * 128 + (size_t)e * 8) * 2;
        v[k] = *(const GAS u32x4*)(a.ws + (c < 1584 ? offz : offe)); }
}
__device__ __forceinline__ void s1_stage_store(LAS unsigned char* L, int tid, int d, int q, int ck, const u32x4 (&stg)[6], f32x2_t par) {
    const int S = seq_len(q), t0 = ck * 64;
#pragma unroll
    for (int k = 0; k < 6; ++k) { const int c = tid + k * NTHR;
        if (c < 1584) { const int seg = c >> 3, part = c & 7, row = seg / 3, grp = seg - row * 3, t = t0 - 1 + row; const bool ok = t >= 0 && t < S;
            *(LAS u32x4*)(L + O_ZS + (grp * 66 + row) * PZ + part * 16) = ok ? stg[k] : (u32x4){0u, 0u, 0u, 0u}; }
        else if (c < 2608) { const int e = c - 1584, tr = e >> 4, part = e & 15, tau = d == 0 ? tr : 63 - tr;
            *(LAS u32x4*)(L + (part < 8 ? O_TW : O_ADN) + tau * P + (part & 7) * 16) = stg[k]; } }
    if (tid < 480) *(LAS f32x2_t*)(L + O_PAR + tid * 8) = par;
}
__device__ __forceinline__ void s1_item(const Frame& F, const Args& a, int d, int q, int h, int ck, unsigned char* slot, int nd, int nq, int nh, int nck, bool wt, unsigned* publish_prev) {
    LAS unsigned char* L = F.lds;
#if PROBE_S1 >= 0
    unsigned long long pt_last = 0; int pt_n = 0;
#define PST() do { if (F.tid == 0) { const unsigned long long n_ = __builtin_amdgcn_s_memrealtime(); if (pt_n == PROBE_S1 + 1) *(LAS unsigned long long*)(L + PTRS_OFF - 64) += n_ - pt_last; pt_last = n_; } ++pt_n; } while (0)
#else
#define PST() do { } while (0)
#endif
    PST();
    int lane_ = F.lane; asm volatile("" : "+v"(lane_));
    const int lane = lane_, w = F.wave, tid = w * 64 + lane, r32 = lane & 31, hi = lane >> 5;
    const int j = lane, tg = w;
    const int row0 = seq_row0(q), S = seq_len(q), t0 = ck * 64;
    const bf16_t* Zs = (const bf16_t*)(a.ws + WS_Z) + (size_t)row0 * ZP; (void)Zs; (void)S;
    const int t_lo = d == 0 ? t0 + 8 * tg : t0 + 56 - 8 * tg;
    const int tau0 = 8 * tg;
#define TAU(u) (d == 0 ? tau0 + (u) : tau0 + 7 - (u))
    const int ch = h * 64 + j; (void)ch;
    bf16x8 wfr[4];
    { const int which = w >> 2, mt = (w >> 1) & 1;
      const bf16_t* WT = (const bf16_t*)(a.ws + WS_LORA) + (which ? 2 * 512 * 64 : 0) + ((size_t)d * 512 + h * 64 + 32 * mt + r32) * 64;
#pragma unroll
      for (int ks = 0; ks < 4; ++ks) wfr[ks] = *(const bf16x8*)(WT + 16 * ks + 8 * hi); }
    u32x4 stg[6]; s1_stage_load(a, tid, nq, nh, nck, stg); const f32x2_t par = s1_param_load(L, tid, nd, nh);
#define PAR(seg, idx) (*(const LAS float*)(L + O_PAR + ((seg) * 64 + (idx)) * 4))
    const LAS unsigned char* zsb = L + O_ZS + (t_lo - t0) * PZ + j * 2;
#define LD10(z, g) do { _Pragma("unroll") for (int i_ = 0; i_ < 10; ++i_) z[i_] = bf2f(*(const LAS bf16_t*)(zsb + ((g) * 66 + i_) * PZ)); } while (0)
    {
        const int which = w >> 2, mt = (w >> 1) & 1, nt = w & 1;
        const LAS unsigned char* B = L + (which ? O_ADN : O_TW);
        f32x16 acc = f32x16{};
#pragma unroll
        for (int ks = 0; ks < 4; ++ks) { const bf16x8 bv = *(const LAS bf16x8*)(B + (32 * nt + r32) * P + (16 * ks + 8 * hi) * 2);
            acc = __builtin_amdgcn_mfma_f32_32x32x16_bf16(wfr[ks], bv, acc, 0, 0, 0); }
        LAS unsigned char* O = L + (which ? O_AR : O_WL) + (32 * nt + r32) * PF;
#pragma unroll
        for (int g = 0; g < 4; ++g) { const int jj = 8 * g + 4 * hi; const f32x4 bv = *(const LAS f32x4*)(L + O_PAR + ((10 + which) * 64 + 32 * mt + jj) * 4);
            *(LAS f32x4*)(O + (32 * mt + jj) * 4) = (f32x4){acc[4 * g] + bv[0], acc[4 * g + 1] + bv[1], acc[4 * g + 2] + bv[2], acc[4 * g + 3] + bv[3]}; }
    }
    LBAR(); PST();
    typedef f32x2_t v2;
    const int cp = lane & 31, th = lane >> 5;
    v2 aa2[4], bb2[4], rr2[4], kd2[4], vv2[4], ld2[4], tot4, oth;
#define EXP2V(a) ({ const v2 t_ = (a) * 1.4426950408889634f; (v2){__builtin_amdgcn_exp2f(t_.x), __builtin_amdgcn_exp2f(t_.y)}; })
#define SIG2V(a) ({ const v2 e_ = EXP2V(-(a)) + 1.0f; (v2){__builtin_amdgcn_rcpf(e_.x), __builtin_amdgcn_rcpf(e_.y)}; })
#define FOLD4(s_) ({ const bool b4_ = (lane >> 4) & 1, b3_ = (lane >> 3) & 1; float g_[2]; \
        _Pragma("unroll") for (int i_ = 0; i_ < 2; ++i_) { const float kp_ = b4_ ? s_[i_ + 2] : s_[i_], sd_ = b4_ ? s_[i_] : s_[i_ + 2]; g_[i_] = kp_ + __int_as_float(__builtin_amdgcn_ds_swizzle(__float_as_int(sd_), 0x401F)); } \
        const float kp2_ = b3_ ? g_[1] : g_[0], sd2_ = b3_ ? g_[0] : g_[1]; \
        float h_ = kp2_ + __int_as_float(__builtin_amdgcn_update_dpp(0, __float_as_int(sd2_), 0x128, 0xF, 0xF, true)); \
        h_ += __int_as_float(__builtin_amdgcn_update_dpp(0, __float_as_int(h_), 0x141, 0xF, 0xF, true)); \
        h_ += __int_as_float(__builtin_amdgcn_update_dpp(0, __float_as_int(h_), 0xB1, 0xF, 0xF, true)); \
        h_ += __int_as_float(__builtin_amdgcn_update_dpp(0, __float_as_int(h_), 0x4E, 0xF, 0xF, true)); h_; })
    {
        v2 zr[6], zk[6], zv[6];
        const LAS unsigned char* zb2 = L + O_ZS + ((t_lo - t0) + 4 * th) * PZ + cp * 4;
#define LDZ(z, g) do { _Pragma("unroll") for (int i_ = 0; i_ < 6; ++i_) { const unsigned w_ = *(const LAS unsigned*)(zb2 + ((g) * 66 + i_) * PZ); z[i_] = (v2){bflo(w_), bfhi(w_)}; } } while (0)
        LDZ(zr, 0); LDZ(zk, 1); LDZ(zv, 2);
#undef LDZ
#define PAR2(seg) (*(const LAS v2*)(L + O_PAR + ((seg) * 64 + 2 * cp) * 4))
        const v2 mpr = PAR2(0), mnr = PAR2(1), mpk = PAR2(2), mnk = PAR2(3), mpv = PAR2(4), mnv = PAR2(5), kkc = PAR2(12), kac = PAR2(13), rkc = PAR2(14);
#undef PAR2
        float* bon = (float*)(a.ws + WS_BONUS) + ((size_t)d * MTOK + row0) * 8 + h;
        v2 k02[4], ar2[4]; float red[4];
#pragma unroll
        for (int k = 0; k < 4; ++k) { const int tau = TAU(4 * th + k);
            const v2 wl = *(const LAS v2*)(L + O_WL + tau * PF + cp * 8), ar = *(const LAS v2*)(L + O_AR + tau * PF + cp * 8);
            ld2[k] = SIG2V(wl) * (-0.6065306597126334f); ar2[k] = SIG2V(ar);
            rr2[k] = zr[k + 1] + mpr * (zr[k] - zr[k + 1]) + mnr * (zr[k + 2] - zr[k + 1]);
            k02[k] = zk[k + 1] + mpk * (zk[k] - zk[k + 1]) + mnk * (zk[k + 2] - zk[k + 1]);
            vv2[k] = zv[k + 1] + mpv * (zv[k] - zv[k + 1]) + mnv * (zv[k + 2] - zv[k + 1]);
            aa2[k] = k02[k] * kkc; red[k] = aa2[k].x * aa2[k].x + aa2[k].y * aa2[k].y; }
        const int hs = __float_as_int(FOLD4(red));
        float ssq[4];
#pragma unroll
        for (int k = 0; k < 4; ++k) { const float lo_ = __int_as_float(__builtin_amdgcn_readlane(hs, 8 * k)), hi_ = __int_as_float(__builtin_amdgcn_readlane(hs, 32 + 8 * k)); ssq[k] = th ? hi_ : lo_; }
#pragma unroll
        for (int k = 0; k < 4; ++k) { const v2 kkn = aa2[k] * __builtin_amdgcn_rsqf(ssq[k] + 1e-12f);
            kd2[k] = k02[k] * ((ar2[k] - 1.0f) * kac + 1.0f); aa2[k] = -kkn; bb2[k] = kkn * ar2[k];
            const v2 bt = rr2[k] * kd2[k] * rkc; red[k] = bt.x + bt.y; }
        const float hb = FOLD4(red);
        if ((lane & 7) == 0) bon[(size_t)(t_lo + (lane >> 3)) * 8] = hb;
        tot4 = (ld2[0] + ld2[1]) + (ld2[2] + ld2[3]);
        { auto rx = __builtin_amdgcn_permlane32_swap(__float_as_uint(tot4.x), __float_as_uint(tot4.x), false, false), ry = __builtin_amdgcn_permlane32_swap(__float_as_uint(tot4.y), __float_as_uint(tot4.y), false, false);
          oth.x = __uint_as_float(th ? rx[0] : rx[1]); oth.y = __uint_as_float(th ? ry[0] : ry[1]); }
        if (th == 0) *(LAS v2*)(L + O_GSUM + tg * 256 + cp * 8) = tot4 + oth;
    }
    LBAR(); PST();
    {
        v2 pre = {0.f, 0.f}, cC = {0.f, 0.f};
#pragma unroll
        for (int g = 0; g < 8; ++g) { const v2 sg = *(const LAS v2*)(L + O_GSUM + g * 256 + cp * 8); cC += sg; if (g < tg) pre += sg; }
        const v2 zero2 = {0.f, 0.f};
        const v2 base = pre + ((d == 0) == (th == 1) ? oth : zero2);
        v2 At2[4], Vt2[4], Bh2[4], Kh2[4]; v2 pf = {0.f, 0.f};
#pragma unroll
        for (int k = 0; k < 4; ++k) { pf += ld2[k]; const int tau = TAU(4 * th + k);
            const v2 cl = base + (d == 0 ? pf : tot4 - pf + ld2[k]);
            const v2 e_m1 = EXP2V(cl - ld2[k]), e_p = EXP2V(cl), e_n = EXP2V(-cl), e_c = EXP2V(cC - cl);
            At2[k] = aa2[k] * e_m1; Vt2[k] = vv2[k]; Bh2[k] = bb2[k] * e_c; Kh2[k] = kd2[k] * e_c;
            const v2 rt = rr2[k] * e_p, bt = bb2[k] * e_n, kt = kd2[k] * e_n;
            *(LAS unsigned*)(L + O_AT + tau * P + cp * 4) = cvt_pk_bf16(At2[k].x, At2[k].y); *(LAS unsigned*)(L + O_RT + tau * P + cp * 4) = cvt_pk_bf16(rt.x, rt.y);
            *(LAS unsigned*)(L + O_BT + tau * P + cp * 4) = cvt_pk_bf16(bt.x, bt.y);         *(LAS unsigned*)(L + O_KT + tau * P + cp * 4) = cvt_pk_bf16(kt.x, kt.y); }
        const int tb4 = tau0 + (d == 0 ? 4 * th : 4 * (1 - th));
#define PK4(dst, X) do { u32x2 wx_, wy_; \
            wx_.x = cvt_pk_bf16(d == 0 ? X[0].x : X[3].x, d == 0 ? X[1].x : X[2].x); wx_.y = cvt_pk_bf16(d == 0 ? X[2].x : X[1].x, d == 0 ? X[3].x : X[0].x); \
            wy_.x = cvt_pk_bf16(d == 0 ? X[0].y : X[3].y, d == 0 ? X[1].y : X[2].y); wy_.y = cvt_pk_bf16(d == 0 ? X[2].y : X[1].y, d == 0 ? X[3].y : X[0].y); \
            *(LAS u32x2*)(L + (dst) + (2 * cp) * P + tb4 * 2) = wx_; *(LAS u32x2*)(L + (dst) + (2 * cp + 1) * P + tb4 * 2) = wy_; } while (0)
        PK4(O_ATT, At2); PK4(O_VT, Vt2); PK4(O_BHT, Bh2); PK4(O_KHT, Kh2);
#undef PK4
        if (tg == 0 && th == 0) *(LAS v2*)(L + O_WC + cp * 8) = EXP2V(cC);
    }
#undef FOLD4
#undef SIG2V
#undef EXP2V
    LBAR(); PST();
#pragma unroll
    for (int i = 0; i < 2; ++i) {
        const int ti = 2 * w + i, ms = ti >> 2, nl = ti & 3;
        const int sb = 32 * (ms & 1), tb = 32 * (nl & 1);
        f32x16 acc = f32x16{};
        if (sb <= tb) acc = mm_ll(L + (ms < 2 ? O_BT : O_KT), sb, L + (nl < 2 ? O_AT : O_RT), tb, acc, r32, hi);
        const bool incl = nl >= 2; const int dst = ms < 2 ? (nl < 2 ? O_LAB : O_ARB) : (nl < 2 ? O_LAK : O_ARK);
        const int t = tb + r32;
#pragma unroll
        for (int g = 0; g < 4; ++g) { const int s0 = sb + 8 * g + 4 * hi; float v[4];
#pragma unroll
            for (int e = 0; e < 4; ++e) { const int s = s0 + e; v[e] = (incl ? (s <= t) : (s < t)) ? acc[4 * g + e] : 0.f; }
            st4(L + dst + t * P + s0 * 2, v[0], v[1], v[2], v[3]);
            if (dst == O_LAB && (s0 >> 4) == (t >> 4)) *(LAS f32x4*)(L + O_LABD + (((t >> 4) * 16 + (t & 15)) * 16 + (s0 & 15)) * 4) = (f32x4){v[0], v[1], v[2], v[3]}; }
    }
    LBAR(); PST();
    if (w < 4) {
        const int mt = w >> 1, nt = w & 1; f32x16 acc = f32x16{};
        acc = mm_ll(L + O_LAK, 32 * mt, L + O_VT, 32 * nt, acc, r32, hi);
#pragma unroll
        for (int g = 0; g < 4; ++g) st4(L + O_XT + (32 * nt + r32) * P + (32 * mt + 8 * g + 4 * hi) * 2, acc[4 * g], acc[4 * g + 1], acc[4 * g + 2], acc[4 * g + 3]);
    } else if (w == 7) {
        const int blk = lane >> 4, cc = lane & 15; float x[16];
#pragma unroll
        for (int t = 0; t < 16; ++t) { float s = (t == cc) ? 1.f : 0.f; const LAS float* lr = (const LAS float*)(L + O_LABD + ((blk * 16 + t) * 16) * 4);
#pragma unroll
            for (int k = 0; k < t; ++k) s += lr[k] * x[k];
            x[t] = s; *(LAS bf16_t*)(L + O_TII + ((blk * 16 + t) * 16 + cc) * 2) = f2bf(s); }
    }
    LBAR(); PST();
    {
        const int c16 = lane & 15, q4 = lane >> 4;
        const LAS unsigned char* RT = L + (w < 4 ? O_ATT : O_XT) + (16 * (w & 3) + c16) * P;
        LAS unsigned char* OT = L + (w < 4 ? O_ABT : O_U0T) + (16 * (w & 3) + c16) * P;
        const LAS unsigned char* LA = L + O_LAB + c16 * P;
#define RHS(i) ({ const u32x2 r_ = *(const LAS u32x2*)(RT + (16 * (i) + 4 * q4) * 2); (f32x4){bflo(r_.x), bfhi(r_.x), bflo(r_.y), bfhi(r_.y)}; })
#define AFR(i, k1, k2) ({ const u32x2 lo_ = *(const LAS u32x2*)(LA + 16 * (i) * P + (16 * (k1) + 4 * q4) * 2); u32x2 hi_ = {0u, 0u}; if ((k2) >= 0) hi_ = *(const LAS u32x2*)(LA + 16 * (i) * P + (16 * ((k2) < 0 ? 0 : (k2)) + 4 * q4) * 2); \
        __builtin_bit_cast(bf16x8, (u32x4){lo_.x, lo_.y, hi_.x, hi_.y}); })
#define TFR(i) ({ const u32x2 lo_ = *(const LAS u32x2*)(L + O_TII + (((i) * 16 + c16) * 16 + 4 * q4) * 2); __builtin_bit_cast(bf16x8, (u32x4){lo_.x, lo_.y, 0u, 0u}); })
#define BFR(U1, U2) __builtin_bit_cast(bf16x8, (u32x4){cvt_pk_bf16(U1[0], U1[1]), cvt_pk_bf16(U1[2], U1[3]), cvt_pk_bf16(U2[0], U2[1]), cvt_pk_bf16(U2[2], U2[3])})
#define MF16(A_, B_, C_) __builtin_amdgcn_mfma_f32_16x16x32_bf16(A_, B_, C_, 0, 0, 0)
        const f32x4 zero4 = {0.f, 0.f, 0.f, 0.f};
        f32x4 U0 = MF16(TFR(0), BFR(RHS(0), zero4), zero4);
        f32x4 Z1 = MF16(AFR(1, 0, -1), BFR(U0, zero4), RHS(1));
        f32x4 U1 = MF16(TFR(1), BFR(Z1, zero4), zero4);
        f32x4 Z2 = MF16(AFR(2, 0, 1), BFR(U0, U1), RHS(2));
        f32x4 U2 = MF16(TFR(2), BFR(Z2, zero4), zero4);
        f32x4 Z3 = MF16(AFR(3, 0, 1), BFR(U0, U1), RHS(3));
        Z3 = MF16(AFR(3, 2, -1), BFR(U2, zero4), Z3);
        f32x4 U3 = MF16(TFR(3), BFR(Z3, zero4), zero4);
        st4(OT + (0 + 4 * q4) * 2, U0[0], U0[1], U0[2], U0[3]); st4(OT + (16 + 4 * q4) * 2, U1[0], U1[1], U1[2], U1[3]);
        st4(OT + (32 + 4 * q4) * 2, U2[0], U2[1], U2[2], U2[3]); st4(OT + (48 + 4 * q4) * 2, U3[0], U3[1], U3[2], U3[3]);
#undef RHS
#undef AFR
#undef TFR
#undef BFR
#undef MF16
    }
    if (publish_prev) asm volatile("s_waitcnt vmcnt(0)" ::: "memory");
    LBAR(); PST();
    if (publish_prev && tid == 0) __hip_atomic_fetch_add(publish_prev, 1u, __ATOMIC_RELAXED, __HIP_MEMORY_SCOPE_AGENT);
    {
        const int mt = (w >> 1) & 1, nt = w & 1;
        if (w < 4) {
            f32x16 acc = f32x16{};
            acc = mm_ll(L + O_ABT, 32 * mt, L + O_BHT, 32 * nt, acc, r32, hi);
            if (mt == nt) { const float wc = *(const LAS float*)(L + O_WC + (32 * nt + r32) * 4);
#pragma unroll
                for (int r = 0; r < 16; ++r) if (crow(r, hi) == r32) acc[r] += wc; }
            store_native(slot + (mt * 2 + nt) * 2048, acc, lane, wt);
            f32x16 rb;
#pragma unroll
            for (int g = 0; g < 4; ++g) { const u32x2 r_ = *(const LAS u32x2*)(L + O_RT + (32 * nt + r32) * P + (32 * mt + 8 * g + 4 * hi) * 2);
                rb[4 * g] = bflo(r_.x); rb[4 * g + 1] = bfhi(r_.x); rb[4 * g + 2] = bflo(r_.y); rb[4 * g + 3] = bfhi(r_.y); }
            rb = mm_ll(L + O_ABT, 32 * mt, L + O_ARB, 32 * nt, rb, r32, hi);
            store_native(slot + 16384 + (mt * 2 + nt) * 2048, rb, lane, wt);
        } else {
            f32x16 acc = f32x16{};
            acc = mm_ll(L + O_BHT, 32 * mt, L + O_U0T, 32 * nt, acc, r32, hi);
            acc = mm_ll(L + O_KHT, 32 * mt, L + O_VT, 32 * nt, acc, r32, hi);
            store_native(slot + 8192 + (mt * 2 + nt) * 2048, acc, lane, wt);
            f32x16 y0 = f32x16{};
            y0 = mm_ll(L + O_ARB, 32 * mt, L + O_U0T, 32 * nt, y0, r32, hi);
            y0 = mm_ll(L + O_ARK, 32 * mt, L + O_VT, 32 * nt, y0, r32, hi);
            store_native(slot + 24576 + (mt * 2 + nt) * 2048, y0, lane, wt);
        }
    }
    LBAR(); PST();
    s1_stage_store(L, tid, nd, nq, nck, stg, par);
    LBAR(); PST();
#undef PAR
#undef TAU
#undef LD10
#undef PST
}

__device__ __forceinline__ void s23_wait_round(unsigned* ready, int r, int lane) {
    unsigned spins = 0;
    while ((unsigned)__builtin_amdgcn_readfirstlane(__hip_atomic_load(ready + r, __ATOMIC_RELAXED, __HIP_MEMORY_SCOPE_AGENT)) < 16u) { __builtin_amdgcn_s_sleep(8); if (++spins > (1u << 22)) break; }
    __builtin_amdgcn_fence(__ATOMIC_ACQUIRE, "agent");
    asm volatile("s_waitcnt vmcnt(0)" ::: "memory");
}
__device__ __forceinline__ void s23_chain_wg(const Frame& F, const Args& a, int d, int q, int h, unsigned char* slots  , unsigned* ready) {
    LAS unsigned char* L = F.lds;
    const int lane = F.lane, w = F.wave, icb = w & 1;
    const int NC = seq_len(q) / 64;
    f32x16 X0 = f32x16{}, X1 = f32x16{};
    const bool loader = w >= 4, compute = w < 2;
    constexpr int D = 6;
#define CKOF(cc) (d == 0 ? (cc) : NC - 1 - (cc))
#define S23_DMA(cc) do { const unsigned char* src_ = slots + (size_t)CKOF(cc) * SLOT_BYTES + (w - 4) * 4096 + lane * 16; LAS unsigned char* dst_ = L + ((cc) & 7) * 16384 + (w - 4) * 4096; \
        _Pragma("unroll") for (int p_ = 0; p_ < 4; ++p_) __builtin_amdgcn_global_load_lds((const unsigned*)(src_ + p_ * 1024), (LAS unsigned*)(dst_ + p_ * 1024), 16, 0, 0); } while (0)
#define UNPK(dst, w0, w1) do { _Pragma("unroll") for (int q_ = 0; q_ < 4; ++q_) { dst[2 * q_] = bflo(w0[q_]); dst[2 * q_ + 1] = bfhi(w0[q_]); dst[8 + 2 * q_] = bflo(w1[q_]); dst[9 + 2 * q_] = bfhi(w1[q_]); } } while (0)
    if (ready) { if (w == 4) s23_wait_round(ready, 0, lane); asm volatile("s_waitcnt lgkmcnt(0)\n\ts_barrier" ::: "memory"); }
    if (loader) {
#pragma unroll
        for (int c0 = 0; c0 < D; ++c0) if (c0 < NC) S23_DMA(c0); }
#pragma unroll 1
    for (int cc = 0; cc < NC; ++cc) {
        if (ready && w == 4 && ((cc + D) & 15) == 0 && cc + D < NC) s23_wait_round(ready, (cc + D) >> 4, lane);
        if (loader) { const int later = NC - 1 - cc;
            if (later >= 5) asm volatile("s_waitcnt vmcnt(20)" ::: "memory"); else if (later == 4) asm volatile("s_waitcnt vmcnt(16)" ::: "memory"); else if (later == 3) asm volatile("s_waitcnt vmcnt(12)" ::: "memory");
            else if (later == 2) asm volatile("s_waitcnt vmcnt(8)" ::: "memory"); else if (later == 1) asm volatile("s_waitcnt vmcnt(4)" ::: "memory"); else asm volatile("s_waitcnt vmcnt(0)" ::: "memory"); }
        asm volatile("s_waitcnt lgkmcnt(0)\n\ts_barrier" ::: "memory");
        if (loader) { if (cc + D < NC) S23_DMA(cc + D); }
        if (compute) {
            const LAS unsigned char* sl = L + (cc & 7) * 16384 + lane * 32;
            u32x4 mw[4][2], dw[2][2];
#pragma unroll
            for (int t = 0; t < 4; ++t) { mw[t][0] = *(const LAS u32x4*)(sl + t * 2048); mw[t][1] = *(const LAS u32x4*)(sl + t * 2048 + 16); }
#pragma unroll
            for (int t = 0; t < 2; ++t) { dw[t][0] = *(const LAS u32x4*)(sl + 8192 + (t * 2 + icb) * 2048); dw[t][1] = *(const LAS u32x4*)(sl + 8192 + (t * 2 + icb) * 2048 + 16); }
            __builtin_amdgcn_sched_barrier(0);
            u32x4 xw[2][2];
#pragma unroll
            for (int s = 0; s < 2; ++s) {
                xw[0][s] = (u32x4){cvt_pk_bf16(X0[8 * s], X0[8 * s + 1]), cvt_pk_bf16(X0[8 * s + 2], X0[8 * s + 3]), cvt_pk_bf16(X0[8 * s + 4], X0[8 * s + 5]), cvt_pk_bf16(X0[8 * s + 6], X0[8 * s + 7])};
                xw[1][s] = (u32x4){cvt_pk_bf16(X1[8 * s], X1[8 * s + 1]), cvt_pk_bf16(X1[8 * s + 2], X1[8 * s + 3]), cvt_pk_bf16(X1[8 * s + 4], X1[8 * s + 5]), cvt_pk_bf16(X1[8 * s + 6], X1[8 * s + 7])}; }
            { unsigned char* xo = slots + (size_t)CKOF(cc) * SLOT_BYTES + ((icb * 2) * 64 + lane) * 32;
              *(u32x4*)(xo) = xw[0][0]; *(u32x4*)(xo + 16) = xw[0][1]; *(u32x4*)(xo + 2048) = xw[1][0]; *(u32x4*)(xo + 2048 + 16) = xw[1][1]; }
            asm volatile("s_waitcnt lgkmcnt(0)" ::: "memory");
            __builtin_amdgcn_sched_barrier(0);
            f32x16 N0, N1;
            UNPK(N0, dw[0][0], dw[0][1]); UNPK(N1, dw[1][0], dw[1][1]);
#pragma unroll
            for (int rb = 0; rb < 2; ++rb)
#pragma unroll
                for (int s = 0; s < 2; ++s) {
                    N0 = __builtin_amdgcn_mfma_f32_32x32x16_bf16(__builtin_bit_cast(bf16x8, mw[rb * 2 + 0][s]), __builtin_bit_cast(bf16x8, xw[rb][s]), N0, 0, 0, 0);
                    N1 = __builtin_amdgcn_mfma_f32_32x32x16_bf16(__builtin_bit_cast(bf16x8, mw[rb * 2 + 1][s]), __builtin_bit_cast(bf16x8, xw[rb][s]), N1, 0, 0, 0); }
            X0 = N0; X1 = N1;
        }
    }
    asm volatile("s_waitcnt vmcnt(0) lgkmcnt(0)\n\ts_barrier" ::: "memory");
#undef UNPK
#undef S23_DMA
#undef CKOF
}

constexpr int PO_V = 0, PO_G = PO_V + 66 * 144, PO_Y = PO_G + 66 * 272, PO_SG = PO_Y + 2 * 64 * 272, PO_GF = PO_SG + 64 * 272, PO_END = PO_GF + 64 * 272;
static_assert(PO_END <= PTRS_OFF - 64, "post lds");
struct PostPre { u32x4 stg[4]; u32x4 ra[2][2], xb[2][2], yc[2]; };
__device__ __forceinline__ void post_decode(int c, int& reg, int& row, int& part) {
    if (c < 528) { reg = 0; row = c >> 3; part = c & 7; } else { reg = 1; row = (c - 528) >> 4; part = (c - 528) & 15; }
}
__device__ __forceinline__ void post_stage_load(const Args& a, int tid, int q, int h, int blk, PostPre& pp) {
    const int row0 = seq_row0(q), S = seq_len(q), t0 = blk * 64;
    const bf16_t* Zs = (const bf16_t*)(a.ws + WS_Z) + (size_t)row0 * ZP;
#pragma unroll
    for (int k = 0; k < 4; ++k) { const int c = tid + k * NTHR; int reg, row, part; post_decode(c, reg, row, part);
        const int t = t0 - 1 + row; const int col = reg == 0 ? ZRV + h * 64 : ZGD;
        pp.stg[k] = (u32x4){0u, 0u, 0u, 0u};
        if (c < 1584 && t >= 0 && t < S) pp.stg[k] = *(const u32x4*)(Zs + (size_t)t * ZP + col + part * 8); }
    const int w = tid >> 6, lane = tid & 63, dd = w >> 2, tb = (w >> 1) & 1, icb = w & 1;
    const size_t si = q == 0 ? (size_t)(dd * 8 + h) * 256 + blk : (size_t)((dd * 8 + (q - 1)) * 8 + h) * 32 + blk;
    const unsigned char* sl = (const unsigned char*)a.out + si * SLOT_BYTES + lane * 32;
#pragma unroll
    for (int rb = 0; rb < 2; ++rb) { pp.ra[rb][0] = *(const u32x4*)(sl + 16384 + (rb * 2 + tb) * 2048); pp.ra[rb][1] = *(const u32x4*)(sl + 16384 + (rb * 2 + tb) * 2048 + 16);
                                     pp.xb[rb][0] = *(const u32x4*)(sl + (icb * 2 + rb) * 2048); pp.xb[rb][1] = *(const u32x4*)(sl + (icb * 2 + rb) * 2048 + 16); }
    pp.yc[0] = *(const u32x4*)(sl + 24576 + (tb * 2 + icb) * 2048); pp.yc[1] = *(const u32x4*)(sl + 24576 + (tb * 2 + icb) * 2048 + 16);
}
__device__ __forceinline__ void post_item(const Frame& F, const Args& a, int q, int h, int blk, PostPre& pp, int nq, int nh, int nblk) {
    LAS unsigned char* L = F.lds;
    int lane_ = F.lane; asm volatile("" : "+v"(lane_));
    const int lane = lane_, w = F.wave, tid = w * 64 + lane, r32 = lane & 31, hi = lane >> 5, j = lane, tg = w;
    const int row0 = seq_row0(q), t_lo = blk * 64 + 8 * tg;
    bf16_t* Zs = (bf16_t*)(a.ws + WS_Z) + (size_t)row0 * ZP;
    const float* mup = inp(L, 11); const float* mun = inp(L, 12);
    const int chp = h * 64 + j;
    const float mp0 = gld(mup + ZGD - ZRR + j), mn0 = gld(mun + ZGD - ZRR + j), mp1 = gld(mup + ZGD - ZRR + 64 + j), mn1 = gld(mun + ZGD - ZRR + 64 + j);
    const float mpv = gld(mup + 1024 + chp), mnv = gld(mun + 1024 + chp), lg = gld(inp(L, 21) + chp), lb = gld(inp(L, 22) + chp);
    float bsum[8];
    { const float* bon0 = (const float*)(a.ws + WS_BONUS) + (size_t)row0 * 8 + h; const float* bon1 = bon0 + (size_t)MTOK * 8;
#pragma unroll
      for (int u = 0; u < 8; ++u) bsum[u] = bon0[(size_t)(t_lo + u) * 8] + bon1[(size_t)(t_lo + u) * 8]; }
    bf16x8 gfr[8];
    { const bf16_t* GT = (const bf16_t*)(a.ws + WS_LORA) + 4 * 512 * 64 + ((size_t)h * 64 + 32 * ((w >> 1) & 1) + r32) * 128;
#pragma unroll
      for (int ks = 0; ks < 8; ++ks) gfr[ks] = *(const bf16x8*)(GT + 16 * ks + 8 * hi); }
#pragma unroll
    for (int k = 0; k < 4; ++k) { const int c = tid + k * NTHR; int reg, row, part; post_decode(c, reg, row, part);
        const int off = reg == 0 ? PO_V + row * 144 : PO_G + row * 272;
        if (c < 1584) *(LAS u32x4*)(L + off + part * 16) = pp.stg[k]; }
    {
        const int dd = w >> 2, tb = (w >> 1) & 1, icb = w & 1;
        f32x16 Y;
#pragma unroll
        for (int q_ = 0; q_ < 4; ++q_) { Y[2 * q_] = bflo(pp.yc[0][q_]); Y[2 * q_ + 1] = bfhi(pp.yc[0][q_]); Y[8 + 2 * q_] = bflo(pp.yc[1][q_]); Y[9 + 2 * q_] = bfhi(pp.yc[1][q_]); }
#pragma unroll
        for (int rb = 0; rb < 2; ++rb)
#pragma unroll
            for (int s2 = 0; s2 < 2; ++s2) Y = __builtin_amdgcn_mfma_f32_32x32x16_bf16(__builtin_bit_cast(bf16x8, pp.ra[rb][s2]), __builtin_bit_cast(bf16x8, pp.xb[rb][s2]), Y, 0, 0, 0);
#pragma unroll
        for (int r = 0; r < 16; ++r) { const int tau = 32 * tb + (r & 3) + 8 * (r >> 2) + 4 * hi; const int t = dd == 0 ? tau : 63 - tau;
            *(LAS float*)(L + PO_Y + (dd * 64 + t) * 272 + (32 * icb + r32) * 4) = Y[r]; }
    }
    LBAR();
    post_stage_load(a, tid, nq, nh, nblk, pp);
    {
        float z0[10], z1[10];
#pragma unroll
        for (int i = 0; i < 10; ++i) { z0[i] = bf2f(*(const LAS bf16_t*)(L + PO_G + (8 * tg + i) * 272 + j * 2)); z1[i] = bf2f(*(const LAS bf16_t*)(L + PO_G + (8 * tg + i) * 272 + (64 + j) * 2)); }
#pragma unroll
        for (int u = 0; u < 8; ++u) { const float s0_ = sigmoidf_(tshift(z0, u, mp0, mn0)), s1_ = sigmoidf_(tshift(z1, u, mp1, mn1));
#define NBR(x) __int_as_float(__builtin_amdgcn_update_dpp(0, __float_as_int(x), 0xB1, 0xF, 0xF, true))
            const unsigned p0_ = cvt_pk_bf16(s0_, NBR(s0_)), p1_ = cvt_pk_bf16(s1_, NBR(s1_));
#undef NBR
            if (!(lane & 1)) { *(LAS unsigned*)(L + PO_SG + (8 * tg + u) * 272 + j * 2) = p0_; *(LAS unsigned*)(L + PO_SG + (8 * tg + u) * 272 + (64 + j) * 2) = p1_; } }
    }
    LBAR();
    if (w < 4) {
        const int mt = w >> 1, nt = w & 1;
        f32x16 acc = f32x16{};
#pragma unroll
        for (int ks = 0; ks < 8; ++ks) { const bf16x8 bv = *(const LAS bf16x8*)(L + PO_SG + (32 * nt + r32) * 272 + (16 * ks + 8 * hi) * 2);
            acc = __builtin_amdgcn_mfma_f32_32x32x16_bf16(gfr[ks], bv, acc, 0, 0, 0); }
#pragma unroll
        for (int g = 0; g < 4; ++g) *(LAS f32x4*)(L + PO_GF + (32 * nt + r32) * 272 + (32 * mt + 8 * g + 4 * hi) * 4) = (f32x4){acc[4 * g], acc[4 * g + 1], acc[4 * g + 2], acc[4 * g + 3]};
    }
    LBAR();
    {
        const int ch = h * 64 + j;
        float zv[10];
#pragma unroll
        for (int i = 0; i < 10; ++i) zv[i] = bf2f(*(const LAS bf16_t*)(L + PO_V + (8 * tg + i) * 144 + j * 2));
        float y8[8], m8[8], v8[8];
#pragma unroll
        for (int u = 0; u < 8; ++u) { y8[u] = *(const LAS float*)(L + PO_Y + (8 * tg + u) * 272 + j * 4) + *(const LAS float*)(L + PO_Y + (64 + 8 * tg + u) * 272 + j * 4); m8[u] = y8[u]; }
        wave_sum8(m8, lane);
#pragma unroll
        for (int u = 0; u < 8; ++u) { y8[u] -= m8[u] * (1.f / 64.f); v8[u] = y8[u] * y8[u]; }
        wave_sum8(v8, lane);
#pragma unroll
        for (int u = 0; u < 8; ++u) { const int t = t_lo + u;
            const float yn = y8[u] * __builtin_amdgcn_rsqf(v8[u] * (1.f / 64.f) + LNX_EPS) * lg + lb;
            const float g = *(const LAS float*)(L + PO_GF + (8 * tg + u) * 272 + j * 4);
            Zs[(size_t)t * ZP + ZRR + ch] = f2bf((yn + bsum[u] * tshift(zv, u, mpv, mnv)) * g); }
    }
    LBAR();
}
}


#define XB_TMO      128
#define XB_XCNT(j)  (256  + 64 * (j))
#define XB_XSUB(j)  (1280 + 64 * (j))
#define XB_XGEN(j)  (2304 + 64 * (j))
#define XB_TOP      3328
#define XB_TOPGEN   3392
#define XCD_BAR_WORDS 3456
#define XB_SPIN_CAP (1u << 20)
constexpr size_t CTL_ZERO_BYTES = 16384;
__device__ __forceinline__ unsigned xb_ld(unsigned* p)              { return __hip_atomic_load(p, __ATOMIC_RELAXED, __HIP_MEMORY_SCOPE_AGENT); }
__device__ __forceinline__ unsigned xb_add(unsigned* p, unsigned v) { return __hip_atomic_fetch_add(p, v, __ATOMIC_RELAXED, __HIP_MEMORY_SCOPE_AGENT); }
__device__ __forceinline__ unsigned xb_xcc_id() { return (unsigned)__builtin_amdgcn_s_getreg((3 << 11) | 20) & 0xFu; }
#define XB_SPIN(cond, bar) do { unsigned _sp = 0; while (cond) { __builtin_amdgcn_s_sleep(1); \
    if ((++_sp & 255u) == 0u) { if (xb_ld(&(bar)[XB_TMO])) break; if (_sp > XB_SPIN_CAP) { atomicAdd(&(bar)[XB_TMO], 1u); break; } } } } while (0)
struct XcdBarrier { unsigned* bar; unsigned x; volatile LAS unsigned* st; };
__device__ __forceinline__ XcdBarrier xcd_barrier_post(unsigned* bar, volatile LAS unsigned* st) {
    XcdBarrier b; b.bar = bar; b.x = xb_xcc_id(); b.st = st;
    if (threadIdx.x == 0) (void)xb_add(&bar[XB_XCNT(b.x)], 1u);
    return b;
}
__device__ __forceinline__ void xcd_barrier_complete(unsigned* bar, unsigned x, unsigned& nloc, unsigned& nx) {
    const unsigned G = gridDim.x * gridDim.y * gridDim.z;
    unsigned sum, cnt, mine, sp = 0u;
    for (;;) {
        sum = 0u; cnt = 0u; mine = 0u;
#pragma unroll
        for (unsigned j = 0; j < 16; ++j) { const unsigned c = xb_ld(&bar[XB_XCNT(j)]); sum += c; cnt += (c > 0u) ? 1u : 0u; mine = (j == x) ? c : mine; }
        if (sum == G) break;
        __builtin_amdgcn_s_sleep(1);
        if ((++sp & 255u) == 0u) { if (xb_ld(&bar[XB_TMO])) break; if (sp > XB_SPIN_CAP) { atomicAdd(&bar[XB_TMO], 1u); break; } }
    }
    nloc = mine > 0u ? mine : 1u; nx = cnt > 0u ? cnt : 1u;
}
__device__ __forceinline__ void xcd_barrier(const XcdBarrier& b) {
    asm volatile("s_waitcnt vmcnt(0)" ::: "memory");
    __syncthreads();
    if (threadIdx.x == 0) {
        unsigned* bar = b.bar;
        __builtin_amdgcn_s_waitcnt(0);
        unsigned nloc = b.st[0], nx = b.st[1];
        if (nloc == 0u) { xcd_barrier_complete(bar, b.x, nloc, nx); b.st[0] = nloc; b.st[1] = nx; }
        const unsigned old = xb_add(&bar[XB_XSUB(b.x)], 1u);
        const unsigned gen = old / nloc;
        if (old + 1u == (gen + 1u) * nloc) {
            __builtin_amdgcn_fence(__ATOMIC_RELEASE, "agent");
            asm volatile("s_waitcnt vmcnt(0)" ::: "memory");
            const unsigned og = xb_add(&bar[XB_TOP], 1u);
            const unsigned tg = og / nx;
            if (og + 1u == (tg + 1u) * nx) xb_add(&bar[XB_TOPGEN], 1u);
            else XB_SPIN(xb_ld(&bar[XB_TOPGEN]) == tg, bar);
            __builtin_amdgcn_fence(__ATOMIC_ACQUIRE, "agent");
            xb_add(&bar[XB_XGEN(b.x)], 1u);
            asm volatile("s_waitcnt vmcnt(0)" ::: "memory");
        } else {
            XB_SPIN(xb_ld(&bar[XB_XGEN(b.x)]) == gen, bar);
            __builtin_amdgcn_fence(__ATOMIC_ACQUIRE, "agent");
            asm volatile("s_waitcnt vmcnt(0)" ::: "memory");
        }
    }
    __syncthreads();
}

constexpr int NPHASE = 10;
constexpr int NOJUMP = 1 << 30;
template <int LO, int HI>
__global__ void __launch_bounds__(NTHR, 2) fwd_kernel(Args a) {
    extern __shared__ __attribute__((aligned(16))) unsigned char lds_raw[];
    Frame F; F.lds = (LAS unsigned char*)lds_raw; F.tid = threadIdx.x; F.lane = F.tid & 63; F.wave = __builtin_amdgcn_readfirstlane(F.tid >> 6);
    F.G = gridDim.x; { const int bx = blockIdx.x; F.vcu = (F.G % 8 == 0) ? (bx % 8) * (F.G / 8) + bx / 8 : bx; }
    unsigned char* ws = a.ws; bf16_t* Z = (bf16_t*)(ws + WS_Z);
    unsigned char* slots = (unsigned char*)a.out;
    if (F.tid == 0) {
#pragma unroll
        for (int i = 0; i < 27; ++i) *(const float* LAS*)(F.lds + PTRS_OFF + i * 8) = a.in[i];
        *(volatile LAS unsigned*)(F.lds + PTRS_OFF + 224) = 0u; *(volatile LAS unsigned*)(F.lds + PTRS_OFF + 228) = 0u;
        *(LAS unsigned long long*)(F.lds + PTRS_OFF - 64) = 0ull;
    }
    __syncthreads();
#if ONE_LAUNCH && !USE_CG
    const XcdBarrier bar = xcd_barrier_post((unsigned*)(ws + WS_CTL), (volatile LAS unsigned*)(F.lds + PTRS_OFF + 224));
#endif
#if ONE_LAUNCH
#if PROBE_SEG >= 0 || PROBE_CLK >= 0
    unsigned long long* tsb = (unsigned long long*)(ws + WS_CTL + 15872); int nts = 0;
#define STAMP() do { if (blockIdx.x == 0 && F.tid == 0) { tsb[nts] = __builtin_amdgcn_s_memrealtime(); tsb[32 + nts] = __builtin_amdgcn_s_memtime(); } ++nts; } while (0)
    STAMP();
#else
#define STAMP() do { } while (0)
#endif
#if USE_CG
#define SEAM(k) do { if constexpr ((k) + 1 < HI) { cg::this_grid().sync(); STAMP(); } } while (0)
#define RSYNC() do { cg::this_grid().sync(); STAMP(); } while (0)
#else
#define SEAM(k) do { if constexpr ((k) + 1 < HI) { xcd_barrier(bar); STAMP(); } } while (0)
#define RSYNC() do { xcd_barrier(bar); STAMP(); } while (0)
#endif
#else
#define SEAM(k) do { } while (0)
#define RSYNC() do { } while (0)
#endif
#define IN(k) (LO <= (k) && (k) < HI)
    if constexpr (IN(0)) { p0_prologue(F, a); SEAM(0);
#if PROBE_DOUBLE == 4
        p0_prologue(F, a); RSYNC();
#endif
    }
    if constexpr (IN(1)) { pg8::Gemm g{(const char*)a.out, (const bf16_t*)(ws + WS_WIN), MTOK, ZP, DM, DM * 2, NOJUMP, 0}; pg8::StaticOrder S; S.init(MTOK, ZP, F.G, (int)blockIdx.x);
        pg8::EpiZ E{Z, ZP}; pg8::gemm_phase<pg8::EpiZ, pg8::StaticOrder, true>(F.lds, g, S, E); SEAM(1);
#if PROBE_DOUBLE == 3
        pg8::gemm_phase<pg8::EpiZ, pg8::StaticOrder, true>(F.lds, g, S, E); RSYNC();
#endif
    }
    if constexpr (IN(2)) { qk_prep(F, a);
        unsigned* rdy = (unsigned*)(ws + WS_CTL) + 3584;
#pragma unroll 1
        for (int rnd = 0; rnd < 2; ++rnd) {
            const int nprod = rnd == 1 ? F.G - 16 : F.G;
            if (F.vcu < nprod) {
#define S1_DECODE(i_, d_, q_, h_, ck_, it_, pub_) do { if (rnd == 1) { const int c_ = ((i_) >> 4) & 15, cc_ = (((i_) >> 8) << 4) + ((i_) & 15); d_ = c_ >> 3; h_ = c_ & 7; q_ = 0; ck_ = d_ ? 255 - cc_ : cc_; it_ = c_ * 256 + ck_; pub_ = rdy + c_ * 16 + ((i_) >> 8); } \
                    else { ck_ = (i_) & 31; h_ = ((i_) >> 5) & 7; q_ = 1 + (((i_) >> 8) & 7); d_ = (i_) >> 11; it_ = (i_); pub_ = nullptr; } } while (0)
                { int d, q, h, ck, it; unsigned* pub; S1_DECODE(F.vcu, d, q, h, ck, it, pub); (void)it; (void)pub;
                  u32x4 stg[6]; rw::s1_stage_load(a, F.tid, q, h, ck, stg); const f32x2_t par = rw::s1_param_load(F.lds, F.tid, d, h);
                  rw::s1_stage_store(F.lds, F.tid, d, q, ck, stg, par); LBAR(); }
                unsigned* pub_prev = nullptr;
#pragma unroll 1
                for (int i = F.vcu; i < 4096; i += nprod) {
                    int d, q, h, ck, it, nd, nq, nh, nck, nit; unsigned* pub; unsigned* npub; S1_DECODE(i, d, q, h, ck, it, pub); const int ni = i + nprod < 4096 ? i + nprod : i; S1_DECODE(ni, nd, nq, nh, nck, nit, npub); (void)nit; (void)npub;
                    rw::s1_item(F, a, d, q, h, ck, slots + (size_t)it * SLOT_BYTES, nd, nq, nh, nck, rnd == 1, pub_prev); pub_prev = pub; }
                if (pub_prev) { asm volatile("s_waitcnt vmcnt(0)" ::: "memory"); __syncthreads(); if (F.tid == 0) __hip_atomic_fetch_add(pub_prev, 1u, __ATOMIC_RELAXED, __HIP_MEMORY_SCOPE_AGENT); }
#undef S1_DECODE
            } else {
                const int c = F.vcu - nprod;
                rw::s23_chain_wg(F, a, c >> 3, 0, c & 7, slots + (size_t)c * 256 * SLOT_BYTES, rdy + c * 16);
            }
            if (rnd == 0) {
                RSYNC();
                for (int chain = F.vcu; chain < 128; chain += F.G) { const int h = chain & 7, q = 1 + ((chain >> 3) & 7), d = chain >> 6;
                    rw::s23_chain_wg(F, a, d, q, h, slots + (size_t)chain * 32 * SLOT_BYTES, nullptr); }
            }
            RSYNC();
            {
#define PO_DECODE(it_, q_, h_, b_) do { if (rnd == 1) { q_ = 0; h_ = ((it_) >> 8) & 7; b_ = (it_) & 255; } else { q_ = 1 + (((it_) >> 8) & 7); h_ = ((it_) >> 5) & 7; b_ = (it_) & 31; } } while (0)
                rw::PostPre pp;
                { int q, h, b; PO_DECODE(F.vcu, q, h, b); rw::post_stage_load(a, F.tid, q, h, b, pp); }
#pragma unroll 1
                for (int it = F.vcu; it < 2048; it += F.G) { int q, h, b, nq, nh, nb; PO_DECODE(it, q, h, b); const int nit = it + F.G < 2048 ? it + F.G : it; PO_DECODE(nit, nq, nh, nb);
                    rw::post_item(F, a, q, h, b, pp, nq, nh, nb); }
#undef PO_DECODE
            }
            if (rnd == 0) RSYNC();
        }
        SEAM(2); }
    if constexpr (IN(4)) {
        float lam; { const float p1 = wave_sum(a.in[6][F.lane] * a.in[7][F.lane]), p2 = wave_sum(a.in[8][F.lane] * a.in[9][F.lane]); lam = __expf(p1) - __expf(p2) + LAMBDA_INIT; }
#if PROBE_DOUBLE == 1
        for (int v = F.vcu; v < 256; v += F.G) {
            att::attn_unit(0, SP, v >> 6, v & 63, Z, F.lds, lam, a.in[10], (bf16_t*)a.out, 512);
            att::attn_unit(SP + (v >> 5) * SS, SS, (v >> 3) & 3, v & 7, Z, F.lds, lam, a.in[10], (bf16_t*)a.out, 512); }
        RSYNC();
#endif
        for (int v = F.vcu; v < 256; v += F.G) {
            att::attn_unit(0, SP, v >> 6, v & 63, Z, F.lds, lam, a.in[10], Z, ZP);
            att::attn_unit(SP + (v >> 5) * SS, SS, (v >> 3) & 3, v & 7, Z, F.lds, lam, a.in[10], Z, ZP); }
        SEAM(4); }
    if constexpr (IN(5)) { pg8::Gemm g{(const char*)Z, (const bf16_t*)(ws + WS_WOUT), MTOK, DM, DM, ZP * 2, 8, 2048}; pg8::StaticOrder S; S.init(MTOK, DM, F.G, (int)blockIdx.x);
        pg8::EpiOut E{a.in[0], a.in[1], a.out, Z, (float*)(ws + WS_ROWSQ)}; pg8::gemm_phase<pg8::EpiOut, pg8::StaticOrder, true>(F.lds, g, S, E); SEAM(5); }
#define FFN_UP(k, half) if constexpr (IN(k)) { pg8::Gemm g{(const char*)(Z + (size_t)(half) * 16384 * ZP + ZXN2), (const bf16_t*)(ws + WS_W1), 16384, DFF, DM, ZP * 2, NOJUMP, 0}; pg8::StaticOrder S; S.init(16384, DFF, F.G, (int)blockIdx.x); \
        pg8::EpiUp E{(char*)(ws + WS_Z), (const float*)(ws + WS_ROWSQ), (half) * 16384}; pg8::gemm_phase<pg8::EpiUp, pg8::StaticOrder, true>(F.lds, g, S, E); SEAM(k); }
#define FFN_DN(k, half) if constexpr (IN(k)) { pg8::Gemm g{(const char*)(ws + WS_Z), (const bf16_t*)(ws + WS_W2), 16384, DM, DFF, 13312, 32, 2560}; pg8::StaticOrder S; S.init(16384, DM, F.G, (int)blockIdx.x); \
        pg8::EpiDown E{a.out, (half) * 16384}; pg8::gemm_phase<pg8::EpiDown, pg8::StaticOrder, true>(F.lds, g, S, E); SEAM(k); }
    FFN_UP(6, 0) FFN_DN(7, 0) FFN_UP(8, 1) FFN_DN(9, 1)
#if PROBE_S1 >= 0 || PROBE_ATT
    if (F.tid == 0) { const unsigned long long dt = *(LAS unsigned long long*)(F.lds + PTRS_OFF - 64), t0_ = __builtin_amdgcn_s_memrealtime();
        while (__builtin_amdgcn_s_memrealtime() - t0_ < dt) __builtin_amdgcn_s_sleep(16); }
#endif
#if PROBE_SEG >= 0 || PROBE_CLK >= 0
    STAMP();
#if PROBE_CLK >= 0
    if (blockIdx.x == 0 && F.tid == 0) { asm volatile("s_waitcnt vmcnt(0)" ::: "memory"); const unsigned long long wt_ = tsb[PROBE_CLK + 1] - tsb[PROBE_CLK], cy_ = tsb[32 + PROBE_CLK + 1] - tsb[32 + PROBE_CLK];
        const unsigned long long dt = cy_ * 1000ull / (wt_ ? wt_ : 1ull), t0_ = __builtin_amdgcn_s_memrealtime();
        while (__builtin_amdgcn_s_memrealtime() - t0_ < dt) __builtin_amdgcn_s_sleep(16); }
#endif
    if (PROBE_CLK < 0 && blockIdx.x == 0 && F.tid == 0) { asm volatile("s_waitcnt vmcnt(0)" ::: "memory"); const unsigned long long dt = tsb[PROBE_SEG + 1] - tsb[PROBE_SEG], t0_ = __builtin_amdgcn_s_memrealtime();
        while (__builtin_amdgcn_s_memrealtime() - t0_ < dt) __builtin_amdgcn_s_sleep(16); }
#endif
#undef FFN_UP
#undef FFN_DN
#undef IN
#undef SEAM
#undef RSYNC
}

extern "C" void kernel_launch(void* const* d_in, const int* in_sizes, int n_in, void* d_out, int out_size, void* d_ws, size_t ws_size, hipStream_t stream) {
    static int grid = 0;
    if (grid == 0) {
        if (n_in != 27 || out_size != MTOK * DM || ws_size < WS_TOTAL) { fprintf(stderr, "kernel_launch: unexpected shapes (n_in %d out %d ws %zu)\n", n_in, out_size, ws_size); grid = -1; return; }
        int dev = 0, cus = 0; (void)hipGetDevice(&dev); (void)hipDeviceGetAttribute(&cus, hipDeviceAttributeMultiprocessorCount, dev);
        bool ok = true;
#if ONE_LAUNCH
        ok = ok && hipFuncSetAttribute((const void*)fwd_kernel<0, NPHASE>, hipFuncAttributeMaxDynamicSharedMemorySize, LDS_BYTES) == hipSuccess;
        int per_cu = 0; (void)hipOccupancyMaxActiveBlocksPerMultiprocessor(&per_cu, (const void*)fwd_kernel<0, NPHASE>, NTHR, LDS_BYTES); (void)hipGetLastError();
        if (per_cu < 1) fprintf(stderr, "kernel_launch: occupancy query says %d blocks/CU\n", per_cu);
#else
#define SETA(p) ok = ok && hipFuncSetAttribute((const void*)fwd_kernel<p, p + 1>, hipFuncAttributeMaxDynamicSharedMemorySize, LDS_BYTES) == hipSuccess;
        SETA(0) SETA(1) SETA(2) SETA(3) SETA(4) SETA(5) SETA(6) SETA(7) SETA(8) SETA(9)
#undef SETA
#endif
        if (!ok) { fprintf(stderr, "kernel_launch: hipFuncSetAttribute failed\n"); grid = -1; return; }
        grid = cus > 256 ? 256 : cus;
    }
    if (grid < 0) return;
    Args a{};
    for (int i = 0; i < 27; ++i) a.in[i] = (const float*)d_in[i];
    a.out = (float*)d_out; a.ws = (unsigned char*)d_ws;
#if ONE_LAUNCH
    a.ph_lo = 0; a.ph_hi = NPHASE;
#if !USE_CG
    if (hipMemsetAsync((char*)d_ws + WS_CTL, 0, CTL_ZERO_BYTES, stream) != hipSuccess) { fprintf(stderr, "kernel_launch: hipMemsetAsync failed\n"); return; }
#endif
    void* args[] = {&a};
    hipError_t e = hipLaunchCooperativeKernel((const void*)fwd_kernel<0, NPHASE>, dim3(grid), dim3(NTHR), args, LDS_BYTES, stream);
    if (e != hipSuccess) fprintf(stderr, "cooperative launch failed: %s (grid %d)\n", hipGetErrorString(e), grid);
#else
#define LAUNCH(p) hipLaunchKernelGGL((fwd_kernel<p, p + 1>), dim3(grid), dim3(NTHR), LDS_BYTES, stream, a);
    LAUNCH(0) LAUNCH(1) LAUNCH(2) LAUNCH(3) LAUNCH(4) LAUNCH(5) LAUNCH(6) LAUNCH(7) LAUNCH(8) LAUNCH(9)
#undef LAUNCH
#endif
}
```

```cpp
#include <hip/hip_runtime.h>
#include <hip/hip_cooperative_groups.h>
#include <cstdio>
#include <cstdint>
namespace cg = cooperative_groups;

#ifndef ONE_LAUNCH
#define ONE_LAUNCH 1
#endif
#ifndef USE_CG
#define USE_CG 0
#endif
#ifndef PROBE_SEG
#define PROBE_SEG -1
#endif
#ifndef PROBE_S1
#define PROBE_S1 -1
#endif
#ifndef PROBE_ATT
#define PROBE_ATT 0
#endif
#ifndef PROBE_CLK
#define PROBE_CLK -1
#endif
#ifndef PROBE_DOUBLE
#define PROBE_DOUBLE 0
#endif

#define LAS __attribute__((address_space(3)))
#define GAS __attribute__((address_space(1)))
typedef unsigned short bf16_t;
typedef short bf16x8 __attribute__((ext_vector_type(8)));
typedef short s16x4 __attribute__((ext_vector_type(4)));
typedef float f32x4 __attribute__((ext_vector_type(4)));
typedef float f32x16 __attribute__((ext_vector_type(16)));
typedef unsigned u32x4 __attribute__((ext_vector_type(4)));
typedef unsigned u32x2 __attribute__((ext_vector_type(2)));
typedef float f32x2_t __attribute__((ext_vector_type(2)));
typedef __bf16 bf16x2_t __attribute__((ext_vector_type(2)));

constexpr int MTOK = 32768, DM = 1024, ZP = 3328, DFF = 4096;
constexpr int SP = 16384, SS = 2048;
constexpr int ZQ = 0, ZK = 512, ZV = 1024, ZRR = 1536, ZRK = 2048, ZRV = 2560, ZWD = 3072, ZAD = 3136, ZGD = 3200;
constexpr int ZXN2 = 2048;
constexpr float NORM_EPS = 1e-6f, LNX_EPS = 64e-5f;
constexpr float QSCALE = 0.125f * 1.4426950408889634f;
constexpr float LAMBDA_INIT = 0.2f;
constexpr int NCHUNK_P = SP / 64, NCHUNK_S = SS / 64;

constexpr size_t MiB = 1u << 20;
constexpr size_t WS_CTL = 0;
constexpr size_t WS_WIN = 1 * MiB, WS_WOUT = 8 * MiB, WS_W1 = 10 * MiB, WS_W2 = 18 * MiB;
constexpr size_t WS_ROPE = 26 * MiB;
constexpr size_t WS_LORA = 30 * MiB;
constexpr size_t WS_ROWSQ = 31 * MiB;
constexpr size_t WS_BONUS = 33 * MiB;
constexpr size_t WS_Z = 36 * MiB;
constexpr size_t WS_END = 244 * MiB;
constexpr size_t WS_E1 = 244 * MiB;
constexpr size_t WS_TOTAL = 252 * MiB;
static_assert(WS_Z + (size_t)MTOK * ZP * 2 <= WS_END, "ws map");
constexpr size_t SLOT_BYTES = 32768;

__device__ __forceinline__ unsigned cvt_pk_bf16(float lo, float hi) { f32x2_t v = {lo, hi}; bf16x2_t b = __builtin_convertvector(v, bf16x2_t); return __builtin_bit_cast(unsigned, b); }
__device__ __forceinline__ float bf2f(unsigned short u) { return __uint_as_float(((unsigned)u) << 16); }
__device__ __forceinline__ float bflo(unsigned u) { return __uint_as_float(u << 16); }
__device__ __forceinline__ float bfhi(unsigned u) { return __uint_as_float(u & 0xffff0000u); }
__device__ __forceinline__ unsigned short f2bf(float f) { return (unsigned short)(cvt_pk_bf16(f, 0.f) & 0xffffu); }
__device__ __forceinline__ float wave_sum(float v) {
#pragma unroll
    for (int o = 1; o < 64; o <<= 1) v += __shfl_xor(v, o);
    return v;
}
__device__ __forceinline__ float wave_sum_dpp(float v) {
    int x = __float_as_int(v);
    v += __int_as_float(__builtin_amdgcn_update_dpp(0, x, 0xB1, 0xF, 0xF, true)); x = __float_as_int(v);
    v += __int_as_float(__builtin_amdgcn_update_dpp(0, x, 0x4E, 0xF, 0xF, true)); x = __float_as_int(v);
    v += __int_as_float(__builtin_amdgcn_update_dpp(0, x, 0x124, 0xF, 0xF, true)); x = __float_as_int(v);
    v += __int_as_float(__builtin_amdgcn_update_dpp(0, x, 0x128, 0xF, 0xF, true)); x = __float_as_int(v);
    const float a = __int_as_float(__builtin_amdgcn_readlane(x, 0)), b = __int_as_float(__builtin_amdgcn_readlane(x, 16)), c = __int_as_float(__builtin_amdgcn_readlane(x, 32)), d = __int_as_float(__builtin_amdgcn_readlane(x, 48));
    return (a + b) + (c + d);
}
__device__ __forceinline__ void wave_sum8(float (&s)[8], int lane) {
    float f[4];
#pragma unroll
    for (int i = 0; i < 4; ++i) { auto rr = __builtin_amdgcn_permlane32_swap(__float_as_uint(s[i]), __float_as_uint(s[i + 4]), false, false); f[i] = __uint_as_float(rr[0]) + __uint_as_float(rr[1]); }
    const bool b4 = (lane >> 4) & 1, b3 = (lane >> 3) & 1;
    float g[2];
#pragma unroll
    for (int i = 0; i < 2; ++i) { const float keep = b4 ? f[i + 2] : f[i], send = b4 ? f[i] : f[i + 2];
        g[i] = keep + __int_as_float(__builtin_amdgcn_ds_swizzle(__float_as_int(send), 0x401F)); }
    const float keep = b3 ? g[1] : g[0], send = b3 ? g[0] : g[1];
    float h = keep + __int_as_float(__builtin_amdgcn_update_dpp(0, __float_as_int(send), 0x128, 0xF, 0xF, true));
    h += __int_as_float(__builtin_amdgcn_update_dpp(0, __float_as_int(h), 0x141, 0xF, 0xF, true));
    h += __int_as_float(__builtin_amdgcn_update_dpp(0, __float_as_int(h), 0xB1, 0xF, 0xF, true));
    h += __int_as_float(__builtin_amdgcn_update_dpp(0, __float_as_int(h), 0x4E, 0xF, 0xF, true));
    const int hx = __float_as_int(h);
#pragma unroll
    for (int k = 0; k < 8; ++k) s[k] = __int_as_float(__builtin_amdgcn_readlane(hx, 8 * k));
}
#define LDS_WAIT() asm volatile("s_waitcnt lgkmcnt(0)" ::: "memory")
#define VM_WAIT() asm volatile("s_waitcnt vmcnt(0)" ::: "memory")
#define LBAR() asm volatile("s_waitcnt lgkmcnt(0)\n\ts_barrier" ::: "memory")

namespace pg8 {
constexpr int BM = 256, BK = 64, HALF = 128, HTB = HALF * BK * 2, STAGE_BYTES = 8 * HTB, NXCD = 8, WGM = 8;
__host__ __device__ __forceinline__ int lds_byte(int r, int c) { const int st = (r >> 4) * 2 + (c >> 5), rr = r & 15, cc = c & 31, ob = rr * 64 + cc * 2; return st * 1024 + (ob ^ (((ob >> 9) & 1) << 5)); }
__host__ __device__ __forceinline__ void stage_rc(int b, int& R, int& C) { const int st = b / 1024, sb = b % 1024, swz = sb ^ (((sb >> 9) & 1) << 5); R = (st >> 1) * 16 + swz / 64; C = (st & 1) * 32 + (swz % 64) / 2; }
__host__ __device__ __forceinline__ int perm32(int rho) { const int n = rho >> 4, i = rho & 15; return 8 * (i >> 2) + 4 * n + (i & 3); }
struct Unit { int pm, pn; };
struct Gemm { const char* A; const bf16_t* Bt; int M, N, K; int lda; int jkt; int jbytes; };
struct StaticOrder {
    int nM, nN, nwg, G, c;
    __host__ __device__ void init(int M, int N, int G_, int c_) { nM = M / BM; nN = N / BM; nwg = nM * nN; G = G_; c = c_; }
    __host__ __device__ bool next(int i, Unit& u) const {
        const long L = (long)i * G + c; if (L >= nwg) return false;
        int wgid = (int)L; { const int q = nwg / NXCD, r = nwg % NXCD, xcd = wgid % NXCD, off = wgid / NXCD; wgid = (xcd < r ? xcd * (q + 1) : r * (q + 1) + (xcd - r) * q) + off; }
        const int nig = WGM * nN, gid = wgid / nig, fm = gid * WGM, gsz = (nM - fm) < WGM ? (nM - fm) : WGM;
        u.pm = fm + ((wgid % nig) % gsz); u.pn = (wgid % nig) / gsz; return true;
    }
};

struct EpiZ {
    static constexpr bool PERM = true;
    bf16_t* O; int ldc;
    __device__ __forceinline__ void operator()(const f32x4 (&acc)[2][2][4][2], const Unit& u, int wr, int wc, int fr, int fq) const {
        const int row0 = u.pm * BM + wr * 64 + fr, col0 = u.pn * BM + wc * 32 + 8 * fq;
#pragma unroll
        for (int ai = 0; ai < 2; ++ai)
#pragma unroll
            for (int m = 0; m < 4; ++m) { bf16_t* rowp = O + (size_t)(row0 + ai * HALF + m * 16) * ldc + col0;
#pragma unroll
                for (int bj = 0; bj < 2; ++bj) { const f32x4 v0 = acc[ai][bj][m][0], v1 = acc[ai][bj][m][1];
                    u32x4 w; w.x = cvt_pk_bf16(v0[0], v0[1]); w.y = cvt_pk_bf16(v0[2], v0[3]); w.z = cvt_pk_bf16(v1[0], v1[1]); w.w = cvt_pk_bf16(v1[2], v1[3]);
                    *(u32x4*)(rowp + bj * HALF) = w; } }
    }
};
struct EpiOut {
    static constexpr bool PERM = true;
    const float* xp; const float* xs; float* out; bf16_t* Z; float* rowsq;
    __device__ __forceinline__ void operator()(const f32x4 (&acc)[2][2][4][2], const Unit& u, int wr, int wc, int fr, int fq) const {
        const int col0 = u.pn * BM + wc * 32 + 8 * fq;
#pragma unroll
        for (int ai = 0; ai < 2; ++ai)
#pragma unroll
            for (int m = 0; m < 4; ++m) { const int r = u.pm * BM + ai * HALF + wr * 64 + m * 16 + fr;
                const float* xr = (r < SP ? xp + (size_t)r * DM : xs + (size_t)(r - SP) * DM) + col0; float* orow = out + (size_t)r * DM + col0; bf16_t* zr = Z + (size_t)r * ZP + ZXN2 + col0;
                float ss = 0.f;
#pragma unroll
                for (int bj = 0; bj < 2; ++bj) { const f32x4 x0 = *(const f32x4*)(xr + bj * HALF), x1 = *(const f32x4*)(xr + bj * HALF + 4);
                    const f32x4 o0 = x0 + acc[ai][bj][m][0], o1 = x1 + acc[ai][bj][m][1];
                    *(f32x4*)(orow + bj * HALF) = o0; *(f32x4*)(orow + bj * HALF + 4) = o1;
                    ss += ((o0[0] * o0[0] + o0[1] * o0[1]) + (o0[2] * o0[2] + o0[3] * o0[3])) + ((o1[0] * o1[0] + o1[1] * o1[1]) + (o1[2] * o1[2] + o1[3] * o1[3]));
                    u32x4 w; w.x = cvt_pk_bf16(o0[0], o0[1]); w.y = cvt_pk_bf16(o0[2], o0[3]); w.z = cvt_pk_bf16(o1[0], o1[1]); w.w = cvt_pk_bf16(o1[2], o1[3]); *(u32x4*)(zr + bj * HALF) = w; }
                ss += __shfl_xor(ss, 16); ss += __shfl_xor(ss, 32);
                if (fq == 0) rowsq[(size_t)r * 16 + u.pn * 4 + wc] = ss;
                if (m & 1) asm volatile("" ::: "memory"); }
    }
};
struct EpiUp {
    static constexpr bool PERM = true;
    char* H; const float* rowsq; int row_off;
    __device__ __forceinline__ void operator()(const f32x4 (&acc)[2][2][4][2], const Unit& u, int wr, int wc, int fr, int fq) const {
        const int row0 = u.pm * BM + wr * 64 + fr, col0 = u.pn * BM + wc * 32 + 8 * fq;
#pragma unroll
        for (int ai = 0; ai < 2; ++ai)
#pragma unroll
            for (int m = 0; m < 4; ++m) { const int r = row0 + ai * HALF + m * 16; const f32x4* rq = (const f32x4*)(rowsq + (size_t)(row_off + r) * 16);
                const f32x4 q0 = rq[0], q1 = rq[1], q2 = rq[2], q3 = rq[3];
                const float ssum = ((q0[0] + q0[1]) + (q0[2] + q0[3])) + ((q1[0] + q1[1]) + (q1[2] + q1[3])) + ((q2[0] + q2[1]) + (q2[2] + q2[3])) + ((q3[0] + q3[1]) + (q3[2] + q3[3]));
                const float rstd = __builtin_amdgcn_rsqf(ssum * (1.0f / DM) + NORM_EPS);
                char* rowp = H + (size_t)r * 13312;
#pragma unroll
                for (int bj = 0; bj < 2; ++bj) { const int c = col0 + bj * HALF; f32x4 v0 = acc[ai][bj][m][0] * rstd, v1 = acc[ai][bj][m][1] * rstd;
#pragma unroll
                    for (int e = 0; e < 4; ++e) { const float a = fmaxf(v0[e], 0.f), b = fmaxf(v1[e], 0.f); v0[e] = a * a; v1[e] = b * b; }
                    u32x4 w; w.x = cvt_pk_bf16(v0[0], v0[1]); w.y = cvt_pk_bf16(v0[2], v0[3]); w.z = cvt_pk_bf16(v1[0], v1[1]); w.w = cvt_pk_bf16(v1[2], v1[3]);
                    *(u32x4*)(rowp + (size_t)c * 2 + (c >= 2048 ? 2560 : 0)) = w; } }
    }
};
struct EpiDown {
    static constexpr bool PERM = true;
    float* out; int row_off;
    __device__ __forceinline__ void operator()(const f32x4 (&acc)[2][2][4][2], const Unit& u, int wr, int wc, int fr, int fq) const {
        const int col0 = u.pn * BM + wc * 32 + 8 * fq;
#pragma unroll
        for (int ai = 0; ai < 2; ++ai)
#pragma unroll
            for (int m = 0; m < 4; ++m) { const int r = row_off + u.pm * BM + ai * HALF + wr * 64 + m * 16 + fr; float* orow = out + (size_t)r * DM + col0;
#pragma unroll
                for (int bj = 0; bj < 2; ++bj) { const f32x4 x0 = *(const f32x4*)(orow + bj * HALF), x1 = *(const f32x4*)(orow + bj * HALF + 4);
                    *(f32x4*)(orow + bj * HALF) = x0 + acc[ai][bj][m][0]; *(f32x4*)(orow + bj * HALF + 4) = x1 + acc[ai][bj][m][1]; }
                if (m & 1) asm volatile("" ::: "memory"); }
    }
};

template <class Epi, class Sched, bool ALIGN_EPI>
__device__ __forceinline__ void gemm_phase(LAS unsigned char* lds, const Gemm g, const Sched& S, const Epi& E) {
    int tid_ = threadIdx.x; asm volatile("" : "+v"(tid_));
    const int tid = tid_, wid = __builtin_amdgcn_readfirstlane(tid >> 6), lane = tid & 63, wr = wid >> 2, wc = wid & 3, fr = lane & 15, fq = lane >> 4;
    const int K = g.K, nt = K / BK;
    unsigned voffA[2], voffB[2];
#pragma unroll
    for (int i = 0; i < 2; ++i) { int R, C; stage_rc(tid * 16 + i * 8192, R, C); const int Rb = Epi::PERM ? ((R & ~31) + perm32(R & 31)) : R;
        voffA[i] = (unsigned)(R * g.lda + C * 2); voffB[i] = (unsigned)(Rb * K + C) * 2u; }
    const size_t kstep = (size_t)(BK * 2);
    const size_t hstepA = (size_t)HALF * g.lda, tstepA = 2 * hstepA;
    const size_t hstepB = (size_t)HALF * K * 2, tstepB = 2 * hstepB;
    const unsigned ldsw = (unsigned)wid * 1024u;
    const int aoff = lds_byte(wr * 64 + fr, fq * 8), boff = lds_byte(wc * 32 + fr, fq * 8);
#define PG8_AOFF(kt) ((size_t)(kt) * kstep + ((kt) >= g.jkt ? (size_t)g.jbytes : (size_t)0))
#define PG8_SA(b, h) (((b) * 2 + (h)) * HTB)
#define PG8_SB(b, h) ((4 + (b) * 2 + (h)) * HTB)
#define PG8_STAGE(bufoff, gbase, voff) do { _Pragma("unroll") for (int _i = 0; _i < 2; ++_i) \
        __builtin_amdgcn_global_load_lds((const unsigned*)((const char*)(gbase) + (voff)[_i]), (LAS unsigned*)(lds + (bufoff) + ldsw + _i * 8192), 16, 0, 0); } while (0)
#define PG8_LDA(dst, b, h) do { _Pragma("unroll") for (int m = 0; m < 4; ++m) _Pragma("unroll") for (int k = 0; k < 2; ++k) dst[m][k] = *(const LAS bf16x8*)(lds + PG8_SA(b, h) + aoff + m * 2048 + k * 1024); } while (0)
#define PG8_LDB(dst, b, h) do { _Pragma("unroll") for (int n = 0; n < 2; ++n) _Pragma("unroll") for (int k = 0; k < 2; ++k) dst[n][k] = *(const LAS bf16x8*)(lds + PG8_SB(b, h) + boff + n * 2048 + k * 1024); } while (0)
#define PG8_MMA(ai, bj, At, Bt) do { __builtin_amdgcn_s_setprio(1); _Pragma("unroll") for (int m = 0; m < 4; ++m) _Pragma("unroll") for (int n = 0; n < 2; ++n) _Pragma("unroll") for (int k = 0; k < 2; ++k) \
        acc[ai][bj][m][n] = __builtin_amdgcn_mfma_f32_16x16x32_bf16(Bt[n][k], At[m][k], acc[ai][bj][m][n], 0, 0, 0); __builtin_amdgcn_s_setprio(0); } while (0)
#define PG8_WAIT_V(n) asm volatile("s_waitcnt vmcnt(" #n ")" ::: "memory")
#define PG8_WAIT_L(n) asm volatile("s_waitcnt lgkmcnt(" #n ")" ::: "memory")
#define PG8_BAR __builtin_amdgcn_s_barrier()
#define PG8_SCHED __builtin_amdgcn_sched_barrier(0)
    Unit cur, nxt; int ui = 0;
    if (!S.next(0, cur)) return;
    f32x4 acc[2][2][4][2];
#pragma unroll
    for (int a = 0; a < 2; ++a)
#pragma unroll
        for (int b = 0; b < 2; ++b)
#pragma unroll
            for (int m = 0; m < 4; ++m)
#pragma unroll
                for (int n = 0; n < 2; ++n) acc[a][b][m][n] = (f32x4){0.f, 0.f, 0.f, 0.f};
    bf16x8 At[4][2], B0[2][2], B1[2][2];
    const char* cA = g.A + (size_t)cur.pm * tstepA; const char* cB = (const char*)g.Bt + (size_t)cur.pn * tstepB;
    {
        PG8_STAGE(PG8_SB(0, 0), cB, voffB); PG8_STAGE(PG8_SB(0, 1), cB + hstepB, voffB); PG8_STAGE(PG8_SA(0, 0), cA + PG8_AOFF(0), voffA); PG8_STAGE(PG8_SA(0, 1), cA + hstepA + PG8_AOFF(0), voffA);
        if (wr == 1) PG8_BAR;
        PG8_WAIT_V(2); PG8_BAR;
        PG8_STAGE(PG8_SB(1, 0), cB + kstep, voffB); PG8_STAGE(PG8_SA(1, 0), cA + PG8_AOFF(1), voffA); PG8_STAGE(PG8_SB(1, 1), cB + hstepB + kstep, voffB);
        PG8_WAIT_V(6); PG8_BAR;
    }
    for (;;) {
        const bool has_next = S.next(ui + 1, nxt);
        const char* nA = has_next ? g.A + (size_t)nxt.pm * tstepA : cA; const char* nB = has_next ? (const char*)g.Bt + (size_t)nxt.pn * tstepB : cB;
        for (int t = 0; t < nt; t += 2) {
            const bool last = (t == nt - 2);
            const char* a1 = cA + PG8_AOFF(t + 1);
            const char* a2 = last ? nA + PG8_AOFF(0) : cA + PG8_AOFF(t + 2); const char* b2 = last ? nB : cB + (size_t)(t + 2) * kstep;
            const char* a3 = last ? nA + PG8_AOFF(1) : cA + PG8_AOFF(t + 3); const char* b3 = b2 + kstep;
            PG8_LDB(B0, 0, 0); PG8_LDB(B1, 0, 1); PG8_SCHED; PG8_LDA(At, 0, 0); PG8_STAGE(PG8_SA(1, 1), a1 + hstepA, voffA);
            PG8_WAIT_V(8); PG8_WAIT_L(0); PG8_BAR; PG8_MMA(0, 0, At, B0); PG8_MMA(0, 1, At, B1); PG8_BAR; PG8_SCHED;
            PG8_LDA(At, 0, 1); PG8_STAGE(PG8_SB(0, 0), b2, voffB); PG8_STAGE(PG8_SB(0, 1), b2 + hstepB, voffB); PG8_STAGE(PG8_SA(0, 0), a2, voffA);
            PG8_WAIT_V(8); PG8_WAIT_L(0); PG8_BAR; PG8_MMA(1, 0, At, B0); PG8_MMA(1, 1, At, B1); PG8_BAR; PG8_SCHED;
            PG8_LDB(B0, 1, 0); PG8_LDB(B1, 1, 1); PG8_SCHED; PG8_LDA(At, 1, 0); PG8_STAGE(PG8_SA(0, 1), a2 + hstepA, voffA);
            PG8_WAIT_V(8); PG8_WAIT_L(0); PG8_BAR; PG8_MMA(0, 0, At, B0); PG8_MMA(0, 1, At, B1); PG8_BAR; PG8_SCHED;
            PG8_LDA(At, 1, 1); PG8_STAGE(PG8_SB(1, 0), b3, voffB); PG8_STAGE(PG8_SB(1, 1), b3 + hstepB, voffB); PG8_STAGE(PG8_SA(1, 0), a3, voffA);
            PG8_WAIT_V(8); PG8_WAIT_L(0); PG8_BAR; PG8_MMA(1, 0, At, B0); PG8_MMA(1, 1, At, B1); PG8_BAR; PG8_SCHED;
        }
        if constexpr (ALIGN_EPI) { if (wr == 0) PG8_BAR; }
        E(acc, cur, wr, wc, fr, fq);
        if (!has_next) break;
#pragma unroll
        for (int a = 0; a < 2; ++a)
#pragma unroll
            for (int b = 0; b < 2; ++b)
#pragma unroll
                for (int m = 0; m < 4; ++m)
#pragma unroll
                    for (int n = 0; n < 2; ++n) acc[a][b][m][n] = (f32x4){0.f, 0.f, 0.f, 0.f};
        cur = nxt; cA = nA; cB = nB; ++ui;
        if constexpr (ALIGN_EPI) { if (wr == 1) PG8_BAR; }
    }
    PG8_WAIT_V(0);
    if constexpr (!ALIGN_EPI) { if (wr == 0) PG8_BAR; }
    PG8_BAR;
#undef PG8_AOFF
#undef PG8_SA
#undef PG8_SB
#undef PG8_STAGE
#undef PG8_LDA
#undef PG8_LDB
#undef PG8_MMA
#undef PG8_WAIT_V
#undef PG8_WAIT_L
#undef PG8_BAR
#undef PG8_SCHED
}
}

constexpr int NWAVES = 8, NTHR = 512;
constexpr int LDS_BYTES = 163840;
struct Args {
    const float* in[27]; float* out; unsigned char* ws; int ph_lo, ph_hi;
};
struct Frame {
    LAS unsigned char* lds; int tid, lane, wave, vcu, G;
};
constexpr int PTRS_OFF = LDS_BYTES - 256;
__device__ __forceinline__ const float* inp(LAS unsigned char* lds, int i) { return *(const float* LAS*)(lds + PTRS_OFF + i * 8); }
__device__ __forceinline__ float gld(const float* p) { return *(const GAS float*)p; }
__device__ __forceinline__ int seq_row0(int q) { return q == 0 ? 0 : SP + (q - 1) * SS; }
__device__ __forceinline__ int seq_len(int q) { return q == 0 ? SP : SS; }

__device__ __forceinline__ void p0_transpose_item(const float* W, int K, int N, bf16_t* WT, const float* kscale, LAS float* scr, int item, int lane) {
    const int nblk = N / 32, kb = item / nblk, nb = item % nblk, k0 = 64 * kb, n0 = 32 * nb;
#pragma unroll 8
    for (int i = 0; i < 32; ++i) { const int kk = 2 * i + (lane >> 5); float v = W[(size_t)(k0 + kk) * N + n0 + (lane & 31)]; if (kscale) v *= kscale[k0 + kk]; scr[kk * 33 + (lane & 31)] = v; }
    LDS_WAIT(); asm volatile("" ::: "memory");
    const int c = lane & 7;
#pragma unroll
    for (int j = 0; j < 4; ++j) { const int n = (lane >> 3) + 8 * j; const LAS float* s = scr + (8 * c) * 33 + n;
        u32x4 o; o.x = cvt_pk_bf16(s[0 * 33], s[1 * 33]); o.y = cvt_pk_bf16(s[2 * 33], s[3 * 33]); o.z = cvt_pk_bf16(s[4 * 33], s[5 * 33]); o.w = cvt_pk_bf16(s[6 * 33], s[7 * 33]);
        *(u32x4*)(WT + (size_t)(n0 + n) * K + k0 + 8 * c) = o; }
    LDS_WAIT(); asm volatile("" ::: "memory");
}
__device__ __forceinline__ void p0_prologue(const Frame& F, const Args& a) {
    LAS float* scr = (LAS float*)(F.lds + F.wave * 16384);
    const int gw = F.vcu * NWAVES + F.wave, NGW = F.G * NWAVES;
    unsigned char* ws = a.ws;
    constexpr int I_IN = (DM / 64) * (ZP / 32), I_O = (DM / 64) * (DM / 32), I_1 = (DM / 64) * (DFF / 32), I_2 = (DFF / 64) * (DM / 32);
    for (int it = gw; it < I_IN + I_O + I_1 + I_2; it += NGW) {
        int r = it;
        if (r < I_IN) { p0_transpose_item(a.in[3], DM, ZP, (bf16_t*)(ws + WS_WIN), nullptr, scr, r, F.lane); continue; } r -= I_IN;
        if (r < I_O) { p0_transpose_item(a.in[23], DM, DM, (bf16_t*)(ws + WS_WOUT), nullptr, scr, r, F.lane); continue; } r -= I_O;
        if (r < I_1) { p0_transpose_item(a.in[25], DM, DFF, (bf16_t*)(ws + WS_W1), a.in[24], scr, r, F.lane); continue; } r -= I_1;
        p0_transpose_item(a.in[26], DFF, DM, (bf16_t*)(ws + WS_W2), nullptr, scr, r, F.lane);
    }
    bf16_t* XN = (bf16_t*)a.out; const float* g1 = a.in[2];
    for (int m = gw; m < MTOK; m += NGW) {
        const float* xrow = m < SP ? a.in[0] + (size_t)m * DM : a.in[1] + (size_t)(m - SP) * DM;
        const f32x4* xr = (const f32x4*)xrow + F.lane; f32x4 v[4]; float s = 0.f;
#pragma unroll
        for (int j = 0; j < 4; ++j) { v[j] = xr[64 * j]; s += (v[j][0] * v[j][0] + v[j][1] * v[j][1]) + (v[j][2] * v[j][2] + v[j][3] * v[j][3]); }
        const float rstd = 1.0f / sqrtf(wave_sum(s) * (1.f / DM) + NORM_EPS);
        u32x2* o8 = (u32x2*)(XN + (size_t)m * DM) + F.lane;
#pragma unroll
        for (int j = 0; j < 4; ++j) { const f32x4 gv = ((const f32x4*)g1)[F.lane + 64 * j]; u32x2 w; w.x = cvt_pk_bf16(v[j][0] * rstd * gv[0], v[j][1] * rstd * gv[1]); w.y = cvt_pk_bf16(v[j][2] * rstd * gv[2], v[j][3] * rstd * gv[3]); o8[64 * j] = w; }
    }
    const int gt = F.vcu * NTHR + F.tid, NGT = F.G * NTHR;
    float* rope = (float*)(ws + WS_ROPE);
    for (int e = gt; e < SP * 32; e += NGT) { const int pos = e >> 5, i = e & 31;
        const float invf = 1.0f / powf(10000.0f, (float)(2 * i) / 64.0f); const float ang = (float)pos * invf; float sn, cs; sincosf(ang, &sn, &cs);
        rope[2 * e] = cs; rope[2 * e + 1] = sn; }
    bf16_t* wupT = (bf16_t*)(ws + WS_LORA); bf16_t* aupT = wupT + 2 * 512 * 64; bf16_t* gupT = aupT + 2 * 512 * 64;
    for (int e = gt; e < 2 * 512 * 64; e += NGT) { const int d = e >> 15, c = (e >> 6) & 511, r = e & 63;
        wupT[e] = f2bf(a.in[14][((size_t)d * 64 + r) * 512 + c]); aupT[e] = f2bf(a.in[16][((size_t)d * 64 + r) * 512 + c]); }
    for (int e = gt; e < 512 * 128; e += NGT) { const int c = e >> 7, r = e & 127; gupT[e] = f2bf(a.in[17][(size_t)r * 512 + c]); }
}

__device__ __forceinline__ void qk_prep(const Frame& F, const Args& a) {
    const int gw = F.vcu * NWAVES + F.wave, NGW = F.G * NWAVES;
    bf16_t* Z = (bf16_t*)(a.ws + WS_Z); const float* rope = (const float*)(a.ws + WS_ROPE);
    const int g = F.lane >> 2, qd = F.lane & 3;
    const float* gain = (g < 8) ? a.in[4] : a.in[5];
    float glo[8], ghi[8];
#pragma unroll
    for (int j = 0; j < 8; ++j) { glo[j] = gain[8 * qd + j]; ghi[j] = gain[32 + 8 * qd + j]; }
    const float osc = (g < 8) ? QSCALE : 1.0f;
    const float mpw = a.in[11][ZWD - ZRR + F.lane], mnw = a.in[12][ZWD - ZRR + F.lane], mpa = a.in[11][ZAD - ZRR + F.lane], mna = a.in[12][ZAD - ZRR + F.lane];
    for (int blk = gw; blk < MTOK / 16; blk += NGW) {
        const int m0 = blk * 16;
        const int pos0 = m0 < SP ? m0 : ((m0 - SP) & (SS - 1)); const int S = m0 < SP ? SP : SS;
        {
            float zw[18], za[18]; const bf16_t* zr = Z + (size_t)m0 * ZP; const int j = F.lane;
#pragma unroll
            for (int i = 0; i < 18; ++i) { const int pp = pos0 - 1 + i; const bool ok = pp >= 0 && pp < S; const long ro = (long)(ok ? i - 1 : 0) * ZP;
                const float w_ = bf2f(zr[ro + ZWD + j]), a_ = bf2f(zr[ro + ZAD + j]); zw[i] = ok ? w_ : 0.f; za[i] = ok ? a_ : 0.f; }
            bf16_t* e1 = (bf16_t*)(a.ws + WS_E1) + (size_t)m0 * 128;
#pragma unroll
            for (int i = 0; i < 16; ++i) { const float wc = zw[i + 1], ac = za[i + 1];
                const float ws_ = wc + mpw * (zw[i] - wc) + mnw * (zw[i + 2] - wc), as_ = ac + mpa * (za[i] - ac) + mna * (za[i + 2] - ac);
                e1[i * 128 + j] = f2bf(1.0f - 2.0f * __builtin_amdgcn_rcpf(__expf(2.0f * ws_) + 1.0f)); e1[i * 128 + 64 + j] = f2bf(as_); }
        }
#pragma unroll 4
        for (int i = 0; i < 16; ++i) {
            const int m = m0 + i, pos = pos0 + i;
            bf16_t* p = Z + (size_t)m * ZP + g * 64 + 8 * qd;
            const u32x4 lo4 = *(const u32x4*)p, hi4 = *(const u32x4*)(p + 32);
            float lo[8], hi[8];
#pragma unroll
            for (int j = 0; j < 4; ++j) { lo[2 * j] = bflo(lo4[j]); lo[2 * j + 1] = bfhi(lo4[j]); hi[2 * j] = bflo(hi4[j]); hi[2 * j + 1] = bfhi(hi4[j]); }
            float ss = 0.f;
#pragma unroll
            for (int j = 0; j < 8; ++j) ss += lo[j] * lo[j] + hi[j] * hi[j];
            ss += __shfl_xor(ss, 1); ss += __shfl_xor(ss, 2);
            const float rstd = __builtin_amdgcn_rsqf(ss * (1.f / 64.f) + NORM_EPS);
            const f32x4* rp = (const f32x4*)(rope + ((size_t)pos * 32 + 8 * qd) * 2);
            float ol[8], oh[8];
#pragma unroll
            for (int j2 = 0; j2 < 4; ++j2) { const f32x4 cs = rp[j2];
#pragma unroll
                for (int e = 0; e < 2; ++e) { const int j = 2 * j2 + e; const float c = cs[2 * e], sn = cs[2 * e + 1]; const float l = lo[j] * rstd * glo[j], h = hi[j] * rstd * ghi[j];
                    ol[j] = (l * c - h * sn) * osc; oh[j] = (h * c + l * sn) * osc; } }
            u32x4 wl, wh;
#pragma unroll
            for (int j = 0; j < 4; ++j) { wl[j] = cvt_pk_bf16(ol[2 * j], ol[2 * j + 1]); wh[j] = cvt_pk_bf16(oh[2 * j], oh[2 * j + 1]); }
            *(u32x4*)p = wl; *(u32x4*)(p + 32) = wh;
        }
    }
}

namespace att {
constexpr int KSLOT = 8192, VSLOT = 16384, NKS = 4, NVS = 3;
constexpr int L_K = 0, L_V = NKS * KSLOT, L_WS = L_V + NVS * VSLOT, L_ST = L_WS + NWAVES * 256, L_END = L_ST + NWAVES * 8192;
static_assert(L_END <= PTRS_OFF, "attention lds");
__device__ __forceinline__ int crow(int r, int hi) { return (r & 3) + 8 * (r >> 2) + 4 * hi; }
__device__ __forceinline__ void glds16(const void* gsrc, unsigned lds_dst) { unsigned keep;
    asm volatile("s_mov_b32 %0, m0\n\ts_mov_b32 m0, %2\n\ts_nop 0\n\tglobal_load_lds_dwordx4 %1, off\n\ts_mov_b32 m0, %0" : "=&s"(keep) : "v"(gsrc), "s"(lds_dst) : "memory"); }
typedef short v4i16_t __attribute__((ext_vector_type(4)));
typedef const LAS char* lds_cptr;
__device__ __forceinline__ s16x4 vtr(lds_cptr p) { return __builtin_bit_cast(s16x4, __builtin_amdgcn_ds_read_tr16_b64_v4i16((LAS v4i16_t*)p)); }
#define SBAR() __builtin_amdgcn_sched_barrier(0)
#define WAIT_BAR(N) asm volatile("s_waitcnt vmcnt(" #N ") lgkmcnt(0)\n\ts_barrier" ::: "memory")
__device__ __forceinline__ void kload8(bf16x8* kf, lds_cptr kp) {
    kf[0] = *(const LAS bf16x8*)(kp);        kf[1] = *(const LAS bf16x8*)(kp + 512);
    kf[2] = *(const LAS bf16x8*)(kp + 2048); kf[3] = *(const LAS bf16x8*)(kp + 2560);
    kf[4] = *(const LAS bf16x8*)(kp + 4096); kf[5] = *(const LAS bf16x8*)(kp + 4608);
    kf[6] = *(const LAS bf16x8*)(kp + 6144); kf[7] = *(const LAS bf16x8*)(kp + 6656);
}
__device__ __forceinline__ void kload2(bf16x8* kf, lds_cptr kp, int j) { kf[2 * j] = *(const LAS bf16x8*)(kp + j * 2048); kf[2 * j + 1] = *(const LAS bf16x8*)(kp + j * 2048 + 512); }

__device__ __forceinline__ void attn_unit(int row0, int S, int h, int qb, bf16_t* Z, LAS unsigned char* shm, float lam, const float* subln_g, bf16_t* Ob, int opitch) {
    int tid_ = threadIdx.x; asm volatile("" : "+v"(tid_));
    const int tid = tid_, lane = tid & 63, r32 = lane & 31, hi = lane >> 5; const int wid = __builtin_amdgcn_readfirstlane(tid >> 6);
    const unsigned lds0 = (unsigned)(uintptr_t)shm;
    LAS float* wsf = (LAS float*)(shm + L_WS) + wid * 64;
    LAS bf16_t* stash = (LAS bf16_t*)(shm + L_ST) + wid * 4096;
    const int NT = S / 64;
    const size_t qrow = (size_t)(row0 + qb * 256 + wid * 32);
    const lds_cptr shm3 = (lds_cptr)shm;
    const lds_cptr kp0 = shm3 + L_K + hi * 1024 + r32 * 16;
    const lds_cptr vp0 = shm3 + L_V + ((lane >> 4) & 1) * 32 + (lane & 3) * 8 + (4 * hi + ((lane & 15) >> 2)) * 64;
    f32x16 o[4];
#pragma unroll 1
    for (int c = 0; c < 2; ++c) {
        const bf16_t* Qw = Z + qrow * ZP + ZQ + h * 128 + c * 64;
        const bf16_t* Kh = Z + (size_t)row0 * ZP + ZK + h * 128 + c * 64;
        const bf16_t* Vh = Z + (size_t)row0 * ZP + ZV + h * 128;
        const int p0 = 2 * wid, p1 = 2 * wid + 1;
        const unsigned koff = (unsigned)(lane * ZP + wid * 8) * 2u;
        const unsigned voff0 = (unsigned)((16 * (p0 & 3) + (lane >> 2)) * ZP + (p0 >> 2) * 32 + (lane & 3) * 8) * 2u;
        const unsigned voff1 = (unsigned)((16 * (p1 & 3) + (lane >> 2)) * ZP + (p1 >> 2) * 32 + (lane & 3) * 8) * 2u;
        const unsigned kdst = lds0 + L_K + wid * 1024, vdst0 = lds0 + L_V + p0 * 1024, vdst1 = lds0 + L_V + p1 * 1024;
#define DMA_K(t, si) glds16((const char*)(Kh + (size_t)(t) * 64 * ZP) + koff, (unsigned)__builtin_amdgcn_readfirstlane(kdst + (si) * KSLOT))
#define DMA_V(t, si) do { const char* vb_ = (const char*)(Vh + (size_t)(t) * 64 * ZP); glds16(vb_ + voff0, (unsigned)__builtin_amdgcn_readfirstlane(vdst0 + (si) * VSLOT)); glds16(vb_ + voff1, (unsigned)__builtin_amdgcn_readfirstlane(vdst1 + (si) * VSLOT)); } while (0)
        DMA_K(0, 0); DMA_V(0, 0); DMA_K(1, 1);
        bf16x8 qr[4];
#pragma unroll
        for (int d0 = 0; d0 < 4; ++d0) qr[d0] = *(const bf16x8*)(Qw + (size_t)r32 * ZP + d0 * 16 + hi * 8);
#pragma unroll
        for (int d0 = 0; d0 < 4; ++d0) o[d0] = f32x16{};
        float l_reg = 0.f;
        bf16x8 kf[4];
        f32x16 pA0, pA1, pB0, pB1;
        int i_prev = 0, i_cur = 0, i_next = 1;
        int k_cur = 0, k_next = 1;
#define ROT() do { i_prev = i_cur; i_cur = i_next; i_next = (i_next == NVS - 1) ? 0 : i_next + 1; k_cur = k_next; k_next = (k_next + 1) & 3; } while (0)
#define KFRAG(slot, i) (*(const LAS bf16x8*)(kp0 + (slot) * KSLOT + ((i) >> 1) * 2048 + ((i) & 1) * 512))
        DMA_K(2, 2);
        WAIT_BAR(4);
        {
            const lds_cptr kb = kp0;
            pA0 = f32x16{}; pA1 = f32x16{};
#pragma unroll
            for (int d0 = 0; d0 < 4; ++d0) { const bf16x8 b0 = *(const LAS bf16x8*)(kb + d0 * 2048), b1 = *(const LAS bf16x8*)(kb + d0 * 2048 + 512);
                pA0 = __builtin_amdgcn_mfma_f32_32x32x16_bf16(b0, qr[d0], pA0, 0, 0, 0); pA1 = __builtin_amdgcn_mfma_f32_32x32x16_bf16(b1, qr[d0], pA1, 0, 0, 0); }
#pragma unroll
            for (int r = 0; r < 16; ++r) { pA0[r] = __builtin_amdgcn_exp2f(pA0[r]); pA1[r] = __builtin_amdgcn_exp2f(pA1[r]); }
        }
        WAIT_BAR(0);
        DMA_K(3, 3); DMA_V(1, 1);
        ROT();
        kf[0] = KFRAG(k_cur, 0); kf[1] = KFRAG(k_cur, 1); kf[2] = KFRAG(k_cur, 2); kf[3] = KFRAG(k_cur, 3);
        WAIT_BAR(3);
        s16x4 vlo[4], vhi[4]; u32x4 pw0, pw1, pw2, pw3;
#define PKW(P, B) cvt_pk_bf16(P[B], P[B + 1])
#define PAF(k) __builtin_bit_cast(bf16x8, pw##k)
#define VFR(i) (bf16x8){vlo[i][0], vlo[i][1], vlo[i][2], vlo[i][3], vhi[i][0], vhi[i][1], vhi[i][2], vhi[i][3]}
#define PIN(x) asm volatile("" : "+v"(x))
#define EX(v) __builtin_amdgcn_exp2f(v)
#define VRD(slot, f) do { vlo[slot] = vtr(vp_ + (((f) & 3) * 4096 + ((f) >> 2) * 1024)); vhi[slot] = vtr(vp_ + (((f) & 3) * 4096 + ((f) >> 2) * 1024 + 512)); } while (0)
#define GAPA(MF, LDX, A0, A1, A2, A3, W0, W1, PW) do { MF; LDX; sacc += A0; sacc += A1; sacc += A2; sacc += A3; PIN(sacc); W0; W1; PIN(PW); SBAR(); } while (0)
#define GAPB(MF, LDX, X, B) do { MF; LDX; X[B] = EX(X[B]); X[B + 1] = EX(X[B + 1]); PIN(X); SBAR(); } while (0)
#define PVM(f) o[(f) & 3] = __builtin_amdgcn_mfma_f32_32x32x16_bf16(__builtin_bit_cast(bf16x8, (f) < 4 ? pw0 : (f) < 8 ? pw1 : (f) < 12 ? pw2 : pw3), VFR((f) & 3), o[(f) & 3], 0, 0, 0)
#define NOP_ do { } while (0)
#if PROBE_ATT
#define ATT_T(k) do { if (PROBE_ATT == (k)) { const unsigned long long n_ = __builtin_amdgcn_s_memrealtime(); if (tid == 0) *(LAS unsigned long long*)(shm + PTRS_OFF - 64) += n_ - att_t0; } } while (0)
#define ATT_T0() const unsigned long long att_t0 = __builtin_amdgcn_s_memrealtime()
#else
#define ATT_T(k) do { } while (0)
#define ATT_T0() do { } while (0)
#endif
#define STEP(C0, C1, P0, P1, t, GK, GV, GL) do { SBAR(); \
        const lds_cptr vp_ = vp0 + i_prev * VSLOT; \
        float sacc = (P0[0] + P0[1]); \
        GAPA(C0 = __builtin_amdgcn_mfma_f32_32x32x16_bf16(kf[0], qr[0], (f32x16){}, 0, 0, 0), kf[0] = KFRAG(k_cur, 4), P0[2], P0[3], P0[4], P0[5],     pw0[0] = PKW(P0, 0), pw0[1] = PKW(P0, 2), pw0); \
        GAPA(C1 = __builtin_amdgcn_mfma_f32_32x32x16_bf16(kf[1], qr[0], (f32x16){}, 0, 0, 0), kf[1] = KFRAG(k_cur, 5), P0[6], P0[7], P0[8], P0[9],     pw0[2] = PKW(P0, 4), pw0[3] = PKW(P0, 6), pw0); \
        GAPA(C0 = __builtin_amdgcn_mfma_f32_32x32x16_bf16(kf[2], qr[1], C0, 0, 0, 0),         kf[2] = KFRAG(k_cur, 6), P0[10], P0[11], P0[12], P0[13], pw1[0] = PKW(P0, 8), pw1[1] = PKW(P0, 10), pw1); \
        GAPA(C1 = __builtin_amdgcn_mfma_f32_32x32x16_bf16(kf[3], qr[1], C1, 0, 0, 0),         kf[3] = KFRAG(k_cur, 7), P0[14], P0[15], P1[0], P1[1],   pw1[2] = PKW(P0, 12), pw1[3] = PKW(P0, 14), pw1); \
        GAPA(C0 = __builtin_amdgcn_mfma_f32_32x32x16_bf16(kf[0], qr[2], C0, 0, 0, 0),         VRD(0, 0), P1[2], P1[3], P1[4], P1[5],     pw2[0] = PKW(P1, 0), pw2[1] = PKW(P1, 2), pw2); \
        GAPA(C1 = __builtin_amdgcn_mfma_f32_32x32x16_bf16(kf[1], qr[2], C1, 0, 0, 0),         VRD(1, 1), P1[6], P1[7], P1[8], P1[9],     pw2[2] = PKW(P1, 4), pw2[3] = PKW(P1, 6), pw2); \
        GAPA(C0 = __builtin_amdgcn_mfma_f32_32x32x16_bf16(kf[2], qr[3], C0, 0, 0, 0),         VRD(2, 2), P1[10], P1[11], P1[12], P1[13], pw3[0] = PKW(P1, 8), pw3[1] = PKW(P1, 10), pw3); \
        GAPA(C1 = __builtin_amdgcn_mfma_f32_32x32x16_bf16(kf[3], qr[3], C1, 0, 0, 0),         VRD(3, 3), P1[14], P1[15], 0.f, 0.f,       pw3[2] = PKW(P1, 12), pw3[3] = PKW(P1, 14), pw3); \
        l_reg += sacc; \
        if (GK) { DMA_K((t) + 3, (k_cur + 3) & 3); } if (GV) { DMA_V((t) + 1, i_next); } \
        SBAR(); \
        GAPB(PVM(0), VRD(0, 4), C0, 0);   GAPB(PVM(1), VRD(1, 5), C0, 2);   GAPB(PVM(2), VRD(2, 6), C0, 4);    GAPB(PVM(3), VRD(3, 7), C0, 6); \
        GAPB(PVM(4), VRD(0, 8), C0, 8);   GAPB(PVM(5), VRD(1, 9), C0, 10);  GAPB(PVM(6), VRD(2, 10), C0, 12);  GAPB(PVM(7), VRD(3, 11), C0, 14); \
        GAPB(PVM(8), VRD(0, 12), C1, 0);  GAPB(PVM(9), VRD(1, 13), C1, 2);  GAPB(PVM(10), VRD(2, 14), C1, 4);  GAPB(PVM(11), VRD(3, 15), C1, 6); \
        GAPB(PVM(12), if (GL) kf[0] = KFRAG(k_next, 0), C1, 8);  GAPB(PVM(13), if (GL) kf[1] = KFRAG(k_next, 1), C1, 10); \
        GAPB(PVM(14), if (GL) kf[2] = KFRAG(k_next, 2), C1, 12); GAPB(PVM(15), if (GL) kf[3] = KFRAG(k_next, 3), C1, 14); \
        } while (0)
        int t = 1;
#pragma unroll 1
        for (; t + 5 < NT; t += 2) {
#if PROBE_ATT == 1
            STEP(pB0, pB1, pA0, pA1, t, true, true, true);     { ATT_T0(); WAIT_BAR(3); ATT_T(1); } ROT();
            STEP(pA0, pA1, pB0, pB1, t + 1, true, true, true); { ATT_T0(); WAIT_BAR(3); ATT_T(1); } ROT();
#elif PROBE_ATT >= 2
            { ATT_T0(); STEP(pB0, pB1, pA0, pA1, t, true, true, true); ATT_T(2); }    WAIT_BAR(3); ROT();
            { ATT_T0(); STEP(pA0, pA1, pB0, pB1, t + 1, true, true, true); ATT_T(2); } WAIT_BAR(3); ROT();
#else
            STEP(pB0, pB1, pA0, pA1, t, true, true, true);     WAIT_BAR(3); ROT();
            STEP(pA0, pA1, pB0, pB1, t + 1, true, true, true); WAIT_BAR(3); ROT();
#endif
        }
#define ENDW(tt) do { if ((tt) + 3 < NT) { WAIT_BAR(3); } else if ((tt) + 2 < NT) { WAIT_BAR(2); } else { WAIT_BAR(0); } } while (0)
#pragma unroll 1
        for (; t + 1 < NT; t += 2) {
            STEP(pB0, pB1, pA0, pA1, t, (t + 3 < NT), (t + 1 < NT), (t + 1 < NT));         ENDW(t);     ROT();
            STEP(pA0, pA1, pB0, pB1, t + 1, (t + 4 < NT), (t + 2 < NT), (t + 2 < NT));     ENDW(t + 1); ROT();
        }
        STEP(pB0, pB1, pA0, pA1, NT - 1, false, false, false);
        {
            float sacc = pB0[0] + pB0[1];
#pragma unroll
            for (int r = 2; r < 16; ++r) sacc += pB0[r];
#pragma unroll
            for (int r = 0; r < 16; ++r) sacc += pB1[r];
            l_reg += sacc;
            pw0 = (u32x4){PKW(pB0, 0), PKW(pB0, 2), PKW(pB0, 4), PKW(pB0, 6)}; pw1 = (u32x4){PKW(pB0, 8), PKW(pB0, 10), PKW(pB0, 12), PKW(pB0, 14)};
            pw2 = (u32x4){PKW(pB1, 0), PKW(pB1, 2), PKW(pB1, 4), PKW(pB1, 6)}; pw3 = (u32x4){PKW(pB1, 8), PKW(pB1, 10), PKW(pB1, 12), PKW(pB1, 14)};
            const lds_cptr vp_ = vp0 + i_cur * VSLOT;
            VRD(0, 0); VRD(1, 1); VRD(2, 2); VRD(3, 3); PVM(0); PVM(1); PVM(2); PVM(3);
            VRD(0, 4); VRD(1, 5); VRD(2, 6); VRD(3, 7); PVM(4); PVM(5); PVM(6); PVM(7);
            VRD(0, 8); VRD(1, 9); VRD(2, 10); VRD(3, 11); PVM(8); PVM(9); PVM(10); PVM(11);
            VRD(0, 12); VRD(1, 13); VRD(2, 14); VRD(3, 15); PVM(12); PVM(13); PVM(14); PVM(15);
        }
#undef DMA_K
#undef DMA_V
#undef ROT
#undef PKW
#undef PAF
#undef VFR
#undef PIN
#undef EX
#undef VRD
#undef GAPA
#undef GAPB
#undef KFRAG
#undef NOP_
#undef PVM
#undef STEP
#undef ENDW
        { auto rr = __builtin_amdgcn_permlane32_swap(__float_as_uint(l_reg), __float_as_uint(l_reg), false, false); l_reg = __uint_as_float(rr[0]) + __uint_as_float(rr[1]); }
        if (hi == 0) wsf[r32] = l_reg;
        LDS_WAIT();
        float rli[16];
#pragma unroll
        for (int r = 0; r < 16; ++r) rli[r] = 1.0f / wsf[crow(r, hi)];
        if (c == 0) {
#pragma unroll
            for (int d0 = 0; d0 < 4; ++d0)
#pragma unroll
                for (int r = 0; r < 16; ++r) stash[(d0 * 16 + r) * 64 + lane] = f2bf(o[d0][r] * rli[r]);
            LDS_WAIT();
        } else {
#pragma unroll
            for (int d0 = 0; d0 < 4; ++d0)
#pragma unroll
                for (int r = 0; r < 16; ++r) o[d0][r] = bf2f(stash[(d0 * 16 + r) * 64 + lane]) - lam * (o[d0][r] * rli[r]);
            LDS_WAIT(); asm volatile("" ::: "memory");
#pragma unroll
            for (int d0 = 0; d0 < 4; ++d0)
#pragma unroll
                for (int r = 0; r < 16; ++r) stash[crow(r, hi) * 128 + d0 * 32 + r32] = f2bf(o[d0][r]);
            LDS_WAIT(); asm volatile("" ::: "memory");
            bf16_t* Ow = Ob + qrow * opitch + ZQ + h * 128;
#pragma unroll
            for (int i = 0; i < 4; ++i) { const int row = i * 8 + (lane >> 3), ch = lane & 7;
                const u32x4 w0 = *(const LAS u32x4*)(stash + row * 128 + ch * 16), w1 = *(const LAS u32x4*)(stash + row * 128 + ch * 16 + 8);
                float v[16];
#pragma unroll
                for (int j = 0; j < 4; ++j) { v[2 * j] = bflo(w0[j]); v[2 * j + 1] = bfhi(w0[j]); v[8 + 2 * j] = bflo(w1[j]); v[9 + 2 * j] = bfhi(w1[j]); }
                float ss = 0.f;
#pragma unroll
                for (int j = 0; j < 16; ++j) ss += v[j] * v[j];
                ss += __shfl_xor(ss, 1); ss += __shfl_xor(ss, 2); ss += __shfl_xor(ss, 4);
                const float rs = (1.0f - LAMBDA_INIT) / sqrtf(ss * (1.f / 128.f) + NORM_EPS);
                u32x4 x0, x1;
#pragma unroll
                for (int j = 0; j < 4; ++j) { x0[j] = cvt_pk_bf16(v[2 * j] * rs * subln_g[ch * 16 + 2 * j], v[2 * j + 1] * rs * subln_g[ch * 16 + 2 * j + 1]);
                                              x1[j] = cvt_pk_bf16(v[8 + 2 * j] * rs * subln_g[ch * 16 + 8 + 2 * j], v[9 + 2 * j] * rs * subln_g[ch * 16 + 9 + 2 * j]); }
                *(u32x4*)(Ow + (size_t)row * opitch + ch * 16) = x0; *(u32x4*)(Ow + (size_t)row * opitch + ch * 16 + 8) = x1; }
            LDS_WAIT();
        }
        asm volatile("s_waitcnt vmcnt(0) lgkmcnt(0)\n\ts_barrier" ::: "memory");
    }
}
#undef SBAR
#undef WAIT_BAR
}

namespace rw {
constexpr int P = 144, MAT = 64 * P;
constexpr int O_AT = 0, O_BT = MAT, O_KT = 2 * MAT, O_RT = 3 * MAT, O_ATT = 4 * MAT, O_VT = 5 * MAT, O_BHT = 6 * MAT, O_KHT = 7 * MAT;
constexpr int O_LAB = 8 * MAT, O_LAK = 9 * MAT, O_ARB = 10 * MAT, O_ARK = 11 * MAT, O_XT = 12 * MAT, O_ABT = 13 * MAT, O_U0T = 14 * MAT;
constexpr int O_LABD = 15 * MAT, O_TII = O_LABD + 4096, O_WC = O_TII + 2048, O_GSUM = O_WC + 256, O_PAR = O_GSUM + 2048, O_END = O_PAR + 960 * 4;
constexpr int O_ZS = 0, PZ = 128;
static_assert(3 * 66 * PZ <= 3 * MAT, "ZS fits At|Bt|Kt");
constexpr int O_TW = O_LAB, O_ADN = O_LAK, O_WL = O_ARB, O_AR = O_XT, PF = 272;
static_assert(O_END <= PTRS_OFF - 64 && 64 * PF <= 2 * MAT, "rwkv lds");
__device__ __forceinline__ int crow(int r, int hi) { return (r & 3) + 8 * (r >> 2) + 4 * hi; }
__device__ __forceinline__ float sigmoidf_(float x) { return __builtin_amdgcn_rcpf(1.0f + __expf(-x)); }
__device__ __forceinline__ float tanhf_(float x) { return 1.0f - 2.0f * __builtin_amdgcn_rcpf(__expf(2.0f * x) + 1.0f); }
__device__ __forceinline__ void load10(const bf16_t* zc, int t_lo, int S, float (&z)[10]) {
#pragma unroll
    for (int i = 0; i < 10; ++i) { const int t = t_lo - 1 + i; z[i] = (t >= 0 && t < S) ? bf2f(zc[(size_t)t * ZP]) : 0.f; }
}
__device__ __forceinline__ float tshift(const float (&z)[10], int u, float mp, float mn) { const float c = z[u + 1]; return c + mp * (z[u] - c) + mn * (z[u + 2] - c); }
__device__ __forceinline__ f32x16 mm_ll(const LAS unsigned char* A, int rowA, const LAS unsigned char* B, int rowB, f32x16 acc, int r32, int hi) {
#pragma unroll
    for (int ks = 0; ks < 4; ++ks) { const bf16x8 a = *(const LAS bf16x8*)(A + (rowA + r32) * P + (16 * ks + 8 * hi) * 2), b = *(const LAS bf16x8*)(B + (rowB + r32) * P + (16 * ks + 8 * hi) * 2);
        acc = __builtin_amdgcn_mfma_f32_32x32x16_bf16(a, b, acc, 0, 0, 0); }
    return acc;
}
__device__ __forceinline__ void store_native(unsigned char* dst, const f32x16& acc, int lane, bool wt) {
    u32x4 w0, w1;
#pragma unroll
    for (int q = 0; q < 4; ++q) { w0[q] = cvt_pk_bf16(acc[2 * q], acc[2 * q + 1]); w1[q] = cvt_pk_bf16(acc[8 + 2 * q], acc[9 + 2 * q]); }
    if (wt) {
        asm volatile("global_store_dwordx4 %0, %1, off sc1\n\tglobal_store_dwordx4 %0, %2, off offset:16 sc1\n\ts_nop 1" :: "v"(dst + lane * 32), "v"(w0), "v"(w1) : "memory");
    } else { *(u32x4*)(dst + lane * 32) = w0; *(u32x4*)(dst + lane * 32 + 16) = w1; }
}
__device__ __forceinline__ void st4(LAS unsigned char* p, float a, float b, float c, float d) { u32x2 w; w.x = cvt_pk_bf16(a, b); w.y = cvt_pk_bf16(c, d); *(LAS u32x2*)p = w; }

__device__ __forceinline__ f32x2_t s1_param_load(LAS unsigned char* L, int tid, int d, int h) {
    const int sg = tid >> 5, seg = sg < 15 ? sg : 14, off = (tid & 31) * 2;
    const int ti = seg < 10 ? 11 + (seg & 1) : (seg == 10 ? 13 : (seg == 11 ? 15 : 6 + seg));
    const int eo = seg < 6 ? (seg >> 1) * 512 + h * 64 : (seg < 8 ? ZWD - ZRR : (seg < 10 ? ZAD - ZRR : (seg < 12 ? d * 512 + h * 64 : h * 64)));
    const float* src = *(const float* LAS*)(L + PTRS_OFF + ti * 8) + eo + off;
    return *(const GAS f32x2_t*)src;
}
__device__ __forceinline__ void s1_stage_load(const Args& a, int tid, int q, int h, int ck, u32x4 (&v)[6]) {
    const int row0 = seq_row0(q), S = seq_len(q), t0 = ck * 64;
#pragma unroll
    for (int k = 0; k < 6; ++k) { const int c = tid + k * NTHR;
        const int seg = c >> 3, part = c & 7, grp = (seg >= 66) + (seg >= 132), row = seg - 66 * grp; int t = t0 - 1 + row; t = t < 0 ? 0 : (t >= S ? S - 1 : t);
        const int e = c - 1584 < 0 ? 0 : (c - 1584 > 1023 ? 1023 : c - 1584);
        const size_t offz = WS_Z + ((size_t)(row0 + t) * ZP + ZRR + grp * 512 + h * 64 + part * 8) * 2, offe = WS_E1 + ((size_t)(row0 + t0) * 128 + (size_t)e * 8) * 2;
        v[k] = *(const GAS u32x4*)(a.ws + (c < 1584 ? offz : offe)); }
}
__device__ __forceinline__ void s1_stage_store(LAS unsigned char* L, int tid, int d, int q, int ck, const u32x4 (&stg)[6], f32x2_t par) {
    const int S = seq_len(q), t0 = ck * 64, dummy = O_GSUM + (tid & 63) * 16;
#pragma unroll
    for (int k = 0; k < 6; ++k) { const int c = tid + k * NTHR;
        const int seg = c >> 3, grp = (seg >= 66) + (seg >= 132), row = seg - 66 * grp, t = t0 - 1 + row; const bool zok = t >= 0 && t < S;
        const int e = c - 1584, tr = (e >> 4) & 63, part = e & 15, tau = d == 0 ? tr : 63 - tr;
        const int addr = c < 1584 ? O_ZS + c * 16 : (c < 2608 ? (part < 8 ? O_TW : O_ADN) + tau * P + (part & 7) * 16 : dummy);
        const bool zero = c < 1584 && !zok;
        *(LAS u32x4*)(L + addr) = zero ? (u32x4){0u, 0u, 0u, 0u} : stg[k]; }
    *(LAS f32x2_t*)(L + (tid < 480 ? O_PAR + tid * 8 : dummy)) = par;
}
__device__ __forceinline__ void s1_item(const Frame& F, const Args& a, int d, int q, int h, int ck, unsigned char* slot, int nd, int nq, int nh, int nck, bool wt, unsigned* publish_prev) {
    LAS unsigned char* L = F.lds;
#if PROBE_S1 >= 0
    unsigned long long pt_last = 0; int pt_n = 0;
#define PST() do { if (F.tid == 0) { const unsigned long long n_ = __builtin_amdgcn_s_memrealtime(); if (pt_n == PROBE_S1 + 1) *(LAS unsigned long long*)(L + PTRS_OFF - 64) += n_ - pt_last; pt_last = n_; } ++pt_n; } while (0)
#else
#define PST() do { } while (0)
#endif
    PST();
    int lane_ = F.lane; asm volatile("" : "+v"(lane_));
    const int lane = lane_, w = F.wave, tid = w * 64 + lane, r32 = lane & 31, hi = lane >> 5;
    const int j = lane, tg = w;
    const int row0 = seq_row0(q), S = seq_len(q), t0 = ck * 64;
    const bf16_t* Zs = (const bf16_t*)(a.ws + WS_Z) + (size_t)row0 * ZP; (void)Zs; (void)S;
    const int t_lo = d == 0 ? t0 + 8 * tg : t0 + 56 - 8 * tg;
    const int tau0 = 8 * tg;
#define TAU(u) (d == 0 ? tau0 + (u) : tau0 + 7 - (u))
    const int ch = h * 64 + j; (void)ch;
    bf16x8 wfr[4];
    { const int which = w >> 2, mt = (w >> 1) & 1;
      const bf16_t* WT = (const bf16_t*)(a.ws + WS_LORA) + (which ? 2 * 512 * 64 : 0) + ((size_t)d * 512 + h * 64 + 32 * mt + r32) * 64;
#pragma unroll
      for (int ks = 0; ks < 4; ++ks) wfr[ks] = *(const bf16x8*)(WT + 16 * ks + 8 * hi); }
    u32x4 stg[6]; s1_stage_load(a, tid, nq, nh, nck, stg); const f32x2_t par = s1_param_load(L, tid, nd, nh);
#define PAR(seg, idx) (*(const LAS float*)(L + O_PAR + ((seg) * 64 + (idx)) * 4))
    const LAS unsigned char* zsb = L + O_ZS + (t_lo - t0) * PZ + j * 2;
#define LD10(z, g) do { _Pragma("unroll") for (int i_ = 0; i_ < 10; ++i_) z[i_] = bf2f(*(const LAS bf16_t*)(zsb + ((g) * 66 + i_) * PZ)); } while (0)
    {
        const int which = w >> 2, mt = (w >> 1) & 1, nt = w & 1;
        const LAS unsigned char* B = L + (which ? O_ADN : O_TW);
        f32x16 acc = f32x16{};
#pragma unroll
        for (int ks = 0; ks < 4; ++ks) { const bf16x8 bv = *(const LAS bf16x8*)(B + (32 * nt + r32) * P + (16 * ks + 8 * hi) * 2);
            acc = __builtin_amdgcn_mfma_f32_32x32x16_bf16(wfr[ks], bv, acc, 0, 0, 0); }
        LAS unsigned char* O = L + (which ? O_AR : O_WL) + (32 * nt + r32) * PF;
#pragma unroll
        for (int g = 0; g < 4; ++g) { const int jj = 8 * g + 4 * hi; const f32x4 bv = *(const LAS f32x4*)(L + O_PAR + ((10 + which) * 64 + 32 * mt + jj) * 4);
            *(LAS f32x4*)(O + (32 * mt + jj) * 4) = (f32x4){acc[4 * g] + bv[0], acc[4 * g + 1] + bv[1], acc[4 * g + 2] + bv[2], acc[4 * g + 3] + bv[3]}; }
    }
    LBAR(); PST();
    typedef f32x2_t v2;
    const int cp = lane & 31, th = lane >> 5;
    v2 aa2[4], bb2[4], rr2[4], kd2[4], vv2[4], ld2[4], tot4, oth;
#define EXP2V(a) ({ const v2 t_ = (a) * 1.4426950408889634f; (v2){__builtin_amdgcn_exp2f(t_.x), __builtin_amdgcn_exp2f(t_.y)}; })
#define SIG2V(a) ({ const v2 e_ = EXP2V(-(a)) + 1.0f; (v2){__builtin_amdgcn_rcpf(e_.x), __builtin_amdgcn_rcpf(e_.y)}; })
#define FOLD4(s_) ({ const bool b4_ = (lane >> 4) & 1, b3_ = (lane >> 3) & 1; float g_[2]; \
        _Pragma("unroll") for (int i_ = 0; i_ < 2; ++i_) { const float kp_ = b4_ ? s_[i_ + 2] : s_[i_], sd_ = b4_ ? s_[i_] : s_[i_ + 2]; g_[i_] = kp_ + __int_as_float(__builtin_amdgcn_ds_swizzle(__float_as_int(sd_), 0x401F)); } \
        const float kp2_ = b3_ ? g_[1] : g_[0], sd2_ = b3_ ? g_[0] : g_[1]; \
        float h_ = kp2_ + __int_as_float(__builtin_amdgcn_update_dpp(0, __float_as_int(sd2_), 0x128, 0xF, 0xF, true)); \
        h_ += __int_as_float(__builtin_amdgcn_update_dpp(0, __float_as_int(h_), 0x141, 0xF, 0xF, true)); \
        h_ += __int_as_float(__builtin_amdgcn_update_dpp(0, __float_as_int(h_), 0xB1, 0xF, 0xF, true)); \
        h_ += __int_as_float(__builtin_amdgcn_update_dpp(0, __float_as_int(h_), 0x4E, 0xF, 0xF, true)); h_; })
    {
        v2 zr[6], zk[6], zv[6];
        const LAS unsigned char* zb2 = L + O_ZS + ((t_lo - t0) + 4 * th) * PZ + cp * 4;
#define LDZ(z, g) do { _Pragma("unroll") for (int i_ = 0; i_ < 6; ++i_) { const unsigned w_ = *(const LAS unsigned*)(zb2 + ((g) * 66 + i_) * PZ); z[i_] = (v2){bflo(w_), bfhi(w_)}; } } while (0)
        LDZ(zr, 0); LDZ(zk, 1); LDZ(zv, 2);
#undef LDZ
#define PAR2(seg) (*(const LAS v2*)(L + O_PAR + ((seg) * 64 + 2 * cp) * 4))
        const v2 mpr = PAR2(0), mnr = PAR2(1), mpk = PAR2(2), mnk = PAR2(3), mpv = PAR2(4), mnv = PAR2(5), kkc = PAR2(12), kac = PAR2(13), rkc = PAR2(14);
#undef PAR2
        float* bon = (float*)(a.ws + WS_BONUS) + ((size_t)d * MTOK + row0) * 8 + h;
        v2 k02[4], ar2[4]; float red[4];
#pragma unroll
        for (int k = 0; k < 4; ++k) { const int tau = TAU(4 * th + k);
            const v2 wl = *(const LAS v2*)(L + O_WL + tau * PF + cp * 8), ar = *(const LAS v2*)(L + O_AR + tau * PF + cp * 8);
            ld2[k] = SIG2V(wl) * (-0.6065306597126334f); ar2[k] = SIG2V(ar);
            rr2[k] = zr[k + 1] + mpr * (zr[k] - zr[k + 1]) + mnr * (zr[k + 2] - zr[k + 1]);
            k02[k] = zk[k + 1] + mpk * (zk[k] - zk[k + 1]) + mnk * (zk[k + 2] - zk[k + 1]);
            vv2[k] = zv[k + 1] + mpv * (zv[k] - zv[k + 1]) + mnv * (zv[k + 2] - zv[k + 1]);
            aa2[k] = k02[k] * kkc; red[k] = aa2[k].x * aa2[k].x + aa2[k].y * aa2[k].y; }
        const int hs = __float_as_int(FOLD4(red));
        float ssq[4];
#pragma unroll
        for (int k = 0; k < 4; ++k) { const float lo_ = __int_as_float(__builtin_amdgcn_readlane(hs, 8 * k)), hi_ = __int_as_float(__builtin_amdgcn_readlane(hs, 32 + 8 * k)); ssq[k] = th ? hi_ : lo_; }
#pragma unroll
        for (int k = 0; k < 4; ++k) { const v2 kkn = aa2[k] * __builtin_amdgcn_rsqf(ssq[k] + 1e-12f);
            kd2[k] = k02[k] * ((ar2[k] - 1.0f) * kac + 1.0f); aa2[k] = -kkn; bb2[k] = kkn * ar2[k];
            const v2 bt = rr2[k] * kd2[k] * rkc; red[k] = bt.x + bt.y; }
        const float hb = FOLD4(red);
        if ((lane & 7) == 0) bon[(size_t)(t_lo + (lane >> 3)) * 8] = hb;
        tot4 = (ld2[0] + ld2[1]) + (ld2[2] + ld2[3]);
        { auto rx = __builtin_amdgcn_permlane32_swap(__float_as_uint(tot4.x), __float_as_uint(tot4.x), false, false), ry = __builtin_amdgcn_permlane32_swap(__float_as_uint(tot4.y), __float_as_uint(tot4.y), false, false);
          oth.x = __uint_as_float(th ? rx[0] : rx[1]); oth.y = __uint_as_float(th ? ry[0] : ry[1]); }
        if (th == 0) *(LAS v2*)(L + O_GSUM + tg * 256 + cp * 8) = tot4 + oth;
    }
    LBAR(); PST();
    {
        v2 pre = {0.f, 0.f}, cC = {0.f, 0.f};
#pragma unroll
        for (int g = 0; g < 8; ++g) { const v2 sg = *(const LAS v2*)(L + O_GSUM + g * 256 + cp * 8); cC += sg; if (g < tg) pre += sg; }
        const v2 zero2 = {0.f, 0.f};
        const v2 base = pre + ((d == 0) == (th == 1) ? oth : zero2);
        v2 At2[4], Vt2[4], Bh2[4], Kh2[4]; v2 pf = {0.f, 0.f};
#pragma unroll
        for (int k = 0; k < 4; ++k) { pf += ld2[k]; const int tau = TAU(4 * th + k);
            const v2 cl = base + (d == 0 ? pf : tot4 - pf + ld2[k]);
            const v2 e_m1 = EXP2V(cl - ld2[k]), e_p = EXP2V(cl), e_n = EXP2V(-cl), e_c = EXP2V(cC - cl);
            At2[k] = aa2[k] * e_m1; Vt2[k] = vv2[k]; Bh2[k] = bb2[k] * e_c; Kh2[k] = kd2[k] * e_c;
            const v2 rt = rr2[k] * e_p, bt = bb2[k] * e_n, kt = kd2[k] * e_n;
            *(LAS unsigned*)(L + O_AT + tau * P + cp * 4) = cvt_pk_bf16(At2[k].x, At2[k].y); *(LAS unsigned*)(L + O_RT + tau * P + cp * 4) = cvt_pk_bf16(rt.x, rt.y);
            *(LAS unsigned*)(L + O_BT + tau * P + cp * 4) = cvt_pk_bf16(bt.x, bt.y);         *(LAS unsigned*)(L + O_KT + tau * P + cp * 4) = cvt_pk_bf16(kt.x, kt.y); }
        const int tb4 = tau0 + (d == 0 ? 4 * th : 4 * (1 - th));
#define PK4(dst, X) do { u32x2 wx_, wy_; \
            wx_.x = cvt_pk_bf16(d == 0 ? X[0].x : X[3].x, d == 0 ? X[1].x : X[2].x); wx_.y = cvt_pk_bf16(d == 0 ? X[2].x : X[1].x, d == 0 ? X[3].x : X[0].x); \
            wy_.x = cvt_pk_bf16(d == 0 ? X[0].y : X[3].y, d == 0 ? X[1].y : X[2].y); wy_.y = cvt_pk_bf16(d == 0 ? X[2].y : X[1].y, d == 0 ? X[3].y : X[0].y); \
            *(LAS u32x2*)(L + (dst) + (2 * cp) * P + tb4 * 2) = wx_; *(LAS u32x2*)(L + (dst) + (2 * cp + 1) * P + tb4 * 2) = wy_; } while (0)
        PK4(O_ATT, At2); PK4(O_VT, Vt2); PK4(O_BHT, Bh2); PK4(O_KHT, Kh2);
#undef PK4
        if (tg == 0 && th == 0) *(LAS v2*)(L + O_WC + cp * 8) = EXP2V(cC);
    }
#undef FOLD4
#undef SIG2V
#undef EXP2V
    LBAR(); PST();
#pragma unroll
    for (int i = 0; i < 2; ++i) {
        const int ti = 2 * w + i, ms = ti >> 2, nl = ti & 3;
        const int sb = 32 * (ms & 1), tb = 32 * (nl & 1);
        f32x16 acc = f32x16{};
        if (sb <= tb) acc = mm_ll(L + (ms < 2 ? O_BT : O_KT), sb, L + (nl < 2 ? O_AT : O_RT), tb, acc, r32, hi);
        const int dst = ms < 2 ? (nl < 2 ? O_LAB : O_ARB) : (nl < 2 ? O_LAK : O_ARK);
        const int t = tb + r32, tlim = t + (nl >= 2 ? 1 : 0);
        const bool diagtile = (dst == O_LAB) && (sb == tb);
#pragma unroll
        for (int g = 0; g < 4; ++g) { const int s0 = sb + 8 * g + 4 * hi; float v[4];
#pragma unroll
            for (int e = 0; e < 4; ++e) v[e] = (s0 + e < tlim) ? acc[4 * g + e] : 0.f;
            st4(L + dst + t * P + s0 * 2, v[0], v[1], v[2], v[3]);
            if (diagtile) { const bool match = (g >> 1) == (r32 >> 4);
                const int off = match ? O_LABD + (((t >> 4) * 16 + (t & 15)) * 16 + (s0 & 15)) * 4 : O_GSUM + lane * 16;
                *(LAS f32x4*)(L + off) = (f32x4){v[0], v[1], v[2], v[3]}; } }
    }
    LBAR(); PST();
    if (w < 4) {
        const int mt = w >> 1, nt = w & 1; f32x16 acc = f32x16{};
        acc = mm_ll(L + O_LAK, 32 * mt, L + O_VT, 32 * nt, acc, r32, hi);
#pragma unroll
        for (int g = 0; g < 4; ++g) st4(L + O_XT + (32 * nt + r32) * P + (32 * mt + 8 * g + 4 * hi) * 2, acc[4 * g], acc[4 * g + 1], acc[4 * g + 2], acc[4 * g + 3]);
    } else if (w == 7) {
        const int blk = lane >> 4, cc = lane & 15;
        float x[16];
#pragma unroll
        for (int t = 0; t < 16; ++t) x[t] = (t == cc) ? 1.f : 0.f;
#pragma unroll
        for (int kb = 0; kb < 4; ++kb) {
            f32x4 Lc[16];
#pragma unroll
            for (int t = 0; t < 16; ++t) if (t > 4 * kb) Lc[t] = *(const LAS f32x4*)(L + O_LABD + ((blk * 16 + t) * 16 + 4 * kb) * 4);
#pragma unroll
            for (int t = 0; t < 16; ++t) {
                if (t > 4 * kb + 0) x[t] += Lc[t][0] * x[4 * kb + 0];
            }
#pragma unroll
            for (int t = 0; t < 16; ++t) {
                if (t > 4 * kb + 1) x[t] += Lc[t][1] * x[4 * kb + 1];
            }
#pragma unroll
            for (int t = 0; t < 16; ++t) {
                if (t > 4 * kb + 2) x[t] += Lc[t][2] * x[4 * kb + 2];
            }
#pragma unroll
            for (int t = 0; t < 16; ++t) {
                if (t > 4 * kb + 3) x[t] += Lc[t][3] * x[4 * kb + 3];
            }
        }
#pragma unroll
        for (int t = 0; t < 16; ++t) *(LAS bf16_t*)(L + O_TII + ((blk * 16 + t) * 16 + cc) * 2) = f2bf(x[t]);
    }
    LBAR(); PST();
    {
        const int c16 = lane & 15, q4 = lane >> 4;
        const LAS unsigned char* RT = L + (w < 4 ? O_ATT : O_XT) + (16 * (w & 3) + c16) * P;
        LAS unsigned char* OT = L + (w < 4 ? O_ABT : O_U0T) + (16 * (w & 3) + c16) * P;
        const LAS unsigned char* LA = L + O_LAB + c16 * P;
#define RHS(i) ({ const u32x2 r_ = *(const LAS u32x2*)(RT + (16 * (i) + 4 * q4) * 2); (f32x4){bflo(r_.x), bfhi(r_.x), bflo(r_.y), bfhi(r_.y)}; })
#define AFR(i, k1, k2) ({ const u32x2 lo_ = *(const LAS u32x2*)(LA + 16 * (i) * P + (16 * (k1) + 4 * q4) * 2); u32x2 hi_ = {0u, 0u}; if ((k2) >= 0) hi_ = *(const LAS u32x2*)(LA + 16 * (i) * P + (16 * ((k2) < 0 ? 0 : (k2)) + 4 * q4) * 2); \
        __builtin_bit_cast(bf16x8, (u32x4){lo_.x, lo_.y, hi_.x, hi_.y}); })
#define TFR(i) ({ const u32x2 lo_ = *(const LAS u32x2*)(L + O_TII + (((i) * 16 + c16) * 16 + 4 * q4) * 2); __builtin_bit_cast(bf16x8, (u32x4){lo_.x, lo_.y, 0u, 0u}); })
#define BFR(U1, U2) __builtin_bit_cast(bf16x8, (u32x4){cvt_pk_bf16(U1[0], U1[1]), cvt_pk_bf16(U1[2], U1[3]), cvt_pk_bf16(U2[0], U2[1]), cvt_pk_bf16(U2[2], U2[3])})
#define MF16(A_, B_, C_) __builtin_amdgcn_mfma_f32_16x16x32_bf16(A_, B_, C_, 0, 0, 0)
        const f32x4 zero4 = {0.f, 0.f, 0.f, 0.f};
        f32x4 U0 = MF16(TFR(0), BFR(RHS(0), zero4), zero4);
        f32x4 Z1 = MF16(AFR(1, 0, -1), BFR(U0, zero4), RHS(1));
        f32x4 U1 = MF16(TFR(1), BFR(Z1, zero4), zero4);
        f32x4 Z2 = MF16(AFR(2, 0, 1), BFR(U0, U1), RHS(2));
        f32x4 U2 = MF16(TFR(2), BFR(Z2, zero4), zero4);
        f32x4 Z3 = MF16(AFR(3, 0, 1), BFR(U0, U1), RHS(3));
        Z3 = MF16(AFR(3, 2, -1), BFR(U2, zero4), Z3);
        f32x4 U3 = MF16(TFR(3), BFR(Z3, zero4), zero4);
        st4(OT + (0 + 4 * q4) * 2, U0[0], U0[1], U0[2], U0[3]); st4(OT + (16 + 4 * q4) * 2, U1[0], U1[1], U1[2], U1[3]);
        st4(OT + (32 + 4 * q4) * 2, U2[0], U2[1], U2[2], U2[3]); st4(OT + (48 + 4 * q4) * 2, U3[0], U3[1], U3[2], U3[3]);
#undef RHS
#undef AFR
#undef TFR
#undef BFR
#undef MF16
    }
    if (publish_prev) asm volatile("s_waitcnt vmcnt(0)" ::: "memory");
    LBAR(); PST();
    if (publish_prev && tid == 0) __hip_atomic_fetch_add(publish_prev, 1u, __ATOMIC_RELAXED, __HIP_MEMORY_SCOPE_AGENT);
    {
        const int mt = (w >> 1) & 1, nt = w & 1;
        if (w < 4) {
            f32x16 acc = f32x16{};
            acc = mm_ll(L + O_ABT, 32 * mt, L + O_BHT, 32 * nt, acc, r32, hi);
            if (mt == nt) { const float wc = *(const LAS float*)(L + O_WC + (32 * nt + r32) * 4);
#pragma unroll
                for (int r = 0; r < 16; ++r) if (crow(r, hi) == r32) acc[r] += wc; }
            store_native(slot + (mt * 2 + nt) * 2048, acc, lane, wt);
            f32x16 rb;
#pragma unroll
            for (int g = 0; g < 4; ++g) { const u32x2 r_ = *(const LAS u32x2*)(L + O_RT + (32 * nt + r32) * P + (32 * mt + 8 * g + 4 * hi) * 2);
                rb[4 * g] = bflo(r_.x); rb[4 * g + 1] = bfhi(r_.x); rb[4 * g + 2] = bflo(r_.y); rb[4 * g + 3] = bfhi(r_.y); }
            rb = mm_ll(L + O_ABT, 32 * mt, L + O_ARB, 32 * nt, rb, r32, hi);
            store_native(slot + 16384 + (mt * 2 + nt) * 2048, rb, lane, wt);
        } else {
            f32x16 acc = f32x16{};
            acc = mm_ll(L + O_BHT, 32 * mt, L + O_U0T, 32 * nt, acc, r32, hi);
            acc = mm_ll(L + O_KHT, 32 * mt, L + O_VT, 32 * nt, acc, r32, hi);
            store_native(slot + 8192 + (mt * 2 + nt) * 2048, acc, lane, wt);
            f32x16 y0 = f32x16{};
            y0 = mm_ll(L + O_ARB, 32 * mt, L + O_U0T, 32 * nt, y0, r32, hi);
            y0 = mm_ll(L + O_ARK, 32 * mt, L + O_VT, 32 * nt, y0, r32, hi);
            store_native(slot + 24576 + (mt * 2 + nt) * 2048, y0, lane, wt);
        }
    }
    LBAR(); PST();
    s1_stage_store(L, tid, nd, nq, nck, stg, par);
    LBAR(); PST();
#undef PAR
#undef TAU
#undef LD10
#undef PST
}

__device__ __forceinline__ void s23_wait_round(unsigned* ready, int r, int lane) {
    unsigned spins = 0;
    while ((unsigned)__builtin_amdgcn_readfirstlane(__hip_atomic_load(ready + r, __ATOMIC_RELAXED, __HIP_MEMORY_SCOPE_AGENT)) < 16u) { __builtin_amdgcn_s_sleep(8); if (++spins > (1u << 22)) break; }
    __builtin_amdgcn_fence(__ATOMIC_ACQUIRE, "agent");
    asm volatile("s_waitcnt vmcnt(0)" ::: "memory");
}
__device__ __forceinline__ void s23_chain_wg(const Frame& F, const Args& a, int d, int q, int h, unsigned char* slots  , unsigned* ready) {
    LAS unsigned char* L = F.lds;
    const int lane = F.lane, w = F.wave, icb = w & 1;
    const int NC = seq_len(q) / 64;
    f32x16 X0 = f32x16{}, X1 = f32x16{};
    const bool loader = w >= 4, compute = w < 2;
    constexpr int D = 6;
#define CKOF(cc) (d == 0 ? (cc) : NC - 1 - (cc))
#define S23_DMA(cc) do { const unsigned char* src_ = slots + (size_t)CKOF(cc) * SLOT_BYTES + (w - 4) * 4096 + lane * 16; LAS unsigned char* dst_ = L + ((cc) & 7) * 16384 + (w - 4) * 4096; \
        _Pragma("unroll") for (int p_ = 0; p_ < 4; ++p_) __builtin_amdgcn_global_load_lds((const unsigned*)(src_ + p_ * 1024), (LAS unsigned*)(dst_ + p_ * 1024), 16, 0, 0); } while (0)
#define UNPK(dst, w0, w1) do { _Pragma("unroll") for (int q_ = 0; q_ < 4; ++q_) { dst[2 * q_] = bflo(w0[q_]); dst[2 * q_ + 1] = bfhi(w0[q_]); dst[8 + 2 * q_] = bflo(w1[q_]); dst[9 + 2 * q_] = bfhi(w1[q_]); } } while (0)
    if (ready) { if (w == 4) s23_wait_round(ready, 0, lane); asm volatile("s_waitcnt lgkmcnt(0)\n\ts_barrier" ::: "memory"); }
    if (loader) {
#pragma unroll
        for (int c0 = 0; c0 < D; ++c0) if (c0 < NC) S23_DMA(c0); }
#pragma unroll 1
    for (int cc = 0; cc < NC; ++cc) {
        if (ready && w == 4 && ((cc + D) & 15) == 0 && cc + D < NC) s23_wait_round(ready, (cc + D) >> 4, lane);
        if (loader) { const int later = NC - 1 - cc;
            if (later >= 5) asm volatile("s_waitcnt vmcnt(20)" ::: "memory"); else if (later == 4) asm volatile("s_waitcnt vmcnt(16)" ::: "memory"); else if (later == 3) asm volatile("s_waitcnt vmcnt(12)" ::: "memory");
            else if (later == 2) asm volatile("s_waitcnt vmcnt(8)" ::: "memory"); else if (later == 1) asm volatile("s_waitcnt vmcnt(4)" ::: "memory"); else asm volatile("s_waitcnt vmcnt(0)" ::: "memory"); }
        asm volatile("s_waitcnt lgkmcnt(0)\n\ts_barrier" ::: "memory");
        if (loader) { if (cc + D < NC) S23_DMA(cc + D); }
        if (compute) {
            const LAS unsigned char* sl = L + (cc & 7) * 16384 + lane * 32;
            u32x4 mw[4][2], dw[2][2];
#pragma unroll
            for (int t = 0; t < 4; ++t) { mw[t][0] = *(const LAS u32x4*)(sl + t * 2048); mw[t][1] = *(const LAS u32x4*)(sl + t * 2048 + 16); }
#pragma unroll
            for (int t = 0; t < 2; ++t) { dw[t][0] = *(const LAS u32x4*)(sl + 8192 + (t * 2 + icb) * 2048); dw[t][1] = *(const LAS u32x4*)(sl + 8192 + (t * 2 + icb) * 2048 + 16); }
            __builtin_amdgcn_sched_barrier(0);
            u32x4 xw[2][2];
#pragma unroll
            for (int s = 0; s < 2; ++s) {
                xw[0][s] = (u32x4){cvt_pk_bf16(X0[8 * s], X0[8 * s + 1]), cvt_pk_bf16(X0[8 * s + 2], X0[8 * s + 3]), cvt_pk_bf16(X0[8 * s + 4], X0[8 * s + 5]), cvt_pk_bf16(X0[8 * s + 6], X0[8 * s + 7])};
                xw[1][s] = (u32x4){cvt_pk_bf16(X1[8 * s], X1[8 * s + 1]), cvt_pk_bf16(X1[8 * s + 2], X1[8 * s + 3]), cvt_pk_bf16(X1[8 * s + 4], X1[8 * s + 5]), cvt_pk_bf16(X1[8 * s + 6], X1[8 * s + 7])}; }
            { unsigned char* xo = slots + (size_t)CKOF(cc) * SLOT_BYTES + ((icb * 2) * 64 + lane) * 32;
              *(u32x4*)(xo) = xw[0][0]; *(u32x4*)(xo + 16) = xw[0][1]; *(u32x4*)(xo + 2048) = xw[1][0]; *(u32x4*)(xo + 2048 + 16) = xw[1][1]; }
            asm volatile("s_waitcnt lgkmcnt(0)" ::: "memory");
            __builtin_amdgcn_sched_barrier(0);
            f32x16 N0, N1;
            UNPK(N0, dw[0][0], dw[0][1]); UNPK(N1, dw[1][0], dw[1][1]);
#pragma unroll
            for (int rb = 0; rb < 2; ++rb)
#pragma unroll
                for (int s = 0; s < 2; ++s) {
                    N0 = __builtin_amdgcn_mfma_f32_32x32x16_bf16(__builtin_bit_cast(bf16x8, mw[rb * 2 + 0][s]), __builtin_bit_cast(bf16x8, xw[rb][s]), N0, 0, 0, 0);
                    N1 = __builtin_amdgcn_mfma_f32_32x32x16_bf16(__builtin_bit_cast(bf16x8, mw[rb * 2 + 1][s]), __builtin_bit_cast(bf16x8, xw[rb][s]), N1, 0, 0, 0); }
            X0 = N0; X1 = N1;
        }
    }
    asm volatile("s_waitcnt vmcnt(0) lgkmcnt(0)\n\ts_barrier" ::: "memory");
#undef UNPK
#undef S23_DMA
#undef CKOF
}

constexpr int PO_V = 0, PO_G = PO_V + 66 * 144, PO_Y = PO_G + 66 * 272, PO_SG = PO_Y + 2 * 64 * 272, PO_GF = PO_SG + 64 * 272, PO_END = PO_GF + 64 * 272;
static_assert(PO_END <= PTRS_OFF - 64, "post lds");
struct PostPre { u32x4 stg[4]; u32x4 ra[2][2], xb[2][2], yc[2]; };
__device__ __forceinline__ void post_decode(int c, int& reg, int& row, int& part) {
    if (c < 528) { reg = 0; row = c >> 3; part = c & 7; } else { reg = 1; row = (c - 528) >> 4; part = (c - 528) & 15; }
}
__device__ __forceinline__ void post_stage_load(const Args& a, int tid, int q, int h, int blk, PostPre& pp) {
    const int row0 = seq_row0(q), S = seq_len(q), t0 = blk * 64;
    const bf16_t* Zs = (const bf16_t*)(a.ws + WS_Z) + (size_t)row0 * ZP;
#pragma unroll
    for (int k = 0; k < 4; ++k) { const int c = tid + k * NTHR; int reg, row, part; post_decode(c, reg, row, part);
        const int t = t0 - 1 + row; const int col = reg == 0 ? ZRV + h * 64 : ZGD;
        pp.stg[k] = (u32x4){0u, 0u, 0u, 0u};
        if (c < 1584 && t >= 0 && t < S) pp.stg[k] = *(const u32x4*)(Zs + (size_t)t * ZP + col + part * 8); }
    const int w = tid >> 6, lane = tid & 63, dd = w >> 2, tb = (w >> 1) & 1, icb = w & 1;
    const size_t si = q == 0 ? (size_t)(dd * 8 + h) * 256 + blk : (size_t)((dd * 8 + (q - 1)) * 8 + h) * 32 + blk;
    const unsigned char* sl = (const unsigned char*)a.out + si * SLOT_BYTES + lane * 32;
#pragma unroll
    for (int rb = 0; rb < 2; ++rb) { pp.ra[rb][0] = *(const u32x4*)(sl + 16384 + (rb * 2 + tb) * 2048); pp.ra[rb][1] = *(const u32x4*)(sl + 16384 + (rb * 2 + tb) * 2048 + 16);
                                     pp.xb[rb][0] = *(const u32x4*)(sl + (icb * 2 + rb) * 2048); pp.xb[rb][1] = *(const u32x4*)(sl + (icb * 2 + rb) * 2048 + 16); }
    pp.yc[0] = *(const u32x4*)(sl + 24576 + (tb * 2 + icb) * 2048); pp.yc[1] = *(const u32x4*)(sl + 24576 + (tb * 2 + icb) * 2048 + 16);
}
__device__ __forceinline__ void post_item(const Frame& F, const Args& a, int q, int h, int blk, PostPre& pp, int nq, int nh, int nblk) {
    LAS unsigned char* L = F.lds;
    int lane_ = F.lane; asm volatile("" : "+v"(lane_));
    const int lane = lane_, w = F.wave, tid = w * 64 + lane, r32 = lane & 31, hi = lane >> 5, j = lane, tg = w;
    const int row0 = seq_row0(q), t_lo = blk * 64 + 8 * tg;
    bf16_t* Zs = (bf16_t*)(a.ws + WS_Z) + (size_t)row0 * ZP;
    const float* mup = inp(L, 11); const float* mun = inp(L, 12);
    const int chp = h * 64 + j;
    const float mp0 = gld(mup + ZGD - ZRR + j), mn0 = gld(mun + ZGD - ZRR + j), mp1 = gld(mup + ZGD - ZRR + 64 + j), mn1 = gld(mun + ZGD - ZRR + 64 + j);
    const float mpv = gld(mup + 1024 + chp), mnv = gld(mun + 1024 + chp), lg = gld(inp(L, 21) + chp), lb = gld(inp(L, 22) + chp);
    float bsum[8];
    { const float* bon0 = (const float*)(a.ws + WS_BONUS) + (size_t)row0 * 8 + h; const float* bon1 = bon0 + (size_t)MTOK * 8;
#pragma unroll
      for (int u = 0; u < 8; ++u) bsum[u] = bon0[(size_t)(t_lo + u) * 8] + bon1[(size_t)(t_lo + u) * 8]; }
    bf16x8 gfr[8];
    { const bf16_t* GT = (const bf16_t*)(a.ws + WS_LORA) + 4 * 512 * 64 + ((size_t)h * 64 + 32 * ((w >> 1) & 1) + r32) * 128;
#pragma unroll
      for (int ks = 0; ks < 8; ++ks) gfr[ks] = *(const bf16x8*)(GT + 16 * ks + 8 * hi); }
#pragma unroll
    for (int k = 0; k < 4; ++k) { const int c = tid + k * NTHR; int reg, row, part; post_decode(c, reg, row, part);
        const int off = reg == 0 ? PO_V + row * 144 : PO_G + row * 272;
        if (c < 1584) *(LAS u32x4*)(L + off + part * 16) = pp.stg[k]; }
    {
        const int dd = w >> 2, tb = (w >> 1) & 1, icb = w & 1;
        f32x16 Y;
#pragma unroll
        for (int q_ = 0; q_ < 4; ++q_) { Y[2 * q_] = bflo(pp.yc[0][q_]); Y[2 * q_ + 1] = bfhi(pp.yc[0][q_]); Y[8 + 2 * q_] = bflo(pp.yc[1][q_]); Y[9 + 2 * q_] = bfhi(pp.yc[1][q_]); }
#pragma unroll
        for (int rb = 0; rb < 2; ++rb)
#pragma unroll
            for (int s2 = 0; s2 < 2; ++s2) Y = __builtin_amdgcn_mfma_f32_32x32x16_bf16(__builtin_bit_cast(bf16x8, pp.ra[rb][s2]), __builtin_bit_cast(bf16x8, pp.xb[rb][s2]), Y, 0, 0, 0);
#pragma unroll
        for (int r = 0; r < 16; ++r) { const int tau = 32 * tb + (r & 3) + 8 * (r >> 2) + 4 * hi; const int t = dd == 0 ? tau : 63 - tau;
            *(LAS float*)(L + PO_Y + (dd * 64 + t) * 272 + (32 * icb + r32) * 4) = Y[r]; }
    }
    LBAR();
    post_stage_load(a, tid, nq, nh, nblk, pp);
    {
        float z0[10], z1[10];
#pragma unroll
        for (int i = 0; i < 10; ++i) { z0[i] = bf2f(*(const LAS bf16_t*)(L + PO_G + (8 * tg + i) * 272 + j * 2)); z1[i] = bf2f(*(const LAS bf16_t*)(L + PO_G + (8 * tg + i) * 272 + (64 + j) * 2)); }
#pragma unroll
        for (int u = 0; u < 8; ++u) { const float s0_ = sigmoidf_(tshift(z0, u, mp0, mn0)), s1_ = sigmoidf_(tshift(z1, u, mp1, mn1));
#define NBR(x) __int_as_float(__builtin_amdgcn_update_dpp(0, __float_as_int(x), 0xB1, 0xF, 0xF, true))
            const unsigned p0_ = cvt_pk_bf16(s0_, NBR(s0_)), p1_ = cvt_pk_bf16(s1_, NBR(s1_));
#undef NBR
            if (!(lane & 1)) { *(LAS unsigned*)(L + PO_SG + (8 * tg + u) * 272 + j * 2) = p0_; *(LAS unsigned*)(L + PO_SG + (8 * tg + u) * 272 + (64 + j) * 2) = p1_; } }
    }
    LBAR();
    if (w < 4) {
        const int mt = w >> 1, nt = w & 1;
        f32x16 acc = f32x16{};
#pragma unroll
        for (int ks = 0; ks < 8; ++ks) { const bf16x8 bv = *(const LAS bf16x8*)(L + PO_SG + (32 * nt + r32) * 272 + (16 * ks + 8 * hi) * 2);
            acc = __builtin_amdgcn_mfma_f32_32x32x16_bf16(gfr[ks], bv, acc, 0, 0, 0); }
#pragma unroll
        for (int g = 0; g < 4; ++g) *(LAS f32x4*)(L + PO_GF + (32 * nt + r32) * 272 + (32 * mt + 8 * g + 4 * hi) * 4) = (f32x4){acc[4 * g], acc[4 * g + 1], acc[4 * g + 2], acc[4 * g + 3]};
    }
    LBAR();
    {
        const int ch = h * 64 + j;
        float zv[10];
#pragma unroll
        for (int i = 0; i < 10; ++i) zv[i] = bf2f(*(const LAS bf16_t*)(L + PO_V + (8 * tg + i) * 144 + j * 2));
        float y8[8], m8[8], v8[8];
#pragma unroll
        for (int u = 0; u < 8; ++u) { y8[u] = *(const LAS float*)(L + PO_Y + (8 * tg + u) * 272 + j * 4) + *(const LAS float*)(L + PO_Y + (64 + 8 * tg + u) * 272 + j * 4); m8[u] = y8[u]; }
        wave_sum8(m8, lane);
#pragma unroll
        for (int u = 0; u < 8; ++u) { y8[u] -= m8[u] * (1.f / 64.f); v8[u] = y8[u] * y8[u]; }
        wave_sum8(v8, lane);
#pragma unroll
        for (int u = 0; u < 8; ++u) { const int t = t_lo + u;
            const float yn = y8[u] * __builtin_amdgcn_rsqf(v8[u] * (1.f / 64.f) + LNX_EPS) * lg + lb;
            const float g = *(const LAS float*)(L + PO_GF + (8 * tg + u) * 272 + j * 4);
            Zs[(size_t)t * ZP + ZRR + ch] = f2bf((yn + bsum[u] * tshift(zv, u, mpv, mnv)) * g); }
    }
    LBAR();
}
}


#define XB_TMO      128
#define XB_XCNT(j)  (256  + 64 * (j))
#define XB_XSUB(j)  (1280 + 64 * (j))
#define XB_XGEN(j)  (2304 + 64 * (j))
#define XB_TOP      3328
#define XB_TOPGEN   3392
#define XCD_BAR_WORDS 3456
#define XB_SPIN_CAP (1u << 20)
constexpr size_t CTL_ZERO_BYTES = 16384;
__device__ __forceinline__ unsigned xb_ld(unsigned* p)              { return __hip_atomic_load(p, __ATOMIC_RELAXED, __HIP_MEMORY_SCOPE_AGENT); }
__device__ __forceinline__ unsigned xb_add(unsigned* p, unsigned v) { return __hip_atomic_fetch_add(p, v, __ATOMIC_RELAXED, __HIP_MEMORY_SCOPE_AGENT); }
__device__ __forceinline__ unsigned xb_xcc_id() { return (unsigned)__builtin_amdgcn_s_getreg((3 << 11) | 20) & 0xFu; }
#define XB_SPIN(cond, bar) do { unsigned _sp = 0; while (cond) { __builtin_amdgcn_s_sleep(1); \
    if ((++_sp & 255u) == 0u) { if (xb_ld(&(bar)[XB_TMO])) break; if (_sp > XB_SPIN_CAP) { atomicAdd(&(bar)[XB_TMO], 1u); break; } } } } while (0)
struct XcdBarrier { unsigned* bar; unsigned x; volatile LAS unsigned* st; };
__device__ __forceinline__ XcdBarrier xcd_barrier_post(unsigned* bar, volatile LAS unsigned* st) {
    XcdBarrier b; b.bar = bar; b.x = xb_xcc_id(); b.st = st;
    if (threadIdx.x == 0) (void)xb_add(&bar[XB_XCNT(b.x)], 1u);
    return b;
}
__device__ __forceinline__ void xcd_barrier_complete(unsigned* bar, unsigned x, unsigned& nloc, unsigned& nx) {
    const unsigned G = gridDim.x * gridDim.y * gridDim.z;
    unsigned sum, cnt, mine, sp = 0u;
    for (;;) {
        sum = 0u; cnt = 0u; mine = 0u;
#pragma unroll
        for (unsigned j = 0; j < 16; ++j) { const unsigned c = xb_ld(&bar[XB_XCNT(j)]); sum += c; cnt += (c > 0u) ? 1u : 0u; mine = (j == x) ? c : mine; }
        if (sum == G) break;
        __builtin_amdgcn_s_sleep(1);
        if ((++sp & 255u) == 0u) { if (xb_ld(&bar[XB_TMO])) break; if (sp > XB_SPIN_CAP) { atomicAdd(&bar[XB_TMO], 1u); break; } }
    }
    nloc = mine > 0u ? mine : 1u; nx = cnt > 0u ? cnt : 1u;
}
__device__ __forceinline__ void xcd_barrier(const XcdBarrier& b) {
    asm volatile("s_waitcnt vmcnt(0)" ::: "memory");
    __syncthreads();
    if (threadIdx.x == 0) {
        unsigned* bar = b.bar;
        __builtin_amdgcn_s_waitcnt(0);
        unsigned nloc = b.st[0], nx = b.st[1];
        if (nloc == 0u) { xcd_barrier_complete(bar, b.x, nloc, nx); b.st[0] = nloc; b.st[1] = nx; }
        const unsigned old = xb_add(&bar[XB_XSUB(b.x)], 1u);
        const unsigned gen = old / nloc;
        if (old + 1u == (gen + 1u) * nloc) {
            __builtin_amdgcn_fence(__ATOMIC_RELEASE, "agent");
            asm volatile("s_waitcnt vmcnt(0)" ::: "memory");
            const unsigned og = xb_add(&bar[XB_TOP], 1u);
            const unsigned tg = og / nx;
            if (og + 1u == (tg + 1u) * nx) xb_add(&bar[XB_TOPGEN], 1u);
            else XB_SPIN(xb_ld(&bar[XB_TOPGEN]) == tg, bar);
            __builtin_amdgcn_fence(__ATOMIC_ACQUIRE, "agent");
            xb_add(&bar[XB_XGEN(b.x)], 1u);
            asm volatile("s_waitcnt vmcnt(0)" ::: "memory");
        } else {
            XB_SPIN(xb_ld(&bar[XB_XGEN(b.x)]) == gen, bar);
            __builtin_amdgcn_fence(__ATOMIC_ACQUIRE, "agent");
            asm volatile("s_waitcnt vmcnt(0)" ::: "memory");
        }
    }
    __syncthreads();
}

constexpr int NPHASE = 10;
constexpr int NOJUMP = 1 << 30;
template <int LO, int HI>
__global__ void __launch_bounds__(NTHR, 2) fwd_kernel(Args a) {
    extern __shared__ __attribute__((aligned(16))) unsigned char lds_raw[];
    Frame F; F.lds = (LAS unsigned char*)lds_raw; F.tid = threadIdx.x; F.lane = F.tid & 63; F.wave = __builtin_amdgcn_readfirstlane(F.tid >> 6);
    F.G = gridDim.x; { const int bx = blockIdx.x; F.vcu = (F.G % 8 == 0) ? (bx % 8) * (F.G / 8) + bx / 8 : bx; }
    unsigned char* ws = a.ws; bf16_t* Z = (bf16_t*)(ws + WS_Z);
    unsigned char* slots = (unsigned char*)a.out;
    if (F.tid == 0) {
#pragma unroll
        for (int i = 0; i < 27; ++i) *(const float* LAS*)(F.lds + PTRS_OFF + i * 8) = a.in[i];
        *(volatile LAS unsigned*)(F.lds + PTRS_OFF + 224) = 0u; *(volatile LAS unsigned*)(F.lds + PTRS_OFF + 228) = 0u;
        *(LAS unsigned long long*)(F.lds + PTRS_OFF - 64) = 0ull;
    }
    __syncthreads();
#if ONE_LAUNCH && !USE_CG
    const XcdBarrier bar = xcd_barrier_post((unsigned*)(ws + WS_CTL), (volatile LAS unsigned*)(F.lds + PTRS_OFF + 224));
#endif
#if ONE_LAUNCH
#if PROBE_SEG >= 0 || PROBE_CLK >= 0
    unsigned long long* tsb = (unsigned long long*)(ws + WS_CTL + 15872); int nts = 0;
#define STAMP() do { if (blockIdx.x == 0 && F.tid == 0) { tsb[nts] = __builtin_amdgcn_s_memrealtime(); tsb[32 + nts] = __builtin_amdgcn_s_memtime(); } ++nts; } while (0)
    STAMP();
#else
#define STAMP() do { } while (0)
#endif
#if USE_CG
#define SEAM(k) do { if constexpr ((k) + 1 < HI) { cg::this_grid().sync(); STAMP(); } } while (0)
#define RSYNC() do { cg::this_grid().sync(); STAMP(); } while (0)
#else
#define SEAM(k) do { if constexpr ((k) + 1 < HI) { xcd_barrier(bar); STAMP(); } } while (0)
#define RSYNC() do { xcd_barrier(bar); STAMP(); } while (0)
#endif
#else
#define SEAM(k) do { } while (0)
#define RSYNC() do { } while (0)
#endif
#define IN(k) (LO <= (k) && (k) < HI)
    if constexpr (IN(0)) { p0_prologue(F, a); SEAM(0);
#if PROBE_DOUBLE == 4
        p0_prologue(F, a); RSYNC();
#endif
    }
    if constexpr (IN(1)) { pg8::Gemm g{(const char*)a.out, (const bf16_t*)(ws + WS_WIN), MTOK, ZP, DM, DM * 2, NOJUMP, 0}; pg8::StaticOrder S; S.init(MTOK, ZP, F.G, (int)blockIdx.x);
        pg8::EpiZ E{Z, ZP}; pg8::gemm_phase<pg8::EpiZ, pg8::StaticOrder, true>(F.lds, g, S, E); SEAM(1);
#if PROBE_DOUBLE == 3
        pg8::gemm_phase<pg8::EpiZ, pg8::StaticOrder, true>(F.lds, g, S, E); RSYNC();
#endif
    }
    if constexpr (IN(2)) { qk_prep(F, a);
        unsigned* rdy = (unsigned*)(ws + WS_CTL) + 3584;
#pragma unroll 1
        for (int rnd = 0; rnd < 2; ++rnd) {
            const int nprod = rnd == 1 ? F.G - 16 : F.G;
            if (F.vcu < nprod) {
#define S1_DECODE(i_, d_, q_, h_, ck_, it_, pub_) do { if (rnd == 1) { const int c_ = ((i_) >> 4) & 15, cc_ = (((i_) >> 8) << 4) + ((i_) & 15); d_ = c_ >> 3; h_ = c_ & 7; q_ = 0; ck_ = d_ ? 255 - cc_ : cc_; it_ = c_ * 256 + ck_; pub_ = rdy + c_ * 16 + ((i_) >> 8); } \
                    else { ck_ = (i_) & 31; h_ = ((i_) >> 5) & 7; q_ = 1 + (((i_) >> 8) & 7); d_ = (i_) >> 11; it_ = (i_); pub_ = nullptr; } } while (0)
                { int d, q, h, ck, it; unsigned* pub; S1_DECODE(F.vcu, d, q, h, ck, it, pub); (void)it; (void)pub;
                  u32x4 stg[6]; rw::s1_stage_load(a, F.tid, q, h, ck, stg); const f32x2_t par = rw::s1_param_load(F.lds, F.tid, d, h);
                  rw::s1_stage_store(F.lds, F.tid, d, q, ck, stg, par); LBAR(); }
                unsigned* pub_prev = nullptr;
#pragma unroll 1
                for (int i = F.vcu; i < 4096; i += nprod) {
                    int d, q, h, ck, it, nd, nq, nh, nck, nit; unsigned* pub; unsigned* npub; S1_DECODE(i, d, q, h, ck, it, pub); const int ni = i + nprod < 4096 ? i + nprod : i; S1_DECODE(ni, nd, nq, nh, nck, nit, npub); (void)nit; (void)npub;
                    rw::s1_item(F, a, d, q, h, ck, slots + (size_t)it * SLOT_BYTES, nd, nq, nh, nck, rnd == 1, pub_prev); pub_prev = pub; }
                if (pub_prev) { asm volatile("s_waitcnt vmcnt(0)" ::: "memory"); __syncthreads(); if (F.tid == 0) __hip_atomic_fetch_add(pub_prev, 1u, __ATOMIC_RELAXED, __HIP_MEMORY_SCOPE_AGENT); }
#undef S1_DECODE
            } else {
                const int c = F.vcu - nprod;
                rw::s23_chain_wg(F, a, c >> 3, 0, c & 7, slots + (size_t)c * 256 * SLOT_BYTES, rdy + c * 16);
            }
            if (rnd == 0) {
                RSYNC();
                for (int chain = F.vcu; chain < 128; chain += F.G) { const int h = chain & 7, q = 1 + ((chain >> 3) & 7), d = chain >> 6;
                    rw::s23_chain_wg(F, a, d, q, h, slots + (size_t)chain * 32 * SLOT_BYTES, nullptr); }
            }
            RSYNC();
            {
#define PO_DECODE(it_, q_, h_, b_) do { if (rnd == 1) { q_ = 0; h_ = ((it_) >> 8) & 7; b_ = (it_) & 255; } else { q_ = 1 + (((it_) >> 8) & 7); h_ = ((it_) >> 5) & 7; b_ = (it_) & 31; } } while (0)
                rw::PostPre pp;
                { int q, h, b; PO_DECODE(F.vcu, q, h, b); rw::post_stage_load(a, F.tid, q, h, b, pp); }
#pragma unroll 1
                for (int it = F.vcu; it < 2048; it += F.G) { int q, h, b, nq, nh, nb; PO_DECODE(it, q, h, b); const int nit = it + F.G < 2048 ? it + F.G : it; PO_DECODE(nit, nq, nh, nb);
                    rw::post_item(F, a, q, h, b, pp, nq, nh, nb); }
#undef PO_DECODE
            }
            if (rnd == 0) RSYNC();
        }
        SEAM(2); }
    if constexpr (IN(4)) {
        float lam; { const float p1 = wave_sum(a.in[6][F.lane] * a.in[7][F.lane]), p2 = wave_sum(a.in[8][F.lane] * a.in[9][F.lane]); lam = __expf(p1) - __expf(p2) + LAMBDA_INIT; }
#if PROBE_DOUBLE == 1
        for (int v = F.vcu; v < 256; v += F.G) {
            att::attn_unit(0, SP, v >> 6, v & 63, Z, F.lds, lam, a.in[10], (bf16_t*)a.out, 512);
            att::attn_unit(SP + (v >> 5) * SS, SS, (v >> 3) & 3, v & 7, Z, F.lds, lam, a.in[10], (bf16_t*)a.out, 512); }
        RSYNC();
#endif
        for (int v = F.vcu; v < 256; v += F.G) {
            att::attn_unit(0, SP, v >> 6, v & 63, Z, F.lds, lam, a.in[10], Z, ZP);
            att::attn_unit(SP + (v >> 5) * SS, SS, (v >> 3) & 3, v & 7, Z, F.lds, lam, a.in[10], Z, ZP); }
        SEAM(4); }
    if constexpr (IN(5)) { pg8::Gemm g{(const char*)Z, (const bf16_t*)(ws + WS_WOUT), MTOK, DM, DM, ZP * 2, 8, 2048}; pg8::StaticOrder S; S.init(MTOK, DM, F.G, (int)blockIdx.x);
        pg8::EpiOut E{a.in[0], a.in[1], a.out, Z, (float*)(ws + WS_ROWSQ)}; pg8::gemm_phase<pg8::EpiOut, pg8::StaticOrder, true>(F.lds, g, S, E); SEAM(5); }
#define FFN_UP(k, half) if constexpr (IN(k)) { pg8::Gemm g{(const char*)(Z + (size_t)(half) * 16384 * ZP + ZXN2), (const bf16_t*)(ws + WS_W1), 16384, DFF, DM, ZP * 2, NOJUMP, 0}; pg8::StaticOrder S; S.init(16384, DFF, F.G, (int)blockIdx.x); \
        pg8::EpiUp E{(char*)(ws + WS_Z), (const float*)(ws + WS_ROWSQ), (half) * 16384}; pg8::gemm_phase<pg8::EpiUp, pg8::StaticOrder, true>(F.lds, g, S, E); SEAM(k); }
#define FFN_DN(k, half) if constexpr (IN(k)) { pg8::Gemm g{(const char*)(ws + WS_Z), (const bf16_t*)(ws + WS_W2), 16384, DM, DFF, 13312, 32, 2560}; pg8::StaticOrder S; S.init(16384, DM, F.G, (int)blockIdx.x); \
        pg8::EpiDown E{a.out, (half) * 16384}; pg8::gemm_phase<pg8::EpiDown, pg8::StaticOrder, true>(F.lds, g, S, E); SEAM(k); }
    FFN_UP(6, 0) FFN_DN(7, 0) FFN_UP(8, 1) FFN_DN(9, 1)
#if PROBE_S1 >= 0 || PROBE_ATT
    if (F.tid == 0) { const unsigned long long dt = *(LAS unsigned long long*)(F.lds + PTRS_OFF - 64), t0_ = __builtin_amdgcn_s_memrealtime();
        while (__builtin_amdgcn_s_memrealtime() - t0_ < dt) __builtin_amdgcn_s_sleep(16); }
#endif
#if PROBE_SEG >= 0 || PROBE_CLK >= 0
    STAMP();
#if PROBE_CLK >= 0
    if (blockIdx.x == 0 && F.tid == 0) { asm volatile("s_waitcnt vmcnt(0)" ::: "memory"); const unsigned long long wt_ = tsb[PROBE_CLK + 1] - tsb[PROBE_CLK], cy_ = tsb[32 + PROBE_CLK + 1] - tsb[32 + PROBE_CLK];
        const unsigned long long dt = cy_ * 1000ull / (wt_ ? wt_ : 1ull), t0_ = __builtin_amdgcn_s_memrealtime();
        while (__builtin_amdgcn_s_memrealtime() - t0_ < dt) __builtin_amdgcn_s_sleep(16); }
#endif
    if (PROBE_CLK < 0 && blockIdx.x == 0 && F.tid == 0) { asm volatile("s_waitcnt vmcnt(0)" ::: "memory"); const unsigned long long dt = tsb[PROBE_SEG + 1] - tsb[PROBE_SEG], t0_ = __builtin_amdgcn_s_memrealtime();
        while (__builtin_amdgcn_s_memrealtime() - t0_ < dt) __builtin_amdgcn_s_sleep(16); }
#endif
#undef FFN_UP
#undef FFN_DN
#undef IN
#undef SEAM
#undef RSYNC
}

extern "C" void kernel_launch(void* const* d_in, const int* in_sizes, int n_in, void* d_out, int out_size, void* d_ws, size_t ws_size, hipStream_t stream) {
    static int grid = 0;
    if (grid == 0) {
        if (n_in != 27 || out_size != MTOK * DM || ws_size < WS_TOTAL) { fprintf(stderr, "kernel_launch: unexpected shapes (n_in %d out %d ws %zu)\n", n_in, out_size, ws_size); grid = -1; return; }
        int dev = 0, cus = 0; (void)hipGetDevice(&dev); (void)hipDeviceGetAttribute(&cus, hipDeviceAttributeMultiprocessorCount, dev);
        bool ok = true;
#if ONE_LAUNCH
        ok = ok && hipFuncSetAttribute((const void*)fwd_kernel<0, NPHASE>, hipFuncAttributeMaxDynamicSharedMemorySize, LDS_BYTES) == hipSuccess;
        int per_cu = 0; (void)hipOccupancyMaxActiveBlocksPerMultiprocessor(&per_cu, (const void*)fwd_kernel<0, NPHASE>, NTHR, LDS_BYTES); (void)hipGetLastError();
        if (per_cu < 1) fprintf(stderr, "kernel_launch: occupancy query says %d blocks/CU\n", per_cu);
#else
#define SETA(p) ok = ok && hipFuncSetAttribute((const void*)fwd_kernel<p, p + 1>, hipFuncAttributeMaxDynamicSharedMemorySize, LDS_BYTES) == hipSuccess;
        SETA(0) SETA(1) SETA(2) SETA(3) SETA(4) SETA(5) SETA(6) SETA(7) SETA(8) SETA(9)
#undef SETA
#endif
        if (!ok) { fprintf(stderr, "kernel_launch: hipFuncSetAttribute failed\n"); grid = -1; return; }
        grid = cus > 256 ? 256 : cus;
    }
    if (grid < 0) return;
    Args a{};
    for (int i = 0; i < 27; ++i) a.in[i] = (const float*)d_in[i];
    a.out = (float*)d_out; a.ws = (unsigned char*)d_ws;
#if ONE_LAUNCH
    a.ph_lo = 0; a.ph_hi = NPHASE;
#if !USE_CG
    if (hipMemsetAsync((char*)d_ws + WS_CTL, 0, CTL_ZERO_BYTES, stream) != hipSuccess) { fprintf(stderr, "kernel_launch: hipMemsetAsync failed\n"); return; }
#endif
    void* args[] = {&a};
    hipError_t e = hipLaunchCooperativeKernel((const void*)fwd_kernel<0, NPHASE>, dim3(grid), dim3(NTHR), args, LDS_BYTES, stream);
    if (e != hipSuccess) fprintf(stderr, "cooperative launch failed: %s (grid %d)\n", hipGetErrorString(e), grid);
#else
#define LAUNCH(p) hipLaunchKernelGGL((fwd_kernel<p, p + 1>), dim3(grid), dim3(NTHR), LDS_BYTES, stream, a);
    LAUNCH(0) LAUNCH(1) LAUNCH(2) LAUNCH(3) LAUNCH(4) LAUNCH(5) LAUNCH(6) LAUNCH(7) LAUNCH(8) LAUNCH(9)
#undef LAUNCH
#endif
}
```

```cpp
#include <hip/hip_runtime.h>
#include <hip/hip_cooperative_groups.h>
#include <cstdio>
#include <cstdint>
namespace cg = cooperative_groups;

#ifndef ONE_LAUNCH
#define ONE_LAUNCH 1
#endif
#ifndef USE_CG
#define USE_CG 0
#endif
#ifndef PROBE_SEG
#define PROBE_SEG -1
#endif
#ifndef PROBE_S1
#define PROBE_S1 -1
#endif
#ifndef PROBE_ATT
#define PROBE_ATT 0
#endif
#ifndef PROBE_CLK
#define PROBE_CLK -1
#endif
#ifndef PROBE_DOUBLE
#define PROBE_DOUBLE 0
#endif

#define LAS __attribute__((address_space(3)))
#define GAS __attribute__((address_space(1)))
typedef unsigned short bf16_t;
typedef short bf16x8 __attribute__((ext_vector_type(8)));
typedef short s16x4 __attribute__((ext_vector_type(4)));
typedef float f32x4 __attribute__((ext_vector_type(4)));
typedef float f32x16 __attribute__((ext_vector_type(16)));
typedef unsigned u32x4 __attribute__((ext_vector_type(4)));
typedef unsigned u32x2 __attribute__((ext_vector_type(2)));
typedef float f32x2_t __attribute__((ext_vector_type(2)));
typedef __bf16 bf16x2_t __attribute__((ext_vector_type(2)));

constexpr int MTOK = 32768, DM = 1024, ZP = 3328, DFF = 4096;
constexpr int SP = 16384, SS = 2048;
constexpr int ZQ = 0, ZK = 512, ZV = 1024, ZRR = 1536, ZRK = 2048, ZRV = 2560, ZWD = 3072, ZAD = 3136, ZGD = 3200;
constexpr int ZXN2 = 2048;
constexpr float NORM_EPS = 1e-6f, LNX_EPS = 64e-5f;
constexpr float QSCALE = 0.125f * 1.4426950408889634f;
constexpr float LAMBDA_INIT = 0.2f;
constexpr int NCHUNK_P = SP / 64, NCHUNK_S = SS / 64;

constexpr size_t MiB = 1u << 20;
constexpr size_t WS_CTL = 0;
constexpr size_t WS_WIN = 1 * MiB, WS_WOUT = 8 * MiB, WS_W1 = 10 * MiB, WS_W2 = 18 * MiB;
constexpr size_t WS_ROPE = 26 * MiB;
constexpr size_t WS_LORA = 30 * MiB;
constexpr size_t WS_ROWSQ = 31 * MiB;
constexpr size_t WS_BONUS = 33 * MiB;
constexpr size_t WS_Z = 36 * MiB;
constexpr size_t WS_END = 244 * MiB;
constexpr size_t WS_E1 = 244 * MiB;
constexpr size_t WS_TOTAL = 252 * MiB;
static_assert(WS_Z + (size_t)MTOK * ZP * 2 <= WS_END, "ws map");
constexpr size_t SLOT_BYTES = 32768;

__device__ __forceinline__ unsigned cvt_pk_bf16(float lo, float hi) { f32x2_t v = {lo, hi}; bf16x2_t b = __builtin_convertvector(v, bf16x2_t); return __builtin_bit_cast(unsigned, b); }
__device__ __forceinline__ float bf2f(unsigned short u) { return __uint_as_float(((unsigned)u) << 16); }
__device__ __forceinline__ float bflo(unsigned u) { return __uint_as_float(u << 16); }
__device__ __forceinline__ float bfhi(unsigned u) { return __uint_as_float(u & 0xffff0000u); }
__device__ __forceinline__ unsigned short f2bf(float f) { return (unsigned short)(cvt_pk_bf16(f, 0.f) & 0xffffu); }
__device__ __forceinline__ float wave_sum(float v) {
#pragma unroll
    for (int o = 1; o < 64; o <<= 1) v += __shfl_xor(v, o);
    return v;
}
__device__ __forceinline__ float wave_sum_dpp(float v) {
    int x = __float_as_int(v);
    v += __int_as_float(__builtin_amdgcn_update_dpp(0, x, 0xB1, 0xF, 0xF, true)); x = __float_as_int(v);
    v += __int_as_float(__builtin_amdgcn_update_dpp(0, x, 0x4E, 0xF, 0xF, true)); x = __float_as_int(v);
    v += __int_as_float(__builtin_amdgcn_update_dpp(0, x, 0x124, 0xF, 0xF, true)); x = __float_as_int(v);
    v += __int_as_float(__builtin_amdgcn_update_dpp(0, x, 0x128, 0xF, 0xF, true)); x = __float_as_int(v);
    const float a = __int_as_float(__builtin_amdgcn_readlane(x, 0)), b = __int_as_float(__builtin_amdgcn_readlane(x, 16)), c = __int_as_float(__builtin_amdgcn_readlane(x, 32)), d = __int_as_float(__builtin_amdgcn_readlane(x, 48));
    return (a + b) + (c + d);
}
__device__ __forceinline__ void wave_sum8(float (&s)[8], int lane) {
    float f[4];
#pragma unroll
    for (int i = 0; i < 4; ++i) { auto rr = __builtin_amdgcn_permlane32_swap(__float_as_uint(s[i]), __float_as_uint(s[i + 4]), false, false); f[i] = __uint_as_float(rr[0]) + __uint_as_float(rr[1]); }
    const bool b4 = (lane >> 4) & 1, b3 = (lane >> 3) & 1;
    float g[2];
#pragma unroll
    for (int i = 0; i < 2; ++i) { const float keep = b4 ? f[i + 2] : f[i], send = b4 ? f[i] : f[i + 2];
        g[i] = keep + __int_as_float(__builtin_amdgcn_ds_swizzle(__float_as_int(send), 0x401F)); }
    const float keep = b3 ? g[1] : g[0], send = b3 ? g[0] : g[1];
    float h = keep + __int_as_float(__builtin_amdgcn_update_dpp(0, __float_as_int(send), 0x128, 0xF, 0xF, true));
    h += __int_as_float(__builtin_amdgcn_update_dpp(0, __float_as_int(h), 0x141, 0xF, 0xF, true));
    h += __int_as_float(__builtin_amdgcn_update_dpp(0, __float_as_int(h), 0xB1, 0xF, 0xF, true));
    h += __int_as_float(__builtin_amdgcn_update_dpp(0, __float_as_int(h), 0x4E, 0xF, 0xF, true));
    const int hx = __float_as_int(h);
#pragma unroll
    for (int k = 0; k < 8; ++k) s[k] = __int_as_float(__builtin_amdgcn_readlane(hx, 8 * k));
}
#define LDS_WAIT() asm volatile("s_waitcnt lgkmcnt(0)" ::: "memory")
#define VM_WAIT() asm volatile("s_waitcnt vmcnt(0)" ::: "memory")
#define LBAR() asm volatile("s_waitcnt lgkmcnt(0)\n\ts_barrier" ::: "memory")

namespace pg8 {
constexpr int BM = 256, BK = 64, HALF = 128, HTB = HALF * BK * 2, STAGE_BYTES = 8 * HTB, NXCD = 8, WGM = 8;
__host__ __device__ __forceinline__ int lds_byte(int r, int c) { const int st = (r >> 4) * 2 + (c >> 5), rr = r & 15, cc = c & 31, ob = rr * 64 + cc * 2; return st * 1024 + (ob ^ (((ob >> 9) & 1) << 5)); }
__host__ __device__ __forceinline__ void stage_rc(int b, int& R, int& C) { const int st = b / 1024, sb = b % 1024, swz = sb ^ (((sb >> 9) & 1) << 5); R = (st >> 1) * 16 + swz / 64; C = (st & 1) * 32 + (swz % 64) / 2; }
__host__ __device__ __forceinline__ int perm32(int rho) { const int n = rho >> 4, i = rho & 15; return 8 * (i >> 2) + 4 * n + (i & 3); }
struct Unit { int pm, pn; };
struct Gemm { const char* A; const bf16_t* Bt; int M, N, K; int lda; int jkt; int jbytes; };
struct StaticOrder {
    int nM, nN, nwg, G, c;
    __host__ __device__ void init(int M, int N, int G_, int c_) { nM = M / BM; nN = N / BM; nwg = nM * nN; G = G_; c = c_; }
    __host__ __device__ bool next(int i, Unit& u) const {
        const long L = (long)i * G + c; if (L >= nwg) return false;
        int wgid = (int)L; { const int q = nwg / NXCD, r = nwg % NXCD, xcd = wgid % NXCD, off = wgid / NXCD; wgid = (xcd < r ? xcd * (q + 1) : r * (q + 1) + (xcd - r) * q) + off; }
        const int nig = WGM * nN, gid = wgid / nig, fm = gid * WGM, gsz = (nM - fm) < WGM ? (nM - fm) : WGM;
        u.pm = fm + ((wgid % nig) % gsz); u.pn = (wgid % nig) / gsz; return true;
    }
};

struct EpiZ {
    static constexpr bool PERM = true;
    bf16_t* O; int ldc;
    __device__ __forceinline__ void operator()(const f32x4 (&acc)[2][2][4][2], const Unit& u, int wr, int wc, int fr, int fq) const {
        const int row0 = u.pm * BM + wr * 64 + fr, col0 = u.pn * BM + wc * 32 + 8 * fq;
#pragma unroll
        for (int ai = 0; ai < 2; ++ai)
#pragma unroll
            for (int m = 0; m < 4; ++m) { bf16_t* rowp = O + (size_t)(row0 + ai * HALF + m * 16) * ldc + col0;
#pragma unroll
                for (int bj = 0; bj < 2; ++bj) { const f32x4 v0 = acc[ai][bj][m][0], v1 = acc[ai][bj][m][1];
                    u32x4 w; w.x = cvt_pk_bf16(v0[0], v0[1]); w.y = cvt_pk_bf16(v0[2], v0[3]); w.z = cvt_pk_bf16(v1[0], v1[1]); w.w = cvt_pk_bf16(v1[2], v1[3]);
                    *(u32x4*)(rowp + bj * HALF) = w; } }
    }
};
struct EpiOut {
    static constexpr bool PERM = true;
    const float* xp; const float* xs; float* out; bf16_t* Z; float* rowsq;
    __device__ __forceinline__ void operator()(const f32x4 (&acc)[2][2][4][2], const Unit& u, int wr, int wc, int fr, int fq) const {
        const int col0 = u.pn * BM + wc * 32 + 8 * fq;
#pragma unroll
        for (int ai = 0; ai < 2; ++ai)
#pragma unroll
            for (int m = 0; m < 4; ++m) { const int r = u.pm * BM + ai * HALF + wr * 64 + m * 16 + fr;
                const float* xr = (r < SP ? xp + (size_t)r * DM : xs + (size_t)(r - SP) * DM) + col0; float* orow = out + (size_t)r * DM + col0; bf16_t* zr = Z + (size_t)r * ZP + ZXN2 + col0;
                float ss = 0.f;
#pragma unroll
                for (int bj = 0; bj < 2; ++bj) { const f32x4 x0 = *(const f32x4*)(xr + bj * HALF), x1 = *(const f32x4*)(xr + bj * HALF + 4);
                    const f32x4 o0 = x0 + acc[ai][bj][m][0], o1 = x1 + acc[ai][bj][m][1];
                    *(f32x4*)(orow + bj * HALF) = o0; *(f32x4*)(orow + bj * HALF + 4) = o1;
                    ss += ((o0[0] * o0[0] + o0[1] * o0[1]) + (o0[2] * o0[2] + o0[3] * o0[3])) + ((o1[0] * o1[0] + o1[1] * o1[1]) + (o1[2] * o1[2] + o1[3] * o1[3]));
                    u32x4 w; w.x = cvt_pk_bf16(o0[0], o0[1]); w.y = cvt_pk_bf16(o0[2], o0[3]); w.z = cvt_pk_bf16(o1[0], o1[1]); w.w = cvt_pk_bf16(o1[2], o1[3]); *(u32x4*)(zr + bj * HALF) = w; }
                ss += __shfl_xor(ss, 16); ss += __shfl_xor(ss, 32);
                if (fq == 0) rowsq[(size_t)r * 16 + u.pn * 4 + wc] = ss;
                if (m & 1) asm volatile("" ::: "memory"); }
    }
};
struct EpiUp {
    static constexpr bool PERM = true;
    char* H; const float* rowsq; int row_off;
    __device__ __forceinline__ void operator()(const f32x4 (&acc)[2][2][4][2], const Unit& u, int wr, int wc, int fr, int fq) const {
        const int row0 = u.pm * BM + wr * 64 + fr, col0 = u.pn * BM + wc * 32 + 8 * fq;
#pragma unroll
        for (int ai = 0; ai < 2; ++ai)
#pragma unroll
            for (int m = 0; m < 4; ++m) { const int r = row0 + ai * HALF + m * 16; const f32x4* rq = (const f32x4*)(rowsq + (size_t)(row_off + r) * 16);
                const f32x4 q0 = rq[0], q1 = rq[1], q2 = rq[2], q3 = rq[3];
                const float ssum = ((q0[0] + q0[1]) + (q0[2] + q0[3])) + ((q1[0] + q1[1]) + (q1[2] + q1[3])) + ((q2[0] + q2[1]) + (q2[2] + q2[3])) + ((q3[0] + q3[1]) + (q3[2] + q3[3]));
                const float rstd = __builtin_amdgcn_rsqf(ssum * (1.0f / DM) + NORM_EPS);
                char* rowp = H + (size_t)r * 13312;
#pragma unroll
                for (int bj = 0; bj < 2; ++bj) { const int c = col0 + bj * HALF; f32x4 v0 = acc[ai][bj][m][0] * rstd, v1 = acc[ai][bj][m][1] * rstd;
#pragma unroll
                    for (int e = 0; e < 4; ++e) { const float a = fmaxf(v0[e], 0.f), b = fmaxf(v1[e], 0.f); v0[e] = a * a; v1[e] = b * b; }
                    u32x4 w; w.x = cvt_pk_bf16(v0[0], v0[1]); w.y = cvt_pk_bf16(v0[2], v0[3]); w.z = cvt_pk_bf16(v1[0], v1[1]); w.w = cvt_pk_bf16(v1[2], v1[3]);
                    *(u32x4*)(rowp + (size_t)c * 2 + (c >= 2048 ? 2560 : 0)) = w; } }
    }
};
struct EpiDown {
    static constexpr bool PERM = true;
    float* out; int row_off;
    __device__ __forceinline__ void operator()(const f32x4 (&acc)[2][2][4][2], const Unit& u, int wr, int wc, int fr, int fq) const {
        const int col0 = u.pn * BM + wc * 32 + 8 * fq;
#pragma unroll
        for (int ai = 0; ai < 2; ++ai)
#pragma unroll
            for (int m = 0; m < 4; ++m) { const int r = row_off + u.pm * BM + ai * HALF + wr * 64 + m * 16 + fr; float* orow = out + (size_t)r * DM + col0;
#pragma unroll
                for (int bj = 0; bj < 2; ++bj) { const f32x4 x0 = *(const f32x4*)(orow + bj * HALF), x1 = *(const f32x4*)(orow + bj * HALF + 4);
                    *(f32x4*)(orow + bj * HALF) = x0 + acc[ai][bj][m][0]; *(f32x4*)(orow + bj * HALF + 4) = x1 + acc[ai][bj][m][1]; }
                if (m & 1) asm volatile("" ::: "memory"); }
    }
};

template <class Epi, class Sched, bool ALIGN_EPI>
__device__ __forceinline__ void gemm_phase(LAS unsigned char* lds, const Gemm g, const Sched& S, const Epi& E) {
    int tid_ = threadIdx.x; asm volatile("" : "+v"(tid_));
    const int tid = tid_, wid = __builtin_amdgcn_readfirstlane(tid >> 6), lane = tid & 63, wr = wid >> 2, wc = wid & 3, fr = lane & 15, fq = lane >> 4;
    const int K = g.K, nt = K / BK;
    unsigned voffA[2], voffB[2];
#pragma unroll
    for (int i = 0; i < 2; ++i) { int R, C; stage_rc(tid * 16 + i * 8192, R, C); const int Rb = Epi::PERM ? ((R & ~31) + perm32(R & 31)) : R;
        voffA[i] = (unsigned)(R * g.lda + C * 2); voffB[i] = (unsigned)(Rb * K + C) * 2u; }
    const size_t kstep = (size_t)(BK * 2);
    const size_t hstepA = (size_t)HALF * g.lda, tstepA = 2 * hstepA;
    const size_t hstepB = (size_t)HALF * K * 2, tstepB = 2 * hstepB;
    const unsigned ldsw = (unsigned)wid * 1024u;
    const int aoff = lds_byte(wr * 64 + fr, fq * 8), boff = lds_byte(wc * 32 + fr, fq * 8);
#define PG8_AOFF(kt) ((size_t)(kt) * kstep + ((kt) >= g.jkt ? (size_t)g.jbytes : (size_t)0))
#define PG8_SA(b, h) (((b) * 2 + (h)) * HTB)
#define PG8_SB(b, h) ((4 + (b) * 2 + (h)) * HTB)
#define PG8_STAGE(bufoff, gbase, voff) do { _Pragma("unroll") for (int _i = 0; _i < 2; ++_i) \
        __builtin_amdgcn_global_load_lds((const unsigned*)((const char*)(gbase) + (voff)[_i]), (LAS unsigned*)(lds + (bufoff) + ldsw + _i * 8192), 16, 0, 0); } while (0)
#define PG8_LDA(dst, b, h) do { _Pragma("unroll") for (int m = 0; m < 4; ++m) _Pragma("unroll") for (int k = 0; k < 2; ++k) dst[m][k] = *(const LAS bf16x8*)(lds + PG8_SA(b, h) + aoff + m * 2048 + k * 1024); } while (0)
#define PG8_LDB(dst, b, h) do { _Pragma("unroll") for (int n = 0; n < 2; ++n) _Pragma("unroll") for (int k = 0; k < 2; ++k) dst[n][k] = *(const LAS bf16x8*)(lds + PG8_SB(b, h) + boff + n * 2048 + k * 1024); } while (0)
#define PG8_MMA(ai, bj, At, Bt) do { __builtin_amdgcn_s_setprio(1); _Pragma("unroll") for (int m = 0; m < 4; ++m) _Pragma("unroll") for (int n = 0; n < 2; ++n) _Pragma("unroll") for (int k = 0; k < 2; ++k) \
        acc[ai][bj][m][n] = __builtin_amdgcn_mfma_f32_16x16x32_bf16(Bt[n][k], At[m][k], acc[ai][bj][m][n], 0, 0, 0); __builtin_amdgcn_s_setprio(0); } while (0)
#define PG8_WAIT_V(n) asm volatile("s_waitcnt vmcnt(" #n ")" ::: "memory")
#define PG8_WAIT_L(n) asm volatile("s_waitcnt lgkmcnt(" #n ")" ::: "memory")
#define PG8_BAR __builtin_amdgcn_s_barrier()
#define PG8_SCHED __builtin_amdgcn_sched_barrier(0)
    Unit cur, nxt; int ui = 0;
    if (!S.next(0, cur)) return;
    f32x4 acc[2][2][4][2];
#pragma unroll
    for (int a = 0; a < 2; ++a)
#pragma unroll
        for (int b = 0; b < 2; ++b)
#pragma unroll
            for (int m = 0; m < 4; ++m)
#pragma unroll
                for (int n = 0; n < 2; ++n) acc[a][b][m][n] = (f32x4){0.f, 0.f, 0.f, 0.f};
    bf16x8 At[4][2], B0[2][2], B1[2][2];
    const char* cA = g.A + (size_t)cur.pm * tstepA; const char* cB = (const char*)g.Bt + (size_t)cur.pn * tstepB;
    {
        PG8_STAGE(PG8_SB(0, 0), cB, voffB); PG8_STAGE(PG8_SB(0, 1), cB + hstepB, voffB); PG8_STAGE(PG8_SA(0, 0), cA + PG8_AOFF(0), voffA); PG8_STAGE(PG8_SA(0, 1), cA + hstepA + PG8_AOFF(0), voffA);
        if (wr == 1) PG8_BAR;
        PG8_WAIT_V(2); PG8_BAR;
        PG8_STAGE(PG8_SB(1, 0), cB + kstep, voffB); PG8_STAGE(PG8_SA(1, 0), cA + PG8_AOFF(1), voffA); PG8_STAGE(PG8_SB(1, 1), cB + hstepB + kstep, voffB);
        PG8_WAIT_V(6); PG8_BAR;
    }
    for (;;) {
        const bool has_next = S.next(ui + 1, nxt);
        const char* nA = has_next ? g.A + (size_t)nxt.pm * tstepA : cA; const char* nB = has_next ? (const char*)g.Bt + (size_t)nxt.pn * tstepB : cB;
        for (int t = 0; t < nt; t += 2) {
            const bool last = (t == nt - 2);
            const char* a1 = cA + PG8_AOFF(t + 1);
            const char* a2 = last ? nA + PG8_AOFF(0) : cA + PG8_AOFF(t + 2); const char* b2 = last ? nB : cB + (size_t)(t + 2) * kstep;
            const char* a3 = last ? nA + PG8_AOFF(1) : cA + PG8_AOFF(t + 3); const char* b3 = b2 + kstep;
            PG8_LDB(B0, 0, 0); PG8_LDB(B1, 0, 1); PG8_SCHED; PG8_LDA(At, 0, 0); PG8_STAGE(PG8_SA(1, 1), a1 + hstepA, voffA);
            PG8_WAIT_V(8); PG8_WAIT_L(0); PG8_BAR; PG8_MMA(0, 0, At, B0); PG8_MMA(0, 1, At, B1); PG8_BAR; PG8_SCHED;
            PG8_LDA(At, 0, 1); PG8_STAGE(PG8_SB(0, 0), b2, voffB); PG8_STAGE(PG8_SB(0, 1), b2 + hstepB, voffB); PG8_STAGE(PG8_SA(0, 0), a2, voffA);
            PG8_WAIT_V(8); PG8_WAIT_L(0); PG8_BAR; PG8_MMA(1, 0, At, B0); PG8_MMA(1, 1, At, B1); PG8_BAR; PG8_SCHED;
            PG8_LDB(B0, 1, 0); PG8_LDB(B1, 1, 1); PG8_SCHED; PG8_LDA(At, 1, 0); PG8_STAGE(PG8_SA(0, 1), a2 + hstepA, voffA);
            PG8_WAIT_V(8); PG8_WAIT_L(0); PG8_BAR; PG8_MMA(0, 0, At, B0); PG8_MMA(0, 1, At, B1); PG8_BAR; PG8_SCHED;
            PG8_LDA(At, 1, 1); PG8_STAGE(PG8_SB(1, 0), b3, voffB); PG8_STAGE(PG8_SB(1, 1), b3 + hstepB, voffB); PG8_STAGE(PG8_SA(1, 0), a3, voffA);
            PG8_WAIT_V(8); PG8_WAIT_L(0); PG8_BAR; PG8_MMA(1, 0, At, B0); PG8_MMA(1, 1, At, B1); PG8_BAR; PG8_SCHED;
        }
        if constexpr (ALIGN_EPI) { if (wr == 0) PG8_BAR; }
        E(acc, cur, wr, wc, fr, fq);
        if (!has_next) break;
#pragma unroll
        for (int a = 0; a < 2; ++a)
#pragma unroll
            for (int b = 0; b < 2; ++b)
#pragma unroll
                for (int m = 0; m < 4; ++m)
#pragma unroll
                    for (int n = 0; n < 2; ++n) acc[a][b][m][n] = (f32x4){0.f, 0.f, 0.f, 0.f};
        cur = nxt; cA = nA; cB = nB; ++ui;
        if constexpr (ALIGN_EPI) { if (wr == 1) PG8_BAR; }
    }
    PG8_WAIT_V(0);
    if constexpr (!ALIGN_EPI) { if (wr == 0) PG8_BAR; }
    PG8_BAR;
#undef PG8_AOFF
#undef PG8_SA
#undef PG8_SB
#undef PG8_STAGE
#undef PG8_LDA
#undef PG8_LDB
#undef PG8_MMA
#undef PG8_WAIT_V
#undef PG8_WAIT_L
#undef PG8_BAR
#undef PG8_SCHED
}
}

constexpr int NWAVES = 8, NTHR = 512;
constexpr int LDS_BYTES = 163840;
struct Args {
    const float* in[27]; float* out; unsigned char* ws; int ph_lo, ph_hi;
};
struct Frame {
    LAS unsigned char* lds; int tid, lane, wave, vcu, G;
};
constexpr int PTRS_OFF = LDS_BYTES - 256;
__device__ __forceinline__ const float* inp(LAS unsigned char* lds, int i) { return *(const float* LAS*)(lds + PTRS_OFF + i * 8); }
__device__ __forceinline__ float gld(const float* p) { return *(const GAS float*)p; }
__device__ __forceinline__ int seq_row0(int q) { return q == 0 ? 0 : SP + (q - 1) * SS; }
__device__ __forceinline__ int seq_len(int q) { return q == 0 ? SP : SS; }

__device__ __forceinline__ void p0_transpose_item(const float* W, int K, int N, bf16_t* WT, const float* kscale, LAS float* scr, int item, int lane) {
    const int nblk = N / 32, kb = item / nblk, nb = item % nblk, k0 = 64 * kb, n0 = 32 * nb;
    {
        float v[32];
#pragma unroll
        for (int i = 0; i < 32; ++i) { const int kk = 2 * i + (lane >> 5); v[i] = W[(size_t)(k0 + kk) * N + n0 + (lane & 31)]; }
        if (kscale) {
#pragma unroll
            for (int i = 0; i < 32; ++i) v[i] *= kscale[k0 + 2 * i + (lane >> 5)]; }
#pragma unroll
        for (int i = 0; i < 32; ++i) scr[(2 * i + (lane >> 5)) * 33 + (lane & 31)] = v[i];
    }
    LDS_WAIT(); asm volatile("" ::: "memory");
    const int c = lane & 7;
#pragma unroll
    for (int j = 0; j < 4; ++j) { const int n = (lane >> 3) + 8 * j; const LAS float* s = scr + (8 * c) * 33 + n;
        u32x4 o; o.x = cvt_pk_bf16(s[0 * 33], s[1 * 33]); o.y = cvt_pk_bf16(s[2 * 33], s[3 * 33]); o.z = cvt_pk_bf16(s[4 * 33], s[5 * 33]); o.w = cvt_pk_bf16(s[6 * 33], s[7 * 33]);
        *(u32x4*)(WT + (size_t)(n0 + n) * K + k0 + 8 * c) = o; }
    LDS_WAIT(); asm volatile("" ::: "memory");
}
__device__ __forceinline__ void p0_prologue(const Frame& F, const Args& a) {
    LAS float* scr = (LAS float*)(F.lds + F.wave * 16384);
    const int gw = F.vcu * NWAVES + F.wave, NGW = F.G * NWAVES;
    unsigned char* ws = a.ws;
    constexpr int I_IN = (DM / 64) * (ZP / 32), I_O = (DM / 64) * (DM / 32), I_1 = (DM / 64) * (DFF / 32), I_2 = (DFF / 64) * (DM / 32);
    for (int it = gw; it < I_IN + I_O + I_1 + I_2; it += NGW) {
        int r = it;
        if (r < I_IN) { p0_transpose_item(a.in[3], DM, ZP, (bf16_t*)(ws + WS_WIN), nullptr, scr, r, F.lane); continue; } r -= I_IN;
        if (r < I_O) { p0_transpose_item(a.in[23], DM, DM, (bf16_t*)(ws + WS_WOUT), nullptr, scr, r, F.lane); continue; } r -= I_O;
        if (r < I_1) { p0_transpose_item(a.in[25], DM, DFF, (bf16_t*)(ws + WS_W1), a.in[24], scr, r, F.lane); continue; } r -= I_1;
        p0_transpose_item(a.in[26], DFF, DM, (bf16_t*)(ws + WS_W2), nullptr, scr, r, F.lane);
    }
    bf16_t* XN = (bf16_t*)a.out; const float* g1 = a.in[2];
    for (int m = gw; m < MTOK; m += 4 * NGW) {
        f32x4 v[4][4]; float ss[4];
#pragma unroll
        for (int r = 0; r < 4; ++r) { int mr = m + r * NGW; mr = mr < MTOK ? mr : MTOK - 1;
            const float* xrow = mr < SP ? a.in[0] + (size_t)mr * DM : a.in[1] + (size_t)(mr - SP) * DM;
#pragma unroll
            for (int j = 0; j < 4; ++j) v[r][j] = ((const f32x4*)xrow)[F.lane + 64 * j]; }
#pragma unroll
        for (int r = 0; r < 4; ++r) { float s0 = 0.f;
#pragma unroll
            for (int j = 0; j < 4; ++j) s0 += (v[r][j][0] * v[r][j][0] + v[r][j][1] * v[r][j][1]) + (v[r][j][2] * v[r][j][2] + v[r][j][3] * v[r][j][3]);
            ss[r] = __builtin_amdgcn_rsqf(wave_sum_dpp(s0) * (1.f / DM) + NORM_EPS); }
#pragma unroll
        for (int j = 0; j < 4; ++j) { const f32x4 gv = ((const f32x4*)g1)[F.lane + 64 * j];
#pragma unroll
            for (int r = 0; r < 4; ++r) { const int mr = m + r * NGW;
                if (mr < MTOK) { u32x2 w; w.x = cvt_pk_bf16(v[r][j][0] * ss[r] * gv[0], v[r][j][1] * ss[r] * gv[1]); w.y = cvt_pk_bf16(v[r][j][2] * ss[r] * gv[2], v[r][j][3] * ss[r] * gv[3]);
                    ((u32x2*)(XN + (size_t)mr * DM))[F.lane + 64 * j] = w; } } }
    }
    const int gt = F.vcu * NTHR + F.tid, NGT = F.G * NTHR;
    float* rope = (float*)(ws + WS_ROPE);
    for (int e = gt; e < SP * 32; e += NGT) { const int pos = e >> 5, i = e & 31;
        const float invf = 1.0f / powf(10000.0f, (float)(2 * i) / 64.0f); const float ang = (float)pos * invf; float sn, cs; sincosf(ang, &sn, &cs);
        rope[2 * e] = cs; rope[2 * e + 1] = sn; }
    bf16_t* wupT = (bf16_t*)(ws + WS_LORA); bf16_t* aupT = wupT + 2 * 512 * 64; bf16_t* gupT = aupT + 2 * 512 * 64;
    for (int e = gt; e < 2 * 512 * 64; e += NGT) { const int d = e >> 15, c = (e >> 6) & 511, r = e & 63;
        wupT[e] = f2bf(a.in[14][((size_t)d * 64 + r) * 512 + c]); aupT[e] = f2bf(a.in[16][((size_t)d * 64 + r) * 512 + c]); }
    for (int e = gt; e < 512 * 128; e += NGT) { const int c = e >> 7, r = e & 127; gupT[e] = f2bf(a.in[17][(size_t)r * 512 + c]); }
}

__device__ __forceinline__ void qk_prep(const Frame& F, const Args& a) {
    const int gw = F.vcu * NWAVES + F.wave, NGW = F.G * NWAVES;
    bf16_t* Z = (bf16_t*)(a.ws + WS_Z); const float* rope = (const float*)(a.ws + WS_ROPE);
    const int g = F.lane >> 2, qd = F.lane & 3;
    const float* gain = (g < 8) ? a.in[4] : a.in[5];
    float glo[8], ghi[8];
#pragma unroll
    for (int j = 0; j < 8; ++j) { glo[j] = gain[8 * qd + j]; ghi[j] = gain[32 + 8 * qd + j]; }
    const float osc = (g < 8) ? QSCALE : 1.0f;
    const float mpw = a.in[11][ZWD - ZRR + F.lane], mnw = a.in[12][ZWD - ZRR + F.lane], mpa = a.in[11][ZAD - ZRR + F.lane], mna = a.in[12][ZAD - ZRR + F.lane];
    for (int blk = gw; blk < MTOK / 16; blk += NGW) {
        const int m0 = blk * 16;
        const int pos0 = m0 < SP ? m0 : ((m0 - SP) & (SS - 1)); const int S = m0 < SP ? SP : SS;
        {
            float zw[18], za[18]; const bf16_t* zr = Z + (size_t)m0 * ZP; const int j = F.lane;
#pragma unroll
            for (int i = 0; i < 18; ++i) { const int pp = pos0 - 1 + i; const bool ok = pp >= 0 && pp < S; const long ro = (long)(ok ? i - 1 : 0) * ZP;
                const float w_ = bf2f(zr[ro + ZWD + j]), a_ = bf2f(zr[ro + ZAD + j]); zw[i] = ok ? w_ : 0.f; za[i] = ok ? a_ : 0.f; }
            bf16_t* e1 = (bf16_t*)(a.ws + WS_E1) + (size_t)m0 * 128;
#pragma unroll
            for (int i = 0; i < 16; ++i) { const float wc = zw[i + 1], ac = za[i + 1];
                const float ws_ = wc + mpw * (zw[i] - wc) + mnw * (zw[i + 2] - wc), as_ = ac + mpa * (za[i] - ac) + mna * (za[i + 2] - ac);
                e1[i * 128 + j] = f2bf(1.0f - 2.0f * __builtin_amdgcn_rcpf(__expf(2.0f * ws_) + 1.0f)); e1[i * 128 + 64 + j] = f2bf(as_); }
        }
#pragma unroll 4
        for (int i = 0; i < 16; ++i) {
            const int m = m0 + i, pos = pos0 + i;
            bf16_t* p = Z + (size_t)m * ZP + g * 64 + 8 * qd;
            const u32x4 lo4 = *(const u32x4*)p, hi4 = *(const u32x4*)(p + 32);
            float lo[8], hi[8];
#pragma unroll
            for (int j = 0; j < 4; ++j) { lo[2 * j] = bflo(lo4[j]); lo[2 * j + 1] = bfhi(lo4[j]); hi[2 * j] = bflo(hi4[j]); hi[2 * j + 1] = bfhi(hi4[j]); }
            float ss = 0.f;
#pragma unroll
            for (int j = 0; j < 8; ++j) ss += lo[j] * lo[j] + hi[j] * hi[j];
            ss += __shfl_xor(ss, 1); ss += __shfl_xor(ss, 2);
            const float rstd = __builtin_amdgcn_rsqf(ss * (1.f / 64.f) + NORM_EPS);
            const f32x4* rp = (const f32x4*)(rope + ((size_t)pos * 32 + 8 * qd) * 2);
            float ol[8], oh[8];
#pragma unroll
            for (int j2 = 0; j2 < 4; ++j2) { const f32x4 cs = rp[j2];
#pragma unroll
                for (int e = 0; e < 2; ++e) { const int j = 2 * j2 + e; const float c = cs[2 * e], sn = cs[2 * e + 1]; const float l = lo[j] * rstd * glo[j], h = hi[j] * rstd * ghi[j];
                    ol[j] = (l * c - h * sn) * osc; oh[j] = (h * c + l * sn) * osc; } }
            u32x4 wl, wh;
#pragma unroll
            for (int j = 0; j < 4; ++j) { wl[j] = cvt_pk_bf16(ol[2 * j], ol[2 * j + 1]); wh[j] = cvt_pk_bf16(oh[2 * j], oh[2 * j + 1]); }
            *(u32x4*)p = wl; *(u32x4*)(p + 32) = wh;
        }
    }
}

namespace att {
constexpr int KSLOT = 8192, VSLOT = 16384, NKS = 4, NVS = 3;
constexpr int L_K = 0, L_V = NKS * KSLOT, L_WS = L_V + NVS * VSLOT, L_ST = L_WS + NWAVES * 256, L_END = L_ST + NWAVES * 8192;
static_assert(L_END <= PTRS_OFF, "attention lds");
__device__ __forceinline__ int crow(int r, int hi) { return (r & 3) + 8 * (r >> 2) + 4 * hi; }
__device__ __forceinline__ void glds16(const void* gsrc, unsigned lds_dst) { unsigned keep;
    asm volatile("s_mov_b32 %0, m0\n\ts_mov_b32 m0, %2\n\ts_nop 0\n\tglobal_load_lds_dwordx4 %1, off\n\ts_mov_b32 m0, %0" : "=&s"(keep) : "v"(gsrc), "s"(lds_dst) : "memory"); }
typedef short v4i16_t __attribute__((ext_vector_type(4)));
typedef const LAS char* lds_cptr;
__device__ __forceinline__ s16x4 vtr(lds_cptr p) { return __builtin_bit_cast(s16x4, __builtin_amdgcn_ds_read_tr16_b64_v4i16((LAS v4i16_t*)p)); }
#define SBAR() __builtin_amdgcn_sched_barrier(0)
#define WAIT_BAR(N) asm volatile("s_waitcnt vmcnt(" #N ") lgkmcnt(0)\n\ts_barrier" ::: "memory")
__device__ __forceinline__ void kload8(bf16x8* kf, lds_cptr kp) {
    kf[0] = *(const LAS bf16x8*)(kp);        kf[1] = *(const LAS bf16x8*)(kp + 512);
    kf[2] = *(const LAS bf16x8*)(kp + 2048); kf[3] = *(const LAS bf16x8*)(kp + 2560);
    kf[4] = *(const LAS bf16x8*)(kp + 4096); kf[5] = *(const LAS bf16x8*)(kp + 4608);
    kf[6] = *(const LAS bf16x8*)(kp + 6144); kf[7] = *(const LAS bf16x8*)(kp + 6656);
}
__device__ __forceinline__ void kload2(bf16x8* kf, lds_cptr kp, int j) { kf[2 * j] = *(const LAS bf16x8*)(kp + j * 2048); kf[2 * j + 1] = *(const LAS bf16x8*)(kp + j * 2048 + 512); }

__device__ __forceinline__ void attn_unit(int row0, int S, int h, int qb, bf16_t* Z, LAS unsigned char* shm, float lam, const float* subln_g, bf16_t* Ob, int opitch) {
    int tid_ = threadIdx.x; asm volatile("" : "+v"(tid_));
    const int tid = tid_, lane = tid & 63, r32 = lane & 31, hi = lane >> 5; const int wid = __builtin_amdgcn_readfirstlane(tid >> 6);
    const unsigned lds0 = (unsigned)(uintptr_t)shm;
    LAS float* wsf = (LAS float*)(shm + L_WS) + wid * 64;
    LAS bf16_t* stash = (LAS bf16_t*)(shm + L_ST) + wid * 4096;
    const int NT = S / 64;
    const size_t qrow = (size_t)(row0 + qb * 256 + wid * 32);
    const lds_cptr shm3 = (lds_cptr)shm;
    const lds_cptr kp0 = shm3 + L_K + hi * 1024 + r32 * 16;
    const lds_cptr vp0 = shm3 + L_V + ((lane >> 4) & 1) * 32 + (lane & 3) * 8 + (4 * hi + ((lane & 15) >> 2)) * 64;
    f32x16 o[4];
#pragma unroll 1
    for (int c = 0; c < 2; ++c) {
        const bf16_t* Qw = Z + qrow * ZP + ZQ + h * 128 + c * 64;
        const bf16_t* Kh = Z + (size_t)row0 * ZP + ZK + h * 128 + c * 64;
        const bf16_t* Vh = Z + (size_t)row0 * ZP + ZV + h * 128;
        const int p0 = 2 * wid, p1 = 2 * wid + 1;
        const unsigned koff = (unsigned)(lane * ZP + wid * 8) * 2u;
        const unsigned voff0 = (unsigned)((16 * (p0 & 3) + (lane >> 2)) * ZP + (p0 >> 2) * 32 + (lane & 3) * 8) * 2u;
        const unsigned voff1 = (unsigned)((16 * (p1 & 3) + (lane >> 2)) * ZP + (p1 >> 2) * 32 + (lane & 3) * 8) * 2u;
        const unsigned kdst = lds0 + L_K + wid * 1024, vdst0 = lds0 + L_V + p0 * 1024, vdst1 = lds0 + L_V + p1 * 1024;
#define DMA_K(t, si) glds16((const char*)(Kh + (size_t)(t) * 64 * ZP) + koff, (unsigned)__builtin_amdgcn_readfirstlane(kdst + (si) * KSLOT))
#define DMA_V(t, si) do { const char* vb_ = (const char*)(Vh + (size_t)(t) * 64 * ZP); glds16(vb_ + voff0, (unsigned)__builtin_amdgcn_readfirstlane(vdst0 + (si) * VSLOT)); glds16(vb_ + voff1, (unsigned)__builtin_amdgcn_readfirstlane(vdst1 + (si) * VSLOT)); } while (0)
        DMA_K(0, 0); DMA_V(0, 0); DMA_K(1, 1);
        bf16x8 qr[4];
#pragma unroll
        for (int d0 = 0; d0 < 4; ++d0) qr[d0] = *(const bf16x8*)(Qw + (size_t)r32 * ZP + d0 * 16 + hi * 8);
#pragma unroll
        for (int d0 = 0; d0 < 4; ++d0) o[d0] = f32x16{};
        float l_reg = 0.f;
        bf16x8 kf[4];
        f32x16 pA0, pA1, pB0, pB1;
        int i_prev = 0, i_cur = 0, i_next = 1;
        int k_cur = 0, k_next = 1;
#define ROT() do { i_prev = i_cur; i_cur = i_next; i_next = (i_next == NVS - 1) ? 0 : i_next + 1; k_cur = k_next; k_next = (k_next + 1) & 3; } while (0)
#define KFRAG(slot, i) (*(const LAS bf16x8*)(kp0 + (slot) * KSLOT + ((i) >> 1) * 2048 + ((i) & 1) * 512))
        DMA_K(2, 2);
        WAIT_BAR(4);
        {
            const lds_cptr kb = kp0;
            pA0 = f32x16{}; pA1 = f32x16{};
#pragma unroll
            for (int d0 = 0; d0 < 4; ++d0) { const bf16x8 b0 = *(const LAS bf16x8*)(kb + d0 * 2048), b1 = *(const LAS bf16x8*)(kb + d0 * 2048 + 512);
                pA0 = __builtin_amdgcn_mfma_f32_32x32x16_bf16(b0, qr[d0], pA0, 0, 0, 0); pA1 = __builtin_amdgcn_mfma_f32_32x32x16_bf16(b1, qr[d0], pA1, 0, 0, 0); }
#pragma unroll
            for (int r = 0; r < 16; ++r) { pA0[r] = __builtin_amdgcn_exp2f(pA0[r]); pA1[r] = __builtin_amdgcn_exp2f(pA1[r]); }
        }
        WAIT_BAR(0);
        DMA_K(3, 3); DMA_V(1, 1);
        ROT();
        kf[0] = KFRAG(k_cur, 0); kf[1] = KFRAG(k_cur, 1); kf[2] = KFRAG(k_cur, 2); kf[3] = KFRAG(k_cur, 3);
        WAIT_BAR(3);
        s16x4 vlo[4], vhi[4]; u32x4 pw0, pw1, pw2, pw3;
#define PKW(P, B) cvt_pk_bf16(P[B], P[B + 1])
#define PAF(k) __builtin_bit_cast(bf16x8, pw##k)
#define VFR(i) (bf16x8){vlo[i][0], vlo[i][1], vlo[i][2], vlo[i][3], vhi[i][0], vhi[i][1], vhi[i][2], vhi[i][3]}
#define PIN(x) asm volatile("" : "+v"(x))
#define EX(v) __builtin_amdgcn_exp2f(v)
#define VRD(slot, f) do { vlo[slot] = vtr(vp_ + (((f) & 3) * 4096 + ((f) >> 2) * 1024)); vhi[slot] = vtr(vp_ + (((f) & 3) * 4096 + ((f) >> 2) * 1024 + 512)); } while (0)
#define GAPA(MF, LDX, A0, A1, A2, A3, W0, W1, PW) do { MF; LDX; sacc += A0; sacc += A1; sacc += A2; sacc += A3; PIN(sacc); W0; W1; PIN(PW); SBAR(); } while (0)
#define GAPB(MF, LDX, X, B) do { MF; LDX; X[B] = EX(X[B]); X[B + 1] = EX(X[B + 1]); PIN(X); SBAR(); } while (0)
#define PVM(f) o[(f) & 3] = __builtin_amdgcn_mfma_f32_32x32x16_bf16(__builtin_bit_cast(bf16x8, (f) < 4 ? pw0 : (f) < 8 ? pw1 : (f) < 12 ? pw2 : pw3), VFR((f) & 3), o[(f) & 3], 0, 0, 0)
#define NOP_ do { } while (0)
#if PROBE_ATT
#define ATT_T(k) do { if (PROBE_ATT == (k)) { const unsigned long long n_ = __builtin_amdgcn_s_memrealtime(); if (tid == 0) *(LAS unsigned long long*)(shm + PTRS_OFF - 64) += n_ - att_t0; } } while (0)
#define ATT_T0() const unsigned long long att_t0 = __builtin_amdgcn_s_memrealtime()
#else
#define ATT_T(k) do { } while (0)
#define ATT_T0() do { } while (0)
#endif
#define STEP(C0, C1, P0, P1, t, GK, GV, GL) do { SBAR(); \
        const lds_cptr vp_ = vp0 + i_prev * VSLOT; \
        float sacc = (P0[0] + P0[1]); \
        GAPA(C0 = __builtin_amdgcn_mfma_f32_32x32x16_bf16(kf[0], qr[0], (f32x16){}, 0, 0, 0), kf[0] = KFRAG(k_cur, 4), P0[2], P0[3], P0[4], P0[5],     pw0[0] = PKW(P0, 0), pw0[1] = PKW(P0, 2), pw0); \
        GAPA(C1 = __builtin_amdgcn_mfma_f32_32x32x16_bf16(kf[1], qr[0], (f32x16){}, 0, 0, 0), kf[1] = KFRAG(k_cur, 5), P0[6], P0[7], P0[8], P0[9],     pw0[2] = PKW(P0, 4), pw0[3] = PKW(P0, 6), pw0); \
        GAPA(C0 = __builtin_amdgcn_mfma_f32_32x32x16_bf16(kf[2], qr[1], C0, 0, 0, 0),         kf[2] = KFRAG(k_cur, 6), P0[10], P0[11], P0[12], P0[13], pw1[0] = PKW(P0, 8), pw1[1] = PKW(P0, 10), pw1); \
        GAPA(C1 = __builtin_amdgcn_mfma_f32_32x32x16_bf16(kf[3], qr[1], C1, 0, 0, 0),         kf[3] = KFRAG(k_cur, 7), P0[14], P0[15], P1[0], P1[1],   pw1[2] = PKW(P0, 12), pw1[3] = PKW(P0, 14), pw1); \
        GAPA(C0 = __builtin_amdgcn_mfma_f32_32x32x16_bf16(kf[0], qr[2], C0, 0, 0, 0),         VRD(0, 0), P1[2], P1[3], P1[4], P1[5],     pw2[0] = PKW(P1, 0), pw2[1] = PKW(P1, 2), pw2); \
        GAPA(C1 = __builtin_amdgcn_mfma_f32_32x32x16_bf16(kf[1], qr[2], C1, 0, 0, 0),         VRD(1, 1), P1[6], P1[7], P1[8], P1[9],     pw2[2] = PKW(P1, 4), pw2[3] = PKW(P1, 6), pw2); \
        GAPA(C0 = __builtin_amdgcn_mfma_f32_32x32x16_bf16(kf[2], qr[3], C0, 0, 0, 0),         VRD(2, 2), P1[10], P1[11], P1[12], P1[13], pw3[0] = PKW(P1, 8), pw3[1] = PKW(P1, 10), pw3); \
        GAPA(C1 = __builtin_amdgcn_mfma_f32_32x32x16_bf16(kf[3], qr[3], C1, 0, 0, 0),         VRD(3, 3), P1[14], P1[15], 0.f, 0.f,       pw3[2] = PKW(P1, 12), pw3[3] = PKW(P1, 14), pw3); \
        l_reg += sacc; \
        if (GK) { DMA_K((t) + 3, (k_cur + 3) & 3); } if (GV) { DMA_V((t) + 1, i_next); } \
        SBAR(); \
        GAPB(PVM(0), VRD(0, 4), C0, 0);   GAPB(PVM(1), VRD(1, 5), C0, 2);   GAPB(PVM(2), VRD(2, 6), C0, 4);    GAPB(PVM(3), VRD(3, 7), C0, 6); \
        GAPB(PVM(4), VRD(0, 8), C0, 8);   GAPB(PVM(5), VRD(1, 9), C0, 10);  GAPB(PVM(6), VRD(2, 10), C0, 12);  GAPB(PVM(7), VRD(3, 11), C0, 14); \
        GAPB(PVM(8), VRD(0, 12), C1, 0);  GAPB(PVM(9), VRD(1, 13), C1, 2);  GAPB(PVM(10), VRD(2, 14), C1, 4);  GAPB(PVM(11), VRD(3, 15), C1, 6); \
        GAPB(PVM(12), if (GL) kf[0] = KFRAG(k_next, 0), C1, 8);  GAPB(PVM(13), if (GL) kf[1] = KFRAG(k_next, 1), C1, 10); \
        GAPB(PVM(14), if (GL) kf[2] = KFRAG(k_next, 2), C1, 12); GAPB(PVM(15), if (GL) kf[3] = KFRAG(k_next, 3), C1, 14); \
        } while (0)
        int t = 1;
#pragma unroll 1
        for (; t + 5 < NT; t += 2) {
#if PROBE_ATT == 1
            STEP(pB0, pB1, pA0, pA1, t, true, true, true);     { ATT_T0(); WAIT_BAR(3); ATT_T(1); } ROT();
            STEP(pA0, pA1, pB0, pB1, t + 1, true, true, true); { ATT_T0(); WAIT_BAR(3); ATT_T(1); } ROT();
#elif PROBE_ATT >= 2
            { ATT_T0(); STEP(pB0, pB1, pA0, pA1, t, true, true, true); ATT_T(2); }    WAIT_BAR(3); ROT();
            { ATT_T0(); STEP(pA0, pA1, pB0, pB1, t + 1, true, true, true); ATT_T(2); } WAIT_BAR(3); ROT();
#else
            STEP(pB0, pB1, pA0, pA1, t, true, true, true);     WAIT_BAR(3); ROT();
            STEP(pA0, pA1, pB0, pB1, t + 1, true, true, true); WAIT_BAR(3); ROT();
#endif
        }
#define ENDW(tt) do { if ((tt) + 3 < NT) { WAIT_BAR(3); } else if ((tt) + 2 < NT) { WAIT_BAR(2); } else { WAIT_BAR(0); } } while (0)
#pragma unroll 1
        for (; t + 1 < NT; t += 2) {
            STEP(pB0, pB1, pA0, pA1, t, (t + 3 < NT), (t + 1 < NT), (t + 1 < NT));         ENDW(t);     ROT();
            STEP(pA0, pA1, pB0, pB1, t + 1, (t + 4 < NT), (t + 2 < NT), (t + 2 < NT));     ENDW(t + 1); ROT();
        }
        STEP(pB0, pB1, pA0, pA1, NT - 1, false, false, false);
        {
            float sacc = pB0[0] + pB0[1];
#pragma unroll
            for (int r = 2; r < 16; ++r) sacc += pB0[r];
#pragma unroll
            for (int r = 0; r < 16; ++r) sacc += pB1[r];
            l_reg += sacc;
            pw0 = (u32x4){PKW(pB0, 0), PKW(pB0, 2), PKW(pB0, 4), PKW(pB0, 6)}; pw1 = (u32x4){PKW(pB0, 8), PKW(pB0, 10), PKW(pB0, 12), PKW(pB0, 14)};
            pw2 = (u32x4){PKW(pB1, 0), PKW(pB1, 2), PKW(pB1, 4), PKW(pB1, 6)}; pw3 = (u32x4){PKW(pB1, 8), PKW(pB1, 10), PKW(pB1, 12), PKW(pB1, 14)};
            const lds_cptr vp_ = vp0 + i_cur * VSLOT;
            VRD(0, 0); VRD(1, 1); VRD(2, 2); VRD(3, 3); PVM(0); PVM(1); PVM(2); PVM(3);
            VRD(0, 4); VRD(1, 5); VRD(2, 6); VRD(3, 7); PVM(4); PVM(5); PVM(6); PVM(7);
            VRD(0, 8); VRD(1, 9); VRD(2, 10); VRD(3, 11); PVM(8); PVM(9); PVM(10); PVM(11);
            VRD(0, 12); VRD(1, 13); VRD(2, 14); VRD(3, 15); PVM(12); PVM(13); PVM(14); PVM(15);
        }
#undef DMA_K
#undef DMA_V
#undef ROT
#undef PKW
#undef PAF
#undef VFR
#undef PIN
#undef EX
#undef VRD
#undef GAPA
#undef GAPB
#undef KFRAG
#undef NOP_
#undef PVM
#undef STEP
#undef ENDW
        { auto rr = __builtin_amdgcn_permlane32_swap(__float_as_uint(l_reg), __float_as_uint(l_reg), false, false); l_reg = __uint_as_float(rr[0]) + __uint_as_float(rr[1]); }
        if (hi == 0) wsf[r32] = l_reg;
        LDS_WAIT();
        float rli[16];
#pragma unroll
        for (int r = 0; r < 16; ++r) rli[r] = 1.0f / wsf[crow(r, hi)];
        if (c == 0) {
#pragma unroll
            for (int d0 = 0; d0 < 4; ++d0)
#pragma unroll
                for (int r = 0; r < 16; ++r) stash[(d0 * 16 + r) * 64 + lane] = f2bf(o[d0][r] * rli[r]);
            LDS_WAIT();
        } else {
#pragma unroll
            for (int d0 = 0; d0 < 4; ++d0)
#pragma unroll
                for (int r = 0; r < 16; ++r) o[d0][r] = bf2f(stash[(d0 * 16 + r) * 64 + lane]) - lam * (o[d0][r] * rli[r]);
            LDS_WAIT(); asm volatile("" ::: "memory");
#pragma unroll
            for (int d0 = 0; d0 < 4; ++d0)
#pragma unroll
                for (int r = 0; r < 16; ++r) stash[crow(r, hi) * 128 + d0 * 32 + r32] = f2bf(o[d0][r]);
            LDS_WAIT(); asm volatile("" ::: "memory");
            bf16_t* Ow = Ob + qrow * opitch + ZQ + h * 128;
#pragma unroll
            for (int i = 0; i < 4; ++i) { const int row = i * 8 + (lane >> 3), ch = lane & 7;
                const u32x4 w0 = *(const LAS u32x4*)(stash + row * 128 + ch * 16), w1 = *(const LAS u32x4*)(stash + row * 128 + ch * 16 + 8);
                float v[16];
#pragma unroll
                for (int j = 0; j < 4; ++j) { v[2 * j] = bflo(w0[j]); v[2 * j + 1] = bfhi(w0[j]); v[8 + 2 * j] = bflo(w1[j]); v[9 + 2 * j] = bfhi(w1[j]); }
                float ss = 0.f;
#pragma unroll
                for (int j = 0; j < 16; ++j) ss += v[j] * v[j];
                ss += __shfl_xor(ss, 1); ss += __shfl_xor(ss, 2); ss += __shfl_xor(ss, 4);
                const float rs = (1.0f - LAMBDA_INIT) / sqrtf(ss * (1.f / 128.f) + NORM_EPS);
                u32x4 x0, x1;
#pragma unroll
                for (int j = 0; j < 4; ++j) { x0[j] = cvt_pk_bf16(v[2 * j] * rs * subln_g[ch * 16 + 2 * j], v[2 * j + 1] * rs * subln_g[ch * 16 + 2 * j + 1]);
                                              x1[j] = cvt_pk_bf16(v[8 + 2 * j] * rs * subln_g[ch * 16 + 8 + 2 * j], v[9 + 2 * j] * rs * subln_g[ch * 16 + 9 + 2 * j]); }
                *(u32x4*)(Ow + (size_t)row * opitch + ch * 16) = x0; *(u32x4*)(Ow + (size_t)row * opitch + ch * 16 + 8) = x1; }
            LDS_WAIT();
        }
        asm volatile("s_waitcnt vmcnt(0) lgkmcnt(0)\n\ts_barrier" ::: "memory");
    }
}
#undef SBAR
#undef WAIT_BAR
}

namespace rw {
constexpr int P = 144, MAT = 64 * P;
constexpr int O_AT = 0, O_BT = MAT, O_KT = 2 * MAT, O_RT = 3 * MAT, O_ATT = 4 * MAT, O_VT = 5 * MAT, O_BHT = 6 * MAT, O_KHT = 7 * MAT;
constexpr int O_LAB = 8 * MAT, O_LAK = 9 * MAT, O_ARB = 10 * MAT, O_ARK = 11 * MAT, O_XT = 12 * MAT, O_ABT = 13 * MAT, O_U0T = 14 * MAT;
constexpr int O_LABD = 15 * MAT, O_TII = O_LABD + 4096, O_WC = O_TII + 2048, O_GSUM = O_WC + 256, O_PAR = O_GSUM + 2048, O_END = O_PAR + 960 * 4;
constexpr int O_ZS = 0, PZ = 128;
static_assert(3 * 66 * PZ <= 3 * MAT, "ZS fits At|Bt|Kt");
constexpr int O_TW = O_LAB, O_ADN = O_LAK, O_WL = O_ARB, O_AR = O_XT, PF = 272;
static_assert(O_END <= PTRS_OFF - 64 && 64 * PF <= 2 * MAT, "rwkv lds");
__device__ __forceinline__ int crow(int r, int hi) { return (r & 3) + 8 * (r >> 2) + 4 * hi; }
__device__ __forceinline__ float sigmoidf_(float x) { return __builtin_amdgcn_rcpf(1.0f + __expf(-x)); }
__device__ __forceinline__ float tanhf_(float x) { return 1.0f - 2.0f * __builtin_amdgcn_rcpf(__expf(2.0f * x) + 1.0f); }
__device__ __forceinline__ void load10(const bf16_t* zc, int t_lo, int S, float (&z)[10]) {
#pragma unroll
    for (int i = 0; i < 10; ++i) { const int t = t_lo - 1 + i; z[i] = (t >= 0 && t < S) ? bf2f(zc[(size_t)t * ZP]) : 0.f; }
}
__device__ __forceinline__ float tshift(const float (&z)[10], int u, float mp, float mn) { const float c = z[u + 1]; return c + mp * (z[u] - c) + mn * (z[u + 2] - c); }
__device__ __forceinline__ f32x16 mm_ll(const LAS unsigned char* A, int rowA, const LAS unsigned char* B, int rowB, f32x16 acc, int r32, int hi) {
#pragma unroll
    for (int ks = 0; ks < 4; ++ks) { const bf16x8 a = *(const LAS bf16x8*)(A + (rowA + r32) * P + (16 * ks + 8 * hi) * 2), b = *(const LAS bf16x8*)(B + (rowB + r32) * P + (16 * ks + 8 * hi) * 2);
        acc = __builtin_amdgcn_mfma_f32_32x32x16_bf16(a, b, acc, 0, 0, 0); }
    return acc;
}
__device__ __forceinline__ void store_native(unsigned char* dst, const f32x16& acc, int lane, bool wt) {
    u32x4 w0, w1;
#pragma unroll
    for (int q = 0; q < 4; ++q) { w0[q] = cvt_pk_bf16(acc[2 * q], acc[2 * q + 1]); w1[q] = cvt_pk_bf16(acc[8 + 2 * q], acc[9 + 2 * q]); }
    if (wt) {
        asm volatile("global_store_dwordx4 %0, %1, off sc1\n\tglobal_store_dwordx4 %0, %2, off offset:16 sc1\n\ts_nop 1" :: "v"(dst + lane * 32), "v"(w0), "v"(w1) : "memory");
    } else { *(u32x4*)(dst + lane * 32) = w0; *(u32x4*)(dst + lane * 32 + 16) = w1; }
}
__device__ __forceinline__ void st4(LAS unsigned char* p, float a, float b, float c, float d) { u32x2 w; w.x = cvt_pk_bf16(a, b); w.y = cvt_pk_bf16(c, d); *(LAS u32x2*)p = w; }

__device__ __forceinline__ f32x2_t s1_param_load(LAS unsigned char* L, int tid, int d, int h) {
    const int sg = tid >> 5, seg = sg < 15 ? sg : 14, off = (tid & 31) * 2;
    const int ti = seg < 10 ? 11 + (seg & 1) : (seg == 10 ? 13 : (seg == 11 ? 15 : 6 + seg));
    const int eo = seg < 6 ? (seg >> 1) * 512 + h * 64 : (seg < 8 ? ZWD - ZRR : (seg < 10 ? ZAD - ZRR : (seg < 12 ? d * 512 + h * 64 : h * 64)));
    const float* src = *(const float* LAS*)(L + PTRS_OFF + ti * 8) + eo + off;
    return *(const GAS f32x2_t*)src;
}
__device__ __forceinline__ void s1_stage_load(const Args& a, int tid, int q, int h, int ck, u32x4 (&v)[6]) {
    const int row0 = seq_row0(q), S = seq_len(q), t0 = ck * 64;
#pragma unroll
    for (int k = 0; k < 6; ++k) { const int c = tid + k * NTHR;
        const int seg = c >> 3, part = c & 7, grp = (seg >= 66) + (seg >= 132), row = seg - 66 * grp; int t = t0 - 1 + row; t = t < 0 ? 0 : (t >= S ? S - 1 : t);
        const int e = c - 1584 < 0 ? 0 : (c - 1584 > 1023 ? 1023 : c - 1584);
        const size_t offz = WS_Z + ((size_t)(row0 + t) * ZP + ZRR + grp * 512 + h * 64 + part * 8) * 2, offe = WS_E1 + ((size_t)(row0 + t0) * 128 + (size_t)e * 8) * 2;
        v[k] = *(const GAS u32x4*)(a.ws + (c < 1584 ? offz : offe)); }
}
__device__ __forceinline__ void s1_stage_store(LAS unsigned char* L, int tid, int d, int q, int ck, const u32x4 (&stg)[6], f32x2_t par) {
    const int S = seq_len(q), t0 = ck * 64, dummy = O_GSUM + (tid & 63) * 16;
#pragma unroll
    for (int k = 0; k < 6; ++k) { const int c = tid + k * NTHR;
        const int seg = c >> 3, grp = (seg >= 66) + (seg >= 132), row = seg - 66 * grp, t = t0 - 1 + row; const bool zok = t >= 0 && t < S;
        const int e = c - 1584, tr = (e >> 4) & 63, part = e & 15, tau = d == 0 ? tr : 63 - tr;
        const int addr = c < 1584 ? O_ZS + c * 16 : (c < 2608 ? (part < 8 ? O_TW : O_ADN) + tau * P + (part & 7) * 16 : dummy);
        const bool zero = c < 1584 && !zok;
        *(LAS u32x4*)(L + addr) = zero ? (u32x4){0u, 0u, 0u, 0u} : stg[k]; }
    *(LAS f32x2_t*)(L + (tid < 480 ? O_PAR + tid * 8 : dummy)) = par;
}
__device__ __forceinline__ void s1_item(const Frame& F, const Args& a, int d, int q, int h, int ck, unsigned char* slot, int nd, int nq, int nh, int nck, bool wt, unsigned* publish_prev) {
    LAS unsigned char* L = F.lds;
#if PROBE_S1 >= 0
    unsigned long long pt_last = 0; int pt_n = 0;
#define PST() do { if (F.tid == 0) { const unsigned long long n_ = __builtin_amdgcn_s_memrealtime(); if (pt_n == PROBE_S1 + 1) *(LAS unsigned long long*)(L + PTRS_OFF - 64) += n_ - pt_last; pt_last = n_; } ++pt_n; } while (0)
#else
#define PST() do { } while (0)
#endif
    PST();
    int lane_ = F.lane; asm volatile("" : "+v"(lane_));
    const int lane = lane_, w = F.wave, tid = w * 64 + lane, r32 = lane & 31, hi = lane >> 5;
    const int j = lane, tg = w;
    const int row0 = seq_row0(q), S = seq_len(q), t0 = ck * 64;
    const bf16_t* Zs = (const bf16_t*)(a.ws + WS_Z) + (size_t)row0 * ZP; (void)Zs; (void)S;
    const int t_lo = d == 0 ? t0 + 8 * tg : t0 + 56 - 8 * tg;
    const int tau0 = 8 * tg;
#define TAU(u) (d == 0 ? tau0 + (u) : tau0 + 7 - (u))
    const int ch = h * 64 + j; (void)ch;
    bf16x8 wfr[4];
    { const int which = w >> 2, mt = (w >> 1) & 1;
      const bf16_t* WT = (const bf16_t*)(a.ws + WS_LORA) + (which ? 2 * 512 * 64 : 0) + ((size_t)d * 512 + h * 64 + 32 * mt + r32) * 64;
#pragma unroll
      for (int ks = 0; ks < 4; ++ks) wfr[ks] = *(const bf16x8*)(WT + 16 * ks + 8 * hi); }
    u32x4 stg[6]; s1_stage_load(a, tid, nq, nh, nck, stg); const f32x2_t par = s1_param_load(L, tid, nd, nh);
#define PAR(seg, idx) (*(const LAS float*)(L + O_PAR + ((seg) * 64 + (idx)) * 4))
    const LAS unsigned char* zsb = L + O_ZS + (t_lo - t0) * PZ + j * 2;
#define LD10(z, g) do { _Pragma("unroll") for (int i_ = 0; i_ < 10; ++i_) z[i_] = bf2f(*(const LAS bf16_t*)(zsb + ((g) * 66 + i_) * PZ)); } while (0)
    {
        const int which = w >> 2, mt = (w >> 1) & 1, nt = w & 1;
        const LAS unsigned char* B = L + (which ? O_ADN : O_TW);
        f32x16 acc = f32x16{};
#pragma unroll
        for (int ks = 0; ks < 4; ++ks) { const bf16x8 bv = *(const LAS bf16x8*)(B + (32 * nt + r32) * P + (16 * ks + 8 * hi) * 2);
            acc = __builtin_amdgcn_mfma_f32_32x32x16_bf16(wfr[ks], bv, acc, 0, 0, 0); }
        LAS unsigned char* O = L + (which ? O_AR : O_WL) + (32 * nt + r32) * PF;
#pragma unroll
        for (int g = 0; g < 4; ++g) { const int jj = 8 * g + 4 * hi; const f32x4 bv = *(const LAS f32x4*)(L + O_PAR + ((10 + which) * 64 + 32 * mt + jj) * 4);
            *(LAS f32x4*)(O + (32 * mt + jj) * 4) = (f32x4){acc[4 * g] + bv[0], acc[4 * g + 1] + bv[1], acc[4 * g + 2] + bv[2], acc[4 * g + 3] + bv[3]}; }
    }
    LBAR(); PST();
    typedef f32x2_t v2;
    const int cp = lane & 31, th = lane >> 5;
    v2 aa2[4], bb2[4], rr2[4], kd2[4], vv2[4], ld2[4], tot4, oth;
#define EXP2V(a) ({ const v2 t_ = (a) * 1.4426950408889634f; (v2){__builtin_amdgcn_exp2f(t_.x), __builtin_amdgcn_exp2f(t_.y)}; })
#define SIG2V(a) ({ const v2 e_ = EXP2V(-(a)) + 1.0f; (v2){__builtin_amdgcn_rcpf(e_.x), __builtin_amdgcn_rcpf(e_.y)}; })
#define FOLD4(s_) ({ const bool b4_ = (lane >> 4) & 1, b3_ = (lane >> 3) & 1; float g_[2]; \
        _Pragma("unroll") for (int i_ = 0; i_ < 2; ++i_) { const float kp_ = b4_ ? s_[i_ + 2] : s_[i_], sd_ = b4_ ? s_[i_] : s_[i_ + 2]; g_[i_] = kp_ + __int_as_float(__builtin_amdgcn_ds_swizzle(__float_as_int(sd_), 0x401F)); } \
        const float kp2_ = b3_ ? g_[1] : g_[0], sd2_ = b3_ ? g_[0] : g_[1]; \
        float h_ = kp2_ + __int_as_float(__builtin_amdgcn_update_dpp(0, __float_as_int(sd2_), 0x128, 0xF, 0xF, true)); \
        h_ += __int_as_float(__builtin_amdgcn_update_dpp(0, __float_as_int(h_), 0x141, 0xF, 0xF, true)); \
        h_ += __int_as_float(__builtin_amdgcn_update_dpp(0, __float_as_int(h_), 0xB1, 0xF, 0xF, true)); \
        h_ += __int_as_float(__builtin_amdgcn_update_dpp(0, __float_as_int(h_), 0x4E, 0xF, 0xF, true)); h_; })
    {
        v2 zr[6], zk[6], zv[6];
        const LAS unsigned char* zb2 = L + O_ZS + ((t_lo - t0) + 4 * th) * PZ + cp * 4;
#define LDZ(z, g) do { _Pragma("unroll") for (int i_ = 0; i_ < 6; ++i_) { const unsigned w_ = *(const LAS unsigned*)(zb2 + ((g) * 66 + i_) * PZ); z[i_] = (v2){bflo(w_), bfhi(w_)}; } } while (0)
        LDZ(zr, 0); LDZ(zk, 1); LDZ(zv, 2);
#undef LDZ
#define PAR2(seg) (*(const LAS v2*)(L + O_PAR + ((seg) * 64 + 2 * cp) * 4))
        const v2 mpr = PAR2(0), mnr = PAR2(1), mpk = PAR2(2), mnk = PAR2(3), mpv = PAR2(4), mnv = PAR2(5), kkc = PAR2(12), kac = PAR2(13), rkc = PAR2(14);
#undef PAR2
        float* bon = (float*)(a.ws + WS_BONUS) + ((size_t)d * MTOK + row0) * 8 + h;
        v2 k02[4], ar2[4]; float red[4];
#pragma unroll
        for (int k = 0; k < 4; ++k) { const int tau = TAU(4 * th + k);
            const v2 wl = *(const LAS v2*)(L + O_WL + tau * PF + cp * 8), ar = *(const LAS v2*)(L + O_AR + tau * PF + cp * 8);
            ld2[k] = SIG2V(wl) * (-0.6065306597126334f); ar2[k] = SIG2V(ar);
            rr2[k] = zr[k + 1] + mpr * (zr[k] - zr[k + 1]) + mnr * (zr[k + 2] - zr[k + 1]);
            k02[k] = zk[k + 1] + mpk * (zk[k] - zk[k + 1]) + mnk * (zk[k + 2] - zk[k + 1]);
            vv2[k] = zv[k + 1] + mpv * (zv[k] - zv[k + 1]) + mnv * (zv[k + 2] - zv[k + 1]);
            aa2[k] = k02[k] * kkc; red[k] = aa2[k].x * aa2[k].x + aa2[k].y * aa2[k].y; }
        const int hs = __float_as_int(FOLD4(red));
        float ssq[4];
#pragma unroll
        for (int k = 0; k < 4; ++k) { const float lo_ = __int_as_float(__builtin_amdgcn_readlane(hs, 8 * k)), hi_ = __int_as_float(__builtin_amdgcn_readlane(hs, 32 + 8 * k)); ssq[k] = th ? hi_ : lo_; }
#pragma unroll
        for (int k = 0; k < 4; ++k) { const v2 kkn = aa2[k] * __builtin_amdgcn_rsqf(ssq[k] + 1e-12f);
            kd2[k] = k02[k] * ((ar2[k] - 1.0f) * kac + 1.0f); aa2[k] = -kkn; bb2[k] = kkn * ar2[k];
            const v2 bt = rr2[k] * kd2[k] * rkc; red[k] = bt.x + bt.y; }
        const float hb = FOLD4(red);
        if ((lane & 7) == 0) bon[(size_t)(t_lo + (lane >> 3)) * 8] = hb;
        tot4 = (ld2[0] + ld2[1]) + (ld2[2] + ld2[3]);
        { auto rx = __builtin_amdgcn_permlane32_swap(__float_as_uint(tot4.x), __float_as_uint(tot4.x), false, false), ry = __builtin_amdgcn_permlane32_swap(__float_as_uint(tot4.y), __float_as_uint(tot4.y), false, false);
          oth.x = __uint_as_float(th ? rx[0] : rx[1]); oth.y = __uint_as_float(th ? ry[0] : ry[1]); }
        if (th == 0) *(LAS v2*)(L + O_GSUM + tg * 256 + cp * 8) = tot4 + oth;
    }
    LBAR(); PST();
    {
        v2 pre = {0.f, 0.f}, cC = {0.f, 0.f};
#pragma unroll
        for (int g = 0; g < 8; ++g) { const v2 sg = *(const LAS v2*)(L + O_GSUM + g * 256 + cp * 8); cC += sg; if (g < tg) pre += sg; }
        const v2 zero2 = {0.f, 0.f};
        const v2 base = pre + ((d == 0) == (th == 1) ? oth : zero2);
        v2 At2[4], Vt2[4], Bh2[4], Kh2[4]; v2 pf = {0.f, 0.f};
#pragma unroll
        for (int k = 0; k < 4; ++k) { pf += ld2[k]; const int tau = TAU(4 * th + k);
            const v2 cl = base + (d == 0 ? pf : tot4 - pf + ld2[k]);
            const v2 e_m1 = EXP2V(cl - ld2[k]), e_p = EXP2V(cl), e_n = EXP2V(-cl), e_c = EXP2V(cC - cl);
            At2[k] = aa2[k] * e_m1; Vt2[k] = vv2[k]; Bh2[k] = bb2[k] * e_c; Kh2[k] = kd2[k] * e_c;
            const v2 rt = rr2[k] * e_p, bt = bb2[k] * e_n, kt = kd2[k] * e_n;
            *(LAS unsigned*)(L + O_AT + tau * P + cp * 4) = cvt_pk_bf16(At2[k].x, At2[k].y); *(LAS unsigned*)(L + O_RT + tau * P + cp * 4) = cvt_pk_bf16(rt.x, rt.y);
            *(LAS unsigned*)(L + O_BT + tau * P + cp * 4) = cvt_pk_bf16(bt.x, bt.y);         *(LAS unsigned*)(L + O_KT + tau * P + cp * 4) = cvt_pk_bf16(kt.x, kt.y); }
        const int tb4 = tau0 + (d == 0 ? 4 * th : 4 * (1 - th));
#define PK4(dst, X) do { u32x2 wx_, wy_; \
            wx_.x = cvt_pk_bf16(d == 0 ? X[0].x : X[3].x, d == 0 ? X[1].x : X[2].x); wx_.y = cvt_pk_bf16(d == 0 ? X[2].x : X[1].x, d == 0 ? X[3].x : X[0].x); \
            wy_.x = cvt_pk_bf16(d == 0 ? X[0].y : X[3].y, d == 0 ? X[1].y : X[2].y); wy_.y = cvt_pk_bf16(d == 0 ? X[2].y : X[1].y, d == 0 ? X[3].y : X[0].y); \
            *(LAS u32x2*)(L + (dst) + (2 * cp) * P + tb4 * 2) = wx_; *(LAS u32x2*)(L + (dst) + (2 * cp + 1) * P + tb4 * 2) = wy_; } while (0)
        PK4(O_ATT, At2); PK4(O_VT, Vt2); PK4(O_BHT, Bh2); PK4(O_KHT, Kh2);
#undef PK4
        if (tg == 0 && th == 0) *(LAS v2*)(L + O_WC + cp * 8) = EXP2V(cC);
    }
#undef FOLD4
#undef SIG2V
#undef EXP2V
    LBAR(); PST();
#pragma unroll
    for (int i = 0; i < 2; ++i) {
        const int ti = 2 * w + i, ms = ti >> 2, nl = ti & 3;
        const int sb = 32 * (ms & 1), tb = 32 * (nl & 1);
        f32x16 acc = f32x16{};
        if (sb <= tb) acc = mm_ll(L + (ms < 2 ? O_BT : O_KT), sb, L + (nl < 2 ? O_AT : O_RT), tb, acc, r32, hi);
        const int dst = ms < 2 ? (nl < 2 ? O_LAB : O_ARB) : (nl < 2 ? O_LAK : O_ARK);
        const int t = tb + r32, tlim = t + (nl >= 2 ? 1 : 0);
        const bool diagtile = (dst == O_LAB) && (sb == tb);
#pragma unroll
        for (int g = 0; g < 4; ++g) { const int s0 = sb + 8 * g + 4 * hi; float v[4];
#pragma unroll
            for (int e = 0; e < 4; ++e) v[e] = (s0 + e < tlim) ? acc[4 * g + e] : 0.f;
            st4(L + dst + t * P + s0 * 2, v[0], v[1], v[2], v[3]);
            if (diagtile) { const bool match = (g >> 1) == (r32 >> 4);
                const int off = match ? O_LABD + (((t >> 4) * 16 + (t & 15)) * 16 + (s0 & 15)) * 4 : O_GSUM + lane * 16;
                *(LAS f32x4*)(L + off) = (f32x4){v[0], v[1], v[2], v[3]}; } }
    }
    LBAR(); PST();
    if (w < 4) {
        const int mt = w >> 1, nt = w & 1; f32x16 acc = f32x16{};
        acc = mm_ll(L + O_LAK, 32 * mt, L + O_VT, 32 * nt, acc, r32, hi);
#pragma unroll
        for (int g = 0; g < 4; ++g) st4(L + O_XT + (32 * nt + r32) * P + (32 * mt + 8 * g + 4 * hi) * 2, acc[4 * g], acc[4 * g + 1], acc[4 * g + 2], acc[4 * g + 3]);
    } else if (w == 7) {
        const int blk = lane >> 4, cc = lane & 15;
        float x[16];
#pragma unroll
        for (int t = 0; t < 16; ++t) x[t] = (t == cc) ? 1.f : 0.f;
#pragma unroll
        for (int kb = 0; kb < 4; ++kb) {
            f32x4 Lc[16];
#pragma unroll
            for (int t = 0; t < 16; ++t) if (t > 4 * kb) Lc[t] = *(const LAS f32x4*)(L + O_LABD + ((blk * 16 + t) * 16 + 4 * kb) * 4);
#pragma unroll
            for (int t = 0; t < 16; ++t) {
                if (t > 4 * kb + 0) x[t] += Lc[t][0] * x[4 * kb + 0];
            }
#pragma unroll
            for (int t = 0; t < 16; ++t) {
                if (t > 4 * kb + 1) x[t] += Lc[t][1] * x[4 * kb + 1];
            }
#pragma unroll
            for (int t = 0; t < 16; ++t) {
                if (t > 4 * kb + 2) x[t] += Lc[t][2] * x[4 * kb + 2];
            }
#pragma unroll
            for (int t = 0; t < 16; ++t) {
                if (t > 4 * kb + 3) x[t] += Lc[t][3] * x[4 * kb + 3];
            }
        }
#pragma unroll
        for (int t = 0; t < 16; ++t) *(LAS bf16_t*)(L + O_TII + ((blk * 16 + t) * 16 + cc) * 2) = f2bf(x[t]);
    }
    LBAR(); PST();
    {
        const int c16 = lane & 15, q4 = lane >> 4;
        const LAS unsigned char* RT = L + (w < 4 ? O_ATT : O_XT) + (16 * (w & 3) + c16) * P;
        LAS unsigned char* OT = L + (w < 4 ? O_ABT : O_U0T) + (16 * (w & 3) + c16) * P;
        const LAS unsigned char* LA = L + O_LAB + c16 * P;
#define RHS(i) ({ const u32x2 r_ = *(const LAS u32x2*)(RT + (16 * (i) + 4 * q4) * 2); (f32x4){bflo(r_.x), bfhi(r_.x), bflo(r_.y), bfhi(r_.y)}; })
#define AFR(i, k1, k2) ({ const u32x2 lo_ = *(const LAS u32x2*)(LA + 16 * (i) * P + (16 * (k1) + 4 * q4) * 2); u32x2 hi_ = {0u, 0u}; if ((k2) >= 0) hi_ = *(const LAS u32x2*)(LA + 16 * (i) * P + (16 * ((k2) < 0 ? 0 : (k2)) + 4 * q4) * 2); \
        __builtin_bit_cast(bf16x8, (u32x4){lo_.x, lo_.y, hi_.x, hi_.y}); })
#define TFR(i) ({ const u32x2 lo_ = *(const LAS u32x2*)(L + O_TII + (((i) * 16 + c16) * 16 + 4 * q4) * 2); __builtin_bit_cast(bf16x8, (u32x4){lo_.x, lo_.y, 0u, 0u}); })
#define BFR(U1, U2) __builtin_bit_cast(bf16x8, (u32x4){cvt_pk_bf16(U1[0], U1[1]), cvt_pk_bf16(U1[2], U1[3]), cvt_pk_bf16(U2[0], U2[1]), cvt_pk_bf16(U2[2], U2[3])})
#define MF16(A_, B_, C_) __builtin_amdgcn_mfma_f32_16x16x32_bf16(A_, B_, C_, 0, 0, 0)
        const f32x4 zero4 = {0.f, 0.f, 0.f, 0.f};
        f32x4 U0 = MF16(TFR(0), BFR(RHS(0), zero4), zero4);
        f32x4 Z1 = MF16(AFR(1, 0, -1), BFR(U0, zero4), RHS(1));
        f32x4 U1 = MF16(TFR(1), BFR(Z1, zero4), zero4);
        f32x4 Z2 = MF16(AFR(2, 0, 1), BFR(U0, U1), RHS(2));
        f32x4 U2 = MF16(TFR(2), BFR(Z2, zero4), zero4);
        f32x4 Z3 = MF16(AFR(3, 0, 1), BFR(U0, U1), RHS(3));
        Z3 = MF16(AFR(3, 2, -1), BFR(U2, zero4), Z3);
        f32x4 U3 = MF16(TFR(3), BFR(Z3, zero4), zero4);
        st4(OT + (0 + 4 * q4) * 2, U0[0], U0[1], U0[2], U0[3]); st4(OT + (16 + 4 * q4) * 2, U1[0], U1[1], U1[2], U1[3]);
        st4(OT + (32 + 4 * q4) * 2, U2[0], U2[1], U2[2], U2[3]); st4(OT + (48 + 4 * q4) * 2, U3[0], U3[1], U3[2], U3[3]);
#undef RHS
#undef AFR
#undef TFR
#undef BFR
#undef MF16
    }
    if (publish_prev) asm volatile("s_waitcnt vmcnt(0)" ::: "memory");
    LBAR(); PST();
    if (publish_prev && tid == 0) __hip_atomic_fetch_add(publish_prev, 1u, __ATOMIC_RELAXED, __HIP_MEMORY_SCOPE_AGENT);
    {
        const int mt = (w >> 1) & 1, nt = w & 1;
        if (w < 4) {
            f32x16 acc = f32x16{};
            acc = mm_ll(L + O_ABT, 32 * mt, L + O_BHT, 32 * nt, acc, r32, hi);
            if (mt == nt) { const float wc = *(const LAS float*)(L + O_WC + (32 * nt + r32) * 4);
#pragma unroll
                for (int r = 0; r < 16; ++r) if (crow(r, hi) == r32) acc[r] += wc; }
            store_native(slot + (mt * 2 + nt) * 2048, acc, lane, wt);
            f32x16 rb;
#pragma unroll
            for (int g = 0; g < 4; ++g) { const u32x2 r_ = *(const LAS u32x2*)(L + O_RT + (32 * nt + r32) * P + (32 * mt + 8 * g + 4 * hi) * 2);
                rb[4 * g] = bflo(r_.x); rb[4 * g + 1] = bfhi(r_.x); rb[4 * g + 2] = bflo(r_.y); rb[4 * g + 3] = bfhi(r_.y); }
            rb = mm_ll(L + O_ABT, 32 * mt, L + O_ARB, 32 * nt, rb, r32, hi);
            store_native(slot + 16384 + (mt * 2 + nt) * 2048, rb, lane, wt);
        } else {
            f32x16 acc = f32x16{};
            acc = mm_ll(L + O_BHT, 32 * mt, L + O_U0T, 32 * nt, acc, r32, hi);
            acc = mm_ll(L + O_KHT, 32 * mt, L + O_VT, 32 * nt, acc, r32, hi);
            store_native(slot + 8192 + (mt * 2 + nt) * 2048, acc, lane, wt);
            f32x16 y0 = f32x16{};
            y0 = mm_ll(L + O_ARB, 32 * mt, L + O_U0T, 32 * nt, y0, r32, hi);
            y0 = mm_ll(L + O_ARK, 32 * mt, L + O_VT, 32 * nt, y0, r32, hi);
            store_native(slot + 24576 + (mt * 2 + nt) * 2048, y0, lane, wt);
        }
    }
    LBAR(); PST();
    s1_stage_store(L, tid, nd, nq, nck, stg, par);
    LBAR(); PST();
#undef PAR
#undef TAU
#undef LD10
#undef PST
}

__device__ __forceinline__ void s23_wait_round(unsigned* ready, int r, int lane) {
    unsigned spins = 0;
    while ((unsigned)__builtin_amdgcn_readfirstlane(__hip_atomic_load(ready + r, __ATOMIC_RELAXED, __HIP_MEMORY_SCOPE_AGENT)) < 16u) { __builtin_amdgcn_s_sleep(8); if (++spins > (1u << 22)) break; }
    __builtin_amdgcn_fence(__ATOMIC_ACQUIRE, "agent");
    asm volatile("s_waitcnt vmcnt(0)" ::: "memory");
}
__device__ __forceinline__ void s23_chain_wg(const Frame& F, const Args& a, int d, int q, int h, unsigned char* slots  , unsigned* ready) {
    LAS unsigned char* L = F.lds;
    const int lane = F.lane, w = F.wave, icb = w & 1;
    const int NC = seq_len(q) / 64;
    f32x16 X0 = f32x16{}, X1 = f32x16{};
    const bool loader = w >= 4, compute = w < 2;
    constexpr int D = 6;
#define CKOF(cc) (d == 0 ? (cc) : NC - 1 - (cc))
#define S23_DMA(cc) do { const unsigned char* src_ = slots + (size_t)CKOF(cc) * SLOT_BYTES + (w - 4) * 4096 + lane * 16; LAS unsigned char* dst_ = L + ((cc) & 7) * 16384 + (w - 4) * 4096; \
        _Pragma("unroll") for (int p_ = 0; p_ < 4; ++p_) __builtin_amdgcn_global_load_lds((const unsigned*)(src_ + p_ * 1024), (LAS unsigned*)(dst_ + p_ * 1024), 16, 0, 0); } while (0)
#define UNPK(dst, w0, w1) do { _Pragma("unroll") for (int q_ = 0; q_ < 4; ++q_) { dst[2 * q_] = bflo(w0[q_]); dst[2 * q_ + 1] = bfhi(w0[q_]); dst[8 + 2 * q_] = bflo(w1[q_]); dst[9 + 2 * q_] = bfhi(w1[q_]); } } while (0)
    if (ready) { if (w == 4) s23_wait_round(ready, 0, lane); asm volatile("s_waitcnt lgkmcnt(0)\n\ts_barrier" ::: "memory"); }
    if (loader) {
#pragma unroll
        for (int c0 = 0; c0 < D; ++c0) if (c0 < NC) S23_DMA(c0); }
#pragma unroll 1
    for (int cc = 0; cc < NC; ++cc) {
        if (ready && w == 4 && ((cc + D) & 15) == 0 && cc + D < NC) s23_wait_round(ready, (cc + D) >> 4, lane);
        if (loader) { const int later = NC - 1 - cc;
            if (later >= 5) asm volatile("s_waitcnt vmcnt(20)" ::: "memory"); else if (later == 4) asm volatile("s_waitcnt vmcnt(16)" ::: "memory"); else if (later == 3) asm volatile("s_waitcnt vmcnt(12)" ::: "memory");
            else if (later == 2) asm volatile("s_waitcnt vmcnt(8)" ::: "memory"); else if (later == 1) asm volatile("s_waitcnt vmcnt(4)" ::: "memory"); else asm volatile("s_waitcnt vmcnt(0)" ::: "memory"); }
        asm volatile("s_waitcnt lgkmcnt(0)\n\ts_barrier" ::: "memory");
        if (loader) { if (cc + D < NC) S23_DMA(cc + D); }
        if (compute) {
            const LAS unsigned char* sl = L + (cc & 7) * 16384 + lane * 32;
            u32x4 mw[4][2], dw[2][2];
#pragma unroll
            for (int t = 0; t < 4; ++t) { mw[t][0] = *(const LAS u32x4*)(sl + t * 2048); mw[t][1] = *(const LAS u32x4*)(sl + t * 2048 + 16); }
#pragma unroll
            for (int t = 0; t < 2; ++t) { dw[t][0] = *(const LAS u32x4*)(sl + 8192 + (t * 2 + icb) * 2048); dw[t][1] = *(const LAS u32x4*)(sl + 8192 + (t * 2 + icb) * 2048 + 16); }
            __builtin_amdgcn_sched_barrier(0);
            u32x4 xw[2][2];
#pragma unroll
            for (int s = 0; s < 2; ++s) {
                xw[0][s] = (u32x4){cvt_pk_bf16(X0[8 * s], X0[8 * s + 1]), cvt_pk_bf16(X0[8 * s + 2], X0[8 * s + 3]), cvt_pk_bf16(X0[8 * s + 4], X0[8 * s + 5]), cvt_pk_bf16(X0[8 * s + 6], X0[8 * s + 7])};
                xw[1][s] = (u32x4){cvt_pk_bf16(X1[8 * s], X1[8 * s + 1]), cvt_pk_bf16(X1[8 * s + 2], X1[8 * s + 3]), cvt_pk_bf16(X1[8 * s + 4], X1[8 * s + 5]), cvt_pk_bf16(X1[8 * s + 6], X1[8 * s + 7])}; }
            { unsigned char* xo = slots + (size_t)CKOF(cc) * SLOT_BYTES + ((icb * 2) * 64 + lane) * 32;
              *(u32x4*)(xo) = xw[0][0]; *(u32x4*)(xo + 16) = xw[0][1]; *(u32x4*)(xo + 2048) = xw[1][0]; *(u32x4*)(xo + 2048 + 16) = xw[1][1]; }
            asm volatile("s_waitcnt lgkmcnt(0)" ::: "memory");
            __builtin_amdgcn_sched_barrier(0);
            f32x16 N0, N1;
            UNPK(N0, dw[0][0], dw[0][1]); UNPK(N1, dw[1][0], dw[1][1]);
#pragma unroll
            for (int rb = 0; rb < 2; ++rb)
#pragma unroll
                for (int s = 0; s < 2; ++s) {
                    N0 = __builtin_amdgcn_mfma_f32_32x32x16_bf16(__builtin_bit_cast(bf16x8, mw[rb * 2 + 0][s]), __builtin_bit_cast(bf16x8, xw[rb][s]), N0, 0, 0, 0);
                    N1 = __builtin_amdgcn_mfma_f32_32x32x16_bf16(__builtin_bit_cast(bf16x8, mw[rb * 2 + 1][s]), __builtin_bit_cast(bf16x8, xw[rb][s]), N1, 0, 0, 0); }
            X0 = N0; X1 = N1;
        }
    }
    asm volatile("s_waitcnt vmcnt(0) lgkmcnt(0)\n\ts_barrier" ::: "memory");
#undef UNPK
#undef S23_DMA
#undef CKOF
}

constexpr int PO_V = 0, PO_G = PO_V + 66 * 144, PO_Y = PO_G + 66 * 272, PO_SG = PO_Y + 2 * 64 * 272, PO_GF = PO_SG + 64 * 272, PO_END = PO_GF + 64 * 272;
static_assert(PO_END <= PTRS_OFF - 64, "post lds");
struct PostPre { u32x4 stg[4]; u32x4 ra[2][2], xb[2][2], yc[2]; };
__device__ __forceinline__ void post_decode(int c, int& reg, int& row, int& part) {
    if (c < 528) { reg = 0; row = c >> 3; part = c & 7; } else { reg = 1; row = (c - 528) >> 4; part = (c - 528) & 15; }
}
__device__ __forceinline__ void post_stage_load(const Args& a, int tid, int q, int h, int blk, PostPre& pp) {
    const int row0 = seq_row0(q), S = seq_len(q), t0 = blk * 64;
    const bf16_t* Zs = (const bf16_t*)(a.ws + WS_Z) + (size_t)row0 * ZP;
#pragma unroll
    for (int k = 0; k < 4; ++k) { const int c = tid + k * NTHR; int reg, row, part; post_decode(c, reg, row, part);
        const int t = t0 - 1 + row; const int col = reg == 0 ? ZRV + h * 64 : ZGD;
        pp.stg[k] = (u32x4){0u, 0u, 0u, 0u};
        if (c < 1584 && t >= 0 && t < S) pp.stg[k] = *(const u32x4*)(Zs + (size_t)t * ZP + col + part * 8); }
    const int w = tid >> 6, lane = tid & 63, dd = w >> 2, tb = (w >> 1) & 1, icb = w & 1;
    const size_t si = q == 0 ? (size_t)(dd * 8 + h) * 256 + blk : (size_t)((dd * 8 + (q - 1)) * 8 + h) * 32 + blk;
    const unsigned char* sl = (const unsigned char*)a.out + si * SLOT_BYTES + lane * 32;
#pragma unroll
    for (int rb = 0; rb < 2; ++rb) { pp.ra[rb][0] = *(const u32x4*)(sl + 16384 + (rb * 2 + tb) * 2048); pp.ra[rb][1] = *(const u32x4*)(sl + 16384 + (rb * 2 + tb) * 2048 + 16);
                                     pp.xb[rb][0] = *(const u32x4*)(sl + (icb * 2 + rb) * 2048); pp.xb[rb][1] = *(const u32x4*)(sl + (icb * 2 + rb) * 2048 + 16); }
    pp.yc[0] = *(const u32x4*)(sl + 24576 + (tb * 2 + icb) * 2048); pp.yc[1] = *(const u32x4*)(sl + 24576 + (tb * 2 + icb) * 2048 + 16);
}
__device__ __forceinline__ void post_item(const Frame& F, const Args& a, int q, int h, int blk, PostPre& pp, int nq, int nh, int nblk) {
    LAS unsigned char* L = F.lds;
    int lane_ = F.lane; asm volatile("" : "+v"(lane_));
    const int lane = lane_, w = F.wave, tid = w * 64 + lane, r32 = lane & 31, hi = lane >> 5, tg = w;
    typedef f32x2_t v2;
    const int cp = lane & 31, th = lane >> 5;
    const int row0 = seq_row0(q), t_lo = blk * 64 + 8 * tg + 4 * th;
    bf16_t* Zs = (bf16_t*)(a.ws + WS_Z) + (size_t)row0 * ZP;
    const float* mup = inp(L, 11); const float* mun = inp(L, 12);
#define GLD2(p_) (*(const GAS v2*)(p_))
    const int chp = h * 64 + 2 * cp;
    const v2 mp0 = GLD2(mup + ZGD - ZRR + 2 * cp), mn0 = GLD2(mun + ZGD - ZRR + 2 * cp), mp1 = GLD2(mup + ZGD - ZRR + 64 + 2 * cp), mn1 = GLD2(mun + ZGD - ZRR + 64 + 2 * cp);
    const v2 mpv = GLD2(mup + 1024 + chp), mnv = GLD2(mun + 1024 + chp), lg = GLD2(inp(L, 21) + chp), lb = GLD2(inp(L, 22) + chp);
#undef GLD2
    float bsum[4];
    { const GAS float* bon0 = (const GAS float*)(a.ws + WS_BONUS) + (size_t)row0 * 8 + h; const GAS float* bon1 = bon0 + (size_t)MTOK * 8;
#pragma unroll
      for (int k = 0; k < 4; ++k) bsum[k] = bon0[(size_t)(t_lo + k) * 8] + bon1[(size_t)(t_lo + k) * 8]; }
    bf16x8 gfr[8];
    { const GAS bf16_t* GT = (const GAS bf16_t*)(a.ws + WS_LORA) + 4 * 512 * 64 + ((size_t)h * 64 + 32 * ((w >> 1) & 1) + r32) * 128;
#pragma unroll
      for (int ks = 0; ks < 8; ++ks) gfr[ks] = *(const GAS bf16x8*)(GT + 16 * ks + 8 * hi); }
#pragma unroll
    for (int k = 0; k < 4; ++k) { const int c = tid + k * NTHR; int reg, row, part; post_decode(c, reg, row, part);
        const int off = reg == 0 ? PO_V + row * 144 : PO_G + row * 272;
        if (c < 1584) *(LAS u32x4*)(L + off + part * 16) = pp.stg[k]; }
    {
        const int dd = w >> 2, tb = (w >> 1) & 1, icb = w & 1;
        f32x16 Y;
#pragma unroll
        for (int q_ = 0; q_ < 4; ++q_) { Y[2 * q_] = bflo(pp.yc[0][q_]); Y[2 * q_ + 1] = bfhi(pp.yc[0][q_]); Y[8 + 2 * q_] = bflo(pp.yc[1][q_]); Y[9 + 2 * q_] = bfhi(pp.yc[1][q_]); }
#pragma unroll
        for (int rb = 0; rb < 2; ++rb)
#pragma unroll
            for (int s2 = 0; s2 < 2; ++s2) Y = __builtin_amdgcn_mfma_f32_32x32x16_bf16(__builtin_bit_cast(bf16x8, pp.ra[rb][s2]), __builtin_bit_cast(bf16x8, pp.xb[rb][s2]), Y, 0, 0, 0);
#pragma unroll
        for (int r = 0; r < 16; ++r) { const int tau = 32 * tb + (r & 3) + 8 * (r >> 2) + 4 * hi; const int t = dd == 0 ? tau : 63 - tau;
            *(LAS float*)(L + PO_Y + (dd * 64 + t) * 272 + (32 * icb + r32) * 4) = Y[r]; }
    }
    LBAR();
    post_stage_load(a, tid, nq, nh, nblk, pp);
    const int tl = 8 * tg + 4 * th;
#define SIG2V(a_) ({ const v2 t_ = (a_) * (-1.4426950408889634f); const v2 e_ = (v2){__builtin_amdgcn_exp2f(t_.x), __builtin_amdgcn_exp2f(t_.y)} + 1.0f; (v2){__builtin_amdgcn_rcpf(e_.x), __builtin_amdgcn_rcpf(e_.y)}; })
    {
        v2 z0[6], z1[6];
#pragma unroll
        for (int i = 0; i < 6; ++i) { const unsigned w0 = *(const LAS unsigned*)(L + PO_G + (tl + i) * 272 + cp * 4), w1 = *(const LAS unsigned*)(L + PO_G + (tl + i) * 272 + 128 + cp * 4);
            z0[i] = (v2){bflo(w0), bfhi(w0)}; z1[i] = (v2){bflo(w1), bfhi(w1)}; }
#pragma unroll
        for (int k = 0; k < 4; ++k) { const v2 s0 = SIG2V(z0[k + 1] + mp0 * (z0[k] - z0[k + 1]) + mn0 * (z0[k + 2] - z0[k + 1])), s1 = SIG2V(z1[k + 1] + mp1 * (z1[k] - z1[k + 1]) + mn1 * (z1[k + 2] - z1[k + 1]));
            *(LAS unsigned*)(L + PO_SG + (tl + k) * 272 + cp * 4) = cvt_pk_bf16(s0.x, s0.y); *(LAS unsigned*)(L + PO_SG + (tl + k) * 272 + 128 + cp * 4) = cvt_pk_bf16(s1.x, s1.y); }
    }
#undef SIG2V
    LBAR();
    if (w < 4) {
        const int mt = w >> 1, nt = w & 1;
        f32x16 acc = f32x16{};
#pragma unroll
        for (int ks = 0; ks < 8; ++ks) { const bf16x8 bv = *(const LAS bf16x8*)(L + PO_SG + (32 * nt + r32) * 272 + (16 * ks + 8 * hi) * 2);
            acc = __builtin_amdgcn_mfma_f32_32x32x16_bf16(gfr[ks], bv, acc, 0, 0, 0); }
#pragma unroll
        for (int g = 0; g < 4; ++g) *(LAS f32x4*)(L + PO_GF + (32 * nt + r32) * 272 + (32 * mt + 8 * g + 4 * hi) * 4) = (f32x4){acc[4 * g], acc[4 * g + 1], acc[4 * g + 2], acc[4 * g + 3]};
    }
    LBAR();
    {
        v2 zv[6];
#pragma unroll
        for (int i = 0; i < 6; ++i) { const unsigned wv = *(const LAS unsigned*)(L + PO_V + (tl + i) * 144 + cp * 4); zv[i] = (v2){bflo(wv), bfhi(wv)}; }
        v2 y2[4]; float red[4];
#pragma unroll
        for (int k = 0; k < 4; ++k) { y2[k] = *(const LAS v2*)(L + PO_Y + (tl + k) * 272 + cp * 8) + *(const LAS v2*)(L + PO_Y + (64 + tl + k) * 272 + cp * 8); red[k] = y2[k].x + y2[k].y; }
#define FOLD4(s_) ({ const bool b4_ = (lane >> 4) & 1, b3_ = (lane >> 3) & 1; float g_[2]; \
        _Pragma("unroll") for (int i_ = 0; i_ < 2; ++i_) { const float kp_ = b4_ ? s_[i_ + 2] : s_[i_], sd_ = b4_ ? s_[i_] : s_[i_ + 2]; g_[i_] = kp_ + __int_as_float(__builtin_amdgcn_ds_swizzle(__float_as_int(sd_), 0x401F)); } \
        const float kp2_ = b3_ ? g_[1] : g_[0], sd2_ = b3_ ? g_[0] : g_[1]; \
        float h_ = kp2_ + __int_as_float(__builtin_amdgcn_update_dpp(0, __float_as_int(sd2_), 0x128, 0xF, 0xF, true)); \
        h_ += __int_as_float(__builtin_amdgcn_update_dpp(0, __float_as_int(h_), 0x141, 0xF, 0xF, true)); \
        h_ += __int_as_float(__builtin_amdgcn_update_dpp(0, __float_as_int(h_), 0xB1, 0xF, 0xF, true)); \
        h_ += __int_as_float(__builtin_amdgcn_update_dpp(0, __float_as_int(h_), 0x4E, 0xF, 0xF, true)); h_; })
#define MINE(hs_, k_) ({ const float lo_ = __int_as_float(__builtin_amdgcn_readlane(hs_, 8 * (k_))), hi_ = __int_as_float(__builtin_amdgcn_readlane(hs_, 32 + 8 * (k_))); th ? hi_ : lo_; })
        const int hm = __float_as_int(FOLD4(red));
#pragma unroll
        for (int k = 0; k < 4; ++k) { y2[k] = y2[k] - MINE(hm, k) * (1.f / 64.f); red[k] = y2[k].x * y2[k].x + y2[k].y * y2[k].y; }
        const int hv = __float_as_int(FOLD4(red));
#pragma unroll
        for (int k = 0; k < 4; ++k) {
            const v2 yn = y2[k] * __builtin_amdgcn_rsqf(MINE(hv, k) * (1.f / 64.f) + LNX_EPS) * lg + lb;
            const v2 vs = zv[k + 1] + mpv * (zv[k] - zv[k + 1]) + mnv * (zv[k + 2] - zv[k + 1]);
            const v2 g = *(const LAS v2*)(L + PO_GF + (tl + k) * 272 + cp * 8);
            const v2 o = (yn + vs * bsum[k]) * g;
            *(unsigned*)(Zs + (size_t)(t_lo + k) * ZP + ZRR + chp) = cvt_pk_bf16(o.x, o.y); }
#undef FOLD4
#undef MINE
    }
    LBAR();
}
}


#define XB_TMO      128
#define XB_XCNT(j)  (256  + 64 * (j))
#define XB_XSUB(j)  (1280 + 64 * (j))
#define XB_XGEN(j)  (2304 + 64 * (j))
#define XB_TOP      3328
#define XB_TOPGEN   3392
#define XCD_BAR_WORDS 3456
#define XB_SPIN_CAP (1u << 20)
constexpr size_t CTL_ZERO_BYTES = 16384;
__device__ __forceinline__ unsigned xb_ld(unsigned* p)              { return __hip_atomic_load(p, __ATOMIC_RELAXED, __HIP_MEMORY_SCOPE_AGENT); }
__device__ __forceinline__ unsigned xb_add(unsigned* p, unsigned v) { return __hip_atomic_fetch_add(p, v, __ATOMIC_RELAXED, __HIP_MEMORY_SCOPE_AGENT); }
__device__ __forceinline__ unsigned xb_xcc_id() { return (unsigned)__builtin_amdgcn_s_getreg((3 << 11) | 20) & 0xFu; }
#define XB_SPIN(cond, bar) do { unsigned _sp = 0; while (cond) { __builtin_amdgcn_s_sleep(1); \
    if ((++_sp & 255u) == 0u) { if (xb_ld(&(bar)[XB_TMO])) break; if (_sp > XB_SPIN_CAP) { atomicAdd(&(bar)[XB_TMO], 1u); break; } } } } while (0)
struct XcdBarrier { unsigned* bar; unsigned x; volatile LAS unsigned* st; };
__device__ __forceinline__ XcdBarrier xcd_barrier_post(unsigned* bar, volatile LAS unsigned* st) {
    XcdBarrier b; b.bar = bar; b.x = xb_xcc_id(); b.st = st;
    if (threadIdx.x == 0) (void)xb_add(&bar[XB_XCNT(b.x)], 1u);
    return b;
}
__device__ __forceinline__ void xcd_barrier_complete(unsigned* bar, unsigned x, unsigned& nloc, unsigned& nx) {
    const unsigned G = gridDim.x * gridDim.y * gridDim.z;
    unsigned sum, cnt, mine, sp = 0u;
    for (;;) {
        sum = 0u; cnt = 0u; mine = 0u;
#pragma unroll
        for (unsigned j = 0; j < 16; ++j) { const unsigned c = xb_ld(&bar[XB_XCNT(j)]); sum += c; cnt += (c > 0u) ? 1u : 0u; mine = (j == x) ? c : mine; }
        if (sum == G) break;
        __builtin_amdgcn_s_sleep(1);
        if ((++sp & 255u) == 0u) { if (xb_ld(&bar[XB_TMO])) break; if (sp > XB_SPIN_CAP) { atomicAdd(&bar[XB_TMO], 1u); break; } }
    }
    nloc = mine > 0u ? mine : 1u; nx = cnt > 0u ? cnt : 1u;
}
__device__ __forceinline__ void xcd_barrier(const XcdBarrier& b) {
    asm volatile("s_waitcnt vmcnt(0)" ::: "memory");
    __syncthreads();
    if (threadIdx.x == 0) {
        unsigned* bar = b.bar;
        __builtin_amdgcn_s_waitcnt(0);
        unsigned nloc = b.st[0], nx = b.st[1];
        if (nloc == 0u) { xcd_barrier_complete(bar, b.x, nloc, nx); b.st[0] = nloc; b.st[1] = nx; }
        const unsigned old = xb_add(&bar[XB_XSUB(b.x)], 1u);
        const unsigned gen = old / nloc;
        if (old + 1u == (gen + 1u) * nloc) {
            __builtin_amdgcn_fence(__ATOMIC_RELEASE, "agent");
            asm volatile("s_waitcnt vmcnt(0)" ::: "memory");
            const unsigned og = xb_add(&bar[XB_TOP], 1u);
            const unsigned tg = og / nx;
            if (og + 1u == (tg + 1u) * nx) xb_add(&bar[XB_TOPGEN], 1u);
            else XB_SPIN(xb_ld(&bar[XB_TOPGEN]) == tg, bar);
            __builtin_amdgcn_fence(__ATOMIC_ACQUIRE, "agent");
            xb_add(&bar[XB_XGEN(b.x)], 1u);
            asm volatile("s_waitcnt vmcnt(0)" ::: "memory");
        } else {
            XB_SPIN(xb_ld(&bar[XB_XGEN(b.x)]) == gen, bar);
            __builtin_amdgcn_fence(__ATOMIC_ACQUIRE, "agent");
            asm volatile("s_waitcnt vmcnt(0)" ::: "memory");
        }
    }
    __syncthreads();
}

constexpr int NPHASE = 10;
constexpr int NOJUMP = 1 << 30;
template <int LO, int HI>
__global__ void __launch_bounds__(NTHR, 2) fwd_kernel(Args a) {
    extern __shared__ __attribute__((aligned(16))) unsigned char lds_raw[];
    Frame F; F.lds = (LAS unsigned char*)lds_raw; F.tid = threadIdx.x; F.lane = F.tid & 63; F.wave = __builtin_amdgcn_readfirstlane(F.tid >> 6);
    F.G = gridDim.x; { const int bx = blockIdx.x; F.vcu = (F.G % 8 == 0) ? (bx % 8) * (F.G / 8) + bx / 8 : bx; }
    unsigned char* ws = a.ws; bf16_t* Z = (bf16_t*)(ws + WS_Z);
    unsigned char* slots = (unsigned char*)a.out;
    if (F.tid == 0) {
#pragma unroll
        for (int i = 0; i < 27; ++i) *(const float* LAS*)(F.lds + PTRS_OFF + i * 8) = a.in[i];
        *(volatile LAS unsigned*)(F.lds + PTRS_OFF + 224) = 0u; *(volatile LAS unsigned*)(F.lds + PTRS_OFF + 228) = 0u;
        *(LAS unsigned long long*)(F.lds + PTRS_OFF - 64) = 0ull;
    }
    __syncthreads();
#if ONE_LAUNCH && !USE_CG
    const XcdBarrier bar = xcd_barrier_post((unsigned*)(ws + WS_CTL), (volatile LAS unsigned*)(F.lds + PTRS_OFF + 224));
#endif
#if ONE_LAUNCH
#if PROBE_SEG >= 0 || PROBE_CLK >= 0
    unsigned long long* tsb = (unsigned long long*)(ws + WS_CTL + 15872); int nts = 0;
#define STAMP() do { if (blockIdx.x == 0 && F.tid == 0) { tsb[nts] = __builtin_amdgcn_s_memrealtime(); tsb[32 + nts] = __builtin_amdgcn_s_memtime(); } ++nts; } while (0)
    STAMP();
#else
#define STAMP() do { } while (0)
#endif
#if USE_CG
#define SEAM(k) do { if constexpr ((k) + 1 < HI) { cg::this_grid().sync(); STAMP(); } } while (0)
#define RSYNC() do { cg::this_grid().sync(); STAMP(); } while (0)
#else
#define SEAM(k) do { if constexpr ((k) + 1 < HI) { xcd_barrier(bar); STAMP(); } } while (0)
#define RSYNC() do { xcd_barrier(bar); STAMP(); } while (0)
#endif
#else
#define SEAM(k) do { } while (0)
#define RSYNC() do { } while (0)
#endif
#define IN(k) (LO <= (k) && (k) < HI)
    if constexpr (IN(0)) { p0_prologue(F, a); SEAM(0);
#if PROBE_DOUBLE == 4
        p0_prologue(F, a); RSYNC();
#endif
    }
    if constexpr (IN(1)) { pg8::Gemm g{(const char*)a.out, (const bf16_t*)(ws + WS_WIN), MTOK, ZP, DM, DM * 2, NOJUMP, 0}; pg8::StaticOrder S; S.init(MTOK, ZP, F.G, (int)blockIdx.x);
        pg8::EpiZ E{Z, ZP}; pg8::gemm_phase<pg8::EpiZ, pg8::StaticOrder, true>(F.lds, g, S, E); SEAM(1);
#if PROBE_DOUBLE == 3
        pg8::gemm_phase<pg8::EpiZ, pg8::StaticOrder, true>(F.lds, g, S, E); RSYNC();
#endif
    }
    if constexpr (IN(2)) { qk_prep(F, a);
        unsigned* rdy = (unsigned*)(ws + WS_CTL) + 3584;
#pragma unroll 1
        for (int rnd = 0; rnd < 2; ++rnd) {
            const int nprod = rnd == 1 ? F.G - 16 : F.G;
            if (F.vcu < nprod) {
#define S1_DECODE(i_, d_, q_, h_, ck_, it_, pub_) do { if (rnd == 1) { const int c_ = ((i_) >> 4) & 15, cc_ = (((i_) >> 8) << 4) + ((i_) & 15); d_ = c_ >> 3; h_ = c_ & 7; q_ = 0; ck_ = d_ ? 255 - cc_ : cc_; it_ = c_ * 256 + ck_; pub_ = rdy + c_ * 16 + ((i_) >> 8); } \
                    else { ck_ = (i_) & 31; h_ = ((i_) >> 5) & 7; q_ = 1 + (((i_) >> 8) & 7); d_ = (i_) >> 11; it_ = (i_); pub_ = nullptr; } } while (0)
                { int d, q, h, ck, it; unsigned* pub; S1_DECODE(F.vcu, d, q, h, ck, it, pub); (void)it; (void)pub;
                  u32x4 stg[6]; rw::s1_stage_load(a, F.tid, q, h, ck, stg); const f32x2_t par = rw::s1_param_load(F.lds, F.tid, d, h);
                  rw::s1_stage_store(F.lds, F.tid, d, q, ck, stg, par); LBAR(); }
                unsigned* pub_prev = nullptr;
#pragma unroll 1
                for (int i = F.vcu; i < 4096; i += nprod) {
                    int d, q, h, ck, it, nd, nq, nh, nck, nit; unsigned* pub; unsigned* npub; S1_DECODE(i, d, q, h, ck, it, pub); const int ni = i + nprod < 4096 ? i + nprod : i; S1_DECODE(ni, nd, nq, nh, nck, nit, npub); (void)nit; (void)npub;
                    rw::s1_item(F, a, d, q, h, ck, slots + (size_t)it * SLOT_BYTES, nd, nq, nh, nck, rnd == 1, pub_prev); pub_prev = pub; }
                if (pub_prev) { asm volatile("s_waitcnt vmcnt(0)" ::: "memory"); __syncthreads(); if (F.tid == 0) __hip_atomic_fetch_add(pub_prev, 1u, __ATOMIC_RELAXED, __HIP_MEMORY_SCOPE_AGENT); }
#undef S1_DECODE
            } else {
                const int c = F.vcu - nprod;
                rw::s23_chain_wg(F, a, c >> 3, 0, c & 7, slots + (size_t)c * 256 * SLOT_BYTES, rdy + c * 16);
            }
            if (rnd == 0) {
                RSYNC();
                for (int chain = F.vcu; chain < 128; chain += F.G) { const int h = chain & 7, q = 1 + ((chain >> 3) & 7), d = chain >> 6;
                    rw::s23_chain_wg(F, a, d, q, h, slots + (size_t)chain * 32 * SLOT_BYTES, nullptr); }
            }
            RSYNC();
            {
#define PO_DECODE(it_, q_, h_, b_) do { if (rnd == 1) { q_ = 0; h_ = ((it_) >> 8) & 7; b_ = (it_) & 255; } else { q_ = 1 + (((it_) >> 8) & 7); h_ = ((it_) >> 5) & 7; b_ = (it_) & 31; } } while (0)
                rw::PostPre pp;
                { int q, h, b; PO_DECODE(F.vcu, q, h, b); rw::post_stage_load(a, F.tid, q, h, b, pp); }
#pragma unroll 1
                for (int it = F.vcu; it < 2048; it += F.G) { int q, h, b, nq, nh, nb; PO_DECODE(it, q, h, b); const int nit = it + F.G < 2048 ? it + F.G : it; PO_DECODE(nit, nq, nh, nb);
                    rw::post_item(F, a, q, h, b, pp, nq, nh, nb); }
#undef PO_DECODE
            }
            if (rnd == 0) RSYNC();
        }
        SEAM(2); }
    if constexpr (IN(4)) {
        float lam; { const float p1 = wave_sum(a.in[6][F.lane] * a.in[7][F.lane]), p2 = wave_sum(a.in[8][F.lane] * a.in[9][F.lane]); lam = __expf(p1) - __expf(p2) + LAMBDA_INIT; }
#if PROBE_DOUBLE == 1
        for (int v = F.vcu; v < 256; v += F.G) {
            att::attn_unit(0, SP, v >> 6, v & 63, Z, F.lds, lam, a.in[10], (bf16_t*)a.out, 512);
            att::attn_unit(SP + (v >> 5) * SS, SS, (v >> 3) & 3, v & 7, Z, F.lds, lam, a.in[10], (bf16_t*)a.out, 512); }
        RSYNC();
#endif
        for (int v = F.vcu; v < 256; v += F.G) {
            att::attn_unit(0, SP, v >> 6, v & 63, Z, F.lds, lam, a.in[10], Z, ZP);
            att::attn_unit(SP + (v >> 5) * SS, SS, (v >> 3) & 3, v & 7, Z, F.lds, lam, a.in[10], Z, ZP); }
        SEAM(4); }
    if constexpr (IN(5)) { pg8::Gemm g{(const char*)Z, (const bf16_t*)(ws + WS_WOUT), MTOK, DM, DM, ZP * 2, 8, 2048}; pg8::StaticOrder S; S.init(MTOK, DM, F.G, (int)blockIdx.x);
        pg8::EpiOut E{a.in[0], a.in[1], a.out, Z, (float*)(ws + WS_ROWSQ)}; pg8::gemm_phase<pg8::EpiOut, pg8::StaticOrder, true>(F.lds, g, S, E); SEAM(5); }
#define FFN_UP(k, half) if constexpr (IN(k)) { pg8::Gemm g{(const char*)(Z + (size_t)(half) * 16384 * ZP + ZXN2), (const bf16_t*)(ws + WS_W1), 16384, DFF, DM, ZP * 2, NOJUMP, 0}; pg8::StaticOrder S; S.init(16384, DFF, F.G, (int)blockIdx.x); \
        pg8::EpiUp E{(char*)(ws + WS_Z), (const float*)(ws + WS_ROWSQ), (half) * 16384}; pg8::gemm_phase<pg8::EpiUp, pg8::StaticOrder, true>(F.lds, g, S, E); SEAM(k); }
#define FFN_DN(k, half) if constexpr (IN(k)) { pg8::Gemm g{(const char*)(ws + WS_Z), (const bf16_t*)(ws + WS_W2), 16384, DM, DFF, 13312, 32, 2560}; pg8::StaticOrder S; S.init(16384, DM, F.G, (int)blockIdx.x); \
        pg8::EpiDown E{a.out, (half) * 16384}; pg8::gemm_phase<pg8::EpiDown, pg8::StaticOrder, true>(F.lds, g, S, E); SEAM(k); }
    FFN_UP(6, 0) FFN_DN(7, 0) FFN_UP(8, 1) FFN_DN(9, 1)
#if PROBE_S1 >= 0 || PROBE_ATT
    if (F.tid == 0) { const unsigned long long dt = *(LAS unsigned long long*)(F.lds + PTRS_OFF - 64), t0_ = __builtin_amdgcn_s_memrealtime();
        while (__builtin_amdgcn_s_memrealtime() - t0_ < dt) __builtin_amdgcn_s_sleep(16); }
#endif
#if PROBE_SEG >= 0 || PROBE_CLK >= 0
    STAMP();
#if PROBE_CLK >= 0
    if (blockIdx.x == 0 && F.tid == 0) { asm volatile("s_waitcnt vmcnt(0)" ::: "memory"); const unsigned long long wt_ = tsb[PROBE_CLK + 1] - tsb[PROBE_CLK], cy_ = tsb[32 + PROBE_CLK + 1] - tsb[32 + PROBE_CLK];
        const unsigned long long dt = cy_ * 1000ull / (wt_ ? wt_ : 1ull), t0_ = __builtin_amdgcn_s_memrealtime();
        while (__builtin_amdgcn_s_memrealtime() - t0_ < dt) __builtin_amdgcn_s_sleep(16); }
#endif
    if (PROBE_CLK < 0 && blockIdx.x == 0 && F.tid == 0) { asm volatile("s_waitcnt vmcnt(0)" ::: "memory"); const unsigned long long dt = tsb[PROBE_SEG + 1] - tsb[PROBE_SEG], t0_ = __builtin_amdgcn_s_memrealtime();
        while (__builtin_amdgcn_s_memrealtime() - t0_ < dt) __builtin_amdgcn_s_sleep(16); }
#endif
#undef FFN_UP
#undef FFN_DN
#undef IN
#undef SEAM
#undef RSYNC
}

extern "C" void kernel_launch(void* const* d_in, const int* in_sizes, int n_in, void* d_out, int out_size, void* d_ws, size_t ws_size, hipStream_t stream) {
    static int grid = 0;
    if (grid == 0) {
        if (n_in != 27 || out_size != MTOK * DM || ws_size < WS_TOTAL) { fprintf(stderr, "kernel_launch: unexpected shapes (n_in %d out %d ws %zu)\n", n_in, out_size, ws_size); grid = -1; return; }
        int dev = 0, cus = 0; (void)hipGetDevice(&dev); (void)hipDeviceGetAttribute(&cus, hipDeviceAttributeMultiprocessorCount, dev);
        bool ok = true;
#if ONE_LAUNCH
        ok = ok && hipFuncSetAttribute((const void*)fwd_kernel<0, NPHASE>, hipFuncAttributeMaxDynamicSharedMemorySize, LDS_BYTES) == hipSuccess;
        int per_cu = 0; (void)hipOccupancyMaxActiveBlocksPerMultiprocessor(&per_cu, (const void*)fwd_kernel<0, NPHASE>, NTHR, LDS_BYTES); (void)hipGetLastError();
        if (per_cu < 1) fprintf(stderr, "kernel_launch: occupancy query says %d blocks/CU\n", per_cu);
#else
#define SETA(p) ok = ok && hipFuncSetAttribute((const void*)fwd_kernel<p, p + 1>, hipFuncAttributeMaxDynamicSharedMemorySize, LDS_BYTES) == hipSuccess;
        SETA(0) SETA(1) SETA(2) SETA(3) SETA(4) SETA(5) SETA(6) SETA(7) SETA(8) SETA(9)
#undef SETA
#endif
        if (!ok) { fprintf(stderr, "kernel_launch: hipFuncSetAttribute failed\n"); grid = -1; return; }
        grid = cus > 256 ? 256 : cus;
    }
    if (grid < 0) return;
    Args a{};
    for (int i = 0; i < 27; ++i) a.in[i] = (const float*)d_in[i];
    a.out = (float*)d_out; a.ws = (unsigned char*)d_ws;
#if ONE_LAUNCH
    a.ph_lo = 0; a.ph_hi = NPHASE;
#if !USE_CG
    if (hipMemsetAsync((char*)d_ws + WS_CTL, 0, CTL_ZERO_BYTES, stream) != hipSuccess) { fprintf(stderr, "kernel_launch: hipMemsetAsync failed\n"); return; }
#endif
    void* args[] = {&a};
    hipError_t e = hipLaunchCooperativeKernel((const void*)fwd_kernel<0, NPHASE>, dim3(grid), dim3(NTHR), args, LDS_BYTES, stream);
    if (e != hipSuccess) fprintf(stderr, "cooperative launch failed: %s (grid %d)\n", hipGetErrorString(e), grid);
#else
#define LAUNCH(p) hipLaunchKernelGGL((fwd_kernel<p, p + 1>), dim3(grid), dim3(NTHR), LDS_BYTES, stream, a);
    LAUNCH(0) LAUNCH(1) LAUNCH(2) LAUNCH(3) LAUNCH(4) LAUNCH(5) LAUNCH(6) LAUNCH(7) LAUNCH(8) LAUNCH(9)
#undef LAUNCH
#endif
}
```

```cpp
#include <hip/hip_runtime.h>
#include <hip/hip_cooperative_groups.h>
#include <cstdio>
#include <cstdint>
namespace cg = cooperative_groups;

#ifndef ONE_LAUNCH
#define ONE_LAUNCH 1
#endif
#ifndef USE_CG
#define USE_CG 0
#endif
#ifndef PROBE_SEG
#define PROBE_SEG -1
#endif
#ifndef PROBE_S1
#define PROBE_S1 -1
#endif
#ifndef PROBE_ATT
#define PROBE_ATT 0
#endif
#ifndef PROBE_CLK
#define PROBE_CLK -1
#endif
#ifndef PROBE_DOUBLE
#define PROBE_DOUBLE 0
#endif

#define LAS __attribute__((address_space(3)))
#define GAS __attribute__((address_space(1)))
typedef unsigned short bf16_t;
typedef short bf16x8 __attribute__((ext_vector_type(8)));
typedef short s16x4 __attribute__((ext_vector_type(4)));
typedef float f32x4 __attribute__((ext_vector_type(4)));
typedef float f32x16 __attribute__((ext_vector_type(16)));
typedef unsigned u32x4 __attribute__((ext_vector_type(4)));
typedef unsigned u32x2 __attribute__((ext_vector_type(2)));
typedef float f32x2_t __attribute__((ext_vector_type(2)));
typedef __bf16 bf16x2_t __attribute__((ext_vector_type(2)));

constexpr int MTOK = 32768, DM = 1024, ZP = 3328, DFF = 4096;
constexpr int SP = 16384, SS = 2048;
constexpr int ZQ = 0, ZK = 512, ZV = 1024, ZRR = 1536, ZRK = 2048, ZRV = 2560, ZWD = 3072, ZAD = 3136, ZGD = 3200;
constexpr int ZXN2 = 2048;
constexpr float NORM_EPS = 1e-6f, LNX_EPS = 64e-5f;
constexpr float QSCALE = 0.125f * 1.4426950408889634f;
constexpr float LAMBDA_INIT = 0.2f;
constexpr int NCHUNK_P = SP / 64, NCHUNK_S = SS / 64;

constexpr size_t MiB = 1u << 20;
constexpr size_t WS_CTL = 0;
constexpr size_t WS_WIN = 1 * MiB, WS_WOUT = 8 * MiB, WS_W1 = 10 * MiB, WS_W2 = 18 * MiB;
constexpr size_t WS_ROPE = 26 * MiB;
constexpr size_t WS_LORA = 30 * MiB;
constexpr size_t WS_ROWSQ = 31 * MiB;
constexpr size_t WS_BONUS = 33 * MiB;
constexpr size_t WS_Z = 36 * MiB;
constexpr size_t WS_END = 244 * MiB;
constexpr size_t WS_E1 = 244 * MiB;
constexpr size_t WS_TOTAL = 252 * MiB;
static_assert(WS_Z + (size_t)MTOK * ZP * 2 <= WS_END, "ws map");
constexpr size_t SLOT_BYTES = 32768;

__device__ __forceinline__ unsigned cvt_pk_bf16(float lo, float hi) { f32x2_t v = {lo, hi}; bf16x2_t b = __builtin_convertvector(v, bf16x2_t); return __builtin_bit_cast(unsigned, b); }
__device__ __forceinline__ float bf2f(unsigned short u) { return __uint_as_float(((unsigned)u) << 16); }
__device__ __forceinline__ float bflo(unsigned u) { return __uint_as_float(u << 16); }
__device__ __forceinline__ float bfhi(unsigned u) { return __uint_as_float(u & 0xffff0000u); }
__device__ __forceinline__ unsigned short f2bf(float f) { return (unsigned short)(cvt_pk_bf16(f, 0.f) & 0xffffu); }
__device__ __forceinline__ float wave_sum(float v) {
#pragma unroll
    for (int o = 1; o < 64; o <<= 1) v += __shfl_xor(v, o);
    return v;
}
__device__ __forceinline__ float wave_sum_dpp(float v) {
    int x = __float_as_int(v);
    v += __int_as_float(__builtin_amdgcn_update_dpp(0, x, 0xB1, 0xF, 0xF, true)); x = __float_as_int(v);
    v += __int_as_float(__builtin_amdgcn_update_dpp(0, x, 0x4E, 0xF, 0xF, true)); x = __float_as_int(v);
    v += __int_as_float(__builtin_amdgcn_update_dpp(0, x, 0x124, 0xF, 0xF, true)); x = __float_as_int(v);
    v += __int_as_float(__builtin_amdgcn_update_dpp(0, x, 0x128, 0xF, 0xF, true)); x = __float_as_int(v);
    const float a = __int_as_float(__builtin_amdgcn_readlane(x, 0)), b = __int_as_float(__builtin_amdgcn_readlane(x, 16)), c = __int_as_float(__builtin_amdgcn_readlane(x, 32)), d = __int_as_float(__builtin_amdgcn_readlane(x, 48));
    return (a + b) + (c + d);
}
__device__ __forceinline__ void wave_sum8(float (&s)[8], int lane) {
    float f[4];
#pragma unroll
    for (int i = 0; i < 4; ++i) { auto rr = __builtin_amdgcn_permlane32_swap(__float_as_uint(s[i]), __float_as_uint(s[i + 4]), false, false); f[i] = __uint_as_float(rr[0]) + __uint_as_float(rr[1]); }
    const bool b4 = (lane >> 4) & 1, b3 = (lane >> 3) & 1;
    float g[2];
#pragma unroll
    for (int i = 0; i < 2; ++i) { const float keep = b4 ? f[i + 2] : f[i], send = b4 ? f[i] : f[i + 2];
        g[i] = keep + __int_as_float(__builtin_amdgcn_ds_swizzle(__float_as_int(send), 0x401F)); }
    const float keep = b3 ? g[1] : g[0], send = b3 ? g[0] : g[1];
    float h = keep + __int_as_float(__builtin_amdgcn_update_dpp(0, __float_as_int(send), 0x128, 0xF, 0xF, true));
    h += __int_as_float(__builtin_amdgcn_update_dpp(0, __float_as_int(h), 0x141, 0xF, 0xF, true));
    h += __int_as_float(__builtin_amdgcn_update_dpp(0, __float_as_int(h), 0xB1, 0xF, 0xF, true));
    h += __int_as_float(__builtin_amdgcn_update_dpp(0, __float_as_int(h), 0x4E, 0xF, 0xF, true));
    const int hx = __float_as_int(h);
#pragma unroll
    for (int k = 0; k < 8; ++k) s[k] = __int_as_float(__builtin_amdgcn_readlane(hx, 8 * k));
}
#define LDS_WAIT() asm volatile("s_waitcnt lgkmcnt(0)" ::: "memory")
#define VM_WAIT() asm volatile("s_waitcnt vmcnt(0)" ::: "memory")
#define LBAR() asm volatile("s_waitcnt lgkmcnt(0)\n\ts_barrier" ::: "memory")

namespace pg8 {
constexpr int BM = 256, BK = 64, HALF = 128, HTB = HALF * BK * 2, STAGE_BYTES = 8 * HTB, NXCD = 8, WGM = 8;
__host__ __device__ __forceinline__ int lds_byte(int r, int c) { const int st = (r >> 4) * 2 + (c >> 5), rr = r & 15, cc = c & 31, ob = rr * 64 + cc * 2; return st * 1024 + (ob ^ (((ob >> 9) & 1) << 5)); }
__host__ __device__ __forceinline__ void stage_rc(int b, int& R, int& C) { const int st = b / 1024, sb = b % 1024, swz = sb ^ (((sb >> 9) & 1) << 5); R = (st >> 1) * 16 + swz / 64; C = (st & 1) * 32 + (swz % 64) / 2; }
__host__ __device__ __forceinline__ int perm32(int rho) { const int n = rho >> 4, i = rho & 15; return 8 * (i >> 2) + 4 * n + (i & 3); }
struct Unit { int pm, pn; };
struct Gemm { const char* A; const bf16_t* Bt; int M, N, K; int lda; int jkt; int jbytes; };
struct StaticOrder {
    int nM, nN, nwg, G, c;
    __host__ __device__ void init(int M, int N, int G_, int c_) { nM = M / BM; nN = N / BM; nwg = nM * nN; G = G_; c = c_; }
    __host__ __device__ bool next(int i, Unit& u) const {
        const long L = (long)i * G + c; if (L >= nwg) return false;
        int wgid = (int)L; { const int q = nwg / NXCD, r = nwg % NXCD, xcd = wgid % NXCD, off = wgid / NXCD; wgid = (xcd < r ? xcd * (q + 1) : r * (q + 1) + (xcd - r) * q) + off; }
        const int nig = WGM * nN, gid = wgid / nig, fm = gid * WGM, gsz = (nM - fm) < WGM ? (nM - fm) : WGM;
        u.pm = fm + ((wgid % nig) % gsz); u.pn = (wgid % nig) / gsz; return true;
    }
};

struct EpiZ {
    static constexpr bool PERM = true;
    bf16_t* O; int ldc;
    __device__ __forceinline__ void operator()(const f32x4 (&acc)[2][2][4][2], const Unit& u, int wr, int wc, int fr, int fq) const {
        const int row0 = u.pm * BM + wr * 64 + fr, col0 = u.pn * BM + wc * 32 + 8 * fq;
#pragma unroll
        for (int ai = 0; ai < 2; ++ai)
#pragma unroll
            for (int m = 0; m < 4; ++m) { bf16_t* rowp = O + (size_t)(row0 + ai * HALF + m * 16) * ldc + col0;
#pragma unroll
                for (int bj = 0; bj < 2; ++bj) { const f32x4 v0 = acc[ai][bj][m][0], v1 = acc[ai][bj][m][1];
                    u32x4 w; w.x = cvt_pk_bf16(v0[0], v0[1]); w.y = cvt_pk_bf16(v0[2], v0[3]); w.z = cvt_pk_bf16(v1[0], v1[1]); w.w = cvt_pk_bf16(v1[2], v1[3]);
                    *(u32x4*)(rowp + bj * HALF) = w; } }
    }
};
struct EpiOut {
    static constexpr bool PERM = true;
    const float* xp; const float* xs; float* out; bf16_t* Z; float* rowsq;
    __device__ __forceinline__ void operator()(const f32x4 (&acc)[2][2][4][2], const Unit& u, int wr, int wc, int fr, int fq) const {
        const int col0 = u.pn * BM + wc * 32 + 8 * fq;
#pragma unroll
        for (int ai = 0; ai < 2; ++ai)
#pragma unroll
            for (int m = 0; m < 4; ++m) { const int r = u.pm * BM + ai * HALF + wr * 64 + m * 16 + fr;
                const float* xr = (r < SP ? xp + (size_t)r * DM : xs + (size_t)(r - SP) * DM) + col0; bf16_t* zr = Z + (size_t)r * ZP + ZXN2 + col0;
                float ss = 0.f;
#pragma unroll
                for (int bj = 0; bj < 2; ++bj) { const f32x4 x0 = *(const f32x4*)(xr + bj * HALF), x1 = *(const f32x4*)(xr + bj * HALF + 4);
                    const f32x4 o0 = x0 + acc[ai][bj][m][0], o1 = x1 + acc[ai][bj][m][1];
                    ss += ((o0[0] * o0[0] + o0[1] * o0[1]) + (o0[2] * o0[2] + o0[3] * o0[3])) + ((o1[0] * o1[0] + o1[1] * o1[1]) + (o1[2] * o1[2] + o1[3] * o1[3]));
                    u32x4 w; w.x = cvt_pk_bf16(o0[0], o0[1]); w.y = cvt_pk_bf16(o0[2], o0[3]); w.z = cvt_pk_bf16(o1[0], o1[1]); w.w = cvt_pk_bf16(o1[2], o1[3]); *(u32x4*)(zr + bj * HALF) = w; }
                ss += __shfl_xor(ss, 16); ss += __shfl_xor(ss, 32);
                if (fq == 0) rowsq[(size_t)r * 16 + u.pn * 4 + wc] = ss;
                if (m & 1) asm volatile("" ::: "memory"); }
    }
};
struct EpiUp {
    static constexpr bool PERM = true;
    char* H; const float* rowsq; int row_off;
    __device__ __forceinline__ void operator()(const f32x4 (&acc)[2][2][4][2], const Unit& u, int wr, int wc, int fr, int fq) const {
        const int row0 = u.pm * BM + wr * 64 + fr, col0 = u.pn * BM + wc * 32 + 8 * fq;
#pragma unroll
        for (int ai = 0; ai < 2; ++ai)
#pragma unroll
            for (int m = 0; m < 4; ++m) { const int r = row0 + ai * HALF + m * 16; const f32x4* rq = (const f32x4*)(rowsq + (size_t)(row_off + r) * 16);
                const f32x4 q0 = rq[0], q1 = rq[1], q2 = rq[2], q3 = rq[3];
                const float ssum = ((q0[0] + q0[1]) + (q0[2] + q0[3])) + ((q1[0] + q1[1]) + (q1[2] + q1[3])) + ((q2[0] + q2[1]) + (q2[2] + q2[3])) + ((q3[0] + q3[1]) + (q3[2] + q3[3]));
                const float rstd = __builtin_amdgcn_rsqf(ssum * (1.0f / DM) + NORM_EPS);
                char* rowp = H + (size_t)r * 13312;
#pragma unroll
                for (int bj = 0; bj < 2; ++bj) { const int c = col0 + bj * HALF; f32x4 v0 = acc[ai][bj][m][0] * rstd, v1 = acc[ai][bj][m][1] * rstd;
#pragma unroll
                    for (int e = 0; e < 4; ++e) { const float a = fmaxf(v0[e], 0.f), b = fmaxf(v1[e], 0.f); v0[e] = a * a; v1[e] = b * b; }
                    u32x4 w; w.x = cvt_pk_bf16(v0[0], v0[1]); w.y = cvt_pk_bf16(v0[2], v0[3]); w.z = cvt_pk_bf16(v1[0], v1[1]); w.w = cvt_pk_bf16(v1[2], v1[3]);
                    *(u32x4*)(rowp + (size_t)c * 2 + (c >= 2048 ? 2560 : 0)) = w; } }
    }
};
struct EpiDown {
    static constexpr bool PERM = true;
    float* out; const bf16_t* Z; int row_off;
    __device__ __forceinline__ void operator()(const f32x4 (&acc)[2][2][4][2], const Unit& u, int wr, int wc, int fr, int fq) const {
        const int col0 = u.pn * BM + wc * 32 + 8 * fq;
#pragma unroll
        for (int ai = 0; ai < 2; ++ai)
#pragma unroll
            for (int m = 0; m < 4; ++m) { const int r = row_off + u.pm * BM + ai * HALF + wr * 64 + m * 16 + fr; float* orow = out + (size_t)r * DM + col0; const bf16_t* zr = Z + (size_t)r * ZP + ZXN2 + col0;
#pragma unroll
                for (int bj = 0; bj < 2; ++bj) { const u32x4 xw = *(const u32x4*)(zr + bj * HALF);
                    const f32x4 x0 = {bflo(xw[0]), bfhi(xw[0]), bflo(xw[1]), bfhi(xw[1])}, x1 = {bflo(xw[2]), bfhi(xw[2]), bflo(xw[3]), bfhi(xw[3])};
                    *(f32x4*)(orow + bj * HALF) = x0 + acc[ai][bj][m][0]; *(f32x4*)(orow + bj * HALF + 4) = x1 + acc[ai][bj][m][1]; }
                if (m & 1) asm volatile("" ::: "memory"); }
    }
};

template <class Epi, class Sched, bool ALIGN_EPI>
__device__ __forceinline__ void gemm_phase(LAS unsigned char* lds, const Gemm g, const Sched& S, const Epi& E) {
    int tid_ = threadIdx.x; asm volatile("" : "+v"(tid_));
    const int tid = tid_, wid = __builtin_amdgcn_readfirstlane(tid >> 6), lane = tid & 63, wr = wid >> 2, wc = wid & 3, fr = lane & 15, fq = lane >> 4;
    const int K = g.K, nt = K / BK;
    unsigned voffA[2], voffB[2];
#pragma unroll
    for (int i = 0; i < 2; ++i) { int R, C; stage_rc(tid * 16 + i * 8192, R, C); const int Rb = Epi::PERM ? ((R & ~31) + perm32(R & 31)) : R;
        voffA[i] = (unsigned)(R * g.lda + C * 2); voffB[i] = (unsigned)(Rb * K + C) * 2u; }
    const size_t kstep = (size_t)(BK * 2);
    const size_t hstepA = (size_t)HALF * g.lda, tstepA = 2 * hstepA;
    const size_t hstepB = (size_t)HALF * K * 2, tstepB = 2 * hstepB;
    const unsigned ldsw = (unsigned)wid * 1024u;
    const int aoff = lds_byte(wr * 64 + fr, fq * 8), boff = lds_byte(wc * 32 + fr, fq * 8);
#define PG8_AOFF(kt) ((size_t)(kt) * kstep + ((kt) >= g.jkt ? (size_t)g.jbytes : (size_t)0))
#define PG8_SA(b, h) (((b) * 2 + (h)) * HTB)
#define PG8_SB(b, h) ((4 + (b) * 2 + (h)) * HTB)
#define PG8_STAGE(bufoff, gbase, voff) do { _Pragma("unroll") for (int _i = 0; _i < 2; ++_i) \
        __builtin_amdgcn_global_load_lds((const unsigned*)((const char*)(gbase) + (voff)[_i]), (LAS unsigned*)(lds + (bufoff) + ldsw + _i * 8192), 16, 0, 0); } while (0)
#define PG8_LDA(dst, b, h) do { _Pragma("unroll") for (int m = 0; m < 4; ++m) _Pragma("unroll") for (int k = 0; k < 2; ++k) dst[m][k] = *(const LAS bf16x8*)(lds + PG8_SA(b, h) + aoff + m * 2048 + k * 1024); } while (0)
#define PG8_LDB(dst, b, h) do { _Pragma("unroll") for (int n = 0; n < 2; ++n) _Pragma("unroll") for (int k = 0; k < 2; ++k) dst[n][k] = *(const LAS bf16x8*)(lds + PG8_SB(b, h) + boff + n * 2048 + k * 1024); } while (0)
#define PG8_MMA(ai, bj, At, Bt) do { __builtin_amdgcn_s_setprio(1); _Pragma("unroll") for (int m = 0; m < 4; ++m) _Pragma("unroll") for (int n = 0; n < 2; ++n) _Pragma("unroll") for (int k = 0; k < 2; ++k) \
        acc[ai][bj][m][n] = __builtin_amdgcn_mfma_f32_16x16x32_bf16(Bt[n][k], At[m][k], acc[ai][bj][m][n], 0, 0, 0); __builtin_amdgcn_s_setprio(0); } while (0)
#define PG8_WAIT_V(n) asm volatile("s_waitcnt vmcnt(" #n ")" ::: "memory")
#define PG8_WAIT_L(n) asm volatile("s_waitcnt lgkmcnt(" #n ")" ::: "memory")
#define PG8_BAR __builtin_amdgcn_s_barrier()
#define PG8_SCHED __builtin_amdgcn_sched_barrier(0)
    Unit cur, nxt; int ui = 0;
    if (!S.next(0, cur)) return;
    f32x4 acc[2][2][4][2];
#pragma unroll
    for (int a = 0; a < 2; ++a)
#pragma unroll
        for (int b = 0; b < 2; ++b)
#pragma unroll
            for (int m = 0; m < 4; ++m)
#pragma unroll
                for (int n = 0; n < 2; ++n) acc[a][b][m][n] = (f32x4){0.f, 0.f, 0.f, 0.f};
    bf16x8 At[4][2], B0[2][2], B1[2][2];
    const char* cA = g.A + (size_t)cur.pm * tstepA; const char* cB = (const char*)g.Bt + (size_t)cur.pn * tstepB;
    {
        PG8_STAGE(PG8_SB(0, 0), cB, voffB); PG8_STAGE(PG8_SB(0, 1), cB + hstepB, voffB); PG8_STAGE(PG8_SA(0, 0), cA + PG8_AOFF(0), voffA); PG8_STAGE(PG8_SA(0, 1), cA + hstepA + PG8_AOFF(0), voffA);
        if (wr == 1) PG8_BAR;
        PG8_WAIT_V(2); PG8_BAR;
        PG8_STAGE(PG8_SB(1, 0), cB + kstep, voffB); PG8_STAGE(PG8_SA(1, 0), cA + PG8_AOFF(1), voffA); PG8_STAGE(PG8_SB(1, 1), cB + hstepB + kstep, voffB);
        PG8_WAIT_V(6); PG8_BAR;
    }
    for (;;) {
        const bool has_next = S.next(ui + 1, nxt);
        const char* nA = has_next ? g.A + (size_t)nxt.pm * tstepA : cA; const char* nB = has_next ? (const char*)g.Bt + (size_t)nxt.pn * tstepB : cB;
        for (int t = 0; t < nt; t += 2) {
            const bool last = (t == nt - 2);
            const char* a1 = cA + PG8_AOFF(t + 1);
            const char* a2 = last ? nA + PG8_AOFF(0) : cA + PG8_AOFF(t + 2); const char* b2 = last ? nB : cB + (size_t)(t + 2) * kstep;
            const char* a3 = last ? nA + PG8_AOFF(1) : cA + PG8_AOFF(t + 3); const char* b3 = b2 + kstep;
            PG8_LDB(B0, 0, 0); PG8_LDB(B1, 0, 1); PG8_SCHED; PG8_LDA(At, 0, 0); PG8_STAGE(PG8_SA(1, 1), a1 + hstepA, voffA);
            PG8_WAIT_V(8); PG8_WAIT_L(0); PG8_BAR; PG8_MMA(0, 0, At, B0); PG8_MMA(0, 1, At, B1); PG8_BAR; PG8_SCHED;
            PG8_LDA(At, 0, 1); PG8_STAGE(PG8_SB(0, 0), b2, voffB); PG8_STAGE(PG8_SB(0, 1), b2 + hstepB, voffB); PG8_STAGE(PG8_SA(0, 0), a2, voffA);
            PG8_WAIT_V(8); PG8_WAIT_L(0); PG8_BAR; PG8_MMA(1, 0, At, B0); PG8_MMA(1, 1, At, B1); PG8_BAR; PG8_SCHED;
            PG8_LDB(B0, 1, 0); PG8_LDB(B1, 1, 1); PG8_SCHED; PG8_LDA(At, 1, 0); PG8_STAGE(PG8_SA(0, 1), a2 + hstepA, voffA);
            PG8_WAIT_V(8); PG8_WAIT_L(0); PG8_BAR; PG8_MMA(0, 0, At, B0); PG8_MMA(0, 1, At, B1); PG8_BAR; PG8_SCHED;
            PG8_LDA(At, 1, 1); PG8_STAGE(PG8_SB(1, 0), b3, voffB); PG8_STAGE(PG8_SB(1, 1), b3 + hstepB, voffB); PG8_STAGE(PG8_SA(1, 0), a3, voffA);
            PG8_WAIT_V(8); PG8_WAIT_L(0); PG8_BAR; PG8_MMA(1, 0, At, B0); PG8_MMA(1, 1, At, B1); PG8_BAR; PG8_SCHED;
        }
        if constexpr (ALIGN_EPI) { if (wr == 0) PG8_BAR; }
        E(acc, cur, wr, wc, fr, fq);
        if (!has_next) break;
#pragma unroll
        for (int a = 0; a < 2; ++a)
#pragma unroll
            for (int b = 0; b < 2; ++b)
#pragma unroll
                for (int m = 0; m < 4; ++m)
#pragma unroll
                    for (int n = 0; n < 2; ++n) acc[a][b][m][n] = (f32x4){0.f, 0.f, 0.f, 0.f};
        cur = nxt; cA = nA; cB = nB; ++ui;
        if constexpr (ALIGN_EPI) { if (wr == 1) PG8_BAR; }
    }
    PG8_WAIT_V(0);
    if constexpr (!ALIGN_EPI) { if (wr == 0) PG8_BAR; }
    PG8_BAR;
#undef PG8_AOFF
#undef PG8_SA
#undef PG8_SB
#undef PG8_STAGE
#undef PG8_LDA
#undef PG8_LDB
#undef PG8_MMA
#undef PG8_WAIT_V
#undef PG8_WAIT_L
#undef PG8_BAR
#undef PG8_SCHED
}
}

constexpr int NWAVES = 8, NTHR = 512;
constexpr int LDS_BYTES = 163840;
struct Args {
    const float* in[27]; float* out; unsigned char* ws; int ph_lo, ph_hi;
};
struct Frame {
    LAS unsigned char* lds; int tid, lane, wave, vcu, G;
};
constexpr int PTRS_OFF = LDS_BYTES - 256;
__device__ __forceinline__ const float* inp(LAS unsigned char* lds, int i) { return *(const float* LAS*)(lds + PTRS_OFF + i * 8); }
__device__ __forceinline__ float gld(const float* p) { return *(const GAS float*)p; }
__device__ __forceinline__ int seq_row0(int q) { return q == 0 ? 0 : SP + (q - 1) * SS; }
__device__ __forceinline__ int seq_len(int q) { return q == 0 ? SP : SS; }

__device__ __forceinline__ void p0_transpose_item(const float* W, int K, int N, bf16_t* WT, const float* kscale, LAS float* scr, int item, int lane) {
    const int nblk = N / 32, kb = item / nblk, nb = item % nblk, k0 = 64 * kb, n0 = 32 * nb;
    {
        float v[32];
#pragma unroll
        for (int i = 0; i < 32; ++i) { const int kk = 2 * i + (lane >> 5); v[i] = W[(size_t)(k0 + kk) * N + n0 + (lane & 31)]; }
        if (kscale) {
#pragma unroll
            for (int i = 0; i < 32; ++i) v[i] *= kscale[k0 + 2 * i + (lane >> 5)]; }
#pragma unroll
        for (int i = 0; i < 32; ++i) scr[(2 * i + (lane >> 5)) * 33 + (lane & 31)] = v[i];
    }
    LDS_WAIT(); asm volatile("" ::: "memory");
    const int c = lane & 7;
#pragma unroll
    for (int j = 0; j < 4; ++j) { const int n = (lane >> 3) + 8 * j; const LAS float* s = scr + (8 * c) * 33 + n;
        u32x4 o; o.x = cvt_pk_bf16(s[0 * 33], s[1 * 33]); o.y = cvt_pk_bf16(s[2 * 33], s[3 * 33]); o.z = cvt_pk_bf16(s[4 * 33], s[5 * 33]); o.w = cvt_pk_bf16(s[6 * 33], s[7 * 33]);
        *(u32x4*)(WT + (size_t)(n0 + n) * K + k0 + 8 * c) = o; }
    LDS_WAIT(); asm volatile("" ::: "memory");
}
__device__ __forceinline__ void p0_prologue(const Frame& F, const Args& a) {
    LAS float* scr = (LAS float*)(F.lds + F.wave * 16384);
    const int gw = F.vcu * NWAVES + F.wave, NGW = F.G * NWAVES;
    unsigned char* ws = a.ws;
    constexpr int I_IN = (DM / 64) * (ZP / 32), I_O = (DM / 64) * (DM / 32), I_1 = (DM / 64) * (DFF / 32), I_2 = (DFF / 64) * (DM / 32);
    for (int it = gw; it < I_IN + I_O + I_1 + I_2; it += NGW) {
        int r = it;
        if (r < I_IN) { p0_transpose_item(a.in[3], DM, ZP, (bf16_t*)(ws + WS_WIN), nullptr, scr, r, F.lane); continue; } r -= I_IN;
        if (r < I_O) { p0_transpose_item(a.in[23], DM, DM, (bf16_t*)(ws + WS_WOUT), nullptr, scr, r, F.lane); continue; } r -= I_O;
        if (r < I_1) { p0_transpose_item(a.in[25], DM, DFF, (bf16_t*)(ws + WS_W1), a.in[24], scr, r, F.lane); continue; } r -= I_1;
        p0_transpose_item(a.in[26], DFF, DM, (bf16_t*)(ws + WS_W2), nullptr, scr, r, F.lane);
    }
    bf16_t* XN = (bf16_t*)a.out; const float* g1 = a.in[2];
    for (int m = gw; m < MTOK; m += 4 * NGW) {
        f32x4 v[4][4]; float ss[4];
#pragma unroll
        for (int r = 0; r < 4; ++r) { int mr = m + r * NGW; mr = mr < MTOK ? mr : MTOK - 1;
            const float* xrow = mr < SP ? a.in[0] + (size_t)mr * DM : a.in[1] + (size_t)(mr - SP) * DM;
#pragma unroll
            for (int j = 0; j < 4; ++j) v[r][j] = ((const f32x4*)xrow)[F.lane + 64 * j]; }
#pragma unroll
        for (int r = 0; r < 4; ++r) { float s0 = 0.f;
#pragma unroll
            for (int j = 0; j < 4; ++j) s0 += (v[r][j][0] * v[r][j][0] + v[r][j][1] * v[r][j][1]) + (v[r][j][2] * v[r][j][2] + v[r][j][3] * v[r][j][3]);
            ss[r] = __builtin_amdgcn_rsqf(wave_sum_dpp(s0) * (1.f / DM) + NORM_EPS); }
#pragma unroll
        for (int j = 0; j < 4; ++j) { const f32x4 gv = ((const f32x4*)g1)[F.lane + 64 * j];
#pragma unroll
            for (int r = 0; r < 4; ++r) { const int mr = m + r * NGW;
                if (mr < MTOK) { u32x2 w; w.x = cvt_pk_bf16(v[r][j][0] * ss[r] * gv[0], v[r][j][1] * ss[r] * gv[1]); w.y = cvt_pk_bf16(v[r][j][2] * ss[r] * gv[2], v[r][j][3] * ss[r] * gv[3]);
                    ((u32x2*)(XN + (size_t)mr * DM))[F.lane + 64 * j] = w; } } }
    }
    const int gt = F.vcu * NTHR + F.tid, NGT = F.G * NTHR;
    float* rope = (float*)(ws + WS_ROPE);
    for (int e = gt; e < SP * 32; e += NGT) { const int pos = e >> 5, i = e & 31;
        const float invf = 1.0f / powf(10000.0f, (float)(2 * i) / 64.0f); const float ang = (float)pos * invf; float sn, cs; sincosf(ang, &sn, &cs);
        rope[2 * e] = cs; rope[2 * e + 1] = sn; }
    bf16_t* wupT = (bf16_t*)(ws + WS_LORA); bf16_t* aupT = wupT + 2 * 512 * 64; bf16_t* gupT = aupT + 2 * 512 * 64;
    for (int e = gt; e < 2 * 512 * 64; e += NGT) { const int d = e >> 15, c = (e >> 6) & 511, r = e & 63;
        wupT[e] = f2bf(a.in[14][((size_t)d * 64 + r) * 512 + c]); aupT[e] = f2bf(a.in[16][((size_t)d * 64 + r) * 512 + c]); }
    for (int e = gt; e < 512 * 128; e += NGT) { const int c = e >> 7, r = e & 127; gupT[e] = f2bf(a.in[17][(size_t)r * 512 + c]); }
}

__device__ __forceinline__ void qk_prep(const Frame& F, const Args& a) {
    const int gw = F.vcu * NWAVES + F.wave, NGW = F.G * NWAVES;
    bf16_t* Z = (bf16_t*)(a.ws + WS_Z); const float* rope = (const float*)(a.ws + WS_ROPE);
    const int g = F.lane >> 2, qd = F.lane & 3;
    const float* gain = (g < 8) ? a.in[4] : a.in[5];
    float glo[8], ghi[8];
#pragma unroll
    for (int j = 0; j < 8; ++j) { glo[j] = gain[8 * qd + j]; ghi[j] = gain[32 + 8 * qd + j]; }
    const float osc = (g < 8) ? QSCALE : 1.0f;
    const float mpw = a.in[11][ZWD - ZRR + F.lane], mnw = a.in[12][ZWD - ZRR + F.lane], mpa = a.in[11][ZAD - ZRR + F.lane], mna = a.in[12][ZAD - ZRR + F.lane];
    for (int blk = gw; blk < MTOK / 16; blk += NGW) {
        const int m0 = blk * 16;
        const int pos0 = m0 < SP ? m0 : ((m0 - SP) & (SS - 1)); const int S = m0 < SP ? SP : SS;
        {
            float zw[18], za[18]; const bf16_t* zr = Z + (size_t)m0 * ZP; const int j = F.lane;
#pragma unroll
            for (int i = 0; i < 18; ++i) { const int pp = pos0 - 1 + i; const bool ok = pp >= 0 && pp < S; const long ro = (long)(ok ? i - 1 : 0) * ZP;
                const float w_ = bf2f(zr[ro + ZWD + j]), a_ = bf2f(zr[ro + ZAD + j]); zw[i] = ok ? w_ : 0.f; za[i] = ok ? a_ : 0.f; }
            bf16_t* e1 = (bf16_t*)(a.ws + WS_E1) + (size_t)m0 * 128;
#pragma unroll
            for (int i = 0; i < 16; ++i) { const float wc = zw[i + 1], ac = za[i + 1];
                const float ws_ = wc + mpw * (zw[i] - wc) + mnw * (zw[i + 2] - wc), as_ = ac + mpa * (za[i] - ac) + mna * (za[i + 2] - ac);
                e1[i * 128 + j] = f2bf(1.0f - 2.0f * __builtin_amdgcn_rcpf(__expf(2.0f * ws_) + 1.0f)); e1[i * 128 + 64 + j] = f2bf(as_); }
        }
#pragma unroll 4
        for (int i = 0; i < 16; ++i) {
            const int m = m0 + i, pos = pos0 + i;
            bf16_t* p = Z + (size_t)m * ZP + g * 64 + 8 * qd;
            const u32x4 lo4 = *(const u32x4*)p, hi4 = *(const u32x4*)(p + 32);
            float lo[8], hi[8];
#pragma unroll
            for (int j = 0; j < 4; ++j) { lo[2 * j] = bflo(lo4[j]); lo[2 * j + 1] = bfhi(lo4[j]); hi[2 * j] = bflo(hi4[j]); hi[2 * j + 1] = bfhi(hi4[j]); }
            float ss = 0.f;
#pragma unroll
            for (int j = 0; j < 8; ++j) ss += lo[j] * lo[j] + hi[j] * hi[j];
            ss += __shfl_xor(ss, 1); ss += __shfl_xor(ss, 2);
            const float rstd = __builtin_amdgcn_rsqf(ss * (1.f / 64.f) + NORM_EPS);
            const f32x4* rp = (const f32x4*)(rope + ((size_t)pos * 32 + 8 * qd) * 2);
            float ol[8], oh[8];
#pragma unroll
            for (int j2 = 0; j2 < 4; ++j2) { const f32x4 cs = rp[j2];
#pragma unroll
                for (int e = 0; e < 2; ++e) { const int j = 2 * j2 + e; const float c = cs[2 * e], sn = cs[2 * e + 1]; const float l = lo[j] * rstd * glo[j], h = hi[j] * rstd * ghi[j];
                    ol[j] = (l * c - h * sn) * osc; oh[j] = (h * c + l * sn) * osc; } }
            u32x4 wl, wh;
#pragma unroll
            for (int j = 0; j < 4; ++j) { wl[j] = cvt_pk_bf16(ol[2 * j], ol[2 * j + 1]); wh[j] = cvt_pk_bf16(oh[2 * j], oh[2 * j + 1]); }
            *(u32x4*)p = wl; *(u32x4*)(p + 32) = wh;
        }
    }
}

namespace att {
constexpr int KSLOT = 8192, VSLOT = 16384, NKS = 4, NVS = 3;
constexpr int L_K = 0, L_V = NKS * KSLOT, L_WS = L_V + NVS * VSLOT, L_ST = L_WS + NWAVES * 256, L_END = L_ST + NWAVES * 8192;
static_assert(L_END <= PTRS_OFF, "attention lds");
__device__ __forceinline__ int crow(int r, int hi) { return (r & 3) + 8 * (r >> 2) + 4 * hi; }
__device__ __forceinline__ void glds16(const void* gsrc, unsigned lds_dst) { unsigned keep;
    asm volatile("s_mov_b32 %0, m0\n\ts_mov_b32 m0, %2\n\ts_nop 0\n\tglobal_load_lds_dwordx4 %1, off\n\ts_mov_b32 m0, %0" : "=&s"(keep) : "v"(gsrc), "s"(lds_dst) : "memory"); }
typedef short v4i16_t __attribute__((ext_vector_type(4)));
typedef const LAS char* lds_cptr;
__device__ __forceinline__ s16x4 vtr(lds_cptr p) { return __builtin_bit_cast(s16x4, __builtin_amdgcn_ds_read_tr16_b64_v4i16((LAS v4i16_t*)p)); }
#define SBAR() __builtin_amdgcn_sched_barrier(0)
#define WAIT_BAR(N) asm volatile("s_waitcnt vmcnt(" #N ") lgkmcnt(0)\n\ts_barrier" ::: "memory")
__device__ __forceinline__ void kload8(bf16x8* kf, lds_cptr kp) {
    kf[0] = *(const LAS bf16x8*)(kp);        kf[1] = *(const LAS bf16x8*)(kp + 512);
    kf[2] = *(const LAS bf16x8*)(kp + 2048); kf[3] = *(const LAS bf16x8*)(kp + 2560);
    kf[4] = *(const LAS bf16x8*)(kp + 4096); kf[5] = *(const LAS bf16x8*)(kp + 4608);
    kf[6] = *(const LAS bf16x8*)(kp + 6144); kf[7] = *(const LAS bf16x8*)(kp + 6656);
}
__device__ __forceinline__ void kload2(bf16x8* kf, lds_cptr kp, int j) { kf[2 * j] = *(const LAS bf16x8*)(kp + j * 2048); kf[2 * j + 1] = *(const LAS bf16x8*)(kp + j * 2048 + 512); }

__device__ __forceinline__ void attn_unit(int row0, int S, int h, int qb, bf16_t* Z, LAS unsigned char* shm, float lam, const float* subln_g, bf16_t* Ob, int opitch) {
    int tid_ = threadIdx.x; asm volatile("" : "+v"(tid_));
    const int tid = tid_, lane = tid & 63, r32 = lane & 31, hi = lane >> 5; const int wid = __builtin_amdgcn_readfirstlane(tid >> 6);
    const unsigned lds0 = (unsigned)(uintptr_t)shm;
    LAS float* wsf = (LAS float*)(shm + L_WS) + wid * 64;
    LAS bf16_t* stash = (LAS bf16_t*)(shm + L_ST) + wid * 4096;
    const int NT = S / 64;
    const size_t qrow = (size_t)(row0 + qb * 256 + wid * 32);
    const lds_cptr shm3 = (lds_cptr)shm;
    const lds_cptr kp0 = shm3 + L_K + hi * 1024 + r32 * 16;
    const lds_cptr vp0 = shm3 + L_V + ((lane >> 4) & 1) * 32 + (lane & 3) * 8 + (4 * hi + ((lane & 15) >> 2)) * 64;
    f32x16 o[4];
#pragma unroll 1
    for (int c = 0; c < 2; ++c) {
        const bf16_t* Qw = Z + qrow * ZP + ZQ + h * 128 + c * 64;
        const bf16_t* Kh = Z + (size_t)row0 * ZP + ZK + h * 128 + c * 64;
        const bf16_t* Vh = Z + (size_t)row0 * ZP + ZV + h * 128;
        const int p0 = 2 * wid, p1 = 2 * wid + 1;
        const unsigned koff = (unsigned)(lane * ZP + wid * 8) * 2u;
        const unsigned voff0 = (unsigned)((16 * (p0 & 3) + (lane >> 2)) * ZP + (p0 >> 2) * 32 + (lane & 3) * 8) * 2u;
        const unsigned voff1 = (unsigned)((16 * (p1 & 3) + (lane >> 2)) * ZP + (p1 >> 2) * 32 + (lane & 3) * 8) * 2u;
        const unsigned kdst = lds0 + L_K + wid * 1024, vdst0 = lds0 + L_V + p0 * 1024, vdst1 = lds0 + L_V + p1 * 1024;
#define DMA_K(t, si) glds16((const char*)(Kh + (size_t)(t) * 64 * ZP) + koff, (unsigned)__builtin_amdgcn_readfirstlane(kdst + (si) * KSLOT))
#define DMA_V(t, si) do { const char* vb_ = (const char*)(Vh + (size_t)(t) * 64 * ZP); glds16(vb_ + voff0, (unsigned)__builtin_amdgcn_readfirstlane(vdst0 + (si) * VSLOT)); glds16(vb_ + voff1, (unsigned)__builtin_amdgcn_readfirstlane(vdst1 + (si) * VSLOT)); } while (0)
        DMA_K(0, 0); DMA_V(0, 0); DMA_K(1, 1);
        bf16x8 qr[4];
#pragma unroll
        for (int d0 = 0; d0 < 4; ++d0) qr[d0] = *(const bf16x8*)(Qw + (size_t)r32 * ZP + d0 * 16 + hi * 8);
#pragma unroll
        for (int d0 = 0; d0 < 4; ++d0) o[d0] = f32x16{};
        float l_reg = 0.f;
        bf16x8 kf[4];
        f32x16 pA0, pA1, pB0, pB1;
        int i_prev = 0, i_cur = 0, i_next = 1;
        int k_cur = 0, k_next = 1;
#define ROT() do { i_prev = i_cur; i_cur = i_next; i_next = (i_next == NVS - 1) ? 0 : i_next + 1; k_cur = k_next; k_next = (k_next + 1) & 3; } while (0)
#define KFRAG(slot, i) (*(const LAS bf16x8*)(kp0 + (slot) * KSLOT + ((i) >> 1) * 2048 + ((i) & 1) * 512))
        DMA_K(2, 2);
        WAIT_BAR(4);
        {
            const lds_cptr kb = kp0;
            pA0 = f32x16{}; pA1 = f32x16{};
#pragma unroll
            for (int d0 = 0; d0 < 4; ++d0) { const bf16x8 b0 = *(const LAS bf16x8*)(kb + d0 * 2048), b1 = *(const LAS bf16x8*)(kb + d0 * 2048 + 512);
                pA0 = __builtin_amdgcn_mfma_f32_32x32x16_bf16(b0, qr[d0], pA0, 0, 0, 0); pA1 = __builtin_amdgcn_mfma_f32_32x32x16_bf16(b1, qr[d0], pA1, 0, 0, 0); }
#pragma unroll
            for (int r = 0; r < 16; ++r) { pA0[r] = __builtin_amdgcn_exp2f(pA0[r]); pA1[r] = __builtin_amdgcn_exp2f(pA1[r]); }
        }
        WAIT_BAR(0);
        DMA_K(3, 3); DMA_V(1, 1);
        ROT();
        kf[0] = KFRAG(k_cur, 0); kf[1] = KFRAG(k_cur, 1); kf[2] = KFRAG(k_cur, 2); kf[3] = KFRAG(k_cur, 3);
        WAIT_BAR(3);
        s16x4 vlo[4], vhi[4]; u32x4 pw0, pw1, pw2, pw3;
#define PKW(P, B) cvt_pk_bf16(P[B], P[B + 1])
#define PAF(k) __builtin_bit_cast(bf16x8, pw##k)
#define VFR(i) (bf16x8){vlo[i][0], vlo[i][1], vlo[i][2], vlo[i][3], vhi[i][0], vhi[i][1], vhi[i][2], vhi[i][3]}
#define PIN(x) asm volatile("" : "+v"(x))
#define EX(v) __builtin_amdgcn_exp2f(v)
#define VRD(slot, f) do { vlo[slot] = vtr(vp_ + (((f) & 3) * 4096 + ((f) >> 2) * 1024)); vhi[slot] = vtr(vp_ + (((f) & 3) * 4096 + ((f) >> 2) * 1024 + 512)); } while (0)
#define GAPA(MF, LDX, A0, A1, A2, A3, W0, W1, PW) do { MF; LDX; sacc += A0; sacc += A1; sacc += A2; sacc += A3; PIN(sacc); W0; W1; PIN(PW); SBAR(); } while (0)
#define GAPB(MF, LDX, X, B) do { MF; LDX; X[B] = EX(X[B]); X[B + 1] = EX(X[B + 1]); PIN(X); SBAR(); } while (0)
#define PVM(f) o[(f) & 3] = __builtin_amdgcn_mfma_f32_32x32x16_bf16(__builtin_bit_cast(bf16x8, (f) < 4 ? pw0 : (f) < 8 ? pw1 : (f) < 12 ? pw2 : pw3), VFR((f) & 3), o[(f) & 3], 0, 0, 0)
#define NOP_ do { } while (0)
#if PROBE_ATT
#define ATT_T(k) do { if (PROBE_ATT == (k)) { const unsigned long long n_ = __builtin_amdgcn_s_memrealtime(); if (tid == 0) *(LAS unsigned long long*)(shm + PTRS_OFF - 64) += n_ - att_t0; } } while (0)
#define ATT_T0() const unsigned long long att_t0 = __builtin_amdgcn_s_memrealtime()
#else
#define ATT_T(k) do { } while (0)
#define ATT_T0() do { } while (0)
#endif
#define STEP(C0, C1, P0, P1, t, GK, GV, GL) do { SBAR(); \
        const lds_cptr vp_ = vp0 + i_prev * VSLOT; \
        float sacc = (P0[0] + P0[1]); \
        GAPA(C0 = __builtin_amdgcn_mfma_f32_32x32x16_bf16(kf[0], qr[0], (f32x16){}, 0, 0, 0), kf[0] = KFRAG(k_cur, 4), P0[2], P0[3], P0[4], P0[5],     pw0[0] = PKW(P0, 0), pw0[1] = PKW(P0, 2), pw0); \
        GAPA(C1 = __builtin_amdgcn_mfma_f32_32x32x16_bf16(kf[1], qr[0], (f32x16){}, 0, 0, 0), kf[1] = KFRAG(k_cur, 5), P0[6], P0[7], P0[8], P0[9],     pw0[2] = PKW(P0, 4), pw0[3] = PKW(P0, 6), pw0); \
        GAPA(C0 = __builtin_amdgcn_mfma_f32_32x32x16_bf16(kf[2], qr[1], C0, 0, 0, 0),         kf[2] = KFRAG(k_cur, 6), P0[10], P0[11], P0[12], P0[13], pw1[0] = PKW(P0, 8), pw1[1] = PKW(P0, 10), pw1); \
        GAPA(C1 = __builtin_amdgcn_mfma_f32_32x32x16_bf16(kf[3], qr[1], C1, 0, 0, 0),         kf[3] = KFRAG(k_cur, 7), P0[14], P0[15], P1[0], P1[1],   pw1[2] = PKW(P0, 12), pw1[3] = PKW(P0, 14), pw1); \
        GAPA(C0 = __builtin_amdgcn_mfma_f32_32x32x16_bf16(kf[0], qr[2], C0, 0, 0, 0),         VRD(0, 0), P1[2], P1[3], P1[4], P1[5],     pw2[0] = PKW(P1, 0), pw2[1] = PKW(P1, 2), pw2); \
        GAPA(C1 = __builtin_amdgcn_mfma_f32_32x32x16_bf16(kf[1], qr[2], C1, 0, 0, 0),         VRD(1, 1), P1[6], P1[7], P1[8], P1[9],     pw2[2] = PKW(P1, 4), pw2[3] = PKW(P1, 6), pw2); \
        GAPA(C0 = __builtin_amdgcn_mfma_f32_32x32x16_bf16(kf[2], qr[3], C0, 0, 0, 0),         VRD(2, 2), P1[10], P1[11], P1[12], P1[13], pw3[0] = PKW(P1, 8), pw3[1] = PKW(P1, 10), pw3); \
        GAPA(C1 = __builtin_amdgcn_mfma_f32_32x32x16_bf16(kf[3], qr[3], C1, 0, 0, 0),         VRD(3, 3), P1[14], P1[15], 0.f, 0.f,       pw3[2] = PKW(P1, 12), pw3[3] = PKW(P1, 14), pw3); \
        l_reg += sacc; \
        if (GK) { DMA_K((t) + 3, (k_cur + 3) & 3); } if (GV) { DMA_V((t) + 1, i_next); } \
        SBAR(); \
        GAPB(PVM(0), VRD(0, 4), C0, 0);   GAPB(PVM(1), VRD(1, 5), C0, 2);   GAPB(PVM(2), VRD(2, 6), C0, 4);    GAPB(PVM(3), VRD(3, 7), C0, 6); \
        GAPB(PVM(4), VRD(0, 8), C0, 8);   GAPB(PVM(5), VRD(1, 9), C0, 10);  GAPB(PVM(6), VRD(2, 10), C0, 12);  GAPB(PVM(7), VRD(3, 11), C0, 14); \
        GAPB(PVM(8), VRD(0, 12), C1, 0);  GAPB(PVM(9), VRD(1, 13), C1, 2);  GAPB(PVM(10), VRD(2, 14), C1, 4);  GAPB(PVM(11), VRD(3, 15), C1, 6); \
        GAPB(PVM(12), if (GL) kf[0] = KFRAG(k_next, 0), C1, 8);  GAPB(PVM(13), if (GL) kf[1] = KFRAG(k_next, 1), C1, 10); \
        GAPB(PVM(14), if (GL) kf[2] = KFRAG(k_next, 2), C1, 12); GAPB(PVM(15), if (GL) kf[3] = KFRAG(k_next, 3), C1, 14); \
        } while (0)
        int t = 1;
#pragma unroll 1
        for (; t + 5 < NT; t += 2) {
#if PROBE_ATT == 1
            STEP(pB0, pB1, pA0, pA1, t, true, true, true);     { ATT_T0(); WAIT_BAR(3); ATT_T(1); } ROT();
            STEP(pA0, pA1, pB0, pB1, t + 1, true, true, true); { ATT_T0(); WAIT_BAR(3); ATT_T(1); } ROT();
#elif PROBE_ATT >= 2
            { ATT_T0(); STEP(pB0, pB1, pA0, pA1, t, true, true, true); ATT_T(2); }    WAIT_BAR(3); ROT();
            { ATT_T0(); STEP(pA0, pA1, pB0, pB1, t + 1, true, true, true); ATT_T(2); } WAIT_BAR(3); ROT();
#else
            STEP(pB0, pB1, pA0, pA1, t, true, true, true);     WAIT_BAR(3); ROT();
            STEP(pA0, pA1, pB0, pB1, t + 1, true, true, true); WAIT_BAR(3); ROT();
#endif
        }
#define ENDW(tt) do { if ((tt) + 3 < NT) { WAIT_BAR(3); } else if ((tt) + 2 < NT) { WAIT_BAR(2); } else { WAIT_BAR(0); } } while (0)
#pragma unroll 1
        for (; t + 1 < NT; t += 2) {
            STEP(pB0, pB1, pA0, pA1, t, (t + 3 < NT), (t + 1 < NT), (t + 1 < NT));         ENDW(t);     ROT();
            STEP(pA0, pA1, pB0, pB1, t + 1, (t + 4 < NT), (t + 2 < NT), (t + 2 < NT));     ENDW(t + 1); ROT();
        }
        STEP(pB0, pB1, pA0, pA1, NT - 1, false, false, false);
        {
            float sacc = pB0[0] + pB0[1];
#pragma unroll
            for (int r = 2; r < 16; ++r) sacc += pB0[r];
#pragma unroll
            for (int r = 0; r < 16; ++r) sacc += pB1[r];
            l_reg += sacc;
            pw0 = (u32x4){PKW(pB0, 0), PKW(pB0, 2), PKW(pB0, 4), PKW(pB0, 6)}; pw1 = (u32x4){PKW(pB0, 8), PKW(pB0, 10), PKW(pB0, 12), PKW(pB0, 14)};
            pw2 = (u32x4){PKW(pB1, 0), PKW(pB1, 2), PKW(pB1, 4), PKW(pB1, 6)}; pw3 = (u32x4){PKW(pB1, 8), PKW(pB1, 10), PKW(pB1, 12), PKW(pB1, 14)};
            const lds_cptr vp_ = vp0 + i_cur * VSLOT;
            VRD(0, 0); VRD(1, 1); VRD(2, 2); VRD(3, 3); PVM(0); PVM(1); PVM(2); PVM(3);
            VRD(0, 4); VRD(1, 5); VRD(2, 6); VRD(3, 7); PVM(4); PVM(5); PVM(6); PVM(7);
            VRD(0, 8); VRD(1, 9); VRD(2, 10); VRD(3, 11); PVM(8); PVM(9); PVM(10); PVM(11);
            VRD(0, 12); VRD(1, 13); VRD(2, 14); VRD(3, 15); PVM(12); PVM(13); PVM(14); PVM(15);
        }
#undef DMA_K
#undef DMA_V
#undef ROT
#undef PKW
#undef PAF
#undef VFR
#undef PIN
#undef EX
#undef VRD
#undef GAPA
#undef GAPB
#undef KFRAG
#undef NOP_
#undef PVM
#undef STEP
#undef ENDW
        { auto rr = __builtin_amdgcn_permlane32_swap(__float_as_uint(l_reg), __float_as_uint(l_reg), false, false); l_reg = __uint_as_float(rr[0]) + __uint_as_float(rr[1]); }
        if (hi == 0) wsf[r32] = l_reg;
        LDS_WAIT();
        float rli[16];
#pragma unroll
        for (int r = 0; r < 16; ++r) rli[r] = 1.0f / wsf[crow(r, hi)];
        if (c == 0) {
#pragma unroll
            for (int d0 = 0; d0 < 4; ++d0)
#pragma unroll
                for (int r = 0; r < 16; ++r) stash[(d0 * 16 + r) * 64 + lane] = f2bf(o[d0][r] * rli[r]);
            LDS_WAIT();
        } else {
#pragma unroll
            for (int d0 = 0; d0 < 4; ++d0)
#pragma unroll
                for (int r = 0; r < 16; ++r) o[d0][r] = bf2f(stash[(d0 * 16 + r) * 64 + lane]) - lam * (o[d0][r] * rli[r]);
            LDS_WAIT(); asm volatile("" ::: "memory");
#pragma unroll
            for (int d0 = 0; d0 < 4; ++d0)
#pragma unroll
                for (int r = 0; r < 16; ++r) stash[crow(r, hi) * 128 + d0 * 32 + r32] = f2bf(o[d0][r]);
            LDS_WAIT(); asm volatile("" ::: "memory");
            bf16_t* Ow = Ob + qrow * opitch + ZQ + h * 128;
#pragma unroll
            for (int i = 0; i < 4; ++i) { const int row = i * 8 + (lane >> 3), ch = lane & 7;
                const u32x4 w0 = *(const LAS u32x4*)(stash + row * 128 + ch * 16), w1 = *(const LAS u32x4*)(stash + row * 128 + ch * 16 + 8);
                float v[16];
#pragma unroll
                for (int j = 0; j < 4; ++j) { v[2 * j] = bflo(w0[j]); v[2 * j + 1] = bfhi(w0[j]); v[8 + 2 * j] = bflo(w1[j]); v[9 + 2 * j] = bfhi(w1[j]); }
                float ss = 0.f;
#pragma unroll
                for (int j = 0; j < 16; ++j) ss += v[j] * v[j];
                ss += __shfl_xor(ss, 1); ss += __shfl_xor(ss, 2); ss += __shfl_xor(ss, 4);
                const float rs = (1.0f - LAMBDA_INIT) / sqrtf(ss * (1.f / 128.f) + NORM_EPS);
                u32x4 x0, x1;
#pragma unroll
                for (int j = 0; j < 4; ++j) { x0[j] = cvt_pk_bf16(v[2 * j] * rs * subln_g[ch * 16 + 2 * j], v[2 * j + 1] * rs * subln_g[ch * 16 + 2 * j + 1]);
                                              x1[j] = cvt_pk_bf16(v[8 + 2 * j] * rs * subln_g[ch * 16 + 8 + 2 * j], v[9 + 2 * j] * rs * subln_g[ch * 16 + 9 + 2 * j]); }
                *(u32x4*)(Ow + (size_t)row * opitch + ch * 16) = x0; *(u32x4*)(Ow + (size_t)row * opitch + ch * 16 + 8) = x1; }
            LDS_WAIT();
        }
        asm volatile("s_waitcnt vmcnt(0) lgkmcnt(0)\n\ts_barrier" ::: "memory");
    }
}
#undef SBAR
#undef WAIT_BAR
}

namespace rw {
constexpr int P = 144, MAT = 64 * P;
constexpr int O_AT = 0, O_BT = MAT, O_KT = 2 * MAT, O_RT = 3 * MAT, O_ATT = 4 * MAT, O_VT = 5 * MAT, O_BHT = 6 * MAT, O_KHT = 7 * MAT;
constexpr int O_LAB = 8 * MAT, O_LAK = 9 * MAT, O_ARB = 10 * MAT, O_ARK = 11 * MAT, O_XT = 12 * MAT, O_ABT = 13 * MAT, O_U0T = 14 * MAT;
constexpr int O_LABD = 15 * MAT, O_TII = O_LABD + 4096, O_WC = O_TII + 2048, O_GSUM = O_WC + 256, O_PAR = O_GSUM + 2048, O_END = O_PAR + 960 * 4;
constexpr int O_ZS = 0, PZ = 128;
static_assert(3 * 66 * PZ <= 3 * MAT, "ZS fits At|Bt|Kt");
constexpr int O_TW = O_LAB, O_ADN = O_LAK, O_WL = O_ARB, O_AR = O_XT, PF = 272;
static_assert(O_END <= PTRS_OFF - 64 && 64 * PF <= 2 * MAT, "rwkv lds");
__device__ __forceinline__ int crow(int r, int hi) { return (r & 3) + 8 * (r >> 2) + 4 * hi; }
__device__ __forceinline__ float sigmoidf_(float x) { return __builtin_amdgcn_rcpf(1.0f + __expf(-x)); }
__device__ __forceinline__ float tanhf_(float x) { return 1.0f - 2.0f * __builtin_amdgcn_rcpf(__expf(2.0f * x) + 1.0f); }
__device__ __forceinline__ void load10(const bf16_t* zc, int t_lo, int S, float (&z)[10]) {
#pragma unroll
    for (int i = 0; i < 10; ++i) { const int t = t_lo - 1 + i; z[i] = (t >= 0 && t < S) ? bf2f(zc[(size_t)t * ZP]) : 0.f; }
}
__device__ __forceinline__ float tshift(const float (&z)[10], int u, float mp, float mn) { const float c = z[u + 1]; return c + mp * (z[u] - c) + mn * (z[u + 2] - c); }
__device__ __forceinline__ f32x16 mm_ll(const LAS unsigned char* A, int rowA, const LAS unsigned char* B, int rowB, f32x16 acc, int r32, int hi) {
#pragma unroll
    for (int ks = 0; ks < 4; ++ks) { const bf16x8 a = *(const LAS bf16x8*)(A + (rowA + r32) * P + (16 * ks + 8 * hi) * 2), b = *(const LAS bf16x8*)(B + (rowB + r32) * P + (16 * ks + 8 * hi) * 2);
        acc = __builtin_amdgcn_mfma_f32_32x32x16_bf16(a, b, acc, 0, 0, 0); }
    return acc;
}
__device__ __forceinline__ void store_native(unsigned char* dst, const f32x16& acc, int lane, bool wt) {
    u32x4 w0, w1;
#pragma unroll
    for (int q = 0; q < 4; ++q) { w0[q] = cvt_pk_bf16(acc[2 * q], acc[2 * q + 1]); w1[q] = cvt_pk_bf16(acc[8 + 2 * q], acc[9 + 2 * q]); }
    if (wt) {
        asm volatile("global_store_dwordx4 %0, %1, off sc1\n\tglobal_store_dwordx4 %0, %2, off offset:16 sc1\n\ts_nop 1" :: "v"(dst + lane * 32), "v"(w0), "v"(w1) : "memory");
    } else { *(u32x4*)(dst + lane * 32) = w0; *(u32x4*)(dst + lane * 32 + 16) = w1; }
}
__device__ __forceinline__ void st4(LAS unsigned char* p, float a, float b, float c, float d) { u32x2 w; w.x = cvt_pk_bf16(a, b); w.y = cvt_pk_bf16(c, d); *(LAS u32x2*)p = w; }

__device__ __forceinline__ f32x2_t s1_param_load(LAS unsigned char* L, int tid, int d, int h) {
    const int sg = tid >> 5, seg = sg < 15 ? sg : 14, off = (tid & 31) * 2;
    const int ti = seg < 10 ? 11 + (seg & 1) : (seg == 10 ? 13 : (seg == 11 ? 15 : 6 + seg));
    const int eo = seg < 6 ? (seg >> 1) * 512 + h * 64 : (seg < 8 ? ZWD - ZRR : (seg < 10 ? ZAD - ZRR : (seg < 12 ? d * 512 + h * 64 : h * 64)));
    const float* src = *(const float* LAS*)(L + PTRS_OFF + ti * 8) + eo + off;
    return *(const GAS f32x2_t*)src;
}
__device__ __forceinline__ void s1_stage_load(const Args& a, int tid, int q, int h, int ck, u32x4 (&v)[6]) {
    const int row0 = seq_row0(q), S = seq_len(q), t0 = ck * 64;
#pragma unroll
    for (int k = 0; k < 6; ++k) { const int c = tid + k * NTHR;
        const int seg = c >> 3, part = c & 7, grp = (seg >= 66) + (seg >= 132), row = seg - 66 * grp; int t = t0 - 1 + row; t = t < 0 ? 0 : (t >= S ? S - 1 : t);
        const int e = c - 1584 < 0 ? 0 : (c - 1584 > 1023 ? 1023 : c - 1584);
        const size_t offz = WS_Z + ((size_t)(row0 + t) * ZP + ZRR + grp * 512 + h * 64 + part * 8) * 2, offe = WS_E1 + ((size_t)(row0 + t0) * 128 + (size_t)e * 8) * 2;
        v[k] = *(const GAS u32x4*)(a.ws + (c < 1584 ? offz : offe)); }
}
__device__ __forceinline__ void s1_stage_store(LAS unsigned char* L, int tid, int d, int q, int ck, const u32x4 (&stg)[6], f32x2_t par) {
    const int S = seq_len(q), t0 = ck * 64, dummy = O_GSUM + (tid & 63) * 16;
#pragma unroll
    for (int k = 0; k < 6; ++k) { const int c = tid + k * NTHR;
        const int seg = c >> 3, grp = (seg >= 66) + (seg >= 132), row = seg - 66 * grp, t = t0 - 1 + row; const bool zok = t >= 0 && t < S;
        const int e = c - 1584, tr = (e >> 4) & 63, part = e & 15, tau = d == 0 ? tr : 63 - tr;
        const int addr = c < 1584 ? O_ZS + c * 16 : (c < 2608 ? (part < 8 ? O_TW : O_ADN) + tau * P + (part & 7) * 16 : dummy);
        const bool zero = c < 1584 && !zok;
        *(LAS u32x4*)(L + addr) = zero ? (u32x4){0u, 0u, 0u, 0u} : stg[k]; }
    *(LAS f32x2_t*)(L + (tid < 480 ? O_PAR + tid * 8 : dummy)) = par;
}
__device__ __forceinline__ void s1_item(const Frame& F, const Args& a, int d, int q, int h, int ck, unsigned char* slot, int nd, int nq, int nh, int nck, bool wt, unsigned* publish_prev) {
    LAS unsigned char* L = F.lds;
#if PROBE_S1 >= 0
    unsigned long long pt_last = 0; int pt_n = 0;
#define PST() do { if (F.tid == 0) { const unsigned long long n_ = __builtin_amdgcn_s_memrealtime(); if (pt_n == PROBE_S1 + 1) *(LAS unsigned long long*)(L + PTRS_OFF - 64) += n_ - pt_last; pt_last = n_; } ++pt_n; } while (0)
#else
#define PST() do { } while (0)
#endif
    PST();
    int lane_ = F.lane; asm volatile("" : "+v"(lane_));
    const int lane = lane_, w = F.wave, tid = w * 64 + lane, r32 = lane & 31, hi = lane >> 5;
    const int j = lane, tg = w;
    const int row0 = seq_row0(q), S = seq_len(q), t0 = ck * 64;
    const bf16_t* Zs = (const bf16_t*)(a.ws + WS_Z) + (size_t)row0 * ZP; (void)Zs; (void)S;
    const int t_lo = d == 0 ? t0 + 8 * tg : t0 + 56 - 8 * tg;
    const int tau0 = 8 * tg;
#define TAU(u) (d == 0 ? tau0 + (u) : tau0 + 7 - (u))
    const int ch = h * 64 + j; (void)ch;
    bf16x8 wfr[4];
    { const int which = w >> 2, mt = (w >> 1) & 1;
      const bf16_t* WT = (const bf16_t*)(a.ws + WS_LORA) + (which ? 2 * 512 * 64 : 0) + ((size_t)d * 512 + h * 64 + 32 * mt + r32) * 64;
#pragma unroll
      for (int ks = 0; ks < 4; ++ks) wfr[ks] = *(const bf16x8*)(WT + 16 * ks + 8 * hi); }
    u32x4 stg[6]; s1_stage_load(a, tid, nq, nh, nck, stg); const f32x2_t par = s1_param_load(L, tid, nd, nh);
#define PAR(seg, idx) (*(const LAS float*)(L + O_PAR + ((seg) * 64 + (idx)) * 4))
    const LAS unsigned char* zsb = L + O_ZS + (t_lo - t0) * PZ + j * 2;
#define LD10(z, g) do { _Pragma("unroll") for (int i_ = 0; i_ < 10; ++i_) z[i_] = bf2f(*(const LAS bf16_t*)(zsb + ((g) * 66 + i_) * PZ)); } while (0)
    {
        const int which = w >> 2, mt = (w >> 1) & 1, nt = w & 1;
        const LAS unsigned char* B = L + (which ? O_ADN : O_TW);
        f32x16 acc = f32x16{};
#pragma unroll
        for (int ks = 0; ks < 4; ++ks) { const bf16x8 bv = *(const LAS bf16x8*)(B + (32 * nt + r32) * P + (16 * ks + 8 * hi) * 2);
            acc = __builtin_amdgcn_mfma_f32_32x32x16_bf16(wfr[ks], bv, acc, 0, 0, 0); }
        LAS unsigned char* O = L + (which ? O_AR : O_WL) + (32 * nt + r32) * PF;
#pragma unroll
        for (int g = 0; g < 4; ++g) { const int jj = 8 * g + 4 * hi; const f32x4 bv = *(const LAS f32x4*)(L + O_PAR + ((10 + which) * 64 + 32 * mt + jj) * 4);
            *(LAS f32x4*)(O + (32 * mt + jj) * 4) = (f32x4){acc[4 * g] + bv[0], acc[4 * g + 1] + bv[1], acc[4 * g + 2] + bv[2], acc[4 * g + 3] + bv[3]}; }
    }
    LBAR(); PST();
    typedef f32x2_t v2;
    const int cp = lane & 31, th = lane >> 5;
    v2 aa2[4], bb2[4], rr2[4], kd2[4], vv2[4], ld2[4], tot4, oth;
#define EXP2V(a) ({ const v2 t_ = (a) * 1.4426950408889634f; (v2){__builtin_amdgcn_exp2f(t_.x), __builtin_amdgcn_exp2f(t_.y)}; })
#define SIG2V(a) ({ const v2 e_ = EXP2V(-(a)) + 1.0f; (v2){__builtin_amdgcn_rcpf(e_.x), __builtin_amdgcn_rcpf(e_.y)}; })
#define FOLD4(s_) ({ const bool b4_ = (lane >> 4) & 1, b3_ = (lane >> 3) & 1; float g_[2]; \
        _Pragma("unroll") for (int i_ = 0; i_ < 2; ++i_) { const float kp_ = b4_ ? s_[i_ + 2] : s_[i_], sd_ = b4_ ? s_[i_] : s_[i_ + 2]; g_[i_] = kp_ + __int_as_float(__builtin_amdgcn_ds_swizzle(__float_as_int(sd_), 0x401F)); } \
        const float kp2_ = b3_ ? g_[1] : g_[0], sd2_ = b3_ ? g_[0] : g_[1]; \
        float h_ = kp2_ + __int_as_float(__builtin_amdgcn_update_dpp(0, __float_as_int(sd2_), 0x128, 0xF, 0xF, true)); \
        h_ += __int_as_float(__builtin_amdgcn_update_dpp(0, __float_as_int(h_), 0x141, 0xF, 0xF, true)); \
        h_ += __int_as_float(__builtin_amdgcn_update_dpp(0, __float_as_int(h_), 0xB1, 0xF, 0xF, true)); \
        h_ += __int_as_float(__builtin_amdgcn_update_dpp(0, __float_as_int(h_), 0x4E, 0xF, 0xF, true)); h_; })
    {
        v2 zr[6], zk[6], zv[6];
        const LAS unsigned char* zb2 = L + O_ZS + ((t_lo - t0) + 4 * th) * PZ + cp * 4;
#define LDZ(z, g) do { _Pragma("unroll") for (int i_ = 0; i_ < 6; ++i_) { const unsigned w_ = *(const LAS unsigned*)(zb2 + ((g) * 66 + i_) * PZ); z[i_] = (v2){bflo(w_), bfhi(w_)}; } } while (0)
        LDZ(zr, 0); LDZ(zk, 1); LDZ(zv, 2);
#undef LDZ
#define PAR2(seg) (*(const LAS v2*)(L + O_PAR + ((seg) * 64 + 2 * cp) * 4))
        const v2 mpr = PAR2(0), mnr = PAR2(1), mpk = PAR2(2), mnk = PAR2(3), mpv = PAR2(4), mnv = PAR2(5), kkc = PAR2(12), kac = PAR2(13), rkc = PAR2(14);
#undef PAR2
        float* bon = (float*)(a.ws + WS_BONUS) + ((size_t)d * MTOK + row0) * 8 + h;
        v2 k02[4], ar2[4]; float red[4];
#pragma unroll
        for (int k = 0; k < 4; ++k) { const int tau = TAU(4 * th + k);
            const v2 wl = *(const LAS v2*)(L + O_WL + tau * PF + cp * 8), ar = *(const LAS v2*)(L + O_AR + tau * PF + cp * 8);
            ld2[k] = SIG2V(wl) * (-0.6065306597126334f); ar2[k] = SIG2V(ar);
            rr2[k] = zr[k + 1] + mpr * (zr[k] - zr[k + 1]) + mnr * (zr[k + 2] - zr[k + 1]);
            k02[k] = zk[k + 1] + mpk * (zk[k] - zk[k + 1]) + mnk * (zk[k + 2] - zk[k + 1]);
            vv2[k] = zv[k + 1] + mpv * (zv[k] - zv[k + 1]) + mnv * (zv[k + 2] - zv[k + 1]);
            aa2[k] = k02[k] * kkc; red[k] = aa2[k].x * aa2[k].x + aa2[k].y * aa2[k].y; }
        const int hs = __float_as_int(FOLD4(red));
        float ssq[4];
#pragma unroll
        for (int k = 0; k < 4; ++k) { const float lo_ = __int_as_float(__builtin_amdgcn_readlane(hs, 8 * k)), hi_ = __int_as_float(__builtin_amdgcn_readlane(hs, 32 + 8 * k)); ssq[k] = th ? hi_ : lo_; }
#pragma unroll
        for (int k = 0; k < 4; ++k) { const v2 kkn = aa2[k] * __builtin_amdgcn_rsqf(ssq[k] + 1e-12f);
            kd2[k] = k02[k] * ((ar2[k] - 1.0f) * kac + 1.0f); aa2[k] = -kkn; bb2[k] = kkn * ar2[k];
            const v2 bt = rr2[k] * kd2[k] * rkc; red[k] = bt.x + bt.y; }
        const float hb = FOLD4(red);
        if ((lane & 7) == 0) bon[(size_t)(t_lo + (lane >> 3)) * 8] = hb;
        tot4 = (ld2[0] + ld2[1]) + (ld2[2] + ld2[3]);
        { auto rx = __builtin_amdgcn_permlane32_swap(__float_as_uint(tot4.x), __float_as_uint(tot4.x), false, false), ry = __builtin_amdgcn_permlane32_swap(__float_as_uint(tot4.y), __float_as_uint(tot4.y), false, false);
          oth.x = __uint_as_float(th ? rx[0] : rx[1]); oth.y = __uint_as_float(th ? ry[0] : ry[1]); }
        if (th == 0) *(LAS v2*)(L + O_GSUM + tg * 256 + cp * 8) = tot4 + oth;
    }
    LBAR(); PST();
    {
        v2 pre = {0.f, 0.f}, cC = {0.f, 0.f};
#pragma unroll
        for (int g = 0; g < 8; ++g) { const v2 sg = *(const LAS v2*)(L + O_GSUM + g * 256 + cp * 8); cC += sg; if (g < tg) pre += sg; }
        const v2 zero2 = {0.f, 0.f};
        const v2 base = pre + ((d == 0) == (th == 1) ? oth : zero2);
        v2 At2[4], Vt2[4], Bh2[4], Kh2[4]; v2 pf = {0.f, 0.f};
#pragma unroll
        for (int k = 0; k < 4; ++k) { pf += ld2[k]; const int tau = TAU(4 * th + k);
            const v2 cl = base + (d == 0 ? pf : tot4 - pf + ld2[k]);
            const v2 e_m1 = EXP2V(cl - ld2[k]), e_p = EXP2V(cl), e_n = EXP2V(-cl), e_c = EXP2V(cC - cl);
            At2[k] = aa2[k] * e_m1; Vt2[k] = vv2[k]; Bh2[k] = bb2[k] * e_c; Kh2[k] = kd2[k] * e_c;
            const v2 rt = rr2[k] * e_p, bt = bb2[k] * e_n, kt = kd2[k] * e_n;
            *(LAS unsigned*)(L + O_AT + tau * P + cp * 4) = cvt_pk_bf16(At2[k].x, At2[k].y); *(LAS unsigned*)(L + O_RT + tau * P + cp * 4) = cvt_pk_bf16(rt.x, rt.y);
            *(LAS unsigned*)(L + O_BT + tau * P + cp * 4) = cvt_pk_bf16(bt.x, bt.y);         *(LAS unsigned*)(L + O_KT + tau * P + cp * 4) = cvt_pk_bf16(kt.x, kt.y); }
        const int tb4 = tau0 + (d == 0 ? 4 * th : 4 * (1 - th));
#define PK4(dst, X) do { u32x2 wx_, wy_; \
            wx_.x = cvt_pk_bf16(d == 0 ? X[0].x : X[3].x, d == 0 ? X[1].x : X[2].x); wx_.y = cvt_pk_bf16(d == 0 ? X[2].x : X[1].x, d == 0 ? X[3].x : X[0].x); \
            wy_.x = cvt_pk_bf16(d == 0 ? X[0].y : X[3].y, d == 0 ? X[1].y : X[2].y); wy_.y = cvt_pk_bf16(d == 0 ? X[2].y : X[1].y, d == 0 ? X[3].y : X[0].y); \
            *(LAS u32x2*)(L + (dst) + (2 * cp) * P + tb4 * 2) = wx_; *(LAS u32x2*)(L + (dst) + (2 * cp + 1) * P + tb4 * 2) = wy_; } while (0)
        PK4(O_ATT, At2); PK4(O_VT, Vt2); PK4(O_BHT, Bh2); PK4(O_KHT, Kh2);
#undef PK4
        if (tg == 0 && th == 0) *(LAS v2*)(L + O_WC + cp * 8) = EXP2V(cC);
    }
#undef FOLD4
#undef SIG2V
#undef EXP2V
    LBAR(); PST();
#pragma unroll
    for (int i = 0; i < 2; ++i) {
        const int ti = 2 * w + i, ms = ti >> 2, nl = ti & 3;
        const int sb = 32 * (ms & 1), tb = 32 * (nl & 1);
        f32x16 acc = f32x16{};
        if (sb <= tb) acc = mm_ll(L + (ms < 2 ? O_BT : O_KT), sb, L + (nl < 2 ? O_AT : O_RT), tb, acc, r32, hi);
        const int dst = ms < 2 ? (nl < 2 ? O_LAB : O_ARB) : (nl < 2 ? O_LAK : O_ARK);
        const int t = tb + r32, tlim = t + (nl >= 2 ? 1 : 0);
        const bool diagtile = (dst == O_LAB) && (sb == tb);
#pragma unroll
        for (int g = 0; g < 4; ++g) { const int s0 = sb + 8 * g + 4 * hi; float v[4];
#pragma unroll
            for (int e = 0; e < 4; ++e) v[e] = (s0 + e < tlim) ? acc[4 * g + e] : 0.f;
            st4(L + dst + t * P + s0 * 2, v[0], v[1], v[2], v[3]);
            if (diagtile) { const bool match = (g >> 1) == (r32 >> 4);
                const int off = match ? O_LABD + (((t >> 4) * 16 + (t & 15)) * 16 + (s0 & 15)) * 4 : O_GSUM + lane * 16;
                *(LAS f32x4*)(L + off) = (f32x4){v[0], v[1], v[2], v[3]}; } }
    }
    LBAR(); PST();
    if (w < 4) {
        const int mt = w >> 1, nt = w & 1; f32x16 acc = f32x16{};
        acc = mm_ll(L + O_LAK, 32 * mt, L + O_VT, 32 * nt, acc, r32, hi);
#pragma unroll
        for (int g = 0; g < 4; ++g) st4(L + O_XT + (32 * nt + r32) * P + (32 * mt + 8 * g + 4 * hi) * 2, acc[4 * g], acc[4 * g + 1], acc[4 * g + 2], acc[4 * g + 3]);
    } else if (w == 7) {
        const int blk = lane >> 4, cc = lane & 15;
        float x[16];
#pragma unroll
        for (int t = 0; t < 16; ++t) x[t] = (t == cc) ? 1.f : 0.f;
#pragma unroll
        for (int kb = 0; kb < 4; ++kb) {
            f32x4 Lc[16];
#pragma unroll
            for (int t = 0; t < 16; ++t) if (t > 4 * kb) Lc[t] = *(const LAS f32x4*)(L + O_LABD + ((blk * 16 + t) * 16 + 4 * kb) * 4);
#pragma unroll
            for (int t = 0; t < 16; ++t) {
                if (t > 4 * kb + 0) x[t] += Lc[t][0] * x[4 * kb + 0];
            }
#pragma unroll
            for (int t = 0; t < 16; ++t) {
                if (t > 4 * kb + 1) x[t] += Lc[t][1] * x[4 * kb + 1];
            }
#pragma unroll
            for (int t = 0; t < 16; ++t) {
                if (t > 4 * kb + 2) x[t] += Lc[t][2] * x[4 * kb + 2];
            }
#pragma unroll
            for (int t = 0; t < 16; ++t) {
                if (t > 4 * kb + 3) x[t] += Lc[t][3] * x[4 * kb + 3];
            }
        }
#pragma unroll
        for (int t = 0; t < 16; ++t) *(LAS bf16_t*)(L + O_TII + ((blk * 16 + t) * 16 + cc) * 2) = f2bf(x[t]);
    }
    LBAR(); PST();
    {
        const int c16 = lane & 15, q4 = lane >> 4;
        const LAS unsigned char* RT = L + (w < 4 ? O_ATT : O_XT) + (16 * (w & 3) + c16) * P;
        LAS unsigned char* OT = L + (w < 4 ? O_ABT : O_U0T) + (16 * (w & 3) + c16) * P;
        const LAS unsigned char* LA = L + O_LAB + c16 * P;
#define RHS(i) ({ const u32x2 r_ = *(const LAS u32x2*)(RT + (16 * (i) + 4 * q4) * 2); (f32x4){bflo(r_.x), bfhi(r_.x), bflo(r_.y), bfhi(r_.y)}; })
#define AFR(i, k1, k2) ({ const u32x2 lo_ = *(const LAS u32x2*)(LA + 16 * (i) * P + (16 * (k1) + 4 * q4) * 2); u32x2 hi_ = {0u, 0u}; if ((k2) >= 0) hi_ = *(const LAS u32x2*)(LA + 16 * (i) * P + (16 * ((k2) < 0 ? 0 : (k2)) + 4 * q4) * 2); \
        __builtin_bit_cast(bf16x8, (u32x4){lo_.x, lo_.y, hi_.x, hi_.y}); })
#define TFR(i) ({ const u32x2 lo_ = *(const LAS u32x2*)(L + O_TII + (((i) * 16 + c16) * 16 + 4 * q4) * 2); __builtin_bit_cast(bf16x8, (u32x4){lo_.x, lo_.y, 0u, 0u}); })
#define BFR(U1, U2) __builtin_bit_cast(bf16x8, (u32x4){cvt_pk_bf16(U1[0], U1[1]), cvt_pk_bf16(U1[2], U1[3]), cvt_pk_bf16(U2[0], U2[1]), cvt_pk_bf16(U2[2], U2[3])})
#define MF16(A_, B_, C_) __builtin_amdgcn_mfma_f32_16x16x32_bf16(A_, B_, C_, 0, 0, 0)
        const f32x4 zero4 = {0.f, 0.f, 0.f, 0.f};
        f32x4 U0 = MF16(TFR(0), BFR(RHS(0), zero4), zero4);
        f32x4 Z1 = MF16(AFR(1, 0, -1), BFR(U0, zero4), RHS(1));
        f32x4 U1 = MF16(TFR(1), BFR(Z1, zero4), zero4);
        f32x4 Z2 = MF16(AFR(2, 0, 1), BFR(U0, U1), RHS(2));
        f32x4 U2 = MF16(TFR(2), BFR(Z2, zero4), zero4);
        f32x4 Z3 = MF16(AFR(3, 0, 1), BFR(U0, U1), RHS(3));
        Z3 = MF16(AFR(3, 2, -1), BFR(U2, zero4), Z3);
        f32x4 U3 = MF16(TFR(3), BFR(Z3, zero4), zero4);
        st4(OT + (0 + 4 * q4) * 2, U0[0], U0[1], U0[2], U0[3]); st4(OT + (16 + 4 * q4) * 2, U1[0], U1[1], U1[2], U1[3]);
        st4(OT + (32 + 4 * q4) * 2, U2[0], U2[1], U2[2], U2[3]); st4(OT + (48 + 4 * q4) * 2, U3[0], U3[1], U3[2], U3[3]);
#undef RHS
#undef AFR
#undef TFR
#undef BFR
#undef MF16
    }
    if (publish_prev) asm volatile("s_waitcnt vmcnt(0)" ::: "memory");
    LBAR(); PST();
    if (publish_prev && tid == 0) __hip_atomic_fetch_add(publish_prev, 1u, __ATOMIC_RELAXED, __HIP_MEMORY_SCOPE_AGENT);
    {
        const int mt = (w >> 1) & 1, nt = w & 1;
        if (w < 4) {
            f32x16 acc = f32x16{};
            acc = mm_ll(L + O_ABT, 32 * mt, L + O_BHT, 32 * nt, acc, r32, hi);
            if (mt == nt) { const float wc = *(const LAS float*)(L + O_WC + (32 * nt + r32) * 4);
#pragma unroll
                for (int r = 0; r < 16; ++r) if (crow(r, hi) == r32) acc[r] += wc; }
            store_native(slot + (mt * 2 + nt) * 2048, acc, lane, wt);
            f32x16 rb;
#pragma unroll
            for (int g = 0; g < 4; ++g) { const u32x2 r_ = *(const LAS u32x2*)(L + O_RT + (32 * nt + r32) * P + (32 * mt + 8 * g + 4 * hi) * 2);
                rb[4 * g] = bflo(r_.x); rb[4 * g + 1] = bfhi(r_.x); rb[4 * g + 2] = bflo(r_.y); rb[4 * g + 3] = bfhi(r_.y); }
            rb = mm_ll(L + O_ABT, 32 * mt, L + O_ARB, 32 * nt, rb, r32, hi);
            store_native(slot + 16384 + (mt * 2 + nt) * 2048, rb, lane, wt);
        } else {
            f32x16 acc = f32x16{};
            acc = mm_ll(L + O_BHT, 32 * mt, L + O_U0T, 32 * nt, acc, r32, hi);
            acc = mm_ll(L + O_KHT, 32 * mt, L + O_VT, 32 * nt, acc, r32, hi);
            store_native(slot + 8192 + (mt * 2 + nt) * 2048, acc, lane, wt);
            f32x16 y0 = f32x16{};
            y0 = mm_ll(L + O_ARB, 32 * mt, L + O_U0T, 32 * nt, y0, r32, hi);
            y0 = mm_ll(L + O_ARK, 32 * mt, L + O_VT, 32 * nt, y0, r32, hi);
            store_native(slot + 24576 + (mt * 2 + nt) * 2048, y0, lane, wt);
        }
    }
    LBAR(); PST();
    s1_stage_store(L, tid, nd, nq, nck, stg, par);
    LBAR(); PST();
#undef PAR
#undef TAU
#undef LD10
#undef PST
}

__device__ __forceinline__ void s23_wait_round(unsigned* ready, int r, int lane) {
    unsigned spins = 0;
    while ((unsigned)__builtin_amdgcn_readfirstlane(__hip_atomic_load(ready + r, __ATOMIC_RELAXED, __HIP_MEMORY_SCOPE_AGENT)) < 16u) { __builtin_amdgcn_s_sleep(8); if (++spins > (1u << 22)) break; }
    __builtin_amdgcn_fence(__ATOMIC_ACQUIRE, "agent");
    asm volatile("s_waitcnt vmcnt(0)" ::: "memory");
}
__device__ __forceinline__ void s23_chain_wg(const Frame& F, const Args& a, int d, int q, int h, unsigned char* slots  , unsigned* ready) {
    LAS unsigned char* L = F.lds;
    const int lane = F.lane, w = F.wave, icb = w & 1;
    const int NC = seq_len(q) / 64;
    f32x16 X0 = f32x16{}, X1 = f32x16{};
    const bool loader = w >= 4, compute = w < 2;
    constexpr int D = 6;
#define CKOF(cc) (d == 0 ? (cc) : NC - 1 - (cc))
#define S23_DMA(cc) do { const unsigned char* src_ = slots + (size_t)CKOF(cc) * SLOT_BYTES + (w - 4) * 4096 + lane * 16; LAS unsigned char* dst_ = L + ((cc) & 7) * 16384 + (w - 4) * 4096; \
        _Pragma("unroll") for (int p_ = 0; p_ < 4; ++p_) __builtin_amdgcn_global_load_lds((const unsigned*)(src_ + p_ * 1024), (LAS unsigned*)(dst_ + p_ * 1024), 16, 0, 0); } while (0)
#define UNPK(dst, w0, w1) do { _Pragma("unroll") for (int q_ = 0; q_ < 4; ++q_) { dst[2 * q_] = bflo(w0[q_]); dst[2 * q_ + 1] = bfhi(w0[q_]); dst[8 + 2 * q_] = bflo(w1[q_]); dst[9 + 2 * q_] = bfhi(w1[q_]); } } while (0)
    if (ready) { if (w == 4) s23_wait_round(ready, 0, lane); asm volatile("s_waitcnt lgkmcnt(0)\n\ts_barrier" ::: "memory"); }
    if (loader) {
#pragma unroll
        for (int c0 = 0; c0 < D; ++c0) if (c0 < NC) S23_DMA(c0); }
#pragma unroll 1
    for (int cc = 0; cc < NC; ++cc) {
        if (ready && w == 4 && ((cc + D) & 15) == 0 && cc + D < NC) s23_wait_round(ready, (cc + D) >> 4, lane);
        if (loader) { const int later = NC - 1 - cc;
            if (later >= 5) asm volatile("s_waitcnt vmcnt(20)" ::: "memory"); else if (later == 4) asm volatile("s_waitcnt vmcnt(16)" ::: "memory"); else if (later == 3) asm volatile("s_waitcnt vmcnt(12)" ::: "memory");
            else if (later == 2) asm volatile("s_waitcnt vmcnt(8)" ::: "memory"); else if (later == 1) asm volatile("s_waitcnt vmcnt(4)" ::: "memory"); else asm volatile("s_waitcnt vmcnt(0)" ::: "memory"); }
        asm volatile("s_waitcnt lgkmcnt(0)\n\ts_barrier" ::: "memory");
        if (loader) { if (cc + D < NC) S23_DMA(cc + D); }
        if (compute) {
            const LAS unsigned char* sl = L + (cc & 7) * 16384 + lane * 32;
            u32x4 mw[4][2], dw[2][2];
#pragma unroll
            for (int t = 0; t < 4; ++t) { mw[t][0] = *(const LAS u32x4*)(sl + t * 2048); mw[t][1] = *(const LAS u32x4*)(sl + t * 2048 + 16); }
#pragma unroll
            for (int t = 0; t < 2; ++t) { dw[t][0] = *(const LAS u32x4*)(sl + 8192 + (t * 2 + icb) * 2048); dw[t][1] = *(const LAS u32x4*)(sl + 8192 + (t * 2 + icb) * 2048 + 16); }
            __builtin_amdgcn_sched_barrier(0);
            u32x4 xw[2][2];
#pragma unroll
            for (int s = 0; s < 2; ++s) {
                xw[0][s] = (u32x4){cvt_pk_bf16(X0[8 * s], X0[8 * s + 1]), cvt_pk_bf16(X0[8 * s + 2], X0[8 * s + 3]), cvt_pk_bf16(X0[8 * s + 4], X0[8 * s + 5]), cvt_pk_bf16(X0[8 * s + 6], X0[8 * s + 7])};
                xw[1][s] = (u32x4){cvt_pk_bf16(X1[8 * s], X1[8 * s + 1]), cvt_pk_bf16(X1[8 * s + 2], X1[8 * s + 3]), cvt_pk_bf16(X1[8 * s + 4], X1[8 * s + 5]), cvt_pk_bf16(X1[8 * s + 6], X1[8 * s + 7])}; }
            { unsigned char* xo = slots + (size_t)CKOF(cc) * SLOT_BYTES + ((icb * 2) * 64 + lane) * 32;
              *(u32x4*)(xo) = xw[0][0]; *(u32x4*)(xo + 16) = xw[0][1]; *(u32x4*)(xo + 2048) = xw[1][0]; *(u32x4*)(xo + 2048 + 16) = xw[1][1]; }
            asm volatile("s_waitcnt lgkmcnt(0)" ::: "memory");
            __builtin_amdgcn_sched_barrier(0);
            f32x16 N0, N1;
            UNPK(N0, dw[0][0], dw[0][1]); UNPK(N1, dw[1][0], dw[1][1]);
#pragma unroll
            for (int rb = 0; rb < 2; ++rb)
#pragma unroll
                for (int s = 0; s < 2; ++s) {
                    N0 = __builtin_amdgcn_mfma_f32_32x32x16_bf16(__builtin_bit_cast(bf16x8, mw[rb * 2 + 0][s]), __builtin_bit_cast(bf16x8, xw[rb][s]), N0, 0, 0, 0);
                    N1 = __builtin_amdgcn_mfma_f32_32x32x16_bf16(__builtin_bit_cast(bf16x8, mw[rb * 2 + 1][s]), __builtin_bit_cast(bf16x8, xw[rb][s]), N1, 0, 0, 0); }
            X0 = N0; X1 = N1;
        }
    }
    asm volatile("s_waitcnt vmcnt(0) lgkmcnt(0)\n\ts_barrier" ::: "memory");
#undef UNPK
#undef S23_DMA
#undef CKOF
}

constexpr int PO_V = 0, PO_G = PO_V + 66 * 144, PO_Y = PO_G + 66 * 272, PO_SG = PO_Y + 2 * 64 * 272, PO_GF = PO_SG + 64 * 272, PO_END = PO_GF + 64 * 272;
static_assert(PO_END <= PTRS_OFF - 64, "post lds");
struct PostPre { u32x4 stg[4]; u32x4 ra[2][2], xb[2][2], yc[2]; };
__device__ __forceinline__ void post_decode(int c, int& reg, int& row, int& part) {
    if (c < 528) { reg = 0; row = c >> 3; part = c & 7; } else { reg = 1; row = (c - 528) >> 4; part = (c - 528) & 15; }
}
__device__ __forceinline__ void post_stage_load(const Args& a, int tid, int q, int h, int blk, PostPre& pp) {
    const int row0 = seq_row0(q), S = seq_len(q), t0 = blk * 64;
    const bf16_t* Zs = (const bf16_t*)(a.ws + WS_Z) + (size_t)row0 * ZP;
#pragma unroll
    for (int k = 0; k < 4; ++k) { const int c = tid + k * NTHR; int reg, row, part; post_decode(c, reg, row, part);
        const int t = t0 - 1 + row; const int col = reg == 0 ? ZRV + h * 64 : ZGD;
        pp.stg[k] = (u32x4){0u, 0u, 0u, 0u};
        if (c < 1584 && t >= 0 && t < S) pp.stg[k] = *(const u32x4*)(Zs + (size_t)t * ZP + col + part * 8); }
    const int w = tid >> 6, lane = tid & 63, dd = w >> 2, tb = (w >> 1) & 1, icb = w & 1;
    const size_t si = q == 0 ? (size_t)(dd * 8 + h) * 256 + blk : (size_t)((dd * 8 + (q - 1)) * 8 + h) * 32 + blk;
    const unsigned char* sl = (const unsigned char*)a.out + si * SLOT_BYTES + lane * 32;
#pragma unroll
    for (int rb = 0; rb < 2; ++rb) { pp.ra[rb][0] = *(const u32x4*)(sl + 16384 + (rb * 2 + tb) * 2048); pp.ra[rb][1] = *(const u32x4*)(sl + 16384 + (rb * 2 + tb) * 2048 + 16);
                                     pp.xb[rb][0] = *(const u32x4*)(sl + (icb * 2 + rb) * 2048); pp.xb[rb][1] = *(const u32x4*)(sl + (icb * 2 + rb) * 2048 + 16); }
    pp.yc[0] = *(const u32x4*)(sl + 24576 + (tb * 2 + icb) * 2048); pp.yc[1] = *(const u32x4*)(sl + 24576 + (tb * 2 + icb) * 2048 + 16);
}
__device__ __forceinline__ void post_item(const Frame& F, const Args& a, int q, int h, int blk, PostPre& pp, int nq, int nh, int nblk) {
    LAS unsigned char* L = F.lds;
    int lane_ = F.lane; asm volatile("" : "+v"(lane_));
    const int lane = lane_, w = F.wave, tid = w * 64 + lane, r32 = lane & 31, hi = lane >> 5, tg = w;
    typedef f32x2_t v2;
    const int cp = lane & 31, th = lane >> 5;
    const int row0 = seq_row0(q), t_lo = blk * 64 + 8 * tg + 4 * th;
    bf16_t* Zs = (bf16_t*)(a.ws + WS_Z) + (size_t)row0 * ZP;
    const float* mup = inp(L, 11); const float* mun = inp(L, 12);
#define GLD2(p_) (*(const GAS v2*)(p_))
    const int chp = h * 64 + 2 * cp;
    const v2 mp0 = GLD2(mup + ZGD - ZRR + 2 * cp), mn0 = GLD2(mun + ZGD - ZRR + 2 * cp), mp1 = GLD2(mup + ZGD - ZRR + 64 + 2 * cp), mn1 = GLD2(mun + ZGD - ZRR + 64 + 2 * cp);
    const v2 mpv = GLD2(mup + 1024 + chp), mnv = GLD2(mun + 1024 + chp), lg = GLD2(inp(L, 21) + chp), lb = GLD2(inp(L, 22) + chp);
#undef GLD2
    float bsum[4];
    { const GAS float* bon0 = (const GAS float*)(a.ws + WS_BONUS) + (size_t)row0 * 8 + h; const GAS float* bon1 = bon0 + (size_t)MTOK * 8;
#pragma unroll
      for (int k = 0; k < 4; ++k) bsum[k] = bon0[(size_t)(t_lo + k) * 8] + bon1[(size_t)(t_lo + k) * 8]; }
    bf16x8 gfr[8];
    { const GAS bf16_t* GT = (const GAS bf16_t*)(a.ws + WS_LORA) + 4 * 512 * 64 + ((size_t)h * 64 + 32 * ((w >> 1) & 1) + r32) * 128;
#pragma unroll
      for (int ks = 0; ks < 8; ++ks) gfr[ks] = *(const GAS bf16x8*)(GT + 16 * ks + 8 * hi); }
#pragma unroll
    for (int k = 0; k < 4; ++k) { const int c = tid + k * NTHR; int reg, row, part; post_decode(c, reg, row, part);
        const int off = reg == 0 ? PO_V + row * 144 : PO_G + row * 272;
        if (c < 1584) *(LAS u32x4*)(L + off + part * 16) = pp.stg[k]; }
    {
        const int dd = w >> 2, tb = (w >> 1) & 1, icb = w & 1;
        f32x16 Y;
#pragma unroll
        for (int q_ = 0; q_ < 4; ++q_) { Y[2 * q_] = bflo(pp.yc[0][q_]); Y[2 * q_ + 1] = bfhi(pp.yc[0][q_]); Y[8 + 2 * q_] = bflo(pp.yc[1][q_]); Y[9 + 2 * q_] = bfhi(pp.yc[1][q_]); }
#pragma unroll
        for (int rb = 0; rb < 2; ++rb)
#pragma unroll
            for (int s2 = 0; s2 < 2; ++s2) Y = __builtin_amdgcn_mfma_f32_32x32x16_bf16(__builtin_bit_cast(bf16x8, pp.ra[rb][s2]), __builtin_bit_cast(bf16x8, pp.xb[rb][s2]), Y, 0, 0, 0);
#pragma unroll
        for (int r = 0; r < 16; ++r) { const int tau = 32 * tb + (r & 3) + 8 * (r >> 2) + 4 * hi; const int t = dd == 0 ? tau : 63 - tau;
            *(LAS float*)(L + PO_Y + (dd * 64 + t) * 272 + (32 * icb + r32) * 4) = Y[r]; }
    }
    LBAR();
    post_stage_load(a, tid, nq, nh, nblk, pp);
    const int tl = 8 * tg + 4 * th;
#define SIG2V(a_) ({ const v2 t_ = (a_) * (-1.4426950408889634f); const v2 e_ = (v2){__builtin_amdgcn_exp2f(t_.x), __builtin_amdgcn_exp2f(t_.y)} + 1.0f; (v2){__builtin_amdgcn_rcpf(e_.x), __builtin_amdgcn_rcpf(e_.y)}; })
    {
        v2 z0[6], z1[6];
#pragma unroll
        for (int i = 0; i < 6; ++i) { const unsigned w0 = *(const LAS unsigned*)(L + PO_G + (tl + i) * 272 + cp * 4), w1 = *(const LAS unsigned*)(L + PO_G + (tl + i) * 272 + 128 + cp * 4);
            z0[i] = (v2){bflo(w0), bfhi(w0)}; z1[i] = (v2){bflo(w1), bfhi(w1)}; }
#pragma unroll
        for (int k = 0; k < 4; ++k) { const v2 s0 = SIG2V(z0[k + 1] + mp0 * (z0[k] - z0[k + 1]) + mn0 * (z0[k + 2] - z0[k + 1])), s1 = SIG2V(z1[k + 1] + mp1 * (z1[k] - z1[k + 1]) + mn1 * (z1[k + 2] - z1[k + 1]));
            *(LAS unsigned*)(L + PO_SG + (tl + k) * 272 + cp * 4) = cvt_pk_bf16(s0.x, s0.y); *(LAS unsigned*)(L + PO_SG + (tl + k) * 272 + 128 + cp * 4) = cvt_pk_bf16(s1.x, s1.y); }
    }
#undef SIG2V
    LBAR();
    if (w < 4) {
        const int mt = w >> 1, nt = w & 1;
        f32x16 acc = f32x16{};
#pragma unroll
        for (int ks = 0; ks < 8; ++ks) { const bf16x8 bv = *(const LAS bf16x8*)(L + PO_SG + (32 * nt + r32) * 272 + (16 * ks + 8 * hi) * 2);
            acc = __builtin_amdgcn_mfma_f32_32x32x16_bf16(gfr[ks], bv, acc, 0, 0, 0); }
#pragma unroll
        for (int g = 0; g < 4; ++g) *(LAS f32x4*)(L + PO_GF + (32 * nt + r32) * 272 + (32 * mt + 8 * g + 4 * hi) * 4) = (f32x4){acc[4 * g], acc[4 * g + 1], acc[4 * g + 2], acc[4 * g + 3]};
    }
    LBAR();
    {
        v2 zv[6];
#pragma unroll
        for (int i = 0; i < 6; ++i) { const unsigned wv = *(const LAS unsigned*)(L + PO_V + (tl + i) * 144 + cp * 4); zv[i] = (v2){bflo(wv), bfhi(wv)}; }
        v2 y2[4]; float red[4];
#pragma unroll
        for (int k = 0; k < 4; ++k) { y2[k] = *(const LAS v2*)(L + PO_Y + (tl + k) * 272 + cp * 8) + *(const LAS v2*)(L + PO_Y + (64 + tl + k) * 272 + cp * 8); red[k] = y2[k].x + y2[k].y; }
#define FOLD4(s_) ({ const bool b4_ = (lane >> 4) & 1, b3_ = (lane >> 3) & 1; float g_[2]; \
        _Pragma("unroll") for (int i_ = 0; i_ < 2; ++i_) { const float kp_ = b4_ ? s_[i_ + 2] : s_[i_], sd_ = b4_ ? s_[i_] : s_[i_ + 2]; g_[i_] = kp_ + __int_as_float(__builtin_amdgcn_ds_swizzle(__float_as_int(sd_), 0x401F)); } \
        const float kp2_ = b3_ ? g_[1] : g_[0], sd2_ = b3_ ? g_[0] : g_[1]; \
        float h_ = kp2_ + __int_as_float(__builtin_amdgcn_update_dpp(0, __float_as_int(sd2_), 0x128, 0xF, 0xF, true)); \
        h_ += __int_as_float(__builtin_amdgcn_update_dpp(0, __float_as_int(h_), 0x141, 0xF, 0xF, true)); \
        h_ += __int_as_float(__builtin_amdgcn_update_dpp(0, __float_as_int(h_), 0xB1, 0xF, 0xF, true)); \
        h_ += __int_as_float(__builtin_amdgcn_update_dpp(0, __float_as_int(h_), 0x4E, 0xF, 0xF, true)); h_; })
#define MINE(hs_, k_) ({ const float lo_ = __int_as_float(__builtin_amdgcn_readlane(hs_, 8 * (k_))), hi_ = __int_as_float(__builtin_amdgcn_readlane(hs_, 32 + 8 * (k_))); th ? hi_ : lo_; })
        const int hm = __float_as_int(FOLD4(red));
#pragma unroll
        for (int k = 0; k < 4; ++k) { y2[k] = y2[k] - MINE(hm, k) * (1.f / 64.f); red[k] = y2[k].x * y2[k].x + y2[k].y * y2[k].y; }
        const int hv = __float_as_int(FOLD4(red));
#pragma unroll
        for (int k = 0; k < 4; ++k) {
            const v2 yn = y2[k] * __builtin_amdgcn_rsqf(MINE(hv, k) * (1.f / 64.f) + LNX_EPS) * lg + lb;
            const v2 vs = zv[k + 1] + mpv * (zv[k] - zv[k + 1]) + mnv * (zv[k + 2] - zv[k + 1]);
            const v2 g = *(const LAS v2*)(L + PO_GF + (tl + k) * 272 + cp * 8);
            const v2 o = (yn + vs * bsum[k]) * g;
            *(unsigned*)(Zs + (size_t)(t_lo + k) * ZP + ZRR + chp) = cvt_pk_bf16(o.x, o.y); }
#undef FOLD4
#undef MINE
    }
    LBAR();
}
}


#define XB_TMO      128
#define XB_XCNT(j)  (256  + 64 * (j))
#define XB_XSUB(j)  (1280 + 64 * (j))
#define XB_XGEN(j)  (2304 + 64 * (j))
#define XB_TOP      3328
#define XB_TOPGEN   3392
#define XCD_BAR_WORDS 3456
#define XB_SPIN_CAP (1u << 20)
constexpr size_t CTL_ZERO_BYTES = 16384;
__device__ __forceinline__ unsigned xb_ld(unsigned* p)              { return __hip_atomic_load(p, __ATOMIC_RELAXED, __HIP_MEMORY_SCOPE_AGENT); }
__device__ __forceinline__ unsigned xb_add(unsigned* p, unsigned v) { return __hip_atomic_fetch_add(p, v, __ATOMIC_RELAXED, __HIP_MEMORY_SCOPE_AGENT); }
__device__ __forceinline__ unsigned xb_xcc_id() { return (unsigned)__builtin_amdgcn_s_getreg((3 << 11) | 20) & 0xFu; }
#define XB_SPIN(cond, bar) do { unsigned _sp = 0; while (cond) { __builtin_amdgcn_s_sleep(1); \
    if ((++_sp & 255u) == 0u) { if (xb_ld(&(bar)[XB_TMO])) break; if (_sp > XB_SPIN_CAP) { atomicAdd(&(bar)[XB_TMO], 1u); break; } } } } while (0)
struct XcdBarrier { unsigned* bar; unsigned x; volatile LAS unsigned* st; };
__device__ __forceinline__ XcdBarrier xcd_barrier_post(unsigned* bar, volatile LAS unsigned* st) {
    XcdBarrier b; b.bar = bar; b.x = xb_xcc_id(); b.st = st;
    if (threadIdx.x == 0) (void)xb_add(&bar[XB_XCNT(b.x)], 1u);
    return b;
}
__device__ __forceinline__ void xcd_barrier_complete(unsigned* bar, unsigned x, unsigned& nloc, unsigned& nx) {
    const unsigned G = gridDim.x * gridDim.y * gridDim.z;
    unsigned sum, cnt, mine, sp = 0u;
    for (;;) {
        sum = 0u; cnt = 0u; mine = 0u;
#pragma unroll
        for (unsigned j = 0; j < 16; ++j) { const unsigned c = xb_ld(&bar[XB_XCNT(j)]); sum += c; cnt += (c > 0u) ? 1u : 0u; mine = (j == x) ? c : mine; }
        if (sum == G) break;
        __builtin_amdgcn_s_sleep(1);
        if ((++sp & 255u) == 0u) { if (xb_ld(&bar[XB_TMO])) break; if (sp > XB_SPIN_CAP) { atomicAdd(&bar[XB_TMO], 1u); break; } }
    }
    nloc = mine > 0u ? mine : 1u; nx = cnt > 0u ? cnt : 1u;
}
__device__ __forceinline__ void xcd_barrier(const XcdBarrier& b) {
    asm volatile("s_waitcnt vmcnt(0)" ::: "memory");
    __syncthreads();
    if (threadIdx.x == 0) {
        unsigned* bar = b.bar;
        __builtin_amdgcn_s_waitcnt(0);
        unsigned nloc = b.st[0], nx = b.st[1];
        if (nloc == 0u) { xcd_barrier_complete(bar, b.x, nloc, nx); b.st[0] = nloc; b.st[1] = nx; }
        const unsigned old = xb_add(&bar[XB_XSUB(b.x)], 1u);
        const unsigned gen = old / nloc;
        if (old + 1u == (gen + 1u) * nloc) {
            __builtin_amdgcn_fence(__ATOMIC_RELEASE, "agent");
            asm volatile("s_waitcnt vmcnt(0)" ::: "memory");
            const unsigned og = xb_add(&bar[XB_TOP], 1u);
            const unsigned tg = og / nx;
            if (og + 1u == (tg + 1u) * nx) xb_add(&bar[XB_TOPGEN], 1u);
            else XB_SPIN(xb_ld(&bar[XB_TOPGEN]) == tg, bar);
            __builtin_amdgcn_fence(__ATOMIC_ACQUIRE, "agent");
            xb_add(&bar[XB_XGEN(b.x)], 1u);
            asm volatile("s_waitcnt vmcnt(0)" ::: "memory");
        } else {
            XB_SPIN(xb_ld(&bar[XB_XGEN(b.x)]) == gen, bar);
            __builtin_amdgcn_fence(__ATOMIC_ACQUIRE, "agent");
            asm volatile("s_waitcnt vmcnt(0)" ::: "memory");
        }
    }
    __syncthreads();
}

constexpr int NPHASE = 10;
constexpr int NOJUMP = 1 << 30;
template <int LO, int HI>
__global__ void __launch_bounds__(NTHR, 2) fwd_kernel(Args a) {
    extern __shared__ __attribute__((aligned(16))) unsigned char lds_raw[];
    Frame F; F.lds = (LAS unsigned char*)lds_raw; F.tid = threadIdx.x; F.lane = F.tid & 63; F.wave = __builtin_amdgcn_readfirstlane(F.tid >> 6);
    F.G = gridDim.x; { const int bx = blockIdx.x; F.vcu = (F.G % 8 == 0) ? (bx % 8) * (F.G / 8) + bx / 8 : bx; }
    unsigned char* ws = a.ws; bf16_t* Z = (bf16_t*)(ws + WS_Z);
    unsigned char* slots = (unsigned char*)a.out;
    if (F.tid == 0) {
#pragma unroll
        for (int i = 0; i < 27; ++i) *(const float* LAS*)(F.lds + PTRS_OFF + i * 8) = a.in[i];
        *(volatile LAS unsigned*)(F.lds + PTRS_OFF + 224) = 0u; *(volatile LAS unsigned*)(F.lds + PTRS_OFF + 228) = 0u;
        *(LAS unsigned long long*)(F.lds + PTRS_OFF - 64) = 0ull;
    }
    __syncthreads();
#if ONE_LAUNCH && !USE_CG
    const XcdBarrier bar = xcd_barrier_post((unsigned*)(ws + WS_CTL), (volatile LAS unsigned*)(F.lds + PTRS_OFF + 224));
#endif
#if ONE_LAUNCH
#if PROBE_SEG >= 0 || PROBE_CLK >= 0
    unsigned long long* tsb = (unsigned long long*)(ws + WS_CTL + 15872); int nts = 0;
#define STAMP() do { if (blockIdx.x == 0 && F.tid == 0) { tsb[nts] = __builtin_amdgcn_s_memrealtime(); tsb[32 + nts] = __builtin_amdgcn_s_memtime(); } ++nts; } while (0)
    STAMP();
#else
#define STAMP() do { } while (0)
#endif
#if USE_CG
#define SEAM(k) do { if constexpr ((k) + 1 < HI) { cg::this_grid().sync(); STAMP(); } } while (0)
#define RSYNC() do { cg::this_grid().sync(); STAMP(); } while (0)
#else
#define SEAM(k) do { if constexpr ((k) + 1 < HI) { xcd_barrier(bar); STAMP(); } } while (0)
#define RSYNC() do { xcd_barrier(bar); STAMP(); } while (0)
#endif
#else
#define SEAM(k) do { } while (0)
#define RSYNC() do { } while (0)
#endif
#define IN(k) (LO <= (k) && (k) < HI)
    if constexpr (IN(0)) { p0_prologue(F, a); SEAM(0);
#if PROBE_DOUBLE == 4
        p0_prologue(F, a); RSYNC();
#endif
    }
    if constexpr (IN(1)) { pg8::Gemm g{(const char*)a.out, (const bf16_t*)(ws + WS_WIN), MTOK, ZP, DM, DM * 2, NOJUMP, 0}; pg8::StaticOrder S; S.init(MTOK, ZP, F.G, (int)blockIdx.x);
        pg8::EpiZ E{Z, ZP}; pg8::gemm_phase<pg8::EpiZ, pg8::StaticOrder, true>(F.lds, g, S, E); SEAM(1);
#if PROBE_DOUBLE == 3
        pg8::gemm_phase<pg8::EpiZ, pg8::StaticOrder, true>(F.lds, g, S, E); RSYNC();
#endif
    }
    if constexpr (IN(2)) { qk_prep(F, a);
        unsigned* rdy = (unsigned*)(ws + WS_CTL) + 3584;
#pragma unroll 1
        for (int rnd = 0; rnd < 2; ++rnd) {
            const int nprod = rnd == 1 ? F.G - 16 : F.G;
            if (F.vcu < nprod) {
#define S1_DECODE(i_, d_, q_, h_, ck_, it_, pub_) do { if (rnd == 1) { const int c_ = ((i_) >> 4) & 15, cc_ = (((i_) >> 8) << 4) + ((i_) & 15); d_ = c_ >> 3; h_ = c_ & 7; q_ = 0; ck_ = d_ ? 255 - cc_ : cc_; it_ = c_ * 256 + ck_; pub_ = rdy + c_ * 16 + ((i_) >> 8); } \
                    else { ck_ = (i_) & 31; h_ = ((i_) >> 5) & 7; q_ = 1 + (((i_) >> 8) & 7); d_ = (i_) >> 11; it_ = (i_); pub_ = nullptr; } } while (0)
                { int d, q, h, ck, it; unsigned* pub; S1_DECODE(F.vcu, d, q, h, ck, it, pub); (void)it; (void)pub;
                  u32x4 stg[6]; rw::s1_stage_load(a, F.tid, q, h, ck, stg); const f32x2_t par = rw::s1_param_load(F.lds, F.tid, d, h);
                  rw::s1_stage_store(F.lds, F.tid, d, q, ck, stg, par); LBAR(); }
                unsigned* pub_prev = nullptr;
#pragma unroll 1
                for (int i = F.vcu; i < 4096; i += nprod) {
                    int d, q, h, ck, it, nd, nq, nh, nck, nit; unsigned* pub; unsigned* npub; S1_DECODE(i, d, q, h, ck, it, pub); const int ni = i + nprod < 4096 ? i + nprod : i; S1_DECODE(ni, nd, nq, nh, nck, nit, npub); (void)nit; (void)npub;
                    rw::s1_item(F, a, d, q, h, ck, slots + (size_t)it * SLOT_BYTES, nd, nq, nh, nck, rnd == 1, pub_prev); pub_prev = pub; }
                if (pub_prev) { asm volatile("s_waitcnt vmcnt(0)" ::: "memory"); __syncthreads(); if (F.tid == 0) __hip_atomic_fetch_add(pub_prev, 1u, __ATOMIC_RELAXED, __HIP_MEMORY_SCOPE_AGENT); }
#undef S1_DECODE
            } else {
                const int c = F.vcu - nprod;
                rw::s23_chain_wg(F, a, c >> 3, 0, c & 7, slots + (size_t)c * 256 * SLOT_BYTES, rdy + c * 16);
            }
            if (rnd == 0) {
                RSYNC();
                for (int chain = F.vcu; chain < 128; chain += F.G) { const int h = chain & 7, q = 1 + ((chain >> 3) & 7), d = chain >> 6;
                    rw::s23_chain_wg(F, a, d, q, h, slots + (size_t)chain * 32 * SLOT_BYTES, nullptr); }
            }
            RSYNC();
            {
#define PO_DECODE(it_, q_, h_, b_) do { if (rnd == 1) { q_ = 0; h_ = ((it_) >> 8) & 7; b_ = (it_) & 255; } else { q_ = 1 + (((it_) >> 8) & 7); h_ = ((it_) >> 5) & 7; b_ = (it_) & 31; } } while (0)
                rw::PostPre pp;
                { int q, h, b; PO_DECODE(F.vcu, q, h, b); rw::post_stage_load(a, F.tid, q, h, b, pp); }
#pragma unroll 1
                for (int it = F.vcu; it < 2048; it += F.G) { int q, h, b, nq, nh, nb; PO_DECODE(it, q, h, b); const int nit = it + F.G < 2048 ? it + F.G : it; PO_DECODE(nit, nq, nh, nb);
                    rw::post_item(F, a, q, h, b, pp, nq, nh, nb); }
#undef PO_DECODE
            }
            if (rnd == 0) RSYNC();
        }
        SEAM(2); }
    if constexpr (IN(4)) {
        float lam; { const float p1 = wave_sum(a.in[6][F.lane] * a.in[7][F.lane]), p2 = wave_sum(a.in[8][F.lane] * a.in[9][F.lane]); lam = __expf(p1) - __expf(p2) + LAMBDA_INIT; }
#if PROBE_DOUBLE == 1
        for (int v = F.vcu; v < 256; v += F.G) {
            att::attn_unit(0, SP, v >> 6, v & 63, Z, F.lds, lam, a.in[10], (bf16_t*)a.out, 512);
            att::attn_unit(SP + (v >> 5) * SS, SS, (v >> 3) & 3, v & 7, Z, F.lds, lam, a.in[10], (bf16_t*)a.out, 512); }
        RSYNC();
#endif
        for (int v = F.vcu; v < 256; v += F.G) {
            att::attn_unit(0, SP, v >> 6, v & 63, Z, F.lds, lam, a.in[10], Z, ZP);
            att::attn_unit(SP + (v >> 5) * SS, SS, (v >> 3) & 3, v & 7, Z, F.lds, lam, a.in[10], Z, ZP); }
        SEAM(4); }
    if constexpr (IN(5)) { pg8::Gemm g{(const char*)Z, (const bf16_t*)(ws + WS_WOUT), MTOK, DM, DM, ZP * 2, 8, 2048}; pg8::StaticOrder S; S.init(MTOK, DM, F.G, (int)blockIdx.x);
        pg8::EpiOut E{a.in[0], a.in[1], a.out, Z, (float*)(ws + WS_ROWSQ)}; pg8::gemm_phase<pg8::EpiOut, pg8::StaticOrder, true>(F.lds, g, S, E); SEAM(5); }
#define FFN_UP(k, half) if constexpr (IN(k)) { pg8::Gemm g{(const char*)(Z + (size_t)(half) * 16384 * ZP + ZXN2), (const bf16_t*)(ws + WS_W1), 16384, DFF, DM, ZP * 2, NOJUMP, 0}; pg8::StaticOrder S; S.init(16384, DFF, F.G, (int)blockIdx.x); \
        pg8::EpiUp E{(char*)(ws + WS_Z), (const float*)(ws + WS_ROWSQ), (half) * 16384}; pg8::gemm_phase<pg8::EpiUp, pg8::StaticOrder, true>(F.lds, g, S, E); SEAM(k); }
#define FFN_DN(k, half) if constexpr (IN(k)) { pg8::Gemm g{(const char*)(ws + WS_Z), (const bf16_t*)(ws + WS_W2), 16384, DM, DFF, 13312, 32, 2560}; pg8::StaticOrder S; S.init(16384, DM, F.G, (int)blockIdx.x); \
        pg8::EpiDown E{a.out, Z, (half) * 16384}; pg8::gemm_phase<pg8::EpiDown, pg8::StaticOrder, true>(F.lds, g, S, E); SEAM(k); }
    FFN_UP(6, 0) FFN_DN(7, 0) FFN_UP(8, 1) FFN_DN(9, 1)
#if PROBE_S1 >= 0 || PROBE_ATT
    if (F.tid == 0) { const unsigned long long dt = *(LAS unsigned long long*)(F.lds + PTRS_OFF - 64), t0_ = __builtin_amdgcn_s_memrealtime();
        while (__builtin_amdgcn_s_memrealtime() - t0_ < dt) __builtin_amdgcn_s_sleep(16); }
#endif
#if PROBE_SEG >= 0 || PROBE_CLK >= 0
    STAMP();
#if PROBE_CLK >= 0
    if (blockIdx.x == 0 && F.tid == 0) { asm volatile("s_waitcnt vmcnt(0)" ::: "memory"); const unsigned long long wt_ = tsb[PROBE_CLK + 1] - tsb[PROBE_CLK], cy_ = tsb[32 + PROBE_CLK + 1] - tsb[32 + PROBE_CLK];
        const unsigned long long dt = cy_ * 1000ull / (wt_ ? wt_ : 1ull), t0_ = __builtin_amdgcn_s_memrealtime();
        while (__builtin_amdgcn_s_memrealtime() - t0_ < dt) __builtin_amdgcn_s_sleep(16); }
#endif
    if (PROBE_CLK < 0 && blockIdx.x == 0 && F.tid == 0) { asm volatile("s_waitcnt vmcnt(0)" ::: "memory"); const unsigned long long dt = tsb[PROBE_SEG + 1] - tsb[PROBE_SEG], t0_ = __builtin_amdgcn_s_memrealtime();
        while (__builtin_amdgcn_s_memrealtime() - t0_ < dt) __builtin_amdgcn_s_sleep(16); }
#endif
#undef FFN_UP
#undef FFN_DN
#undef IN
#undef SEAM
#undef RSYNC
}

extern "C" void kernel_launch(void* const* d_in, const int* in_sizes, int n_in, void* d_out, int out_size, void* d_ws, size_t ws_size, hipStream_t stream) {
    static int grid = 0;
    if (grid == 0) {
        if (n_in != 27 || out_size != MTOK * DM || ws_size < WS_TOTAL) { fprintf(stderr, "kernel_launch: unexpected shapes (n_in %d out %d ws %zu)\n", n_in, out_size, ws_size); grid = -1; return; }
        int dev = 0, cus = 0; (void)hipGetDevice(&dev); (void)hipDeviceGetAttribute(&cus, hipDeviceAttributeMultiprocessorCount, dev);
        bool ok = true;
#if ONE_LAUNCH
        ok = ok && hipFuncSetAttribute((const void*)fwd_kernel<0, NPHASE>, hipFuncAttributeMaxDynamicSharedMemorySize, LDS_BYTES) == hipSuccess;
        int per_cu = 0; (void)hipOccupancyMaxActiveBlocksPerMultiprocessor(&per_cu, (const void*)fwd_kernel<0, NPHASE>, NTHR, LDS_BYTES); (void)hipGetLastError();
        if (per_cu < 1) fprintf(stderr, "kernel_launch: occupancy query says %d blocks/CU\n", per_cu);
#else
#define SETA(p) ok = ok && hipFuncSetAttribute((const void*)fwd_kernel<p, p + 1>, hipFuncAttributeMaxDynamicSharedMemorySize, LDS_BYTES) == hipSuccess;
        SETA(0) SETA(1) SETA(2) SETA(3) SETA(4) SETA(5) SETA(6) SETA(7) SETA(8) SETA(9)
#undef SETA
#endif
        if (!ok) { fprintf(stderr, "kernel_launch: hipFuncSetAttribute failed\n"); grid = -1; return; }
        grid = cus > 256 ? 256 : cus;
    }
    if (grid < 0) return;
    Args a{};
    for (int i = 0; i < 27; ++i) a.in[i] = (const float*)d_in[i];
    a.out = (float*)d_out; a.ws = (unsigned char*)d_ws;
#if ONE_LAUNCH
    a.ph_lo = 0; a.ph_hi = NPHASE;
#if !USE_CG
    if (hipMemsetAsync((char*)d_ws + WS_CTL, 0, CTL_ZERO_BYTES, stream) != hipSuccess) { fprintf(stderr, "kernel_launch: hipMemsetAsync failed\n"); return; }
#endif
    void* args[] = {&a};
    hipError_t e = hipLaunchCooperativeKernel((const void*)fwd_kernel<0, NPHASE>, dim3(grid), dim3(NTHR), args, LDS_BYTES, stream);
    if (e != hipSuccess) fprintf(stderr, "cooperative launch failed: %s (grid %d)\n", hipGetErrorString(e), grid);
#else
#define LAUNCH(p) hipLaunchKernelGGL((fwd_kernel<p, p + 1>), dim3(grid), dim3(NTHR), LDS_BYTES, stream, a);
    LAUNCH(0) LAUNCH(1) LAUNCH(2) LAUNCH(3) LAUNCH(4) LAUNCH(5) LAUNCH(6) LAUNCH(7) LAUNCH(8) LAUNCH(9)
#undef LAUNCH
#endif
}
```

```cpp
#include <hip/hip_runtime.h>
#include <hip/hip_cooperative_groups.h>
#include <cstdio>
#include <cstdint>
namespace cg = cooperative_groups;

#ifndef ONE_LAUNCH
#define ONE_LAUNCH 1
#endif
#ifndef USE_CG
#define USE_CG 0
#endif
#ifndef PROBE_SEG
#define PROBE_SEG -1
#endif
#ifndef PROBE_S1
#define PROBE_S1 -1
#endif
#ifndef PROBE_ATT
#define PROBE_ATT 0
#endif
#ifndef PROBE_CLK
#define PROBE_CLK -1
#endif
#ifndef PROBE_DOUBLE
#define PROBE_DOUBLE 0
#endif

#define LAS __attribute__((address_space(3)))
#define GAS __attribute__((address_space(1)))
typedef unsigned short bf16_t;
typedef short bf16x8 __attribute__((ext_vector_type(8)));
typedef short s16x4 __attribute__((ext_vector_type(4)));
typedef float f32x4 __attribute__((ext_vector_type(4)));
typedef float f32x16 __attribute__((ext_vector_type(16)));
typedef unsigned u32x4 __attribute__((ext_vector_type(4)));
typedef unsigned u32x2 __attribute__((ext_vector_type(2)));
typedef float f32x2_t __attribute__((ext_vector_type(2)));
typedef __bf16 bf16x2_t __attribute__((ext_vector_type(2)));

constexpr int MTOK = 32768, DM = 1024, ZP = 3328, DFF = 4096;
constexpr int SP = 16384, SS = 2048;
constexpr int ZQ = 0, ZK = 512, ZV = 1024, ZRR = 1536, ZRK = 2048, ZRV = 2560, ZWD = 3072, ZAD = 3136, ZGD = 3200;
constexpr int ZXN2 = 2048;
constexpr float NORM_EPS = 1e-6f, LNX_EPS = 64e-5f;
constexpr float QSCALE = 0.125f * 1.4426950408889634f;
constexpr float LAMBDA_INIT = 0.2f;
constexpr int NCHUNK_P = SP / 64, NCHUNK_S = SS / 64;

constexpr size_t MiB = 1u << 20;
constexpr size_t WS_CTL = 0;
constexpr size_t WS_WIN = 1 * MiB, WS_WOUT = 8 * MiB, WS_W1 = 10 * MiB, WS_W2 = 18 * MiB;
constexpr size_t WS_ROPE = 26 * MiB;
constexpr size_t WS_LORA = 30 * MiB;
constexpr size_t WS_ROWSQ = 31 * MiB;
constexpr size_t WS_BONUS = 33 * MiB;
constexpr size_t WS_Z = 36 * MiB;
constexpr size_t WS_END = 244 * MiB;
constexpr size_t WS_E1 = 244 * MiB;
constexpr size_t WS_TOTAL = 252 * MiB;
static_assert(WS_Z + (size_t)MTOK * ZP * 2 <= WS_END, "ws map");
constexpr size_t SLOT_BYTES = 32768;

__device__ __forceinline__ unsigned cvt_pk_bf16(float lo, float hi) { f32x2_t v = {lo, hi}; bf16x2_t b = __builtin_convertvector(v, bf16x2_t); return __builtin_bit_cast(unsigned, b); }
__device__ __forceinline__ float bf2f(unsigned short u) { return __uint_as_float(((unsigned)u) << 16); }
__device__ __forceinline__ float bflo(unsigned u) { return __uint_as_float(u << 16); }
__device__ __forceinline__ float bfhi(unsigned u) { return __uint_as_float(u & 0xffff0000u); }
__device__ __forceinline__ unsigned short f2bf(float f) { return (unsigned short)(cvt_pk_bf16(f, 0.f) & 0xffffu); }
__device__ __forceinline__ float wave_sum(float v) {
#pragma unroll
    for (int o = 1; o < 64; o <<= 1) v += __shfl_xor(v, o);
    return v;
}
__device__ __forceinline__ float wave_sum_dpp(float v) {
    int x = __float_as_int(v);
    v += __int_as_float(__builtin_amdgcn_update_dpp(0, x, 0xB1, 0xF, 0xF, true)); x = __float_as_int(v);
    v += __int_as_float(__builtin_amdgcn_update_dpp(0, x, 0x4E, 0xF, 0xF, true)); x = __float_as_int(v);
    v += __int_as_float(__builtin_amdgcn_update_dpp(0, x, 0x124, 0xF, 0xF, true)); x = __float_as_int(v);
    v += __int_as_float(__builtin_amdgcn_update_dpp(0, x, 0x128, 0xF, 0xF, true)); x = __float_as_int(v);
    const float a = __int_as_float(__builtin_amdgcn_readlane(x, 0)), b = __int_as_float(__builtin_amdgcn_readlane(x, 16)), c = __int_as_float(__builtin_amdgcn_readlane(x, 32)), d = __int_as_float(__builtin_amdgcn_readlane(x, 48));
    return (a + b) + (c + d);
}
__device__ __forceinline__ void wave_sum8(float (&s)[8], int lane) {
    float f[4];
#pragma unroll
    for (int i = 0; i < 4; ++i) { auto rr = __builtin_amdgcn_permlane32_swap(__float_as_uint(s[i]), __float_as_uint(s[i + 4]), false, false); f[i] = __uint_as_float(rr[0]) + __uint_as_float(rr[1]); }
    const bool b4 = (lane >> 4) & 1, b3 = (lane >> 3) & 1;
    float g[2];
#pragma unroll
    for (int i = 0; i < 2; ++i) { const float keep = b4 ? f[i + 2] : f[i], send = b4 ? f[i] : f[i + 2];
        g[i] = keep + __int_as_float(__builtin_amdgcn_ds_swizzle(__float_as_int(send), 0x401F)); }
    const float keep = b3 ? g[1] : g[0], send = b3 ? g[0] : g[1];
    float h = keep + __int_as_float(__builtin_amdgcn_update_dpp(0, __float_as_int(send), 0x128, 0xF, 0xF, true));
    h += __int_as_float(__builtin_amdgcn_update_dpp(0, __float_as_int(h), 0x141, 0xF, 0xF, true));
    h += __int_as_float(__builtin_amdgcn_update_dpp(0, __float_as_int(h), 0xB1, 0xF, 0xF, true));
    h += __int_as_float(__builtin_amdgcn_update_dpp(0, __float_as_int(h), 0x4E, 0xF, 0xF, true));
    const int hx = __float_as_int(h);
#pragma unroll
    for (int k = 0; k < 8; ++k) s[k] = __int_as_float(__builtin_amdgcn_readlane(hx, 8 * k));
}
#define LDS_WAIT() asm volatile("s_waitcnt lgkmcnt(0)" ::: "memory")
#define VM_WAIT() asm volatile("s_waitcnt vmcnt(0)" ::: "memory")
#define LBAR() asm volatile("s_waitcnt lgkmcnt(0)\n\ts_barrier" ::: "memory")

namespace pg8 {
constexpr int BM = 256, BK = 64, HALF = 128, HTB = HALF * BK * 2, STAGE_BYTES = 8 * HTB, NXCD = 8, WGM = 8;
__host__ __device__ __forceinline__ int lds_byte(int r, int c) { const int st = (r >> 4) * 2 + (c >> 5), rr = r & 15, cc = c & 31, ob = rr * 64 + cc * 2; return st * 1024 + (ob ^ (((ob >> 9) & 1) << 5)); }
__host__ __device__ __forceinline__ void stage_rc(int b, int& R, int& C) { const int st = b / 1024, sb = b % 1024, swz = sb ^ (((sb >> 9) & 1) << 5); R = (st >> 1) * 16 + swz / 64; C = (st & 1) * 32 + (swz % 64) / 2; }
__host__ __device__ __forceinline__ int perm32(int rho) { const int n = rho >> 4, i = rho & 15; return 8 * (i >> 2) + 4 * n + (i & 3); }
struct Unit { int pm, pn; };
struct Gemm { const char* A; const bf16_t* Bt; int M, N, K; int lda; int jkt; int jbytes; };
struct StaticOrder {
    int nM, nN, nwg, G, c;
    __host__ __device__ void init(int M, int N, int G_, int c_) { nM = M / BM; nN = N / BM; nwg = nM * nN; G = G_; c = c_; }
    __host__ __device__ bool next(int i, Unit& u) const {
        const long L = (long)i * G + c; if (L >= nwg) return false;
        int wgid = (int)L; { const int q = nwg / NXCD, r = nwg % NXCD, xcd = wgid % NXCD, off = wgid / NXCD; wgid = (xcd < r ? xcd * (q + 1) : r * (q + 1) + (xcd - r) * q) + off; }
        const int nig = WGM * nN, gid = wgid / nig, fm = gid * WGM, gsz = (nM - fm) < WGM ? (nM - fm) : WGM;
        u.pm = fm + ((wgid % nig) % gsz); u.pn = (wgid % nig) / gsz; return true;
    }
};

struct EpiZ {
    static constexpr bool PERM = true;
    bf16_t* O; int ldc;
    __device__ __forceinline__ void operator()(const f32x4 (&acc)[2][2][4][2], const Unit& u, int wr, int wc, int fr, int fq) const {
        const int row0 = u.pm * BM + wr * 64 + fr, col0 = u.pn * BM + wc * 32 + 8 * fq;
#pragma unroll
        for (int ai = 0; ai < 2; ++ai)
#pragma unroll
            for (int m = 0; m < 4; ++m) { bf16_t* rowp = O + (size_t)(row0 + ai * HALF + m * 16) * ldc + col0;
#pragma unroll
                for (int bj = 0; bj < 2; ++bj) { const f32x4 v0 = acc[ai][bj][m][0], v1 = acc[ai][bj][m][1];
                    u32x4 w; w.x = cvt_pk_bf16(v0[0], v0[1]); w.y = cvt_pk_bf16(v0[2], v0[3]); w.z = cvt_pk_bf16(v1[0], v1[1]); w.w = cvt_pk_bf16(v1[2], v1[3]);
                    *(u32x4*)(rowp + bj * HALF) = w; } }
    }
};
struct EpiOut {
    static constexpr bool PERM = true;
    const float* xp; const float* xs; float* out; bf16_t* Z; float* rowsq;
    __device__ __forceinline__ void operator()(const f32x4 (&acc)[2][2][4][2], const Unit& u, int wr, int wc, int fr, int fq) const {
        const int col0 = u.pn * BM + wc * 32 + 8 * fq;
#pragma unroll
        for (int ai = 0; ai < 2; ++ai)
#pragma unroll
            for (int m = 0; m < 4; ++m) { const int r = u.pm * BM + ai * HALF + wr * 64 + m * 16 + fr;
                const float* xr = (r < SP ? xp + (size_t)r * DM : xs + (size_t)(r - SP) * DM) + col0; bf16_t* zr = Z + (size_t)r * ZP + ZXN2 + col0;
                float ss = 0.f;
#pragma unroll
                for (int bj = 0; bj < 2; ++bj) { const f32x4 x0 = *(const f32x4*)(xr + bj * HALF), x1 = *(const f32x4*)(xr + bj * HALF + 4);
                    const f32x4 o0 = x0 + acc[ai][bj][m][0], o1 = x1 + acc[ai][bj][m][1];
                    ss += ((o0[0] * o0[0] + o0[1] * o0[1]) + (o0[2] * o0[2] + o0[3] * o0[3])) + ((o1[0] * o1[0] + o1[1] * o1[1]) + (o1[2] * o1[2] + o1[3] * o1[3]));
                    u32x4 w; w.x = cvt_pk_bf16(o0[0], o0[1]); w.y = cvt_pk_bf16(o0[2], o0[3]); w.z = cvt_pk_bf16(o1[0], o1[1]); w.w = cvt_pk_bf16(o1[2], o1[3]); *(u32x4*)(zr + bj * HALF) = w; }
                ss += __shfl_xor(ss, 16); ss += __shfl_xor(ss, 32);
                if (fq == 0) rowsq[(size_t)r * 16 + u.pn * 4 + wc] = ss;
                if (m & 1) asm volatile("" ::: "memory"); }
    }
};
struct EpiUp {
    static constexpr bool PERM = true;
    char* H; const float* rowsq; int row_off;
    __device__ __forceinline__ void operator()(const f32x4 (&acc)[2][2][4][2], const Unit& u, int wr, int wc, int fr, int fq) const {
        const int row0 = u.pm * BM + wr * 64 + fr, col0 = u.pn * BM + wc * 32 + 8 * fq;
#pragma unroll
        for (int ai = 0; ai < 2; ++ai)
#pragma unroll
            for (int m = 0; m < 4; ++m) { const int r = row0 + ai * HALF + m * 16; const f32x4* rq = (const f32x4*)(rowsq + (size_t)(row_off + r) * 16);
                const f32x4 q0 = rq[0], q1 = rq[1], q2 = rq[2], q3 = rq[3];
                const float ssum = ((q0[0] + q0[1]) + (q0[2] + q0[3])) + ((q1[0] + q1[1]) + (q1[2] + q1[3])) + ((q2[0] + q2[1]) + (q2[2] + q2[3])) + ((q3[0] + q3[1]) + (q3[2] + q3[3]));
                const float rstd = __builtin_amdgcn_rsqf(ssum * (1.0f / DM) + NORM_EPS);
                char* rowp = H + (size_t)r * 13312;
#pragma unroll
                for (int bj = 0; bj < 2; ++bj) { const int c = col0 + bj * HALF; f32x4 v0 = acc[ai][bj][m][0] * rstd, v1 = acc[ai][bj][m][1] * rstd;
#pragma unroll
                    for (int e = 0; e < 4; ++e) { const float a = fmaxf(v0[e], 0.f), b = fmaxf(v1[e], 0.f); v0[e] = a * a; v1[e] = b * b; }
                    u32x4 w; w.x = cvt_pk_bf16(v0[0], v0[1]); w.y = cvt_pk_bf16(v0[2], v0[3]); w.z = cvt_pk_bf16(v1[0], v1[1]); w.w = cvt_pk_bf16(v1[2], v1[3]);
                    *(u32x4*)(rowp + (size_t)c * 2 + (c >= 2048 ? 2560 : 0)) = w; } }
    }
};
struct EpiDown {
    static constexpr bool PERM = true;
    float* out; const bf16_t* Z; int row_off;
    __device__ __forceinline__ void operator()(const f32x4 (&acc)[2][2][4][2], const Unit& u, int wr, int wc, int fr, int fq) const {
        const int col0 = u.pn * BM + wc * 32 + 8 * fq;
#pragma unroll
        for (int ai = 0; ai < 2; ++ai)
#pragma unroll
            for (int m = 0; m < 4; ++m) { const int r = row_off + u.pm * BM + ai * HALF + wr * 64 + m * 16 + fr; float* orow = out + (size_t)r * DM + col0; const bf16_t* zr = Z + (size_t)r * ZP + ZXN2 + col0;
#pragma unroll
                for (int bj = 0; bj < 2; ++bj) { const u32x4 xw = *(const u32x4*)(zr + bj * HALF);
                    const f32x4 x0 = {bflo(xw[0]), bfhi(xw[0]), bflo(xw[1]), bfhi(xw[1])}, x1 = {bflo(xw[2]), bfhi(xw[2]), bflo(xw[3]), bfhi(xw[3])};
                    *(f32x4*)(orow + bj * HALF) = x0 + acc[ai][bj][m][0]; *(f32x4*)(orow + bj * HALF + 4) = x1 + acc[ai][bj][m][1]; }
                if (m & 1) asm volatile("" ::: "memory"); }
    }
};

template <class Epi, class Sched, bool ALIGN_EPI>
__device__ __forceinline__ void gemm_phase(LAS unsigned char* lds, const Gemm g, const Sched& S, const Epi& E) {
    int tid_ = threadIdx.x; asm volatile("" : "+v"(tid_));
    const int tid = tid_, wid = __builtin_amdgcn_readfirstlane(tid >> 6), lane = tid & 63, wr = wid >> 2, wc = wid & 3, fr = lane & 15, fq = lane >> 4;
    const int K = g.K, nt = K / BK;
    unsigned voffA[2], voffB[2];
#pragma unroll
    for (int i = 0; i < 2; ++i) { int R, C; stage_rc(tid * 16 + i * 8192, R, C); const int Rb = Epi::PERM ? ((R & ~31) + perm32(R & 31)) : R;
        voffA[i] = (unsigned)(R * g.lda + C * 2); voffB[i] = (unsigned)(Rb * K + C) * 2u; }
    const size_t kstep = (size_t)(BK * 2);
    const size_t hstepA = (size_t)HALF * g.lda, tstepA = 2 * hstepA;
    const size_t hstepB = (size_t)HALF * K * 2, tstepB = 2 * hstepB;
    const unsigned ldsw = (unsigned)wid * 1024u;
    const int aoff = lds_byte(wr * 64 + fr, fq * 8), boff = lds_byte(wc * 32 + fr, fq * 8);
#define PG8_AOFF(kt) ((size_t)(kt) * kstep + ((kt) >= g.jkt ? (size_t)g.jbytes : (size_t)0))
#define PG8_SA(b, h) (((b) * 2 + (h)) * HTB)
#define PG8_SB(b, h) ((4 + (b) * 2 + (h)) * HTB)
#define PG8_STAGE(bufoff, gbase, voff) do { _Pragma("unroll") for (int _i = 0; _i < 2; ++_i) \
        __builtin_amdgcn_global_load_lds((const unsigned*)((const char*)(gbase) + (voff)[_i]), (LAS unsigned*)(lds + (bufoff) + ldsw + _i * 8192), 16, 0, 0); } while (0)
#define PG8_LDA(dst, b, h) do { _Pragma("unroll") for (int m = 0; m < 4; ++m) _Pragma("unroll") for (int k = 0; k < 2; ++k) dst[m][k] = *(const LAS bf16x8*)(lds + PG8_SA(b, h) + aoff + m * 2048 + k * 1024); } while (0)
#define PG8_LDB(dst, b, h) do { _Pragma("unroll") for (int n = 0; n < 2; ++n) _Pragma("unroll") for (int k = 0; k < 2; ++k) dst[n][k] = *(const LAS bf16x8*)(lds + PG8_SB(b, h) + boff + n * 2048 + k * 1024); } while (0)
#define PG8_MMA(ai, bj, At, Bt) do { __builtin_amdgcn_s_setprio(1); _Pragma("unroll") for (int m = 0; m < 4; ++m) _Pragma("unroll") for (int n = 0; n < 2; ++n) _Pragma("unroll") for (int k = 0; k < 2; ++k) \
        acc[ai][bj][m][n] = __builtin_amdgcn_mfma_f32_16x16x32_bf16(Bt[n][k], At[m][k], acc[ai][bj][m][n], 0, 0, 0); __builtin_amdgcn_s_setprio(0); } while (0)
#define PG8_WAIT_V(n) asm volatile("s_waitcnt vmcnt(" #n ")" ::: "memory")
#define PG8_WAIT_L(n) asm volatile("s_waitcnt lgkmcnt(" #n ")" ::: "memory")
#define PG8_BAR __builtin_amdgcn_s_barrier()
#define PG8_SCHED __builtin_amdgcn_sched_barrier(0)
    Unit cur, nxt; int ui = 0;
    if (!S.next(0, cur)) return;
    f32x4 acc[2][2][4][2];
#pragma unroll
    for (int a = 0; a < 2; ++a)
#pragma unroll
        for (int b = 0; b < 2; ++b)
#pragma unroll
            for (int m = 0; m < 4; ++m)
#pragma unroll
                for (int n = 0; n < 2; ++n) acc[a][b][m][n] = (f32x4){0.f, 0.f, 0.f, 0.f};
    bf16x8 At[4][2], B0[2][2], B1[2][2];
    const char* cA = g.A + (size_t)cur.pm * tstepA; const char* cB = (const char*)g.Bt + (size_t)cur.pn * tstepB;
    {
        PG8_STAGE(PG8_SB(0, 0), cB, voffB); PG8_STAGE(PG8_SB(0, 1), cB + hstepB, voffB); PG8_STAGE(PG8_SA(0, 0), cA + PG8_AOFF(0), voffA); PG8_STAGE(PG8_SA(0, 1), cA + hstepA + PG8_AOFF(0), voffA);
        if (wr == 1) PG8_BAR;
        PG8_WAIT_V(2); PG8_BAR;
        PG8_STAGE(PG8_SB(1, 0), cB + kstep, voffB); PG8_STAGE(PG8_SA(1, 0), cA + PG8_AOFF(1), voffA); PG8_STAGE(PG8_SB(1, 1), cB + hstepB + kstep, voffB);
        PG8_WAIT_V(6); PG8_BAR;
    }
    for (;;) {
        const bool has_next = S.next(ui + 1, nxt);
        const char* nA = has_next ? g.A + (size_t)nxt.pm * tstepA : cA; const char* nB = has_next ? (const char*)g.Bt + (size_t)nxt.pn * tstepB : cB;
        for (int t = 0; t < nt; t += 2) {
            const bool last = (t == nt - 2);
            const char* a1 = cA + PG8_AOFF(t + 1);
            const char* a2 = last ? nA + PG8_AOFF(0) : cA + PG8_AOFF(t + 2); const char* b2 = last ? nB : cB + (size_t)(t + 2) * kstep;
            const char* a3 = last ? nA + PG8_AOFF(1) : cA + PG8_AOFF(t + 3); const char* b3 = b2 + kstep;
            PG8_LDB(B0, 0, 0); PG8_LDB(B1, 0, 1); PG8_SCHED; PG8_LDA(At, 0, 0); PG8_STAGE(PG8_SA(1, 1), a1 + hstepA, voffA);
            PG8_WAIT_V(8); PG8_WAIT_L(0); PG8_BAR; PG8_MMA(0, 0, At, B0); PG8_MMA(0, 1, At, B1); PG8_BAR; PG8_SCHED;
            PG8_LDA(At, 0, 1); PG8_STAGE(PG8_SB(0, 0), b2, voffB); PG8_STAGE(PG8_SB(0, 1), b2 + hstepB, voffB); PG8_STAGE(PG8_SA(0, 0), a2, voffA);
            PG8_WAIT_V(8); PG8_WAIT_L(0); PG8_BAR; PG8_MMA(1, 0, At, B0); PG8_MMA(1, 1, At, B1); PG8_BAR; PG8_SCHED;
            PG8_LDB(B0, 1, 0); PG8_LDB(B1, 1, 1); PG8_SCHED; PG8_LDA(At, 1, 0); PG8_STAGE(PG8_SA(0, 1), a2 + hstepA, voffA);
            PG8_WAIT_V(8); PG8_WAIT_L(0); PG8_BAR; PG8_MMA(0, 0, At, B0); PG8_MMA(0, 1, At, B1); PG8_BAR; PG8_SCHED;
            PG8_LDA(At, 1, 1); PG8_STAGE(PG8_SB(1, 0), b3, voffB); PG8_STAGE(PG8_SB(1, 1), b3 + hstepB, voffB); PG8_STAGE(PG8_SA(1, 0), a3, voffA);
            PG8_WAIT_V(8); PG8_WAIT_L(0); PG8_BAR; PG8_MMA(1, 0, At, B0); PG8_MMA(1, 1, At, B1); PG8_BAR; PG8_SCHED;
        }
        if constexpr (ALIGN_EPI) { if (wr == 0) PG8_BAR; }
        E(acc, cur, wr, wc, fr, fq);
        if (!has_next) break;
#pragma unroll
        for (int a = 0; a < 2; ++a)
#pragma unroll
            for (int b = 0; b < 2; ++b)
#pragma unroll
                for (int m = 0; m < 4; ++m)
#pragma unroll
                    for (int n = 0; n < 2; ++n) acc[a][b][m][n] = (f32x4){0.f, 0.f, 0.f, 0.f};
        cur = nxt; cA = nA; cB = nB; ++ui;
        if constexpr (ALIGN_EPI) { if (wr == 1) PG8_BAR; }
    }
    PG8_WAIT_V(0);
    if constexpr (!ALIGN_EPI) { if (wr == 0) PG8_BAR; }
    PG8_BAR;
#undef PG8_AOFF
#undef PG8_SA
#undef PG8_SB
#undef PG8_STAGE
#undef PG8_LDA
#undef PG8_LDB
#undef PG8_MMA
#undef PG8_WAIT_V
#undef PG8_WAIT_L
#undef PG8_BAR
#undef PG8_SCHED
}
}

constexpr int NWAVES = 8, NTHR = 512;
constexpr int LDS_BYTES = 163840;
struct Args {
    const float* in[27]; float* out; unsigned char* ws; int ph_lo, ph_hi;
};
struct Frame {
    LAS unsigned char* lds; int tid, lane, wave, vcu, G;
};
constexpr int PTRS_OFF = LDS_BYTES - 256;
__device__ __forceinline__ const float* inp(LAS unsigned char* lds, int i) { return *(const float* LAS*)(lds + PTRS_OFF + i * 8); }
__device__ __forceinline__ float gld(const float* p) { return *(const GAS float*)p; }
__device__ __forceinline__ int seq_row0(int q) { return q == 0 ? 0 : SP + (q - 1) * SS; }
__device__ __forceinline__ int seq_len(int q) { return q == 0 ? SP : SS; }

__device__ __forceinline__ void p0_transpose_item(const float* W, int K, int N, bf16_t* WT, const float* kscale, LAS float* scr, int item, int lane) {
    const int nblk = N / 32, kb = item / nblk, nb = item % nblk, k0 = 64 * kb, n0 = 32 * nb;
    {
        float v[32];
#pragma unroll
        for (int i = 0; i < 32; ++i) { const int kk = 2 * i + (lane >> 5); v[i] = W[(size_t)(k0 + kk) * N + n0 + (lane & 31)]; }
        if (kscale) {
#pragma unroll
            for (int i = 0; i < 32; ++i) v[i] *= kscale[k0 + 2 * i + (lane >> 5)]; }
#pragma unroll
        for (int i = 0; i < 32; ++i) scr[(2 * i + (lane >> 5)) * 33 + (lane & 31)] = v[i];
    }
    LDS_WAIT(); asm volatile("" ::: "memory");
    const int c = lane & 7;
#pragma unroll
    for (int j = 0; j < 4; ++j) { const int n = (lane >> 3) + 8 * j; const LAS float* s = scr + (8 * c) * 33 + n;
        u32x4 o; o.x = cvt_pk_bf16(s[0 * 33], s[1 * 33]); o.y = cvt_pk_bf16(s[2 * 33], s[3 * 33]); o.z = cvt_pk_bf16(s[4 * 33], s[5 * 33]); o.w = cvt_pk_bf16(s[6 * 33], s[7 * 33]);
        *(u32x4*)(WT + (size_t)(n0 + n) * K + k0 + 8 * c) = o; }
    LDS_WAIT(); asm volatile("" ::: "memory");
}
__device__ __forceinline__ void p0_prologue(const Frame& F, const Args& a) {
    LAS float* scr = (LAS float*)(F.lds + F.wave * 16384);
    const int gw = F.vcu * NWAVES + F.wave, NGW = F.G * NWAVES;
    unsigned char* ws = a.ws;
    constexpr int I_IN = (DM / 64) * (ZP / 32), I_O = (DM / 64) * (DM / 32), I_1 = (DM / 64) * (DFF / 32), I_2 = (DFF / 64) * (DM / 32);
    for (int it = gw; it < I_IN + I_O + I_1 + I_2; it += NGW) {
        int r = it;
        if (r < I_IN) { p0_transpose_item(a.in[3], DM, ZP, (bf16_t*)(ws + WS_WIN), nullptr, scr, r, F.lane); continue; } r -= I_IN;
        if (r < I_O) { p0_transpose_item(a.in[23], DM, DM, (bf16_t*)(ws + WS_WOUT), nullptr, scr, r, F.lane); continue; } r -= I_O;
        if (r < I_1) { p0_transpose_item(a.in[25], DM, DFF, (bf16_t*)(ws + WS_W1), a.in[24], scr, r, F.lane); continue; } r -= I_1;
        p0_transpose_item(a.in[26], DFF, DM, (bf16_t*)(ws + WS_W2), nullptr, scr, r, F.lane);
    }
    bf16_t* XN = (bf16_t*)a.out; const float* g1 = a.in[2];
    for (int m = gw; m < MTOK; m += 4 * NGW) {
        f32x4 v[4][4]; float ss[4];
#pragma unroll
        for (int r = 0; r < 4; ++r) { int mr = m + r * NGW; mr = mr < MTOK ? mr : MTOK - 1;
            const float* xrow = mr < SP ? a.in[0] + (size_t)mr * DM : a.in[1] + (size_t)(mr - SP) * DM;
#pragma unroll
            for (int j = 0; j < 4; ++j) v[r][j] = ((const f32x4*)xrow)[F.lane + 64 * j]; }
#pragma unroll
        for (int r = 0; r < 4; ++r) { float s0 = 0.f;
#pragma unroll
            for (int j = 0; j < 4; ++j) s0 += (v[r][j][0] * v[r][j][0] + v[r][j][1] * v[r][j][1]) + (v[r][j][2] * v[r][j][2] + v[r][j][3] * v[r][j][3]);
            ss[r] = __builtin_amdgcn_rsqf(wave_sum_dpp(s0) * (1.f / DM) + NORM_EPS); }
#pragma unroll
        for (int j = 0; j < 4; ++j) { const f32x4 gv = ((const f32x4*)g1)[F.lane + 64 * j];
#pragma unroll
            for (int r = 0; r < 4; ++r) { const int mr = m + r * NGW;
                if (mr < MTOK) { u32x2 w; w.x = cvt_pk_bf16(v[r][j][0] * ss[r] * gv[0], v[r][j][1] * ss[r] * gv[1]); w.y = cvt_pk_bf16(v[r][j][2] * ss[r] * gv[2], v[r][j][3] * ss[r] * gv[3]);
                    ((u32x2*)(XN + (size_t)mr * DM))[F.lane + 64 * j] = w; } } }
    }
    const int gt = F.vcu * NTHR + F.tid, NGT = F.G * NTHR;
    float* rope = (float*)(ws + WS_ROPE);
    for (int e = gt; e < SP * 32; e += NGT) { const int pos = e >> 5, i = e & 31;
        const float invf = 1.0f / powf(10000.0f, (float)(2 * i) / 64.0f); const float ang = (float)pos * invf; float sn, cs; sincosf(ang, &sn, &cs);
        rope[2 * e] = cs; rope[2 * e + 1] = sn; }
    bf16_t* wupT = (bf16_t*)(ws + WS_LORA); bf16_t* aupT = wupT + 2 * 512 * 64; bf16_t* gupT = aupT + 2 * 512 * 64;
    for (int e = gt; e < 2 * 512 * 64; e += NGT) { const int d = e >> 15, c = (e >> 6) & 511, r = e & 63;
        wupT[e] = f2bf(a.in[14][((size_t)d * 64 + r) * 512 + c]); aupT[e] = f2bf(a.in[16][((size_t)d * 64 + r) * 512 + c]); }
    for (int e = gt; e < 512 * 128; e += NGT) { const int c = e >> 7, r = e & 127; gupT[e] = f2bf(a.in[17][(size_t)r * 512 + c]); }
}

__device__ __forceinline__ void qk_prep(const Frame& F, const Args& a) {
    const int gw = F.vcu * NWAVES + F.wave, NGW = F.G * NWAVES;
    bf16_t* Z = (bf16_t*)(a.ws + WS_Z); const float* rope = (const float*)(a.ws + WS_ROPE);
    const int g = F.lane >> 2, qd = F.lane & 3;
    const float* gain = (g < 8) ? a.in[4] : a.in[5];
    float glo[8], ghi[8];
#pragma unroll
    for (int j = 0; j < 8; ++j) { glo[j] = gain[8 * qd + j]; ghi[j] = gain[32 + 8 * qd + j]; }
    const float osc = (g < 8) ? QSCALE : 1.0f;
    const float mpw = a.in[11][ZWD - ZRR + F.lane], mnw = a.in[12][ZWD - ZRR + F.lane], mpa = a.in[11][ZAD - ZRR + F.lane], mna = a.in[12][ZAD - ZRR + F.lane];
    for (int blk = gw; blk < MTOK / 16; blk += NGW) {
        const int m0 = blk * 16;
        const int pos0 = m0 < SP ? m0 : ((m0 - SP) & (SS - 1)); const int S = m0 < SP ? SP : SS;
        {
            float zw[18], za[18]; const bf16_t* zr = Z + (size_t)m0 * ZP; const int j = F.lane;
#pragma unroll
            for (int i = 0; i < 18; ++i) { const int pp = pos0 - 1 + i; const bool ok = pp >= 0 && pp < S; const long ro = (long)(ok ? i - 1 : 0) * ZP;
                const float w_ = bf2f(zr[ro + ZWD + j]), a_ = bf2f(zr[ro + ZAD + j]); zw[i] = ok ? w_ : 0.f; za[i] = ok ? a_ : 0.f; }
            bf16_t* e1 = (bf16_t*)(a.ws + WS_E1) + (size_t)m0 * 128;
#pragma unroll
            for (int i = 0; i < 16; ++i) { const float wc = zw[i + 1], ac = za[i + 1];
                const float ws_ = wc + mpw * (zw[i] - wc) + mnw * (zw[i + 2] - wc), as_ = ac + mpa * (za[i] - ac) + mna * (za[i + 2] - ac);
                e1[i * 128 + j] = f2bf(1.0f - 2.0f * __builtin_amdgcn_rcpf(__expf(2.0f * ws_) + 1.0f)); e1[i * 128 + 64 + j] = f2bf(as_); }
        }
#pragma unroll 4
        for (int i = 0; i < 16; ++i) {
            const int m = m0 + i, pos = pos0 + i;
            bf16_t* p = Z + (size_t)m * ZP + g * 64 + 8 * qd;
            const u32x4 lo4 = *(const u32x4*)p, hi4 = *(const u32x4*)(p + 32);
            float lo[8], hi[8];
#pragma unroll
            for (int j = 0; j < 4; ++j) { lo[2 * j] = bflo(lo4[j]); lo[2 * j + 1] = bfhi(lo4[j]); hi[2 * j] = bflo(hi4[j]); hi[2 * j + 1] = bfhi(hi4[j]); }
            float ss = 0.f;
#pragma unroll
            for (int j = 0; j < 8; ++j) ss += lo[j] * lo[j] + hi[j] * hi[j];
            ss += __shfl_xor(ss, 1); ss += __shfl_xor(ss, 2);
            const float rstd = __builtin_amdgcn_rsqf(ss * (1.f / 64.f) + NORM_EPS);
            const f32x4* rp = (const f32x4*)(rope + ((size_t)pos * 32 + 8 * qd) * 2);
            float ol[8], oh[8];
#pragma unroll
            for (int j2 = 0; j2 < 4; ++j2) { const f32x4 cs = rp[j2];
#pragma unroll
                for (int e = 0; e < 2; ++e) { const int j = 2 * j2 + e; const float c = cs[2 * e], sn = cs[2 * e + 1]; const float l = lo[j] * rstd * glo[j], h = hi[j] * rstd * ghi[j];
                    ol[j] = (l * c - h * sn) * osc; oh[j] = (h * c + l * sn) * osc; } }
            u32x4 wl, wh;
#pragma unroll
            for (int j = 0; j < 4; ++j) { wl[j] = cvt_pk_bf16(ol[2 * j], ol[2 * j + 1]); wh[j] = cvt_pk_bf16(oh[2 * j], oh[2 * j + 1]); }
            *(u32x4*)p = wl; *(u32x4*)(p + 32) = wh;
        }
    }
}

namespace att {
constexpr int KSLOT = 8192, VSLOT = 16384, NKS = 4, NVS = 3;
constexpr int L_K = 0, L_V = NKS * KSLOT, L_WS = L_V + NVS * VSLOT, L_ST = L_WS + NWAVES * 256, L_END = L_ST + NWAVES * 8192;
static_assert(L_END <= PTRS_OFF, "attention lds");
__device__ __forceinline__ int crow(int r, int hi) { return (r & 3) + 8 * (r >> 2) + 4 * hi; }
__device__ __forceinline__ void glds16(const void* gsrc, unsigned lds_dst) { unsigned keep;
    asm volatile("s_mov_b32 %0, m0\n\ts_mov_b32 m0, %2\n\ts_nop 0\n\tglobal_load_lds_dwordx4 %1, off\n\ts_mov_b32 m0, %0" : "=&s"(keep) : "v"(gsrc), "s"(lds_dst) : "memory"); }
typedef short v4i16_t __attribute__((ext_vector_type(4)));
typedef const LAS char* lds_cptr;
__device__ __forceinline__ s16x4 vtr(lds_cptr p) { return __builtin_bit_cast(s16x4, __builtin_amdgcn_ds_read_tr16_b64_v4i16((LAS v4i16_t*)p)); }
#define SBAR() __builtin_amdgcn_sched_barrier(0)
#define WAIT_BAR(N) asm volatile("s_waitcnt vmcnt(" #N ") lgkmcnt(0)\n\ts_barrier" ::: "memory")
__device__ __forceinline__ void kload8(bf16x8* kf, lds_cptr kp) {
    kf[0] = *(const LAS bf16x8*)(kp);        kf[1] = *(const LAS bf16x8*)(kp + 512);
    kf[2] = *(const LAS bf16x8*)(kp + 2048); kf[3] = *(const LAS bf16x8*)(kp + 2560);
    kf[4] = *(const LAS bf16x8*)(kp + 4096); kf[5] = *(const LAS bf16x8*)(kp + 4608);
    kf[6] = *(const LAS bf16x8*)(kp + 6144); kf[7] = *(const LAS bf16x8*)(kp + 6656);
}
__device__ __forceinline__ void kload2(bf16x8* kf, lds_cptr kp, int j) { kf[2 * j] = *(const LAS bf16x8*)(kp + j * 2048); kf[2 * j + 1] = *(const LAS bf16x8*)(kp + j * 2048 + 512); }

__device__ __forceinline__ void attn_unit(int row0, int S, int h, int qb, bf16_t* Z, LAS unsigned char* shm, float lam, const float* subln_g, bf16_t* Ob, int opitch) {
    int tid_ = threadIdx.x; asm volatile("" : "+v"(tid_));
    const int tid = tid_, lane = tid & 63, r32 = lane & 31, hi = lane >> 5; const int wid = __builtin_amdgcn_readfirstlane(tid >> 6);
    const unsigned lds0 = (unsigned)(uintptr_t)shm;
    LAS float* wsf = (LAS float*)(shm + L_WS) + wid * 64;
    LAS bf16_t* stash = (LAS bf16_t*)(shm + L_ST) + wid * 4096;
    const int NT = S / 64;
    const size_t qrow = (size_t)(row0 + qb * 256 + wid * 32);
    const lds_cptr shm3 = (lds_cptr)shm;
    const lds_cptr kp0 = shm3 + L_K + hi * 1024 + r32 * 16;
    const lds_cptr vp0 = shm3 + L_V + ((lane >> 4) & 1) * 32 + (lane & 3) * 8 + (4 * hi + ((lane & 15) >> 2)) * 64;
    f32x16 o[4];
#pragma unroll 1
    for (int c = 0; c < 2; ++c) {
        const bf16_t* Qw = Z + qrow * ZP + ZQ + h * 128 + c * 64;
        const bf16_t* Kh = Z + (size_t)row0 * ZP + ZK + h * 128 + c * 64;
        const bf16_t* Vh = Z + (size_t)row0 * ZP + ZV + h * 128;
        const int p0 = 2 * wid, p1 = 2 * wid + 1;
        const unsigned koff = (unsigned)(lane * ZP + wid * 8) * 2u;
        const unsigned voff0 = (unsigned)((16 * (p0 & 3) + (lane >> 2)) * ZP + (p0 >> 2) * 32 + (lane & 3) * 8) * 2u;
        const unsigned voff1 = (unsigned)((16 * (p1 & 3) + (lane >> 2)) * ZP + (p1 >> 2) * 32 + (lane & 3) * 8) * 2u;
        const unsigned kdst = lds0 + L_K + wid * 1024, vdst0 = lds0 + L_V + p0 * 1024, vdst1 = lds0 + L_V + p1 * 1024;
#define DMA_K(t, si) glds16((const char*)(Kh + (size_t)(t) * 64 * ZP) + koff, (unsigned)__builtin_amdgcn_readfirstlane(kdst + (si) * KSLOT))
#define DMA_V(t, si) do { const char* vb_ = (const char*)(Vh + (size_t)(t) * 64 * ZP); glds16(vb_ + voff0, (unsigned)__builtin_amdgcn_readfirstlane(vdst0 + (si) * VSLOT)); glds16(vb_ + voff1, (unsigned)__builtin_amdgcn_readfirstlane(vdst1 + (si) * VSLOT)); } while (0)
        DMA_K(0, 0); DMA_V(0, 0); DMA_K(1, 1);
        bf16x8 qr[4];
#pragma unroll
        for (int d0 = 0; d0 < 4; ++d0) qr[d0] = *(const bf16x8*)(Qw + (size_t)r32 * ZP + d0 * 16 + hi * 8);
#pragma unroll
        for (int d0 = 0; d0 < 4; ++d0) o[d0] = f32x16{};
        float l_reg = 0.f;
        bf16x8 kf[4];
        f32x16 pA0, pA1, pB0, pB1;
        int i_prev = 0, i_cur = 0, i_next = 1;
        int k_cur = 0, k_next = 1;
#define ROT() do { i_prev = i_cur; i_cur = i_next; i_next = (i_next == NVS - 1) ? 0 : i_next + 1; k_cur = k_next; k_next = (k_next + 1) & 3; } while (0)
#define KFRAG(slot, i) (*(const LAS bf16x8*)(kp0 + (slot) * KSLOT + ((i) >> 1) * 2048 + ((i) & 1) * 512))
        DMA_K(2, 2);
        WAIT_BAR(4);
        {
            const lds_cptr kb = kp0;
            pA0 = f32x16{}; pA1 = f32x16{};
#pragma unroll
            for (int d0 = 0; d0 < 4; ++d0) { const bf16x8 b0 = *(const LAS bf16x8*)(kb + d0 * 2048), b1 = *(const LAS bf16x8*)(kb + d0 * 2048 + 512);
                pA0 = __builtin_amdgcn_mfma_f32_32x32x16_bf16(b0, qr[d0], pA0, 0, 0, 0); pA1 = __builtin_amdgcn_mfma_f32_32x32x16_bf16(b1, qr[d0], pA1, 0, 0, 0); }
#pragma unroll
            for (int r = 0; r < 16; ++r) { pA0[r] = __builtin_amdgcn_exp2f(pA0[r]); pA1[r] = __builtin_amdgcn_exp2f(pA1[r]); }
        }
        WAIT_BAR(0);
        DMA_K(3, 3); DMA_V(1, 1);
        ROT();
        kf[0] = KFRAG(k_cur, 0); kf[1] = KFRAG(k_cur, 1); kf[2] = KFRAG(k_cur, 2); kf[3] = KFRAG(k_cur, 3);
        WAIT_BAR(3);
        s16x4 vlo[4], vhi[4]; u32x4 pw0, pw1, pw2, pw3;
#define PKW(P, B) cvt_pk_bf16(P[B], P[B + 1])
#define PAF(k) __builtin_bit_cast(bf16x8, pw##k)
#define VFR(i) (bf16x8){vlo[i][0], vlo[i][1], vlo[i][2], vlo[i][3], vhi[i][0], vhi[i][1], vhi[i][2], vhi[i][3]}
#define PIN(x) asm volatile("" : "+v"(x))
#define EX(v) __builtin_amdgcn_exp2f(v)
#define VRD(slot, f) do { vlo[slot] = vtr(vp_ + (((f) & 3) * 4096 + ((f) >> 2) * 1024)); vhi[slot] = vtr(vp_ + (((f) & 3) * 4096 + ((f) >> 2) * 1024 + 512)); } while (0)
#define GAPA(MF, LDX, A0, A1, A2, A3, W0, W1, PW) do { MF; LDX; sacc += A0; sacc += A1; sacc += A2; sacc += A3; PIN(sacc); W0; W1; PIN(PW); SBAR(); } while (0)
#define GAPB(MF, LDX, X, B) do { MF; LDX; X[B] = EX(X[B]); X[B + 1] = EX(X[B + 1]); PIN(X); SBAR(); } while (0)
#define PVM(f) o[(f) & 3] = __builtin_amdgcn_mfma_f32_32x32x16_bf16(__builtin_bit_cast(bf16x8, (f) < 4 ? pw0 : (f) < 8 ? pw1 : (f) < 12 ? pw2 : pw3), VFR((f) & 3), o[(f) & 3], 0, 0, 0)
#define NOP_ do { } while (0)
#if PROBE_ATT
#define ATT_T(k) do { if (PROBE_ATT == (k)) { const unsigned long long n_ = __builtin_amdgcn_s_memrealtime(); if (tid == 0) *(LAS unsigned long long*)(shm + PTRS_OFF - 64) += n_ - att_t0; } } while (0)
#define ATT_T0() const unsigned long long att_t0 = __builtin_amdgcn_s_memrealtime()
#else
#define ATT_T(k) do { } while (0)
#define ATT_T0() do { } while (0)
#endif
#define STEP(C0, C1, P0, P1, t, GK, GV, GL) do { SBAR(); \
        const lds_cptr vp_ = vp0 + i_prev * VSLOT; \
        float sacc = (P0[0] + P0[1]); \
        GAPA(C0 = __builtin_amdgcn_mfma_f32_32x32x16_bf16(kf[0], qr[0], (f32x16){}, 0, 0, 0), kf[0] = KFRAG(k_cur, 4), P0[2], P0[3], P0[4], P0[5],     pw0[0] = PKW(P0, 0), pw0[1] = PKW(P0, 2), pw0); \
        GAPA(C1 = __builtin_amdgcn_mfma_f32_32x32x16_bf16(kf[1], qr[0], (f32x16){}, 0, 0, 0), kf[1] = KFRAG(k_cur, 5), P0[6], P0[7], P0[8], P0[9],     pw0[2] = PKW(P0, 4), pw0[3] = PKW(P0, 6), pw0); \
        GAPA(C0 = __builtin_amdgcn_mfma_f32_32x32x16_bf16(kf[2], qr[1], C0, 0, 0, 0),         kf[2] = KFRAG(k_cur, 6), P0[10], P0[11], P0[12], P0[13], pw1[0] = PKW(P0, 8), pw1[1] = PKW(P0, 10), pw1); \
        GAPA(C1 = __builtin_amdgcn_mfma_f32_32x32x16_bf16(kf[3], qr[1], C1, 0, 0, 0),         kf[3] = KFRAG(k_cur, 7), P0[14], P0[15], P1[0], P1[1],   pw1[2] = PKW(P0, 12), pw1[3] = PKW(P0, 14), pw1); \
        GAPA(C0 = __builtin_amdgcn_mfma_f32_32x32x16_bf16(kf[0], qr[2], C0, 0, 0, 0),         VRD(0, 0), P1[2], P1[3], P1[4], P1[5],     pw2[0] = PKW(P1, 0), pw2[1] = PKW(P1, 2), pw2); \
        GAPA(C1 = __builtin_amdgcn_mfma_f32_32x32x16_bf16(kf[1], qr[2], C1, 0, 0, 0),         VRD(1, 1), P1[6], P1[7], P1[8], P1[9],     pw2[2] = PKW(P1, 4), pw2[3] = PKW(P1, 6), pw2); \
        GAPA(C0 = __builtin_amdgcn_mfma_f32_32x32x16_bf16(kf[2], qr[3], C0, 0, 0, 0),         VRD(2, 2), P1[10], P1[11], P1[12], P1[13], pw3[0] = PKW(P1, 8), pw3[1] = PKW(P1, 10), pw3); \
        GAPA(C1 = __builtin_amdgcn_mfma_f32_32x32x16_bf16(kf[3], qr[3], C1, 0, 0, 0),         VRD(3, 3), P1[14], P1[15], 0.f, 0.f,       pw3[2] = PKW(P1, 12), pw3[3] = PKW(P1, 14), pw3); \
        l_reg += sacc; \
        if (GK) { DMA_K((t) + 3, (k_cur + 3) & 3); } if (GV) { DMA_V((t) + 1, i_next); } \
        SBAR(); \
        GAPB(PVM(0), VRD(0, 4), C0, 0);   GAPB(PVM(1), VRD(1, 5), C0, 2);   GAPB(PVM(2), VRD(2, 6), C0, 4);    GAPB(PVM(3), VRD(3, 7), C0, 6); \
        GAPB(PVM(4), VRD(0, 8), C0, 8);   GAPB(PVM(5), VRD(1, 9), C0, 10);  GAPB(PVM(6), VRD(2, 10), C0, 12);  GAPB(PVM(7), VRD(3, 11), C0, 14); \
        GAPB(PVM(8), VRD(0, 12), C1, 0);  GAPB(PVM(9), VRD(1, 13), C1, 2);  GAPB(PVM(10), VRD(2, 14), C1, 4);  GAPB(PVM(11), VRD(3, 15), C1, 6); \
        GAPB(PVM(12), if (GL) kf[0] = KFRAG(k_next, 0), C1, 8);  GAPB(PVM(13), if (GL) kf[1] = KFRAG(k_next, 1), C1, 10); \
        GAPB(PVM(14), if (GL) kf[2] = KFRAG(k_next, 2), C1, 12); GAPB(PVM(15), if (GL) kf[3] = KFRAG(k_next, 3), C1, 14); \
        } while (0)
        int t = 1;
#pragma unroll 1
        for (; t + 5 < NT; t += 2) {
#if PROBE_ATT == 1
            STEP(pB0, pB1, pA0, pA1, t, true, true, true);     { ATT_T0(); WAIT_BAR(3); ATT_T(1); } ROT();
            STEP(pA0, pA1, pB0, pB1, t + 1, true, true, true); { ATT_T0(); WAIT_BAR(3); ATT_T(1); } ROT();
#elif PROBE_ATT >= 2
            { ATT_T0(); STEP(pB0, pB1, pA0, pA1, t, true, true, true); ATT_T(2); }    WAIT_BAR(3); ROT();
            { ATT_T0(); STEP(pA0, pA1, pB0, pB1, t + 1, true, true, true); ATT_T(2); } WAIT_BAR(3); ROT();
#else
            STEP(pB0, pB1, pA0, pA1, t, true, true, true);     WAIT_BAR(3); ROT();
            STEP(pA0, pA1, pB0, pB1, t + 1, true, true, true); WAIT_BAR(3); ROT();
#endif
        }
#define ENDW(tt) do { if ((tt) + 3 < NT) { WAIT_BAR(3); } else if ((tt) + 2 < NT) { WAIT_BAR(2); } else { WAIT_BAR(0); } } while (0)
#pragma unroll 1
        for (; t + 1 < NT; t += 2) {
            STEP(pB0, pB1, pA0, pA1, t, (t + 3 < NT), (t + 1 < NT), (t + 1 < NT));         ENDW(t);     ROT();
            STEP(pA0, pA1, pB0, pB1, t + 1, (t + 4 < NT), (t + 2 < NT), (t + 2 < NT));     ENDW(t + 1); ROT();
        }
        STEP(pB0, pB1, pA0, pA1, NT - 1, false, false, false);
        {
            float sacc = pB0[0] + pB0[1];
#pragma unroll
            for (int r = 2; r < 16; ++r) sacc += pB0[r];
#pragma unroll
            for (int r = 0; r < 16; ++r) sacc += pB1[r];
            l_reg += sacc;
            pw0 = (u32x4){PKW(pB0, 0), PKW(pB0, 2), PKW(pB0, 4), PKW(pB0, 6)}; pw1 = (u32x4){PKW(pB0, 8), PKW(pB0, 10), PKW(pB0, 12), PKW(pB0, 14)};
            pw2 = (u32x4){PKW(pB1, 0), PKW(pB1, 2), PKW(pB1, 4), PKW(pB1, 6)}; pw3 = (u32x4){PKW(pB1, 8), PKW(pB1, 10), PKW(pB1, 12), PKW(pB1, 14)};
            const lds_cptr vp_ = vp0 + i_cur * VSLOT;
            VRD(0, 0); VRD(1, 1); VRD(2, 2); VRD(3, 3); PVM(0); PVM(1); PVM(2); PVM(3);
            VRD(0, 4); VRD(1, 5); VRD(2, 6); VRD(3, 7); PVM(4); PVM(5); PVM(6); PVM(7);
            VRD(0, 8); VRD(1, 9); VRD(2, 10); VRD(3, 11); PVM(8); PVM(9); PVM(10); PVM(11);
            VRD(0, 12); VRD(1, 13); VRD(2, 14); VRD(3, 15); PVM(12); PVM(13); PVM(14); PVM(15);
        }
#undef DMA_K
#undef DMA_V
#undef ROT
#undef PKW
#undef PAF
#undef VFR
#undef PIN
#undef EX
#undef VRD
#undef GAPA
#undef GAPB
#undef KFRAG
#undef NOP_
#undef PVM
#undef STEP
#undef ENDW
        { auto rr = __builtin_amdgcn_permlane32_swap(__float_as_uint(l_reg), __float_as_uint(l_reg), false, false); l_reg = __uint_as_float(rr[0]) + __uint_as_float(rr[1]); }
        if (hi == 0) wsf[r32] = l_reg;
        LDS_WAIT();
        float rli[16];
#pragma unroll
        for (int r = 0; r < 16; ++r) rli[r] = 1.0f / wsf[crow(r, hi)];
        if (c == 0) {
#pragma unroll
            for (int d0 = 0; d0 < 4; ++d0)
#pragma unroll
                for (int r = 0; r < 16; ++r) stash[(d0 * 16 + r) * 64 + lane] = f2bf(o[d0][r] * rli[r]);
            LDS_WAIT();
        } else {
#pragma unroll
            for (int d0 = 0; d0 < 4; ++d0)
#pragma unroll
                for (int r = 0; r < 16; ++r) o[d0][r] = bf2f(stash[(d0 * 16 + r) * 64 + lane]) - lam * (o[d0][r] * rli[r]);
            LDS_WAIT(); asm volatile("" ::: "memory");
#pragma unroll
            for (int d0 = 0; d0 < 4; ++d0)
#pragma unroll
                for (int r = 0; r < 16; ++r) stash[crow(r, hi) * 128 + d0 * 32 + r32] = f2bf(o[d0][r]);
            LDS_WAIT(); asm volatile("" ::: "memory");
            bf16_t* Ow = Ob + qrow * opitch + ZQ + h * 128;
#pragma unroll
            for (int i = 0; i < 4; ++i) { const int row = i * 8 + (lane >> 3), ch = lane & 7;
                const u32x4 w0 = *(const LAS u32x4*)(stash + row * 128 + ch * 16), w1 = *(const LAS u32x4*)(stash + row * 128 + ch * 16 + 8);
                float v[16];
#pragma unroll
                for (int j = 0; j < 4; ++j) { v[2 * j] = bflo(w0[j]); v[2 * j + 1] = bfhi(w0[j]); v[8 + 2 * j] = bflo(w1[j]); v[9 + 2 * j] = bfhi(w1[j]); }
                float ss = 0.f;
#pragma unroll
                for (int j = 0; j < 16; ++j) ss += v[j] * v[j];
                ss += __shfl_xor(ss, 1); ss += __shfl_xor(ss, 2); ss += __shfl_xor(ss, 4);
                const float rs = (1.0f - LAMBDA_INIT) / sqrtf(ss * (1.f / 128.f) + NORM_EPS);
                u32x4 x0, x1;
#pragma unroll
                for (int j = 0; j < 4; ++j) { x0[j] = cvt_pk_bf16(v[2 * j] * rs * subln_g[ch * 16 + 2 * j], v[2 * j + 1] * rs * subln_g[ch * 16 + 2 * j + 1]);
                                              x1[j] = cvt_pk_bf16(v[8 + 2 * j] * rs * subln_g[ch * 16 + 8 + 2 * j], v[9 + 2 * j] * rs * subln_g[ch * 16 + 9 + 2 * j]); }
                *(u32x4*)(Ow + (size_t)row * opitch + ch * 16) = x0; *(u32x4*)(Ow + (size_t)row * opitch + ch * 16 + 8) = x1; }
            LDS_WAIT();
        }
        asm volatile("s_waitcnt vmcnt(0) lgkmcnt(0)\n\ts_barrier" ::: "memory");
    }
}
#undef SBAR
#undef WAIT_BAR
}

namespace rw {
constexpr int P = 144, MAT = 64 * P;
constexpr int O_AT = 0, O_BT = MAT, O_KT = 2 * MAT, O_RT = 3 * MAT, O_ATT = 4 * MAT, O_VT = 5 * MAT, O_BHT = 6 * MAT, O_KHT = 7 * MAT;
constexpr int O_LAB = 8 * MAT, O_LAK = 9 * MAT, O_ARB = 10 * MAT, O_ARK = 11 * MAT, O_XT = 12 * MAT, O_ABT = 13 * MAT, O_U0T = 14 * MAT;
constexpr int O_LABD = 15 * MAT, O_TII = O_LABD + 4096, O_WC = O_TII + 2048, O_GSUM = O_WC + 256, O_PAR = O_GSUM + 2048, O_END = O_PAR + 960 * 4;
constexpr int O_ZS = 0, PZ = 128;
static_assert(3 * 66 * PZ <= 3 * MAT, "ZS fits At|Bt|Kt");
constexpr int O_TW = O_LAB, O_ADN = O_LAK, O_WL = O_ARB, O_AR = O_XT, PF = 272;
static_assert(O_END <= PTRS_OFF - 64 && 64 * PF <= 2 * MAT, "rwkv lds");
__device__ __forceinline__ int crow(int r, int hi) { return (r & 3) + 8 * (r >> 2) + 4 * hi; }
__device__ __forceinline__ float sigmoidf_(float x) { return __builtin_amdgcn_rcpf(1.0f + __expf(-x)); }
__device__ __forceinline__ float tanhf_(float x) { return 1.0f - 2.0f * __builtin_amdgcn_rcpf(__expf(2.0f * x) + 1.0f); }
__device__ __forceinline__ void load10(const bf16_t* zc, int t_lo, int S, float (&z)[10]) {
#pragma unroll
    for (int i = 0; i < 10; ++i) { const int t = t_lo - 1 + i; z[i] = (t >= 0 && t < S) ? bf2f(zc[(size_t)t * ZP]) : 0.f; }
}
__device__ __forceinline__ float tshift(const float (&z)[10], int u, float mp, float mn) { const float c = z[u + 1]; return c + mp * (z[u] - c) + mn * (z[u + 2] - c); }
__device__ __forceinline__ f32x16 mm_ll(const LAS unsigned char* A, int rowA, const LAS unsigned char* B, int rowB, f32x16 acc, int r32, int hi) {
#pragma unroll
    for (int ks = 0; ks < 4; ++ks) { const bf16x8 a = *(const LAS bf16x8*)(A + (rowA + r32) * P + (16 * ks + 8 * hi) * 2), b = *(const LAS bf16x8*)(B + (rowB + r32) * P + (16 * ks + 8 * hi) * 2);
        acc = __builtin_amdgcn_mfma_f32_32x32x16_bf16(a, b, acc, 0, 0, 0); }
    return acc;
}
__device__ __forceinline__ void store_native(unsigned char* dst, const f32x16& acc, int lane, bool wt) {
    u32x4 w0, w1;
#pragma unroll
    for (int q = 0; q < 4; ++q) { w0[q] = cvt_pk_bf16(acc[2 * q], acc[2 * q + 1]); w1[q] = cvt_pk_bf16(acc[8 + 2 * q], acc[9 + 2 * q]); }
    if (wt) {
        asm volatile("global_store_dwordx4 %0, %1, off sc1\n\tglobal_store_dwordx4 %0, %2, off offset:16 sc1\n\ts_nop 1" :: "v"(dst + lane * 32), "v"(w0), "v"(w1) : "memory");
    } else { *(u32x4*)(dst + lane * 32) = w0; *(u32x4*)(dst + lane * 32 + 16) = w1; }
}
__device__ __forceinline__ void st4(LAS unsigned char* p, float a, float b, float c, float d) { u32x2 w; w.x = cvt_pk_bf16(a, b); w.y = cvt_pk_bf16(c, d); *(LAS u32x2*)p = w; }

__device__ __forceinline__ f32x2_t s1_param_load(LAS unsigned char* L, int tid, int d, int h) {
    const int sg = tid >> 5, seg = sg < 15 ? sg : 14, off = (tid & 31) * 2;
    const int ti = seg < 10 ? 11 + (seg & 1) : (seg == 10 ? 13 : (seg == 11 ? 15 : 6 + seg));
    const int eo = seg < 6 ? (seg >> 1) * 512 + h * 64 : (seg < 8 ? ZWD - ZRR : (seg < 10 ? ZAD - ZRR : (seg < 12 ? d * 512 + h * 64 : h * 64)));
    const float* src = *(const float* LAS*)(L + PTRS_OFF + ti * 8) + eo + off;
    return *(const GAS f32x2_t*)src;
}
__device__ __forceinline__ void s1_stage_load(const Args& a, int tid, int q, int h, int ck, u32x4 (&v)[6]) {
    const int row0 = seq_row0(q), S = seq_len(q), t0 = ck * 64;
#pragma unroll
    for (int k = 0; k < 6; ++k) { const int c = tid + k * NTHR;
        const int seg = c >> 3, part = c & 7, grp = (seg >= 66) + (seg >= 132), row = seg - 66 * grp; int t = t0 - 1 + row; t = t < 0 ? 0 : (t >= S ? S - 1 : t);
        const int e = c - 1584 < 0 ? 0 : (c - 1584 > 1023 ? 1023 : c - 1584);
        const size_t offz = WS_Z + ((size_t)(row0 + t) * ZP + ZRR + grp * 512 + h * 64 + part * 8) * 2, offe = WS_E1 + ((size_t)(row0 + t0) * 128 + (size_t)e * 8) * 2;
        v[k] = *(const GAS u32x4*)(a.ws + (c < 1584 ? offz : offe)); }
}
__device__ __forceinline__ void s1_stage_store(LAS unsigned char* L, int tid, int d, int q, int ck, const u32x4 (&stg)[6], f32x2_t par) {
    const int S = seq_len(q), t0 = ck * 64, dummy = O_GSUM + (tid & 63) * 16;
#pragma unroll
    for (int k = 0; k < 6; ++k) { const int c = tid + k * NTHR;
        const int seg = c >> 3, grp = (seg >= 66) + (seg >= 132), row = seg - 66 * grp, t = t0 - 1 + row; const bool zok = t >= 0 && t < S;
        const int e = c - 1584, tr = (e >> 4) & 63, part = e & 15, tau = d == 0 ? tr : 63 - tr;
        const int addr = c < 1584 ? O_ZS + c * 16 : (c < 2608 ? (part < 8 ? O_TW : O_ADN) + tau * P + (part & 7) * 16 : dummy);
        const bool zero = c < 1584 && !zok;
        *(LAS u32x4*)(L + addr) = zero ? (u32x4){0u, 0u, 0u, 0u} : stg[k]; }
    *(LAS f32x2_t*)(L + (tid < 480 ? O_PAR + tid * 8 : dummy)) = par;
}
__device__ __forceinline__ void s1_item(const Frame& F, const Args& a, int d, int q, int h, int ck, unsigned char* slot, int nd, int nq, int nh, int nck, bool wt, unsigned* publish_prev) {
    LAS unsigned char* L = F.lds;
#if PROBE_S1 >= 0
    unsigned long long pt_last = 0; int pt_n = 0;
#define PST() do { if (F.tid == 0) { const unsigned long long n_ = __builtin_amdgcn_s_memrealtime(); if (pt_n == PROBE_S1 + 1) *(LAS unsigned long long*)(L + PTRS_OFF - 64) += n_ - pt_last; pt_last = n_; } ++pt_n; } while (0)
#else
#define PST() do { } while (0)
#endif
    PST();
    int lane_ = F.lane; asm volatile("" : "+v"(lane_));
    const int lane = lane_, w = F.wave, tid = w * 64 + lane, r32 = lane & 31, hi = lane >> 5;
    const int j = lane, tg = w;
    const int row0 = seq_row0(q), S = seq_len(q), t0 = ck * 64;
    const bf16_t* Zs = (const bf16_t*)(a.ws + WS_Z) + (size_t)row0 * ZP; (void)Zs; (void)S;
    const int t_lo = d == 0 ? t0 + 8 * tg : t0 + 56 - 8 * tg;
    const int tau0 = 8 * tg;
#define TAU(u) (d == 0 ? tau0 + (u) : tau0 + 7 - (u))
    const int ch = h * 64 + j; (void)ch;
    bf16x8 wfr[4];
    { const int which = w >> 2, mt = (w >> 1) & 1;
      const bf16_t* WT = (const bf16_t*)(a.ws + WS_LORA) + (which ? 2 * 512 * 64 : 0) + ((size_t)d * 512 + h * 64 + 32 * mt + r32) * 64;
#pragma unroll
      for (int ks = 0; ks < 4; ++ks) wfr[ks] = *(const bf16x8*)(WT + 16 * ks + 8 * hi); }
    u32x4 stg[6]; s1_stage_load(a, tid, nq, nh, nck, stg); const f32x2_t par = s1_param_load(L, tid, nd, nh);
#define PAR(seg, idx) (*(const LAS float*)(L + O_PAR + ((seg) * 64 + (idx)) * 4))
    const LAS unsigned char* zsb = L + O_ZS + (t_lo - t0) * PZ + j * 2;
#define LD10(z, g) do { _Pragma("unroll") for (int i_ = 0; i_ < 10; ++i_) z[i_] = bf2f(*(const LAS bf16_t*)(zsb + ((g) * 66 + i_) * PZ)); } while (0)
    {
        const int which = w >> 2, mt = (w >> 1) & 1, nt = w & 1;
        const LAS unsigned char* B = L + (which ? O_ADN : O_TW);
        f32x16 acc = f32x16{};
#pragma unroll
        for (int ks = 0; ks < 4; ++ks) { const bf16x8 bv = *(const LAS bf16x8*)(B + (32 * nt + r32) * P + (16 * ks + 8 * hi) * 2);
            acc = __builtin_amdgcn_mfma_f32_32x32x16_bf16(wfr[ks], bv, acc, 0, 0, 0); }
        LAS unsigned char* O = L + (which ? O_AR : O_WL) + (32 * nt + r32) * PF;
#pragma unroll
        for (int g = 0; g < 4; ++g) { const int jj = 8 * g + 4 * hi; const f32x4 bv = *(const LAS f32x4*)(L + O_PAR + ((10 + which) * 64 + 32 * mt + jj) * 4);
            *(LAS f32x4*)(O + (32 * mt + jj) * 4) = (f32x4){acc[4 * g] + bv[0], acc[4 * g + 1] + bv[1], acc[4 * g + 2] + bv[2], acc[4 * g + 3] + bv[3]}; }
    }
    LBAR(); PST();
    typedef f32x2_t v2;
    const int cp = lane & 31, th = lane >> 5;
    v2 aa2[4], bb2[4], rr2[4], kd2[4], vv2[4], ld2[4], tot4, oth;
#define EXP2V(a) ({ const v2 t_ = (a) * 1.4426950408889634f; (v2){__builtin_amdgcn_exp2f(t_.x), __builtin_amdgcn_exp2f(t_.y)}; })
#define SIG2V(a) ({ const v2 e_ = EXP2V(-(a)) + 1.0f; (v2){__builtin_amdgcn_rcpf(e_.x), __builtin_amdgcn_rcpf(e_.y)}; })
#define FOLD4(s_) ({ const bool b4_ = (lane >> 4) & 1, b3_ = (lane >> 3) & 1; float g_[2]; \
        _Pragma("unroll") for (int i_ = 0; i_ < 2; ++i_) { const float kp_ = b4_ ? s_[i_ + 2] : s_[i_], sd_ = b4_ ? s_[i_] : s_[i_ + 2]; g_[i_] = kp_ + __int_as_float(__builtin_amdgcn_ds_swizzle(__float_as_int(sd_), 0x401F)); } \
        const float kp2_ = b3_ ? g_[1] : g_[0], sd2_ = b3_ ? g_[0] : g_[1]; \
        float h_ = kp2_ + __int_as_float(__builtin_amdgcn_update_dpp(0, __float_as_int(sd2_), 0x128, 0xF, 0xF, true)); \
        h_ += __int_as_float(__builtin_amdgcn_update_dpp(0, __float_as_int(h_), 0x141, 0xF, 0xF, true)); \
        h_ += __int_as_float(__builtin_amdgcn_update_dpp(0, __float_as_int(h_), 0xB1, 0xF, 0xF, true)); \
        h_ += __int_as_float(__builtin_amdgcn_update_dpp(0, __float_as_int(h_), 0x4E, 0xF, 0xF, true)); h_; })
    {
        v2 zr[6], zk[6], zv[6];
        const LAS unsigned char* zb2 = L + O_ZS + ((t_lo - t0) + 4 * th) * PZ + cp * 4;
#define LDZ(z, g) do { _Pragma("unroll") for (int i_ = 0; i_ < 6; ++i_) { const unsigned w_ = *(const LAS unsigned*)(zb2 + ((g) * 66 + i_) * PZ); z[i_] = (v2){bflo(w_), bfhi(w_)}; } } while (0)
        LDZ(zr, 0); LDZ(zk, 1); LDZ(zv, 2);
#undef LDZ
#define PAR2(seg) (*(const LAS v2*)(L + O_PAR + ((seg) * 64 + 2 * cp) * 4))
        const v2 mpr = PAR2(0), mnr = PAR2(1), mpk = PAR2(2), mnk = PAR2(3), mpv = PAR2(4), mnv = PAR2(5), kkc = PAR2(12), kac = PAR2(13), rkc = PAR2(14);
#undef PAR2
        float* bon = (float*)(a.ws + WS_BONUS) + ((size_t)d * MTOK + row0) * 8 + h;
        v2 k02[4], ar2[4]; float red[4];
#pragma unroll
        for (int k = 0; k < 4; ++k) { const int tau = TAU(4 * th + k);
            const v2 wl = *(const LAS v2*)(L + O_WL + tau * PF + cp * 8), ar = *(const LAS v2*)(L + O_AR + tau * PF + cp * 8);
            ld2[k] = SIG2V(wl) * (-0.6065306597126334f); ar2[k] = SIG2V(ar);
            rr2[k] = zr[k + 1] + mpr * (zr[k] - zr[k + 1]) + mnr * (zr[k + 2] - zr[k + 1]);
            k02[k] = zk[k + 1] + mpk * (zk[k] - zk[k + 1]) + mnk * (zk[k + 2] - zk[k + 1]);
            vv2[k] = zv[k + 1] + mpv * (zv[k] - zv[k + 1]) + mnv * (zv[k + 2] - zv[k + 1]);
            aa2[k] = k02[k] * kkc; red[k] = aa2[k].x * aa2[k].x + aa2[k].y * aa2[k].y; }
        const int hs = __float_as_int(FOLD4(red));
        float ssq[4];
#pragma unroll
        for (int k = 0; k < 4; ++k) { const float lo_ = __int_as_float(__builtin_amdgcn_readlane(hs, 8 * k)), hi_ = __int_as_float(__builtin_amdgcn_readlane(hs, 32 + 8 * k)); ssq[k] = th ? hi_ : lo_; }
#pragma unroll
        for (int k = 0; k < 4; ++k) { const v2 kkn = aa2[k] * __builtin_amdgcn_rsqf(ssq[k] + 1e-12f);
            kd2[k] = k02[k] * ((ar2[k] - 1.0f) * kac + 1.0f); aa2[k] = -kkn; bb2[k] = kkn * ar2[k];
            const v2 bt = rr2[k] * kd2[k] * rkc; red[k] = bt.x + bt.y; }
        const float hb = FOLD4(red);
        if ((lane & 7) == 0) bon[(size_t)(t_lo + (lane >> 3)) * 8] = hb;
        tot4 = (ld2[0] + ld2[1]) + (ld2[2] + ld2[3]);
        { auto rx = __builtin_amdgcn_permlane32_swap(__float_as_uint(tot4.x), __float_as_uint(tot4.x), false, false), ry = __builtin_amdgcn_permlane32_swap(__float_as_uint(tot4.y), __float_as_uint(tot4.y), false, false);
          oth.x = __uint_as_float(th ? rx[0] : rx[1]); oth.y = __uint_as_float(th ? ry[0] : ry[1]); }
        if (th == 0) *(LAS v2*)(L + O_GSUM + tg * 256 + cp * 8) = tot4 + oth;
    }
    LBAR(); PST();
    {
        v2 pre = {0.f, 0.f}, cC = {0.f, 0.f};
#pragma unroll
        for (int g = 0; g < 8; ++g) { const v2 sg = *(const LAS v2*)(L + O_GSUM + g * 256 + cp * 8); cC += sg; if (g < tg) pre += sg; }
        const v2 zero2 = {0.f, 0.f};
        const v2 base = pre + ((d == 0) == (th == 1) ? oth : zero2);
        v2 At2[4], Vt2[4], Bh2[4], Kh2[4]; v2 pf = {0.f, 0.f};
#pragma unroll
        for (int k = 0; k < 4; ++k) { pf += ld2[k]; const int tau = TAU(4 * th + k);
            const v2 cl = base + (d == 0 ? pf : tot4 - pf + ld2[k]);
            const v2 e_m1 = EXP2V(cl - ld2[k]), e_p = EXP2V(cl), e_n = EXP2V(-cl), e_c = EXP2V(cC - cl);
            At2[k] = aa2[k] * e_m1; Vt2[k] = vv2[k]; Bh2[k] = bb2[k] * e_c; Kh2[k] = kd2[k] * e_c;
            const v2 rt = rr2[k] * e_p, bt = bb2[k] * e_n, kt = kd2[k] * e_n;
            *(LAS unsigned*)(L + O_AT + tau * P + cp * 4) = cvt_pk_bf16(At2[k].x, At2[k].y); *(LAS unsigned*)(L + O_RT + tau * P + cp * 4) = cvt_pk_bf16(rt.x, rt.y);
            *(LAS unsigned*)(L + O_BT + tau * P + cp * 4) = cvt_pk_bf16(bt.x, bt.y);         *(LAS unsigned*)(L + O_KT + tau * P + cp * 4) = cvt_pk_bf16(kt.x, kt.y); }
        const int tb4 = tau0 + (d == 0 ? 4 * th : 4 * (1 - th));
#define PK4(dst, X) do { u32x2 wx_, wy_; \
            wx_.x = cvt_pk_bf16(d == 0 ? X[0].x : X[3].x, d == 0 ? X[1].x : X[2].x); wx_.y = cvt_pk_bf16(d == 0 ? X[2].x : X[1].x, d == 0 ? X[3].x : X[0].x); \
            wy_.x = cvt_pk_bf16(d == 0 ? X[0].y : X[3].y, d == 0 ? X[1].y : X[2].y); wy_.y = cvt_pk_bf16(d == 0 ? X[2].y : X[1].y, d == 0 ? X[3].y : X[0].y); \
            *(LAS u32x2*)(L + (dst) + (2 * cp) * P + tb4 * 2) = wx_; *(LAS u32x2*)(L + (dst) + (2 * cp + 1) * P + tb4 * 2) = wy_; } while (0)
        PK4(O_ATT, At2); PK4(O_VT, Vt2); PK4(O_BHT, Bh2); PK4(O_KHT, Kh2);
#undef PK4
        if (tg == 0 && th == 0) *(LAS v2*)(L + O_WC + cp * 8) = EXP2V(cC);
    }
#undef FOLD4
#undef SIG2V
#undef EXP2V
    LBAR(); PST();
#pragma unroll
    for (int i = 0; i < 2; ++i) {
        const int ti = 2 * w + i, ms = ti >> 2, nl = ti & 3;
        const int sb = 32 * (ms & 1), tb = 32 * (nl & 1);
        f32x16 acc = f32x16{};
        if (sb <= tb) acc = mm_ll(L + (ms < 2 ? O_BT : O_KT), sb, L + (nl < 2 ? O_AT : O_RT), tb, acc, r32, hi);
        const int dst = ms < 2 ? (nl < 2 ? O_LAB : O_ARB) : (nl < 2 ? O_LAK : O_ARK);
        const int t = tb + r32, tlim = t + (nl >= 2 ? 1 : 0);
        const bool diagtile = (dst == O_LAB) && (sb == tb);
#pragma unroll
        for (int g = 0; g < 4; ++g) { const int s0 = sb + 8 * g + 4 * hi; float v[4];
#pragma unroll
            for (int e = 0; e < 4; ++e) v[e] = (s0 + e < tlim) ? acc[4 * g + e] : 0.f;
            st4(L + dst + t * P + s0 * 2, v[0], v[1], v[2], v[3]);
            if (diagtile) { const bool match = (g >> 1) == (r32 >> 4);
                const int off = match ? O_LABD + (((t >> 4) * 16 + (t & 15)) * 16 + (s0 & 15)) * 4 : O_GSUM + lane * 16;
                *(LAS f32x4*)(L + off) = (f32x4){v[0], v[1], v[2], v[3]}; } }
    }
    LBAR(); PST();
    if (w < 4) {
        const int mt = w >> 1, nt = w & 1; f32x16 acc = f32x16{};
        acc = mm_ll(L + O_LAK, 32 * mt, L + O_VT, 32 * nt, acc, r32, hi);
#pragma unroll
        for (int g = 0; g < 4; ++g) st4(L + O_XT + (32 * nt + r32) * P + (32 * mt + 8 * g + 4 * hi) * 2, acc[4 * g], acc[4 * g + 1], acc[4 * g + 2], acc[4 * g + 3]);
    } else if (w == 7) {
        const int blk = lane >> 4, cc = lane & 15;
        float x[16];
#pragma unroll
        for (int t = 0; t < 16; ++t) x[t] = (t == cc) ? 1.f : 0.f;
#pragma unroll
        for (int kb = 0; kb < 4; ++kb) {
            f32x4 Lc[16];
#pragma unroll
            for (int t = 0; t < 16; ++t) if (t > 4 * kb) Lc[t] = *(const LAS f32x4*)(L + O_LABD + ((blk * 16 + t) * 16 + 4 * kb) * 4);
#pragma unroll
            for (int t = 0; t < 16; ++t) {
                if (t > 4 * kb + 0) x[t] += Lc[t][0] * x[4 * kb + 0];
            }
#pragma unroll
            for (int t = 0; t < 16; ++t) {
                if (t > 4 * kb + 1) x[t] += Lc[t][1] * x[4 * kb + 1];
            }
#pragma unroll
            for (int t = 0; t < 16; ++t) {
                if (t > 4 * kb + 2) x[t] += Lc[t][2] * x[4 * kb + 2];
            }
#pragma unroll
            for (int t = 0; t < 16; ++t) {
                if (t > 4 * kb + 3) x[t] += Lc[t][3] * x[4 * kb + 3];
            }
        }
#pragma unroll
        for (int t = 0; t < 16; ++t) *(LAS bf16_t*)(L + O_TII + ((blk * 16 + t) * 16 + cc) * 2) = f2bf(x[t]);
    }
    LBAR(); PST();
    {
        const int c16 = lane & 15, q4 = lane >> 4;
        const LAS unsigned char* RT = L + (w < 4 ? O_ATT : O_XT) + (16 * (w & 3) + c16) * P;
        LAS unsigned char* OT = L + (w < 4 ? O_ABT : O_U0T) + (16 * (w & 3) + c16) * P;
        const LAS unsigned char* LA = L + O_LAB + c16 * P;
#define RHS(i) ({ const u32x2 r_ = *(const LAS u32x2*)(RT + (16 * (i) + 4 * q4) * 2); (f32x4){bflo(r_.x), bfhi(r_.x), bflo(r_.y), bfhi(r_.y)}; })
#define AFR(i, k1, k2) ({ const u32x2 lo_ = *(const LAS u32x2*)(LA + 16 * (i) * P + (16 * (k1) + 4 * q4) * 2); u32x2 hi_ = {0u, 0u}; if ((k2) >= 0) hi_ = *(const LAS u32x2*)(LA + 16 * (i) * P + (16 * ((k2) < 0 ? 0 : (k2)) + 4 * q4) * 2); \
        __builtin_bit_cast(bf16x8, (u32x4){lo_.x, lo_.y, hi_.x, hi_.y}); })
#define TFR(i) ({ const u32x2 lo_ = *(const LAS u32x2*)(L + O_TII + (((i) * 16 + c16) * 16 + 4 * q4) * 2); __builtin_bit_cast(bf16x8, (u32x4){lo_.x, lo_.y, 0u, 0u}); })
#define BFR(U1, U2) __builtin_bit_cast(bf16x8, (u32x4){cvt_pk_bf16(U1[0], U1[1]), cvt_pk_bf16(U1[2], U1[3]), cvt_pk_bf16(U2[0], U2[1]), cvt_pk_bf16(U2[2], U2[3])})
#define MF16(A_, B_, C_) __builtin_amdgcn_mfma_f32_16x16x32_bf16(A_, B_, C_, 0, 0, 0)
        const f32x4 zero4 = {0.f, 0.f, 0.f, 0.f};
        f32x4 U0 = MF16(TFR(0), BFR(RHS(0), zero4), zero4);
        f32x4 Z1 = MF16(AFR(1, 0, -1), BFR(U0, zero4), RHS(1));
        f32x4 U1 = MF16(TFR(1), BFR(Z1, zero4), zero4);
        f32x4 Z2 = MF16(AFR(2, 0, 1), BFR(U0, U1), RHS(2));
        f32x4 U2 = MF16(TFR(2), BFR(Z2, zero4), zero4);
        f32x4 Z3 = MF16(AFR(3, 0, 1), BFR(U0, U1), RHS(3));
        Z3 = MF16(AFR(3, 2, -1), BFR(U2, zero4), Z3);
        f32x4 U3 = MF16(TFR(3), BFR(Z3, zero4), zero4);
        st4(OT + (0 + 4 * q4) * 2, U0[0], U0[1], U0[2], U0[3]); st4(OT + (16 + 4 * q4) * 2, U1[0], U1[1], U1[2], U1[3]);
        st4(OT + (32 + 4 * q4) * 2, U2[0], U2[1], U2[2], U2[3]); st4(OT + (48 + 4 * q4) * 2, U3[0], U3[1], U3[2], U3[3]);
#undef RHS
#undef AFR
#undef TFR
#undef BFR
#undef MF16
    }
    if (publish_prev) asm volatile("s_waitcnt vmcnt(0)" ::: "memory");
    LBAR(); PST();
    if (publish_prev && tid == 0) __hip_atomic_fetch_add(publish_prev, 1u, __ATOMIC_RELAXED, __HIP_MEMORY_SCOPE_AGENT);
    {
        const int mt = (w >> 1) & 1, nt = w & 1;
        if (w < 4) {
            f32x16 acc = f32x16{};
            acc = mm_ll(L + O_ABT, 32 * mt, L + O_BHT, 32 * nt, acc, r32, hi);
            if (mt == nt) { const float wc = *(const LAS float*)(L + O_WC + (32 * nt + r32) * 4);
#pragma unroll
                for (int r = 0; r < 16; ++r) if (crow(r, hi) == r32) acc[r] += wc; }
            store_native(slot + (mt * 2 + nt) * 2048, acc, lane, wt);
            f32x16 rb;
#pragma unroll
            for (int g = 0; g < 4; ++g) { const u32x2 r_ = *(const LAS u32x2*)(L + O_RT + (32 * nt + r32) * P + (32 * mt + 8 * g + 4 * hi) * 2);
                rb[4 * g] = bflo(r_.x); rb[4 * g + 1] = bfhi(r_.x); rb[4 * g + 2] = bflo(r_.y); rb[4 * g + 3] = bfhi(r_.y); }
            rb = mm_ll(L + O_ABT, 32 * mt, L + O_ARB, 32 * nt, rb, r32, hi);
            store_native(slot + 16384 + (mt * 2 + nt) * 2048, rb, lane, wt);
        } else {
            f32x16 acc = f32x16{};
            acc = mm_ll(L + O_BHT, 32 * mt, L + O_U0T, 32 * nt, acc, r32, hi);
            acc = mm_ll(L + O_KHT, 32 * mt, L + O_VT, 32 * nt, acc, r32, hi);
            store_native(slot + 8192 + (mt * 2 + nt) * 2048, acc, lane, wt);
            f32x16 y0 = f32x16{};
            y0 = mm_ll(L + O_ARB, 32 * mt, L + O_U0T, 32 * nt, y0, r32, hi);
            y0 = mm_ll(L + O_ARK, 32 * mt, L + O_VT, 32 * nt, y0, r32, hi);
            store_native(slot + 24576 + (mt * 2 + nt) * 2048, y0, lane, wt);
        }
    }
    LBAR(); PST();
    s1_stage_store(L, tid, nd, nq, nck, stg, par);
    LBAR(); PST();
#undef PAR
#undef TAU
#undef LD10
#undef PST
}

__device__ __forceinline__ void s23_wait_round(unsigned* ready, int r, int lane) {
    unsigned spins = 0;
    while ((unsigned)__builtin_amdgcn_readfirstlane(__hip_atomic_load(ready + r, __ATOMIC_RELAXED, __HIP_MEMORY_SCOPE_AGENT)) < 16u) { __builtin_amdgcn_s_sleep(8); if (++spins > (1u << 22)) break; }
    __builtin_amdgcn_fence(__ATOMIC_ACQUIRE, "agent");
    asm volatile("s_waitcnt vmcnt(0)" ::: "memory");
}
__device__ __forceinline__ void s23_chain_wg(const Frame& F, const Args& a, int d, int q, int h, unsigned char* slots  , unsigned* ready) {
    LAS unsigned char* L = F.lds;
    const int lane = F.lane, w = F.wave, icb = w & 1;
    const int NC = seq_len(q) / 64;
    f32x16 X0 = f32x16{}, X1 = f32x16{};
    const bool loader = w >= 4, compute = w < 2;
    constexpr int D = 6;
#define CKOF(cc) (d == 0 ? (cc) : NC - 1 - (cc))
#define S23_DMA(cc) do { const unsigned char* src_ = slots + (size_t)CKOF(cc) * SLOT_BYTES + (w - 4) * 4096 + lane * 16; LAS unsigned char* dst_ = L + ((cc) & 7) * 16384 + (w - 4) * 4096; \
        _Pragma("unroll") for (int p_ = 0; p_ < 4; ++p_) __builtin_amdgcn_global_load_lds((const unsigned*)(src_ + p_ * 1024), (LAS unsigned*)(dst_ + p_ * 1024), 16, 0, 0); } while (0)
#define UNPK(dst, w0, w1) do { _Pragma("unroll") for (int q_ = 0; q_ < 4; ++q_) { dst[2 * q_] = bflo(w0[q_]); dst[2 * q_ + 1] = bfhi(w0[q_]); dst[8 + 2 * q_] = bflo(w1[q_]); dst[9 + 2 * q_] = bfhi(w1[q_]); } } while (0)
    if (ready) { if (w == 4) s23_wait_round(ready, 0, lane); asm volatile("s_waitcnt lgkmcnt(0)\n\ts_barrier" ::: "memory"); }
    if (loader) {
#pragma unroll
        for (int c0 = 0; c0 < D; ++c0) if (c0 < NC) S23_DMA(c0); }
#pragma unroll 1
    for (int cc = 0; cc < NC; ++cc) {
        if (ready && w == 4 && ((cc + D) & 15) == 0 && cc + D < NC) s23_wait_round(ready, (cc + D) >> 4, lane);
        if (loader) { const int later = NC - 1 - cc;
            if (later >= 5) asm volatile("s_waitcnt vmcnt(20)" ::: "memory"); else if (later == 4) asm volatile("s_waitcnt vmcnt(16)" ::: "memory"); else if (later == 3) asm volatile("s_waitcnt vmcnt(12)" ::: "memory");
            else if (later == 2) asm volatile("s_waitcnt vmcnt(8)" ::: "memory"); else if (later == 1) asm volatile("s_waitcnt vmcnt(4)" ::: "memory"); else asm volatile("s_waitcnt vmcnt(0)" ::: "memory"); }
        asm volatile("s_waitcnt lgkmcnt(0)\n\ts_barrier" ::: "memory");
        if (loader) { if (cc + D < NC) S23_DMA(cc + D); }
        if (compute) {
            const LAS unsigned char* sl = L + (cc & 7) * 16384 + lane * 32;
            u32x4 mw[4][2], dw[2][2];
#pragma unroll
            for (int t = 0; t < 4; ++t) { mw[t][0] = *(const LAS u32x4*)(sl + t * 2048); mw[t][1] = *(const LAS u32x4*)(sl + t * 2048 + 16); }
#pragma unroll
            for (int t = 0; t < 2; ++t) { dw[t][0] = *(const LAS u32x4*)(sl + 8192 + (t * 2 + icb) * 2048); dw[t][1] = *(const LAS u32x4*)(sl + 8192 + (t * 2 + icb) * 2048 + 16); }
            __builtin_amdgcn_sched_barrier(0);
            u32x4 xw[2][2];
#pragma unroll
            for (int s = 0; s < 2; ++s) {
                xw[0][s] = (u32x4){cvt_pk_bf16(X0[8 * s], X0[8 * s + 1]), cvt_pk_bf16(X0[8 * s + 2], X0[8 * s + 3]), cvt_pk_bf16(X0[8 * s + 4], X0[8 * s + 5]), cvt_pk_bf16(X0[8 * s + 6], X0[8 * s + 7])};
                xw[1][s] = (u32x4){cvt_pk_bf16(X1[8 * s], X1[8 * s + 1]), cvt_pk_bf16(X1[8 * s + 2], X1[8 * s + 3]), cvt_pk_bf16(X1[8 * s + 4], X1[8 * s + 5]), cvt_pk_bf16(X1[8 * s + 6], X1[8 * s + 7])}; }
            { unsigned char* xo = slots + (size_t)CKOF(cc) * SLOT_BYTES + ((icb * 2) * 64 + lane) * 32;
              *(u32x4*)(xo) = xw[0][0]; *(u32x4*)(xo + 16) = xw[0][1]; *(u32x4*)(xo + 2048) = xw[1][0]; *(u32x4*)(xo + 2048 + 16) = xw[1][1]; }
            asm volatile("s_waitcnt lgkmcnt(0)" ::: "memory");
            __builtin_amdgcn_sched_barrier(0);
            f32x16 N0, N1;
            UNPK(N0, dw[0][0], dw[0][1]); UNPK(N1, dw[1][0], dw[1][1]);
#pragma unroll
            for (int rb = 0; rb < 2; ++rb)
#pragma unroll
                for (int s = 0; s < 2; ++s) {
                    N0 = __builtin_amdgcn_mfma_f32_32x32x16_bf16(__builtin_bit_cast(bf16x8, mw[rb * 2 + 0][s]), __builtin_bit_cast(bf16x8, xw[rb][s]), N0, 0, 0, 0);
                    N1 = __builtin_amdgcn_mfma_f32_32x32x16_bf16(__builtin_bit_cast(bf16x8, mw[rb * 2 + 1][s]), __builtin_bit_cast(bf16x8, xw[rb][s]), N1, 0, 0, 0); }
            X0 = N0; X1 = N1;
        }
    }
    asm volatile("s_waitcnt vmcnt(0) lgkmcnt(0)\n\ts_barrier" ::: "memory");
#undef UNPK
#undef S23_DMA
#undef CKOF
}

constexpr int PO_V = 0, PO_G = PO_V + 66 * 144, PO_Y = PO_G + 66 * 272, PO_SG = PO_Y + 2 * 64 * 272, PO_GF = PO_SG + 64 * 272, PO_END = PO_GF + 64 * 272;
static_assert(PO_END <= PTRS_OFF - 64, "post lds");
struct PostPre { u32x4 stg[4]; u32x4 ra[2][2], xb[2][2], yc[2]; };
__device__ __forceinline__ void post_decode(int c, int& reg, int& row, int& part) {
    if (c < 528) { reg = 0; row = c >> 3; part = c & 7; } else { reg = 1; row = (c - 528) >> 4; part = (c - 528) & 15; }
}
__device__ __forceinline__ void post_stage_load(const Args& a, int tid, int q, int h, int blk, PostPre& pp) {
    const int row0 = seq_row0(q), S = seq_len(q), t0 = blk * 64;
    const bf16_t* Zs = (const bf16_t*)(a.ws + WS_Z) + (size_t)row0 * ZP;
#pragma unroll
    for (int k = 0; k < 4; ++k) { const int c = tid + k * NTHR; int reg, row, part; post_decode(c, reg, row, part);
        const int t = t0 - 1 + row; const int col = reg == 0 ? ZRV + h * 64 : ZGD;
        pp.stg[k] = (u32x4){0u, 0u, 0u, 0u};
        if (c < 1584 && t >= 0 && t < S) pp.stg[k] = *(const u32x4*)(Zs + (size_t)t * ZP + col + part * 8); }
    const int w = tid >> 6, lane = tid & 63, dd = w >> 2, tb = (w >> 1) & 1, icb = w & 1;
    const size_t si = q == 0 ? (size_t)(dd * 8 + h) * 256 + blk : (size_t)((dd * 8 + (q - 1)) * 8 + h) * 32 + blk;
    const unsigned char* sl = (const unsigned char*)a.out + si * SLOT_BYTES + lane * 32;
#pragma unroll
    for (int rb = 0; rb < 2; ++rb) { pp.ra[rb][0] = *(const u32x4*)(sl + 16384 + (rb * 2 + tb) * 2048); pp.ra[rb][1] = *(const u32x4*)(sl + 16384 + (rb * 2 + tb) * 2048 + 16);
                                     pp.xb[rb][0] = *(const u32x4*)(sl + (icb * 2 + rb) * 2048); pp.xb[rb][1] = *(const u32x4*)(sl + (icb * 2 + rb) * 2048 + 16); }
    pp.yc[0] = *(const u32x4*)(sl + 24576 + (tb * 2 + icb) * 2048); pp.yc[1] = *(const u32x4*)(sl + 24576 + (tb * 2 + icb) * 2048 + 16);
}
__device__ __forceinline__ void post_item(const Frame& F, const Args& a, int q, int h, int blk, PostPre& pp, int nq, int nh, int nblk) {
    LAS unsigned char* L = F.lds;
    int lane_ = F.lane; asm volatile("" : "+v"(lane_));
    const int lane = lane_, w = F.wave, tid = w * 64 + lane, r32 = lane & 31, hi = lane >> 5, tg = w;
    typedef f32x2_t v2;
    const int cp = lane & 31, th = lane >> 5;
    const int row0 = seq_row0(q), t_lo = blk * 64 + 8 * tg + 4 * th;
    bf16_t* Zs = (bf16_t*)(a.ws + WS_Z) + (size_t)row0 * ZP;
    const float* mup = inp(L, 11); const float* mun = inp(L, 12);
#define GLD2(p_) (*(const GAS v2*)(p_))
    const int chp = h * 64 + 2 * cp;
    const v2 mp0 = GLD2(mup + ZGD - ZRR + 2 * cp), mn0 = GLD2(mun + ZGD - ZRR + 2 * cp), mp1 = GLD2(mup + ZGD - ZRR + 64 + 2 * cp), mn1 = GLD2(mun + ZGD - ZRR + 64 + 2 * cp);
    const v2 mpv = GLD2(mup + 1024 + chp), mnv = GLD2(mun + 1024 + chp), lg = GLD2(inp(L, 21) + chp), lb = GLD2(inp(L, 22) + chp);
#undef GLD2
    float bsum[4];
    { const GAS float* bon0 = (const GAS float*)(a.ws + WS_BONUS) + (size_t)row0 * 8 + h; const GAS float* bon1 = bon0 + (size_t)MTOK * 8;
#pragma unroll
      for (int k = 0; k < 4; ++k) bsum[k] = bon0[(size_t)(t_lo + k) * 8] + bon1[(size_t)(t_lo + k) * 8]; }
    bf16x8 gfr[8];
    { const GAS bf16_t* GT = (const GAS bf16_t*)(a.ws + WS_LORA) + 4 * 512 * 64 + ((size_t)h * 64 + 32 * ((w >> 1) & 1) + r32) * 128;
#pragma unroll
      for (int ks = 0; ks < 8; ++ks) gfr[ks] = *(const GAS bf16x8*)(GT + 16 * ks + 8 * hi); }
#pragma unroll
    for (int k = 0; k < 4; ++k) { const int c = tid + k * NTHR; int reg, row, part; post_decode(c, reg, row, part);
        const int off = reg == 0 ? PO_V + row * 144 : PO_G + row * 272;
        if (c < 1584) *(LAS u32x4*)(L + off + part * 16) = pp.stg[k]; }
    {
        const int dd = w >> 2, tb = (w >> 1) & 1, icb = w & 1;
        f32x16 Y;
#pragma unroll
        for (int q_ = 0; q_ < 4; ++q_) { Y[2 * q_] = bflo(pp.yc[0][q_]); Y[2 * q_ + 1] = bfhi(pp.yc[0][q_]); Y[8 + 2 * q_] = bflo(pp.yc[1][q_]); Y[9 + 2 * q_] = bfhi(pp.yc[1][q_]); }
#pragma unroll
        for (int rb = 0; rb < 2; ++rb)
#pragma unroll
            for (int s2 = 0; s2 < 2; ++s2) Y = __builtin_amdgcn_mfma_f32_32x32x16_bf16(__builtin_bit_cast(bf16x8, pp.ra[rb][s2]), __builtin_bit_cast(bf16x8, pp.xb[rb][s2]), Y, 0, 0, 0);
#pragma unroll
        for (int r = 0; r < 16; ++r) { const int tau = 32 * tb + (r & 3) + 8 * (r >> 2) + 4 * hi; const int t = dd == 0 ? tau : 63 - tau;
            *(LAS float*)(L + PO_Y + (dd * 64 + t) * 272 + (32 * icb + r32) * 4) = Y[r]; }
    }
    LBAR();
    post_stage_load(a, tid, nq, nh, nblk, pp);
    const int tl = 8 * tg + 4 * th;
#define SIG2V(a_) ({ const v2 t_ = (a_) * (-1.4426950408889634f); const v2 e_ = (v2){__builtin_amdgcn_exp2f(t_.x), __builtin_amdgcn_exp2f(t_.y)} + 1.0f; (v2){__builtin_amdgcn_rcpf(e_.x), __builtin_amdgcn_rcpf(e_.y)}; })
    {
        v2 z0[6], z1[6];
#pragma unroll
        for (int i = 0; i < 6; ++i) { const unsigned w0 = *(const LAS unsigned*)(L + PO_G + (tl + i) * 272 + cp * 4), w1 = *(const LAS unsigned*)(L + PO_G + (tl + i) * 272 + 128 + cp * 4);
            z0[i] = (v2){bflo(w0), bfhi(w0)}; z1[i] = (v2){bflo(w1), bfhi(w1)}; }
#pragma unroll
        for (int k = 0; k < 4; ++k) { const v2 s0 = SIG2V(z0[k + 1] + mp0 * (z0[k] - z0[k + 1]) + mn0 * (z0[k + 2] - z0[k + 1])), s1 = SIG2V(z1[k + 1] + mp1 * (z1[k] - z1[k + 1]) + mn1 * (z1[k + 2] - z1[k + 1]));
            *(LAS unsigned*)(L + PO_SG + (tl + k) * 272 + cp * 4) = cvt_pk_bf16(s0.x, s0.y); *(LAS unsigned*)(L + PO_SG + (tl + k) * 272 + 128 + cp * 4) = cvt_pk_bf16(s1.x, s1.y); }
    }
#undef SIG2V
    LBAR();
    if (w < 4) {
        const int mt = w >> 1, nt = w & 1;
        f32x16 acc = f32x16{};
#pragma unroll
        for (int ks = 0; ks < 8; ++ks) { const bf16x8 bv = *(const LAS bf16x8*)(L + PO_SG + (32 * nt + r32) * 272 + (16 * ks + 8 * hi) * 2);
            acc = __builtin_amdgcn_mfma_f32_32x32x16_bf16(gfr[ks], bv, acc, 0, 0, 0); }
#pragma unroll
        for (int g = 0; g < 4; ++g) *(LAS f32x4*)(L + PO_GF + (32 * nt + r32) * 272 + (32 * mt + 8 * g + 4 * hi) * 4) = (f32x4){acc[4 * g], acc[4 * g + 1], acc[4 * g + 2], acc[4 * g + 3]};
    }
    LBAR();
    {
        v2 zv[6];
#pragma unroll
        for (int i = 0; i < 6; ++i) { const unsigned wv = *(const LAS unsigned*)(L + PO_V + (tl + i) * 144 + cp * 4); zv[i] = (v2){bflo(wv), bfhi(wv)}; }
        v2 y2[4]; float red[4];
#pragma unroll
        for (int k = 0; k < 4; ++k) { y2[k] = *(const LAS v2*)(L + PO_Y + (tl + k) * 272 + cp * 8) + *(const LAS v2*)(L + PO_Y + (64 + tl + k) * 272 + cp * 8); red[k] = y2[k].x + y2[k].y; }
#define FOLD4(s_) ({ const bool b4_ = (lane >> 4) & 1, b3_ = (lane >> 3) & 1; float g_[2]; \
        _Pragma("unroll") for (int i_ = 0; i_ < 2; ++i_) { const float kp_ = b4_ ? s_[i_ + 2] : s_[i_], sd_ = b4_ ? s_[i_] : s_[i_ + 2]; g_[i_] = kp_ + __int_as_float(__builtin_amdgcn_ds_swizzle(__float_as_int(sd_), 0x401F)); } \
        const float kp2_ = b3_ ? g_[1] : g_[0], sd2_ = b3_ ? g_[0] : g_[1]; \
        float h_ = kp2_ + __int_as_float(__builtin_amdgcn_update_dpp(0, __float_as_int(sd2_), 0x128, 0xF, 0xF, true)); \
        h_ += __int_as_float(__builtin_amdgcn_update_dpp(0, __float_as_int(h_), 0x141, 0xF, 0xF, true)); \
        h_ += __int_as_float(__builtin_amdgcn_update_dpp(0, __float_as_int(h_), 0xB1, 0xF, 0xF, true)); \
        h_ += __int_as_float(__builtin_amdgcn_update_dpp(0, __float_as_int(h_), 0x4E, 0xF, 0xF, true)); h_; })
#define MINE(hs_, k_) ({ const float lo_ = __int_as_float(__builtin_amdgcn_readlane(hs_, 8 * (k_))), hi_ = __int_as_float(__builtin_amdgcn_readlane(hs_, 32 + 8 * (k_))); th ? hi_ : lo_; })
        const int hm = __float_as_int(FOLD4(red));
#pragma unroll
        for (int k = 0; k < 4; ++k) { y2[k] = y2[k] - MINE(hm, k) * (1.f / 64.f); red[k] = y2[k].x * y2[k].x + y2[k].y * y2[k].y; }
        const int hv = __float_as_int(FOLD4(red));
#pragma unroll
        for (int k = 0; k < 4; ++k) {
            const v2 yn = y2[k] * __builtin_amdgcn_rsqf(MINE(hv, k) * (1.f / 64.f) + LNX_EPS) * lg + lb;
            const v2 vs = zv[k + 1] + mpv * (zv[k] - zv[k + 1]) + mnv * (zv[k + 2] - zv[k + 1]);
            const v2 g = *(const LAS v2*)(L + PO_GF + (tl + k) * 272 + cp * 8);
            const v2 o = (yn + vs * bsum[k]) * g;
            *(unsigned*)(Zs + (size_t)(t_lo + k) * ZP + ZRR + chp) = cvt_pk_bf16(o.x, o.y); }
#undef FOLD4
#undef MINE
    }
    LBAR();
}
}


#define XB_TMO      128
#define XB_XCNT(j)  (256  + 64 * (j))
#define XB_XSUB(j)  (1280 + 64 * (j))
#define XB_XGEN(j)  (2304 + 64 * (j))
#define XB_TOP      3328
#define XB_TOPGEN   3392
#define XCD_BAR_WORDS 3456
#define XB_SPIN_CAP (1u << 20)
constexpr size_t CTL_ZERO_BYTES = 16384;
__device__ __forceinline__ unsigned xb_ld(unsigned* p)              { return __hip_atomic_load(p, __ATOMIC_RELAXED, __HIP_MEMORY_SCOPE_AGENT); }
__device__ __forceinline__ unsigned xb_add(unsigned* p, unsigned v) { return __hip_atomic_fetch_add(p, v, __ATOMIC_RELAXED, __HIP_MEMORY_SCOPE_AGENT); }
__device__ __forceinline__ unsigned xb_xcc_id() { return (unsigned)__builtin_amdgcn_s_getreg((3 << 11) | 20) & 0xFu; }
#define XB_SPIN(cond, bar) do { unsigned _sp = 0; while (cond) { __builtin_amdgcn_s_sleep(1); \
    if ((++_sp & 255u) == 0u) { if (xb_ld(&(bar)[XB_TMO])) break; if (_sp > XB_SPIN_CAP) { atomicAdd(&(bar)[XB_TMO], 1u); break; } } } } while (0)
struct XcdBarrier { unsigned* bar; unsigned x; volatile LAS unsigned* st; };
__device__ __forceinline__ XcdBarrier xcd_barrier_post(unsigned* bar, volatile LAS unsigned* st) {
    XcdBarrier b; b.bar = bar; b.x = xb_xcc_id(); b.st = st;
    if (threadIdx.x == 0) (void)xb_add(&bar[XB_XCNT(b.x)], 1u);
    return b;
}
__device__ __forceinline__ void xcd_barrier_complete(unsigned* bar, unsigned x, unsigned& nloc, unsigned& nx) {
    const unsigned G = gridDim.x * gridDim.y * gridDim.z;
    unsigned sum, cnt, mine, sp = 0u;
    for (;;) {
        sum = 0u; cnt = 0u; mine = 0u;
#pragma unroll
        for (unsigned j = 0; j < 16; ++j) { const unsigned c = xb_ld(&bar[XB_XCNT(j)]); sum += c; cnt += (c > 0u) ? 1u : 0u; mine = (j == x) ? c : mine; }
        if (sum == G) break;
        __builtin_amdgcn_s_sleep(1);
        if ((++sp & 255u) == 0u) { if (xb_ld(&bar[XB_TMO])) break; if (sp > XB_SPIN_CAP) { atomicAdd(&bar[XB_TMO], 1u); break; } }
    }
    nloc = mine > 0u ? mine : 1u; nx = cnt > 0u ? cnt : 1u;
}
__device__ __forceinline__ void xcd_barrier(const XcdBarrier& b) {
    asm volatile("s_waitcnt vmcnt(0)" ::: "memory");
    __syncthreads();
    if (threadIdx.x == 0) {
        unsigned* bar = b.bar;
        __builtin_amdgcn_s_waitcnt(0);
        unsigned nloc = b.st[0], nx = b.st[1];
        if (nloc == 0u) { xcd_barrier_complete(bar, b.x, nloc, nx); b.st[0] = nloc; b.st[1] = nx; }
        const unsigned old = xb_add(&bar[XB_XSUB(b.x)], 1u);
        const unsigned gen = old / nloc;
        if (old + 1u == (gen + 1u) * nloc) {
            __builtin_amdgcn_fence(__ATOMIC_RELEASE, "agent");
            asm volatile("s_waitcnt vmcnt(0)" ::: "memory");
            const unsigned og = xb_add(&bar[XB_TOP], 1u);
            const unsigned tg = og / nx;
            if (og + 1u == (tg + 1u) * nx) xb_add(&bar[XB_TOPGEN], 1u);
            else XB_SPIN(xb_ld(&bar[XB_TOPGEN]) == tg, bar);
            __builtin_amdgcn_fence(__ATOMIC_ACQUIRE, "agent");
            xb_add(&bar[XB_XGEN(b.x)], 1u);
            asm volatile("s_waitcnt vmcnt(0)" ::: "memory");
        } else {
            XB_SPIN(xb_ld(&bar[XB_XGEN(b.x)]) == gen, bar);
            __builtin_amdgcn_fence(__ATOMIC_ACQUIRE, "agent");
            asm volatile("s_waitcnt vmcnt(0)" ::: "memory");
        }
    }
    __syncthreads();
}

constexpr int NPHASE = 10;
constexpr int NOJUMP = 1 << 30;
template <int LO, int HI>
__global__ void __launch_bounds__(NTHR, 2) fwd_kernel(Args a) {
    extern __shared__ __attribute__((aligned(16))) unsigned char lds_raw[];
    Frame F; F.lds = (LAS unsigned char*)lds_raw; F.tid = threadIdx.x; F.lane = F.tid & 63; F.wave = __builtin_amdgcn_readfirstlane(F.tid >> 6);
    F.G = gridDim.x; { const int bx = blockIdx.x; F.vcu = (F.G % 8 == 0) ? (bx % 8) * (F.G / 8) + bx / 8 : bx; }
    unsigned char* ws = a.ws; bf16_t* Z = (bf16_t*)(ws + WS_Z);
    unsigned char* slots = (unsigned char*)a.out;
    if (F.tid == 0) {
#pragma unroll
        for (int i = 0; i < 27; ++i) *(const float* LAS*)(F.lds + PTRS_OFF + i * 8) = a.in[i];
        *(volatile LAS unsigned*)(F.lds + PTRS_OFF + 224) = 0u; *(volatile LAS unsigned*)(F.lds + PTRS_OFF + 228) = 0u;
        *(LAS unsigned long long*)(F.lds + PTRS_OFF - 64) = 0ull;
    }
    __syncthreads();
#if ONE_LAUNCH && !USE_CG
    const XcdBarrier bar = xcd_barrier_post((unsigned*)(ws + WS_CTL), (volatile LAS unsigned*)(F.lds + PTRS_OFF + 224));
#endif
#if ONE_LAUNCH
#if PROBE_SEG >= 0 || PROBE_CLK >= 0
    unsigned long long* tsb = (unsigned long long*)(ws + WS_CTL + 15872); int nts = 0;
#define STAMP() do { if (blockIdx.x == 0 && F.tid == 0) { tsb[nts] = __builtin_amdgcn_s_memrealtime(); tsb[32 + nts] = __builtin_amdgcn_s_memtime(); } ++nts; } while (0)
    STAMP();
#else
#define STAMP() do { } while (0)
#endif
#if USE_CG
#define SEAM(k) do { if constexpr ((k) + 1 < HI) { cg::this_grid().sync(); STAMP(); } } while (0)
#define RSYNC() do { cg::this_grid().sync(); STAMP(); } while (0)
#else
#define SEAM(k) do { if constexpr ((k) + 1 < HI) { xcd_barrier(bar); STAMP(); } } while (0)
#define RSYNC() do { xcd_barrier(bar); STAMP(); } while (0)
#endif
#else
#define SEAM(k) do { } while (0)
#define RSYNC() do { } while (0)
#endif
#define IN(k) (LO <= (k) && (k) < HI)
    if constexpr (IN(0)) { p0_prologue(F, a); SEAM(0);
#if PROBE_DOUBLE == 4
        p0_prologue(F, a); RSYNC();
#endif
    }
    if constexpr (IN(1)) { pg8::Gemm g{(const char*)a.out, (const bf16_t*)(ws + WS_WIN), MTOK, ZP, DM, DM * 2, NOJUMP, 0}; pg8::StaticOrder S; S.init(MTOK, ZP, F.G, (int)blockIdx.x);
        pg8::EpiZ E{Z, ZP}; pg8::gemm_phase<pg8::EpiZ, pg8::StaticOrder, true>(F.lds, g, S, E); SEAM(1);
#if PROBE_DOUBLE == 3
        pg8::gemm_phase<pg8::EpiZ, pg8::StaticOrder, true>(F.lds, g, S, E); RSYNC();
#endif
    }
    if constexpr (IN(2)) { qk_prep(F, a);
        unsigned* rdy = (unsigned*)(ws + WS_CTL) + 3584;
#pragma unroll 1
        for (int rnd = 0; rnd < 2; ++rnd) {
            const int nprod = rnd == 1 ? F.G - 16 : F.G;
            if (F.vcu < nprod) {
#define S1_DECODE(i_, d_, q_, h_, ck_, it_, pub_) do { if (rnd == 1) { const int c_ = ((i_) >> 4) & 15, cc_ = (((i_) >> 8) << 4) + ((i_) & 15); d_ = c_ >> 3; h_ = c_ & 7; q_ = 0; ck_ = d_ ? 255 - cc_ : cc_; it_ = c_ * 256 + ck_; pub_ = rdy + c_ * 16 + ((i_) >> 8); } \
                    else { ck_ = (i_) & 31; h_ = ((i_) >> 5) & 7; q_ = 1 + (((i_) >> 8) & 7); d_ = (i_) >> 11; it_ = (i_); pub_ = nullptr; } } while (0)
                { int d, q, h, ck, it; unsigned* pub; S1_DECODE(F.vcu, d, q, h, ck, it, pub); (void)it; (void)pub;
                  u32x4 stg[6]; rw::s1_stage_load(a, F.tid, q, h, ck, stg); const f32x2_t par = rw::s1_param_load(F.lds, F.tid, d, h);
                  rw::s1_stage_store(F.lds, F.tid, d, q, ck, stg, par); LBAR(); }
                unsigned* pub_prev = nullptr;
#pragma unroll 1
                for (int i = F.vcu; i < 4096; i += nprod) {
                    int d, q, h, ck, it, nd, nq, nh, nck, nit; unsigned* pub; unsigned* npub; S1_DECODE(i, d, q, h, ck, it, pub); const int ni = i + nprod < 4096 ? i + nprod : i; S1_DECODE(ni, nd, nq, nh, nck, nit, npub); (void)nit; (void)npub;
                    rw::s1_item(F, a, d, q, h, ck, slots + (size_t)it * SLOT_BYTES, nd, nq, nh, nck, rnd == 1, pub_prev); pub_prev = pub; }
                if (pub_prev) { asm volatile("s_waitcnt vmcnt(0)" ::: "memory"); __syncthreads(); if (F.tid == 0) __hip_atomic_fetch_add(pub_prev, 1u, __ATOMIC_RELAXED, __HIP_MEMORY_SCOPE_AGENT); }
#undef S1_DECODE
            } else {
                const int c = F.vcu - nprod;
                rw::s23_chain_wg(F, a, c >> 3, 0, c & 7, slots + (size_t)c * 256 * SLOT_BYTES, rdy + c * 16);
            }
            if (rnd == 0) {
                RSYNC();
                for (int chain = F.vcu; chain < 128; chain += F.G) { const int h = chain & 7, q = 1 + ((chain >> 3) & 7), d = chain >> 6;
                    rw::s23_chain_wg(F, a, d, q, h, slots + (size_t)chain * 32 * SLOT_BYTES, nullptr); }
            }
            RSYNC();
            {
#define PO_DECODE(it_, q_, h_, b_) do { if (rnd == 1) { q_ = 0; h_ = ((it_) >> 8) & 7; b_ = (it_) & 255; } else { q_ = 1 + (((it_) >> 8) & 7); h_ = ((it_) >> 5) & 7; b_ = (it_) & 31; } } while (0)
                rw::PostPre pp;
                { int q, h, b; PO_DECODE(F.vcu, q, h, b); rw::post_stage_load(a, F.tid, q, h, b, pp); }
#pragma unroll 1
                for (int it = F.vcu; it < 2048; it += F.G) { int q, h, b, nq, nh, nb; PO_DECODE(it, q, h, b); const int nit = it + F.G < 2048 ? it + F.G : it; PO_DECODE(nit, nq, nh, nb);
                    rw::post_item(F, a, q, h, b, pp, nq, nh, nb); }
#undef PO_DECODE
            }
            if (rnd == 0) RSYNC();
        }
          }
    if constexpr (IN(4)) {
        float lam; { const float p1 = wave_sum(a.in[6][F.lane] * a.in[7][F.lane]), p2 = wave_sum(a.in[8][F.lane] * a.in[9][F.lane]); lam = __expf(p1) - __expf(p2) + LAMBDA_INIT; }
#if PROBE_DOUBLE == 1
        for (int v = F.vcu; v < 256; v += F.G) {
            att::attn_unit(0, SP, v >> 6, v & 63, Z, F.lds, lam, a.in[10], (bf16_t*)a.out, 512);
            att::attn_unit(SP + (v >> 5) * SS, SS, (v >> 3) & 3, v & 7, Z, F.lds, lam, a.in[10], (bf16_t*)a.out, 512); }
        RSYNC();
#endif
        for (int v = F.vcu; v < 256; v += F.G) {
            att::attn_unit(0, SP, v >> 6, v & 63, Z, F.lds, lam, a.in[10], Z, ZP);
            att::attn_unit(SP + (v >> 5) * SS, SS, (v >> 3) & 3, v & 7, Z, F.lds, lam, a.in[10], Z, ZP); }
        SEAM(4); }
    if constexpr (IN(5)) { pg8::Gemm g{(const char*)Z, (const bf16_t*)(ws + WS_WOUT), MTOK, DM, DM, ZP * 2, 8, 2048}; pg8::StaticOrder S; S.init(MTOK, DM, F.G, (int)blockIdx.x);
        pg8::EpiOut E{a.in[0], a.in[1], a.out, Z, (float*)(ws + WS_ROWSQ)}; pg8::gemm_phase<pg8::EpiOut, pg8::StaticOrder, true>(F.lds, g, S, E); SEAM(5); }
#define FFN_UP(k, half) if constexpr (IN(k)) { pg8::Gemm g{(const char*)(Z + (size_t)(half) * 16384 * ZP + ZXN2), (const bf16_t*)(ws + WS_W1), 16384, DFF, DM, ZP * 2, NOJUMP, 0}; pg8::StaticOrder S; S.init(16384, DFF, F.G, (int)blockIdx.x); \
        pg8::EpiUp E{(char*)(ws + WS_Z), (const float*)(ws + WS_ROWSQ), (half) * 16384}; pg8::gemm_phase<pg8::EpiUp, pg8::StaticOrder, true>(F.lds, g, S, E); SEAM(k); }
#define FFN_DN(k, half) if constexpr (IN(k)) { pg8::Gemm g{(const char*)(ws + WS_Z), (const bf16_t*)(ws + WS_W2), 16384, DM, DFF, 13312, 32, 2560}; pg8::StaticOrder S; S.init(16384, DM, F.G, (int)blockIdx.x); \
        pg8::EpiDown E{a.out, Z, (half) * 16384}; pg8::gemm_phase<pg8::EpiDown, pg8::StaticOrder, true>(F.lds, g, S, E); SEAM(k); }
    FFN_UP(6, 0) FFN_DN(7, 0) FFN_UP(8, 1) FFN_DN(9, 1)
#if PROBE_S1 >= 0 || PROBE_ATT
    if (F.tid == 0) { const unsigned long long dt = *(LAS unsigned long long*)(F.lds + PTRS_OFF - 64), t0_ = __builtin_amdgcn_s_memrealtime();
        while (__builtin_amdgcn_s_memrealtime() - t0_ < dt) __builtin_amdgcn_s_sleep(16); }
#endif
#if PROBE_SEG >= 0 || PROBE_CLK >= 0
    STAMP();
#if PROBE_CLK >= 0
    if (blockIdx.x == 0 && F.tid == 0) { asm volatile("s_waitcnt vmcnt(0)" ::: "memory"); const unsigned long long wt_ = tsb[PROBE_CLK + 1] - tsb[PROBE_CLK], cy_ = tsb[32 + PROBE_CLK + 1] - tsb[32 + PROBE_CLK];
        const unsigned long long dt = cy_ * 1000ull / (wt_ ? wt_ : 1ull), t0_ = __builtin_amdgcn_s_memrealtime();
        while (__builtin_amdgcn_s_memrealtime() - t0_ < dt) __builtin_amdgcn_s_sleep(16); }
#endif
    if (PROBE_CLK < 0 && blockIdx.x == 0 && F.tid == 0) { asm volatile("s_waitcnt vmcnt(0)" ::: "memory"); const unsigned long long dt = tsb[PROBE_SEG + 1] - tsb[PROBE_SEG], t0_ = __builtin_amdgcn_s_memrealtime();
        while (__builtin_amdgcn_s_memrealtime() - t0_ < dt) __builtin_amdgcn_s_sleep(16); }
#endif
#undef FFN_UP
#undef FFN_DN
#undef IN
#undef SEAM
#undef RSYNC
}

extern "C" void kernel_launch(void* const* d_in, const int* in_sizes, int n_in, void* d_out, int out_size, void* d_ws, size_t ws_size, hipStream_t stream) {
    static int grid = 0;
    if (grid == 0) {
        if (n_in != 27 || out_size != MTOK * DM || ws_size < WS_TOTAL) { fprintf(stderr, "kernel_launch: unexpected shapes (n_in %d out %d ws %zu)\n", n_in, out_size, ws_size); grid = -1; return; }
        int dev = 0, cus = 0; (void)hipGetDevice(&dev); (void)hipDeviceGetAttribute(&cus, hipDeviceAttributeMultiprocessorCount, dev);
        bool ok = true;
#if ONE_LAUNCH
        ok = ok && hipFuncSetAttribute((const void*)fwd_kernel<0, NPHASE>, hipFuncAttributeMaxDynamicSharedMemorySize, LDS_BYTES) == hipSuccess;
        int per_cu = 0; (void)hipOccupancyMaxActiveBlocksPerMultiprocessor(&per_cu, (const void*)fwd_kernel<0, NPHASE>, NTHR, LDS_BYTES); (void)hipGetLastError();
        if (per_cu < 1) fprintf(stderr, "kernel_launch: occupancy query says %d blocks/CU\n", per_cu);
#else
#define SETA(p) ok = ok && hipFuncSetAttribute((const void*)fwd_kernel<p, p + 1>, hipFuncAttributeMaxDynamicSharedMemorySize, LDS_BYTES) == hipSuccess;
        SETA(0) SETA(1) SETA(2) SETA(3) SETA(4) SETA(5) SETA(6) SETA(7) SETA(8) SETA(9)
#undef SETA
#endif
        if (!ok) { fprintf(stderr, "kernel_launch: hipFuncSetAttribute failed\n"); grid = -1; return; }
        grid = cus > 256 ? 256 : cus;
    }
    if (grid < 0) return;
    Args a{};
    for (int i = 0; i < 27; ++i) a.in[i] = (const float*)d_in[i];
    a.out = (float*)d_out; a.ws = (unsigned char*)d_ws;
#if ONE_LAUNCH
    a.ph_lo = 0; a.ph_hi = NPHASE;
#if !USE_CG
    if (hipMemsetAsync((char*)d_ws + WS_CTL, 0, CTL_ZERO_BYTES, stream) != hipSuccess) { fprintf(stderr, "kernel_launch: hipMemsetAsync failed\n"); return; }
#endif
    void* args[] = {&a};
    hipError_t e = hipLaunchCooperativeKernel((const void*)fwd_kernel<0, NPHASE>, dim3(grid), dim3(NTHR), args, LDS_BYTES, stream);
    if (e != hipSuccess) fprintf(stderr, "cooperative launch failed: %s (grid %d)\n", hipGetErrorString(e), grid);
#else
#define LAUNCH(p) hipLaunchKernelGGL((fwd_kernel<p, p + 1>), dim3(grid), dim3(NTHR), LDS_BYTES, stream, a);
    LAUNCH(0) LAUNCH(1) LAUNCH(2) LAUNCH(3) LAUNCH(4) LAUNCH(5) LAUNCH(6) LAUNCH(7) LAUNCH(8) LAUNCH(9)
#undef LAUNCH
#endif
}
```
